# Optimizing an MI355X kernel written in HIP

```python
import numpy as np
import jax
import jax.numpy as jnp
from jax import lax

D_MODEL = 1024
BATCH = 4
SEQ = 4096
DEPTH = 2

GRID_W = 64
CTX_LEN = 256
RMS_EPS = 1e-6

SSD_HEAD_DIM = 64
SSD_W = D_MODEL
SSD_HEADS = SSD_W // SSD_HEAD_DIM
SSD_GROUPS = 2
SSD_STATE = 128
SSD_CONV = 3
SSD_CHUNK = 128
XBC_W = SSD_W + 2 * SSD_GROUPS * SSD_STATE

ML_HEADS = 4
ML_V_W = D_MODEL
ML_DV = ML_V_W // ML_HEADS
ML_DK = ML_DV // 2
ML_CHUNK = 64

MIX_W = SSD_W + ML_V_W
IN_SIZES = (SSD_W, XBC_W, 2 * SSD_HEADS, ML_HEADS * ML_DK, ML_HEADS * ML_DK, ML_V_W, ML_V_W, 2 * ML_HEADS, 2 * ML_HEADS)
IN_W = sum(IN_SIZES)
IN_SPLITS = [int(v) for v in np.cumsum(IN_SIZES)[:-1]]

NA_HEAD_DIM = 64
NA_HEADS = D_MODEL // NA_HEAD_DIM
NA_W = NA_HEADS * NA_HEAD_DIM
NA_KH = 8
NA_KW = 16

MOE_GROUPS = 4
MOE_EXPERTS = 8
MOE_TOP_K = 2
MOE_FF = D_MODEL // 2

kernel_name = 'hybrid_ssd_mlstm_natten_hmoe_prefix'


def _rms_norm(x, w):
    xf = x.astype(jnp.float32)
    y = xf * lax.rsqrt(jnp.mean(xf * xf, axis=-1, keepdims=True) + RMS_EPS)
    return (y * w).astype(x.dtype)


def _modulate(h, shift, scale):
    return h * (1 + scale) + shift


def _centred_dwconv(u, w, b):
    ch = u.shape[-1]
    pad = w.shape[0] // 2
    y = lax.conv_general_dilated(u, w[:, None, :], window_strides=(1,), padding=[(pad, pad)],
                                 dimension_numbers=('NWC', 'WIO', 'NWC'), feature_group_count=ch)
    return y + b


def _ssd_chunked(xdt, log_a, b_in, c_in, state0):
    bsz, L, H, P = xdt.shape
    G, N = b_in.shape[2], b_in.shape[3]
    E = H // G
    nc = L // SSD_CHUNK
    xc = xdt.reshape(bsz, nc, SSD_CHUNK, G, E, P)
    bc = b_in.reshape(bsz, nc, SSD_CHUNK, G, N)
    cc = c_in.reshape(bsz, nc, SSD_CHUNK, G, N)
    ac = log_a.astype(jnp.float32).reshape(bsz, nc, SSD_CHUNK, G, E).transpose(0, 1, 3, 4, 2)
    a_cs = jnp.cumsum(ac, axis=-1)
    causal = jnp.tril(jnp.ones((SSD_CHUNK, SSD_CHUNK), dtype=bool))
    decay = jnp.exp(jnp.where(causal, a_cs[..., :, None] - a_cs[..., None, :], -jnp.inf))
    cb = jnp.einsum('bclgn,bcsgn->bcgls', cc, bc)
    y_diag = jnp.einsum('bcgels,bcsgep->bclgep', cb[:, :, :, None] * decay, xc)
    decay_to_end = jnp.exp(a_cs[..., -1:] - a_cs)
    chunk_states = jnp.einsum('bclgn,bcgel,bclgep->bcgepn', bc, decay_to_end, xc)
    chunk_decay = jnp.exp(a_cs[..., -1])

    def step(s, inp):
        cs, cd = inp
        return s * cd[..., None, None] + cs, s

    s0 = state0.reshape(bsz, G, E, P, N)
    final, prev = lax.scan(step, s0, (jnp.moveaxis(chunk_states, 1, 0), jnp.moveaxis(chunk_decay, 1, 0)))
    prev = jnp.moveaxis(prev, 0, 1)
    y_off = jnp.einsum('bclgn,bcgepn,bcgel->bclgep', cc, prev, jnp.exp(a_cs))
    y = (y_diag + y_off).reshape(bsz, L, H, P)
    return y, final.reshape(bsz, H, P, N)


def _mlstm_chunked(q, k, v, log_i, log_f, state0):
    bsz, L, H, Dk = q.shape
    Dv = v.shape[-1]
    nc = L // ML_CHUNK
    qc = q.reshape(bsz, nc, ML_CHUNK, H, Dk)
    kc = k.reshape(bsz, nc, ML_CHUNK, H, Dk)
    vc = v.reshape(bsz, nc, ML_CHUNK, H, Dv)
    li = log_i.astype(jnp.float32).reshape(bsz, nc, ML_CHUNK, H).transpose(0, 1, 3, 2)
    lf = log_f.astype(jnp.float32).reshape(bsz, nc, ML_CHUNK, H).transpose(0, 1, 3, 2)
    bcum = jnp.cumsum(lf, axis=-1)
    causal = jnp.tril(jnp.ones((ML_CHUNK, ML_CHUNK), dtype=bool))
    dmat = jnp.where(causal, bcum[..., :, None] - bcum[..., None, :] + li[..., None, :], -jnp.inf)
    m_intra = jnp.max(dmat, axis=-1)
    a_end = bcum[..., -1:] - bcum + li
    m_loc = jnp.max(a_end, axis=-1)
    w_end = jnp.exp(a_end - m_loc[..., None])
    c_chunk = jnp.einsum('bchl,bclhk,bclhe->bchke', w_end, kc, vc)
    n_chunk = jnp.einsum('bchl,bclhk->bchk', w_end, kc)
    g_chunk = bcum[..., -1]

    def step(carry, inp):
        C, n, m = carry
        cc_, nc_, ml, gg = inp
        m_new = jnp.maximum(gg + m, ml)
        a = jnp.exp(gg + m - m_new)
        bb = jnp.exp(ml - m_new)
        new = (C * a[..., None, None] + cc_ * bb[..., None, None], n * a[..., None] + nc_ * bb[..., None], m_new)
        return new, (C, n, m)

    final, (c_prev, n_prev, m_prev) = lax.scan(
        step, state0, (jnp.moveaxis(c_chunk, 1, 0), jnp.moveaxis(n_chunk, 1, 0),
                       jnp.moveaxis(m_loc, 1, 0), jnp.moveaxis(g_chunk, 1, 0)))
    c_prev = jnp.moveaxis(c_prev, 0, 1)
    n_prev = jnp.moveaxis(n_prev, 0, 1)
    m_prev = jnp.moveaxis(m_prev, 0, 1)
    m_inter = bcum + m_prev[..., None]
    m_t = jnp.maximum(m_intra, m_inter)
    s = jnp.einsum('bclhk,bcshk->bchls', qc, kc) * jnp.exp(dmat - m_t[..., None])
    w_inter = jnp.exp(m_inter - m_t)
    num = (jnp.einsum('bchls,bcshe->bclhe', s, vc)
           + jnp.einsum('bclhk,bchke->bclhe', qc, c_prev) * w_inter.transpose(0, 1, 3, 2)[..., None])
    den = jnp.sum(s, axis=-1) + jnp.einsum('bclhk,bchk->bchl', qc, n_prev) * w_inter
    den = jnp.maximum(jnp.abs(den), jnp.exp(-m_t))
    h = num / den.transpose(0, 1, 3, 2)[..., None]
    return h.reshape(bsz, L, H, Dv), final


def _ab_streams(h, w_in, conv_w, conv_b, dt_bias):
    bsz, L, _ = h.shape
    z, xbc, dt_raw, q, k, v, o, i_raw, f_raw = jnp.split(h @ w_in, IN_SPLITS, axis=-1)
    xbc = jax.nn.silu(_centred_dwconv(xbc, conv_w, conv_b))
    xs, b_ssm, c_ssm = jnp.split(xbc, [SSD_W, SSD_W + SSD_GROUPS * SSD_STATE], axis=-1)
    dt = jax.nn.softplus(dt_raw.reshape(bsz, L, 2, SSD_HEADS).astype(jnp.float32) + dt_bias.astype(jnp.float32))
    return {
        'z': z,
        'xs': xs.reshape(bsz, L, SSD_HEADS, SSD_HEAD_DIM),
        'b': b_ssm.reshape(bsz, L, SSD_GROUPS, SSD_STATE),
        'c': c_ssm.reshape(bsz, L, SSD_GROUPS, SSD_STATE),
        'dt': dt,
        'q': q.reshape(bsz, L, ML_HEADS, ML_DK),
        'k': k.reshape(bsz, L, ML_HEADS, ML_DK) * ML_DK ** -0.5,
        'v': v.reshape(bsz, L, ML_HEADS, ML_DV),
        'o': o,
        'i': i_raw.reshape(bsz, L, 2, ML_HEADS).astype(jnp.float32),
        'f': f_raw.reshape(bsz, L, 2, ML_HEADS).astype(jnp.float32),
    }


def _ssd_direction(s, d, a, state0):
    dt = s['dt']
    xdt = s['xs'] * dt[:, :, d, :, None]
    la = dt[:, :, d] * a[d]
    bm, cm = s['b'], s['c']
    if d == 1:
        xdt, la, bm, cm = (jnp.flip(t, axis=1) for t in (xdt, la, bm, cm))
    y, fin = _ssd_chunked(xdt, la, bm, cm, state0)
    if d == 1:
        y = jnp.flip(y, axis=1)
    return y, fin


def _mlstm_direction(s, d, i_bias, f_bias, state0):
    log_i = s['i'][:, :, d] + i_bias[d].astype(jnp.float32)
    log_f = jax.nn.log_sigmoid(s['f'][:, :, d] + f_bias[d].astype(jnp.float32))
    q, k, v = s['q'], s['k'], s['v']
    if d == 1:
        q, k, v, log_i, log_f = (jnp.flip(t, axis=1) for t in (q, k, v, log_i, log_f))
    h, fin = _mlstm_chunked(q, k, v, log_i, log_f, state0)
    if d == 1:
        h = jnp.flip(h, axis=1)
    return h, fin


def _ab_output(s, y_ssd, h_ml, d_skip, ssd_norm_w, ml_norm_w, w_out):
    bsz, L = y_ssd.shape[:2]
    dtype = s['z'].dtype
    y = (y_ssd + d_skip[:, None] * s['xs']).reshape(bsz, L, SSD_W) * jax.nn.silu(s['z'])
    y = _rms_norm(y, ssd_norm_w)
    hm = _rms_norm(h_ml, ml_norm_w).reshape(bsz, L, ML_V_W) * jax.nn.sigmoid(s['o'])
    return jnp.concatenate([y.astype(dtype), hm.astype(dtype)], axis=-1) @ w_out


def _ssd_mlstm_mixer(h_lat, h_ctx, w_in, conv_w, conv_b, a_log, dt_bias, d_skip, ssd_norm_w,
                     ml_i_bias, ml_f_bias, ml_norm_w, w_out, need_ctx):
    s_ctx = _ab_streams(h_ctx, w_in, conv_w, conv_b, dt_bias)
    s_lat = _ab_streams(h_lat, w_in, conv_w, conv_b, dt_bias)
    a = -jnp.exp(a_log.astype(jnp.float32))
    bsz = h_lat.shape[0]
    ssd0 = jnp.zeros((bsz, SSD_HEADS, SSD_HEAD_DIM, SSD_STATE), jnp.float32)
    ml0 = (jnp.zeros((bsz, ML_HEADS, ML_DK, ML_DV), jnp.float32),
           jnp.zeros((bsz, ML_HEADS, ML_DK), jnp.float32),
           jnp.zeros((bsz, ML_HEADS), jnp.float32))
    y_c, y_l, m_c, m_l = [], [], [], []
    for d in range(2):
        yc, sc = _ssd_direction(s_ctx, d, a, ssd0)
        yl, _ = _ssd_direction(s_lat, d, a, sc)
        hc, mc = _mlstm_direction(s_ctx, d, ml_i_bias, ml_f_bias, ml0)
        hl, _ = _mlstm_direction(s_lat, d, ml_i_bias, ml_f_bias, mc)
        y_c.append(yc); y_l.append(yl); m_c.append(hc); m_l.append(hl)
    o_lat = _ab_output(s_lat, y_l[0] + y_l[1], m_l[0] + m_l[1], d_skip, ssd_norm_w, ml_norm_w, w_out)
    o_ctx = None
    if need_ctx:
        o_ctx = _ab_output(s_ctx, y_c[0] + y_c[1], m_c[0] + m_c[1], d_skip, ssd_norm_w, ml_norm_w, w_out)
    return o_lat, o_ctx


def _na_qkv(h, w_qkv, q_norm, k_norm):
    q, k, v = jnp.split(h @ w_qkv, 3, axis=-1)
    shp = h.shape[:-1] + (NA_HEADS, NA_HEAD_DIM)
    q = _rms_norm(q.reshape(shp), q_norm) * NA_HEAD_DIM ** -0.5
    k = _rms_norm(k.reshape(shp), k_norm)
    return q, k, v.reshape(shp)


def _neighbourhood_attention(h_lat, h_ctx, w_qkv, q_norm, k_norm, rpb, w_out, need_ctx):
    bsz, seq, _ = h_lat.shape
    dtype = h_lat.dtype
    rows = seq // GRID_W
    kh = min(NA_KH, rows)
    q_l, k_l, v_l = _na_qkv(h_lat, w_qkv, q_norm, k_norm)
    q_c, k_c, v_c = _na_qkv(h_ctx, w_qkv, q_norm, k_norm)
    grid = (bsz, rows, GRID_W, NA_HEADS, NA_HEAD_DIM)
    q_g, k_g, v_g = q_l.reshape(grid), k_l.reshape(grid), v_l.reshape(grid)
    cols = np.arange(GRID_W)
    col_start = np.clip(cols - NA_KW // 2, 0, GRID_W - NA_KW)
    col_idx = col_start[:, None] + np.arange(NA_KW)[None, :]
    col_off = col_idx - cols[:, None] + (NA_KW - 1)
    n_loc = kh * NA_KW

    def row_block(r):
        r0 = jnp.clip(r - kh // 2, 0, rows - kh)
        kr = lax.dynamic_slice_in_dim(k_g, r0, kh, axis=1)
        vr = lax.dynamic_slice_in_dim(v_g, r0, kh, axis=1)
        kw_ = kr[:, :, col_idx]
        vw_ = vr[:, :, col_idx]
        qr = lax.dynamic_index_in_dim(q_g, r, axis=1, keepdims=False)
        s_loc = jnp.einsum('bchd,bicjhd->bhcij', qr, kw_).astype(jnp.float32)
        row_off = r0 + jnp.arange(kh) - r + (NA_KH - 1)
        bias = rpb[:, row_off[:, None, None], col_off[None, :, :]].astype(jnp.float32)
        s_loc = s_loc + bias.transpose(0, 2, 1, 3)[None]
        s_ctx = jnp.einsum('bchd,bmhd->bhcm', qr, k_c).astype(jnp.float32)
        s_all = jnp.concatenate([s_loc.reshape(bsz, NA_HEADS, GRID_W, n_loc), s_ctx], axis=-1)
        p = jax.nn.softmax(s_all, axis=-1)
        p_loc = p[..., :n_loc].reshape(bsz, NA_HEADS, GRID_W, kh, NA_KW)
        o = (jnp.einsum('bhcij,bicjhd->bchd', p_loc, vw_)
             + jnp.einsum('bhcm,bmhd->bchd', p[..., n_loc:], v_c))
        return o.astype(dtype)

    o = lax.map(row_block, jnp.arange(rows))
    o_lat = jnp.moveaxis(o, 0, 1).reshape(bsz, seq, NA_W) @ w_out
    o_ctx = None
    if need_ctx:
        p = jax.nn.softmax(jnp.einsum('bqhd,bkhd->bhqk', q_c, k_c).astype(jnp.float32), axis=-1)
        oc = jnp.einsum('bhqk,bkhd->bqhd', p, v_c).astype(dtype)
        o_ctx = oc.reshape(bsz, h_ctx.shape[1], NA_W) @ w_out
    return o_lat, o_ctx


def _hier_moe(h, w_group, b_group, w_expert, b_expert, w_gate, w_up, w_down):
    t = h.shape[0]
    hf = h.astype(jnp.float32)
    p_group = jax.nn.softmax(hf @ w_group.astype(jnp.float32) + b_group.astype(jnp.float32), axis=-1)
    g_prob, g_idx = lax.top_k(p_group, 1)
    e_logits = (hf @ w_expert.astype(jnp.float32) + b_expert.astype(jnp.float32)).reshape(t, MOE_GROUPS, MOE_EXPERTS)
    e_logits = jnp.take_along_axis(e_logits, g_idx[:, :, None], axis=1)[:, 0]
    e_prob, e_idx = lax.top_k(jax.nn.softmax(e_logits, axis=-1), MOE_TOP_K)
    e_w = g_prob * e_prob / jnp.sum(e_prob, axis=-1, keepdims=True)
    w_in_group = jnp.einsum('tk,tke->te', e_w, jax.nn.one_hot(e_idx, MOE_EXPERTS, dtype=jnp.float32))
    combine = jax.nn.one_hot(g_idx[:, 0], MOE_GROUPS, dtype=jnp.float32)[:, :, None] * w_in_group[:, None, :]
    combine = combine.astype(h.dtype)
    out = jnp.zeros_like(h)
    for g in range(MOE_GROUPS):
        a = jnp.einsum('td,edf->tef', h, w_gate[g])
        u = jnp.einsum('td,edf->tef', h, w_up[g])
        act = jax.nn.silu(a) * u * combine[:, g, :, None]
        out = out + jnp.einsum('tef,efd->td', act, w_down[g])
    return out


def setup_inputs(seed: int = 0) -> dict:
    key = jax.random.key(seed)
    keys = iter(jax.random.split(key, 48))
    n_even = (DEPTH + 1) // 2
    n_odd = DEPTH // 2
    f32 = jnp.float32

    def nrm(shape, scale):
        return scale * jax.random.normal(next(keys), shape, f32)

    def gain(shape):
        return 1.0 + nrm(shape, 0.02)

    dt0 = jnp.exp(jax.random.uniform(next(keys), (n_even, 2, SSD_HEADS), f32, float(np.log(1e-3)), float(np.log(1e-1))))
    inp = {
        'x': nrm((BATCH, SEQ, D_MODEL), 1.0),
        'c': nrm((BATCH, D_MODEL), 1.0),
        'ctx': nrm((BATCH, CTX_LEN, D_MODEL), 1.0),
        'c_ctx': nrm((D_MODEL,), 1.0),
        'norm1_w': gain((DEPTH, D_MODEL)),
        'norm2_w': gain((DEPTH, D_MODEL)),
        'mod_w': nrm((DEPTH, D_MODEL, 6 * D_MODEL), D_MODEL ** -0.5),
        'mod_b': nrm((DEPTH, 6 * D_MODEL), 0.02),
        'ab_w_in': nrm((n_even, D_MODEL, IN_W), D_MODEL ** -0.5),
        'ab_conv_w': nrm((n_even, SSD_CONV, XBC_W), SSD_CONV ** -0.5),
        'ab_conv_b': nrm((n_even, XBC_W), 0.02),
        'ssd_a_log': jnp.log(jax.random.uniform(next(keys), (n_even, 2, SSD_HEADS), f32, 1.0, 16.0)),
        'ssd_dt_bias': dt0 + jnp.log(-jnp.expm1(-dt0)),
        'ssd_d': 1.0 + nrm((n_even, SSD_HEADS), 0.1),
        'ssd_norm_w': gain((n_even, SSD_W)),
        'ml_i_bias': nrm((n_even, 2, ML_HEADS), 0.1),
        'ml_f_bias': jnp.linspace(3.0, 6.0, ML_HEADS, dtype=f32) + nrm((n_even, 2, ML_HEADS), 0.1),
        'ml_norm_w': gain((n_even, ML_HEADS, ML_DV)),
        'ab_w_out': nrm((n_even, MIX_W, D_MODEL), MIX_W ** -0.5),
        'na_w_qkv': nrm((n_odd, D_MODEL, 3 * NA_W), D_MODEL ** -0.5),
        'na_q_norm': gain((n_odd, NA_HEAD_DIM)),
        'na_k_norm': gain((n_odd, NA_HEAD_DIM)),
        'na_rpb': nrm((n_odd, NA_HEADS, 2 * NA_KH - 1, 2 * NA_KW - 1), 0.1),
        'na_w_out': nrm((n_odd, NA_W, D_MODEL), NA_W ** -0.5),
        'moe_w_group': nrm((DEPTH, D_MODEL, MOE_GROUPS), D_MODEL ** -0.5),
        'moe_b_group': nrm((DEPTH, MOE_GROUPS), 0.01),
        'moe_w_expert': nrm((DEPTH, D_MODEL, MOE_GROUPS * MOE_EXPERTS), D_MODEL ** -0.5),
        'moe_b_expert': nrm((DEPTH, MOE_GROUPS * MOE_EXPERTS), 0.01),
        'moe_w_gate': nrm((DEPTH, MOE_GROUPS, MOE_EXPERTS, D_MODEL, MOE_FF), D_MODEL ** -0.5),
        'moe_w_up': nrm((DEPTH, MOE_GROUPS, MOE_EXPERTS, D_MODEL, MOE_FF), D_MODEL ** -0.5),
        'moe_w_down': nrm((DEPTH, MOE_GROUPS, MOE_EXPERTS, MOE_FF, D_MODEL), MOE_FF ** -0.5),
    }
    return inp


def reference(x, c, ctx, c_ctx, norm1_w, norm2_w, mod_w, mod_b,
              ab_w_in, ab_conv_w, ab_conv_b, ssd_a_log, ssd_dt_bias, ssd_d, ssd_norm_w,
              ml_i_bias, ml_f_bias, ml_norm_w, ab_w_out,
              na_w_qkv, na_q_norm, na_k_norm, na_rpb, na_w_out,
              moe_w_group, moe_b_group, moe_w_expert, moe_b_expert, moe_w_gate, moe_w_up, moe_w_down):
    bsz, seq, dm = x.shape
    n_lat = bsz * seq
    cond = jax.nn.silu(c)
    cond_ctx = jax.nn.silu(c_ctx)
    x_lat, x_ctx = x, ctx
    for layer in range(DEPTH):
        last = layer == DEPTH - 1
        j = layer // 2
        mod = jnp.split(cond @ mod_w[layer] + mod_b[layer], 6, axis=-1)
        mod_c = jnp.split(cond_ctx @ mod_w[layer] + mod_b[layer], 6, axis=-1)
        h_lat = _modulate(_rms_norm(x_lat, norm1_w[layer]), mod[0][:, None], mod[1][:, None])
        h_ctx = _modulate(_rms_norm(x_ctx, norm1_w[layer]), mod_c[0], mod_c[1])
        if layer % 2 == 0:
            o_lat, o_ctx = _ssd_mlstm_mixer(h_lat, h_ctx, ab_w_in[j], ab_conv_w[j], ab_conv_b[j], ssd_a_log[j],
                                            ssd_dt_bias[j], ssd_d[j], ssd_norm_w[j], ml_i_bias[j], ml_f_bias[j],
                                            ml_norm_w[j], ab_w_out[j], not last)
        else:
            o_lat, o_ctx = _neighbourhood_attention(h_lat, h_ctx, na_w_qkv[j], na_q_norm[j], na_k_norm[j],
                                                    na_rpb[j], na_w_out[j], not last)
        x_lat = x_lat + mod[2][:, None] * o_lat
        h_lat = _modulate(_rms_norm(x_lat, norm2_w[layer]), mod[3][:, None], mod[4][:, None]).reshape(n_lat, dm)
        moe_args = (moe_w_group[layer], moe_b_group[layer], moe_w_expert[layer], moe_b_expert[layer],
                    moe_w_gate[layer], moe_w_up[layer], moe_w_down[layer])
        if last:
            f_lat = _hier_moe(h_lat, *moe_args)
        else:
            x_ctx = x_ctx + mod_c[2] * o_ctx
            h_ctx = _modulate(_rms_norm(x_ctx, norm2_w[layer]), mod_c[3], mod_c[4]).reshape(-1, dm)
            f_all = _hier_moe(jnp.concatenate([h_lat, h_ctx], axis=0), *moe_args)
            f_lat = f_all[:n_lat]
            x_ctx = x_ctx + mod_c[5] * f_all[n_lat:].reshape(x_ctx.shape)
        x_lat = x_lat + mod[5][:, None] * f_lat.reshape(x_lat.shape)
    return x_lat
```

```cpp
#include <hip/hip_runtime.h>
#include <cstdio>
#include <cstdint>
namespace nv {
constexpr int D = 1024, SEQ = 4096, CTXL = 256, NT = SEQ + CTXL;
constexpr int INW = 5680;
constexpr int C_Z = 0, C_XBC = 1024, C_DT = 2560, C_Q = 2592, C_K = 3104, C_V = 3616, C_O = 4640, C_I = 5664, C_F = 5672;

__device__ __forceinline__ float siluf(float v) { return v / (1.f + expf(-v)); }
__device__ __forceinline__ float sigmf(float v) { return 1.f / (1.f + expf(-v)); }
__device__ __forceinline__ float softplusf(float v) { return v > 20.f ? v : log1pf(expf(v)); }
__device__ __forceinline__ float logsigf(float v) { return fminf(v, 0.f) - log1pf(expf(-fabsf(v))); }

__device__ __forceinline__ float wave_sum(float v) {
#pragma unroll
    for (int o = 32; o > 0; o >>= 1) v += __shfl_xor(v, o);
    return v;
}
__device__ __forceinline__ float block_sum256(float v, float* red) {
    v = wave_sum(v);
    __syncthreads();
    if ((threadIdx.x & 63) == 0) red[threadIdx.x >> 6] = v;
    __syncthreads();
    return red[0] + red[1] + red[2] + red[3];
}

__global__ void k_mod(const float* c, const float* c_ctx, const float* mod_w, const float* mod_b, float* modv) {
    int idx = blockIdx.x * 256 + threadIdx.x;
    if (idx >= 2 * 5 * 6144) return;
    int col = idx % 6144, r = (idx / 6144) % 5, layer = idx / (6144 * 5);
    const float* cv = r < 4 ? c + r * 1024 : c_ctx;
    const float* w = mod_w + (size_t)layer * 1024 * 6144;
    float acc = 0.f;
    for (int k = 0; k < 1024; ++k) acc += siluf(cv[k]) * w[(size_t)k * 6144 + col];
    modv[idx] = acc + mod_b[layer * 6144 + col];
}

__global__ void k_norm_mod(const float* xl, const float* xc, const float* nw, const float* modl, int shift_i, int scale_i, int b, float* out) {
    __shared__ float red[4];
    int r = blockIdx.x;
    const float* src = r < SEQ ? xl + (size_t)r * D : xc + (size_t)(r - SEQ) * D;
    const float* mv = modl + (size_t)(r < SEQ ? b : 4) * 6144;
    float v[4], ss = 0.f;
#pragma unroll
    for (int i = 0; i < 4; ++i) { v[i] = src[threadIdx.x + 256 * i]; ss += v[i] * v[i]; }
    ss = block_sum256(ss, red);
    float rs = rsqrtf(ss / D + 1e-6f);
#pragma unroll
    for (int i = 0; i < 4; ++i) { int cidx = threadIdx.x + 256 * i;
        out[(size_t)r * D + cidx] = v[i] * rs * nw[cidx] * (1.f + mv[scale_i * 1024 + cidx]) + mv[shift_i * 1024 + cidx]; }
}

__global__ void k_sgemm(const float* A, int lda, const float* B, int ldb, size_t strideB, float* C, int ldc, int M, int N, int K,
                        const int* list, int list_stride, const int* cnt, int a_shift) {
    __shared__ float As[16][65];
    __shared__ float Bs[16][64];
    const int z = blockIdx.z;
    const int Mv = cnt ? cnt[z] : M;
    const int m0 = blockIdx.y * 64, n0 = blockIdx.x * 64;
    if (m0 >= Mv) return;
    B += strideB * z;
    if (list) list += (size_t)list_stride * z;
    const int tid = threadIdx.x, tx = tid & 15, ty = tid >> 4;
    float acc[4][4];
#pragma unroll
    for (int i = 0; i < 4; ++i)
#pragma unroll
        for (int j = 0; j < 4; ++j) acc[i][j] = 0.f;
    int arow[4];
#pragma unroll
    for (int i = 0; i < 4; ++i) { int idx = tid + i * 256, row = idx >> 4; int gr = m0 + row;
        arow[i] = gr < Mv ? (list ? (list[gr] >> a_shift) : gr) : -1; }
    for (int k0 = 0; k0 < K; k0 += 16) {
#pragma unroll
        for (int i = 0; i < 4; ++i) { int idx = tid + i * 256, row = idx >> 4, kk = idx & 15;
            As[kk][row] = arow[i] >= 0 ? A[(size_t)arow[i] * lda + k0 + kk] : 0.f; }
#pragma unroll
        for (int i = 0; i < 4; ++i) { int idx = tid + i * 256, kk = idx >> 6, col = idx & 63;
            Bs[kk][col] = (n0 + col < N) ? B[(size_t)(k0 + kk) * ldb + n0 + col] : 0.f; }
        __syncthreads();
#pragma unroll
        for (int kk = 0; kk < 16; ++kk) {
            float a[4], bb[4];
#pragma unroll
            for (int i = 0; i < 4; ++i) a[i] = As[kk][ty * 4 + i];
#pragma unroll
            for (int j = 0; j < 4; ++j) bb[j] = Bs[kk][tx * 4 + j];
#pragma unroll
            for (int i = 0; i < 4; ++i)
#pragma unroll
                for (int j = 0; j < 4; ++j) acc[i][j] += a[i] * bb[j];
        }
        __syncthreads();
    }
#pragma unroll
    for (int i = 0; i < 4; ++i) { int gr = m0 + ty * 4 + i; if (gr >= Mv) continue;
        int crow = list ? list[gr] : gr;
#pragma unroll
        for (int j = 0; j < 4; ++j) { int gc = n0 + tx * 4 + j; if (gc < N) C[(size_t)crow * ldc + gc] = acc[i][j]; } }
}

__global__ void k_conv_silu(const float* proj, const float* cw, const float* cb, float* xbc) {
    int idx = blockIdx.x * 256 + threadIdx.x;
    if (idx >= NT * 1536) return;
    int c = idx % 1536, r = idx / 1536;
    bool hasp = (r != 0 && r != SEQ), hasn = (r != SEQ - 1 && r != NT - 1);
    float v = proj[(size_t)r * INW + C_XBC + c] * cw[1536 + c] + cb[c];
    if (hasp) v += proj[(size_t)(r - 1) * INW + C_XBC + c] * cw[c];
    if (hasn) v += proj[(size_t)(r + 1) * INW + C_XBC + c] * cw[2 * 1536 + c];
    xbc[idx] = siluf(v);
}

__device__ __forceinline__ int scan_row(int s, int d) {
    if (s < CTXL) return SEQ + (d ? CTXL - 1 - s : s);
    s -= CTXL; return d ? SEQ - 1 - s : s;
}

__global__ void __launch_bounds__(256) k_ssd(const float* proj, const float* xbc, const float* a_log, const float* dt_bias, float* yd) {
    const int d = blockIdx.x >> 4, h = blockIdx.x & 15, g = h >> 3;
    const int p = threadIdx.x >> 2, nq = threadIdx.x & 3;
    float S[32];
#pragma unroll
    for (int j = 0; j < 32; ++j) S[j] = 0.f;
    const float a = -expf(a_log[d * 16 + h]), dtb = dt_bias[d * 16 + h];
    for (int s = 0; s < NT; ++s) {
        const int r = scan_row(s, d);
        const float dt = softplusf(proj[(size_t)r * INW + C_DT + d * 16 + h] + dtb);
        const float dec = expf(dt * a);
        const float xv = xbc[(size_t)r * 1536 + h * 64 + p] * dt;
        const float* Bp = xbc + (size_t)r * 1536 + 1024 + g * 128 + nq * 32;
        const float* Cp = xbc + (size_t)r * 1536 + 1280 + g * 128 + nq * 32;
        float y = 0.f;
#pragma unroll
        for (int j = 0; j < 32; ++j) { S[j] = dec * S[j] + xv * Bp[j]; y += Cp[j] * S[j]; }
        y += __shfl_xor(y, 1); y += __shfl_xor(y, 2);
        if (nq == 0) yd[((size_t)d * NT + r) * 1024 + h * 64 + p] = y;
    }
}

__global__ void __launch_bounds__(256) k_mlstm(const float* proj, const float* i_bias, const float* f_bias, float* hd) {
    const int d = blockIdx.x >> 4, hh = (blockIdx.x >> 2) & 3, eb = blockIdx.x & 3;
    const int e = eb * 64 + (threadIdx.x >> 2), kq = threadIdx.x & 3;
    float Cs[32], ns[32];
#pragma unroll
    for (int j = 0; j < 32; ++j) { Cs[j] = 0.f; ns[j] = 0.f; }
    const float ib = i_bias[d * 4 + hh], fb = f_bias[d * 4 + hh];
    const float kscale = 0.08838834764831845f;
    for (int s = 0; s < NT; ++s) {
        const int r = scan_row(s, d);
        const float* pr = proj + (size_t)r * INW;
        const float li = pr[C_I + d * 4 + hh] + ib;
        const float lf = logsigf(pr[C_F + d * 4 + hh] + fb);
        const float fg = expf(lf), ig = expf(li);
        const float v = pr[C_V + hh * 256 + e];
        const float* qp = pr + C_Q + hh * 128 + kq * 32;
        const float* kp = pr + C_K + hh * 128 + kq * 32;
        float num = 0.f, den = 0.f;
#pragma unroll
        for (int j = 0; j < 32; ++j) { const float kk = kp[j] * kscale * ig, qq = qp[j];
            Cs[j] = fg * Cs[j] + kk * v; ns[j] = fg * ns[j] + kk; num += qq * Cs[j]; den += qq * ns[j]; }
        num += __shfl_xor(num, 1); num += __shfl_xor(num, 2);
        den += __shfl_xor(den, 1); den += __shfl_xor(den, 2);
        if (kq == 0) hd[((size_t)d * NT + r) * 1024 + hh * 256 + e] = num / fmaxf(fabsf(den), 1.f);
    }
}

__global__ void k_mixer_out(const float* proj, const float* xbc, const float* yd, const float* hd, const float* dskip,
                            const float* ssd_nw, const float* ml_nw, float* mix) {
    __shared__ float red[4];
    const int r = blockIdx.x, t = threadIdx.x;
    float yv[4], ss = 0.f;
#pragma unroll
    for (int i = 0; i < 4; ++i) { int c = t + 256 * i, h = c >> 6;
        float y = yd[(size_t)r * 1024 + c] + yd[((size_t)NT + r) * 1024 + c] + dskip[h] * xbc[(size_t)r * 1536 + c];
        y *= siluf(proj[(size_t)r * INW + C_Z + c]); yv[i] = y; ss += y * y; }
    ss = block_sum256(ss, red);
    float rs = rsqrtf(ss / 1024.f + 1e-6f);
#pragma unroll
    for (int i = 0; i < 4; ++i) { int c = t + 256 * i; mix[(size_t)r * 2048 + c] = yv[i] * rs * ssd_nw[c]; }
#pragma unroll
    for (int i = 0; i < 4; ++i) { int c = t + 256 * i;
        float hv = hd[(size_t)r * 1024 + c] + hd[((size_t)NT + r) * 1024 + c];
        float s2 = block_sum256(hv * hv, red);
        float rh = rsqrtf(s2 / 256.f + 1e-6f);
        mix[(size_t)r * 2048 + 1024 + c] = hv * rh * ml_nw[c] * sigmf(proj[(size_t)r * INW + C_O + c]); }
}

__global__ void k_resid(const float* xl, const float* xc, const float* o, const float* modl, int mi, int b, float* xout, int nrows) {
    size_t idx = (size_t)blockIdx.x * 256 + threadIdx.x;
    if (idx >= (size_t)nrows * D) return;
    int c = idx % D, r = idx / D;
    const float* src = r < SEQ ? xl + (size_t)r * D : xc + (size_t)(r - SEQ) * D;
    const float* mv = modl + (size_t)(r < SEQ ? b : 4) * 6144;
    xout[idx] = src[c] + mv[mi * 1024 + c] * o[idx];
}

__global__ void k_router(const float* h2, const float* wg, const float* bg, const float* we, const float* be,
                         int* route_e, float* route_w, int* cnt, int* list, int cap, int ntok) {
    const int tok = blockIdx.x * 4 + (threadIdx.x >> 6), lane = threadIdx.x & 63;
    if (tok >= ntok) return;
    const float* hp = h2 + (size_t)tok * D;
    float hv[16];
#pragma unroll
    for (int i = 0; i < 16; ++i) hv[i] = hp[lane + 64 * i];
    float lg[4];
#pragma unroll
    for (int j = 0; j < 4; ++j) { float a = 0.f;
#pragma unroll
        for (int i = 0; i < 16; ++i) a += hv[i] * wg[(size_t)(lane + 64 * i) * 4 + j];
        lg[j] = wave_sum(a) + bg[j]; }
    int gi = 0; float gm = lg[0];
#pragma unroll
    for (int j = 1; j < 4; ++j) if (lg[j] > gm) { gm = lg[j]; gi = j; }
    float gs = 0.f;
#pragma unroll
    for (int j = 0; j < 4; ++j) gs += expf(lg[j] - gm);
    const float gprob = 1.f / gs;
    float le[8];
#pragma unroll
    for (int j = 0; j < 8; ++j) { float a = 0.f;
#pragma unroll
        for (int i = 0; i < 16; ++i) a += hv[i] * we[(size_t)(lane + 64 * i) * 32 + gi * 8 + j];
        le[j] = wave_sum(a) + be[gi * 8 + j]; }
    int e0 = 0; float m0 = le[0];
#pragma unroll
    for (int j = 1; j < 8; ++j) if (le[j] > m0) { m0 = le[j]; e0 = j; }
    int e1 = -1; float m1 = -3.0e38f;
#pragma unroll
    for (int j = 0; j < 8; ++j) if (j != e0 && le[j] > m1) { m1 = le[j]; e1 = j; }
    const float p1 = expf(m1 - m0);
    const float w0 = gprob / (1.f + p1), w1 = gprob * p1 / (1.f + p1);
    if (lane == 0) {
        const int ge0 = gi * 8 + e0, ge1 = gi * 8 + e1;
        route_e[tok * 2] = ge0; route_e[tok * 2 + 1] = ge1; route_w[tok * 2] = w0; route_w[tok * 2 + 1] = w1;
        int s0 = atomicAdd(&cnt[ge0], 1); list[(size_t)ge0 * cap + s0] = tok * 2;
        int s1 = atomicAdd(&cnt[ge1], 1); list[(size_t)ge1 * cap + s1] = tok * 2 + 1;
    }
}

__global__ void k_act(float* ga, const float* up, const float* route_w, int nent) {
    size_t idx = (size_t)blockIdx.x * 256 + threadIdx.x;
    if (idx >= (size_t)nent * 512) return;
    int ent = idx / 512;
    ga[idx] = siluf(ga[idx]) * up[idx] * route_w[ent];
}

__global__ void k_moe_combine(const float* xin, const float* y2, const float* modl, int b, float* xout, int nrows) {
    size_t idx = (size_t)blockIdx.x * 256 + threadIdx.x;
    if (idx >= (size_t)nrows * D) return;
    int c = idx % D, r = idx / D;
    const float* mv = modl + (size_t)(r < SEQ ? b : 4) * 6144;
    xout[idx] = xin[idx] + mv[5 * 1024 + c] * (y2[(size_t)(2 * r) * D + c] + y2[(size_t)(2 * r + 1) * D + c]);
}

__global__ void k_qknorm(float* qkv, const float* qn, const float* kn) {
    const int w = blockIdx.x * 4 + (threadIdx.x >> 6), lane = threadIdx.x & 63;
    if (w >= NT * 32) return;
    const int r = w >> 5, hw = w & 31, which = hw >> 4, hh = hw & 15;
    float* p = qkv + (size_t)r * 3072 + which * 1024 + hh * 64 + lane;
    float v = *p;
    float ss = wave_sum(v * v);
    float rs = rsqrtf(ss / 64.f + 1e-6f);
    *p = which == 0 ? v * rs * qn[lane] * 0.125f : v * rs * kn[lane];
}

__global__ void k_na(const float* qkv, const float* rpb, float* ao) {
    const int w = blockIdx.x * 4 + (threadIdx.x >> 6), lane = threadIdx.x & 63;
    if (w >= SEQ * 16) return;
    const int t = w >> 4, hh = w & 15;
    const int r = t >> 6, c = t & 63;
    int r0 = r - 4; r0 = r0 < 0 ? 0 : (r0 > 56 ? 56 : r0);
    int c0 = c - 8; c0 = c0 < 0 ? 0 : (c0 > 48 ? 48 : c0);
    const float q = qkv[(size_t)t * 3072 + hh * 64 + lane];
    float m = -3.0e38f, l = 0.f, acc = 0.f;
    for (int i = 0; i < 8; ++i)
        for (int j = 0; j < 16; ++j) {
            const int kr = r0 + i, kc = c0 + j, kt = kr * 64 + kc;
            float s = wave_sum(q * qkv[(size_t)kt * 3072 + 1024 + hh * 64 + lane]);
            s += rpb[(hh * 15 + (kr - r + 7)) * 31 + (kc - c + 15)];
            const float mn = fmaxf(m, s), sc = expf(m - mn), p = expf(s - mn);
            l = l * sc + p; acc = acc * sc + p * qkv[(size_t)kt * 3072 + 2048 + hh * 64 + lane]; m = mn;
        }
    for (int j = 0; j < CTXL; ++j) {
        const int kt = SEQ + j;
        float s = wave_sum(q * qkv[(size_t)kt * 3072 + 1024 + hh * 64 + lane]);
        const float mn = fmaxf(m, s), sc = expf(m - mn), p = expf(s - mn);
        l = l * sc + p; acc = acc * sc + p * qkv[(size_t)kt * 3072 + 2048 + hh * 64 + lane]; m = mn;
    }
    ao[(size_t)t * 1024 + hh * 64 + lane] = acc / l;
}

struct Bufs {
    float *modv, *H, *PROJ, *XBC, *YD, *HD, *MIX, *O, *X1, *H2, *GA, *UP, *Y2, *X2;
    float *rw; int *re, *cnt, *list;
    float *H_1, *QKV, *AO, *O_1, *X3, *H2_1, *GA_1, *UP_1, *Y2_1;
};

struct In {
    const float *x, *c, *ctx, *c_ctx, *norm1_w, *norm2_w, *mod_w, *mod_b, *ab_w_in, *ab_conv_w, *ab_conv_b, *ssd_a_log, *ssd_dt_bias, *ssd_d,
        *ssd_norm_w, *ml_i_bias, *ml_f_bias, *ml_norm_w, *ab_w_out, *na_w_qkv, *na_q_norm, *na_k_norm, *na_rpb, *na_w_out,
        *moe_w_group, *moe_b_group, *moe_w_expert, *moe_b_expert, *moe_w_gate, *moe_w_up, *moe_w_down;
};

static inline dim3 g1(size_t n) { return dim3((unsigned)((n + 255) / 256)); }

static void moe(const In& in, const Bufs& B, int layer, float* H2, float* GA, float* UP, float* Y2, int ntok, hipStream_t st) {
    const int cap = NT;
    (void)hipMemsetAsync(B.cnt, 0, 32 * sizeof(int), st);
    k_router<<<dim3((ntok + 3) / 4), 256, 0, st>>>(H2, in.moe_w_group + (size_t)layer * 1024 * 4, in.moe_b_group + layer * 4,
        in.moe_w_expert + (size_t)layer * 1024 * 32, in.moe_b_expert + layer * 32, B.re, B.rw, B.cnt, B.list, cap, ntok);
    const size_t wsz = (size_t)1024 * 512;
    k_sgemm<<<dim3(512 / 64, (cap + 63) / 64, 32), 256, 0, st>>>(H2, 1024, in.moe_w_gate + (size_t)layer * 32 * wsz, 512, wsz, GA, 512, 0, 512, 1024, B.list, cap, B.cnt, 1);
    k_sgemm<<<dim3(512 / 64, (cap + 63) / 64, 32), 256, 0, st>>>(H2, 1024, in.moe_w_up + (size_t)layer * 32 * wsz, 512, wsz, UP, 512, 0, 512, 1024, B.list, cap, B.cnt, 1);
    k_act<<<g1((size_t)ntok * 2 * 512), 256, 0, st>>>(GA, UP, B.rw, ntok * 2);
    k_sgemm<<<dim3(1024 / 64, (cap + 63) / 64, 32), 256, 0, st>>>(GA, 512, in.moe_w_down + (size_t)layer * 32 * wsz, 1024, wsz, Y2, 1024, 0, 1024, 512, B.list, cap, B.cnt, 0);
}

static void forward_batch(const In& in, const Bufs& B, int b, float* out_b, hipStream_t st) {
    const float* xl = in.x + (size_t)b * SEQ * D; const float* xc = in.ctx + (size_t)b * CTXL * D;
    const float* mod0 = B.modv, *mod1 = B.modv + 5 * 6144;
    k_norm_mod<<<NT, 256, 0, st>>>(xl, xc, in.norm1_w, mod0, 0, 1, b, B.H);
    k_sgemm<<<dim3((INW + 63) / 64, NT / 64, 1), 256, 0, st>>>(B.H, 1024, in.ab_w_in, INW, 0, B.PROJ, INW, NT, INW, 1024, nullptr, 0, nullptr, 0);
    k_conv_silu<<<g1((size_t)NT * 1536), 256, 0, st>>>(B.PROJ, in.ab_conv_w, in.ab_conv_b, B.XBC);
    k_ssd<<<32, 256, 0, st>>>(B.PROJ, B.XBC, in.ssd_a_log, in.ssd_dt_bias, B.YD);
    k_mlstm<<<32, 256, 0, st>>>(B.PROJ, in.ml_i_bias, in.ml_f_bias, B.HD);
    k_mixer_out<<<NT, 256, 0, st>>>(B.PROJ, B.XBC, B.YD, B.HD, in.ssd_d, in.ssd_norm_w, in.ml_norm_w, B.MIX);
    k_sgemm<<<dim3(1024 / 64, NT / 64, 1), 256, 0, st>>>(B.MIX, 2048, in.ab_w_out, 1024, 0, B.O, 1024, NT, 1024, 2048, nullptr, 0, nullptr, 0);
    k_resid<<<g1((size_t)NT * D), 256, 0, st>>>(xl, xc, B.O, mod0, 2, b, B.X1, NT);
    k_norm_mod<<<NT, 256, 0, st>>>(B.X1, B.X1 + (size_t)SEQ * D, in.norm2_w, mod0, 3, 4, b, B.H2);
    moe(in, B, 0, B.H2, B.GA, B.UP, B.Y2, NT, st);
    k_moe_combine<<<g1((size_t)NT * D), 256, 0, st>>>(B.X1, B.Y2, mod0, b, B.X2, NT);
    k_norm_mod<<<NT, 256, 0, st>>>(B.X2, B.X2 + (size_t)SEQ * D, in.norm1_w + 1024, mod1, 0, 1, b, B.H_1);
    k_sgemm<<<dim3(3072 / 64, NT / 64, 1), 256, 0, st>>>(B.H_1, 1024, in.na_w_qkv, 3072, 0, B.QKV, 3072, NT, 3072, 1024, nullptr, 0, nullptr, 0);
    k_qknorm<<<dim3(NT * 32 / 4), 256, 0, st>>>(B.QKV, in.na_q_norm, in.na_k_norm);
    k_na<<<dim3(SEQ * 16 / 4), 256, 0, st>>>(B.QKV, in.na_rpb, B.AO);
    k_sgemm<<<dim3(1024 / 64, SEQ / 64, 1), 256, 0, st>>>(B.AO, 1024, in.na_w_out, 1024, 0, B.O_1, 1024, SEQ, 1024, 1024, nullptr, 0, nullptr, 0);
    k_resid<<<g1((size_t)SEQ * D), 256, 0, st>>>(B.X2, B.X2 + (size_t)SEQ * D, B.O_1, mod1, 2, b, B.X3, SEQ);
    k_norm_mod<<<SEQ, 256, 0, st>>>(B.X3, B.X3, in.norm2_w + 1024, mod1, 3, 4, b, B.H2_1);
    moe(in, B, 1, B.H2_1, B.GA_1, B.UP_1, B.Y2_1, SEQ, st);
    k_moe_combine<<<g1((size_t)SEQ * D), 256, 0, st>>>(B.X3, B.Y2_1, mod1, b, out_b, SEQ);
}
}
static nv::In make_in(void* const* d_in) {
    nv::In in;
    const float** p = (const float**)&in;
    for (int i = 0; i < 31; ++i) p[i] = (const float*)d_in[i];
    return in;
}
static void carve_naive(unsigned char* base, nv::Bufs& B, size_t& used) {
    const size_t U = (size_t)nv::NT * 1024 * 4;
    size_t off = 0;
    auto take = [&](size_t bytes) { unsigned char* p = base + off; off += (bytes + 255) & ~(size_t)255; return p; };
    B.modv = (float*)take(2 * 5 * 6144 * 4);
    B.rw = (float*)take((size_t)nv::NT * 2 * 4); B.re = (int*)take((size_t)nv::NT * 2 * 4); B.cnt = (int*)take(256); B.list = (int*)take((size_t)32 * nv::NT * 4);
    unsigned char* RA = take((size_t)nv::NT * nv::INW * 4); unsigned char* RB = take(U); unsigned char* RC = take((size_t)nv::NT * 1536 * 4);
    unsigned char* RD = take(4 * U); unsigned char* RE = take(2 * U);
    B.PROJ = (float*)RA; B.H2 = (float*)RA; B.GA = (float*)(RA + U); B.UP = (float*)(RA + 2 * U); B.Y2 = (float*)(RA + 3 * U);
    B.QKV = (float*)RA; B.H2_1 = (float*)RA; B.GA_1 = (float*)(RA + U); B.UP_1 = (float*)(RA + 2 * U); B.Y2_1 = (float*)(RA + 3 * U);
    B.H = (float*)RB; B.O = (float*)RB; B.H_1 = (float*)RB; B.O_1 = (float*)RB;
    B.XBC = (float*)RC; B.X1 = (float*)RC;
    B.YD = (float*)RD; B.HD = (float*)(RD + 2 * U); B.X2 = (float*)RD; B.AO = (float*)(RD + 2 * U);
    B.MIX = (float*)RE; B.X3 = (float*)RE;
    used = off;
}
__global__ void k_fill(float* p, size_t n, float v) { size_t i = (size_t)blockIdx.x * 256 + threadIdx.x; if (i < n) p[i] = v; }
extern "C" void kernel_launch(void* const* d_in, const int* in_sizes, int n_in, void* d_out, int out_size, void* d_ws, size_t ws_size, hipStream_t stream) {
    nv::In in = make_in(d_in);
    nv::Bufs B; size_t used = 0;
    carve_naive((unsigned char*)d_ws, B, used);
    if (used > ws_size) { k_fill<<<(out_size + 255) / 256, 256, 0, stream>>>((float*)d_out, (size_t)out_size, 0.f); return; }
    nv::k_mod<<<240, 256, 0, stream>>>(in.c, in.c_ctx, in.mod_w, in.mod_b, B.modv);
    for (int b = 0; b < 4; ++b) nv::forward_batch(in, B, b, (float*)d_out + (size_t)b * nv::SEQ * nv::D, stream);
}
```

```cpp
#include <hip/hip_runtime.h>
#include <cstdio>
#include <cstdint>
namespace fx {
#define LAS __attribute__((address_space(3)))
typedef unsigned short bf16;
typedef short bf16x8 __attribute__((ext_vector_type(8)));
typedef short bf16x4 __attribute__((ext_vector_type(4)));
typedef float f32x16 __attribute__((ext_vector_type(16)));
typedef float f32x4 __attribute__((ext_vector_type(4)));
typedef unsigned u32x4 __attribute__((ext_vector_type(4)));
typedef unsigned u32x2 __attribute__((ext_vector_type(2)));
constexpr int NTHR = 512, NWAVE = 8;
constexpr int D = 1024, SEQ = 4096, CTXL = 256;
constexpr int PROJW = 5632, NIN = 5760;
constexpr int PC_Z = 0, PC_XBC = 1024, PC_Q = 2560, PC_K = 3072, PC_V = 3584, PC_O = 4608;
constexpr int LDS_BYTES = 152 * 1024;

__device__ __forceinline__ float bf2f(bf16 v) { return __uint_as_float((unsigned)v << 16); }
__device__ __forceinline__ float bflo(unsigned u) { return __uint_as_float(u << 16); }
__device__ __forceinline__ float bfhi(unsigned u) { return __uint_as_float(u & 0xffff0000u); }
__device__ __forceinline__ unsigned pk2(float lo, float hi) { unsigned r; asm("v_cvt_pk_bf16_f32 %0, %1, %2" : "=v"(r) : "v"(lo), "v"(hi)); return r; }
__device__ __forceinline__ float siluf(float v) { return v / (1.f + __expf(-v)); }
__device__ __forceinline__ float sigmf(float v) { return 1.f / (1.f + __expf(-v)); }
__device__ __forceinline__ float softplusf(float v) { return v > 20.f ? v : log1pf(__expf(v)); }
__device__ __forceinline__ float logsigf(float v) { return fminf(v, 0.f) - log1pf(__expf(-fabsf(v))); }
__device__ __forceinline__ float wave_sum(float v) {
#pragma unroll
    for (int o = 32; o > 0; o >>= 1) v += __shfl_xor(v, o);
    return v;
}
__device__ __forceinline__ float wave_max(float v) {
#pragma unroll
    for (int o = 32; o > 0; o >>= 1) v = fmaxf(v, __shfl_xor(v, o));
    return v;
}
__device__ __forceinline__ f32x16 mfma32(bf16x8 a, bf16x8 b, f32x16 c) { return __builtin_amdgcn_mfma_f32_32x32x16_bf16(a, b, c, 0, 0, 0); }
__device__ __forceinline__ f32x4 mfma16(bf16x8 a, bf16x8 b, f32x4 c) { return __builtin_amdgcn_mfma_f32_16x16x32_bf16(a, b, c, 0, 0, 0); }

__device__ __forceinline__ bf16x8 frag_row(const LAS unsigned char* T, int RS, int r0, int k0, int lane) {
    return *(const LAS bf16x8*)(T + (r0 + (lane & 31)) * RS + (k0 + 8 * (lane >> 5)) * 2);
}
__device__ __forceinline__ bf16x8 frag_col(const LAS unsigned char* T, int RS, int k0, int c0, int lane) {
    const int h = lane >> 5, blk = (lane >> 4) & 1, q = (lane & 15) >> 2, p = lane & 3;
    const unsigned a0 = (unsigned)(size_t)(T + (k0 + 8 * h + q) * RS + (c0 + 16 * blk + 4 * p) * 2);
    const unsigned a1 = a0 + 4 * RS;
    bf16x4 v0, v1;
    asm volatile("ds_read_b64_tr_b16 %0, %2\n\tds_read_b64_tr_b16 %1, %3\n\ts_waitcnt lgkmcnt(0)" : "=&v"(v0), "=&v"(v1) : "v"(a0), "v"(a1) : "memory");
    bf16x8 r; r[0] = v0[0]; r[1] = v0[1]; r[2] = v0[2]; r[3] = v0[3]; r[4] = v1[0]; r[5] = v1[1]; r[6] = v1[2]; r[7] = v1[3];
    return r;
}

struct In {
    const float *x, *c, *ctx, *c_ctx, *norm1_w, *norm2_w, *mod_w, *mod_b, *ab_w_in, *ab_conv_w, *ab_conv_b, *ssd_a_log, *ssd_dt_bias, *ssd_d,
        *ssd_norm_w, *ml_i_bias, *ml_f_bias, *ml_norm_w, *ab_w_out, *na_w_qkv, *na_q_norm, *na_k_norm, *na_rpb, *na_w_out,
        *moe_w_group, *moe_b_group, *moe_w_expert, *moe_b_expert, *moe_w_gate, *moe_w_up, *moe_w_down;
};

constexpr size_t cmax(size_t a, size_t b) { return a > b ? a : b; }
constexpr size_t al256(size_t x) { return (x + 255) & ~(size_t)255; }

template <int NB> struct Plan {
    static constexpr size_t TL = (size_t)NB * SEQ, TC = (size_t)NB * CTXL, T = TL + TC;
    static constexpr size_t CTL = 0;
    static constexpr size_t CTL_BAR = 0, CTL_CNT = 16384  , CTL_BYTES = 32768;
    static constexpr size_t MODV = CTL + CTL_BYTES;
    static constexpr size_t RW = MODV + al256(2 * 5 * 6144 * 4);
    static constexpr size_t LIST = RW + al256(2 * T * 4);
    static constexpr size_t W_IN = LIST + al256(32 * T * 4);
    static constexpr size_t W_OUT = W_IN + (size_t)NIN * 1024 * 2;
    static constexpr size_t W_QKV = W_OUT + (size_t)1024 * 2048 * 2;
    static constexpr size_t W_NAO = W_QKV + (size_t)3072 * 1024 * 2;
    static constexpr size_t ARENA = W_NAO + (size_t)1024 * 1024 * 2;
    static constexpr size_t MOEW = (size_t)32 * 1024 * 1024 * 2 + (size_t)32 * 1024 * 512 * 2;
    static constexpr size_t SZ_B = al256(T * 1024 * 2);
    static constexpr size_t SZ_A = al256(cmax(MOEW, cmax(T * 3072 * 2, T * 1024 * 4)));
    static constexpr size_t SZ_X = al256(T * 1024 * 4);
    static constexpr size_t SZ_C = al256(cmax(T * PROJW * 2 + T * 64 * 4, SZ_X + MOEW));
    static constexpr size_t SZ_D = al256(T * 1536 * 2);
    static constexpr size_t SZ_E = al256(T * 4096 * 2);
    static constexpr size_t RB = ARENA, RA = RB + SZ_B, RC = RA + SZ_A, RD = RC + SZ_C, RE = RD + SZ_D, END = RE + SZ_E;
    static constexpr size_t H = RB;
    static constexpr size_t W_MOE0 = RA;
    static constexpr size_t QKV = RA;
    static constexpr size_t X3 = RA;
    static constexpr size_t PROJ = RC;
    static constexpr size_t GATES = RC + T * PROJW * 2;
    static constexpr size_t X1 = RC;
    static constexpr size_t W_MOE1 = RC + SZ_X;
    static constexpr size_t XBC = RD;
    static constexpr size_t ACT = RD;
    static constexpr size_t AO = RD;
    static constexpr size_t SC = RE;
    static constexpr size_t Y2 = RE;
    static constexpr size_t X2 = RE + al256(2 * T * 1024 * 2);
    static_assert(2 * T * 1024 * 2 + T * 1024 * 4 <= SZ_E, "E");
    static_assert(T * 3072 * 2 <= SZ_A + SZ_X, "QKV spill");
};

struct P { In in; unsigned char* ws; float* out; };

template <int NB> __device__ __forceinline__ int mod_row(int row) { return row < NB * SEQ ? row / SEQ : 4; }

template <class Map>
__device__ __forceinline__ void tconv_tile(const float* src, int ld_src, bf16* dst, int K, int k0, int n0, Map map, LAS unsigned char* lds) {
    LAS float* tl = (LAS float*)lds;
    const int tid = threadIdx.x;
    {
        const int n = tid & 63, kb = tid >> 6;
        const int sc = map(n0 + n);
#pragma unroll
        for (int i = 0; i < 8; ++i) { const int k = kb + 8 * i; tl[k * 65 + n] = sc >= 0 ? src[(size_t)(k0 + k) * ld_src + sc] : 0.f; }
    }
    __syncthreads();
    {
        const int n = tid >> 3, kc = tid & 7;
        float v[8];
#pragma unroll
        for (int j = 0; j < 8; ++j) v[j] = tl[(kc * 8 + j) * 65 + n];
        u32x4 o; o[0] = pk2(v[0], v[1]); o[1] = pk2(v[2], v[3]); o[2] = pk2(v[4], v[5]); o[3] = pk2(v[6], v[7]);
        *(u32x4*)(dst + (size_t)(n0 + n) * K + k0 + kc * 8) = o;
    }
    __syncthreads();
}

struct MapId { __device__ int operator()(int n) const { return n; } };
struct MapIn {
    __device__ int operator()(int n) const { return n < 2560 ? n : (n < 5632 ? n + 32 : (n < 5664 ? n - 3072 : (n < 5680 ? n : -1))); }
};

__device__ __forceinline__ void conv_small_weights(const In& in, unsigned char* ws, size_t o_in, size_t o_out, size_t o_qkv, size_t o_nao, LAS unsigned char* lds) {
    const int total = 1440 + 512 + 768 + 256;
    for (int u = blockIdx.x; u < total; u += gridDim.x) {
        if (u < 1440) { const int kt = u % 16, nt = u / 16; tconv_tile(in.ab_w_in, 5680, (bf16*)(ws + o_in), 1024, kt * 64, nt * 64, MapIn(), lds); }
        else if (u < 1952) { const int v = u - 1440, kt = v % 32, nt = v / 32; tconv_tile(in.ab_w_out, 1024, (bf16*)(ws + o_out), 2048, kt * 64, nt * 64, MapId(), lds); }
        else if (u < 2720) { const int v = u - 1952, kt = v % 16, nt = v / 16; tconv_tile(in.na_w_qkv, 3072, (bf16*)(ws + o_qkv), 1024, kt * 64, nt * 64, MapId(), lds); }
        else { const int v = u - 2720, kt = v % 16, nt = v / 16; tconv_tile(in.na_w_out, 1024, (bf16*)(ws + o_nao), 1024, kt * 64, nt * 64, MapId(), lds); }
    }
}

struct MapGU { __device__ int operator()(int n) const { return (n >> 7) * 64 + ((n >> 6) & 1) * 32 + (n & 31); } };
__device__ __forceinline__ void conv_moe_weights(const In& in, int layer, bf16* wgu, bf16* wd, LAS unsigned char* lds) {
    const size_t wsz = (size_t)1024 * 512;
    const int total_gu = 32 * 16 * 16, total_d = 32 * 8 * 16;
    for (int u = blockIdx.x; u < total_gu + total_d; u += gridDim.x) {
        if (u < total_gu) {
            const int e = u / 256, v = u % 256, kt = v % 16, nt = v / 16;
            const float* g = in.moe_w_gate + ((size_t)layer * 32 + e) * wsz; const float* up = in.moe_w_up + ((size_t)layer * 32 + e) * wsz;
            bf16* dst = wgu + (size_t)e * 1024 * 1024;
            LAS float* tl = (LAS float*)lds;
            const int tid = threadIdx.x;
            { const int n = tid & 63, kb = tid >> 6; const int f = MapGU()(nt * 64 + n); const float* s = (n & 32) ? up : g;
#pragma unroll
              for (int i = 0; i < 8; ++i) { const int k = kb + 8 * i; tl[k * 65 + n] = s[(size_t)(kt * 64 + k) * 512 + f]; } }
            __syncthreads();
            { const int n = tid >> 3, kc = tid & 7; float vv[8];
#pragma unroll
              for (int j = 0; j < 8; ++j) vv[j] = tl[(kc * 8 + j) * 65 + n];
              u32x4 o; o[0] = pk2(vv[0], vv[1]); o[1] = pk2(vv[2], vv[3]); o[2] = pk2(vv[4], vv[5]); o[3] = pk2(vv[6], vv[7]);
              *(u32x4*)(dst + (size_t)(nt * 64 + n) * 1024 + kt * 64 + kc * 8) = o; }
            __syncthreads();
        } else {
            const int w = u - total_gu, e = w / 128, v = w % 128, kt = v % 8, nt = v / 8;
            tconv_tile(in.moe_w_down + ((size_t)layer * 32 + e) * wsz, 1024, wd + (size_t)e * 1024 * 512, 512, kt * 64, nt * 64, MapId(), lds);
        }
    }
}

__device__ __forceinline__ void mod_vectors(const In& in, float* modv, LAS unsigned char* lds) {
    LAS float* sc = (LAS float*)lds;
    LAS float* red = sc + 5 * 1024;
    const int tid = threadIdx.x;
    for (int i = tid; i < 5 * 1024; i += NTHR) { const int r = i >> 10, k = i & 1023; const float v = r < 4 ? in.c[r * 1024 + k] : in.c_ctx[k]; sc[i] = siluf(v); }
    __syncthreads();
    const int col = tid & 31, kq = tid >> 5;
    for (int u = blockIdx.x; u < 2 * 192; u += gridDim.x) {
        const int layer = u / 192, c0 = (u % 192) * 32;
        const float* w = in.mod_w + (size_t)layer * 1024 * 6144 + c0 + col;
        float a0 = 0.f, a1 = 0.f, a2 = 0.f, a3 = 0.f, a4 = 0.f;
#pragma unroll 8
        for (int j = 0; j < 64; ++j) { const int k = kq + 16 * j; const float wv = w[(size_t)k * 6144];
            a0 += sc[k] * wv; a1 += sc[1024 + k] * wv; a2 += sc[2048 + k] * wv; a3 += sc[3072 + k] * wv; a4 += sc[4096 + k] * wv; }
        red[(0 * 16 + kq) * 32 + col] = a0; red[(1 * 16 + kq) * 32 + col] = a1; red[(2 * 16 + kq) * 32 + col] = a2;
        red[(3 * 16 + kq) * 32 + col] = a3; red[(4 * 16 + kq) * 32 + col] = a4;
        __syncthreads();
        if (tid < 160) { const int r = tid >> 5, cc = tid & 31; float s = 0.f;
#pragma unroll
            for (int q = 0; q < 16; ++q) s += red[(r * 16 + q) * 32 + cc];
            modv[((size_t)layer * 5 + r) * 6144 + c0 + cc] = s + in.mod_b[layer * 6144 + c0 + cc]; }
        __syncthreads();
    }
}

template <int NB, bool COMBINE, bool XOUT, bool NORM, bool ROUTER>
__device__ __forceinline__ void rows_phase(const float* xl, const float* xc, int nrows, const bf16* y2, const float* modc  , const float* modl  ,
                                           float* xout, float* out_final, const float* nw, int shift_i, int scale_i, bf16* hout,
                                           const float* wg, const float* bg, const float* we, const float* be, float* route_w, int* cnt, int* list, int cap,
                                           LAS unsigned char* lds) {
    constexpr int TL = NB * SEQ;
    const int tid = threadIdx.x, lane = tid & 63, wave = tid >> 6;
    LAS float* wt = (LAS float*)lds;
    if (ROUTER) {
        for (int i = tid; i < 36 * 1024; i += NTHR) { const int j = i >> 10, k = i & 1023; wt[i] = j < 4 ? wg[k * 4 + j] : we[k * 32 + (j - 4)]; }
        __syncthreads();
    }
    for (int row = blockIdx.x * NWAVE + wave; row < nrows; row += gridDim.x * NWAVE) {
        const float* src = row < TL ? xl + (size_t)row * D : xc + (size_t)(row - TL) * D;
        const float* mv = modl + (size_t)mod_row<NB>(row) * 6144;
        const float* mvc = modc + (size_t)mod_row<NB>(row) * 6144;
        f32x4 v[4];
#pragma unroll
        for (int i = 0; i < 4; ++i) v[i] = *(const f32x4*)(src + lane * 4 + 256 * i);
        if (COMBINE) {
#pragma unroll
            for (int i = 0; i < 4; ++i) { const int c = lane * 4 + 256 * i;
                const u32x2 ya = *(const u32x2*)(y2 + (size_t)(2 * row) * D + c), yb = *(const u32x2*)(y2 + (size_t)(2 * row + 1) * D + c);
                const f32x4 m5 = *(const f32x4*)(mvc + 5 * 1024 + c);
                v[i][0] += m5[0] * (bflo(ya[0]) + bflo(yb[0])); v[i][1] += m5[1] * (bfhi(ya[0]) + bfhi(yb[0]));
                v[i][2] += m5[2] * (bflo(ya[1]) + bflo(yb[1])); v[i][3] += m5[3] * (bfhi(ya[1]) + bfhi(yb[1])); }
            if (XOUT) {
#pragma unroll
                for (int i = 0; i < 4; ++i) *(f32x4*)(xout + (size_t)row * D + lane * 4 + 256 * i) = v[i]; }
            if (out_final) {
#pragma unroll
                for (int i = 0; i < 4; ++i) *(f32x4*)(out_final + (size_t)row * D + lane * 4 + 256 * i) = v[i]; }
        }
        if (NORM) {
            float ss = 0.f;
#pragma unroll
            for (int i = 0; i < 4; ++i) ss += v[i][0] * v[i][0] + v[i][1] * v[i][1] + v[i][2] * v[i][2] + v[i][3] * v[i][3];
            ss = wave_sum(ss);
            const float rs = rsqrtf(ss * (1.f / D) + 1e-6f);
            f32x4 hv[4];
#pragma unroll
            for (int i = 0; i < 4; ++i) { const int c = lane * 4 + 256 * i;
                const f32x4 w4 = *(const f32x4*)(nw + c), sc4 = *(const f32x4*)(mv + scale_i * 1024 + c), sh4 = *(const f32x4*)(mv + shift_i * 1024 + c);
#pragma unroll
                for (int j = 0; j < 4; ++j) hv[i][j] = v[i][j] * rs * w4[j] * (1.f + sc4[j]) + sh4[j];
                u32x2 o; o[0] = pk2(hv[i][0], hv[i][1]); o[1] = pk2(hv[i][2], hv[i][3]);
                *(u32x2*)(hout + (size_t)row * D + c) = o; }
            if (ROUTER) {
                float lg[4];
#pragma unroll
                for (int j = 0; j < 4; ++j) { float a = 0.f;
#pragma unroll
                    for (int i = 0; i < 4; ++i) { const f32x4 w4 = *(const LAS f32x4*)(wt + j * 1024 + lane * 4 + 256 * i);
                        a += hv[i][0] * w4[0] + hv[i][1] * w4[1] + hv[i][2] * w4[2] + hv[i][3] * w4[3]; }
                    lg[j] = wave_sum(a) + bg[j]; }
                int gi = 0; float gm = lg[0];
#pragma unroll
                for (int j = 1; j < 4; ++j) if (lg[j] > gm) { gm = lg[j]; gi = j; }
                float gs = 0.f;
#pragma unroll
                for (int j = 0; j < 4; ++j) gs += __expf(lg[j] - gm);
                const float gprob = 1.f / gs;
                float le[8];
#pragma unroll
                for (int j = 0; j < 8; ++j) { float a = 0.f; const LAS float* wr = wt + (4 + gi * 8 + j) * 1024 + lane * 4;
#pragma unroll
                    for (int i = 0; i < 4; ++i) { const f32x4 w4 = *(const LAS f32x4*)(wr + 256 * i);
                        a += hv[i][0] * w4[0] + hv[i][1] * w4[1] + hv[i][2] * w4[2] + hv[i][3] * w4[3]; }
                    le[j] = wave_sum(a) + be[gi * 8 + j]; }
                int e0 = 0; float m0 = le[0];
#pragma unroll
                for (int j = 1; j < 8; ++j) if (le[j] > m0) { m0 = le[j]; e0 = j; }
                int e1 = 0; float m1 = -3.0e38f;
#pragma unroll
                for (int j = 0; j < 8; ++j) if (j != e0 && le[j] > m1) { m1 = le[j]; e1 = j; }
                const float p1 = __expf(m1 - m0);
                if (lane == 0) {
                    const int ge0 = gi * 8 + e0, ge1 = gi * 8 + e1;
                    route_w[2 * row] = gprob / (1.f + p1); route_w[2 * row + 1] = gprob * p1 / (1.f + p1);
                    const int s0 = atomicAdd(&cnt[ge0], 1); list[(size_t)ge0 * cap + s0] = 2 * row;
                    const int s1 = atomicAdd(&cnt[ge1], 1); list[(size_t)ge1 * cap + s1] = 2 * row + 1;
                }
            }
        }
    }
    if (ROUTER) __syncthreads();
}

constexpr int GEMM_LDS = 2 * (256 * 128 + 128 * 128);
__device__ __forceinline__ int sw_off(int row, int chunk) { return row * 128 + ((chunk ^ ((row >> 1) & 7)) << 4); }

template <class Epi>
__device__ __forceinline__ void gemm_tile(const bf16* const (&arow)[4], const bf16* bt  , int ldb, int K, LAS unsigned char* lds, Epi&& epi) {
    const int tid = threadIdx.x, lane = tid & 63, wave = tid >> 6, wm = wave >> 1, wn = wave & 1;
    const int chunk = tid & 7;
    const bf16* brow[2];
#pragma unroll
    for (int i = 0; i < 2; ++i) brow[i] = bt + (size_t)((tid >> 3) + 64 * i) * ldb + chunk * 8;
    f32x16 acc[2][2];
#pragma unroll
    for (int mi = 0; mi < 2; ++mi)
#pragma unroll
        for (int ni = 0; ni < 2; ++ni)
#pragma unroll
            for (int r = 0; r < 16; ++r) acc[mi][ni][r] = 0.f;
    u32x4 ra[4], rb[2];
#pragma unroll
    for (int i = 0; i < 4; ++i) ra[i] = *(const u32x4*)(arow[i] + chunk * 8);
#pragma unroll
    for (int i = 0; i < 2; ++i) rb[i] = *(const u32x4*)(brow[i]);
    const int KT = K >> 6;
    {
        LAS unsigned char* sa = lds; LAS unsigned char* sb = lds + 256 * 128;
#pragma unroll
        for (int i = 0; i < 4; ++i) *(LAS u32x4*)(sa + sw_off((tid >> 3) + 64 * i, chunk)) = ra[i];
#pragma unroll
        for (int i = 0; i < 2; ++i) *(LAS u32x4*)(sb + sw_off((tid >> 3) + 64 * i, chunk)) = rb[i];
    }
    __syncthreads();
    for (int kt = 0; kt < KT; ++kt) {
        const int cur = kt & 1;
        LAS unsigned char* sa = lds + cur * (256 * 128 + 128 * 128); LAS unsigned char* sb = sa + 256 * 128;
        if (kt + 1 < KT) {
#pragma unroll
            for (int i = 0; i < 4; ++i) ra[i] = *(const u32x4*)(arow[i] + (kt + 1) * 64 + chunk * 8);
#pragma unroll
            for (int i = 0; i < 2; ++i) rb[i] = *(const u32x4*)(brow[i] + (kt + 1) * 64);
        }
#pragma unroll
        for (int kk = 0; kk < 4; ++kk) {
            bf16x8 af[2], bfr[2];
#pragma unroll
            for (int mi = 0; mi < 2; ++mi) af[mi] = *(const LAS bf16x8*)(sa + sw_off(wm * 64 + mi * 32 + (lane & 31), 2 * kk + (lane >> 5)));
#pragma unroll
            for (int ni = 0; ni < 2; ++ni) bfr[ni] = *(const LAS bf16x8*)(sb + sw_off(wn * 64 + ni * 32 + (lane & 31), 2 * kk + (lane >> 5)));
#pragma unroll
            for (int mi = 0; mi < 2; ++mi)
#pragma unroll
                for (int ni = 0; ni < 2; ++ni) acc[mi][ni] = mfma32(bfr[ni], af[mi], acc[mi][ni]);
        }
        if (kt + 1 < KT) {
            LAS unsigned char* na = lds + (cur ^ 1) * (256 * 128 + 128 * 128); LAS unsigned char* nb = na + 256 * 128;
#pragma unroll
            for (int i = 0; i < 4; ++i) *(LAS u32x4*)(na + sw_off((tid >> 3) + 64 * i, chunk)) = ra[i];
#pragma unroll
            for (int i = 0; i < 2; ++i) *(LAS u32x4*)(nb + sw_off((tid >> 3) + 64 * i, chunk)) = rb[i];
        }
        __syncthreads();
    }
    epi(acc, wm, wn, lane);
}

template <int NB>
__device__ __forceinline__ void phase_inproj(const bf16* H, const bf16* Wt, bf16* PROJ, float* GATES, LAS unsigned char* lds) {
    constexpr int T = NB * (SEQ + CTXL), MT = T / 256, NT_ = NIN / 128;
    for (int u = blockIdx.x; u < MT * NT_; u += gridDim.x) {
        const int mt = u / NT_, nt = u % NT_;
        const bf16* arow[4];
#pragma unroll
        for (int i = 0; i < 4; ++i) arow[i] = H + (size_t)(mt * 256 + (threadIdx.x >> 3) + 64 * i) * D;
        gemm_tile(arow, Wt + (size_t)nt * 128 * D, D, D, lds, [&](const f32x16 (&acc)[2][2], int wm, int wn, int lane) {
#pragma unroll
            for (int mi = 0; mi < 2; ++mi) { const int row = mt * 256 + wm * 64 + mi * 32 + (lane & 31);
#pragma unroll
                for (int ni = 0; ni < 2; ++ni)
#pragma unroll
                    for (int g = 0; g < 4; ++g) { const int col = nt * 128 + wn * 64 + ni * 32 + 8 * g + 4 * (lane >> 5);
                        if (nt < NT_ - 1) { u32x2 o; o[0] = pk2(acc[mi][ni][4 * g], acc[mi][ni][4 * g + 1]); o[1] = pk2(acc[mi][ni][4 * g + 2], acc[mi][ni][4 * g + 3]);
                            *(u32x2*)(PROJ + (size_t)row * PROJW + col) = o; }
                        else if (wn == 0) { f32x4 o; o[0] = acc[mi][ni][4 * g]; o[1] = acc[mi][ni][4 * g + 1]; o[2] = acc[mi][ni][4 * g + 2]; o[3] = acc[mi][ni][4 * g + 3];
                            *(f32x4*)(GATES + (size_t)row * 64 + (col - PROJW)) = o; } } }
        });
    }
}

template <int NB>
__device__ __forceinline__ void phase_conv(const bf16* PROJ, const float* cw, const float* cb, bf16* XBC) {
    constexpr int TL = NB * SEQ, T = NB * (SEQ + CTXL);
    for (size_t it = (size_t)blockIdx.x * NTHR + threadIdx.x; it < (size_t)T * 192; it += (size_t)gridDim.x * NTHR) {
        const int row = (int)(it / 192), c0 = (int)(it % 192) * 8;
        int t, L;
        if (row < TL) { t = row % SEQ; L = SEQ; } else { t = (row - TL) % CTXL; L = CTXL; }
        const bf16* p = PROJ + (size_t)row * PROJW + PC_XBC + c0;
        const u32x4 cur = *(const u32x4*)p;
        u32x4 prv = {0u, 0u, 0u, 0u}, nxt = {0u, 0u, 0u, 0u};
        if (t > 0) prv = *(const u32x4*)(p - PROJW);
        if (t < L - 1) nxt = *(const u32x4*)(p + PROJW);
        float o[8];
#pragma unroll
        for (int j = 0; j < 4; ++j) {
            const int c = c0 + 2 * j;
            o[2 * j] = bflo(prv[j]) * cw[c] + bflo(cur[j]) * cw[1536 + c] + bflo(nxt[j]) * cw[3072 + c] + cb[c];
            o[2 * j + 1] = bfhi(prv[j]) * cw[c + 1] + bfhi(cur[j]) * cw[1536 + c + 1] + bfhi(nxt[j]) * cw[3072 + c + 1] + cb[c + 1];
        }
        u32x4 r; r[0] = pk2(siluf(o[0]), siluf(o[1])); r[1] = pk2(siluf(o[2]), siluf(o[3])); r[2] = pk2(siluf(o[4]), siluf(o[5])); r[3] = pk2(siluf(o[6]), siluf(o[7]));
        *(u32x4*)(XBC + (size_t)row * 1536 + c0) = r;
    }
}
}
namespace fx {
constexpr int RS_X = 144, RS_N = 272;

template <int NB> __device__ __forceinline__ int scan_row(int b, int d, int step) {
    if (step < CTXL) return NB * SEQ + b * CTXL + (d ? CTXL - 1 - step : step);
    step -= CTXL; return b * SEQ + (d ? SEQ - 1 - step : step);
}
__device__ __forceinline__ bf16x8 scale_frag(bf16x8 v, f32x4 w0, f32x4 w1) {
    const u32x4 u = __builtin_bit_cast(u32x4, v);
    u32x4 o;
    o[0] = pk2(bflo(u[0]) * w0[0], bfhi(u[0]) * w0[1]); o[1] = pk2(bflo(u[1]) * w0[2], bfhi(u[1]) * w0[3]);
    o[2] = pk2(bflo(u[2]) * w1[0], bfhi(u[2]) * w1[1]); o[3] = pk2(bflo(u[3]) * w1[2], bfhi(u[3]) * w1[3]);
    return __builtin_bit_cast(bf16x8, o);
}

template <int NB>
__device__ __forceinline__ void ssd_item(const bf16* XBC, const float* GATES, const float* a_log, const float* dt_bias, bf16* SCb,
                                         int b, int d, int h, LAS unsigned char* lds) {
    const int tid = threadIdx.x, lane = tid & 63, wave = tid >> 6, g = h >> 3;
    LAS unsigned char* Xs = lds; LAS unsigned char* Bs = lds + 18432; LAS unsigned char* Cs = lds + 53248;
    LAS unsigned char* Ss = lds + 88064; LAS unsigned char* Ms = lds + 105472;
    LAS float* acs = (LAS float*)(lds + 140288); LAS float* dtv = acs + 128; LAS float* wv = acs + 256;
    const float a = -__expf(a_log[d * 16 + h]), dtb = dt_bias[d * 16 + h];
    f32x16 st;
#pragma unroll
    for (int r = 0; r < 16; ++r) st[r] = 0.f;
    constexpr int NCH = (CTXL + SEQ) / 128;
    u32x4 rx[2], rb[4], rc[4]; float rg0 = 0.f, rg1 = 0.f;
#define SSD_LOAD(ch) do { \
    _Pragma("unroll") for (int i = 0; i < 2; ++i) { const int idx = tid + 512 * i, l = idx >> 3, c = idx & 7; \
        rx[i] = *(const u32x4*)(XBC + (size_t)scan_row<NB>(b, d, (ch) * 128 + l) * 1536 + h * 64 + c * 8); } \
    _Pragma("unroll") for (int i = 0; i < 4; ++i) { const int idx = tid + 512 * i, l = idx >> 4, c = idx & 15; \
        const bf16* rp = XBC + (size_t)scan_row<NB>(b, d, (ch) * 128 + l) * 1536 + 1024 + g * 128 + c * 8; \
        rb[i] = *(const u32x4*)rp; rc[i] = *(const u32x4*)(rp + 256); } \
    if (wave == 0) { rg0 = GATES[(size_t)scan_row<NB>(b, d, (ch) * 128 + lane) * 64 + d * 16 + h]; \
                     rg1 = GATES[(size_t)scan_row<NB>(b, d, (ch) * 128 + 64 + lane) * 64 + d * 16 + h]; } } while (0)
    SSD_LOAD(0);
    const int pbw = wave >> 2, nbw = wave & 3;
    for (int ch = 0; ch < NCH; ++ch) {
#pragma unroll
        for (int i = 0; i < 2; ++i) { const int idx = tid + 512 * i, l = idx >> 3, c = idx & 7; *(LAS u32x4*)(Xs + l * RS_X + c * 16) = rx[i]; }
#pragma unroll
        for (int i = 0; i < 4; ++i) { const int idx = tid + 512 * i, l = idx >> 4, c = idx & 15;
            *(LAS u32x4*)(Bs + l * RS_N + c * 16) = rb[i]; *(LAS u32x4*)(Cs + l * RS_N + c * 16) = rc[i]; }
        if (wave == 0) {
            const float dt0 = softplusf(rg0 + dtb), dt1 = softplusf(rg1 + dtb);
            float v0 = dt0 * a, v1 = dt1 * a;
#pragma unroll
            for (int o = 1; o < 64; o <<= 1) { const float t0 = __shfl_up(v0, o), t1 = __shfl_up(v1, o); if (lane >= o) { v0 += t0; v1 += t1; } }
            v1 += __shfl(v0, 63);
            const float tot = __shfl(v1, 63);
            acs[lane] = v0; acs[64 + lane] = v1; dtv[lane] = dt0; dtv[64 + lane] = dt1;
            wv[lane] = dt0 * __expf(tot - v0); wv[64 + lane] = dt1 * __expf(tot - v1);
        }
        {
            const int pp = 32 * pbw + (lane & 31);
#pragma unroll
            for (int gq = 0; gq < 4; ++gq) { u32x2 o; o[0] = pk2(st[4 * gq], st[4 * gq + 1]); o[1] = pk2(st[4 * gq + 2], st[4 * gq + 3]);
                *(LAS u32x2*)(Ss + pp * RS_N + (32 * nbw + 8 * gq + 4 * (lane >> 5)) * 2) = o; }
        }
        __syncthreads();
        {
            const int lbA = wave >> 1, sbp = wave & 1;
            const int l = 32 * lbA + (lane & 31);
            const float al = acs[l];
#pragma unroll
            for (int q = 0; q < 2; ++q) { const int sb = 2 * sbp + q;
                if (sb <= lbA) {
                    f32x16 cb;
#pragma unroll
                    for (int r = 0; r < 16; ++r) cb[r] = 0.f;
#pragma unroll
                    for (int kk = 0; kk < 8; ++kk) cb = mfma32(frag_row(Bs, RS_N, 32 * sb, 16 * kk, lane), frag_row(Cs, RS_N, 32 * lbA, 16 * kk, lane), cb);
#pragma unroll
                    for (int gq = 0; gq < 4; ++gq) { const int s0 = 32 * sb + 8 * gq + 4 * (lane >> 5);
                        const f32x4 as4 = *(const LAS f32x4*)(acs + s0), dt4 = *(const LAS f32x4*)(dtv + s0);
                        float m[4];
#pragma unroll
                        for (int j = 0; j < 4; ++j) m[j] = (s0 + j <= l) ? cb[4 * gq + j] * __expf(fminf(al - as4[j], 0.f)) * dt4[j] : 0.f;
                        u32x2 o; o[0] = pk2(m[0], m[1]); o[1] = pk2(m[2], m[3]);
                        *(LAS u32x2*)(Ms + l * RS_N + s0 * 2) = o; } } }
        }
        {
            const float dec = __expf(acs[127]);
#pragma unroll
            for (int r = 0; r < 16; ++r) st[r] *= dec;
#pragma unroll
            for (int kk = 0; kk < 8; ++kk) {
                const int l0 = 16 * kk + 8 * (lane >> 5);
                const f32x4 w0 = *(const LAS f32x4*)(wv + l0), w1 = *(const LAS f32x4*)(wv + l0 + 4);
                const bf16x8 xa = scale_frag(frag_col(Xs, RS_X, 16 * kk, 32 * pbw, lane), w0, w1);
                st = mfma32(frag_col(Bs, RS_N, 16 * kk, 32 * nbw, lane), xa, st);
            }
        }
        __syncthreads();
        if (ch + 1 < NCH) SSD_LOAD(ch + 1);
        {
            const int pb = wave >> 2, lb = wave & 3;
            f32x16 acc;
#pragma unroll
            for (int r = 0; r < 16; ++r) acc[r] = 0.f;
#pragma unroll
            for (int kk = 0; kk < 8; ++kk) acc = mfma32(frag_row(Ss, RS_N, 32 * pb, 16 * kk, lane), frag_row(Cs, RS_N, 32 * lb, 16 * kk, lane), acc);
            const int l = 32 * lb + (lane & 31);
            const float ea = __expf(acs[l]);
#pragma unroll
            for (int r = 0; r < 16; ++r) acc[r] *= ea;
            for (int sb = 0; sb <= lb; ++sb) {
#pragma unroll
                for (int k2 = 0; k2 < 2; ++k2) acc = mfma32(frag_col(Xs, RS_X, 32 * sb + 16 * k2, 32 * pb, lane), frag_row(Ms, RS_N, 32 * lb, 32 * sb + 16 * k2, lane), acc);
            }
            bf16* yp = SCb + (size_t)scan_row<NB>(b, d, ch * 128 + l) * 4096 + d * 1024 + h * 64 + 32 * pb + 4 * (lane >> 5);
#pragma unroll
            for (int gq = 0; gq < 4; ++gq) { u32x2 o; o[0] = pk2(acc[4 * gq], acc[4 * gq + 1]); o[1] = pk2(acc[4 * gq + 2], acc[4 * gq + 3]); *(u32x2*)(yp + 8 * gq) = o; }
        }
        __syncthreads();
    }
#undef SSD_LOAD
}

template <int NB>
__device__ __forceinline__ void mlstm_item(const bf16* PROJ, const float* GATES, const float* i_bias, const float* f_bias, bf16* SCb,
                                           int b, int d, int hh, int ev, LAS unsigned char* lds) {
    const int tid = threadIdx.x, lane = tid & 63, wave = tid >> 6;
    LAS unsigned char* Qs = lds; LAS unsigned char* Ks = lds + 17408; LAS unsigned char* Vs = lds + 34816;
    LAS unsigned char* Ct = lds + 44032; LAS unsigned char* Sm = lds + 61440;
    LAS float* tb = (LAS float*)(lds + 70656);
    LAS float* t_li = tb, *t_bc = tb + 128, *t_mt = tb + 192, *t_wi = tb + 256, *t_we = tb + 320, *t_qn = tb + 384, *t_rs = tb + 448  ,
              *t_n = tb + 544  , *t_sc = tb + 672  ;
    const float ib = i_bias[d * 4 + hh], fb = f_bias[d * 4 + hh];
    const float kscale = 0.08838834764831845f;
    f32x16 st;
#pragma unroll
    for (int r = 0; r < 16; ++r) st[r] = 0.f;
    if (tid < 128) t_n[tid] = 0.f;
    float m_run = 0.f;
    constexpr int NCH = (CTXL + SEQ) / 64;
    const int kbw = wave & 3, ebw = wave >> 2;
    u32x4 rq[2], rk[2], rv; float rgi = 0.f, rgf = 0.f;
#define ML_LOAD(ch) do { \
    _Pragma("unroll") for (int i = 0; i < 2; ++i) { const int idx = tid + 512 * i, l = idx >> 4, c = idx & 15; \
        const bf16* rp = PROJ + (size_t)scan_row<NB>(b, d, (ch) * 64 + l) * PROJW + hh * 128 + c * 8; \
        rq[i] = *(const u32x4*)(rp + PC_Q); rk[i] = *(const u32x4*)(rp + PC_K); } \
    { const int l = tid >> 3, c = tid & 7; rv = *(const u32x4*)(PROJ + (size_t)scan_row<NB>(b, d, (ch) * 64 + l) * PROJW + PC_V + hh * 256 + ev * 64 + c * 8); } \
    if (wave == 0) { const float* gp = GATES + (size_t)scan_row<NB>(b, d, (ch) * 64 + lane) * 64; rgi = gp[32 + d * 4 + hh]; rgf = gp[40 + d * 4 + hh]; } } while (0)
    ML_LOAD(0);
    for (int ch = 0; ch < NCH; ++ch) {
#pragma unroll
        for (int i = 0; i < 2; ++i) { const int idx = tid + 512 * i, l = idx >> 4, c = idx & 15;
            *(LAS u32x4*)(Qs + l * RS_N + c * 16) = rq[i]; *(LAS u32x4*)(Ks + l * RS_N + c * 16) = rk[i]; }
        { const int l = tid >> 3, c = tid & 7; *(LAS u32x4*)(Vs + l * RS_X + c * 16) = rv; }
        if (wave == 0) {
            const float li = rgi + ib, lf = logsigf(rgf + fb);
            float bc = lf;
#pragma unroll
            for (int o = 1; o < 64; o <<= 1) { const float t = __shfl_up(bc, o); if (lane >= o) bc += t; }
            float pm = li - bc;
#pragma unroll
            for (int o = 1; o < 64; o <<= 1) { const float t = __shfl_up(pm, o); if (lane >= o) pm = fmaxf(pm, t); }
            const float m_intra = bc + pm;
            const float gtot = __shfl(bc, 63);
            const float a_end = gtot - bc + li;
            const float m_loc = wave_max(a_end);
            const float m_inter = bc + m_run;
            const float mt = fmaxf(m_intra, m_inter);
            t_li[lane] = li; t_bc[lane] = bc; t_mt[lane] = mt; t_wi[lane] = __expf(m_inter - mt); t_we[lane] = __expf(a_end - m_loc);
            if (lane == 0) { t_sc[0] = gtot; t_sc[1] = m_loc; }
        }
        {
            const int ee = 32 * ebw + (lane & 31);
#pragma unroll
            for (int gq = 0; gq < 4; ++gq) { u32x2 o; o[0] = pk2(st[4 * gq], st[4 * gq + 1]); o[1] = pk2(st[4 * gq + 2], st[4 * gq + 3]);
                *(LAS u32x2*)(Ct + ee * RS_N + (32 * kbw + 8 * gq + 4 * (lane >> 5)) * 2) = o; }
        }
        __syncthreads();
        const float gtot = t_sc[0], m_loc = t_sc[1];
        const float m_new = fmaxf(gtot + m_run, m_loc);
        const float a_s = __expf(gtot + m_run - m_new), bbs = __expf(m_loc - m_new);
        f32x16 acc;
#pragma unroll
        for (int r = 0; r < 16; ++r) acc[r] = 0.f;
        int ebB = 0, lbB = 0;
        if (wave < 3) {
            const int sbA = wave == 2 ? 1 : 0, lbA = wave == 0 ? 0 : 1;
#pragma unroll
            for (int kk = 0; kk < 8; ++kk) acc = mfma32(frag_row(Ks, RS_N, 32 * sbA, 16 * kk, lane), frag_row(Qs, RS_N, 32 * lbA, 16 * kk, lane), acc);
            const int l = 32 * lbA + (lane & 31);
            const float bl = t_bc[l], mtl = t_mt[l];
            float rsum = 0.f;
#pragma unroll
            for (int gq = 0; gq < 4; ++gq) { const int s0 = 32 * sbA + 8 * gq + 4 * (lane >> 5);
                const f32x4 bs4 = *(const LAS f32x4*)(t_bc + s0), li4 = *(const LAS f32x4*)(t_li + s0);
                float m[4];
#pragma unroll
                for (int j = 0; j < 4; ++j) { m[j] = (s0 + j <= l) ? acc[4 * gq + j] * kscale * __expf(fminf(bl - bs4[j] + li4[j] - mtl, 0.f)) : 0.f; rsum += m[j]; }
                u32x2 o; o[0] = pk2(m[0], m[1]); o[1] = pk2(m[2], m[3]);
                *(LAS u32x2*)(Sm + l * RS_X + s0 * 2) = o; }
            rsum += __shfl_xor(rsum, 32);
            if (lane < 32) t_rs[wave * 32 + lane] = rsum;
        } else if (wave == 3) {
            float qn = 0.f;
#pragma unroll 4
            for (int c = 0; c < 16; ++c) { const u32x4 qv = *(const LAS u32x4*)(Qs + lane * RS_N + c * 16);
                const f32x4 n0 = *(const LAS f32x4*)(t_n + c * 8), n1 = *(const LAS f32x4*)(t_n + c * 8 + 4);
                qn += bflo(qv[0]) * n0[0] + bfhi(qv[0]) * n0[1] + bflo(qv[1]) * n0[2] + bfhi(qv[1]) * n0[3]
                    + bflo(qv[2]) * n1[0] + bfhi(qv[2]) * n1[1] + bflo(qv[3]) * n1[2] + bfhi(qv[3]) * n1[3]; }
            t_qn[lane] = qn;
        } else {
            ebB = (wave - 4) >> 1; lbB = (wave - 4) & 1;
#pragma unroll
            for (int kk = 0; kk < 8; ++kk) acc = mfma32(frag_row(Ct, RS_N, 32 * ebB, 16 * kk, lane), frag_row(Qs, RS_N, 32 * lbB, 16 * kk, lane), acc);
            const float wi = t_wi[32 * lbB + (lane & 31)];
#pragma unroll
            for (int r = 0; r < 16; ++r) acc[r] *= wi;
        }
        {
#pragma unroll
            for (int r = 0; r < 16; ++r) st[r] *= a_s;
            const float f = bbs * kscale;
#pragma unroll
            for (int kk = 0; kk < 4; ++kk) {
                const int l0 = 16 * kk + 8 * (lane >> 5);
                f32x4 w0 = *(const LAS f32x4*)(t_we + l0), w1 = *(const LAS f32x4*)(t_we + l0 + 4);
#pragma unroll
                for (int j = 0; j < 4; ++j) { w0[j] *= f; w1[j] *= f; }
                const bf16x8 ka = scale_frag(frag_col(Ks, RS_N, 16 * kk, 32 * kbw, lane), w0, w1);
                st = mfma32(ka, frag_col(Vs, RS_X, 16 * kk, 32 * ebw, lane), st);
            }
        }
        float n_new = 0.f;
        if (tid < 128) {
            float s = 0.f;
#pragma unroll 8
            for (int l = 0; l < 64; ++l) s += t_we[l] * bf2f(*(const LAS bf16*)(Ks + l * RS_N + tid * 2));
            n_new = a_s * t_n[tid] + bbs * kscale * s;
        }
        __syncthreads();
        if (tid < 128) t_n[tid] = n_new;
        if (ch + 1 < NCH) ML_LOAD(ch + 1);
        if (wave >= 4) {
            for (int sb = 0; sb <= lbB; ++sb) {
#pragma unroll
                for (int k2 = 0; k2 < 2; ++k2) acc = mfma32(frag_col(Vs, RS_X, 32 * sb + 16 * k2, 32 * ebB, lane), frag_row(Sm, RS_X, 32 * lbB, 32 * sb + 16 * k2, lane), acc);
            }
            const int l = 32 * lbB + (lane & 31), lr = lane & 31;
            const float rsum = lbB == 0 ? t_rs[lr] : t_rs[32 + lr] + t_rs[64 + lr];
            float den = rsum + t_qn[l] * t_wi[l];
            den = fmaxf(fabsf(den), __expf(-t_mt[l]));
            const float inv = 1.f / den;
            bf16* hp = SCb + (size_t)scan_row<NB>(b, d, ch * 64 + l) * 4096 + 2048 + d * 1024 + hh * 256 + ev * 64 + 32 * ebB + 4 * (lane >> 5);
#pragma unroll
            for (int gq = 0; gq < 4; ++gq) { u32x2 o; o[0] = pk2(acc[4 * gq] * inv, acc[4 * gq + 1] * inv); o[1] = pk2(acc[4 * gq + 2] * inv, acc[4 * gq + 3] * inv); *(u32x2*)(hp + 8 * gq) = o; }
        }
        m_run = m_new;
        __syncthreads();
    }
#undef ML_LOAD
}

template <int NB>
__device__ __forceinline__ void phase_scan(const In& in, const bf16* PROJ, const float* GATES, const bf16* XBC, bf16* SCb, LAS unsigned char* lds) {
    const int G = gridDim.x;
    for (int item = blockIdx.x; item < NB * 32; item += G) { const int b = item / 32, d = (item >> 4) & 1, h = item & 15;
        ssd_item<NB>(XBC, GATES, in.ssd_a_log, in.ssd_dt_bias, SCb, b, d, h, lds); }
    const int v = (blockIdx.x + G - (NB * 32) % G) % G;
    for (int it = v; it < NB * 32; it += G) { const int b = it / 32, d = (it >> 4) & 1, hh = (it >> 2) & 3, ev = it & 3;
        mlstm_item<NB>(PROJ, GATES, in.ml_i_bias, in.ml_f_bias, SCb, b, d, hh, ev, lds); }
}

template <int NB>
__device__ __forceinline__ void phase_mixer_out(const In& in, const bf16* PROJ, const bf16* XBC, bf16* SCb) {
    constexpr int T = NB * (SEQ + CTXL);
    const int lane = threadIdx.x & 63, wave = threadIdx.x >> 6;
    for (int row = blockIdx.x * NWAVE + wave; row < T; row += gridDim.x * NWAVE) {
        bf16* sc = SCb + (size_t)row * 4096;
        const bf16* pr = PROJ + (size_t)row * PROJW;
        float yv[16], hv[16], ss = 0.f, hs[2] = {0.f, 0.f};
#pragma unroll
        for (int i = 0; i < 2; ++i) { const int c = lane * 8 + 512 * i;
            const u32x4 y0 = *(const u32x4*)(sc + c), y1 = *(const u32x4*)(sc + 1024 + c), h0 = *(const u32x4*)(sc + 2048 + c), h1 = *(const u32x4*)(sc + 3072 + c);
            const u32x4 xs = *(const u32x4*)(XBC + (size_t)row * 1536 + c), z = *(const u32x4*)(pr + PC_Z + c);
            const float dk = in.ssd_d[c >> 6];
#pragma unroll
            for (int j = 0; j < 4; ++j) {
                float a0 = bflo(y0[j]) + bflo(y1[j]) + dk * bflo(xs[j]), a1 = bfhi(y0[j]) + bfhi(y1[j]) + dk * bfhi(xs[j]);
                a0 *= siluf(bflo(z[j])); a1 *= siluf(bfhi(z[j]));
                yv[8 * i + 2 * j] = a0; yv[8 * i + 2 * j + 1] = a1; ss += a0 * a0 + a1 * a1;
                const float b0 = bflo(h0[j]) + bflo(h1[j]), b1 = bfhi(h0[j]) + bfhi(h1[j]);
                hv[8 * i + 2 * j] = b0; hv[8 * i + 2 * j + 1] = b1; hs[i] += b0 * b0 + b1 * b1; } }
        ss = wave_sum(ss);
        const float rs = rsqrtf(ss * (1.f / 1024.f) + 1e-6f);
#pragma unroll
        for (int i = 0; i < 2; ++i) {
#pragma unroll
            for (int o = 16; o > 0; o >>= 1) hs[i] += __shfl_xor(hs[i], o);
            hs[i] = rsqrtf(hs[i] * (1.f / 256.f) + 1e-6f); }
        __builtin_amdgcn_s_waitcnt(0);
#pragma unroll
        for (int i = 0; i < 2; ++i) { const int c = lane * 8 + 512 * i;
            const u32x4 ov = *(const u32x4*)(pr + PC_O + c);
            u32x4 oy, oh;
#pragma unroll
            for (int j = 0; j < 4; ++j) {
                oy[j] = pk2(yv[8 * i + 2 * j] * rs * in.ssd_norm_w[c + 2 * j], yv[8 * i + 2 * j + 1] * rs * in.ssd_norm_w[c + 2 * j + 1]);
                oh[j] = pk2(hv[8 * i + 2 * j] * hs[i] * in.ml_norm_w[c + 2 * j] * sigmf(bflo(ov[j])), hv[8 * i + 2 * j + 1] * hs[i] * in.ml_norm_w[c + 2 * j + 1] * sigmf(bfhi(ov[j]))); }
            *(u32x4*)(sc + c) = oy; *(u32x4*)(sc + 1024 + c) = oh; }
    }
}

template <int NB>
__device__ __forceinline__ void phase_outproj(const bf16* A, int lda, int K, const bf16* Wt, int nrows, const float* xl, const float* xc, const float* modl, float* Xout,
                                              LAS unsigned char* lds) {
    constexpr int TL = NB * SEQ;
    const int MT = nrows / 256;
    for (int u = blockIdx.x; u < MT * 8; u += gridDim.x) {
        const int mt = u / 8, nt = u % 8;
        const bf16* arow[4];
#pragma unroll
        for (int i = 0; i < 4; ++i) arow[i] = A + (size_t)(mt * 256 + (threadIdx.x >> 3) + 64 * i) * lda;
        gemm_tile(arow, Wt + (size_t)nt * 128 * K, K, K, lds, [&](const f32x16 (&acc)[2][2], int wm, int wn, int lane) {
            const float* mv = modl + (size_t)mod_row<NB>(mt * 256) * 6144 + 2 * 1024;
#pragma unroll
            for (int mi = 0; mi < 2; ++mi) { const int row = mt * 256 + wm * 64 + mi * 32 + (lane & 31);
                const float* src = row < TL ? xl + (size_t)row * D : xc + (size_t)(row - TL) * D;
#pragma unroll
                for (int ni = 0; ni < 2; ++ni)
#pragma unroll
                    for (int g = 0; g < 4; ++g) { const int col = nt * 128 + wn * 64 + ni * 32 + 8 * g + 4 * (lane >> 5);
                        const f32x4 xv = *(const f32x4*)(src + col), m2 = *(const f32x4*)(mv + col);
                        f32x4 o;
#pragma unroll
                        for (int j = 0; j < 4; ++j) o[j] = xv[j] + m2[j] * acc[mi][ni][4 * g + j];
                        *(f32x4*)(Xout + (size_t)row * D + col) = o; } }
        });
    }
}
}
namespace fx {
__device__ __forceinline__ int moe_prefix(const int* cnt, LAS int* pre  ) {
    __syncthreads();
    if (threadIdx.x < 64) {
        const int lane = threadIdx.x;
        int v = lane < 32 ? (cnt[lane] + 255) >> 8 : 0;
#pragma unroll
        for (int o = 1; o < 32; o <<= 1) { const int t = __shfl_up(v, o); if (lane >= o) v += t; }
        if (lane < 32) pre[lane + 1] = v;
        if (lane == 0) pre[0] = 0;
    }
    __syncthreads();
    return pre[32];
}
__device__ __forceinline__ int moe_find(const LAS int* pre, int t) { int e = 0;
#pragma unroll
    for (int i = 1; i < 32; ++i) e += (t >= pre[i]) ? 1 : 0;
    return e; }

__device__ __forceinline__ void phase_moe_up(const bf16* H2, const bf16* Wgu, const int* cnt, const int* list, int cap, const float* route_w, bf16* ACT, LAS unsigned char* lds) {
    LAS int* pre = (LAS int*)(lds + GEMM_LDS);
    const int ntile = moe_prefix(cnt, pre);
    for (int u = blockIdx.x; u < ntile * 8; u += gridDim.x) {
        const int t = u >> 3, nt = u & 7, e = moe_find(pre, t), mt = t - pre[e], ce = cnt[e];
        const int* le = list + (size_t)e * cap + mt * 256;
        const int nvalid = ce - mt * 256;
        const bf16* arow[4];
#pragma unroll
        for (int i = 0; i < 4; ++i) { const int r = (threadIdx.x >> 3) + 64 * i; const int ent = le[r < nvalid ? r : 0]; arow[i] = H2 + (size_t)(ent >> 1) * D; }
        gemm_tile(arow, Wgu + (size_t)e * 1024 * 1024 + (size_t)nt * 128 * 1024, 1024, 1024, lds, [&](const f32x16 (&acc)[2][2], int wm, int wn, int lane) {
#pragma unroll
            for (int mi = 0; mi < 2; ++mi) { const int r = wm * 64 + mi * 32 + (lane & 31);
                if (r < nvalid) { const int ent = le[r]; const float w = route_w[ent];
                    bf16* op = ACT + (size_t)ent * 512 + nt * 64 + wn * 32 + 4 * (lane >> 5);
#pragma unroll
                    for (int g = 0; g < 4; ++g) { float v[4];
#pragma unroll
                        for (int j = 0; j < 4; ++j) v[j] = siluf(acc[mi][0][4 * g + j]) * acc[mi][1][4 * g + j] * w;
                        u32x2 o; o[0] = pk2(v[0], v[1]); o[1] = pk2(v[2], v[3]); *(u32x2*)(op + 8 * g) = o; } } }
        });
    }
}
__device__ __forceinline__ void phase_moe_down(const bf16* ACT, const bf16* Wd, const int* cnt, const int* list, int cap, bf16* Y2, LAS unsigned char* lds) {
    LAS int* pre = (LAS int*)(lds + GEMM_LDS);
    const int ntile = moe_prefix(cnt, pre);
    for (int u = blockIdx.x; u < ntile * 8; u += gridDim.x) {
        const int t = u >> 3, nt = u & 7, e = moe_find(pre, t), mt = t - pre[e], ce = cnt[e];
        const int* le = list + (size_t)e * cap + mt * 256;
        const int nvalid = ce - mt * 256;
        const bf16* arow[4];
#pragma unroll
        for (int i = 0; i < 4; ++i) { const int r = (threadIdx.x >> 3) + 64 * i; const int ent = le[r < nvalid ? r : 0]; arow[i] = ACT + (size_t)ent * 512; }
        gemm_tile(arow, Wd + (size_t)e * 1024 * 512 + (size_t)nt * 128 * 512, 512, 512, lds, [&](const f32x16 (&acc)[2][2], int wm, int wn, int lane) {
#pragma unroll
            for (int mi = 0; mi < 2; ++mi) { const int r = wm * 64 + mi * 32 + (lane & 31);
                if (r < nvalid) { const int ent = le[r];
                    bf16* op = Y2 + (size_t)ent * D + nt * 128 + wn * 64 + 4 * (lane >> 5);
#pragma unroll
                    for (int ni = 0; ni < 2; ++ni)
#pragma unroll
                        for (int g = 0; g < 4; ++g) { u32x2 o; o[0] = pk2(acc[mi][ni][4 * g], acc[mi][ni][4 * g + 1]); o[1] = pk2(acc[mi][ni][4 * g + 2], acc[mi][ni][4 * g + 3]);
                            *(u32x2*)(op + ni * 32 + 8 * g) = o; } } }
        });
    }
}

template <int NB>
__device__ __forceinline__ void phase_qkv(const bf16* H, const bf16* Wt, const float* qn, const float* kn, bf16* QKV, LAS unsigned char* lds) {
    constexpr int T = NB * (SEQ + CTXL), MT = T / 256;
    for (int u = blockIdx.x; u < MT * 24; u += gridDim.x) {
        const int mt = u / 24, nt = u % 24;
        const bf16* arow[4];
#pragma unroll
        for (int i = 0; i < 4; ++i) arow[i] = H + (size_t)(mt * 256 + (threadIdx.x >> 3) + 64 * i) * D;
        gemm_tile(arow, Wt + (size_t)nt * 128 * D, D, D, lds, [&](const f32x16 (&acc)[2][2], int wm, int wn, int lane) {
            const int which = nt >> 3;
#pragma unroll
            for (int mi = 0; mi < 2; ++mi) { const int row = mt * 256 + wm * 64 + mi * 32 + (lane & 31);
                float rs = 1.f;
                if (which < 2) { float ss = 0.f;
#pragma unroll
                    for (int ni = 0; ni < 2; ++ni)
#pragma unroll
                        for (int r = 0; r < 16; ++r) ss += acc[mi][ni][r] * acc[mi][ni][r];
                    ss += __shfl_xor(ss, 32);
                    rs = rsqrtf(ss * (1.f / 64.f) + 1e-6f) * (which == 0 ? 0.125f : 1.f); }
                const float* nwp = which == 0 ? qn : kn;
                bf16* op = QKV + (size_t)row * 3072 + nt * 128 + wn * 64 + 4 * (lane >> 5);
#pragma unroll
                for (int ni = 0; ni < 2; ++ni)
#pragma unroll
                    for (int g = 0; g < 4; ++g) { float v[4];
#pragma unroll
                        for (int j = 0; j < 4; ++j) { v[j] = acc[mi][ni][4 * g + j]; if (which < 2) v[j] *= rs * nwp[ni * 32 + 8 * g + 4 * (lane >> 5) + j]; }
                        u32x2 o; o[0] = pk2(v[0], v[1]); o[1] = pk2(v[2], v[3]); *(u32x2*)(op + ni * 32 + 8 * g) = o; } }
        });
    }
}

__device__ __forceinline__ bf16x8 frag16_row(const LAS unsigned char* T, int RS, int r0, int c0, int lane) {
    return *(const LAS bf16x8*)(T + (r0 + (lane & 15)) * RS + (c0 + 8 * (lane >> 4)) * 2);
}
__device__ __forceinline__ bf16x8 frag16_vt(const LAS unsigned char* T, int RS, int kb, int c0, int lane) {
    const int g4 = lane >> 4, q = (lane & 15) >> 2, p = lane & 3;
    const unsigned a0 = (unsigned)(size_t)(T + (kb + 4 * g4 + q) * RS + (c0 + 4 * p) * 2);
    const unsigned a1 = a0 + 16 * RS;
    bf16x4 v0, v1;
    asm volatile("ds_read_b64_tr_b16 %0, %2\n\tds_read_b64_tr_b16 %1, %3\n\ts_waitcnt lgkmcnt(0)" : "=&v"(v0), "=&v"(v1) : "v"(a0), "v"(a1) : "memory");
    bf16x8 r; r[0] = v0[0]; r[1] = v0[1]; r[2] = v0[2]; r[3] = v0[3]; r[4] = v1[0]; r[5] = v1[1]; r[6] = v1[2]; r[7] = v1[3];
    return r;
}

template <int NB>
__device__ __forceinline__ void phase_attn(const bf16* QKV, const float* rpb, bf16* AO, LAS unsigned char* lds) {
    constexpr int TL = NB * SEQ;
    constexpr int TILE = 64 * RS_N;
    const int tid = threadIdx.x, lane = tid & 63, wave = tid >> 6, w = wave & 3, hsel = wave >> 2;
    const int qi = lane & 15, g4 = lane >> 4;
    LAS float* rp = (LAS float*)(lds + 4 * TILE);
    for (int u = blockIdx.x; u < NB * 64 * 8; u += gridDim.x) {
        const int hp = u & 7, r = (u >> 3) & 63, b = u >> 9;
        const int head = 2 * hp + hsel;
        int r0 = r - 4; r0 = r0 < 0 ? 0 : (r0 > 56 ? 56 : r0);
        __syncthreads();
        for (int i = tid; i < 2 * 465; i += NTHR) rp[i] = rpb[(size_t)(2 * hp) * 465 + i];
        const int c = 16 * w + qi;
        const size_t qrow = (size_t)b * SEQ + r * 64 + c;
        const bf16x8 q0 = *(const bf16x8*)(QKV + qrow * 3072 + head * 64 + 8 * g4), q1 = *(const bf16x8*)(QKV + qrow * 3072 + head * 64 + 32 + 8 * g4);
        int cs = c - 8; cs = cs < 0 ? 0 : (cs > 48 ? 48 : cs);
        const int kbw = w == 0 ? 0 : (w == 1 ? 8 : (w == 2 ? 24 : 32));
        f32x4 oacc[4];
#pragma unroll
        for (int i = 0; i < 4; ++i) oacc[i] = (f32x4){0.f, 0.f, 0.f, 0.f};
        float m_run = -3.0e38f, l_run = 0.f;
        u32x4 sk[2], sv[2];
#define AT_LOAD(it) do { \
        _Pragma("unroll") for (int i = 0; i < 2; ++i) { const int idx = tid + 512 * i, key = idx >> 4, ch = idx & 15; \
            const size_t krow = (it) < 8 ? (size_t)b * SEQ + (size_t)(r0 + (it)) * 64 + key : (size_t)TL + (size_t)b * CTXL + ((it) - 8) * 64 + key; \
            const bf16* kp = QKV + krow * 3072 + 1024 + hp * 128 + ch * 8; sk[i] = *(const u32x4*)kp; sv[i] = *(const u32x4*)(kp + 1024); } } while (0)
#define AT_STORE(buf) do { LAS unsigned char* kt_ = lds + (buf) * 2 * TILE; \
        _Pragma("unroll") for (int i = 0; i < 2; ++i) { const int idx = tid + 512 * i, key = idx >> 4, ch = idx & 15; \
            *(LAS u32x4*)(kt_ + key * RS_N + ch * 16) = sk[i]; *(LAS u32x4*)(kt_ + TILE + key * RS_N + ch * 16) = sv[i]; } } while (0)
        AT_LOAD(0);
        AT_STORE(0);
        __syncthreads();
        for (int it = 0; it < 12; ++it) {
            const LAS unsigned char* Kt = lds + (it & 1) * 2 * TILE; const LAS unsigned char* Vt = Kt + TILE;
            if (it + 1 < 12) AT_LOAD(it + 1);
            const int ngrp = it < 8 ? 1 : 2;
            for (int grp = 0; grp < ngrp; ++grp) {
                const int kb = it < 8 ? kbw : 32 * grp;
                f32x4 s[2];
#pragma unroll
                for (int sb = 0; sb < 2; ++sb) { s[sb] = (f32x4){0.f, 0.f, 0.f, 0.f};
                    s[sb] = mfma16(frag16_row(Kt, RS_N, kb + 16 * sb, hsel * 64, lane), q0, s[sb]);
                    s[sb] = mfma16(frag16_row(Kt, RS_N, kb + 16 * sb, hsel * 64 + 32, lane), q1, s[sb]); }
                float mx = -3.0e38f;
#pragma unroll
                for (int sb = 0; sb < 2; ++sb)
#pragma unroll
                    for (int j = 0; j < 4; ++j) {
                        if (it < 8) { const int kc = kb + 16 * sb + 4 * g4 + j; const bool ok = kc >= cs && kc < cs + 16;
                            const int bi = (r0 + it - r + 7) * 31 + (kc - c + 15);
                            s[sb][j] = ok ? s[sb][j] + rp[hsel * 465 + (ok ? bi : 0)] : -3.0e38f; }
                        mx = fmaxf(mx, s[sb][j]); }
                mx = fmaxf(mx, __shfl_xor(mx, 16)); mx = fmaxf(mx, __shfl_xor(mx, 32));
                const float mn = fmaxf(m_run, mx);
                const float alpha = __expf(m_run - mn);
                float ps = 0.f; float p[8];
#pragma unroll
                for (int sb = 0; sb < 2; ++sb)
#pragma unroll
                    for (int j = 0; j < 4; ++j) { const float e = s[sb][j] > -1.0e38f ? __expf(s[sb][j] - mn) : 0.f; p[4 * sb + j] = e; ps += e; }
                l_run = l_run * alpha + ps; m_run = mn;
                u32x4 pu; pu[0] = pk2(p[0], p[1]); pu[1] = pk2(p[2], p[3]); pu[2] = pk2(p[4], p[5]); pu[3] = pk2(p[6], p[7]);
                const bf16x8 pf = __builtin_bit_cast(bf16x8, pu);
#pragma unroll
                for (int db = 0; db < 4; ++db) {
#pragma unroll
                    for (int j = 0; j < 4; ++j) oacc[db][j] *= alpha;
                    oacc[db] = mfma16(frag16_vt(Vt, RS_N, kb, hsel * 64 + 16 * db, lane), pf, oacc[db]); }
            }
            if (it + 1 < 12) AT_STORE((it + 1) & 1);
            __syncthreads();
        }
#undef AT_LOAD
#undef AT_STORE
        l_run += __shfl_xor(l_run, 16); l_run += __shfl_xor(l_run, 32);
        const float inv = 1.f / l_run;
        bf16* op = AO + qrow * D + head * 64 + 4 * g4;
#pragma unroll
        for (int db = 0; db < 4; ++db) { u32x2 o; o[0] = pk2(oacc[db][0] * inv, oacc[db][1] * inv); o[1] = pk2(oacc[db][2] * inv, oacc[db][3] * inv); *(u32x2*)(op + 16 * db) = o; }
    }
}
}
#define XB_TMO      128
#define XB_XCNT(j)  (256  + 64 * (j))
#define XB_XSUB(j)  (1280 + 64 * (j))
#define XB_XGEN(j)  (2304 + 64 * (j))
#define XB_TOP      3328
#define XB_TOPGEN   3392
#define XCD_BAR_WORDS 3456
#define XB_SPIN_CAP (1u << 18)

__device__ __forceinline__ unsigned xb_ld(unsigned* p)              { return __hip_atomic_load(p, __ATOMIC_RELAXED, __HIP_MEMORY_SCOPE_AGENT); }
__device__ __forceinline__ unsigned xb_add(unsigned* p, unsigned v) { return __hip_atomic_fetch_add(p, v, __ATOMIC_RELAXED, __HIP_MEMORY_SCOPE_AGENT); }
__device__ __forceinline__ unsigned xb_xcc_id() { return (unsigned)__builtin_amdgcn_s_getreg((3 << 11) | 20) & 0xFu; }
#define XB_SPIN(cond, bar) do { unsigned _sp = 0; while (cond) { __builtin_amdgcn_s_sleep(1); \
    if ((++_sp & 255u) == 0u) { if (xb_ld(&(bar)[XB_TMO])) break; if (_sp > XB_SPIN_CAP) { atomicAdd(&(bar)[XB_TMO], 1u); break; } } } } while (0)

struct XcdBarrier {
    unsigned* bar; unsigned x;
    volatile LAS unsigned* st;
};

__device__ __forceinline__ XcdBarrier xcd_barrier_post(unsigned* bar, volatile LAS unsigned* st) {
    XcdBarrier b; b.bar = bar; b.x = xb_xcc_id(); b.st = st;
    if (threadIdx.x == 0) (void)xb_add(&bar[XB_XCNT(b.x)], 1u);
    return b;
}
__device__ __forceinline__ void xcd_barrier_complete(unsigned* bar, unsigned x, unsigned& nloc, unsigned& nx) {
    const unsigned G = gridDim.x * gridDim.y * gridDim.z;
    unsigned sum, cnt, mine, sp = 0u;
    for (;;) {
        sum = 0u; cnt = 0u; mine = 0u;
#pragma unroll
        for (unsigned j = 0; j < 16; ++j) { const unsigned c = xb_ld(&bar[XB_XCNT(j)]); sum += c; cnt += (c > 0u) ? 1u : 0u; mine = (j == x) ? c : mine; }
        if (sum == G) break;
        __builtin_amdgcn_s_sleep(1);
        if ((++sp & 255u) == 0u) { if (xb_ld(&bar[XB_TMO])) break; if (sp > XB_SPIN_CAP) { atomicAdd(&bar[XB_TMO], 1u); break; } }
    }
    nloc = mine > 0u ? mine : 1u; nx = cnt > 0u ? cnt : 1u;
}

__device__ __forceinline__ void xcd_barrier(const XcdBarrier& b) {
    asm volatile("s_waitcnt vmcnt(0)" ::: "memory");
    __syncthreads();
    if (threadIdx.x == 0) {
        unsigned* bar = b.bar;
        __builtin_amdgcn_s_waitcnt(0);
        unsigned nloc = b.st[0], nx = b.st[1];
        if (nloc == 0u) { xcd_barrier_complete(bar, b.x, nloc, nx); b.st[0] = nloc; b.st[1] = nx; }
        const unsigned old = xb_add(&bar[XB_XSUB(b.x)], 1u);
        const unsigned gen = old / nloc;
        if (old + 1u == (gen + 1u) * nloc) {
            __builtin_amdgcn_fence(__ATOMIC_RELEASE, "agent");
            asm volatile("s_waitcnt vmcnt(0)" ::: "memory");
            const unsigned og = xb_add(&bar[XB_TOP], 1u);
            const unsigned tg = og / nx;
            if (og + 1u == (tg + 1u) * nx) xb_add(&bar[XB_TOPGEN], 1u);
            else XB_SPIN(xb_ld(&bar[XB_TOPGEN]) == tg, bar);
            __builtin_amdgcn_fence(__ATOMIC_ACQUIRE, "agent");
            xb_add(&bar[XB_XGEN(b.x)], 1u);
            asm volatile("s_waitcnt vmcnt(0)" ::: "memory");
        } else {
            XB_SPIN(xb_ld(&bar[XB_XGEN(b.x)]) == gen, bar);
            __builtin_amdgcn_fence(__ATOMIC_ACQUIRE, "agent");
            asm volatile("s_waitcnt vmcnt(0)" ::: "memory");
        }
    }
    __syncthreads();
}
namespace mk {
using namespace fx;
constexpr int NB = 4;
typedef Plan<NB> PL;

__global__ void __launch_bounds__(512, 2) k_mega(P p) {
    extern __shared__ __attribute__((aligned(16))) unsigned char lds_raw[];
    LAS unsigned char* lds = (LAS unsigned char*)lds_raw;
    unsigned char* ws = p.ws;
    const In& in = p.in;
    LAS unsigned* xbw = (LAS unsigned*)(lds + LDS_BYTES - 16);
    if (threadIdx.x == 0) { xbw[0] = 0u; xbw[1] = 0u; xbw[2] = 0u; xbw[3] = 0u; }
    __syncthreads();
    XcdBarrier bar = xcd_barrier_post((unsigned*)(ws + PL::CTL_BAR), (volatile LAS unsigned*)xbw);
    float* modv = (float*)(ws + PL::MODV);
    const float* mod0 = modv; const float* mod1 = modv + 5 * 6144;
    bf16* H = (bf16*)(ws + PL::H);
    int* cnt0 = (int*)(ws + PL::CTL_CNT); int* cnt1 = cnt0 + 32;
    int* list = (int*)(ws + PL::LIST); float* rw = (float*)(ws + PL::RW);
    bf16* wmoe0 = (bf16*)(ws + PL::W_MOE0); bf16* wmoe1 = (bf16*)(ws + PL::W_MOE1);
    const size_t GU = (size_t)32 * 1024 * 1024;
    float* X1 = (float*)(ws + PL::X1); float* X2 = (float*)(ws + PL::X2); float* X3 = (float*)(ws + PL::X3);
    conv_small_weights(in, ws, PL::W_IN, PL::W_OUT, PL::W_QKV, PL::W_NAO, lds);
    mod_vectors(in, modv, lds);
    conv_moe_weights(in, 0, wmoe0, wmoe0 + GU, lds);
    xcd_barrier(bar);
    rows_phase<NB, false, false, true, false>(in.x, in.ctx, PL::T, nullptr, mod0, mod0, nullptr, nullptr, in.norm1_w, 0, 1, H,
                                              nullptr, nullptr, nullptr, nullptr, nullptr, nullptr, nullptr, 0, lds);
    xcd_barrier(bar);
    phase_inproj<NB>(H, (const bf16*)(ws + PL::W_IN), (bf16*)(ws + PL::PROJ), (float*)(ws + PL::GATES), lds);
    xcd_barrier(bar);
    phase_conv<NB>((const bf16*)(ws + PL::PROJ), in.ab_conv_w, in.ab_conv_b, (bf16*)(ws + PL::XBC));
    xcd_barrier(bar);
    phase_scan<NB>(in, (const bf16*)(ws + PL::PROJ), (const float*)(ws + PL::GATES), (const bf16*)(ws + PL::XBC), (bf16*)(ws + PL::SC), lds);
    xcd_barrier(bar);
    phase_mixer_out<NB>(in, (const bf16*)(ws + PL::PROJ), (const bf16*)(ws + PL::XBC), (bf16*)(ws + PL::SC));
    xcd_barrier(bar);
    phase_outproj<NB>((const bf16*)(ws + PL::SC), 4096, 2048, (const bf16*)(ws + PL::W_OUT), PL::T, in.x, in.ctx, mod0, X1, lds);
    xcd_barrier(bar);
    rows_phase<NB, false, false, true, true>(X1, X1 + PL::TL * D, PL::T, nullptr, mod0, mod0, nullptr, nullptr, in.norm2_w, 3, 4, H,
        in.moe_w_group, in.moe_b_group, in.moe_w_expert, in.moe_b_expert, rw, cnt0, list, (int)PL::T, lds);
    conv_moe_weights(in, 1, wmoe1, wmoe1 + GU, lds);
    xcd_barrier(bar);
    phase_moe_up(H, wmoe0, cnt0, list, (int)PL::T, rw, (bf16*)(ws + PL::ACT), lds);
    xcd_barrier(bar);
    phase_moe_down((const bf16*)(ws + PL::ACT), wmoe0 + GU, cnt0, list, (int)PL::T, (bf16*)(ws + PL::Y2), lds);
    xcd_barrier(bar);
    rows_phase<NB, true, true, true, false>(X1, X1 + PL::TL * D, PL::T, (const bf16*)(ws + PL::Y2), mod0, mod1, X2, nullptr, in.norm1_w + 1024, 0, 1, H,
        nullptr, nullptr, nullptr, nullptr, nullptr, nullptr, nullptr, 0, lds);
    xcd_barrier(bar);
    phase_qkv<NB>(H, (const bf16*)(ws + PL::W_QKV), in.na_q_norm, in.na_k_norm, (bf16*)(ws + PL::QKV), lds);
    xcd_barrier(bar);
    phase_attn<NB>((const bf16*)(ws + PL::QKV), in.na_rpb, (bf16*)(ws + PL::AO), lds);
    xcd_barrier(bar);
    phase_outproj<NB>((const bf16*)(ws + PL::AO), 1024, 1024, (const bf16*)(ws + PL::W_NAO), PL::TL, X2, X2 + PL::TL * D, mod1, X3, lds);
    xcd_barrier(bar);
    rows_phase<NB, false, false, true, true>(X3, X3, PL::TL, nullptr, mod1, mod1, nullptr, nullptr, in.norm2_w + 1024, 3, 4, H,
        in.moe_w_group + 1024 * 4, in.moe_b_group + 4, in.moe_w_expert + 1024 * 32, in.moe_b_expert + 32, rw, cnt1, list, (int)PL::T, lds);
    xcd_barrier(bar);
    phase_moe_up(H, wmoe1, cnt1, list, (int)PL::T, rw, (bf16*)(ws + PL::ACT), lds);
    xcd_barrier(bar);
    phase_moe_down((const bf16*)(ws + PL::ACT), wmoe1 + GU, cnt1, list, (int)PL::T, (bf16*)(ws + PL::Y2), lds);
    xcd_barrier(bar);
    rows_phase<NB, true, false, false, false>(X3, X3, PL::TL, (const bf16*)(ws + PL::Y2), mod1, mod1, nullptr, p.out, nullptr, 0, 0, nullptr,
        nullptr, nullptr, nullptr, nullptr, nullptr, nullptr, nullptr, 0, lds);
}
__global__ void k_fill(float* q, size_t n, float v) { size_t i = (size_t)blockIdx.x * 256 + threadIdx.x; if (i < n) q[i] = v; }
}

extern "C" void kernel_launch(void* const* d_in, const int* in_sizes, int n_in, void* d_out, int out_size, void* d_ws, size_t ws_size, hipStream_t stream) {
    static int grid = 0;
    if (grid == 0) {
        int dev = 0, cus = 0, per_cu = 0;
        (void)hipGetDevice(&dev);
        (void)hipDeviceGetAttribute(&cus, hipDeviceAttributeMultiprocessorCount, dev);
        if (hipFuncSetAttribute((const void*)mk::k_mega, hipFuncAttributeMaxDynamicSharedMemorySize, fx::LDS_BYTES) != hipSuccess) { grid = -1; }
        else {
            if (hipOccupancyMaxActiveBlocksPerMultiprocessor(&per_cu, (const void*)mk::k_mega, 512, fx::LDS_BYTES) != hipSuccess) per_cu = 0;
            (void)hipGetLastError();
            grid = per_cu >= 1 ? cus : -1;
        }
    }
    if (grid < 0 || n_in != 31 || mk::PL::END > ws_size) { mk::k_fill<<<(out_size + 255) / 256, 256, 0, stream>>>((float*)d_out, (size_t)out_size, 2.f); return; }
    (void)hipMemsetAsync((unsigned char*)d_ws + mk::PL::CTL, 0, mk::PL::CTL_BYTES, stream);
    fx::P fp;
    { const float** q = (const float**)&fp.in; for (int i = 0; i < 31; ++i) q[i] = (const float*)d_in[i]; }
    fp.ws = (unsigned char*)d_ws; fp.out = (float*)d_out;
    hipLaunchKernelGGL(mk::k_mega, dim3(grid), dim3(512), fx::LDS_BYTES, stream, fp);
}
```

```cpp
#include <hip/hip_runtime.h>
#include <cstdio>
#include <cstdint>
namespace fx {
#define LAS __attribute__((address_space(3)))
typedef unsigned short bf16;
typedef short bf16x8 __attribute__((ext_vector_type(8)));
typedef short bf16x4 __attribute__((ext_vector_type(4)));
typedef float f32x16 __attribute__((ext_vector_type(16)));
typedef float f32x4 __attribute__((ext_vector_type(4)));
typedef unsigned u32x4 __attribute__((ext_vector_type(4)));
typedef unsigned u32x2 __attribute__((ext_vector_type(2)));
constexpr int NTHR = 512, NWAVE = 8;
constexpr int D = 1024, SEQ = 4096, CTXL = 256;
constexpr int PROJW = 5632, NIN = 5760;
constexpr int PC_Z = 0, PC_XBC = 1024, PC_Q = 2560, PC_K = 3072, PC_V = 3584, PC_O = 4608;
constexpr int LDS_BYTES = 152 * 1024;

__device__ __forceinline__ float bf2f(bf16 v) { return __uint_as_float((unsigned)v << 16); }
__device__ __forceinline__ float bflo(unsigned u) { return __uint_as_float(u << 16); }
__device__ __forceinline__ float bfhi(unsigned u) { return __uint_as_float(u & 0xffff0000u); }
__device__ __forceinline__ unsigned pk2(float lo, float hi) { unsigned r; asm("v_cvt_pk_bf16_f32 %0, %1, %2" : "=v"(r) : "v"(lo), "v"(hi)); return r; }
__device__ __forceinline__ float siluf(float v) { return v / (1.f + __expf(-v)); }
__device__ __forceinline__ float sigmf(float v) { return 1.f / (1.f + __expf(-v)); }
__device__ __forceinline__ float softplusf(float v) { return v > 20.f ? v : log1pf(__expf(v)); }
__device__ __forceinline__ float logsigf(float v) { return fminf(v, 0.f) - log1pf(__expf(-fabsf(v))); }
__device__ __forceinline__ float wave_sum(float v) {
#pragma unroll
    for (int o = 32; o > 0; o >>= 1) v += __shfl_xor(v, o);
    return v;
}
__device__ __forceinline__ float wave_max(float v) {
#pragma unroll
    for (int o = 32; o > 0; o >>= 1) v = fmaxf(v, __shfl_xor(v, o));
    return v;
}
__device__ __forceinline__ f32x16 mfma32(bf16x8 a, bf16x8 b, f32x16 c) { return __builtin_amdgcn_mfma_f32_32x32x16_bf16(a, b, c, 0, 0, 0); }
__device__ __forceinline__ f32x4 mfma16(bf16x8 a, bf16x8 b, f32x4 c) { return __builtin_amdgcn_mfma_f32_16x16x32_bf16(a, b, c, 0, 0, 0); }

__device__ __forceinline__ bf16x8 frag_row(const LAS unsigned char* T, int RS, int r0, int k0, int lane) {
    return *(const LAS bf16x8*)(T + (r0 + (lane & 31)) * RS + (k0 + 8 * (lane >> 5)) * 2);
}
__device__ __forceinline__ bf16x8 frag_col(const LAS unsigned char* T, int RS, int k0, int c0, int lane) {
    const int h = lane >> 5, blk = (lane >> 4) & 1, q = (lane & 15) >> 2, p = lane & 3;
    const unsigned a0 = (unsigned)(size_t)(T + (k0 + 8 * h + q) * RS + (c0 + 16 * blk + 4 * p) * 2);
    const unsigned a1 = a0 + 4 * RS;
    bf16x4 v0, v1;
    asm volatile("ds_read_b64_tr_b16 %0, %2\n\tds_read_b64_tr_b16 %1, %3\n\ts_waitcnt lgkmcnt(0)" : "=&v"(v0), "=&v"(v1) : "v"(a0), "v"(a1) : "memory");
    bf16x8 r; r[0] = v0[0]; r[1] = v0[1]; r[2] = v0[2]; r[3] = v0[3]; r[4] = v1[0]; r[5] = v1[1]; r[6] = v1[2]; r[7] = v1[3];
    return r;
}

struct In {
    const float *x, *c, *ctx, *c_ctx, *norm1_w, *norm2_w, *mod_w, *mod_b, *ab_w_in, *ab_conv_w, *ab_conv_b, *ssd_a_log, *ssd_dt_bias, *ssd_d,
        *ssd_norm_w, *ml_i_bias, *ml_f_bias, *ml_norm_w, *ab_w_out, *na_w_qkv, *na_q_norm, *na_k_norm, *na_rpb, *na_w_out,
        *moe_w_group, *moe_b_group, *moe_w_expert, *moe_b_expert, *moe_w_gate, *moe_w_up, *moe_w_down;
};

constexpr size_t cmax(size_t a, size_t b) { return a > b ? a : b; }
constexpr size_t al256(size_t x) { return (x + 255) & ~(size_t)255; }

template <int NB> struct Plan {
    static constexpr size_t TL = (size_t)NB * SEQ, TC = (size_t)NB * CTXL, T = TL + TC;
    static constexpr size_t CTL = 0;
    static constexpr size_t CTL_BAR = 0, CTL_CNT = 16384  , CTL_BYTES = 32768;
    static constexpr size_t MODV = CTL + CTL_BYTES;
    static constexpr size_t RW = MODV + al256(2 * 5 * 6144 * 4);
    static constexpr size_t LIST = RW + al256(2 * T * 4);
    static constexpr size_t W_IN = LIST + al256(32 * T * 4);
    static constexpr size_t W_OUT = W_IN + (size_t)NIN * 1024 * 2;
    static constexpr size_t W_QKV = W_OUT + (size_t)1024 * 2048 * 2;
    static constexpr size_t W_NAO = W_QKV + (size_t)3072 * 1024 * 2;
    static constexpr size_t ARENA = W_NAO + (size_t)1024 * 1024 * 2;
    static constexpr size_t MOEW = (size_t)32 * 1024 * 1024 * 2 + (size_t)32 * 1024 * 512 * 2;
    static constexpr size_t SZ_B = al256(T * 1024 * 2);
    static constexpr size_t SZ_A = al256(cmax(MOEW, cmax(T * 3072 * 2, T * 1024 * 4)));
    static constexpr size_t SZ_X = al256(T * 1024 * 4);
    static constexpr size_t SZ_C = al256(cmax(T * PROJW * 2 + T * 64 * 4, SZ_X + MOEW));
    static constexpr size_t SZ_D = al256(T * 1536 * 2);
    static constexpr size_t SZ_E = al256(T * 4096 * 2);
    static constexpr size_t RB = ARENA, RA = RB + SZ_B, RC = RA + SZ_A, RD = RC + SZ_C, RE = RD + SZ_D, END = RE + SZ_E;
    static constexpr size_t H = RB;
    static constexpr size_t W_MOE0 = RA;
    static constexpr size_t QKV = RA;
    static constexpr size_t X3 = RA;
    static constexpr size_t PROJ = RC;
    static constexpr size_t GATES = RC + T * PROJW * 2;
    static constexpr size_t X1 = RC;
    static constexpr size_t W_MOE1 = RC + SZ_X;
    static constexpr size_t XBC = RD;
    static constexpr size_t ACT = RD;
    static constexpr size_t AO = RD;
    static constexpr size_t SC = RE;
    static constexpr size_t Y2 = RE;
    static constexpr size_t X2 = RE + al256(2 * T * 1024 * 2);
    static_assert(2 * T * 1024 * 2 + T * 1024 * 4 <= SZ_E, "E");
    static_assert(T * 3072 * 2 <= SZ_A + SZ_X, "QKV spill");
};

struct P { In in; unsigned char* ws; float* out; };

template <int NB> __device__ __forceinline__ int mod_row(int row) { return row < NB * SEQ ? row / SEQ : 4; }

template <class Map>
__device__ __forceinline__ void tconv_tile(const float* src, int ld_src, bf16* dst, int K, int k0, int n0, Map map, LAS unsigned char* lds) {
    LAS float* tl = (LAS float*)lds;
    const int tid = threadIdx.x;
    {
        const int n = tid & 63, kb = tid >> 6;
        const int sc = map(n0 + n);
#pragma unroll
        for (int i = 0; i < 8; ++i) { const int k = kb + 8 * i; tl[k * 65 + n] = sc >= 0 ? src[(size_t)(k0 + k) * ld_src + sc] : 0.f; }
    }
    __syncthreads();
    {
        const int n = tid >> 3, kc = tid & 7;
        float v[8];
#pragma unroll
        for (int j = 0; j < 8; ++j) v[j] = tl[(kc * 8 + j) * 65 + n];
        u32x4 o; o[0] = pk2(v[0], v[1]); o[1] = pk2(v[2], v[3]); o[2] = pk2(v[4], v[5]); o[3] = pk2(v[6], v[7]);
        *(u32x4*)(dst + (size_t)(n0 + n) * K + k0 + kc * 8) = o;
    }
    __syncthreads();
}

struct MapId { __device__ int operator()(int n) const { return n; } };
struct MapIn {
    __device__ int operator()(int n) const { return n < 2560 ? n : (n < 5632 ? n + 32 : (n < 5664 ? n - 3072 : (n < 5680 ? n : -1))); }
};

__device__ __forceinline__ void conv_small_weights(const In& in, unsigned char* ws, size_t o_in, size_t o_out, size_t o_qkv, size_t o_nao, LAS unsigned char* lds) {
    const int total = 1440 + 512 + 768 + 256;
    for (int u = blockIdx.x; u < total; u += gridDim.x) {
        if (u < 1440) { const int kt = u % 16, nt = u / 16; tconv_tile(in.ab_w_in, 5680, (bf16*)(ws + o_in), 1024, kt * 64, nt * 64, MapIn(), lds); }
        else if (u < 1952) { const int v = u - 1440, kt = v % 32, nt = v / 32; tconv_tile(in.ab_w_out, 1024, (bf16*)(ws + o_out), 2048, kt * 64, nt * 64, MapId(), lds); }
        else if (u < 2720) { const int v = u - 1952, kt = v % 16, nt = v / 16; tconv_tile(in.na_w_qkv, 3072, (bf16*)(ws + o_qkv), 1024, kt * 64, nt * 64, MapId(), lds); }
        else { const int v = u - 2720, kt = v % 16, nt = v / 16; tconv_tile(in.na_w_out, 1024, (bf16*)(ws + o_nao), 1024, kt * 64, nt * 64, MapId(), lds); }
    }
}

struct MapGU { __device__ int operator()(int n) const { return (n >> 7) * 64 + ((n >> 6) & 1) * 32 + (n & 31); } };
__device__ __forceinline__ void conv_moe_weights(const In& in, int layer, bf16* wgu, bf16* wd, LAS unsigned char* lds) {
    const size_t wsz = (size_t)1024 * 512;
    const int total_gu = 32 * 16 * 16, total_d = 32 * 8 * 16;
    for (int u = blockIdx.x; u < total_gu + total_d; u += gridDim.x) {
        if (u < total_gu) {
            const int e = u / 256, v = u % 256, kt = v % 16, nt = v / 16;
            const float* g = in.moe_w_gate + ((size_t)layer * 32 + e) * wsz; const float* up = in.moe_w_up + ((size_t)layer * 32 + e) * wsz;
            bf16* dst = wgu + (size_t)e * 1024 * 1024;
            LAS float* tl = (LAS float*)lds;
            const int tid = threadIdx.x;
            { const int n = tid & 63, kb = tid >> 6; const int f = MapGU()(nt * 64 + n); const float* s = (n & 32) ? up : g;
#pragma unroll
              for (int i = 0; i < 8; ++i) { const int k = kb + 8 * i; tl[k * 65 + n] = s[(size_t)(kt * 64 + k) * 512 + f]; } }
            __syncthreads();
            { const int n = tid >> 3, kc = tid & 7; float vv[8];
#pragma unroll
              for (int j = 0; j < 8; ++j) vv[j] = tl[(kc * 8 + j) * 65 + n];
              u32x4 o; o[0] = pk2(vv[0], vv[1]); o[1] = pk2(vv[2], vv[3]); o[2] = pk2(vv[4], vv[5]); o[3] = pk2(vv[6], vv[7]);
              *(u32x4*)(dst + (size_t)(nt * 64 + n) * 1024 + kt * 64 + kc * 8) = o; }
            __syncthreads();
        } else {
            const int w = u - total_gu, e = w / 128, v = w % 128, kt = v % 8, nt = v / 8;
            tconv_tile(in.moe_w_down + ((size_t)layer * 32 + e) * wsz, 1024, wd + (size_t)e * 1024 * 512, 512, kt * 64, nt * 64, MapId(), lds);
        }
    }
}

__device__ __forceinline__ void mod_vectors(const In& in, float* modv, LAS unsigned char* lds) {
    LAS float* sc = (LAS float*)lds;
    LAS float* red = sc + 5 * 1024;
    const int tid = threadIdx.x;
    for (int i = tid; i < 5 * 1024; i += NTHR) { const int r = i >> 10, k = i & 1023; const float v = r < 4 ? in.c[r * 1024 + k] : in.c_ctx[k]; sc[i] = siluf(v); }
    __syncthreads();
    const int col = tid & 31, kq = tid >> 5;
    for (int u = blockIdx.x; u < 2 * 192; u += gridDim.x) {
        const int layer = u / 192, c0 = (u % 192) * 32;
        const float* w = in.mod_w + (size_t)layer * 1024 * 6144 + c0 + col;
        float a0 = 0.f, a1 = 0.f, a2 = 0.f, a3 = 0.f, a4 = 0.f;
#pragma unroll 8
        for (int j = 0; j < 64; ++j) { const int k = kq + 16 * j; const float wv = w[(size_t)k * 6144];
            a0 += sc[k] * wv; a1 += sc[1024 + k] * wv; a2 += sc[2048 + k] * wv; a3 += sc[3072 + k] * wv; a4 += sc[4096 + k] * wv; }
        red[(0 * 16 + kq) * 32 + col] = a0; red[(1 * 16 + kq) * 32 + col] = a1; red[(2 * 16 + kq) * 32 + col] = a2;
        red[(3 * 16 + kq) * 32 + col] = a3; red[(4 * 16 + kq) * 32 + col] = a4;
        __syncthreads();
        if (tid < 160) { const int r = tid >> 5, cc = tid & 31; float s = 0.f;
#pragma unroll
            for (int q = 0; q < 16; ++q) s += red[(r * 16 + q) * 32 + cc];
            modv[((size_t)layer * 5 + r) * 6144 + c0 + cc] = s + in.mod_b[layer * 6144 + c0 + cc]; }
        __syncthreads();
    }
}

template <int NB, bool COMBINE, bool XOUT, bool NORM, bool ROUTER>
__device__ __forceinline__ void rows_phase(const float* xl, const float* xc, int nrows, const bf16* y2, const float* modc  , const float* modl  ,
                                           float* xout, float* out_final, const float* nw, int shift_i, int scale_i, bf16* hout,
                                           const float* wg, const float* bg, const float* we, const float* be, float* route_w, int* cnt, int* list, int cap,
                                           LAS unsigned char* lds) {
    constexpr int TL = NB * SEQ;
    const int tid = threadIdx.x, lane = tid & 63, wave = tid >> 6;
    LAS float* wt = (LAS float*)lds;
    LAS int* lcnt = (LAS int*)(lds + 36 * 1024 * 4); LAS int* lbase = lcnt + 32; LAS int* rinfo = lcnt + 64;
    if (ROUTER) {
        if (tid < 32) lcnt[tid] = 0;
        for (int i = tid; i < 4 * 1024; i += NTHR) wt[(i & 3) * 1024 + (i >> 2)] = wg[i];
        for (int i = tid; i < 32 * 1024; i += NTHR) wt[(4 + (i & 31)) * 1024 + (i >> 5)] = we[i];
        __syncthreads();
    }
    int lrow = wave;
    for (int row = blockIdx.x * NWAVE + wave; row < nrows; row += gridDim.x * NWAVE, lrow += NWAVE) {
        const float* src = row < TL ? xl + (size_t)row * D : xc + (size_t)(row - TL) * D;
        const float* mv = modl + (size_t)mod_row<NB>(row) * 6144;
        const float* mvc = modc + (size_t)mod_row<NB>(row) * 6144;
        f32x4 v[4];
#pragma unroll
        for (int i = 0; i < 4; ++i) v[i] = *(const f32x4*)(src + lane * 4 + 256 * i);
        if (COMBINE) {
#pragma unroll
            for (int i = 0; i < 4; ++i) { const int c = lane * 4 + 256 * i;
                const u32x2 ya = *(const u32x2*)(y2 + (size_t)(2 * row) * D + c), yb = *(const u32x2*)(y2 + (size_t)(2 * row + 1) * D + c);
                const f32x4 m5 = *(const f32x4*)(mvc + 5 * 1024 + c);
                v[i][0] += m5[0] * (bflo(ya[0]) + bflo(yb[0])); v[i][1] += m5[1] * (bfhi(ya[0]) + bfhi(yb[0]));
                v[i][2] += m5[2] * (bflo(ya[1]) + bflo(yb[1])); v[i][3] += m5[3] * (bfhi(ya[1]) + bfhi(yb[1])); }
            if (XOUT) {
#pragma unroll
                for (int i = 0; i < 4; ++i) *(f32x4*)(xout + (size_t)row * D + lane * 4 + 256 * i) = v[i]; }
            if (out_final) {
#pragma unroll
                for (int i = 0; i < 4; ++i) *(f32x4*)(out_final + (size_t)row * D + lane * 4 + 256 * i) = v[i]; }
        }
        if (NORM) {
            float ss = 0.f;
#pragma unroll
            for (int i = 0; i < 4; ++i) ss += v[i][0] * v[i][0] + v[i][1] * v[i][1] + v[i][2] * v[i][2] + v[i][3] * v[i][3];
            ss = wave_sum(ss);
            const float rs = rsqrtf(ss * (1.f / D) + 1e-6f);
            f32x4 hv[4];
#pragma unroll
            for (int i = 0; i < 4; ++i) { const int c = lane * 4 + 256 * i;
                const f32x4 w4 = *(const f32x4*)(nw + c), sc4 = *(const f32x4*)(mv + scale_i * 1024 + c), sh4 = *(const f32x4*)(mv + shift_i * 1024 + c);
#pragma unroll
                for (int j = 0; j < 4; ++j) hv[i][j] = v[i][j] * rs * w4[j] * (1.f + sc4[j]) + sh4[j];
                u32x2 o; o[0] = pk2(hv[i][0], hv[i][1]); o[1] = pk2(hv[i][2], hv[i][3]);
                *(u32x2*)(hout + (size_t)row * D + c) = o; }
            if (ROUTER) {
                float lg[4];
#pragma unroll
                for (int j = 0; j < 4; ++j) { float a = 0.f;
#pragma unroll
                    for (int i = 0; i < 4; ++i) { const f32x4 w4 = *(const LAS f32x4*)(wt + j * 1024 + lane * 4 + 256 * i);
                        a += hv[i][0] * w4[0] + hv[i][1] * w4[1] + hv[i][2] * w4[2] + hv[i][3] * w4[3]; }
                    lg[j] = wave_sum(a) + bg[j]; }
                int gi = 0; float gm = lg[0];
#pragma unroll
                for (int j = 1; j < 4; ++j) if (lg[j] > gm) { gm = lg[j]; gi = j; }
                float gs = 0.f;
#pragma unroll
                for (int j = 0; j < 4; ++j) gs += __expf(lg[j] - gm);
                const float gprob = 1.f / gs;
                float le[8];
#pragma unroll
                for (int j = 0; j < 8; ++j) { float a = 0.f; const LAS float* wr = wt + (4 + gi * 8 + j) * 1024 + lane * 4;
#pragma unroll
                    for (int i = 0; i < 4; ++i) { const f32x4 w4 = *(const LAS f32x4*)(wr + 256 * i);
                        a += hv[i][0] * w4[0] + hv[i][1] * w4[1] + hv[i][2] * w4[2] + hv[i][3] * w4[3]; }
                    le[j] = wave_sum(a) + be[gi * 8 + j]; }
                int e0 = 0; float m0 = le[0];
#pragma unroll
                for (int j = 1; j < 8; ++j) if (le[j] > m0) { m0 = le[j]; e0 = j; }
                int e1 = 0; float m1 = -3.0e38f;
#pragma unroll
                for (int j = 0; j < 8; ++j) if (j != e0 && le[j] > m1) { m1 = le[j]; e1 = j; }
                const float p1 = __expf(m1 - m0);
                if (lane == 0) {
                    const int ge0 = gi * 8 + e0, ge1 = gi * 8 + e1;
                    route_w[2 * row] = gprob / (1.f + p1); route_w[2 * row + 1] = gprob * p1 / (1.f + p1);
                    const int s0 = atomicAdd((int*)&lcnt[ge0], 1), s1 = atomicAdd((int*)&lcnt[ge1], 1);
                    rinfo[2 * lrow] = (ge0 << 16) | s0; rinfo[2 * lrow + 1] = (ge1 << 16) | s1;
                }
            }
        }
    }
    if (ROUTER) {
        __syncthreads();
        if (tid < 32) { const int c = lcnt[tid]; lbase[tid] = c ? atomicAdd(&cnt[tid * 64], c) : 0; }
        __syncthreads();
        int lrow = wave;
        for (int row = blockIdx.x * NWAVE + wave; row < nrows; row += gridDim.x * NWAVE, lrow += NWAVE) {
            if (lane < 2) { const int ri = rinfo[2 * lrow + lane], ge = ri >> 16, sl = ri & 0xffff; list[(size_t)ge * cap + lbase[ge] + sl] = 2 * row + lane; }
        }
        __syncthreads();
    }
}

constexpr int GEMM_STAGE = 256 * 128 + 128 * 128;
constexpr int GEMM_LDS = 3 * GEMM_STAGE;
__device__ __forceinline__ int sw_off(int row, int chunk) { return row * 128 + ((chunk ^ ((row >> 1) & 7)) << 4); }

template <class Epi>
__device__ __forceinline__ void gemm_tile(const bf16* const (&arow)[4], const bf16* bt  , int ldb, int K, LAS unsigned char* lds, Epi&& epi) {
    const int tid = threadIdx.x, lane = tid & 63, wave = tid >> 6, wm = wave >> 1, wn = wave & 1;
    const int r8 = tid >> 3;
    const int schunk = (lane & 7) ^ ((r8 >> 1) & 7);
    const bf16* ga[4]; const bf16* gb[2];
#pragma unroll
    for (int i = 0; i < 4; ++i) ga[i] = arow[i] + schunk * 8;
#pragma unroll
    for (int i = 0; i < 2; ++i) gb[i] = bt + (size_t)(r8 + 64 * i) * ldb + schunk * 8;
    f32x16 acc[2][2];
#pragma unroll
    for (int mi = 0; mi < 2; ++mi)
#pragma unroll
        for (int ni = 0; ni < 2; ++ni)
#pragma unroll
            for (int r = 0; r < 16; ++r) acc[mi][ni][r] = 0.f;
#define G_DMA(t, st) do { LAS unsigned char* sa_ = lds + (st) * GEMM_STAGE + wave * 1024 + lane * 16; \
    _Pragma("unroll") for (int i = 0; i < 4; ++i) __builtin_amdgcn_global_load_lds((const unsigned*)(ga[i] + (t) * 64), (LAS unsigned*)(sa_ + i * 8192), 16, 0, 0); \
    _Pragma("unroll") for (int i = 0; i < 2; ++i) __builtin_amdgcn_global_load_lds((const unsigned*)(gb[i] + (t) * 64), (LAS unsigned*)(sa_ + 256 * 128 + i * 8192), 16, 0, 0); } while (0)
    const int KT = K >> 6;
    G_DMA(0, 0);
    G_DMA(1, 1);
    asm volatile("s_waitcnt vmcnt(6)" ::: "memory");
    __builtin_amdgcn_s_barrier();
    asm volatile("" ::: "memory");
    int st = 0;
    for (int kt = 0; kt < KT; ++kt) {
        const int st2 = st >= 1 ? st - 1 : 2;
        if (kt + 2 < KT) G_DMA(kt + 2, st2);
        const LAS unsigned char* sa = lds + st * GEMM_STAGE; const LAS unsigned char* sb = sa + 256 * 128;
#pragma unroll
        for (int kk = 0; kk < 4; ++kk) {
            bf16x8 af[2], bfr[2];
#pragma unroll
            for (int mi = 0; mi < 2; ++mi) af[mi] = *(const LAS bf16x8*)(sa + sw_off(wm * 64 + mi * 32 + (lane & 31), 2 * kk + (lane >> 5)));
#pragma unroll
            for (int ni = 0; ni < 2; ++ni) bfr[ni] = *(const LAS bf16x8*)(sb + sw_off(wn * 64 + ni * 32 + (lane & 31), 2 * kk + (lane >> 5)));
#pragma unroll
            for (int mi = 0; mi < 2; ++mi)
#pragma unroll
                for (int ni = 0; ni < 2; ++ni) acc[mi][ni] = mfma32(bfr[ni], af[mi], acc[mi][ni]);
        }
        if (kt + 2 < KT) asm volatile("s_waitcnt vmcnt(6)" ::: "memory"); else asm volatile("s_waitcnt vmcnt(0)" ::: "memory");
        __builtin_amdgcn_s_barrier();
        asm volatile("" ::: "memory");
        st = st == 2 ? 0 : st + 1;
    }
#undef G_DMA
    epi(acc, wm, wn, lane);
}

template <int NB>
__device__ __forceinline__ void phase_inproj(const bf16* H, const bf16* Wt, bf16* PROJ, float* GATES, LAS unsigned char* lds) {
    constexpr int T = NB * (SEQ + CTXL), MT = T / 256, NT_ = NIN / 128;
    for (int u = blockIdx.x; u < MT * NT_; u += gridDim.x) {
        const int mt = u / NT_, nt = u % NT_;
        const bf16* arow[4];
#pragma unroll
        for (int i = 0; i < 4; ++i) arow[i] = H + (size_t)(mt * 256 + (threadIdx.x >> 3) + 64 * i) * D;
        gemm_tile(arow, Wt + (size_t)nt * 128 * D, D, D, lds, [&](const f32x16 (&acc)[2][2], int wm, int wn, int lane) {
#pragma unroll
            for (int mi = 0; mi < 2; ++mi) { const int row = mt * 256 + wm * 64 + mi * 32 + (lane & 31);
#pragma unroll
                for (int ni = 0; ni < 2; ++ni)
#pragma unroll
                    for (int g = 0; g < 4; ++g) { const int col = nt * 128 + wn * 64 + ni * 32 + 8 * g + 4 * (lane >> 5);
                        if (nt < NT_ - 1) { u32x2 o; o[0] = pk2(acc[mi][ni][4 * g], acc[mi][ni][4 * g + 1]); o[1] = pk2(acc[mi][ni][4 * g + 2], acc[mi][ni][4 * g + 3]);
                            *(u32x2*)(PROJ + (size_t)row * PROJW + col) = o; }
                        else if (wn == 0) { f32x4 o; o[0] = acc[mi][ni][4 * g]; o[1] = acc[mi][ni][4 * g + 1]; o[2] = acc[mi][ni][4 * g + 2]; o[3] = acc[mi][ni][4 * g + 3];
                            *(f32x4*)(GATES + (size_t)row * 64 + (col - PROJW)) = o; } } }
        });
    }
}

template <int NB>
__device__ __forceinline__ void phase_conv(const bf16* PROJ, const float* cw, const float* cb, bf16* XBC) {
    constexpr int TL = NB * SEQ, T = NB * (SEQ + CTXL);
    for (size_t it = (size_t)blockIdx.x * NTHR + threadIdx.x; it < (size_t)T * 192; it += (size_t)gridDim.x * NTHR) {
        const int row = (int)(it / 192), c0 = (int)(it % 192) * 8;
        int t, L;
        if (row < TL) { t = row % SEQ; L = SEQ; } else { t = (row - TL) % CTXL; L = CTXL; }
        const bf16* p = PROJ + (size_t)row * PROJW + PC_XBC + c0;
        const u32x4 cur = *(const u32x4*)p;
        u32x4 prv = {0u, 0u, 0u, 0u}, nxt = {0u, 0u, 0u, 0u};
        if (t > 0) prv = *(const u32x4*)(p - PROJW);
        if (t < L - 1) nxt = *(const u32x4*)(p + PROJW);
        float o[8];
#pragma unroll
        for (int j = 0; j < 4; ++j) {
            const int c = c0 + 2 * j;
            o[2 * j] = bflo(prv[j]) * cw[c] + bflo(cur[j]) * cw[1536 + c] + bflo(nxt[j]) * cw[3072 + c] + cb[c];
            o[2 * j + 1] = bfhi(prv[j]) * cw[c + 1] + bfhi(cur[j]) * cw[1536 + c + 1] + bfhi(nxt[j]) * cw[3072 + c + 1] + cb[c + 1];
        }
        u32x4 r; r[0] = pk2(siluf(o[0]), siluf(o[1])); r[1] = pk2(siluf(o[2]), siluf(o[3])); r[2] = pk2(siluf(o[4]), siluf(o[5])); r[3] = pk2(siluf(o[6]), siluf(o[7]));
        *(u32x4*)(XBC + (size_t)row * 1536 + c0) = r;
    }
}
}
namespace fx {
constexpr int RS_X = 144, RS_N = 272;

template <int NB> __device__ __forceinline__ int scan_row(int b, int d, int step) {
    if (step < CTXL) return NB * SEQ + b * CTXL + (d ? CTXL - 1 - step : step);
    step -= CTXL; return b * SEQ + (d ? SEQ - 1 - step : step);
}
__device__ __forceinline__ bf16x8 scale_frag(bf16x8 v, f32x4 w0, f32x4 w1) {
    const u32x4 u = __builtin_bit_cast(u32x4, v);
    u32x4 o;
    o[0] = pk2(bflo(u[0]) * w0[0], bfhi(u[0]) * w0[1]); o[1] = pk2(bflo(u[1]) * w0[2], bfhi(u[1]) * w0[3]);
    o[2] = pk2(bflo(u[2]) * w1[0], bfhi(u[2]) * w1[1]); o[3] = pk2(bflo(u[3]) * w1[2], bfhi(u[3]) * w1[3]);
    return __builtin_bit_cast(bf16x8, o);
}

template <int NB>
__device__ __forceinline__ void ssd_item(const bf16* XBC, const float* GATES, const float* a_log, const float* dt_bias, bf16* SCb,
                                         int b, int d, int h, LAS unsigned char* lds) {
    const int tid = threadIdx.x, lane = tid & 63, wave = tid >> 6, g = h >> 3;
    LAS unsigned char* Xs = lds; LAS unsigned char* Bs = lds + 18432; LAS unsigned char* Cs = lds + 53248;
    LAS unsigned char* Ss = lds + 88064; LAS unsigned char* Ms = lds + 105472;
    LAS float* acs = (LAS float*)(lds + 140288); LAS float* dtv = acs + 128; LAS float* wv = acs + 256;
    const float a = -__expf(a_log[d * 16 + h]), dtb = dt_bias[d * 16 + h];
    f32x16 st;
#pragma unroll
    for (int r = 0; r < 16; ++r) st[r] = 0.f;
    constexpr int NCH = (CTXL + SEQ) / 128;
    u32x4 rx[2], rb[4], rc[4]; float rg0 = 0.f, rg1 = 0.f;
#define SSD_LOAD(ch) do { \
    _Pragma("unroll") for (int i = 0; i < 2; ++i) { const int idx = tid + 512 * i, l = idx >> 3, c = idx & 7; \
        rx[i] = *(const u32x4*)(XBC + (size_t)scan_row<NB>(b, d, (ch) * 128 + l) * 1536 + h * 64 + c * 8); } \
    _Pragma("unroll") for (int i = 0; i < 4; ++i) { const int idx = tid + 512 * i, l = idx >> 4, c = idx & 15; \
        const bf16* rp = XBC + (size_t)scan_row<NB>(b, d, (ch) * 128 + l) * 1536 + 1024 + g * 128 + c * 8; \
        rb[i] = *(const u32x4*)rp; rc[i] = *(const u32x4*)(rp + 256); } \
    if (wave == 0) { rg0 = GATES[(size_t)scan_row<NB>(b, d, (ch) * 128 + lane) * 64 + d * 16 + h]; \
                     rg1 = GATES[(size_t)scan_row<NB>(b, d, (ch) * 128 + 64 + lane) * 64 + d * 16 + h]; } } while (0)
    SSD_LOAD(0);
    const int pbw = wave >> 2, nbw = wave & 3;
    for (int ch = 0; ch < NCH; ++ch) {
#pragma unroll
        for (int i = 0; i < 2; ++i) { const int idx = tid + 512 * i, l = idx >> 3, c = idx & 7; *(LAS u32x4*)(Xs + l * RS_X + c * 16) = rx[i]; }
#pragma unroll
        for (int i = 0; i < 4; ++i) { const int idx = tid + 512 * i, l = idx >> 4, c = idx & 15;
            *(LAS u32x4*)(Bs + l * RS_N + c * 16) = rb[i]; *(LAS u32x4*)(Cs + l * RS_N + c * 16) = rc[i]; }
        if (wave == 0) {
            const float dt0 = softplusf(rg0 + dtb), dt1 = softplusf(rg1 + dtb);
            float v0 = dt0 * a, v1 = dt1 * a;
#pragma unroll
            for (int o = 1; o < 64; o <<= 1) { const float t0 = __shfl_up(v0, o), t1 = __shfl_up(v1, o); if (lane >= o) { v0 += t0; v1 += t1; } }
            v1 += __shfl(v0, 63);
            const float tot = __shfl(v1, 63);
            acs[lane] = v0; acs[64 + lane] = v1; dtv[lane] = dt0; dtv[64 + lane] = dt1;
            wv[lane] = dt0 * __expf(tot - v0); wv[64 + lane] = dt1 * __expf(tot - v1);
        }
        {
            const int pp = 32 * pbw + (lane & 31);
#pragma unroll
            for (int gq = 0; gq < 4; ++gq) { u32x2 o; o[0] = pk2(st[4 * gq], st[4 * gq + 1]); o[1] = pk2(st[4 * gq + 2], st[4 * gq + 3]);
                *(LAS u32x2*)(Ss + pp * RS_N + (32 * nbw + 8 * gq + 4 * (lane >> 5)) * 2) = o; }
        }
        __syncthreads();
        {
            const int lbA = wave >> 1, sbp = wave & 1;
            const int l = 32 * lbA + (lane & 31);
            const float al = acs[l];
#pragma unroll
            for (int q = 0; q < 2; ++q) { const int sb = 2 * sbp + q;
                if (sb <= lbA) {
                    f32x16 cb;
#pragma unroll
                    for (int r = 0; r < 16; ++r) cb[r] = 0.f;
#pragma unroll
                    for (int kk = 0; kk < 8; ++kk) cb = mfma32(frag_row(Bs, RS_N, 32 * sb, 16 * kk, lane), frag_row(Cs, RS_N, 32 * lbA, 16 * kk, lane), cb);
#pragma unroll
                    for (int gq = 0; gq < 4; ++gq) { const int s0 = 32 * sb + 8 * gq + 4 * (lane >> 5);
                        const f32x4 as4 = *(const LAS f32x4*)(acs + s0), dt4 = *(const LAS f32x4*)(dtv + s0);
                        float m[4];
#pragma unroll
                        for (int j = 0; j < 4; ++j) m[j] = (s0 + j <= l) ? cb[4 * gq + j] * __expf(fminf(al - as4[j], 0.f)) * dt4[j] : 0.f;
                        u32x2 o; o[0] = pk2(m[0], m[1]); o[1] = pk2(m[2], m[3]);
                        *(LAS u32x2*)(Ms + l * RS_N + s0 * 2) = o; } } }
        }
        {
            const float dec = __expf(acs[127]);
#pragma unroll
            for (int r = 0; r < 16; ++r) st[r] *= dec;
#pragma unroll
            for (int kk = 0; kk < 8; ++kk) {
                const int l0 = 16 * kk + 8 * (lane >> 5);
                const f32x4 w0 = *(const LAS f32x4*)(wv + l0), w1 = *(const LAS f32x4*)(wv + l0 + 4);
                const bf16x8 xa = scale_frag(frag_col(Xs, RS_X, 16 * kk, 32 * pbw, lane), w0, w1);
                st = mfma32(frag_col(Bs, RS_N, 16 * kk, 32 * nbw, lane), xa, st);
            }
        }
        __syncthreads();
        if (ch + 1 < NCH) SSD_LOAD(ch + 1);
        {
            const int pb = wave >> 2, lb = wave & 3;
            f32x16 acc;
#pragma unroll
            for (int r = 0; r < 16; ++r) acc[r] = 0.f;
#pragma unroll
            for (int kk = 0; kk < 8; ++kk) acc = mfma32(frag_row(Ss, RS_N, 32 * pb, 16 * kk, lane), frag_row(Cs, RS_N, 32 * lb, 16 * kk, lane), acc);
            const int l = 32 * lb + (lane & 31);
            const float ea = __expf(acs[l]);
#pragma unroll
            for (int r = 0; r < 16; ++r) acc[r] *= ea;
            for (int sb = 0; sb <= lb; ++sb) {
#pragma unroll
                for (int k2 = 0; k2 < 2; ++k2) acc = mfma32(frag_col(Xs, RS_X, 32 * sb + 16 * k2, 32 * pb, lane), frag_row(Ms, RS_N, 32 * lb, 32 * sb + 16 * k2, lane), acc);
            }
            bf16* yp = SCb + (size_t)scan_row<NB>(b, d, ch * 128 + l) * 4096 + d * 1024 + h * 64 + 32 * pb + 4 * (lane >> 5);
#pragma unroll
            for (int gq = 0; gq < 4; ++gq) { u32x2 o; o[0] = pk2(acc[4 * gq], acc[4 * gq + 1]); o[1] = pk2(acc[4 * gq + 2], acc[4 * gq + 3]); *(u32x2*)(yp + 8 * gq) = o; }
        }
        __syncthreads();
    }
#undef SSD_LOAD
}

template <int NB>
__device__ __forceinline__ void mlstm_item(const bf16* PROJ, const float* GATES, const float* i_bias, const float* f_bias, bf16* SCb,
                                           int b, int d, int hh, int ev, LAS unsigned char* lds) {
    const int tid = threadIdx.x, lane = tid & 63, wave = tid >> 6;
    LAS unsigned char* Qs = lds; LAS unsigned char* Ks = lds + 17408; LAS unsigned char* Vs = lds + 34816;
    LAS unsigned char* Ct = lds + 44032; LAS unsigned char* Sm = lds + 61440;
    LAS float* tb = (LAS float*)(lds + 70656);
    LAS float* t_li = tb, *t_bc = tb + 128, *t_mt = tb + 192, *t_wi = tb + 256, *t_we = tb + 320, *t_qn = tb + 384, *t_rs = tb + 448  ,
              *t_n = tb + 544  , *t_sc = tb + 672  ;
    const float ib = i_bias[d * 4 + hh], fb = f_bias[d * 4 + hh];
    const float kscale = 0.08838834764831845f;
    f32x16 st;
#pragma unroll
    for (int r = 0; r < 16; ++r) st[r] = 0.f;
    if (tid < 128) t_n[tid] = 0.f;
    float m_run = 0.f;
    constexpr int NCH = (CTXL + SEQ) / 64;
    const int kbw = wave & 3, ebw = wave >> 2;
    u32x4 rq[2], rk[2], rv; float rgi = 0.f, rgf = 0.f;
#define ML_LOAD(ch) do { \
    _Pragma("unroll") for (int i = 0; i < 2; ++i) { const int idx = tid + 512 * i, l = idx >> 4, c = idx & 15; \
        const bf16* rp = PROJ + (size_t)scan_row<NB>(b, d, (ch) * 64 + l) * PROJW + hh * 128 + c * 8; \
        rq[i] = *(const u32x4*)(rp + PC_Q); rk[i] = *(const u32x4*)(rp + PC_K); } \
    { const int l = tid >> 3, c = tid & 7; rv = *(const u32x4*)(PROJ + (size_t)scan_row<NB>(b, d, (ch) * 64 + l) * PROJW + PC_V + hh * 256 + ev * 64 + c * 8); } \
    if (wave == 0) { const float* gp = GATES + (size_t)scan_row<NB>(b, d, (ch) * 64 + lane) * 64; rgi = gp[32 + d * 4 + hh]; rgf = gp[40 + d * 4 + hh]; } } while (0)
    ML_LOAD(0);
    for (int ch = 0; ch < NCH; ++ch) {
#pragma unroll
        for (int i = 0; i < 2; ++i) { const int idx = tid + 512 * i, l = idx >> 4, c = idx & 15;
            *(LAS u32x4*)(Qs + l * RS_N + c * 16) = rq[i]; *(LAS u32x4*)(Ks + l * RS_N + c * 16) = rk[i]; }
        { const int l = tid >> 3, c = tid & 7; *(LAS u32x4*)(Vs + l * RS_X + c * 16) = rv; }
        if (wave == 0) {
            const float li = rgi + ib, lf = logsigf(rgf + fb);
            float bc = lf;
#pragma unroll
            for (int o = 1; o < 64; o <<= 1) { const float t = __shfl_up(bc, o); if (lane >= o) bc += t; }
            float pm = li - bc;
#pragma unroll
            for (int o = 1; o < 64; o <<= 1) { const float t = __shfl_up(pm, o); if (lane >= o) pm = fmaxf(pm, t); }
            const float m_intra = bc + pm;
            const float gtot = __shfl(bc, 63);
            const float a_end = gtot - bc + li;
            const float m_loc = wave_max(a_end);
            const float m_inter = bc + m_run;
            const float mt = fmaxf(m_intra, m_inter);
            t_li[lane] = li; t_bc[lane] = bc; t_mt[lane] = mt; t_wi[lane] = __expf(m_inter - mt); t_we[lane] = __expf(a_end - m_loc);
            if (lane == 0) { t_sc[0] = gtot; t_sc[1] = m_loc; }
        }
        {
            const int ee = 32 * ebw + (lane & 31);
#pragma unroll
            for (int gq = 0; gq < 4; ++gq) { u32x2 o; o[0] = pk2(st[4 * gq], st[4 * gq + 1]); o[1] = pk2(st[4 * gq + 2], st[4 * gq + 3]);
                *(LAS u32x2*)(Ct + ee * RS_N + (32 * kbw + 8 * gq + 4 * (lane >> 5)) * 2) = o; }
        }
        __syncthreads();
        const float gtot = t_sc[0], m_loc = t_sc[1];
        const float m_new = fmaxf(gtot + m_run, m_loc);
        const float a_s = __expf(gtot + m_run - m_new), bbs = __expf(m_loc - m_new);
        f32x16 acc;
#pragma unroll
        for (int r = 0; r < 16; ++r) acc[r] = 0.f;
        int ebB = 0, lbB = 0;
        if (wave < 3) {
            const int sbA = wave == 2 ? 1 : 0, lbA = wave == 0 ? 0 : 1;
#pragma unroll
            for (int kk = 0; kk < 8; ++kk) acc = mfma32(frag_row(Ks, RS_N, 32 * sbA, 16 * kk, lane), frag_row(Qs, RS_N, 32 * lbA, 16 * kk, lane), acc);
            const int l = 32 * lbA + (lane & 31);
            const float bl = t_bc[l], mtl = t_mt[l];
            float rsum = 0.f;
#pragma unroll
            for (int gq = 0; gq < 4; ++gq) { const int s0 = 32 * sbA + 8 * gq + 4 * (lane >> 5);
                const f32x4 bs4 = *(const LAS f32x4*)(t_bc + s0), li4 = *(const LAS f32x4*)(t_li + s0);
                float m[4];
#pragma unroll
                for (int j = 0; j < 4; ++j) { m[j] = (s0 + j <= l) ? acc[4 * gq + j] * kscale * __expf(fminf(bl - bs4[j] + li4[j] - mtl, 0.f)) : 0.f; rsum += m[j]; }
                u32x2 o; o[0] = pk2(m[0], m[1]); o[1] = pk2(m[2], m[3]);
                *(LAS u32x2*)(Sm + l * RS_X + s0 * 2) = o; }
            rsum += __shfl_xor(rsum, 32);
            if (lane < 32) t_rs[wave * 32 + lane] = rsum;
        } else if (wave == 3) {
            float qn = 0.f;
#pragma unroll 4
            for (int c = 0; c < 16; ++c) { const u32x4 qv = *(const LAS u32x4*)(Qs + lane * RS_N + c * 16);
                const f32x4 n0 = *(const LAS f32x4*)(t_n + c * 8), n1 = *(const LAS f32x4*)(t_n + c * 8 + 4);
                qn += bflo(qv[0]) * n0[0] + bfhi(qv[0]) * n0[1] + bflo(qv[1]) * n0[2] + bfhi(qv[1]) * n0[3]
                    + bflo(qv[2]) * n1[0] + bfhi(qv[2]) * n1[1] + bflo(qv[3]) * n1[2] + bfhi(qv[3]) * n1[3]; }
            t_qn[lane] = qn;
        } else {
            ebB = (wave - 4) >> 1; lbB = (wave - 4) & 1;
#pragma unroll
            for (int kk = 0; kk < 8; ++kk) acc = mfma32(frag_row(Ct, RS_N, 32 * ebB, 16 * kk, lane), frag_row(Qs, RS_N, 32 * lbB, 16 * kk, lane), acc);
            const float wi = t_wi[32 * lbB + (lane & 31)];
#pragma unroll
            for (int r = 0; r < 16; ++r) acc[r] *= wi;
        }
        {
#pragma unroll
            for (int r = 0; r < 16; ++r) st[r] *= a_s;
            const float f = bbs * kscale;
#pragma unroll
            for (int kk = 0; kk < 4; ++kk) {
                const int l0 = 16 * kk + 8 * (lane >> 5);
                f32x4 w0 = *(const LAS f32x4*)(t_we + l0), w1 = *(const LAS f32x4*)(t_we + l0 + 4);
#pragma unroll
                for (int j = 0; j < 4; ++j) { w0[j] *= f; w1[j] *= f; }
                const bf16x8 ka = scale_frag(frag_col(Ks, RS_N, 16 * kk, 32 * kbw, lane), w0, w1);
                st = mfma32(ka, frag_col(Vs, RS_X, 16 * kk, 32 * ebw, lane), st);
            }
        }
        float n_new = 0.f;
        if (tid < 128) {
            float s = 0.f;
#pragma unroll 8
            for (int l = 0; l < 64; ++l) s += t_we[l] * bf2f(*(const LAS bf16*)(Ks + l * RS_N + tid * 2));
            n_new = a_s * t_n[tid] + bbs * kscale * s;
        }
        __syncthreads();
        if (tid < 128) t_n[tid] = n_new;
        if (ch + 1 < NCH) ML_LOAD(ch + 1);
        if (wave >= 4) {
            for (int sb = 0; sb <= lbB; ++sb) {
#pragma unroll
                for (int k2 = 0; k2 < 2; ++k2) acc = mfma32(frag_col(Vs, RS_X, 32 * sb + 16 * k2, 32 * ebB, lane), frag_row(Sm, RS_X, 32 * lbB, 32 * sb + 16 * k2, lane), acc);
            }
            const int l = 32 * lbB + (lane & 31), lr = lane & 31;
            const float rsum = lbB == 0 ? t_rs[lr] : t_rs[32 + lr] + t_rs[64 + lr];
            float den = rsum + t_qn[l] * t_wi[l];
            den = fmaxf(fabsf(den), __expf(-t_mt[l]));
            const float inv = 1.f / den;
            bf16* hp = SCb + (size_t)scan_row<NB>(b, d, ch * 64 + l) * 4096 + 2048 + d * 1024 + hh * 256 + ev * 64 + 32 * ebB + 4 * (lane >> 5);
#pragma unroll
            for (int gq = 0; gq < 4; ++gq) { u32x2 o; o[0] = pk2(acc[4 * gq] * inv, acc[4 * gq + 1] * inv); o[1] = pk2(acc[4 * gq + 2] * inv, acc[4 * gq + 3] * inv); *(u32x2*)(hp + 8 * gq) = o; }
        }
        m_run = m_new;
        __syncthreads();
    }
#undef ML_LOAD
}

template <int NB>
__device__ __forceinline__ void phase_scan(const In& in, const bf16* PROJ, const float* GATES, const bf16* XBC, bf16* SCb, LAS unsigned char* lds) {
    const int G = gridDim.x;
    for (int item = blockIdx.x; item < NB * 32; item += G) { const int b = item / 32, d = (item >> 4) & 1, h = item & 15;
        ssd_item<NB>(XBC, GATES, in.ssd_a_log, in.ssd_dt_bias, SCb, b, d, h, lds); }
    const int v = (blockIdx.x + G - (NB * 32) % G) % G;
    for (int it = v; it < NB * 32; it += G) { const int b = it / 32, d = (it >> 4) & 1, hh = (it >> 2) & 3, ev = it & 3;
        mlstm_item<NB>(PROJ, GATES, in.ml_i_bias, in.ml_f_bias, SCb, b, d, hh, ev, lds); }
}

template <int NB>
__device__ __forceinline__ void phase_mixer_out(const In& in, const bf16* PROJ, const bf16* XBC, bf16* SCb) {
    constexpr int T = NB * (SEQ + CTXL);
    const int lane = threadIdx.x & 63, wave = threadIdx.x >> 6;
    for (int row = blockIdx.x * NWAVE + wave; row < T; row += gridDim.x * NWAVE) {
        bf16* sc = SCb + (size_t)row * 4096;
        const bf16* pr = PROJ + (size_t)row * PROJW;
        float yv[16], hv[16], ss = 0.f, hs[2] = {0.f, 0.f};
#pragma unroll
        for (int i = 0; i < 2; ++i) { const int c = lane * 8 + 512 * i;
            const u32x4 y0 = *(const u32x4*)(sc + c), y1 = *(const u32x4*)(sc + 1024 + c), h0 = *(const u32x4*)(sc + 2048 + c), h1 = *(const u32x4*)(sc + 3072 + c);
            const u32x4 xs = *(const u32x4*)(XBC + (size_t)row * 1536 + c), z = *(const u32x4*)(pr + PC_Z + c);
            const float dk = in.ssd_d[c >> 6];
#pragma unroll
            for (int j = 0; j < 4; ++j) {
                float a0 = bflo(y0[j]) + bflo(y1[j]) + dk * bflo(xs[j]), a1 = bfhi(y0[j]) + bfhi(y1[j]) + dk * bfhi(xs[j]);
                a0 *= siluf(bflo(z[j])); a1 *= siluf(bfhi(z[j]));
                yv[8 * i + 2 * j] = a0; yv[8 * i + 2 * j + 1] = a1; ss += a0 * a0 + a1 * a1;
                const float b0 = bflo(h0[j]) + bflo(h1[j]), b1 = bfhi(h0[j]) + bfhi(h1[j]);
                hv[8 * i + 2 * j] = b0; hv[8 * i + 2 * j + 1] = b1; hs[i] += b0 * b0 + b1 * b1; } }
        ss = wave_sum(ss);
        const float rs = rsqrtf(ss * (1.f / 1024.f) + 1e-6f);
#pragma unroll
        for (int i = 0; i < 2; ++i) {
#pragma unroll
            for (int o = 16; o > 0; o >>= 1) hs[i] += __shfl_xor(hs[i], o);
            hs[i] = rsqrtf(hs[i] * (1.f / 256.f) + 1e-6f); }
        __builtin_amdgcn_s_waitcnt(0);
#pragma unroll
        for (int i = 0; i < 2; ++i) { const int c = lane * 8 + 512 * i;
            const u32x4 ov = *(const u32x4*)(pr + PC_O + c);
            u32x4 oy, oh;
#pragma unroll
            for (int j = 0; j < 4; ++j) {
                oy[j] = pk2(yv[8 * i + 2 * j] * rs * in.ssd_norm_w[c + 2 * j], yv[8 * i + 2 * j + 1] * rs * in.ssd_norm_w[c + 2 * j + 1]);
                oh[j] = pk2(hv[8 * i + 2 * j] * hs[i] * in.ml_norm_w[c + 2 * j] * sigmf(bflo(ov[j])), hv[8 * i + 2 * j + 1] * hs[i] * in.ml_norm_w[c + 2 * j + 1] * sigmf(bfhi(ov[j]))); }
            *(u32x4*)(sc + c) = oy; *(u32x4*)(sc + 1024 + c) = oh; }
    }
}

template <int NB>
__device__ __forceinline__ void phase_outproj(const bf16* A, int lda, int K, const bf16* Wt, int nrows, const float* xl, const float* xc, const float* modl, float* Xout,
                                              LAS unsigned char* lds) {
    constexpr int TL = NB * SEQ;
    const int MT = nrows / 256;
    for (int u = blockIdx.x; u < MT * 8; u += gridDim.x) {
        const int mt = u / 8, nt = u % 8;
        const bf16* arow[4];
#pragma unroll
        for (int i = 0; i < 4; ++i) arow[i] = A + (size_t)(mt * 256 + (threadIdx.x >> 3) + 64 * i) * lda;
        gemm_tile(arow, Wt + (size_t)nt * 128 * K, K, K, lds, [&](const f32x16 (&acc)[2][2], int wm, int wn, int lane) {
            const float* mv = modl + (size_t)mod_row<NB>(mt * 256) * 6144 + 2 * 1024;
#pragma unroll
            for (int mi = 0; mi < 2; ++mi) { const int row = mt * 256 + wm * 64 + mi * 32 + (lane & 31);
                const float* src = row < TL ? xl + (size_t)row * D : xc + (size_t)(row - TL) * D;
#pragma unroll
                for (int ni = 0; ni < 2; ++ni)
#pragma unroll
                    for (int g = 0; g < 4; ++g) { const int col = nt * 128 + wn * 64 + ni * 32 + 8 * g + 4 * (lane >> 5);
                        const f32x4 xv = *(const f32x4*)(src + col), m2 = *(const f32x4*)(mv + col);
                        f32x4 o;
#pragma unroll
                        for (int j = 0; j < 4; ++j) o[j] = xv[j] + m2[j] * acc[mi][ni][4 * g + j];
                        *(f32x4*)(Xout + (size_t)row * D + col) = o; } }
        });
    }
}
}
namespace fx {
__device__ __forceinline__ int moe_prefix(const int* cnt, LAS int* pre  ) {
    __syncthreads();
    if (threadIdx.x < 64) {
        const int lane = threadIdx.x;
        int v = lane < 32 ? (cnt[lane * 64] + 255) >> 8 : 0;
#pragma unroll
        for (int o = 1; o < 32; o <<= 1) { const int t = __shfl_up(v, o); if (lane >= o) v += t; }
        if (lane < 32) pre[lane + 1] = v;
        if (lane == 0) pre[0] = 0;
    }
    __syncthreads();
    return pre[32];
}
__device__ __forceinline__ int moe_find(const LAS int* pre, int t) { int e = 0;
#pragma unroll
    for (int i = 1; i < 32; ++i) e += (t >= pre[i]) ? 1 : 0;
    return e; }

__device__ __forceinline__ void phase_moe_up(const bf16* H2, const bf16* Wgu, const int* cnt, const int* list, int cap, const float* route_w, bf16* ACT, LAS unsigned char* lds) {
    LAS int* pre = (LAS int*)(lds + GEMM_LDS);
    const int ntile = moe_prefix(cnt, pre);
    for (int u = blockIdx.x; u < ntile * 8; u += gridDim.x) {
        const int t = u >> 3, nt = u & 7, e = moe_find(pre, t), mt = t - pre[e], ce = cnt[e * 64];
        const int* le = list + (size_t)e * cap + mt * 256;
        const int nvalid = ce - mt * 256;
        const bf16* arow[4];
#pragma unroll
        for (int i = 0; i < 4; ++i) { const int r = (threadIdx.x >> 3) + 64 * i; const int ent = le[r < nvalid ? r : 0]; arow[i] = H2 + (size_t)(ent >> 1) * D; }
        gemm_tile(arow, Wgu + (size_t)e * 1024 * 1024 + (size_t)nt * 128 * 1024, 1024, 1024, lds, [&](const f32x16 (&acc)[2][2], int wm, int wn, int lane) {
#pragma unroll
            for (int mi = 0; mi < 2; ++mi) { const int r = wm * 64 + mi * 32 + (lane & 31);
                if (r < nvalid) { const int ent = le[r]; const float w = route_w[ent];
                    bf16* op = ACT + (size_t)ent * 512 + nt * 64 + wn * 32 + 4 * (lane >> 5);
#pragma unroll
                    for (int g = 0; g < 4; ++g) { float v[4];
#pragma unroll
                        for (int j = 0; j < 4; ++j) v[j] = siluf(acc[mi][0][4 * g + j]) * acc[mi][1][4 * g + j] * w;
                        u32x2 o; o[0] = pk2(v[0], v[1]); o[1] = pk2(v[2], v[3]); *(u32x2*)(op + 8 * g) = o; } } }
        });
    }
}
__device__ __forceinline__ void phase_moe_down(const bf16* ACT, const bf16* Wd, const int* cnt, const int* list, int cap, bf16* Y2, LAS unsigned char* lds) {
    LAS int* pre = (LAS int*)(lds + GEMM_LDS);
    const int ntile = moe_prefix(cnt, pre);
    for (int u = blockIdx.x; u < ntile * 8; u += gridDim.x) {
        const int t = u >> 3, nt = u & 7, e = moe_find(pre, t), mt = t - pre[e], ce = cnt[e * 64];
        const int* le = list + (size_t)e * cap + mt * 256;
        const int nvalid = ce - mt * 256;
        const bf16* arow[4];
#pragma unroll
        for (int i = 0; i < 4; ++i) { const int r = (threadIdx.x >> 3) + 64 * i; const int ent = le[r < nvalid ? r : 0]; arow[i] = ACT + (size_t)ent * 512; }
        gemm_tile(arow, Wd + (size_t)e * 1024 * 512 + (size_t)nt * 128 * 512, 512, 512, lds, [&](const f32x16 (&acc)[2][2], int wm, int wn, int lane) {
#pragma unroll
            for (int mi = 0; mi < 2; ++mi) { const int r = wm * 64 + mi * 32 + (lane & 31);
                if (r < nvalid) { const int ent = le[r];
                    bf16* op = Y2 + (size_t)ent * D + nt * 128 + wn * 64 + 4 * (lane >> 5);
#pragma unroll
                    for (int ni = 0; ni < 2; ++ni)
#pragma unroll
                        for (int g = 0; g < 4; ++g) { u32x2 o; o[0] = pk2(acc[mi][ni][4 * g], acc[mi][ni][4 * g + 1]); o[1] = pk2(acc[mi][ni][4 * g + 2], acc[mi][ni][4 * g + 3]);
                            *(u32x2*)(op + ni * 32 + 8 * g) = o; } } }
        });
    }
}

template <int NB>
__device__ __forceinline__ void phase_qkv(const bf16* H, const bf16* Wt, const float* qn, const float* kn, bf16* QKV, LAS unsigned char* lds) {
    constexpr int T = NB * (SEQ + CTXL), MT = T / 256;
    for (int u = blockIdx.x; u < MT * 24; u += gridDim.x) {
        const int mt = u / 24, nt = u % 24;
        const bf16* arow[4];
#pragma unroll
        for (int i = 0; i < 4; ++i) arow[i] = H + (size_t)(mt * 256 + (threadIdx.x >> 3) + 64 * i) * D;
        gemm_tile(arow, Wt + (size_t)nt * 128 * D, D, D, lds, [&](const f32x16 (&acc)[2][2], int wm, int wn, int lane) {
            const int which = nt >> 3;
#pragma unroll
            for (int mi = 0; mi < 2; ++mi) { const int row = mt * 256 + wm * 64 + mi * 32 + (lane & 31);
                float rs = 1.f;
                if (which < 2) { float ss = 0.f;
#pragma unroll
                    for (int ni = 0; ni < 2; ++ni)
#pragma unroll
                        for (int r = 0; r < 16; ++r) ss += acc[mi][ni][r] * acc[mi][ni][r];
                    ss += __shfl_xor(ss, 32);
                    rs = rsqrtf(ss * (1.f / 64.f) + 1e-6f) * (which == 0 ? 0.125f : 1.f); }
                const float* nwp = which == 0 ? qn : kn;
                bf16* op = QKV + (size_t)row * 3072 + nt * 128 + wn * 64 + 4 * (lane >> 5);
#pragma unroll
                for (int ni = 0; ni < 2; ++ni)
#pragma unroll
                    for (int g = 0; g < 4; ++g) { float v[4];
#pragma unroll
                        for (int j = 0; j < 4; ++j) { v[j] = acc[mi][ni][4 * g + j]; if (which < 2) v[j] *= rs * nwp[ni * 32 + 8 * g + 4 * (lane >> 5) + j]; }
                        u32x2 o; o[0] = pk2(v[0], v[1]); o[1] = pk2(v[2], v[3]); *(u32x2*)(op + ni * 32 + 8 * g) = o; } }
        });
    }
}

__device__ __forceinline__ bf16x8 frag16_row(const LAS unsigned char* T, int RS, int r0, int c0, int lane) {
    return *(const LAS bf16x8*)(T + (r0 + (lane & 15)) * RS + (c0 + 8 * (lane >> 4)) * 2);
}
__device__ __forceinline__ bf16x8 frag16_vt(const LAS unsigned char* T, int RS, int kb, int c0, int lane) {
    const int g4 = lane >> 4, q = (lane & 15) >> 2, p = lane & 3;
    const unsigned a0 = (unsigned)(size_t)(T + (kb + 4 * g4 + q) * RS + (c0 + 4 * p) * 2);
    const unsigned a1 = a0 + 16 * RS;
    bf16x4 v0, v1;
    asm volatile("ds_read_b64_tr_b16 %0, %2\n\tds_read_b64_tr_b16 %1, %3\n\ts_waitcnt lgkmcnt(0)" : "=&v"(v0), "=&v"(v1) : "v"(a0), "v"(a1) : "memory");
    bf16x8 r; r[0] = v0[0]; r[1] = v0[1]; r[2] = v0[2]; r[3] = v0[3]; r[4] = v1[0]; r[5] = v1[1]; r[6] = v1[2]; r[7] = v1[3];
    return r;
}

template <int NB>
__device__ __forceinline__ void phase_attn(const bf16* QKV, const float* rpb, bf16* AO, LAS unsigned char* lds) {
    constexpr int TL = NB * SEQ;
    constexpr int TILE = 64 * RS_N;
    const int tid = threadIdx.x, lane = tid & 63, wave = tid >> 6, w = wave & 3, hsel = wave >> 2;
    const int qi = lane & 15, g4 = lane >> 4;
    LAS float* rp = (LAS float*)(lds + 4 * TILE);
    for (int u = blockIdx.x; u < NB * 64 * 8; u += gridDim.x) {
        const int hp = u & 7, r = (u >> 3) & 63, b = u >> 9;
        const int head = 2 * hp + hsel;
        int r0 = r - 4; r0 = r0 < 0 ? 0 : (r0 > 56 ? 56 : r0);
        __syncthreads();
        for (int i = tid; i < 2 * 465; i += NTHR) rp[i] = rpb[(size_t)(2 * hp) * 465 + i];
        const int c = 16 * w + qi;
        const size_t qrow = (size_t)b * SEQ + r * 64 + c;
        const bf16x8 q0 = *(const bf16x8*)(QKV + qrow * 3072 + head * 64 + 8 * g4), q1 = *(const bf16x8*)(QKV + qrow * 3072 + head * 64 + 32 + 8 * g4);
        int cs = c - 8; cs = cs < 0 ? 0 : (cs > 48 ? 48 : cs);
        const int kbw = w == 0 ? 0 : (w == 1 ? 8 : (w == 2 ? 24 : 32));
        f32x4 oacc[4];
#pragma unroll
        for (int i = 0; i < 4; ++i) oacc[i] = (f32x4){0.f, 0.f, 0.f, 0.f};
        float m_run = -3.0e38f, l_run = 0.f;
        u32x4 sk[2], sv[2];
#define AT_LOAD(it) do { \
        _Pragma("unroll") for (int i = 0; i < 2; ++i) { const int idx = tid + 512 * i, key = idx >> 4, ch = idx & 15; \
            const size_t krow = (it) < 8 ? (size_t)b * SEQ + (size_t)(r0 + (it)) * 64 + key : (size_t)TL + (size_t)b * CTXL + ((it) - 8) * 64 + key; \
            const bf16* kp = QKV + krow * 3072 + 1024 + hp * 128 + ch * 8; sk[i] = *(const u32x4*)kp; sv[i] = *(const u32x4*)(kp + 1024); } } while (0)
#define AT_STORE(buf) do { LAS unsigned char* kt_ = lds + (buf) * 2 * TILE; \
        _Pragma("unroll") for (int i = 0; i < 2; ++i) { const int idx = tid + 512 * i, key = idx >> 4, ch = idx & 15; \
            *(LAS u32x4*)(kt_ + key * RS_N + ch * 16) = sk[i]; *(LAS u32x4*)(kt_ + TILE + key * RS_N + ch * 16) = sv[i]; } } while (0)
        AT_LOAD(0);
        AT_STORE(0);
        __syncthreads();
        for (int it = 0; it < 12; ++it) {
            const LAS unsigned char* Kt = lds + (it & 1) * 2 * TILE; const LAS unsigned char* Vt = Kt + TILE;
            if (it + 1 < 12) AT_LOAD(it + 1);
            const int ngrp = it < 8 ? 1 : 2;
            for (int grp = 0; grp < ngrp; ++grp) {
                const int kb = it < 8 ? kbw : 32 * grp;
                f32x4 s[2];
#pragma unroll
                for (int sb = 0; sb < 2; ++sb) { s[sb] = (f32x4){0.f, 0.f, 0.f, 0.f};
                    s[sb] = mfma16(frag16_row(Kt, RS_N, kb + 16 * sb, hsel * 64, lane), q0, s[sb]);
                    s[sb] = mfma16(frag16_row(Kt, RS_N, kb + 16 * sb, hsel * 64 + 32, lane), q1, s[sb]); }
                float mx = -3.0e38f;
#pragma unroll
                for (int sb = 0; sb < 2; ++sb)
#pragma unroll
                    for (int j = 0; j < 4; ++j) {
                        if (it < 8) { const int kc = kb + 16 * sb + 4 * g4 + j; const bool ok = kc >= cs && kc < cs + 16;
                            const int bi = (r0 + it - r + 7) * 31 + (kc - c + 15);
                            s[sb][j] = ok ? s[sb][j] + rp[hsel * 465 + (ok ? bi : 0)] : -3.0e38f; }
                        mx = fmaxf(mx, s[sb][j]); }
                mx = fmaxf(mx, __shfl_xor(mx, 16)); mx = fmaxf(mx, __shfl_xor(mx, 32));
                const float mn = fmaxf(m_run, mx);
                const float alpha = __expf(m_run - mn);
                float ps = 0.f; float p[8];
#pragma unroll
                for (int sb = 0; sb < 2; ++sb)
#pragma unroll
                    for (int j = 0; j < 4; ++j) { const float e = s[sb][j] > -1.0e38f ? __expf(s[sb][j] - mn) : 0.f; p[4 * sb + j] = e; ps += e; }
                l_run = l_run * alpha + ps; m_run = mn;
                u32x4 pu; pu[0] = pk2(p[0], p[1]); pu[1] = pk2(p[2], p[3]); pu[2] = pk2(p[4], p[5]); pu[3] = pk2(p[6], p[7]);
                const bf16x8 pf = __builtin_bit_cast(bf16x8, pu);
#pragma unroll
                for (int db = 0; db < 4; ++db) {
#pragma unroll
                    for (int j = 0; j < 4; ++j) oacc[db][j] *= alpha;
                    oacc[db] = mfma16(frag16_vt(Vt, RS_N, kb, hsel * 64 + 16 * db, lane), pf, oacc[db]); }
            }
            if (it + 1 < 12) AT_STORE((it + 1) & 1);
            __syncthreads();
        }
#undef AT_LOAD
#undef AT_STORE
        l_run += __shfl_xor(l_run, 16); l_run += __shfl_xor(l_run, 32);
        const float inv = 1.f / l_run;
        bf16* op = AO + qrow * D + head * 64 + 4 * g4;
#pragma unroll
        for (int db = 0; db < 4; ++db) { u32x2 o; o[0] = pk2(oacc[db][0] * inv, oacc[db][1] * inv); o[1] = pk2(oacc[db][2] * inv, oacc[db][3] * inv); *(u32x2*)(op + 16 * db) = o; }
    }
}
}
#define XB_TMO      128
#define XB_XCNT(j)  (256  + 64 * (j))
#define XB_XSUB(j)  (1280 + 64 * (j))
#define XB_XGEN(j)  (2304 + 64 * (j))
#define XB_TOP      3328
#define XB_TOPGEN   3392
#define XCD_BAR_WORDS 3456
#define XB_SPIN_CAP (1u << 18)

__device__ __forceinline__ unsigned xb_ld(unsigned* p)              { return __hip_atomic_load(p, __ATOMIC_RELAXED, __HIP_MEMORY_SCOPE_AGENT); }
__device__ __forceinline__ unsigned xb_add(unsigned* p, unsigned v) { return __hip_atomic_fetch_add(p, v, __ATOMIC_RELAXED, __HIP_MEMORY_SCOPE_AGENT); }
__device__ __forceinline__ unsigned xb_xcc_id() { return (unsigned)__builtin_amdgcn_s_getreg((3 << 11) | 20) & 0xFu; }
#define XB_SPIN(cond, bar) do { unsigned _sp = 0; while (cond) { __builtin_amdgcn_s_sleep(1); \
    if ((++_sp & 255u) == 0u) { if (xb_ld(&(bar)[XB_TMO])) break; if (_sp > XB_SPIN_CAP) { atomicAdd(&(bar)[XB_TMO], 1u); break; } } } } while (0)

struct XcdBarrier {
    unsigned* bar; unsigned x;
    volatile LAS unsigned* st;
};

__device__ __forceinline__ XcdBarrier xcd_barrier_post(unsigned* bar, volatile LAS unsigned* st) {
    XcdBarrier b; b.bar = bar; b.x = xb_xcc_id(); b.st = st;
    if (threadIdx.x == 0) (void)xb_add(&bar[XB_XCNT(b.x)], 1u);
    return b;
}
__device__ __forceinline__ void xcd_barrier_complete(unsigned* bar, unsigned x, unsigned& nloc, unsigned& nx) {
    const unsigned G = gridDim.x * gridDim.y * gridDim.z;
    unsigned sum, cnt, mine, sp = 0u;
    for (;;) {
        sum = 0u; cnt = 0u; mine = 0u;
#pragma unroll
        for (unsigned j = 0; j < 16; ++j) { const unsigned c = xb_ld(&bar[XB_XCNT(j)]); sum += c; cnt += (c > 0u) ? 1u : 0u; mine = (j == x) ? c : mine; }
        if (sum == G) break;
        __builtin_amdgcn_s_sleep(1);
        if ((++sp & 255u) == 0u) { if (xb_ld(&bar[XB_TMO])) break; if (sp > XB_SPIN_CAP) { atomicAdd(&bar[XB_TMO], 1u); break; } }
    }
    nloc = mine > 0u ? mine : 1u; nx = cnt > 0u ? cnt : 1u;
}

__device__ __forceinline__ void xcd_barrier(const XcdBarrier& b) {
    asm volatile("s_waitcnt vmcnt(0)" ::: "memory");
    __syncthreads();
    if (threadIdx.x == 0) {
        unsigned* bar = b.bar;
        __builtin_amdgcn_s_waitcnt(0);
        unsigned nloc = b.st[0], nx = b.st[1];
        if (nloc == 0u) { xcd_barrier_complete(bar, b.x, nloc, nx); b.st[0] = nloc; b.st[1] = nx; }
        const unsigned old = xb_add(&bar[XB_XSUB(b.x)], 1u);
        const unsigned gen = old / nloc;
        if (old + 1u == (gen + 1u) * nloc) {
            __builtin_amdgcn_fence(__ATOMIC_RELEASE, "agent");
            asm volatile("s_waitcnt vmcnt(0)" ::: "memory");
            const unsigned og = xb_add(&bar[XB_TOP], 1u);
            const unsigned tg = og / nx;
            if (og + 1u == (tg + 1u) * nx) xb_add(&bar[XB_TOPGEN], 1u);
            else XB_SPIN(xb_ld(&bar[XB_TOPGEN]) == tg, bar);
            __builtin_amdgcn_fence(__ATOMIC_ACQUIRE, "agent");
            xb_add(&bar[XB_XGEN(b.x)], 1u);
            asm volatile("s_waitcnt vmcnt(0)" ::: "memory");
        } else {
            XB_SPIN(xb_ld(&bar[XB_XGEN(b.x)]) == gen, bar);
            __builtin_amdgcn_fence(__ATOMIC_ACQUIRE, "agent");
            asm volatile("s_waitcnt vmcnt(0)" ::: "memory");
        }
    }
    __syncthreads();
}
namespace mk {
using namespace fx;
constexpr int NB = 4;
typedef Plan<NB> PL;

__global__ void __launch_bounds__(512, 2) k_mega(P p) {
    extern __shared__ __attribute__((aligned(16))) unsigned char lds_raw[];
    LAS unsigned char* lds = (LAS unsigned char*)lds_raw;
    unsigned char* ws = p.ws;
    const In& in = p.in;
    LAS unsigned* xbw = (LAS unsigned*)(lds + LDS_BYTES - 16);
    if (threadIdx.x == 0) { xbw[0] = 0u; xbw[1] = 0u; xbw[2] = 0u; xbw[3] = 0u; }
    __syncthreads();
    XcdBarrier bar = xcd_barrier_post((unsigned*)(ws + PL::CTL_BAR), (volatile LAS unsigned*)xbw);
    float* modv = (float*)(ws + PL::MODV);
    const float* mod0 = modv; const float* mod1 = modv + 5 * 6144;
    bf16* H = (bf16*)(ws + PL::H);
    int* cnt0 = (int*)(ws + PL::CTL_CNT); int* cnt1 = cnt0 + 32 * 64;
    int* list = (int*)(ws + PL::LIST); float* rw = (float*)(ws + PL::RW);
    bf16* wmoe0 = (bf16*)(ws + PL::W_MOE0); bf16* wmoe1 = (bf16*)(ws + PL::W_MOE1);
    const size_t GU = (size_t)32 * 1024 * 1024;
    float* X1 = (float*)(ws + PL::X1); float* X2 = (float*)(ws + PL::X2); float* X3 = (float*)(ws + PL::X3);
#ifndef REPMASK
#define REPMASK 0
#endif
#ifndef XBAR
#define XBAR 0
#endif
#define PH(k, ...) { __VA_ARGS__; xcd_barrier(bar); if ((REPMASK >> (k)) & 1) { __VA_ARGS__; xcd_barrier(bar); } }
    PH(0, conv_small_weights(in, ws, PL::W_IN, PL::W_OUT, PL::W_QKV, PL::W_NAO, lds); mod_vectors(in, modv, lds); conv_moe_weights(in, 0, wmoe0, wmoe0 + GU, lds))
    for (int i = 0; i < XBAR; ++i) xcd_barrier(bar);
    PH(1, rows_phase<NB, false, false, true, false>(in.x, in.ctx, PL::T, nullptr, mod0, mod0, nullptr, nullptr, in.norm1_w, 0, 1, H,
                                              nullptr, nullptr, nullptr, nullptr, nullptr, nullptr, nullptr, 0, lds))
    PH(2, phase_inproj<NB>(H, (const bf16*)(ws + PL::W_IN), (bf16*)(ws + PL::PROJ), (float*)(ws + PL::GATES), lds))
    PH(3, phase_conv<NB>((const bf16*)(ws + PL::PROJ), in.ab_conv_w, in.ab_conv_b, (bf16*)(ws + PL::XBC)))
    PH(4, phase_scan<NB>(in, (const bf16*)(ws + PL::PROJ), (const float*)(ws + PL::GATES), (const bf16*)(ws + PL::XBC), (bf16*)(ws + PL::SC), lds))
    phase_mixer_out<NB>(in, (const bf16*)(ws + PL::PROJ), (const bf16*)(ws + PL::XBC), (bf16*)(ws + PL::SC));
    xcd_barrier(bar);
    PH(6, phase_outproj<NB>((const bf16*)(ws + PL::SC), 4096, 2048, (const bf16*)(ws + PL::W_OUT), PL::T, in.x, in.ctx, mod0, X1, lds))
    rows_phase<NB, false, false, true, true>(X1, X1 + PL::TL * D, PL::T, nullptr, mod0, mod0, nullptr, nullptr, in.norm2_w, 3, 4, H,
        in.moe_w_group, in.moe_b_group, in.moe_w_expert, in.moe_b_expert, rw, cnt0, list, (int)PL::T, lds);
    PH(7, conv_moe_weights(in, 1, wmoe1, wmoe1 + GU, lds))
    PH(8, phase_moe_up(H, wmoe0, cnt0, list, (int)PL::T, rw, (bf16*)(ws + PL::ACT), lds))
    PH(9, phase_moe_down((const bf16*)(ws + PL::ACT), wmoe0 + GU, cnt0, list, (int)PL::T, (bf16*)(ws + PL::Y2), lds))
    PH(10, rows_phase<NB, true, true, true, false>(X1, X1 + PL::TL * D, PL::T, (const bf16*)(ws + PL::Y2), mod0, mod1, X2, nullptr, in.norm1_w + 1024, 0, 1, H,
        nullptr, nullptr, nullptr, nullptr, nullptr, nullptr, nullptr, 0, lds))
    PH(11, phase_qkv<NB>(H, (const bf16*)(ws + PL::W_QKV), in.na_q_norm, in.na_k_norm, (bf16*)(ws + PL::QKV), lds))
    PH(12, phase_attn<NB>((const bf16*)(ws + PL::QKV), in.na_rpb, (bf16*)(ws + PL::AO), lds))
    PH(13, phase_outproj<NB>((const bf16*)(ws + PL::AO), 1024, 1024, (const bf16*)(ws + PL::W_NAO), PL::TL, X2, X2 + PL::TL * D, mod1, X3, lds))
    rows_phase<NB, false, false, true, true>(X3, X3, PL::TL, nullptr, mod1, mod1, nullptr, nullptr, in.norm2_w + 1024, 3, 4, H,
        in.moe_w_group + 1024 * 4, in.moe_b_group + 4, in.moe_w_expert + 1024 * 32, in.moe_b_expert + 32, rw, cnt1, list, (int)PL::T, lds);
    xcd_barrier(bar);
    PH(15, phase_moe_up(H, wmoe1, cnt1, list, (int)PL::T, rw, (bf16*)(ws + PL::ACT), lds))
    PH(16, phase_moe_down((const bf16*)(ws + PL::ACT), wmoe1 + GU, cnt1, list, (int)PL::T, (bf16*)(ws + PL::Y2), lds))
    rows_phase<NB, true, false, false, false>(X3, X3, PL::TL, (const bf16*)(ws + PL::Y2), mod1, mod1, nullptr, p.out, nullptr, 0, 0, nullptr,
        nullptr, nullptr, nullptr, nullptr, nullptr, nullptr, nullptr, 0, lds);
    if ((REPMASK >> 17) & 1) { xcd_barrier(bar); rows_phase<NB, true, false, false, false>(X3, X3, PL::TL, (const bf16*)(ws + PL::Y2), mod1, mod1, nullptr, p.out, nullptr, 0, 0, nullptr,
        nullptr, nullptr, nullptr, nullptr, nullptr, nullptr, nullptr, 0, lds); }
#undef PH
}
__global__ void k_fill(float* q, size_t n, float v) { size_t i = (size_t)blockIdx.x * 256 + threadIdx.x; if (i < n) q[i] = v; }
}

extern "C" void kernel_launch(void* const* d_in, const int* in_sizes, int n_in, void* d_out, int out_size, void* d_ws, size_t ws_size, hipStream_t stream) {
    static int grid = 0;
    if (grid == 0) {
        int dev = 0, cus = 0, per_cu = 0;
        (void)hipGetDevice(&dev);
        (void)hipDeviceGetAttribute(&cus, hipDeviceAttributeMultiprocessorCount, dev);
        if (hipFuncSetAttribute((const void*)mk::k_mega, hipFuncAttributeMaxDynamicSharedMemorySize, fx::LDS_BYTES) != hipSuccess) { grid = -1; }
        else {
            if (hipOccupancyMaxActiveBlocksPerMultiprocessor(&per_cu, (const void*)mk::k_mega, 512, fx::LDS_BYTES) != hipSuccess) per_cu = 0;
            (void)hipGetLastError();
            grid = per_cu >= 1 ? cus : -1;
        }
    }
    if (grid < 0 || n_in != 31 || mk::PL::END > ws_size) { mk::k_fill<<<(out_size + 255) / 256, 256, 0, stream>>>((float*)d_out, (size_t)out_size, 2.f); return; }
    (void)hipMemsetAsync((unsigned char*)d_ws + mk::PL::CTL, 0, mk::PL::CTL_BYTES, stream);
    fx::P fp;
    { const float** q = (const float**)&fp.in; for (int i = 0; i < 31; ++i) q[i] = (const float*)d_in[i]; }
    fp.ws = (unsigned char*)d_ws; fp.out = (float*)d_out;
    hipLaunchKernelGGL(mk::k_mega, dim3(grid), dim3(512), fx::LDS_BYTES, stream, fp);
}
```

```cpp
#include <hip/hip_runtime.h>
#include <cstdio>
#include <cstdint>
namespace fx {
#define LAS __attribute__((address_space(3)))
typedef unsigned short bf16;
typedef short bf16x8 __attribute__((ext_vector_type(8)));
typedef short bf16x4 __attribute__((ext_vector_type(4)));
typedef float f32x16 __attribute__((ext_vector_type(16)));
typedef float f32x4 __attribute__((ext_vector_type(4)));
typedef unsigned u32x4 __attribute__((ext_vector_type(4)));
typedef unsigned u32x2 __attribute__((ext_vector_type(2)));
constexpr int NTHR = 512, NWAVE = 8;
constexpr int D = 1024, SEQ = 4096, CTXL = 256;
constexpr int PROJW = 5632, NIN = 5760;
constexpr int PC_Z = 0, PC_XBC = 1024, PC_Q = 2560, PC_K = 3072, PC_V = 3584, PC_O = 4608;
constexpr int LDS_BYTES = 152 * 1024;

__device__ __forceinline__ int otid() { int t = threadIdx.x; asm volatile("" : "+v"(t)); return t; }
__device__ __forceinline__ float bf2f(bf16 v) { return __uint_as_float((unsigned)v << 16); }
__device__ __forceinline__ float bflo(unsigned u) { return __uint_as_float(u << 16); }
__device__ __forceinline__ float bfhi(unsigned u) { return __uint_as_float(u & 0xffff0000u); }
__device__ __forceinline__ unsigned pk2(float lo, float hi) { unsigned r; asm("v_cvt_pk_bf16_f32 %0, %1, %2" : "=v"(r) : "v"(lo), "v"(hi)); return r; }
__device__ __forceinline__ float siluf(float v) { return v / (1.f + __expf(-v)); }
__device__ __forceinline__ float sigmf(float v) { return 1.f / (1.f + __expf(-v)); }
__device__ __forceinline__ float softplusf(float v) { return v > 20.f ? v : log1pf(__expf(v)); }
__device__ __forceinline__ float logsigf(float v) { return fminf(v, 0.f) - log1pf(__expf(-fabsf(v))); }
__device__ __forceinline__ float wave_sum(float v) {
#pragma unroll
    for (int o = 32; o > 0; o >>= 1) v += __shfl_xor(v, o);
    return v;
}
__device__ __forceinline__ float wave_max(float v) {
#pragma unroll
    for (int o = 32; o > 0; o >>= 1) v = fmaxf(v, __shfl_xor(v, o));
    return v;
}
__device__ __forceinline__ f32x16 mfma32(bf16x8 a, bf16x8 b, f32x16 c) { return __builtin_amdgcn_mfma_f32_32x32x16_bf16(a, b, c, 0, 0, 0); }
__device__ __forceinline__ f32x4 mfma16(bf16x8 a, bf16x8 b, f32x4 c) { return __builtin_amdgcn_mfma_f32_16x16x32_bf16(a, b, c, 0, 0, 0); }

__device__ __forceinline__ bf16x8 frag_row(const LAS unsigned char* T, int RS, int r0, int k0, int lane) {
    return *(const LAS bf16x8*)(T + (r0 + (lane & 31)) * RS + (k0 + 8 * (lane >> 5)) * 2);
}
__device__ __forceinline__ bf16x8 frag_col(const LAS unsigned char* T, int RS, int k0, int c0, int lane) {
    const int h = lane >> 5, blk = (lane >> 4) & 1, q = (lane & 15) >> 2, p = lane & 3;
    const unsigned a0 = (unsigned)(size_t)(T + (k0 + 8 * h + q) * RS + (c0 + 16 * blk + 4 * p) * 2);
    const unsigned a1 = a0 + 4 * RS;
    bf16x4 v0, v1;
    asm volatile("ds_read_b64_tr_b16 %0, %2\n\tds_read_b64_tr_b16 %1, %3\n\ts_waitcnt lgkmcnt(0)" : "=&v"(v0), "=&v"(v1) : "v"(a0), "v"(a1) : "memory");
    bf16x8 r; r[0] = v0[0]; r[1] = v0[1]; r[2] = v0[2]; r[3] = v0[3]; r[4] = v1[0]; r[5] = v1[1]; r[6] = v1[2]; r[7] = v1[3];
    return r;
}

struct In {
    const float *x, *c, *ctx, *c_ctx, *norm1_w, *norm2_w, *mod_w, *mod_b, *ab_w_in, *ab_conv_w, *ab_conv_b, *ssd_a_log, *ssd_dt_bias, *ssd_d,
        *ssd_norm_w, *ml_i_bias, *ml_f_bias, *ml_norm_w, *ab_w_out, *na_w_qkv, *na_q_norm, *na_k_norm, *na_rpb, *na_w_out,
        *moe_w_group, *moe_b_group, *moe_w_expert, *moe_b_expert, *moe_w_gate, *moe_w_up, *moe_w_down;
};

constexpr size_t cmax(size_t a, size_t b) { return a > b ? a : b; }
constexpr size_t al256(size_t x) { return (x + 255) & ~(size_t)255; }

template <int NB> struct Plan {
    static constexpr size_t TL = (size_t)NB * SEQ, TC = (size_t)NB * CTXL, T = TL + TC;
    static constexpr size_t CTL = 0;
    static constexpr size_t CTL_BAR = 0, CTL_CNT = 16384  , CTL_BYTES = 32768;
    static constexpr size_t MODV = CTL + CTL_BYTES;
    static constexpr size_t RW = MODV + al256(2 * 5 * 6144 * 4);
    static constexpr size_t LIST = RW + al256(2 * T * 4);
    static constexpr size_t W_IN = LIST + al256(32 * T * 4);
    static constexpr size_t W_OUT = W_IN + (size_t)NIN * 1024 * 2;
    static constexpr size_t W_QKV = W_OUT + (size_t)1024 * 2048 * 2;
    static constexpr size_t W_NAO = W_QKV + (size_t)3072 * 1024 * 2;
    static constexpr size_t ARENA = W_NAO + (size_t)1024 * 1024 * 2;
    static constexpr size_t MOEW = (size_t)32 * 1024 * 1024 * 2 + (size_t)32 * 1024 * 512 * 2;
    static constexpr size_t SZ_B = al256(T * 1024 * 2);
    static constexpr size_t SZ_A = al256(cmax(MOEW, cmax(T * 3072 * 2, T * 1024 * 4)));
    static constexpr size_t SZ_X = al256(T * 1024 * 4);
    static constexpr size_t SZ_C = al256(cmax(T * PROJW * 2 + T * 64 * 4, SZ_X + MOEW));
    static constexpr size_t SZ_D = al256(T * 1536 * 2);
    static constexpr size_t SZ_E = al256(T * 4096 * 2);
    static constexpr size_t RB = ARENA, RA = RB + SZ_B, RC = RA + SZ_A, RD = RC + SZ_C, RE = RD + SZ_D, END = RE + SZ_E;
    static constexpr size_t H = RB;
    static constexpr size_t W_MOE0 = RA;
    static constexpr size_t QKV = RA;
    static constexpr size_t X3 = RA;
    static constexpr size_t PROJ = RC;
    static constexpr size_t GATES = RC + T * PROJW * 2;
    static constexpr size_t X1 = RC;
    static constexpr size_t W_MOE1 = RC + SZ_X;
    static constexpr size_t XBC = RD;
    static constexpr size_t ACT = RD;
    static constexpr size_t AO = RD;
    static constexpr size_t SC = RE;
    static constexpr size_t Y2 = RE;
    static constexpr size_t X2 = RE + al256(2 * T * 1024 * 2);
    static_assert(2 * T * 1024 * 2 + T * 1024 * 4 <= SZ_E, "E");
    static_assert(T * 3072 * 2 <= SZ_A + SZ_X, "QKV spill");
};

struct P { In in; unsigned char* ws; float* out; };

template <int NB> __device__ __forceinline__ int mod_row(int row) { return row < NB * SEQ ? row / SEQ : 4; }

template <class Map>
__device__ __forceinline__ void tconv_tile(const float* src, int ld_src, bf16* dst, int K, int k0, int n0, Map map, LAS unsigned char* lds) {
    LAS float* tl = (LAS float*)lds;
    const int tid = otid();
    {
        const int n = tid & 63, kb = tid >> 6;
        const int sc = map(n0 + n);
#pragma unroll
        for (int i = 0; i < 8; ++i) { const int k = kb + 8 * i; tl[k * 65 + n] = sc >= 0 ? src[(size_t)(k0 + k) * ld_src + sc] : 0.f; }
    }
    __syncthreads();
    {
        const int n = tid >> 3, kc = tid & 7;
        float v[8];
#pragma unroll
        for (int j = 0; j < 8; ++j) v[j] = tl[(kc * 8 + j) * 65 + n];
        u32x4 o; o[0] = pk2(v[0], v[1]); o[1] = pk2(v[2], v[3]); o[2] = pk2(v[4], v[5]); o[3] = pk2(v[6], v[7]);
        *(u32x4*)(dst + (size_t)(n0 + n) * K + k0 + kc * 8) = o;
    }
    __syncthreads();
}

struct MapId { __device__ int operator()(int n) const { return n; } };
struct MapIn {
    __device__ int operator()(int n) const { return n < 2560 ? n : (n < 5632 ? n + 32 : (n < 5664 ? n - 3072 : (n < 5680 ? n : -1))); }
};

__device__ __forceinline__ void conv_small_weights(const In& in, unsigned char* ws, size_t o_in, size_t o_out, size_t o_qkv, size_t o_nao, LAS unsigned char* lds) {
    const int total = 1440 + 512 + 768 + 256;
    for (int u = blockIdx.x; u < total; u += gridDim.x) {
        if (u < 1440) { const int kt = u % 16, nt = u / 16; tconv_tile(in.ab_w_in, 5680, (bf16*)(ws + o_in), 1024, kt * 64, nt * 64, MapIn(), lds); }
        else if (u < 1952) { const int v = u - 1440, kt = v % 32, nt = v / 32; tconv_tile(in.ab_w_out, 1024, (bf16*)(ws + o_out), 2048, kt * 64, nt * 64, MapId(), lds); }
        else if (u < 2720) { const int v = u - 1952, kt = v % 16, nt = v / 16; tconv_tile(in.na_w_qkv, 3072, (bf16*)(ws + o_qkv), 1024, kt * 64, nt * 64, MapId(), lds); }
        else { const int v = u - 2720, kt = v % 16, nt = v / 16; tconv_tile(in.na_w_out, 1024, (bf16*)(ws + o_nao), 1024, kt * 64, nt * 64, MapId(), lds); }
    }
}

struct MapGU { __device__ int operator()(int n) const { return (n >> 7) * 64 + ((n >> 6) & 1) * 32 + (n & 31); } };
__device__ __forceinline__ void conv_moe_weights(const In& in, int layer, bf16* wgu, bf16* wd, LAS unsigned char* lds) {
    const size_t wsz = (size_t)1024 * 512;
    const int total_gu = 32 * 16 * 16, total_d = 32 * 8 * 16;
    for (int u = blockIdx.x; u < total_gu + total_d; u += gridDim.x) {
        if (u < total_gu) {
            const int e = u / 256, v = u % 256, kt = v % 16, nt = v / 16;
            const float* g = in.moe_w_gate + ((size_t)layer * 32 + e) * wsz; const float* up = in.moe_w_up + ((size_t)layer * 32 + e) * wsz;
            bf16* dst = wgu + (size_t)e * 1024 * 1024;
            LAS float* tl = (LAS float*)lds;
            const int tid = otid();
            { const int n = tid & 63, kb = tid >> 6; const int f = MapGU()(nt * 64 + n); const float* s = (n & 32) ? up : g;
#pragma unroll
              for (int i = 0; i < 8; ++i) { const int k = kb + 8 * i; tl[k * 65 + n] = s[(size_t)(kt * 64 + k) * 512 + f]; } }
            __syncthreads();
            { const int n = tid >> 3, kc = tid & 7; float vv[8];
#pragma unroll
              for (int j = 0; j < 8; ++j) vv[j] = tl[(kc * 8 + j) * 65 + n];
              u32x4 o; o[0] = pk2(vv[0], vv[1]); o[1] = pk2(vv[2], vv[3]); o[2] = pk2(vv[4], vv[5]); o[3] = pk2(vv[6], vv[7]);
              *(u32x4*)(dst + (size_t)(nt * 64 + n) * 1024 + kt * 64 + kc * 8) = o; }
            __syncthreads();
        } else {
            const int w = u - total_gu, e = w / 128, v = w % 128, kt = v % 8, nt = v / 8;
            tconv_tile(in.moe_w_down + ((size_t)layer * 32 + e) * wsz, 1024, wd + (size_t)e * 1024 * 512, 512, kt * 64, nt * 64, MapId(), lds);
        }
    }
}

__device__ __forceinline__ void mod_vectors(const In& in, float* modv, LAS unsigned char* lds) {
    LAS float* sc = (LAS float*)lds;
    LAS float* red = sc + 5 * 1024;
    const int tid = otid();
    for (int i = tid; i < 5 * 1024; i += NTHR) { const int r = i >> 10, k = i & 1023; const float v = r < 4 ? in.c[r * 1024 + k] : in.c_ctx[k]; sc[i] = siluf(v); }
    __syncthreads();
    const int col = tid & 31, kq = tid >> 5;
    for (int u = blockIdx.x; u < 2 * 192; u += gridDim.x) {
        const int layer = u / 192, c0 = (u % 192) * 32;
        const float* w = in.mod_w + (size_t)layer * 1024 * 6144 + c0 + col;
        float a0 = 0.f, a1 = 0.f, a2 = 0.f, a3 = 0.f, a4 = 0.f;
#pragma unroll 8
        for (int j = 0; j < 64; ++j) { const int k = kq + 16 * j; const float wv = w[(size_t)k * 6144];
            a0 += sc[k] * wv; a1 += sc[1024 + k] * wv; a2 += sc[2048 + k] * wv; a3 += sc[3072 + k] * wv; a4 += sc[4096 + k] * wv; }
        red[(0 * 16 + kq) * 32 + col] = a0; red[(1 * 16 + kq) * 32 + col] = a1; red[(2 * 16 + kq) * 32 + col] = a2;
        red[(3 * 16 + kq) * 32 + col] = a3; red[(4 * 16 + kq) * 32 + col] = a4;
        __syncthreads();
        if (tid < 160) { const int r = tid >> 5, cc = tid & 31; float s = 0.f;
#pragma unroll
            for (int q = 0; q < 16; ++q) s += red[(r * 16 + q) * 32 + cc];
            modv[((size_t)layer * 5 + r) * 6144 + c0 + cc] = s + in.mod_b[layer * 6144 + c0 + cc]; }
        __syncthreads();
    }
}

template <int NB, bool COMBINE, bool XOUT, bool NORM, bool ROUTER>
__device__ __forceinline__ void rows_phase(const float* xl, const float* xc, int nrows, const bf16* y2, const float* modc  , const float* modl  ,
                                           float* xout, float* out_final, const float* nw, int shift_i, int scale_i, bf16* hout,
                                           const float* wg, const float* bg, const float* we, const float* be, float* route_w, int* cnt, int* list, int cap,
                                           LAS unsigned char* lds) {
    constexpr int TL = NB * SEQ;
    const int tid = otid(), lane = tid & 63, wave = tid >> 6;
    LAS float* wt = (LAS float*)lds;
    LAS int* lcnt = (LAS int*)(lds + 36 * 1024 * 4); LAS int* lbase = lcnt + 32; LAS int* rinfo = lcnt + 64;
    if (ROUTER) {
        if (tid < 32) lcnt[tid] = 0;
        for (int i = tid; i < 4 * 1024; i += NTHR) wt[(i & 3) * 1024 + (i >> 2)] = wg[i];
        for (int i = tid; i < 32 * 1024; i += NTHR) wt[(4 + (i & 31)) * 1024 + (i >> 5)] = we[i];
        __syncthreads();
    }
    int lrow = wave;
    for (int row = blockIdx.x * NWAVE + wave; row < nrows; row += gridDim.x * NWAVE, lrow += NWAVE) {
        const float* src = row < TL ? xl + (size_t)row * D : xc + (size_t)(row - TL) * D;
        const float* mv = modl + (size_t)mod_row<NB>(row) * 6144;
        const float* mvc = modc + (size_t)mod_row<NB>(row) * 6144;
        f32x4 v[4];
#pragma unroll
        for (int i = 0; i < 4; ++i) v[i] = *(const f32x4*)(src + lane * 4 + 256 * i);
        if (COMBINE) {
#pragma unroll
            for (int i = 0; i < 4; ++i) { const int c = lane * 4 + 256 * i;
                const u32x2 ya = *(const u32x2*)(y2 + (size_t)(2 * row) * D + c), yb = *(const u32x2*)(y2 + (size_t)(2 * row + 1) * D + c);
                const f32x4 m5 = *(const f32x4*)(mvc + 5 * 1024 + c);
                v[i][0] += m5[0] * (bflo(ya[0]) + bflo(yb[0])); v[i][1] += m5[1] * (bfhi(ya[0]) + bfhi(yb[0]));
                v[i][2] += m5[2] * (bflo(ya[1]) + bflo(yb[1])); v[i][3] += m5[3] * (bfhi(ya[1]) + bfhi(yb[1])); }
            if (XOUT) {
#pragma unroll
                for (int i = 0; i < 4; ++i) *(f32x4*)(xout + (size_t)row * D + lane * 4 + 256 * i) = v[i]; }
            if (out_final) {
#pragma unroll
                for (int i = 0; i < 4; ++i) *(f32x4*)(out_final + (size_t)row * D + lane * 4 + 256 * i) = v[i]; }
        }
        if (NORM) {
            float ss = 0.f;
#pragma unroll
            for (int i = 0; i < 4; ++i) ss += v[i][0] * v[i][0] + v[i][1] * v[i][1] + v[i][2] * v[i][2] + v[i][3] * v[i][3];
            ss = wave_sum(ss);
            const float rs = rsqrtf(ss * (1.f / D) + 1e-6f);
            f32x4 hv[4];
#pragma unroll
            for (int i = 0; i < 4; ++i) { const int c = lane * 4 + 256 * i;
                const f32x4 w4 = *(const f32x4*)(nw + c), sc4 = *(const f32x4*)(mv + scale_i * 1024 + c), sh4 = *(const f32x4*)(mv + shift_i * 1024 + c);
#pragma unroll
                for (int j = 0; j < 4; ++j) hv[i][j] = v[i][j] * rs * w4[j] * (1.f + sc4[j]) + sh4[j];
                u32x2 o; o[0] = pk2(hv[i][0], hv[i][1]); o[1] = pk2(hv[i][2], hv[i][3]);
                *(u32x2*)(hout + (size_t)row * D + c) = o; }
            if (ROUTER) {
                float lg[4];
#pragma unroll
                for (int j = 0; j < 4; ++j) { float a = 0.f;
#pragma unroll
                    for (int i = 0; i < 4; ++i) { const f32x4 w4 = *(const LAS f32x4*)(wt + j * 1024 + lane * 4 + 256 * i);
                        a += hv[i][0] * w4[0] + hv[i][1] * w4[1] + hv[i][2] * w4[2] + hv[i][3] * w4[3]; }
                    lg[j] = wave_sum(a) + bg[j]; }
                int gi = 0; float gm = lg[0];
#pragma unroll
                for (int j = 1; j < 4; ++j) if (lg[j] > gm) { gm = lg[j]; gi = j; }
                float gs = 0.f;
#pragma unroll
                for (int j = 0; j < 4; ++j) gs += __expf(lg[j] - gm);
                const float gprob = 1.f / gs;
                float le[8];
#pragma unroll
                for (int j = 0; j < 8; ++j) { float a = 0.f; const LAS float* wr = wt + (4 + gi * 8 + j) * 1024 + lane * 4;
#pragma unroll
                    for (int i = 0; i < 4; ++i) { const f32x4 w4 = *(const LAS f32x4*)(wr + 256 * i);
                        a += hv[i][0] * w4[0] + hv[i][1] * w4[1] + hv[i][2] * w4[2] + hv[i][3] * w4[3]; }
                    le[j] = wave_sum(a) + be[gi * 8 + j]; }
                int e0 = 0; float m0 = le[0];
#pragma unroll
                for (int j = 1; j < 8; ++j) if (le[j] > m0) { m0 = le[j]; e0 = j; }
                int e1 = 0; float m1 = -3.0e38f;
#pragma unroll
                for (int j = 0; j < 8; ++j) if (j != e0 && le[j] > m1) { m1 = le[j]; e1 = j; }
                const float p1 = __expf(m1 - m0);
                if (lane == 0) {
                    const int ge0 = gi * 8 + e0, ge1 = gi * 8 + e1;
                    route_w[2 * row] = gprob / (1.f + p1); route_w[2 * row + 1] = gprob * p1 / (1.f + p1);
                    const int s0 = atomicAdd((int*)&lcnt[ge0], 1), s1 = atomicAdd((int*)&lcnt[ge1], 1);
                    rinfo[2 * lrow] = (ge0 << 16) | s0; rinfo[2 * lrow + 1] = (ge1 << 16) | s1;
                }
            }
        }
    }
    if (ROUTER) {
        __syncthreads();
        if (tid < 32) { const int c = lcnt[tid]; lbase[tid] = c ? atomicAdd(&cnt[tid * 64], c) : 0; }
        __syncthreads();
        int lrow = wave;
        for (int row = blockIdx.x * NWAVE + wave; row < nrows; row += gridDim.x * NWAVE, lrow += NWAVE) {
            if (lane < 2) { const int ri = rinfo[2 * lrow + lane], ge = ri >> 16, sl = ri & 0xffff; list[(size_t)ge * cap + lbase[ge] + sl] = 2 * row + lane; }
        }
        __syncthreads();
    }
}

__device__ __forceinline__ int xcd_unit(int r) { const int G = gridDim.x, bx = blockIdx.x; return G == 256 ? ((r * 8 + (bx & 7)) * 32 + (bx >> 3)) : r * G + bx; }
__device__ __forceinline__ void unit_tile(int u, int MT, int NT, int& mt, int& nt) {
    if ((MT & 3) == 0) { const int band = u / (4 * NT), w = u - band * 4 * NT; nt = w >> 2; mt = band * 4 + (w & 3); }
    else { mt = u / NT; nt = u - mt * NT; }
}
constexpr int GEMM_STAGE = 256 * 128 + 128 * 128;
constexpr int GEMM_LDS = 3 * GEMM_STAGE;
__device__ __forceinline__ int sw_off(int row, int chunk) { return row * 128 + ((chunk ^ ((row >> 1) & 7)) << 4); }

template <int VAR = 0, class Epi>
__device__ __forceinline__ void gemm_tile(const bf16* const (&arow)[4], const bf16* bt  , int ldb, int K, LAS unsigned char* lds, Epi&& epi) {
    const int tid = otid(), lane = tid & 63, wave = tid >> 6, wm = wave >> 1, wn = wave & 1;
    const int r8 = tid >> 3;
    const int schunk = (lane & 7) ^ ((r8 >> 1) & 7);
    const bf16* ga[4]; const bf16* gb[2];
#pragma unroll
    for (int i = 0; i < 4; ++i) ga[i] = arow[i] + schunk * 8;
#pragma unroll
    for (int i = 0; i < 2; ++i) gb[i] = bt + (size_t)(r8 + 64 * i) * ldb + schunk * 8;
    f32x16 acc[2][2];
#pragma unroll
    for (int mi = 0; mi < 2; ++mi)
#pragma unroll
        for (int ni = 0; ni < 2; ++ni)
#pragma unroll
            for (int r = 0; r < 16; ++r) acc[mi][ni][r] = 0.f;
#define G_DMA(t, st) do { LAS unsigned char* sa_ = lds + (st) * GEMM_STAGE + wave * 1024 + lane * 16; \
    _Pragma("unroll") for (int i = 0; i < 4; ++i) __builtin_amdgcn_global_load_lds((const unsigned*)(ga[i] + (t) * 64), (LAS unsigned*)(sa_ + i * 8192), 16, 0, 0); \
    _Pragma("unroll") for (int i = 0; i < 2; ++i) __builtin_amdgcn_global_load_lds((const unsigned*)(gb[i] + (t) * 64), (LAS unsigned*)(sa_ + 256 * 128 + i * 8192), 16, 0, 0); } while (0)
    const int KT = K >> 6;
    G_DMA(0, 0);
    G_DMA(1, 1);
    asm volatile("s_waitcnt vmcnt(6)" ::: "memory");
    __builtin_amdgcn_s_barrier();
    asm volatile("" ::: "memory");
    int st = 0;
    for (int kt = 0; kt < KT; ++kt) {
        const int st2 = st >= 1 ? st - 1 : 2;
        if (VAR != 2) { if (kt + 2 < KT) G_DMA(kt + 2, st2); }
        const LAS unsigned char* sa = lds + st * GEMM_STAGE; const LAS unsigned char* sb = sa + 256 * 128;
        bf16x8 af[2], bfr[2];
        if (VAR == 1) {
#pragma unroll
            for (int mi = 0; mi < 2; ++mi) af[mi] = *(const LAS bf16x8*)(sa + sw_off(wm * 64 + mi * 32 + (lane & 31), (lane >> 5)));
#pragma unroll
            for (int ni = 0; ni < 2; ++ni) bfr[ni] = *(const LAS bf16x8*)(sb + sw_off(wn * 64 + ni * 32 + (lane & 31), (lane >> 5)));
        }
#pragma unroll
        for (int kk = 0; kk < 4; ++kk) {
            if (VAR != 1) {
#pragma unroll
            for (int mi = 0; mi < 2; ++mi) af[mi] = *(const LAS bf16x8*)(sa + sw_off(wm * 64 + mi * 32 + (lane & 31), 2 * kk + (lane >> 5)));
#pragma unroll
            for (int ni = 0; ni < 2; ++ni) bfr[ni] = *(const LAS bf16x8*)(sb + sw_off(wn * 64 + ni * 32 + (lane & 31), 2 * kk + (lane >> 5)));
            }
            if (VAR == 3) {
#pragma unroll
                for (int mi = 0; mi < 2; ++mi) acc[mi][0][kk] += __builtin_bit_cast(f32x4, af[mi])[0] + __builtin_bit_cast(f32x4, bfr[mi])[1];
            } else {
#pragma unroll
            for (int mi = 0; mi < 2; ++mi)
#pragma unroll
                for (int ni = 0; ni < 2; ++ni) acc[mi][ni] = mfma32(bfr[ni], af[mi], acc[mi][ni]);
            }
        }
        if (kt + 2 < KT) asm volatile("s_waitcnt vmcnt(6)" ::: "memory"); else asm volatile("s_waitcnt vmcnt(0)" ::: "memory");
        __builtin_amdgcn_s_barrier();
        asm volatile("" ::: "memory");
        st = st == 2 ? 0 : st + 1;
    }
#undef G_DMA
    epi(acc, wm, wn, lane);
}

constexpr int CST_BF = 272, CST_BF64 = 144, CST_F32 = 528;
__device__ __forceinline__ void stage_bf16_128(const f32x16 (&acc)[2][2], LAS unsigned char* lds, int wm, int wn, int lane) {
#pragma unroll
    for (int mi = 0; mi < 2; ++mi) { LAS unsigned char* rp = lds + (wm * 64 + mi * 32 + (lane & 31)) * CST_BF + (wn * 64 + 4 * (lane >> 5)) * 2;
#pragma unroll
        for (int ni = 0; ni < 2; ++ni)
#pragma unroll
            for (int g = 0; g < 4; ++g) { u32x2 o; o[0] = pk2(acc[mi][ni][4 * g], acc[mi][ni][4 * g + 1]); o[1] = pk2(acc[mi][ni][4 * g + 2], acc[mi][ni][4 * g + 3]);
                *(LAS u32x2*)(rp + (ni * 32 + 8 * g) * 2) = o; } }
}
template <class RowPtr>
__device__ __forceinline__ void flush_bf16_128(const LAS unsigned char* lds, RowPtr&& rowptr) {
    const int t = otid();
#pragma unroll
    for (int it = 0; it < 8; ++it) { const int row = it * 32 + (t >> 4), piece = t & 15;
        const u32x4 v = *(const LAS u32x4*)(lds + row * CST_BF + piece * 16);
        bf16* dst = rowptr(row);
        if (dst) *(u32x4*)(dst + piece * 8) = v; }
}
template <class RowPtr>
__device__ __forceinline__ void flush_bf16_64(const LAS unsigned char* lds, RowPtr&& rowptr) {
    const int t = otid();
#pragma unroll
    for (int it = 0; it < 4; ++it) { const int row = it * 64 + (t >> 3), piece = t & 7;
        const u32x4 v = *(const LAS u32x4*)(lds + row * CST_BF64 + piece * 16);
        bf16* dst = rowptr(row);
        if (dst) *(u32x4*)(dst + piece * 8) = v; }
}
__device__ __forceinline__ void stage_f32_128(const f32x16 (&acc)[2][2], LAS unsigned char* lds, int wm, int wn, int lane) {
#pragma unroll
    for (int mi = 0; mi < 2; ++mi) { LAS unsigned char* rp = lds + (wm * 64 + mi * 32 + (lane & 31)) * CST_F32 + (wn * 64 + 4 * (lane >> 5)) * 4;
#pragma unroll
        for (int ni = 0; ni < 2; ++ni)
#pragma unroll
            for (int g = 0; g < 4; ++g) { f32x4 o; o[0] = acc[mi][ni][4 * g]; o[1] = acc[mi][ni][4 * g + 1]; o[2] = acc[mi][ni][4 * g + 2]; o[3] = acc[mi][ni][4 * g + 3];
                *(LAS f32x4*)(rp + (ni * 32 + 8 * g) * 4) = o; } }
}

template <int NB, int VAR = 0>
__device__ __forceinline__ void phase_inproj_v(const bf16* H, const bf16* Wt, bf16* PROJ, float* GATES, LAS unsigned char* lds, bool dostore = true) {
    constexpr int T = NB * (SEQ + CTXL), MT = T / 256, NT_ = NIN / 128;
    for (int r = 0; r * (int)gridDim.x < MT * NT_; ++r) {
        const int u = xcd_unit(r); if (u >= MT * NT_) continue;
        int mt, nt; unit_tile(u, MT, NT_, mt, nt);
        const bf16* arow[4];
#pragma unroll
        for (int i = 0; i < 4; ++i) arow[i] = H + (size_t)(mt * 256 + (otid() >> 3) + 64 * i) * D;
        gemm_tile<VAR>(arow, Wt + (size_t)nt * 128 * D, D, D, lds, [&](const f32x16 (&acc)[2][2], int wm, int wn, int lane) {
            if (!dostore) return;
            if (nt < NT_ - 1) stage_bf16_128(acc, lds, wm, wn, lane);
            else if (wn == 0) {
#pragma unroll
                for (int mi = 0; mi < 2; ++mi) { const int row = mt * 256 + wm * 64 + mi * 32 + (lane & 31);
#pragma unroll
                    for (int ni = 0; ni < 2; ++ni)
#pragma unroll
                        for (int g = 0; g < 4; ++g) { f32x4 o; o[0] = acc[mi][ni][4 * g]; o[1] = acc[mi][ni][4 * g + 1]; o[2] = acc[mi][ni][4 * g + 2]; o[3] = acc[mi][ni][4 * g + 3];
                            *(f32x4*)(GATES + (size_t)row * 64 + ni * 32 + 8 * g + 4 * (lane >> 5)) = o; } } }
        });
        if (dostore && nt < NT_ - 1) {
            __syncthreads();
            flush_bf16_128(lds, [&](int r) { return PROJ + (size_t)(mt * 256 + r) * PROJW + nt * 128; });
        }
        __syncthreads();
    }
}

template <int NB> __device__ __forceinline__ void phase_inproj(const bf16* H, const bf16* Wt, bf16* PROJ, float* GATES, LAS unsigned char* lds) { phase_inproj_v<NB, 0>(H, Wt, PROJ, GATES, lds, true); }

template <int NB>
__device__ __forceinline__ void phase_conv(const bf16* PROJ, const float* cw, const float* cb, bf16* XBC) {
    constexpr int TL = NB * SEQ, T = NB * (SEQ + CTXL);
    for (size_t it = (size_t)blockIdx.x * NTHR + otid(); it < (size_t)T * 192; it += (size_t)gridDim.x * NTHR) {
        const int row = (int)(it / 192), c0 = (int)(it % 192) * 8;
        int t, L;
        if (row < TL) { t = row % SEQ; L = SEQ; } else { t = (row - TL) % CTXL; L = CTXL; }
        const bf16* p = PROJ + (size_t)row * PROJW + PC_XBC + c0;
        const u32x4 cur = *(const u32x4*)p;
        u32x4 prv = {0u, 0u, 0u, 0u}, nxt = {0u, 0u, 0u, 0u};
        if (t > 0) prv = *(const u32x4*)(p - PROJW);
        if (t < L - 1) nxt = *(const u32x4*)(p + PROJW);
        float o[8];
#pragma unroll
        for (int j = 0; j < 4; ++j) {
            const int c = c0 + 2 * j;
            o[2 * j] = bflo(prv[j]) * cw[c] + bflo(cur[j]) * cw[1536 + c] + bflo(nxt[j]) * cw[3072 + c] + cb[c];
            o[2 * j + 1] = bfhi(prv[j]) * cw[c + 1] + bfhi(cur[j]) * cw[1536 + c + 1] + bfhi(nxt[j]) * cw[3072 + c + 1] + cb[c + 1];
        }
        u32x4 r; r[0] = pk2(siluf(o[0]), siluf(o[1])); r[1] = pk2(siluf(o[2]), siluf(o[3])); r[2] = pk2(siluf(o[4]), siluf(o[5])); r[3] = pk2(siluf(o[6]), siluf(o[7]));
        *(u32x4*)(XBC + (size_t)row * 1536 + c0) = r;
    }
}
}
namespace fx {
constexpr int RS_X = 144, RS_N = 272;

template <int NB> __device__ __forceinline__ int scan_row(int b, int d, int step) {
    if (step < CTXL) return NB * SEQ + b * CTXL + (d ? CTXL - 1 - step : step);
    step -= CTXL; return b * SEQ + (d ? SEQ - 1 - step : step);
}
__device__ __forceinline__ bf16x8 scale_frag(bf16x8 v, f32x4 w0, f32x4 w1) {
    const u32x4 u = __builtin_bit_cast(u32x4, v);
    u32x4 o;
    o[0] = pk2(bflo(u[0]) * w0[0], bfhi(u[0]) * w0[1]); o[1] = pk2(bflo(u[1]) * w0[2], bfhi(u[1]) * w0[3]);
    o[2] = pk2(bflo(u[2]) * w1[0], bfhi(u[2]) * w1[1]); o[3] = pk2(bflo(u[3]) * w1[2], bfhi(u[3]) * w1[3]);
    return __builtin_bit_cast(bf16x8, o);
}

__device__ __forceinline__ void tr_issue(const LAS unsigned char* T, int RS, int k0, int c0, int lane, bf16x4& v0, bf16x4& v1) {
    const int h = lane >> 5, blk = (lane >> 4) & 1, q = (lane & 15) >> 2, p = lane & 3;
    const unsigned a0 = (unsigned)(size_t)(T + (k0 + 8 * h + q) * RS + (c0 + 16 * blk + 4 * p) * 2);
    const unsigned a1 = a0 + 4 * RS;
    asm volatile("ds_read_b64_tr_b16 %0, %2\n\tds_read_b64_tr_b16 %1, %3" : "=&v"(v0), "=&v"(v1) : "v"(a0), "v"(a1) : "memory");
}
__device__ __forceinline__ bf16x8 tr_join(bf16x4 v0, bf16x4 v1) { bf16x8 r; r[0] = v0[0]; r[1] = v0[1]; r[2] = v0[2]; r[3] = v0[3]; r[4] = v1[0]; r[5] = v1[1]; r[6] = v1[2]; r[7] = v1[3]; return r; }
#define TR_WAIT4(a, b, c, d) asm volatile("s_waitcnt lgkmcnt(0)" : "+v"(a), "+v"(b), "+v"(c), "+v"(d) :: "memory")
#define TR_WAIT8(a, b, c, d, e, f, g, h) asm volatile("s_waitcnt lgkmcnt(0)" : "+v"(a), "+v"(b), "+v"(c), "+v"(d), "+v"(e), "+v"(f), "+v"(g), "+v"(h) :: "memory")

constexpr int NSTEP = SEQ + CTXL;
template <int NB> struct ScanTab {
    static constexpr size_t SSD_TAB = 0, ML_TAB = SSD_TAB + (size_t)NB * 32 * NSTEP * 16, SSD_DEC = ML_TAB + (size_t)NB * 8 * NSTEP * 32,
                            ML_CH = SSD_DEC + (size_t)NB * 32 * 34 * 4, END = ML_CH + (size_t)NB * 8 * 68 * 8;
};
template <int NB>
__device__ __forceinline__ void phase_tables(const In& in, const float* GATES, unsigned char* tab, LAS unsigned char* lds) {
    typedef ScanTab<NB> ST;
    const int tid = otid(), lane = tid & 63, wave = tid >> 6;
    LAS float* l_g = (LAS float*)lds; LAS float* l_ml = l_g + 68; LAS float* l_mr = l_g + 136;
    for (int job = blockIdx.x; job < NB * 40; job += gridDim.x) {
        if (job < NB * 32) {
            const int b = job >> 5, d = (job >> 4) & 1, h = job & 15;
            const float a = -__expf(in.ssd_a_log[d * 16 + h]), dtb = in.ssd_dt_bias[d * 16 + h];
            f32x4* T4 = (f32x4*)(tab + ST::SSD_TAB) + (size_t)job * NSTEP; float* DEC = (float*)(tab + ST::SSD_DEC) + job * 34;
            for (int ch = wave; ch < 34; ch += NWAVE) {
                const float dt0 = softplusf(GATES[(size_t)scan_row<NB>(b, d, ch * 128 + lane) * 64 + d * 16 + h] + dtb);
                const float dt1 = softplusf(GATES[(size_t)scan_row<NB>(b, d, ch * 128 + 64 + lane) * 64 + d * 16 + h] + dtb);
                float v0 = dt0 * a, v1 = dt1 * a;
#pragma unroll
                for (int o = 1; o < 64; o <<= 1) { const float t0 = __shfl_up(v0, o), t1 = __shfl_up(v1, o); if (lane >= o) { v0 += t0; v1 += t1; } }
                v1 += __shfl(v0, 63);
                const float tot = __shfl(v1, 63);
                T4[ch * 128 + lane] = (f32x4){v0, dt0, dt0 * __expf(tot - v0), __expf(v0)};
                T4[ch * 128 + 64 + lane] = (f32x4){v1, dt1, dt1 * __expf(tot - v1), __expf(v1)};
                if (lane == 0) DEC[ch] = __expf(tot);
            }
        } else {
            const int j2 = job - NB * 32, b = j2 >> 3, d = (j2 >> 2) & 1, hh = j2 & 3;
            const float ib = in.ml_i_bias[d * 4 + hh], fb = in.ml_f_bias[d * 4 + hh];
            f32x4* T4 = (f32x4*)(tab + ST::ML_TAB) + (size_t)j2 * NSTEP * 2; float* CH = (float*)(tab + ST::ML_CH) + j2 * 68 * 2;
            float s_li[9], s_bc[9], s_mi[9], s_we[9];
            __syncthreads();
#pragma unroll
            for (int k = 0; k < 9; ++k) { const int ch = wave + 8 * k;
                s_li[k] = 0.f; s_bc[k] = 0.f; s_mi[k] = 0.f; s_we[k] = 0.f;
                if (ch < 68) {
                    const float* gp = GATES + (size_t)scan_row<NB>(b, d, ch * 64 + lane) * 64;
                    const float li = gp[32 + d * 4 + hh] + ib, lf = logsigf(gp[40 + d * 4 + hh] + fb);
                    float bc = lf;
#pragma unroll
                    for (int o = 1; o < 64; o <<= 1) { const float t = __shfl_up(bc, o); if (lane >= o) bc += t; }
                    float pm = li - bc;
#pragma unroll
                    for (int o = 1; o < 64; o <<= 1) { const float t = __shfl_up(pm, o); if (lane >= o) pm = fmaxf(pm, t); }
                    const float gtot = __shfl(bc, 63);
                    const float a_end = gtot - bc + li;
                    const float m_loc = wave_max(a_end);
                    s_li[k] = li; s_bc[k] = bc; s_mi[k] = bc + pm; s_we[k] = __expf(a_end - m_loc);
                    if (lane == 0) { l_g[ch] = gtot; l_ml[ch] = m_loc; }
                } }
            __syncthreads();
            if (tid == 0) { float m = 0.f;
                for (int ch = 0; ch < 68; ++ch) { const float g = l_g[ch], ml = l_ml[ch], mn = fmaxf(g + m, ml);
                    l_mr[ch] = m; CH[2 * ch] = __expf(g + m - mn); CH[2 * ch + 1] = __expf(ml - mn); m = mn; } }
            __syncthreads();
#pragma unroll
            for (int k = 0; k < 9; ++k) { const int ch = wave + 8 * k;
                if (ch < 68) {
                    const float m_inter = s_bc[k] + l_mr[ch], mt = fmaxf(s_mi[k], m_inter);
                    T4[(size_t)(ch * 64 + lane) * 2] = (f32x4){s_bc[k] - mt, s_li[k] - s_bc[k], __expf(m_inter - mt), s_we[k]};
                    T4[(size_t)(ch * 64 + lane) * 2 + 1] = (f32x4){__expf(-mt), 0.f, 0.f, 0.f};
                } }
        }
    }
}

template <int NB>
__device__ __forceinline__ void ssd_item(const bf16* XBC, const unsigned char* tab, bf16* SCb, int b, int d, int h, LAS unsigned char* lds) {
    typedef ScanTab<NB> ST;
    const int tid = otid(), lane = tid & 63, wave = tid >> 6, g = h >> 3, combo = b * 32 + d * 16 + h;
    LAS unsigned char* Xs = lds; LAS unsigned char* Bs = lds + 18432; LAS unsigned char* Cs = lds + 53248;
    LAS unsigned char* Ss = lds + 88064; LAS unsigned char* Ms = lds + 105472;
    LAS float* acs = (LAS float*)(lds + 140288); LAS float* dtv = acs + 128; LAS float* wv = acs + 256; LAS float* eav = acs + 384;
    const f32x4* T4 = (const f32x4*)(tab + ST::SSD_TAB) + (size_t)combo * NSTEP; const float* DEC = (const float*)(tab + ST::SSD_DEC) + combo * 34;
    f32x16 st;
#pragma unroll
    for (int r = 0; r < 16; ++r) st[r] = 0.f;
    constexpr int NCH = (CTXL + SEQ) / 128;
    u32x4 rx[2], rb[4], rc[4]; f32x4 rt = {0.f, 0.f, 0.f, 0.f}; float rdec = 0.f;
#define SSD_LOAD(ch) do { \
    _Pragma("unroll") for (int i = 0; i < 2; ++i) { const int idx = tid + 512 * i, l = idx >> 3, c = idx & 7; \
        rx[i] = *(const u32x4*)(XBC + (size_t)scan_row<NB>(b, d, (ch) * 128 + l) * 1536 + h * 64 + c * 8); } \
    _Pragma("unroll") for (int i = 0; i < 4; ++i) { const int idx = tid + 512 * i, l = idx >> 4, c = idx & 15; \
        const bf16* rp = XBC + (size_t)scan_row<NB>(b, d, (ch) * 128 + l) * 1536 + 1024 + g * 128 + c * 8; \
        rb[i] = *(const u32x4*)rp; rc[i] = *(const u32x4*)(rp + 256); } \
    if (tid < 128) rt = T4[(ch) * 128 + tid]; \
    rdec = DEC[ch]; } while (0)
    SSD_LOAD(0);
    const int pbw = wave >> 2, nbw = wave & 3;
    for (int ch = 0; ch < NCH; ++ch) {
#pragma unroll
        for (int i = 0; i < 2; ++i) { const int idx = tid + 512 * i, l = idx >> 3, c = idx & 7; *(LAS u32x4*)(Xs + l * RS_X + c * 16) = rx[i]; }
#pragma unroll
        for (int i = 0; i < 4; ++i) { const int idx = tid + 512 * i, l = idx >> 4, c = idx & 15;
            *(LAS u32x4*)(Bs + l * RS_N + c * 16) = rb[i]; *(LAS u32x4*)(Cs + l * RS_N + c * 16) = rc[i]; }
        if (tid < 128) { acs[tid] = rt[0]; dtv[tid] = rt[1]; wv[tid] = rt[2]; eav[tid] = rt[3]; }
        const float dec = rdec;
        {
            const int pp = 32 * pbw + (lane & 31);
#pragma unroll
            for (int gq = 0; gq < 4; ++gq) { u32x2 o; o[0] = pk2(st[4 * gq], st[4 * gq + 1]); o[1] = pk2(st[4 * gq + 2], st[4 * gq + 3]);
                *(LAS u32x2*)(Ss + pp * RS_N + (32 * nbw + 8 * gq + 4 * (lane >> 5)) * 2) = o; }
        }
        __syncthreads();
        if (ch + 1 < NCH) SSD_LOAD(ch + 1);
        {
            const int lbA = wave >> 1, sbp = wave & 1;
            const int l = 32 * lbA + (lane & 31);
            const float al = acs[l];
#pragma unroll
            for (int q = 0; q < 2; ++q) { const int sb = 2 * sbp + q;
                if (sb <= lbA) {
                    f32x16 cb;
#pragma unroll
                    for (int r = 0; r < 16; ++r) cb[r] = 0.f;
#pragma unroll
                    for (int kk = 0; kk < 8; ++kk) cb = mfma32(frag_row(Bs, RS_N, 32 * sb, 16 * kk, lane), frag_row(Cs, RS_N, 32 * lbA, 16 * kk, lane), cb);
#pragma unroll
                    for (int gq = 0; gq < 4; ++gq) { const int s0 = 32 * sb + 8 * gq + 4 * (lane >> 5);
                        const f32x4 as4 = *(const LAS f32x4*)(acs + s0), dt4 = *(const LAS f32x4*)(dtv + s0);
                        float m[4];
#pragma unroll
                        for (int j = 0; j < 4; ++j) m[j] = (s0 + j <= l) ? cb[4 * gq + j] * __expf(fminf(al - as4[j], 0.f)) * dt4[j] : 0.f;
                        u32x2 o; o[0] = pk2(m[0], m[1]); o[1] = pk2(m[2], m[3]);
                        *(LAS u32x2*)(Ms + l * RS_N + s0 * 2) = o; } } }
        }
        {
#pragma unroll
            for (int r = 0; r < 16; ++r) st[r] *= dec;
#pragma unroll
            for (int kb = 0; kb < 2; ++kb) {
                bf16x4 tx[4][2], tb[4][2];
#pragma unroll
                for (int k4 = 0; k4 < 4; ++k4) { tr_issue(Xs, RS_X, 16 * (4 * kb + k4), 32 * pbw, lane, tx[k4][0], tx[k4][1]); tr_issue(Bs, RS_N, 16 * (4 * kb + k4), 32 * nbw, lane, tb[k4][0], tb[k4][1]); }
                TR_WAIT8(tx[0][0], tx[0][1], tx[1][0], tx[1][1], tx[2][0], tx[2][1], tx[3][0], tx[3][1]);
                TR_WAIT8(tb[0][0], tb[0][1], tb[1][0], tb[1][1], tb[2][0], tb[2][1], tb[3][0], tb[3][1]);
#pragma unroll
                for (int k4 = 0; k4 < 4; ++k4) {
                    const int l0 = 16 * (4 * kb + k4) + 8 * (lane >> 5);
                    const f32x4 w0 = *(const LAS f32x4*)(wv + l0), w1 = *(const LAS f32x4*)(wv + l0 + 4);
                    st = mfma32(tr_join(tb[k4][0], tb[k4][1]), scale_frag(tr_join(tx[k4][0], tx[k4][1]), w0, w1), st);
                }
            }
        }
        __syncthreads();
        {
            const int pb = wave >> 2, lb = wave & 3;
            f32x16 acc;
#pragma unroll
            for (int r = 0; r < 16; ++r) acc[r] = 0.f;
#pragma unroll
            for (int kk = 0; kk < 8; ++kk) acc = mfma32(frag_row(Ss, RS_N, 32 * pb, 16 * kk, lane), frag_row(Cs, RS_N, 32 * lb, 16 * kk, lane), acc);
            const int l = 32 * lb + (lane & 31);
            const float ea = eav[l];
#pragma unroll
            for (int r = 0; r < 16; ++r) acc[r] *= ea;
            for (int sb = 0; sb <= lb; ++sb) {
                bf16x4 t0a, t0b, t1a, t1b;
                tr_issue(Xs, RS_X, 32 * sb, 32 * pb, lane, t0a, t0b); tr_issue(Xs, RS_X, 32 * sb + 16, 32 * pb, lane, t1a, t1b);
                const bf16x8 m0 = frag_row(Ms, RS_N, 32 * lb, 32 * sb, lane), m1 = frag_row(Ms, RS_N, 32 * lb, 32 * sb + 16, lane);
                TR_WAIT4(t0a, t0b, t1a, t1b);
                acc = mfma32(tr_join(t0a, t0b), m0, acc);
                acc = mfma32(tr_join(t1a, t1b), m1, acc);
            }
            bf16* yp = SCb + (size_t)scan_row<NB>(b, d, ch * 128 + l) * 4096 + d * 1024 + h * 64 + 32 * pb + 4 * (lane >> 5);
#pragma unroll
            for (int gq = 0; gq < 4; ++gq) { u32x2 o; o[0] = pk2(acc[4 * gq], acc[4 * gq + 1]); o[1] = pk2(acc[4 * gq + 2], acc[4 * gq + 3]); *(u32x2*)(yp + 8 * gq) = o; }
        }
        __syncthreads();
    }
#undef SSD_LOAD
}

template <int NB>
__device__ __forceinline__ void mlstm_item(const bf16* PROJ, const unsigned char* tab, bf16* SCb, int b, int d, int hh, int ev, LAS unsigned char* lds) {
    typedef ScanTab<NB> ST;
    const int tid = otid(), lane = tid & 63, wave = tid >> 6, combo = b * 8 + d * 4 + hh;
    LAS unsigned char* Qs = lds; LAS unsigned char* Ks = lds + 17408; LAS unsigned char* Vs = lds + 34816;
    LAS unsigned char* Ct = lds + 44032; LAS unsigned char* Sm = lds + 61440;
    LAS float* tb = (LAS float*)(lds + 70656);
    LAS float* t_u = tb, *t_v = tb + 64, *t_wi = tb + 128, *t_we = tb + 192, *t_em = tb + 256, *t_qn = tb + 320, *t_rs = tb + 384  , *t_n = tb + 480  ;
    const f32x4* T4 = (const f32x4*)(tab + ST::ML_TAB) + (size_t)combo * NSTEP * 2; const float* CH = (const float*)(tab + ST::ML_CH) + combo * 68 * 2;
    const float kscale = 0.08838834764831845f;
    f32x16 st;
#pragma unroll
    for (int r = 0; r < 16; ++r) st[r] = 0.f;
    if (tid < 128) t_n[tid] = 0.f;
    constexpr int NCH = (CTXL + SEQ) / 64;
    const int kbw = wave & 3, ebw = wave >> 2;
    u32x4 rq[2], rk[2], rv; f32x4 rt = {0.f, 0.f, 0.f, 0.f}; float ras = 0.f, rbb = 0.f;
#define ML_LOAD(ch) do { \
    _Pragma("unroll") for (int i = 0; i < 2; ++i) { const int idx = tid + 512 * i, l = idx >> 4, c = idx & 15; \
        const bf16* rp = PROJ + (size_t)scan_row<NB>(b, d, (ch) * 64 + l) * PROJW + hh * 128 + c * 8; \
        rq[i] = *(const u32x4*)(rp + PC_Q); rk[i] = *(const u32x4*)(rp + PC_K); } \
    { const int l = tid >> 3, c = tid & 7; rv = *(const u32x4*)(PROJ + (size_t)scan_row<NB>(b, d, (ch) * 64 + l) * PROJW + PC_V + hh * 256 + ev * 64 + c * 8); } \
    if (tid < 128) rt = T4[(size_t)(ch) * 128 + tid]; \
    ras = CH[2 * (ch)]; rbb = CH[2 * (ch) + 1]; } while (0)
    ML_LOAD(0);
    for (int ch = 0; ch < NCH; ++ch) {
#pragma unroll
        for (int i = 0; i < 2; ++i) { const int idx = tid + 512 * i, l = idx >> 4, c = idx & 15;
            *(LAS u32x4*)(Qs + l * RS_N + c * 16) = rq[i]; *(LAS u32x4*)(Ks + l * RS_N + c * 16) = rk[i]; }
        { const int l = tid >> 3, c = tid & 7; *(LAS u32x4*)(Vs + l * RS_X + c * 16) = rv; }
        if (tid < 128) { const int l = tid >> 1; if (tid & 1) t_em[l] = rt[0]; else { t_u[l] = rt[0]; t_v[l] = rt[1]; t_wi[l] = rt[2]; t_we[l] = rt[3]; } }
        const float a_s = ras, bbs = rbb;
        {
            const int ee = 32 * ebw + (lane & 31);
#pragma unroll
            for (int gq = 0; gq < 4; ++gq) { u32x2 o; o[0] = pk2(st[4 * gq], st[4 * gq + 1]); o[1] = pk2(st[4 * gq + 2], st[4 * gq + 3]);
                *(LAS u32x2*)(Ct + ee * RS_N + (32 * kbw + 8 * gq + 4 * (lane >> 5)) * 2) = o; }
        }
        __syncthreads();
        if (ch + 1 < NCH) ML_LOAD(ch + 1);
        f32x16 acc;
#pragma unroll
        for (int r = 0; r < 16; ++r) acc[r] = 0.f;
        int ebB = 0, lbB = 0;
        if (wave < 3) {
            const int sbA = wave == 2 ? 1 : 0, lbA = wave == 0 ? 0 : 1;
#pragma unroll
            for (int kk = 0; kk < 8; ++kk) acc = mfma32(frag_row(Ks, RS_N, 32 * sbA, 16 * kk, lane), frag_row(Qs, RS_N, 32 * lbA, 16 * kk, lane), acc);
            const int l = 32 * lbA + (lane & 31);
            const float ul = t_u[l];
            float rsum = 0.f;
#pragma unroll
            for (int gq = 0; gq < 4; ++gq) { const int s0 = 32 * sbA + 8 * gq + 4 * (lane >> 5);
                const f32x4 v4 = *(const LAS f32x4*)(t_v + s0);
                float m[4];
#pragma unroll
                for (int j = 0; j < 4; ++j) { m[j] = (s0 + j <= l) ? acc[4 * gq + j] * kscale * __expf(fminf(ul + v4[j], 0.f)) : 0.f; rsum += m[j]; }
                u32x2 o; o[0] = pk2(m[0], m[1]); o[1] = pk2(m[2], m[3]);
                *(LAS u32x2*)(Sm + l * RS_X + s0 * 2) = o; }
            rsum += __shfl_xor(rsum, 32);
            if (lane < 32) t_rs[wave * 32 + lane] = rsum;
        } else if (wave == 3) {
            float qn = 0.f;
#pragma unroll 4
            for (int c = 0; c < 16; ++c) { const u32x4 qv = *(const LAS u32x4*)(Qs + lane * RS_N + c * 16);
                const f32x4 n0 = *(const LAS f32x4*)(t_n + c * 8), n1 = *(const LAS f32x4*)(t_n + c * 8 + 4);
                qn += bflo(qv[0]) * n0[0] + bfhi(qv[0]) * n0[1] + bflo(qv[1]) * n0[2] + bfhi(qv[1]) * n0[3]
                    + bflo(qv[2]) * n1[0] + bfhi(qv[2]) * n1[1] + bflo(qv[3]) * n1[2] + bfhi(qv[3]) * n1[3]; }
            t_qn[lane] = qn;
        } else {
            ebB = (wave - 4) >> 1; lbB = (wave - 4) & 1;
#pragma unroll
            for (int kk = 0; kk < 8; ++kk) acc = mfma32(frag_row(Ct, RS_N, 32 * ebB, 16 * kk, lane), frag_row(Qs, RS_N, 32 * lbB, 16 * kk, lane), acc);
            const float wi = t_wi[32 * lbB + (lane & 31)];
#pragma unroll
            for (int r = 0; r < 16; ++r) acc[r] *= wi;
        }
        {
#pragma unroll
            for (int r = 0; r < 16; ++r) st[r] *= a_s;
            const float f = bbs * kscale;
            bf16x4 tk[4][2], tv[4][2];
#pragma unroll
            for (int kk = 0; kk < 4; ++kk) { tr_issue(Ks, RS_N, 16 * kk, 32 * kbw, lane, tk[kk][0], tk[kk][1]); tr_issue(Vs, RS_X, 16 * kk, 32 * ebw, lane, tv[kk][0], tv[kk][1]); }
            TR_WAIT8(tk[0][0], tk[0][1], tk[1][0], tk[1][1], tk[2][0], tk[2][1], tk[3][0], tk[3][1]);
            TR_WAIT8(tv[0][0], tv[0][1], tv[1][0], tv[1][1], tv[2][0], tv[2][1], tv[3][0], tv[3][1]);
#pragma unroll
            for (int kk = 0; kk < 4; ++kk) {
                const int l0 = 16 * kk + 8 * (lane >> 5);
                f32x4 w0 = *(const LAS f32x4*)(t_we + l0), w1 = *(const LAS f32x4*)(t_we + l0 + 4);
#pragma unroll
                for (int j = 0; j < 4; ++j) { w0[j] *= f; w1[j] *= f; }
                st = mfma32(scale_frag(tr_join(tk[kk][0], tk[kk][1]), w0, w1), tr_join(tv[kk][0], tv[kk][1]), st);
            }
        }
        __syncthreads();
        if (wave >= 4) {
            for (int sb = 0; sb <= lbB; ++sb) {
                bf16x4 t0a, t0b, t1a, t1b;
                tr_issue(Vs, RS_X, 32 * sb, 32 * ebB, lane, t0a, t0b); tr_issue(Vs, RS_X, 32 * sb + 16, 32 * ebB, lane, t1a, t1b);
                const bf16x8 m0 = frag_row(Sm, RS_X, 32 * lbB, 32 * sb, lane), m1 = frag_row(Sm, RS_X, 32 * lbB, 32 * sb + 16, lane);
                TR_WAIT4(t0a, t0b, t1a, t1b);
                acc = mfma32(tr_join(t0a, t0b), m0, acc);
                acc = mfma32(tr_join(t1a, t1b), m1, acc);
            }
            const int l = 32 * lbB + (lane & 31), lr = lane & 31;
            const float rsum = lbB == 0 ? t_rs[lr] : t_rs[32 + lr] + t_rs[64 + lr];
            float den = rsum + t_qn[l] * t_wi[l];
            den = fmaxf(fabsf(den), t_em[l]);
            const float inv = 1.f / den;
            bf16* hp = SCb + (size_t)scan_row<NB>(b, d, ch * 64 + l) * 4096 + 2048 + d * 1024 + hh * 256 + ev * 64 + 32 * ebB + 4 * (lane >> 5);
#pragma unroll
            for (int gq = 0; gq < 4; ++gq) { u32x2 o; o[0] = pk2(acc[4 * gq] * inv, acc[4 * gq + 1] * inv); o[1] = pk2(acc[4 * gq + 2] * inv, acc[4 * gq + 3] * inv); *(u32x2*)(hp + 8 * gq) = o; }
        } else if (wave < 2) {
            float s = 0.f;
#pragma unroll 16
            for (int l = 0; l < 64; ++l) s += t_we[l] * bf2f(*(const LAS bf16*)(Ks + l * RS_N + tid * 2));
            t_n[tid] = a_s * t_n[tid] + bbs * kscale * s;
        }
        __syncthreads();
    }
#undef ML_LOAD
}

template <int NB>
__device__ __forceinline__ void phase_scan(const bf16* PROJ, const unsigned char* tab, const bf16* XBC, bf16* SCb, LAS unsigned char* lds, int mode = 3) {
    const int G = gridDim.x;
    if (mode & 1) for (int item = blockIdx.x; item < NB * 32; item += G) { const int b = item / 32, d = (item >> 4) & 1, h = item & 15;
        ssd_item<NB>(XBC, tab, SCb, b, d, h, lds); }
    const int v = (blockIdx.x + G - (NB * 32) % G) % G;
    if (mode & 2) for (int it = v; it < NB * 32; it += G) { const int b = it / 32, d = (it >> 4) & 1, hh = (it >> 2) & 3, ev = it & 3;
        mlstm_item<NB>(PROJ, tab, SCb, b, d, hh, ev, lds); }
}

template <int NB>
__device__ __forceinline__ void phase_mixer_out(const In& in, const bf16* PROJ, const bf16* XBC, bf16* SCb) {
    constexpr int T = NB * (SEQ + CTXL);
    const int lane = otid() & 63, wave = otid() >> 6;
    for (int row = blockIdx.x * NWAVE + wave; row < T; row += gridDim.x * NWAVE) {
        bf16* sc = SCb + (size_t)row * 4096;
        const bf16* pr = PROJ + (size_t)row * PROJW;
        float yv[16], hv[16], ss = 0.f, hs[2] = {0.f, 0.f};
#pragma unroll
        for (int i = 0; i < 2; ++i) { const int c = lane * 8 + 512 * i;
            const u32x4 y0 = *(const u32x4*)(sc + c), y1 = *(const u32x4*)(sc + 1024 + c), h0 = *(const u32x4*)(sc + 2048 + c), h1 = *(const u32x4*)(sc + 3072 + c);
            const u32x4 xs = *(const u32x4*)(XBC + (size_t)row * 1536 + c), z = *(const u32x4*)(pr + PC_Z + c);
            const float dk = in.ssd_d[c >> 6];
#pragma unroll
            for (int j = 0; j < 4; ++j) {
                float a0 = bflo(y0[j]) + bflo(y1[j]) + dk * bflo(xs[j]), a1 = bfhi(y0[j]) + bfhi(y1[j]) + dk * bfhi(xs[j]);
                a0 *= siluf(bflo(z[j])); a1 *= siluf(bfhi(z[j]));
                yv[8 * i + 2 * j] = a0; yv[8 * i + 2 * j + 1] = a1; ss += a0 * a0 + a1 * a1;
                const float b0 = bflo(h0[j]) + bflo(h1[j]), b1 = bfhi(h0[j]) + bfhi(h1[j]);
                hv[8 * i + 2 * j] = b0; hv[8 * i + 2 * j + 1] = b1; hs[i] += b0 * b0 + b1 * b1; } }
        ss = wave_sum(ss);
        const float rs = rsqrtf(ss * (1.f / 1024.f) + 1e-6f);
#pragma unroll
        for (int i = 0; i < 2; ++i) {
#pragma unroll
            for (int o = 16; o > 0; o >>= 1) hs[i] += __shfl_xor(hs[i], o);
            hs[i] = rsqrtf(hs[i] * (1.f / 256.f) + 1e-6f); }
        __builtin_amdgcn_s_waitcnt(0);
#pragma unroll
        for (int i = 0; i < 2; ++i) { const int c = lane * 8 + 512 * i;
            const u32x4 ov = *(const u32x4*)(pr + PC_O + c);
            u32x4 oy, oh;
#pragma unroll
            for (int j = 0; j < 4; ++j) {
                oy[j] = pk2(yv[8 * i + 2 * j] * rs * in.ssd_norm_w[c + 2 * j], yv[8 * i + 2 * j + 1] * rs * in.ssd_norm_w[c + 2 * j + 1]);
                oh[j] = pk2(hv[8 * i + 2 * j] * hs[i] * in.ml_norm_w[c + 2 * j] * sigmf(bflo(ov[j])), hv[8 * i + 2 * j + 1] * hs[i] * in.ml_norm_w[c + 2 * j + 1] * sigmf(bfhi(ov[j]))); }
            *(u32x4*)(sc + c) = oy; *(u32x4*)(sc + 1024 + c) = oh; }
    }
}

template <int NB>
__device__ __forceinline__ void phase_outproj(const bf16* A, int lda, int K, const bf16* Wt, int nrows, const float* xl, const float* xc, const float* modl, float* Xout,
                                              LAS unsigned char* lds) {
    constexpr int TL = NB * SEQ;
    const int MT = nrows / 256;
    for (int r = 0; r * (int)gridDim.x < MT * 8; ++r) {
        const int u = xcd_unit(r); if (u >= MT * 8) continue;
        int mt, nt; unit_tile(u, MT, 8, mt, nt);
        const bf16* arow[4];
#pragma unroll
        for (int i = 0; i < 4; ++i) arow[i] = A + (size_t)(mt * 256 + (otid() >> 3) + 64 * i) * lda;
        gemm_tile(arow, Wt + (size_t)nt * 128 * K, K, K, lds, [&](const f32x16 (&acc)[2][2], int wm, int wn, int lane) { stage_f32_128(acc, lds, wm, wn, lane); });
        __syncthreads();
        {
            const float* mv = modl + (size_t)mod_row<NB>(mt * 256) * 6144 + 2 * 1024 + nt * 128;
            const int t = otid(), piece = t & 31;
            const f32x4 m2 = *(const f32x4*)(mv + piece * 4);
#pragma unroll 4
            for (int it = 0; it < 16; ++it) { const int rl = it * 16 + (t >> 5), row = mt * 256 + rl;
                const f32x4 a = *(const LAS f32x4*)(lds + rl * CST_F32 + piece * 16);
                const float* srcp = (row < TL ? xl + (size_t)row * D : xc + (size_t)(row - TL) * D) + nt * 128 + piece * 4;
                const f32x4 xv = *(const f32x4*)srcp;
                f32x4 o;
#pragma unroll
                for (int j = 0; j < 4; ++j) o[j] = xv[j] + m2[j] * a[j];
                *(f32x4*)(Xout + (size_t)row * D + nt * 128 + piece * 4) = o; }
        }
        __syncthreads();
    }
}
}
namespace fx {
__device__ __forceinline__ int moe_prefix(const int* cnt, LAS int* pre  ) {
    __syncthreads();
    if (otid() < 64) {
        const int lane = otid();
        int v = lane < 32 ? (cnt[lane * 64] + 255) >> 8 : 0;
#pragma unroll
        for (int o = 1; o < 32; o <<= 1) { const int t = __shfl_up(v, o); if (lane >= o) v += t; }
        if (lane < 32) pre[lane + 1] = v;
        if (lane == 0) pre[0] = 0;
    }
    __syncthreads();
    return pre[32];
}
__device__ __forceinline__ int moe_find(const LAS int* pre, int t) { int e = 0;
#pragma unroll
    for (int i = 1; i < 32; ++i) e += (t >= pre[i]) ? 1 : 0;
    return e; }

__device__ __forceinline__ void phase_moe_up(const bf16* H2, const bf16* Wgu, const int* cnt, const int* list, int cap, const float* route_w, bf16* ACT, LAS unsigned char* lds) {
    LAS int* pre = (LAS int*)(lds + GEMM_LDS);
    const int ntile = moe_prefix(cnt, pre);
    for (int r = 0; r * (int)gridDim.x < ntile * 8; ++r) {
        const int u = xcd_unit(r); if (u >= ntile * 8) continue;
        const int t = u >> 3, nt = u & 7, e = moe_find(pre, t), mt = t - pre[e], ce = cnt[e * 64];
        const int* le = list + (size_t)e * cap + mt * 256;
        const int nvalid = ce - mt * 256;
        const bf16* arow[4];
#pragma unroll
        for (int i = 0; i < 4; ++i) { const int r = (otid() >> 3) + 64 * i; const int ent = le[r < nvalid ? r : 0]; arow[i] = H2 + (size_t)(ent >> 1) * D; }
        gemm_tile(arow, Wgu + (size_t)e * 1024 * 1024 + (size_t)nt * 128 * 1024, 1024, 1024, lds, [&](const f32x16 (&acc)[2][2], int wm, int wn, int lane) {
#pragma unroll
            for (int mi = 0; mi < 2; ++mi) { const int r = wm * 64 + mi * 32 + (lane & 31);
                const float w = r < nvalid ? route_w[le[r]] : 0.f;
                LAS unsigned char* rp = lds + r * CST_BF64 + (wn * 32 + 4 * (lane >> 5)) * 2;
#pragma unroll
                for (int g = 0; g < 4; ++g) { float v[4];
#pragma unroll
                    for (int j = 0; j < 4; ++j) v[j] = siluf(acc[mi][0][4 * g + j]) * acc[mi][1][4 * g + j] * w;
                    u32x2 o; o[0] = pk2(v[0], v[1]); o[1] = pk2(v[2], v[3]); *(LAS u32x2*)(rp + 8 * g * 2) = o; } }
        });
        __syncthreads();
        flush_bf16_64(lds, [&](int r) -> bf16* { return r < nvalid ? ACT + (size_t)le[r] * 512 + nt * 64 : nullptr; });
        __syncthreads();
    }
}
__device__ __forceinline__ void phase_moe_down(const bf16* ACT, const bf16* Wd, const int* cnt, const int* list, int cap, bf16* Y2, LAS unsigned char* lds) {
    LAS int* pre = (LAS int*)(lds + GEMM_LDS);
    const int ntile = moe_prefix(cnt, pre);
    for (int r = 0; r * (int)gridDim.x < ntile * 8; ++r) {
        const int u = xcd_unit(r); if (u >= ntile * 8) continue;
        const int t = u >> 3, nt = u & 7, e = moe_find(pre, t), mt = t - pre[e], ce = cnt[e * 64];
        const int* le = list + (size_t)e * cap + mt * 256;
        const int nvalid = ce - mt * 256;
        const bf16* arow[4];
#pragma unroll
        for (int i = 0; i < 4; ++i) { const int r = (otid() >> 3) + 64 * i; const int ent = le[r < nvalid ? r : 0]; arow[i] = ACT + (size_t)ent * 512; }
        gemm_tile(arow, Wd + (size_t)e * 1024 * 512 + (size_t)nt * 128 * 512, 512, 512, lds, [&](const f32x16 (&acc)[2][2], int wm, int wn, int lane) {
#pragma unroll
            for (int mi = 0; mi < 2; ++mi) { const int r = wm * 64 + mi * 32 + (lane & 31);
                if (r < nvalid) { const int ent = le[r];
                    bf16* op = Y2 + (size_t)ent * D + nt * 128 + wn * 64 + 4 * (lane >> 5);
#pragma unroll
                    for (int ni = 0; ni < 2; ++ni)
#pragma unroll
                        for (int g = 0; g < 4; ++g) { u32x2 o; o[0] = pk2(acc[mi][ni][4 * g], acc[mi][ni][4 * g + 1]); o[1] = pk2(acc[mi][ni][4 * g + 2], acc[mi][ni][4 * g + 3]);
                            *(u32x2*)(op + ni * 32 + 8 * g) = o; } } }
        });
    }
}

template <int NB>
__device__ __forceinline__ void phase_qkv(const bf16* H, const bf16* Wt, const float* qn, const float* kn, bf16* QKV, LAS unsigned char* lds) {
    constexpr int T = NB * (SEQ + CTXL), MT = T / 256;
    for (int r = 0; r * (int)gridDim.x < MT * 24; ++r) {
        const int u = xcd_unit(r); if (u >= MT * 24) continue;
        int mt, nt; unit_tile(u, MT, 24, mt, nt);
        const bf16* arow[4];
#pragma unroll
        for (int i = 0; i < 4; ++i) arow[i] = H + (size_t)(mt * 256 + (otid() >> 3) + 64 * i) * D;
        gemm_tile(arow, Wt + (size_t)nt * 128 * D, D, D, lds, [&](const f32x16 (&acc)[2][2], int wm, int wn, int lane) {
            const int which = nt >> 3;
#pragma unroll
            for (int mi = 0; mi < 2; ++mi) {
                float rs = 1.f;
                if (which < 2) { float ss = 0.f;
#pragma unroll
                    for (int ni = 0; ni < 2; ++ni)
#pragma unroll
                        for (int r = 0; r < 16; ++r) ss += acc[mi][ni][r] * acc[mi][ni][r];
                    ss += __shfl_xor(ss, 32);
                    rs = rsqrtf(ss * (1.f / 64.f) + 1e-6f) * (which == 0 ? 0.125f : 1.f); }
                const float* nwp = which == 0 ? qn : kn;
                LAS unsigned char* rp = lds + (wm * 64 + mi * 32 + (lane & 31)) * CST_BF + (wn * 64 + 4 * (lane >> 5)) * 2;
#pragma unroll
                for (int ni = 0; ni < 2; ++ni)
#pragma unroll
                    for (int g = 0; g < 4; ++g) { float v[4];
#pragma unroll
                        for (int j = 0; j < 4; ++j) { v[j] = acc[mi][ni][4 * g + j]; if (which < 2) v[j] *= rs * nwp[ni * 32 + 8 * g + 4 * (lane >> 5) + j]; }
                        u32x2 o; o[0] = pk2(v[0], v[1]); o[1] = pk2(v[2], v[3]); *(LAS u32x2*)(rp + (ni * 32 + 8 * g) * 2) = o; } }
        });
        __syncthreads();
        flush_bf16_128(lds, [&](int r) { return QKV + (size_t)(mt * 256 + r) * 3072 + nt * 128; });
        __syncthreads();
    }
}

__device__ __forceinline__ bf16x8 frag16_row(const LAS unsigned char* T, int RS, int r0, int c0, int lane) {
    return *(const LAS bf16x8*)(T + (r0 + (lane & 15)) * RS + (c0 + 8 * (lane >> 4)) * 2);
}
__device__ __forceinline__ bf16x8 frag16_vt(const LAS unsigned char* T, int RS, int kb, int c0, int lane) {
    const int g4 = lane >> 4, q = (lane & 15) >> 2, p = lane & 3;
    const unsigned a0 = (unsigned)(size_t)(T + (kb + 4 * g4 + q) * RS + (c0 + 4 * p) * 2);
    const unsigned a1 = a0 + 16 * RS;
    bf16x4 v0, v1;
    asm volatile("ds_read_b64_tr_b16 %0, %2\n\tds_read_b64_tr_b16 %1, %3\n\ts_waitcnt lgkmcnt(0)" : "=&v"(v0), "=&v"(v1) : "v"(a0), "v"(a1) : "memory");
    bf16x8 r; r[0] = v0[0]; r[1] = v0[1]; r[2] = v0[2]; r[3] = v0[3]; r[4] = v1[0]; r[5] = v1[1]; r[6] = v1[2]; r[7] = v1[3];
    return r;
}

template <int NB>
__device__ __forceinline__ void phase_attn(const bf16* QKV, const float* rpb, bf16* AO, LAS unsigned char* lds) {
    constexpr int TL = NB * SEQ;
    constexpr int TILE = 64 * RS_N;
    const int tid = otid(), lane = tid & 63, wave = tid >> 6, w = wave & 3, hsel = wave >> 2;
    const int qi = lane & 15, g4 = lane >> 4;
    LAS float* rp = (LAS float*)(lds + 4 * TILE);
    for (int u = blockIdx.x; u < NB * 64 * 8; u += gridDim.x) {
        const int hp = u & 7, r = (u >> 3) & 63, b = u >> 9;
        const int head = 2 * hp + hsel;
        int r0 = r - 4; r0 = r0 < 0 ? 0 : (r0 > 56 ? 56 : r0);
        __syncthreads();
        for (int i = tid; i < 2 * 465; i += NTHR) rp[i] = rpb[(size_t)(2 * hp) * 465 + i];
        const int c = 16 * w + qi;
        const size_t qrow = (size_t)b * SEQ + r * 64 + c;
        const bf16x8 q0 = *(const bf16x8*)(QKV + qrow * 3072 + head * 64 + 8 * g4), q1 = *(const bf16x8*)(QKV + qrow * 3072 + head * 64 + 32 + 8 * g4);
        int cs = c - 8; cs = cs < 0 ? 0 : (cs > 48 ? 48 : cs);
        const int kbw = w == 0 ? 0 : (w == 1 ? 8 : (w == 2 ? 24 : 32));
        f32x4 oacc[4];
#pragma unroll
        for (int i = 0; i < 4; ++i) oacc[i] = (f32x4){0.f, 0.f, 0.f, 0.f};
        float m_run = -3.0e38f, l_run = 0.f;
        u32x4 sk[2], sv[2];
#define AT_LOAD(it) do { \
        _Pragma("unroll") for (int i = 0; i < 2; ++i) { const int idx = tid + 512 * i, key = idx >> 4, ch = idx & 15; \
            const size_t krow = (it) < 8 ? (size_t)b * SEQ + (size_t)(r0 + (it)) * 64 + key : (size_t)TL + (size_t)b * CTXL + ((it) - 8) * 64 + key; \
            const bf16* kp = QKV + krow * 3072 + 1024 + hp * 128 + ch * 8; sk[i] = *(const u32x4*)kp; sv[i] = *(const u32x4*)(kp + 1024); } } while (0)
#define AT_STORE(buf) do { LAS unsigned char* kt_ = lds + (buf) * 2 * TILE; \
        _Pragma("unroll") for (int i = 0; i < 2; ++i) { const int idx = tid + 512 * i, key = idx >> 4, ch = idx & 15; \
            *(LAS u32x4*)(kt_ + key * RS_N + ch * 16) = sk[i]; *(LAS u32x4*)(kt_ + TILE + key * RS_N + ch * 16) = sv[i]; } } while (0)
        AT_LOAD(0);
        AT_STORE(0);
        __syncthreads();
        for (int it = 0; it < 12; ++it) {
            const LAS unsigned char* Kt = lds + (it & 1) * 2 * TILE; const LAS unsigned char* Vt = Kt + TILE;
            if (it + 1 < 12) AT_LOAD(it + 1);
            const int ngrp = it < 8 ? 1 : 2;
            for (int grp = 0; grp < ngrp; ++grp) {
                const int kb = it < 8 ? kbw : 32 * grp;
                f32x4 s[2];
#pragma unroll
                for (int sb = 0; sb < 2; ++sb) { s[sb] = (f32x4){0.f, 0.f, 0.f, 0.f};
                    s[sb] = mfma16(frag16_row(Kt, RS_N, kb + 16 * sb, hsel * 64, lane), q0, s[sb]);
                    s[sb] = mfma16(frag16_row(Kt, RS_N, kb + 16 * sb, hsel * 64 + 32, lane), q1, s[sb]); }
                float mx = -3.0e38f;
#pragma unroll
                for (int sb = 0; sb < 2; ++sb)
#pragma unroll
                    for (int j = 0; j < 4; ++j) {
                        if (it < 8) { const int kc = kb + 16 * sb + 4 * g4 + j; const bool ok = kc >= cs && kc < cs + 16;
                            const int bi = (r0 + it - r + 7) * 31 + (kc - c + 15);
                            s[sb][j] = ok ? s[sb][j] + rp[hsel * 465 + (ok ? bi : 0)] : -3.0e38f; }
                        mx = fmaxf(mx, s[sb][j]); }
                mx = fmaxf(mx, __shfl_xor(mx, 16)); mx = fmaxf(mx, __shfl_xor(mx, 32));
                const float mn = fmaxf(m_run, mx);
                const float alpha = __expf(m_run - mn);
                float ps = 0.f; float p[8];
#pragma unroll
                for (int sb = 0; sb < 2; ++sb)
#pragma unroll
                    for (int j = 0; j < 4; ++j) { const float e = s[sb][j] > -1.0e38f ? __expf(s[sb][j] - mn) : 0.f; p[4 * sb + j] = e; ps += e; }
                l_run = l_run * alpha + ps; m_run = mn;
                u32x4 pu; pu[0] = pk2(p[0], p[1]); pu[1] = pk2(p[2], p[3]); pu[2] = pk2(p[4], p[5]); pu[3] = pk2(p[6], p[7]);
                const bf16x8 pf = __builtin_bit_cast(bf16x8, pu);
#pragma unroll
                for (int db = 0; db < 4; ++db) {
#pragma unroll
                    for (int j = 0; j < 4; ++j) oacc[db][j] *= alpha;
                    oacc[db] = mfma16(frag16_vt(Vt, RS_N, kb, hsel * 64 + 16 * db, lane), pf, oacc[db]); }
            }
            if (it + 1 < 12) AT_STORE((it + 1) & 1);
            __syncthreads();
        }
#undef AT_LOAD
#undef AT_STORE
        l_run += __shfl_xor(l_run, 16); l_run += __shfl_xor(l_run, 32);
        const float inv = 1.f / l_run;
        bf16* op = AO + qrow * D + head * 64 + 4 * g4;
#pragma unroll
        for (int db = 0; db < 4; ++db) { u32x2 o; o[0] = pk2(oacc[db][0] * inv, oacc[db][1] * inv); o[1] = pk2(oacc[db][2] * inv, oacc[db][3] * inv); *(u32x2*)(op + 16 * db) = o; }
    }
}
}
#define XB_TMO      128
#define XB_XCNT(j)  (256  + 64 * (j))
#define XB_XSUB(j)  (1280 + 64 * (j))
#define XB_XGEN(j)  (2304 + 64 * (j))
#define XB_TOP      3328
#define XB_TOPGEN   3392
#define XCD_BAR_WORDS 3456
#define XB_SPIN_CAP (1u << 18)

__device__ __forceinline__ unsigned xb_ld(unsigned* p)              { return __hip_atomic_load(p, __ATOMIC_RELAXED, __HIP_MEMORY_SCOPE_AGENT); }
__device__ __forceinline__ unsigned xb_add(unsigned* p, unsigned v) { return __hip_atomic_fetch_add(p, v, __ATOMIC_RELAXED, __HIP_MEMORY_SCOPE_AGENT); }
__device__ __forceinline__ unsigned xb_xcc_id() { return (unsigned)__builtin_amdgcn_s_getreg((3 << 11) | 20) & 0xFu; }
#define XB_SPIN(cond, bar) do { unsigned _sp = 0; while (cond) { __builtin_amdgcn_s_sleep(1); \
    if ((++_sp & 255u) == 0u) { if (xb_ld(&(bar)[XB_TMO])) break; if (_sp > XB_SPIN_CAP) { atomicAdd(&(bar)[XB_TMO], 1u); break; } } } } while (0)

struct XcdBarrier {
    unsigned* bar; unsigned x;
    volatile LAS unsigned* st;
};

__device__ __forceinline__ XcdBarrier xcd_barrier_post(unsigned* bar, volatile LAS unsigned* st) {
    XcdBarrier b; b.bar = bar; b.x = xb_xcc_id(); b.st = st;
    if (threadIdx.x == 0) (void)xb_add(&bar[XB_XCNT(b.x)], 1u);
    return b;
}
__device__ __forceinline__ void xcd_barrier_complete(unsigned* bar, unsigned x, unsigned& nloc, unsigned& nx) {
    const unsigned G = gridDim.x * gridDim.y * gridDim.z;
    unsigned sum, cnt, mine, sp = 0u;
    for (;;) {
        sum = 0u; cnt = 0u; mine = 0u;
#pragma unroll
        for (unsigned j = 0; j < 16; ++j) { const unsigned c = xb_ld(&bar[XB_XCNT(j)]); sum += c; cnt += (c > 0u) ? 1u : 0u; mine = (j == x) ? c : mine; }
        if (sum == G) break;
        __builtin_amdgcn_s_sleep(1);
        if ((++sp & 255u) == 0u) { if (xb_ld(&bar[XB_TMO])) break; if (sp > XB_SPIN_CAP) { atomicAdd(&bar[XB_TMO], 1u); break; } }
    }
    nloc = mine > 0u ? mine : 1u; nx = cnt > 0u ? cnt : 1u;
}

__device__ __forceinline__ void xcd_barrier(const XcdBarrier& b) {
    asm volatile("s_waitcnt vmcnt(0)" ::: "memory");
    __syncthreads();
    if (threadIdx.x == 0) {
        unsigned* bar = b.bar;
        __builtin_amdgcn_s_waitcnt(0);
        unsigned nloc = b.st[0], nx = b.st[1];
        if (nloc == 0u) { xcd_barrier_complete(bar, b.x, nloc, nx); b.st[0] = nloc; b.st[1] = nx; }
        const unsigned old = xb_add(&bar[XB_XSUB(b.x)], 1u);
        const unsigned gen = old / nloc;
        if (old + 1u == (gen + 1u) * nloc) {
            __builtin_amdgcn_fence(__ATOMIC_RELEASE, "agent");
            asm volatile("s_waitcnt vmcnt(0)" ::: "memory");
            const unsigned og = xb_add(&bar[XB_TOP], 1u);
            const unsigned tg = og / nx;
            if (og + 1u == (tg + 1u) * nx) xb_add(&bar[XB_TOPGEN], 1u);
            else XB_SPIN(xb_ld(&bar[XB_TOPGEN]) == tg, bar);
            __builtin_amdgcn_fence(__ATOMIC_ACQUIRE, "agent");
            xb_add(&bar[XB_XGEN(b.x)], 1u);
            asm volatile("s_waitcnt vmcnt(0)" ::: "memory");
        } else {
            XB_SPIN(xb_ld(&bar[XB_XGEN(b.x)]) == gen, bar);
            __builtin_amdgcn_fence(__ATOMIC_ACQUIRE, "agent");
            asm volatile("s_waitcnt vmcnt(0)" ::: "memory");
        }
    }
    __syncthreads();
}
namespace mk {
using namespace fx;
constexpr int NB = 4;
typedef Plan<NB> PL;

__global__ void __launch_bounds__(512, 2) k_mega(P p) {
    extern __shared__ __attribute__((aligned(16))) unsigned char lds_raw[];
    LAS unsigned char* lds = (LAS unsigned char*)lds_raw;
    unsigned char* ws = p.ws;
    const In& in = p.in;
    LAS unsigned* xbw = (LAS unsigned*)(lds + LDS_BYTES - 16);
    if (threadIdx.x == 0) { xbw[0] = 0u; xbw[1] = 0u; xbw[2] = 0u; xbw[3] = 0u; }
    __syncthreads();
    XcdBarrier bar = xcd_barrier_post((unsigned*)(ws + PL::CTL_BAR), (volatile LAS unsigned*)xbw);
    float* modv = (float*)(ws + PL::MODV);
    const float* mod0 = modv; const float* mod1 = modv + 5 * 6144;
    bf16* H = (bf16*)(ws + PL::H);
    int* cnt0 = (int*)(ws + PL::CTL_CNT); int* cnt1 = cnt0 + 32 * 64;
    int* list = (int*)(ws + PL::LIST); float* rw = (float*)(ws + PL::RW);
    bf16* wmoe0 = (bf16*)(ws + PL::W_MOE0); bf16* wmoe1 = (bf16*)(ws + PL::W_MOE1);
    const size_t GU = (size_t)32 * 1024 * 1024;
    float* X1 = (float*)(ws + PL::X1); float* X2 = (float*)(ws + PL::X2); float* X3 = (float*)(ws + PL::X3);
#ifndef REPMASK
#define REPMASK 0
#endif
#ifndef XBAR
#define XBAR 0
#endif
#define PH(k, ...) { __VA_ARGS__; xcd_barrier(bar); if ((REPMASK >> (k)) & 1) { __VA_ARGS__; xcd_barrier(bar); } }
    PH(0, conv_small_weights(in, ws, PL::W_IN, PL::W_OUT, PL::W_QKV, PL::W_NAO, lds); mod_vectors(in, modv, lds); conv_moe_weights(in, 0, wmoe0, wmoe0 + GU, lds))
    for (int i = 0; i < XBAR; ++i) xcd_barrier(bar);
    PH(1, rows_phase<NB, false, false, true, false>(in.x, in.ctx, PL::T, nullptr, mod0, mod0, nullptr, nullptr, in.norm1_w, 0, 1, H,
                                              nullptr, nullptr, nullptr, nullptr, nullptr, nullptr, nullptr, 0, lds))
    phase_inproj<NB>(H, (const bf16*)(ws + PL::W_IN), (bf16*)(ws + PL::PROJ), (float*)(ws + PL::GATES), lds);
    xcd_barrier(bar);
#ifdef GVAR
    phase_inproj_v<NB, GVAR>(H, (const bf16*)(ws + PL::W_IN), (bf16*)(ws + PL::PROJ), (float*)(ws + PL::GATES), lds, p.out == nullptr);
    xcd_barrier(bar);
#endif
    PH(3, phase_tables<NB>(in, (const float*)(ws + PL::GATES), ws + PL::H, lds); phase_conv<NB>((const bf16*)(ws + PL::PROJ), in.ab_conv_w, in.ab_conv_b, (bf16*)(ws + PL::XBC)))
    phase_scan<NB>((const bf16*)(ws + PL::PROJ), ws + PL::H, (const bf16*)(ws + PL::XBC), (bf16*)(ws + PL::SC), lds);
    xcd_barrier(bar);
#ifdef SCANMODE
    phase_scan<NB>((const bf16*)(ws + PL::PROJ), ws + PL::H, (const bf16*)(ws + PL::XBC), (bf16*)(ws + PL::SC), lds, p.out ? SCANMODE : 3);
    xcd_barrier(bar);
#endif
    phase_mixer_out<NB>(in, (const bf16*)(ws + PL::PROJ), (const bf16*)(ws + PL::XBC), (bf16*)(ws + PL::SC));
    xcd_barrier(bar);
    PH(6, phase_outproj<NB>((const bf16*)(ws + PL::SC), 4096, 2048, (const bf16*)(ws + PL::W_OUT), PL::T, in.x, in.ctx, mod0, X1, lds))
    rows_phase<NB, false, false, true, true>(X1, X1 + PL::TL * D, PL::T, nullptr, mod0, mod0, nullptr, nullptr, in.norm2_w, 3, 4, H,
        in.moe_w_group, in.moe_b_group, in.moe_w_expert, in.moe_b_expert, rw, cnt0, list, (int)PL::T, lds);
    PH(7, conv_moe_weights(in, 1, wmoe1, wmoe1 + GU, lds))
    PH(8, phase_moe_up(H, wmoe0, cnt0, list, (int)PL::T, rw, (bf16*)(ws + PL::ACT), lds))
    PH(9, phase_moe_down((const bf16*)(ws + PL::ACT), wmoe0 + GU, cnt0, list, (int)PL::T, (bf16*)(ws + PL::Y2), lds))
    PH(10, rows_phase<NB, true, true, true, false>(X1, X1 + PL::TL * D, PL::T, (const bf16*)(ws + PL::Y2), mod0, mod1, X2, nullptr, in.norm1_w + 1024, 0, 1, H,
        nullptr, nullptr, nullptr, nullptr, nullptr, nullptr, nullptr, 0, lds))
    PH(11, phase_qkv<NB>(H, (const bf16*)(ws + PL::W_QKV), in.na_q_norm, in.na_k_norm, (bf16*)(ws + PL::QKV), lds))
    PH(12, phase_attn<NB>((const bf16*)(ws + PL::QKV), in.na_rpb, (bf16*)(ws + PL::AO), lds))
    PH(13, phase_outproj<NB>((const bf16*)(ws + PL::AO), 1024, 1024, (const bf16*)(ws + PL::W_NAO), PL::TL, X2, X2 + PL::TL * D, mod1, X3, lds))
    rows_phase<NB, false, false, true, true>(X3, X3, PL::TL, nullptr, mod1, mod1, nullptr, nullptr, in.norm2_w + 1024, 3, 4, H,
        in.moe_w_group + 1024 * 4, in.moe_b_group + 4, in.moe_w_expert + 1024 * 32, in.moe_b_expert + 32, rw, cnt1, list, (int)PL::T, lds);
    xcd_barrier(bar);
    PH(15, phase_moe_up(H, wmoe1, cnt1, list, (int)PL::T, rw, (bf16*)(ws + PL::ACT), lds))
    PH(16, phase_moe_down((const bf16*)(ws + PL::ACT), wmoe1 + GU, cnt1, list, (int)PL::T, (bf16*)(ws + PL::Y2), lds))
    rows_phase<NB, true, false, false, false>(X3, X3, PL::TL, (const bf16*)(ws + PL::Y2), mod1, mod1, nullptr, p.out, nullptr, 0, 0, nullptr,
        nullptr, nullptr, nullptr, nullptr, nullptr, nullptr, nullptr, 0, lds);
    if ((REPMASK >> 17) & 1) { xcd_barrier(bar); rows_phase<NB, true, false, false, false>(X3, X3, PL::TL, (const bf16*)(ws + PL::Y2), mod1, mod1, nullptr, p.out, nullptr, 0, 0, nullptr,
        nullptr, nullptr, nullptr, nullptr, nullptr, nullptr, nullptr, 0, lds); }
#undef PH
}
__global__ void k_fill(float* q, size_t n, float v) { size_t i = (size_t)blockIdx.x * 256 + threadIdx.x; if (i < n) q[i] = v; }
}

extern "C" void kernel_launch(void* const* d_in, const int* in_sizes, int n_in, void* d_out, int out_size, void* d_ws, size_t ws_size, hipStream_t stream) {
    static int grid = 0;
    if (grid == 0) {
        int dev = 0, cus = 0, per_cu = 0;
        (void)hipGetDevice(&dev);
        (void)hipDeviceGetAttribute(&cus, hipDeviceAttributeMultiprocessorCount, dev);
        if (hipFuncSetAttribute((const void*)mk::k_mega, hipFuncAttributeMaxDynamicSharedMemorySize, fx::LDS_BYTES) != hipSuccess) { grid = -1; }
        else {
            if (hipOccupancyMaxActiveBlocksPerMultiprocessor(&per_cu, (const void*)mk::k_mega, 512, fx::LDS_BYTES) != hipSuccess) per_cu = 0;
            (void)hipGetLastError();
            grid = per_cu >= 1 ? cus : -1;
        }
    }
    if (grid < 0 || n_in != 31 || mk::PL::END > ws_size) { mk::k_fill<<<(out_size + 255) / 256, 256, 0, stream>>>((float*)d_out, (size_t)out_size, 2.f); return; }
    (void)hipMemsetAsync((unsigned char*)d_ws + mk::PL::CTL, 0, mk::PL::CTL_BYTES, stream);
    fx::P fp;
    { const float** q = (const float**)&fp.in; for (int i = 0; i < 31; ++i) q[i] = (const float*)d_in[i]; }
    fp.ws = (unsigned char*)d_ws; fp.out = (float*)d_out;
    hipLaunchKernelGGL(mk::k_mega, dim3(grid), dim3(512), fx::LDS_BYTES, stream, fp);
}
```

```cpp
#include <hip/hip_runtime.h>
#include <cstdio>
#include <cstdint>
namespace fx {
#define LAS __attribute__((address_space(3)))
typedef unsigned short bf16;
typedef short bf16x8 __attribute__((ext_vector_type(8)));
typedef short bf16x4 __attribute__((ext_vector_type(4)));
typedef float f32x16 __attribute__((ext_vector_type(16)));
typedef float f32x4 __attribute__((ext_vector_type(4)));
typedef unsigned u32x4 __attribute__((ext_vector_type(4)));
typedef unsigned u32x2 __attribute__((ext_vector_type(2)));
constexpr int NTHR = 512, NWAVE = 8;
constexpr int D = 1024, SEQ = 4096, CTXL = 256;
constexpr int PROJW = 5632, NIN = 5760;
constexpr int PC_Z = 0, PC_XBC = 1024, PC_Q = 2560, PC_K = 3072, PC_V = 3584, PC_O = 4608;
constexpr int LDS_BYTES = 152 * 1024;

__device__ __forceinline__ int otid() { int t = threadIdx.x; asm volatile("" : "+v"(t)); return t; }
__device__ __forceinline__ float bf2f(bf16 v) { return __uint_as_float((unsigned)v << 16); }
__device__ __forceinline__ float bflo(unsigned u) { return __uint_as_float(u << 16); }
__device__ __forceinline__ float bfhi(unsigned u) { return __uint_as_float(u & 0xffff0000u); }
typedef __bf16 bf16x2_t __attribute__((ext_vector_type(2)));
typedef float f32x2_t __attribute__((ext_vector_type(2)));
__device__ __forceinline__ unsigned pk2(float lo, float hi) { const f32x2_t v = {lo, hi}; return __builtin_bit_cast(unsigned, __builtin_convertvector(v, bf16x2_t)); }
__device__ __forceinline__ float siluf(float v) { return v / (1.f + __expf(-v)); }
__device__ __forceinline__ float sigmf(float v) { return 1.f / (1.f + __expf(-v)); }
__device__ __forceinline__ float softplusf(float v) { return v > 20.f ? v : log1pf(__expf(v)); }
__device__ __forceinline__ float logsigf(float v) { return fminf(v, 0.f) - log1pf(__expf(-fabsf(v))); }
__device__ __forceinline__ float wave_sum(float v) {
#pragma unroll
    for (int o = 32; o > 0; o >>= 1) v += __shfl_xor(v, o);
    return v;
}
__device__ __forceinline__ float wave_max(float v) {
#pragma unroll
    for (int o = 32; o > 0; o >>= 1) v = fmaxf(v, __shfl_xor(v, o));
    return v;
}
__device__ __forceinline__ f32x16 mfma32(bf16x8 a, bf16x8 b, f32x16 c) { return __builtin_amdgcn_mfma_f32_32x32x16_bf16(a, b, c, 0, 0, 0); }
__device__ __forceinline__ f32x4 mfma16(bf16x8 a, bf16x8 b, f32x4 c) { return __builtin_amdgcn_mfma_f32_16x16x32_bf16(a, b, c, 0, 0, 0); }

__device__ __forceinline__ bf16x8 frag_row(const LAS unsigned char* T, int RS, int r0, int k0, int lane) {
    return *(const LAS bf16x8*)(T + (r0 + (lane & 31)) * RS + (k0 + 8 * (lane >> 5)) * 2);
}
__device__ __forceinline__ bf16x8 frag_col(const LAS unsigned char* T, int RS, int k0, int c0, int lane) {
    const int h = lane >> 5, blk = (lane >> 4) & 1, q = (lane & 15) >> 2, p = lane & 3;
    const unsigned a0 = (unsigned)(size_t)(T + (k0 + 8 * h + q) * RS + (c0 + 16 * blk + 4 * p) * 2);
    const unsigned a1 = a0 + 4 * RS;
    bf16x4 v0, v1;
    asm volatile("ds_read_b64_tr_b16 %0, %2\n\tds_read_b64_tr_b16 %1, %3\n\ts_waitcnt lgkmcnt(0)" : "=&v"(v0), "=&v"(v1) : "v"(a0), "v"(a1) : "memory");
    bf16x8 r; r[0] = v0[0]; r[1] = v0[1]; r[2] = v0[2]; r[3] = v0[3]; r[4] = v1[0]; r[5] = v1[1]; r[6] = v1[2]; r[7] = v1[3];
    return r;
}

struct In {
    const float *x, *c, *ctx, *c_ctx, *norm1_w, *norm2_w, *mod_w, *mod_b, *ab_w_in, *ab_conv_w, *ab_conv_b, *ssd_a_log, *ssd_dt_bias, *ssd_d,
        *ssd_norm_w, *ml_i_bias, *ml_f_bias, *ml_norm_w, *ab_w_out, *na_w_qkv, *na_q_norm, *na_k_norm, *na_rpb, *na_w_out,
        *moe_w_group, *moe_b_group, *moe_w_expert, *moe_b_expert, *moe_w_gate, *moe_w_up, *moe_w_down;
};

constexpr size_t cmax(size_t a, size_t b) { return a > b ? a : b; }
constexpr size_t al256(size_t x) { return (x + 255) & ~(size_t)255; }

template <int NB> struct Plan {
    static constexpr size_t TL = (size_t)NB * SEQ, TC = (size_t)NB * CTXL, T = TL + TC;
    static constexpr size_t CTL = 0;
    static constexpr size_t CTL_BAR = 0, CTL_CNT = 16384  , CTL_BYTES = 32768;
    static constexpr size_t MODV = CTL + CTL_BYTES;
    static constexpr size_t RW = MODV + al256(2 * 5 * 6144 * 4);
    static constexpr size_t LIST = RW + al256(2 * T * 4);
    static constexpr size_t W_IN = LIST + al256(32 * T * 4);
    static constexpr size_t W_OUT = W_IN + (size_t)NIN * 1024 * 2;
    static constexpr size_t W_QKV = W_OUT + (size_t)1024 * 2048 * 2;
    static constexpr size_t W_NAO = W_QKV + (size_t)3072 * 1024 * 2;
    static constexpr size_t ARENA = W_NAO + (size_t)1024 * 1024 * 2;
    static constexpr size_t MOEW = (size_t)32 * 1024 * 1024 * 2 + (size_t)32 * 1024 * 512 * 2;
    static constexpr size_t SZ_B = al256(T * 1024 * 2);
    static constexpr size_t SZ_A = al256(cmax(MOEW, cmax(T * 3072 * 2, T * 1024 * 4)));
    static constexpr size_t SZ_X = al256(T * 1024 * 4);
    static constexpr size_t SZ_C = al256(cmax(T * PROJW * 2 + T * 64 * 4, SZ_X + MOEW));
    static constexpr size_t SZ_D = al256(T * 1536 * 2);
    static constexpr size_t SZ_E = al256(T * 4096 * 2);
    static constexpr size_t RB = ARENA, RA = RB + SZ_B, RC = RA + SZ_A, RD = RC + SZ_C, RE = RD + SZ_D, END = RE + SZ_E;
    static constexpr size_t H = RB;
    static constexpr size_t W_MOE0 = RA;
    static constexpr size_t QKV = RA;
    static constexpr size_t X3 = RA;
    static constexpr size_t PROJ = RC;
    static constexpr size_t GATES = RC + T * PROJW * 2;
    static constexpr size_t X1 = RC;
    static constexpr size_t W_MOE1 = RC + SZ_X;
    static constexpr size_t XBC = RD;
    static constexpr size_t ACT = RD;
    static constexpr size_t AO = RD;
    static constexpr size_t SC = RE;
    static constexpr size_t Y2 = RE;
    static constexpr size_t X2 = RE + al256(2 * T * 1024 * 2);
    static_assert(2 * T * 1024 * 2 + T * 1024 * 4 <= SZ_E, "E");
    static_assert(T * 3072 * 2 <= SZ_A + SZ_X, "QKV spill");
};

struct P { In in; unsigned char* ws; float* out; };

template <int NB> __device__ __forceinline__ int mod_row(int row) { return row < NB * SEQ ? row / SEQ : 4; }

template <class Map>
__device__ __forceinline__ void tconv_tile(const float* src, int ld_src, bf16* dst, int K, int k0, int n0, Map map, LAS unsigned char* lds) {
    LAS float* tl = (LAS float*)lds;
    const int tid = otid();
    {
        const int n = tid & 63, kb = tid >> 6;
        const int sc = map(n0 + n);
#pragma unroll
        for (int i = 0; i < 8; ++i) { const int k = kb + 8 * i; tl[k * 65 + n] = sc >= 0 ? src[(size_t)(k0 + k) * ld_src + sc] : 0.f; }
    }
    __syncthreads();
    {
        const int n = tid >> 3, kc = tid & 7;
        float v[8];
#pragma unroll
        for (int j = 0; j < 8; ++j) v[j] = tl[(kc * 8 + j) * 65 + n];
        u32x4 o; o[0] = pk2(v[0], v[1]); o[1] = pk2(v[2], v[3]); o[2] = pk2(v[4], v[5]); o[3] = pk2(v[6], v[7]);
        *(u32x4*)(dst + (size_t)(n0 + n) * K + k0 + kc * 8) = o;
    }
    __syncthreads();
}

struct MapId { __device__ int operator()(int n) const { return n; } };
struct MapIn {
    __device__ int operator()(int n) const { return n < 2560 ? n : (n < 5632 ? n + 32 : (n < 5664 ? n - 3072 : (n < 5680 ? n : -1))); }
};

__device__ __forceinline__ void conv_small_weights(const In& in, unsigned char* ws, size_t o_in, size_t o_out, size_t o_qkv, size_t o_nao, LAS unsigned char* lds) {
    const int total = 1440 + 512 + 768 + 256;
    for (int u = blockIdx.x; u < total; u += gridDim.x) {
        if (u < 1440) { const int kt = u % 16, nt = u / 16; tconv_tile(in.ab_w_in, 5680, (bf16*)(ws + o_in), 1024, kt * 64, nt * 64, MapIn(), lds); }
        else if (u < 1952) { const int v = u - 1440, kt = v % 32, nt = v / 32; tconv_tile(in.ab_w_out, 1024, (bf16*)(ws + o_out), 2048, kt * 64, nt * 64, MapId(), lds); }
        else if (u < 2720) { const int v = u - 1952, kt = v % 16, nt = v / 16; tconv_tile(in.na_w_qkv, 3072, (bf16*)(ws + o_qkv), 1024, kt * 64, nt * 64, MapId(), lds); }
        else { const int v = u - 2720, kt = v % 16, nt = v / 16; tconv_tile(in.na_w_out, 1024, (bf16*)(ws + o_nao), 1024, kt * 64, nt * 64, MapId(), lds); }
    }
}

struct MapGU { __device__ int operator()(int n) const { return (n >> 7) * 64 + ((n >> 6) & 1) * 32 + (n & 31); } };
__device__ __forceinline__ void conv_moe_weights(const In& in, int layer, bf16* wgu, bf16* wd, LAS unsigned char* lds) {
    const size_t wsz = (size_t)1024 * 512;
    const int total_gu = 32 * 16 * 16, total_d = 32 * 8 * 16;
    for (int u = blockIdx.x; u < total_gu + total_d; u += gridDim.x) {
        if (u < total_gu) {
            const int e = u / 256, v = u % 256, kt = v % 16, nt = v / 16;
            const float* g = in.moe_w_gate + ((size_t)layer * 32 + e) * wsz; const float* up = in.moe_w_up + ((size_t)layer * 32 + e) * wsz;
            bf16* dst = wgu + (size_t)e * 1024 * 1024;
            LAS float* tl = (LAS float*)lds;
            const int tid = otid();
            { const int n = tid & 63, kb = tid >> 6; const int f = MapGU()(nt * 64 + n); const float* s = (n & 32) ? up : g;
#pragma unroll
              for (int i = 0; i < 8; ++i) { const int k = kb + 8 * i; tl[k * 65 + n] = s[(size_t)(kt * 64 + k) * 512 + f]; } }
            __syncthreads();
            { const int n = tid >> 3, kc = tid & 7; float vv[8];
#pragma unroll
              for (int j = 0; j < 8; ++j) vv[j] = tl[(kc * 8 + j) * 65 + n];
              u32x4 o; o[0] = pk2(vv[0], vv[1]); o[1] = pk2(vv[2], vv[3]); o[2] = pk2(vv[4], vv[5]); o[3] = pk2(vv[6], vv[7]);
              *(u32x4*)(dst + (size_t)(nt * 64 + n) * 1024 + kt * 64 + kc * 8) = o; }
            __syncthreads();
        } else {
            const int w = u - total_gu, e = w / 128, v = w % 128, kt = v % 8, nt = v / 8;
            tconv_tile(in.moe_w_down + ((size_t)layer * 32 + e) * wsz, 1024, wd + (size_t)e * 1024 * 512, 512, kt * 64, nt * 64, MapId(), lds);
        }
    }
}

__device__ __forceinline__ void mod_vectors(const In& in, float* modv, LAS unsigned char* lds) {
    LAS float* sc = (LAS float*)lds;
    LAS float* red = sc + 5 * 1024;
    const int tid = otid();
    for (int i = tid; i < 5 * 1024; i += NTHR) { const int r = i >> 10, k = i & 1023; const float v = r < 4 ? in.c[r * 1024 + k] : in.c_ctx[k]; sc[i] = siluf(v); }
    __syncthreads();
    const int col = tid & 31, kq = tid >> 5;
    for (int u = blockIdx.x; u < 2 * 192; u += gridDim.x) {
        const int layer = u / 192, c0 = (u % 192) * 32;
        const float* w = in.mod_w + (size_t)layer * 1024 * 6144 + c0 + col;
        float a0 = 0.f, a1 = 0.f, a2 = 0.f, a3 = 0.f, a4 = 0.f;
#pragma unroll 8
        for (int j = 0; j < 64; ++j) { const int k = kq + 16 * j; const float wv = w[(size_t)k * 6144];
            a0 += sc[k] * wv; a1 += sc[1024 + k] * wv; a2 += sc[2048 + k] * wv; a3 += sc[3072 + k] * wv; a4 += sc[4096 + k] * wv; }
        red[(0 * 16 + kq) * 32 + col] = a0; red[(1 * 16 + kq) * 32 + col] = a1; red[(2 * 16 + kq) * 32 + col] = a2;
        red[(3 * 16 + kq) * 32 + col] = a3; red[(4 * 16 + kq) * 32 + col] = a4;
        __syncthreads();
        if (tid < 160) { const int r = tid >> 5, cc = tid & 31; float s = 0.f;
#pragma unroll
            for (int q = 0; q < 16; ++q) s += red[(r * 16 + q) * 32 + cc];
            modv[((size_t)layer * 5 + r) * 6144 + c0 + cc] = s + in.mod_b[layer * 6144 + c0 + cc]; }
        __syncthreads();
    }
}

template <int NB, bool COMBINE, bool XOUT, bool NORM, bool ROUTER>
__device__ __forceinline__ void rows_phase(const float* xl, const float* xc, int nrows, const bf16* y2, const float* modc  , const float* modl  ,
                                           float* xout, float* out_final, const float* nw, int shift_i, int scale_i, bf16* hout,
                                           const float* wg, const float* bg, const float* we, const float* be, float* route_w, int* cnt, int* list, int cap,
                                           LAS unsigned char* lds) {
    constexpr int TL = NB * SEQ;
    const int tid = otid(), lane = tid & 63, wave = tid >> 6;
    LAS float* wt = (LAS float*)lds;
    LAS int* lcnt = (LAS int*)(lds + 36 * 1024 * 4); LAS int* lbase = lcnt + 32; LAS int* rinfo = lcnt + 64;
    if (ROUTER) {
        if (tid < 32) lcnt[tid] = 0;
        for (int i = tid; i < 4 * 1024; i += NTHR) wt[(i & 3) * 1024 + (i >> 2)] = wg[i];
        for (int i = tid; i < 32 * 1024; i += NTHR) wt[(4 + (i & 31)) * 1024 + (i >> 5)] = we[i];
        __syncthreads();
    }
    int lrow = wave;
    for (int row = blockIdx.x * NWAVE + wave; row < nrows; row += gridDim.x * NWAVE, lrow += NWAVE) {
        const float* src = row < TL ? xl + (size_t)row * D : xc + (size_t)(row - TL) * D;
        const float* mv = modl + (size_t)mod_row<NB>(row) * 6144;
        const float* mvc = modc + (size_t)mod_row<NB>(row) * 6144;
        f32x4 v[4];
#pragma unroll
        for (int i = 0; i < 4; ++i) v[i] = *(const f32x4*)(src + lane * 4 + 256 * i);
        if (COMBINE) {
#pragma unroll
            for (int i = 0; i < 4; ++i) { const int c = lane * 4 + 256 * i;
                const u32x2 ya = *(const u32x2*)(y2 + (size_t)(2 * row) * D + c), yb = *(const u32x2*)(y2 + (size_t)(2 * row + 1) * D + c);
                const f32x4 m5 = *(const f32x4*)(mvc + 5 * 1024 + c);
                v[i][0] += m5[0] * (bflo(ya[0]) + bflo(yb[0])); v[i][1] += m5[1] * (bfhi(ya[0]) + bfhi(yb[0]));
                v[i][2] += m5[2] * (bflo(ya[1]) + bflo(yb[1])); v[i][3] += m5[3] * (bfhi(ya[1]) + bfhi(yb[1])); }
            if (XOUT) {
#pragma unroll
                for (int i = 0; i < 4; ++i) *(f32x4*)(xout + (size_t)row * D + lane * 4 + 256 * i) = v[i]; }
            if (out_final) {
#pragma unroll
                for (int i = 0; i < 4; ++i) *(f32x4*)(out_final + (size_t)row * D + lane * 4 + 256 * i) = v[i]; }
        }
        if (NORM) {
            float ss = 0.f;
#pragma unroll
            for (int i = 0; i < 4; ++i) ss += v[i][0] * v[i][0] + v[i][1] * v[i][1] + v[i][2] * v[i][2] + v[i][3] * v[i][3];
            ss = wave_sum(ss);
            const float rs = rsqrtf(ss * (1.f / D) + 1e-6f);
            f32x4 hv[4];
#pragma unroll
            for (int i = 0; i < 4; ++i) { const int c = lane * 4 + 256 * i;
                const f32x4 w4 = *(const f32x4*)(nw + c), sc4 = *(const f32x4*)(mv + scale_i * 1024 + c), sh4 = *(const f32x4*)(mv + shift_i * 1024 + c);
#pragma unroll
                for (int j = 0; j < 4; ++j) hv[i][j] = v[i][j] * rs * w4[j] * (1.f + sc4[j]) + sh4[j];
                u32x2 o; o[0] = pk2(hv[i][0], hv[i][1]); o[1] = pk2(hv[i][2], hv[i][3]);
                *(u32x2*)(hout + (size_t)row * D + c) = o; }
            if (ROUTER) {
                float lg[4];
#pragma unroll
                for (int j = 0; j < 4; ++j) { float a = 0.f;
#pragma unroll
                    for (int i = 0; i < 4; ++i) { const f32x4 w4 = *(const LAS f32x4*)(wt + j * 1024 + lane * 4 + 256 * i);
                        a += hv[i][0] * w4[0] + hv[i][1] * w4[1] + hv[i][2] * w4[2] + hv[i][3] * w4[3]; }
                    lg[j] = wave_sum(a) + bg[j]; }
                int gi = 0; float gm = lg[0];
#pragma unroll
                for (int j = 1; j < 4; ++j) if (lg[j] > gm) { gm = lg[j]; gi = j; }
                float gs = 0.f;
#pragma unroll
                for (int j = 0; j < 4; ++j) gs += __expf(lg[j] - gm);
                const float gprob = 1.f / gs;
                float le[8];
#pragma unroll
                for (int j = 0; j < 8; ++j) { float a = 0.f; const LAS float* wr = wt + (4 + gi * 8 + j) * 1024 + lane * 4;
#pragma unroll
                    for (int i = 0; i < 4; ++i) { const f32x4 w4 = *(const LAS f32x4*)(wr + 256 * i);
                        a += hv[i][0] * w4[0] + hv[i][1] * w4[1] + hv[i][2] * w4[2] + hv[i][3] * w4[3]; }
                    le[j] = wave_sum(a) + be[gi * 8 + j]; }
                int e0 = 0; float m0 = le[0];
#pragma unroll
                for (int j = 1; j < 8; ++j) if (le[j] > m0) { m0 = le[j]; e0 = j; }
                int e1 = 0; float m1 = -3.0e38f;
#pragma unroll
                for (int j = 0; j < 8; ++j) if (j != e0 && le[j] > m1) { m1 = le[j]; e1 = j; }
                const float p1 = __expf(m1 - m0);
                if (lane == 0) {
                    const int ge0 = gi * 8 + e0, ge1 = gi * 8 + e1;
                    route_w[2 * row] = gprob / (1.f + p1); route_w[2 * row + 1] = gprob * p1 / (1.f + p1);
                    const int s0 = atomicAdd((int*)&lcnt[ge0], 1), s1 = atomicAdd((int*)&lcnt[ge1], 1);
                    rinfo[2 * lrow] = (ge0 << 16) | s0; rinfo[2 * lrow + 1] = (ge1 << 16) | s1;
                }
            }
        }
    }
    if (ROUTER) {
        __syncthreads();
        if (tid < 32) { const int c = lcnt[tid]; lbase[tid] = c ? atomicAdd(&cnt[tid * 64], c) : 0; }
        __syncthreads();
        int lrow = wave;
        for (int row = blockIdx.x * NWAVE + wave; row < nrows; row += gridDim.x * NWAVE, lrow += NWAVE) {
            if (lane < 2) { const int ri = rinfo[2 * lrow + lane], ge = ri >> 16, sl = ri & 0xffff; list[(size_t)ge * cap + lbase[ge] + sl] = 2 * row + lane; }
        }
        __syncthreads();
    }
}

__device__ __forceinline__ int xcd_unit(int r) { const int G = gridDim.x, bx = blockIdx.x; return G == 256 ? ((r * 8 + (bx & 7)) * 32 + (bx >> 3)) : r * G + bx; }
__device__ __forceinline__ void unit_tile(int u, int MT, int NT, int& mt, int& nt) {
    if ((MT & 3) == 0) { const int band = u / (4 * NT), w = u - band * 4 * NT; nt = w >> 2; mt = band * 4 + (w & 3); }
    else { mt = u / NT; nt = u - mt * NT; }
}
constexpr int GEMM_STAGE = 256 * 128 + 128 * 128;
constexpr int GEMM_LDS = 3 * GEMM_STAGE;
__device__ __forceinline__ int sw_off(int row, int chunk) { return row * 128 + ((chunk ^ ((row >> 1) & 7)) << 4); }

template <int VAR = 0, class Epi>
__device__ __forceinline__ void gemm_tile(const bf16* const (&arow)[4], const bf16* bt  , int ldb, int K, LAS unsigned char* lds, Epi&& epi) {
    const int tid = otid(), lane = tid & 63, wave = tid >> 6, wm = wave >> 1, wn = wave & 1;
    const int r8 = tid >> 3;
    const int schunk = (lane & 7) ^ ((r8 >> 1) & 7);
    const bf16* ga[4]; const bf16* gb[2];
#pragma unroll
    for (int i = 0; i < 4; ++i) ga[i] = arow[i] + schunk * 8;
#pragma unroll
    for (int i = 0; i < 2; ++i) gb[i] = bt + (size_t)(r8 + 64 * i) * ldb + schunk * 8;
    f32x16 acc[2][2];
#pragma unroll
    for (int mi = 0; mi < 2; ++mi)
#pragma unroll
        for (int ni = 0; ni < 2; ++ni)
#pragma unroll
            for (int r = 0; r < 16; ++r) acc[mi][ni][r] = 0.f;
#define G_DMA(t, st) do { LAS unsigned char* sa_ = lds + (st) * GEMM_STAGE + wave * 1024 + lane * 16; \
    _Pragma("unroll") for (int i = 0; i < 4; ++i) __builtin_amdgcn_global_load_lds((const unsigned*)(ga[i] + (t) * 64), (LAS unsigned*)(sa_ + i * 8192), 16, 0, 0); \
    _Pragma("unroll") for (int i = 0; i < 2; ++i) __builtin_amdgcn_global_load_lds((const unsigned*)(gb[i] + (t) * 64), (LAS unsigned*)(sa_ + 256 * 128 + i * 8192), 16, 0, 0); } while (0)
    const int KT = K >> 6;
    G_DMA(0, 0);
    G_DMA(1, 1);
    asm volatile("s_waitcnt vmcnt(6)" ::: "memory");
    __builtin_amdgcn_s_barrier();
    asm volatile("" ::: "memory");
    int st = 0;
    for (int kt = 0; kt < KT; ++kt) {
        const int st2 = st >= 1 ? st - 1 : 2;
        if (VAR != 2) { if (kt + 2 < KT) G_DMA(kt + 2, st2); }
        const LAS unsigned char* sa = lds + st * GEMM_STAGE; const LAS unsigned char* sb = sa + 256 * 128;
        bf16x8 af[2], bfr[2];
        if (VAR == 1) {
#pragma unroll
            for (int mi = 0; mi < 2; ++mi) af[mi] = *(const LAS bf16x8*)(sa + sw_off(wm * 64 + mi * 32 + (lane & 31), (lane >> 5)));
#pragma unroll
            for (int ni = 0; ni < 2; ++ni) bfr[ni] = *(const LAS bf16x8*)(sb + sw_off(wn * 64 + ni * 32 + (lane & 31), (lane >> 5)));
        }
#pragma unroll
        for (int kk = 0; kk < 4; ++kk) {
            if (VAR != 1) {
#pragma unroll
            for (int mi = 0; mi < 2; ++mi) af[mi] = *(const LAS bf16x8*)(sa + sw_off(wm * 64 + mi * 32 + (lane & 31), 2 * kk + (lane >> 5)));
#pragma unroll
            for (int ni = 0; ni < 2; ++ni) bfr[ni] = *(const LAS bf16x8*)(sb + sw_off(wn * 64 + ni * 32 + (lane & 31), 2 * kk + (lane >> 5)));
            }
            if (VAR == 3) {
#pragma unroll
                for (int mi = 0; mi < 2; ++mi) acc[mi][0][kk] += __builtin_bit_cast(f32x4, af[mi])[0] + __builtin_bit_cast(f32x4, bfr[mi])[1];
            } else {
#pragma unroll
            for (int mi = 0; mi < 2; ++mi)
#pragma unroll
                for (int ni = 0; ni < 2; ++ni) acc[mi][ni] = mfma32(bfr[ni], af[mi], acc[mi][ni]);
            }
        }
        if (kt + 2 < KT) asm volatile("s_waitcnt vmcnt(6)" ::: "memory"); else asm volatile("s_waitcnt vmcnt(0)" ::: "memory");
        __builtin_amdgcn_s_barrier();
        asm volatile("" ::: "memory");
        st = st == 2 ? 0 : st + 1;
    }
#undef G_DMA
    epi(acc, wm, wn, lane);
}

constexpr int CST_BF = 272, CST_BF64 = 144, CST_F32 = 528;
__device__ __forceinline__ void stage_bf16_128(const f32x16 (&acc)[2][2], LAS unsigned char* lds, int wm, int wn, int lane) {
#pragma unroll
    for (int mi = 0; mi < 2; ++mi) { LAS unsigned char* rp = lds + (wm * 64 + mi * 32 + (lane & 31)) * CST_BF + (wn * 64 + 4 * (lane >> 5)) * 2;
#pragma unroll
        for (int ni = 0; ni < 2; ++ni)
#pragma unroll
            for (int g = 0; g < 4; ++g) { u32x2 o; o[0] = pk2(acc[mi][ni][4 * g], acc[mi][ni][4 * g + 1]); o[1] = pk2(acc[mi][ni][4 * g + 2], acc[mi][ni][4 * g + 3]);
                *(LAS u32x2*)(rp + (ni * 32 + 8 * g) * 2) = o; } }
}
template <class RowPtr>
__device__ __forceinline__ void flush_bf16_128(const LAS unsigned char* lds, RowPtr&& rowptr) {
    const int t = otid();
#pragma unroll
    for (int it = 0; it < 8; ++it) { const int row = it * 32 + (t >> 4), piece = t & 15;
        const u32x4 v = *(const LAS u32x4*)(lds + row * CST_BF + piece * 16);
        bf16* dst = rowptr(row);
        if (dst) *(u32x4*)(dst + piece * 8) = v; }
}
template <class RowPtr>
__device__ __forceinline__ void flush_bf16_64(const LAS unsigned char* lds, RowPtr&& rowptr) {
    const int t = otid();
#pragma unroll
    for (int it = 0; it < 4; ++it) { const int row = it * 64 + (t >> 3), piece = t & 7;
        const u32x4 v = *(const LAS u32x4*)(lds + row * CST_BF64 + piece * 16);
        bf16* dst = rowptr(row);
        if (dst) *(u32x4*)(dst + piece * 8) = v; }
}
__device__ __forceinline__ void stage_f32_128(const f32x16 (&acc)[2][2], LAS unsigned char* lds, int wm, int wn, int lane) {
#pragma unroll
    for (int mi = 0; mi < 2; ++mi) { LAS unsigned char* rp = lds + (wm * 64 + mi * 32 + (lane & 31)) * CST_F32 + (wn * 64 + 4 * (lane >> 5)) * 4;
#pragma unroll
        for (int ni = 0; ni < 2; ++ni)
#pragma unroll
            for (int g = 0; g < 4; ++g) { f32x4 o; o[0] = acc[mi][ni][4 * g]; o[1] = acc[mi][ni][4 * g + 1]; o[2] = acc[mi][ni][4 * g + 2]; o[3] = acc[mi][ni][4 * g + 3];
                *(LAS f32x4*)(rp + (ni * 32 + 8 * g) * 4) = o; } }
}

template <int NB, int VAR = 0>
__device__ __forceinline__ void phase_inproj_v(const bf16* H, const bf16* Wt, bf16* PROJ, float* GATES, LAS unsigned char* lds, bool dostore = true) {
    constexpr int T = NB * (SEQ + CTXL), MT = T / 256, NT_ = NIN / 128;
    for (int r = 0; r * (int)gridDim.x < MT * NT_; ++r) {
        const int u = xcd_unit(r); if (u >= MT * NT_) continue;
        int mt, nt; unit_tile(u, MT, NT_, mt, nt);
        const bf16* arow[4];
#pragma unroll
        for (int i = 0; i < 4; ++i) arow[i] = H + (size_t)(mt * 256 + (otid() >> 3) + 64 * i) * D;
        gemm_tile<VAR>(arow, Wt + (size_t)nt * 128 * D, D, D, lds, [&](const f32x16 (&acc)[2][2], int wm, int wn, int lane) {
            if (!dostore) return;
            if (nt < NT_ - 1) stage_bf16_128(acc, lds, wm, wn, lane);
            else if (wn == 0) {
#pragma unroll
                for (int mi = 0; mi < 2; ++mi) { const int row = mt * 256 + wm * 64 + mi * 32 + (lane & 31);
#pragma unroll
                    for (int ni = 0; ni < 2; ++ni)
#pragma unroll
                        for (int g = 0; g < 4; ++g) { f32x4 o; o[0] = acc[mi][ni][4 * g]; o[1] = acc[mi][ni][4 * g + 1]; o[2] = acc[mi][ni][4 * g + 2]; o[3] = acc[mi][ni][4 * g + 3];
                            *(f32x4*)(GATES + (size_t)row * 64 + ni * 32 + 8 * g + 4 * (lane >> 5)) = o; } } }
        });
        if (dostore && nt < NT_ - 1) {
            __syncthreads();
            flush_bf16_128(lds, [&](int r) { return PROJ + (size_t)(mt * 256 + r) * PROJW + nt * 128; });
        }
        __syncthreads();
    }
}

template <int NB> __device__ __forceinline__ void phase_inproj(const bf16* H, const bf16* Wt, bf16* PROJ, float* GATES, LAS unsigned char* lds) { phase_inproj_v<NB, 0>(H, Wt, PROJ, GATES, lds, true); }

template <int NB>
__device__ __forceinline__ void phase_conv(const bf16* PROJ, const float* cw, const float* cb, bf16* XBC) {
    constexpr int TL = NB * SEQ, T = NB * (SEQ + CTXL);
    for (size_t it = (size_t)blockIdx.x * NTHR + otid(); it < (size_t)T * 192; it += (size_t)gridDim.x * NTHR) {
        const int row = (int)(it / 192), c0 = (int)(it % 192) * 8;
        int t, L;
        if (row < TL) { t = row % SEQ; L = SEQ; } else { t = (row - TL) % CTXL; L = CTXL; }
        const bf16* p = PROJ + (size_t)row * PROJW + PC_XBC + c0;
        const u32x4 cur = *(const u32x4*)p;
        u32x4 prv = {0u, 0u, 0u, 0u}, nxt = {0u, 0u, 0u, 0u};
        if (t > 0) prv = *(const u32x4*)(p - PROJW);
        if (t < L - 1) nxt = *(const u32x4*)(p + PROJW);
        float o[8];
#pragma unroll
        for (int j = 0; j < 4; ++j) {
            const int c = c0 + 2 * j;
            o[2 * j] = bflo(prv[j]) * cw[c] + bflo(cur[j]) * cw[1536 + c] + bflo(nxt[j]) * cw[3072 + c] + cb[c];
            o[2 * j + 1] = bfhi(prv[j]) * cw[c + 1] + bfhi(cur[j]) * cw[1536 + c + 1] + bfhi(nxt[j]) * cw[3072 + c + 1] + cb[c + 1];
        }
        u32x4 r; r[0] = pk2(siluf(o[0]), siluf(o[1])); r[1] = pk2(siluf(o[2]), siluf(o[3])); r[2] = pk2(siluf(o[4]), siluf(o[5])); r[3] = pk2(siluf(o[6]), siluf(o[7]));
        *(u32x4*)(XBC + (size_t)row * 1536 + c0) = r;
    }
}
}
namespace fx {
constexpr int RS_X = 144, RS_N = 272;

template <int NB> __device__ __forceinline__ int scan_row(int b, int d, int step) {
    if (step < CTXL) return NB * SEQ + b * CTXL + (d ? CTXL - 1 - step : step);
    step -= CTXL; return b * SEQ + (d ? SEQ - 1 - step : step);
}
__device__ __forceinline__ bf16x8 scale_frag(bf16x8 v, f32x4 w0, f32x4 w1) {
    const u32x4 u = __builtin_bit_cast(u32x4, v);
    u32x4 o;
    o[0] = pk2(bflo(u[0]) * w0[0], bfhi(u[0]) * w0[1]); o[1] = pk2(bflo(u[1]) * w0[2], bfhi(u[1]) * w0[3]);
    o[2] = pk2(bflo(u[2]) * w1[0], bfhi(u[2]) * w1[1]); o[3] = pk2(bflo(u[3]) * w1[2], bfhi(u[3]) * w1[3]);
    return __builtin_bit_cast(bf16x8, o);
}

__device__ __forceinline__ unsigned tr_addr(const LAS unsigned char* T, int RS, int k0, int c0, int lane) {
    const int h = lane >> 5, blk = (lane >> 4) & 1, q = (lane & 15) >> 2, p = lane & 3;
    return (unsigned)(size_t)(T + (k0 + 8 * h + q) * RS + (c0 + 16 * blk + 4 * p) * 2);
}
__device__ __forceinline__ void tr8(unsigned a0, unsigned a1, unsigned a2, unsigned a3, unsigned a4, unsigned a5, unsigned a6, unsigned a7,
                                    bf16x4& v0, bf16x4& v1, bf16x4& v2, bf16x4& v3, bf16x4& v4, bf16x4& v5, bf16x4& v6, bf16x4& v7) {
    asm volatile("ds_read_b64_tr_b16 %0, %8\n\tds_read_b64_tr_b16 %1, %9\n\tds_read_b64_tr_b16 %2, %10\n\tds_read_b64_tr_b16 %3, %11\n\t"
                 "ds_read_b64_tr_b16 %4, %12\n\tds_read_b64_tr_b16 %5, %13\n\tds_read_b64_tr_b16 %6, %14\n\tds_read_b64_tr_b16 %7, %15\n\ts_waitcnt lgkmcnt(0)"
                 : "=&v"(v0), "=&v"(v1), "=&v"(v2), "=&v"(v3), "=&v"(v4), "=&v"(v5), "=&v"(v6), "=&v"(v7)
                 : "v"(a0), "v"(a1), "v"(a2), "v"(a3), "v"(a4), "v"(a5), "v"(a6), "v"(a7) : "memory");
}
__device__ __forceinline__ void tr4(unsigned a0, unsigned a1, unsigned a2, unsigned a3, bf16x4& v0, bf16x4& v1, bf16x4& v2, bf16x4& v3) {
    asm volatile("ds_read_b64_tr_b16 %0, %4\n\tds_read_b64_tr_b16 %1, %5\n\tds_read_b64_tr_b16 %2, %6\n\tds_read_b64_tr_b16 %3, %7\n\ts_waitcnt lgkmcnt(0)"
                 : "=&v"(v0), "=&v"(v1), "=&v"(v2), "=&v"(v3) : "v"(a0), "v"(a1), "v"(a2), "v"(a3) : "memory");
}
__device__ __forceinline__ bf16x8 tr_join(bf16x4 v0, bf16x4 v1) { bf16x8 r; r[0] = v0[0]; r[1] = v0[1]; r[2] = v0[2]; r[3] = v0[3]; r[4] = v1[0]; r[5] = v1[1]; r[6] = v1[2]; r[7] = v1[3]; return r; }
__device__ __forceinline__ void tr_col4(const LAS unsigned char* T, int RS, int k0, int c0, int lane, bf16x4 (&t)[4][2]) {
    const unsigned a = tr_addr(T, RS, k0, c0, lane);
    tr8(a, a + 4 * RS, a + 16 * RS, a + 20 * RS, a + 32 * RS, a + 36 * RS, a + 48 * RS, a + 52 * RS, t[0][0], t[0][1], t[1][0], t[1][1], t[2][0], t[2][1], t[3][0], t[3][1]);
}
__device__ __forceinline__ void tr_col2(const LAS unsigned char* T, int RS, int k0, int c0, int lane, bf16x4 (&t)[2][2]) {
    const unsigned a = tr_addr(T, RS, k0, c0, lane);
    tr4(a, a + 4 * RS, a + 16 * RS, a + 20 * RS, t[0][0], t[0][1], t[1][0], t[1][1]);
}

constexpr int NSTEP = SEQ + CTXL;
template <int NB> struct ScanTab {
    static constexpr size_t SSD_TAB = 0, ML_TAB = SSD_TAB + (size_t)NB * 32 * NSTEP * 16, SSD_DEC = ML_TAB + (size_t)NB * 8 * NSTEP * 32,
                            ML_CH = SSD_DEC + (size_t)NB * 32 * 34 * 4, END = ML_CH + (size_t)NB * 8 * 34 * 8;
};
template <int NB>
__device__ __forceinline__ void phase_tables(const In& in, const float* GATES, unsigned char* tab, LAS unsigned char* lds) {
    typedef ScanTab<NB> ST;
    const int tid = otid(), lane = tid & 63, wave = tid >> 6;
    LAS float* l_g = (LAS float*)lds; LAS float* l_ml = l_g + 68; LAS float* l_mr = l_g + 136;
    for (int job = blockIdx.x; job < NB * 40; job += gridDim.x) {
        if (job < NB * 32) {
            const int b = job >> 5, d = (job >> 4) & 1, h = job & 15;
            const float a = -__expf(in.ssd_a_log[d * 16 + h]), dtb = in.ssd_dt_bias[d * 16 + h];
            f32x4* T4 = (f32x4*)(tab + ST::SSD_TAB) + (size_t)job * NSTEP; float* DEC = (float*)(tab + ST::SSD_DEC) + job * 34;
            for (int ch = wave; ch < 34; ch += NWAVE) {
                const float dt0 = softplusf(GATES[(size_t)scan_row<NB>(b, d, ch * 128 + lane) * 64 + d * 16 + h] + dtb);
                const float dt1 = softplusf(GATES[(size_t)scan_row<NB>(b, d, ch * 128 + 64 + lane) * 64 + d * 16 + h] + dtb);
                float v0 = dt0 * a, v1 = dt1 * a;
#pragma unroll
                for (int o = 1; o < 64; o <<= 1) { const float t0 = __shfl_up(v0, o), t1 = __shfl_up(v1, o); if (lane >= o) { v0 += t0; v1 += t1; } }
                v1 += __shfl(v0, 63);
                const float tot = __shfl(v1, 63);
                T4[ch * 128 + lane] = (f32x4){v0, dt0, dt0 * __expf(tot - v0), __expf(v0)};
                T4[ch * 128 + 64 + lane] = (f32x4){v1, dt1, dt1 * __expf(tot - v1), __expf(v1)};
                if (lane == 0) DEC[ch] = __expf(tot);
            }
        } else {
            const int j2 = job - NB * 32, b = j2 >> 3, d = (j2 >> 2) & 1, hh = j2 & 3;
            const float ib = in.ml_i_bias[d * 4 + hh], fb = in.ml_f_bias[d * 4 + hh];
            f32x4* T4 = (f32x4*)(tab + ST::ML_TAB) + (size_t)j2 * NSTEP * 2; float* CH = (float*)(tab + ST::ML_CH) + j2 * 34 * 2;
            float s_li[5][2], s_bc[5][2], s_mi[5][2], s_we[5][2];
            __syncthreads();
#pragma unroll
            for (int k = 0; k < 5; ++k) { const int ch = wave + 8 * k;
#pragma unroll
                for (int q = 0; q < 2; ++q) { s_li[k][q] = 0.f; s_bc[k][q] = 0.f; s_mi[k][q] = 0.f; s_we[k][q] = 0.f; }
                if (ch < 34) {
                    const float* g0 = GATES + (size_t)scan_row<NB>(b, d, ch * 128 + lane) * 64; const float* g1 = GATES + (size_t)scan_row<NB>(b, d, ch * 128 + 64 + lane) * 64;
                    const float li0 = g0[32 + d * 4 + hh] + ib, li1 = g1[32 + d * 4 + hh] + ib;
                    float bc0 = logsigf(g0[40 + d * 4 + hh] + fb), bc1 = logsigf(g1[40 + d * 4 + hh] + fb);
#pragma unroll
                    for (int o = 1; o < 64; o <<= 1) { const float t0 = __shfl_up(bc0, o), t1 = __shfl_up(bc1, o); if (lane >= o) { bc0 += t0; bc1 += t1; } }
                    bc1 += __shfl(bc0, 63);
                    float pm0 = li0 - bc0, pm1 = li1 - bc1;
#pragma unroll
                    for (int o = 1; o < 64; o <<= 1) { const float t0 = __shfl_up(pm0, o), t1 = __shfl_up(pm1, o); if (lane >= o) { pm0 = fmaxf(pm0, t0); pm1 = fmaxf(pm1, t1); } }
                    pm1 = fmaxf(pm1, __shfl(pm0, 63));
                    const float gtot = __shfl(bc1, 63);
                    const float ae0 = gtot - bc0 + li0, ae1 = gtot - bc1 + li1;
                    const float m_loc = wave_max(fmaxf(ae0, ae1));
                    s_li[k][0] = li0; s_li[k][1] = li1; s_bc[k][0] = bc0; s_bc[k][1] = bc1; s_mi[k][0] = bc0 + pm0; s_mi[k][1] = bc1 + pm1;
                    s_we[k][0] = __expf(ae0 - m_loc); s_we[k][1] = __expf(ae1 - m_loc);
                    if (lane == 0) { l_g[ch] = gtot; l_ml[ch] = m_loc; }
                } }
            __syncthreads();
            if (tid == 0) { float m = 0.f;
                for (int ch = 0; ch < 34; ++ch) { const float g = l_g[ch], ml = l_ml[ch], mn = fmaxf(g + m, ml);
                    l_mr[ch] = m; CH[2 * ch] = __expf(g + m - mn); CH[2 * ch + 1] = __expf(ml - mn); m = mn; } }
            __syncthreads();
#pragma unroll
            for (int k = 0; k < 5; ++k) { const int ch = wave + 8 * k;
                if (ch < 34) {
#pragma unroll
                    for (int q = 0; q < 2; ++q) {
                        const float m_inter = s_bc[k][q] + l_mr[ch], mt = fmaxf(s_mi[k][q], m_inter);
                        T4[(size_t)(ch * 128 + 64 * q + lane) * 2] = (f32x4){s_bc[k][q] - mt, s_li[k][q] - s_bc[k][q], __expf(m_inter - mt), s_we[k][q]};
                        T4[(size_t)(ch * 128 + 64 * q + lane) * 2 + 1] = (f32x4){__expf(-mt), 0.f, 0.f, 0.f}; }
                } }
        }
    }
}

template <int NB>
__device__ __forceinline__ void ssd_item(const bf16* XBC, const unsigned char* tab, bf16* SCb, int b, int d, int h, LAS unsigned char* lds) {
    typedef ScanTab<NB> ST;
    const int tid = otid(), lane = tid & 63, wave = tid >> 6, g = h >> 3, combo = b * 32 + d * 16 + h;
    LAS unsigned char* Xs = lds; LAS unsigned char* Bs = lds + 18432; LAS unsigned char* Cs = lds + 53248;
    LAS unsigned char* Ss = lds + 88064; LAS unsigned char* Ms = lds + 105472;
    LAS float* acs = (LAS float*)(lds + 140288); LAS float* dtv = acs + 128; LAS float* wv = acs + 256; LAS float* eav = acs + 384;
    const f32x4* T4 = (const f32x4*)(tab + ST::SSD_TAB) + (size_t)combo * NSTEP; const float* DEC = (const float*)(tab + ST::SSD_DEC) + combo * 34;
    f32x16 st;
#pragma unroll
    for (int r = 0; r < 16; ++r) st[r] = 0.f;
    constexpr int NCH = (CTXL + SEQ) / 128;
    u32x4 rx[2], rb[4], rc[4]; f32x4 rt = {0.f, 0.f, 0.f, 0.f}; float rdec = 0.f;
#define SSD_LOAD(ch) do { \
    _Pragma("unroll") for (int i = 0; i < 2; ++i) { const int idx = tid + 512 * i, l = idx >> 3, c = idx & 7; \
        rx[i] = *(const u32x4*)(XBC + (size_t)scan_row<NB>(b, d, (ch) * 128 + l) * 1536 + h * 64 + c * 8); } \
    _Pragma("unroll") for (int i = 0; i < 4; ++i) { const int idx = tid + 512 * i, l = idx >> 4, c = idx & 15; \
        const bf16* rp = XBC + (size_t)scan_row<NB>(b, d, (ch) * 128 + l) * 1536 + 1024 + g * 128 + c * 8; \
        rb[i] = *(const u32x4*)rp; rc[i] = *(const u32x4*)(rp + 256); } \
    if (tid < 128) rt = T4[(ch) * 128 + tid]; \
    rdec = DEC[ch]; } while (0)
    SSD_LOAD(0);
    const int pbw = wave >> 2, nbw = wave & 3;
    for (int ch = 0; ch < NCH; ++ch) {
#pragma unroll
        for (int i = 0; i < 2; ++i) { const int idx = tid + 512 * i, l = idx >> 3, c = idx & 7; *(LAS u32x4*)(Xs + l * RS_X + c * 16) = rx[i]; }
#pragma unroll
        for (int i = 0; i < 4; ++i) { const int idx = tid + 512 * i, l = idx >> 4, c = idx & 15;
            *(LAS u32x4*)(Bs + l * RS_N + c * 16) = rb[i]; *(LAS u32x4*)(Cs + l * RS_N + c * 16) = rc[i]; }
        if (tid < 128) { acs[tid] = rt[0]; dtv[tid] = rt[1]; wv[tid] = rt[2]; eav[tid] = rt[3]; }
        const float dec = rdec;
        {
            const int pp = 32 * pbw + (lane & 31);
#pragma unroll
            for (int gq = 0; gq < 4; ++gq) { u32x2 o; o[0] = pk2(st[4 * gq], st[4 * gq + 1]); o[1] = pk2(st[4 * gq + 2], st[4 * gq + 3]);
                *(LAS u32x2*)(Ss + pp * RS_N + (32 * nbw + 8 * gq + 4 * (lane >> 5)) * 2) = o; }
        }
        __syncthreads();
        if (ch + 1 < NCH) SSD_LOAD(ch + 1);
        {
            const int lbA = wave >> 1, sbp = wave & 1;
            const int l = 32 * lbA + (lane & 31);
            const float al = acs[l];
#pragma unroll
            for (int q = 0; q < 2; ++q) { const int sb = 2 * sbp + q;
                if (sb <= lbA) {
                    f32x16 cb;
#pragma unroll
                    for (int r = 0; r < 16; ++r) cb[r] = 0.f;
#pragma unroll
                    for (int kk = 0; kk < 8; ++kk) cb = mfma32(frag_row(Bs, RS_N, 32 * sb, 16 * kk, lane), frag_row(Cs, RS_N, 32 * lbA, 16 * kk, lane), cb);
#pragma unroll
                    for (int gq = 0; gq < 4; ++gq) { const int s0 = 32 * sb + 8 * gq + 4 * (lane >> 5);
                        const f32x4 as4 = *(const LAS f32x4*)(acs + s0), dt4 = *(const LAS f32x4*)(dtv + s0);
                        float m[4];
#pragma unroll
                        for (int j = 0; j < 4; ++j) m[j] = (s0 + j <= l) ? cb[4 * gq + j] * __expf(fminf(al - as4[j], 0.f)) * dt4[j] : 0.f;
                        u32x2 o; o[0] = pk2(m[0], m[1]); o[1] = pk2(m[2], m[3]);
                        *(LAS u32x2*)(Ms + l * RS_N + s0 * 2) = o; } } }
        }
        {
#pragma unroll
            for (int r = 0; r < 16; ++r) st[r] *= dec;
#pragma unroll
            for (int kb = 0; kb < 2; ++kb) {
                bf16x4 tx[4][2], tb[4][2];
                tr_col4(Xs, RS_X, 64 * kb, 32 * pbw, lane, tx);
                tr_col4(Bs, RS_N, 64 * kb, 32 * nbw, lane, tb);
#pragma unroll
                for (int k4 = 0; k4 < 4; ++k4) {
                    const int l0 = 16 * (4 * kb + k4) + 8 * (lane >> 5);
                    const f32x4 w0 = *(const LAS f32x4*)(wv + l0), w1 = *(const LAS f32x4*)(wv + l0 + 4);
                    st = mfma32(tr_join(tb[k4][0], tb[k4][1]), scale_frag(tr_join(tx[k4][0], tx[k4][1]), w0, w1), st);
                }
            }
        }
        __syncthreads();
        {
            const int pb = wave >> 2, lb = wave & 3;
            f32x16 acc;
#pragma unroll
            for (int r = 0; r < 16; ++r) acc[r] = 0.f;
#pragma unroll
            for (int kk = 0; kk < 8; ++kk) acc = mfma32(frag_row(Ss, RS_N, 32 * pb, 16 * kk, lane), frag_row(Cs, RS_N, 32 * lb, 16 * kk, lane), acc);
            const int l = 32 * lb + (lane & 31);
            const float ea = eav[l];
#pragma unroll
            for (int r = 0; r < 16; ++r) acc[r] *= ea;
            for (int sb = 0; sb <= lb; ++sb) {
                bf16x4 t2[2][2];
                const bf16x8 m0 = frag_row(Ms, RS_N, 32 * lb, 32 * sb, lane), m1 = frag_row(Ms, RS_N, 32 * lb, 32 * sb + 16, lane);
                tr_col2(Xs, RS_X, 32 * sb, 32 * pb, lane, t2);
                acc = mfma32(tr_join(t2[0][0], t2[0][1]), m0, acc);
                acc = mfma32(tr_join(t2[1][0], t2[1][1]), m1, acc);
            }
            bf16* yp = SCb + (size_t)scan_row<NB>(b, d, ch * 128 + l) * 4096 + d * 1024 + h * 64 + 32 * pb + 4 * (lane >> 5);
#pragma unroll
            for (int gq = 0; gq < 4; ++gq) { u32x2 o; o[0] = pk2(acc[4 * gq], acc[4 * gq + 1]); o[1] = pk2(acc[4 * gq + 2], acc[4 * gq + 3]); *(u32x2*)(yp + 8 * gq) = o; }
        }
        __syncthreads();
    }
#undef SSD_LOAD
}

template <int NB>
__device__ __forceinline__ void mlstm_item(const bf16* PROJ, const unsigned char* tab, bf16* SCb, int b, int d, int hh, int ev, LAS unsigned char* lds) {
    typedef ScanTab<NB> ST;
    const int tid = otid(), lane = tid & 63, wave = tid >> 6, combo = b * 8 + d * 4 + hh;
    LAS unsigned char* Qs = lds; LAS unsigned char* Ks = lds + 34816; LAS unsigned char* Vs = lds + 69632;
    LAS unsigned char* Ct = lds + 88064; LAS unsigned char* Sm = lds + 105472;
    LAS float* tb = (LAS float*)(lds + 140288);
    LAS float* t_u = tb, *t_v = tb + 128, *t_wi = tb + 256, *t_we = tb + 384, *t_em = tb + 512, *t_qn = tb + 640, *t_n = tb + 768, *t_nc = tb + 896, *t_rs = tb + 1024  ;
    const f32x4* T4 = (const f32x4*)(tab + ST::ML_TAB) + (size_t)combo * NSTEP * 2; const float* CH = (const float*)(tab + ST::ML_CH) + combo * 34 * 2;
    const float kscale = 0.08838834764831845f;
    f32x16 st;
#pragma unroll
    for (int r = 0; r < 16; ++r) st[r] = 0.f;
    if (tid < 128) t_n[tid] = 0.f;
    constexpr int NCH = (CTXL + SEQ) / 128;
    const int kbw = wave & 3, ebw = wave >> 2;
    u32x4 rq[4], rk[4], rv[2]; f32x4 rt = {0.f, 0.f, 0.f, 0.f}; float ras = 0.f, rbb = 0.f;
#define ML_LOAD(ch) do { \
    _Pragma("unroll") for (int i = 0; i < 4; ++i) { const int idx = tid + 512 * i, l = idx >> 4, c = idx & 15; \
        const bf16* rp = PROJ + (size_t)scan_row<NB>(b, d, (ch) * 128 + l) * PROJW + hh * 128 + c * 8; \
        rq[i] = *(const u32x4*)(rp + PC_Q); rk[i] = *(const u32x4*)(rp + PC_K); } \
    _Pragma("unroll") for (int i = 0; i < 2; ++i) { const int idx = tid + 512 * i, l = idx >> 3, c = idx & 7; \
        rv[i] = *(const u32x4*)(PROJ + (size_t)scan_row<NB>(b, d, (ch) * 128 + l) * PROJW + PC_V + hh * 256 + ev * 64 + c * 8); } \
    if (tid < 256) rt = T4[(size_t)(ch) * 256 + tid]; \
    ras = CH[2 * (ch)]; rbb = CH[2 * (ch) + 1]; } while (0)
    ML_LOAD(0);
    for (int ch = 0; ch < NCH; ++ch) {
#pragma unroll
        for (int i = 0; i < 4; ++i) { const int idx = tid + 512 * i, l = idx >> 4, c = idx & 15;
            *(LAS u32x4*)(Qs + l * RS_N + c * 16) = rq[i]; *(LAS u32x4*)(Ks + l * RS_N + c * 16) = rk[i]; }
#pragma unroll
        for (int i = 0; i < 2; ++i) { const int idx = tid + 512 * i, l = idx >> 3, c = idx & 7; *(LAS u32x4*)(Vs + l * RS_X + c * 16) = rv[i]; }
        if (tid < 256) { const int l = tid >> 1; if (tid & 1) t_em[l] = rt[0]; else { t_u[l] = rt[0]; t_v[l] = rt[1]; t_wi[l] = rt[2]; t_we[l] = rt[3]; } }
        const float a_s = ras, bbs = rbb;
        {
            const int ee = 32 * ebw + (lane & 31);
#pragma unroll
            for (int gq = 0; gq < 4; ++gq) { u32x2 o; o[0] = pk2(st[4 * gq], st[4 * gq + 1]); o[1] = pk2(st[4 * gq + 2], st[4 * gq + 3]);
                *(LAS u32x2*)(Ct + ee * RS_N + (32 * kbw + 8 * gq + 4 * (lane >> 5)) * 2) = o; }
        }
        __syncthreads();
        if (ch + 1 < NCH) ML_LOAD(ch + 1);
        {
            const int lbA = wave >> 1, sbp = wave & 1;
            const int l = 32 * lbA + (lane & 31);
            const float ul = t_u[l];
#pragma unroll
            for (int q = 0; q < 2; ++q) { const int sb = 2 * sbp + q;
                if (sb <= lbA) {
                    f32x16 cb;
#pragma unroll
                    for (int r = 0; r < 16; ++r) cb[r] = 0.f;
#pragma unroll
                    for (int kk = 0; kk < 8; ++kk) cb = mfma32(frag_row(Ks, RS_N, 32 * sb, 16 * kk, lane), frag_row(Qs, RS_N, 32 * lbA, 16 * kk, lane), cb);
                    float rsum = 0.f;
#pragma unroll
                    for (int gq = 0; gq < 4; ++gq) { const int s0 = 32 * sb + 8 * gq + 4 * (lane >> 5);
                        const f32x4 v4 = *(const LAS f32x4*)(t_v + s0);
                        float m[4];
#pragma unroll
                        for (int j = 0; j < 4; ++j) { m[j] = (s0 + j <= l) ? cb[4 * gq + j] * kscale * __expf(fminf(ul + v4[j], 0.f)) : 0.f; rsum += m[j]; }
                        u32x2 o; o[0] = pk2(m[0], m[1]); o[1] = pk2(m[2], m[3]);
                        *(LAS u32x2*)(Sm + l * RS_N + s0 * 2) = o; }
                    rsum += __shfl_xor(rsum, 32);
                    if (lane < 32) t_rs[sb * 128 + l] = rsum;
                } }
            if (wave == 1 || wave == 3) {
                const int lq = (wave == 1 ? 0 : 64) + lane;
                float qn = 0.f;
#pragma unroll 4
                for (int c = 0; c < 16; ++c) { const u32x4 qv = *(const LAS u32x4*)(Qs + lq * RS_N + c * 16);
                    const f32x4 n0 = *(const LAS f32x4*)(t_n + c * 8), n1 = *(const LAS f32x4*)(t_n + c * 8 + 4);
                    qn += bflo(qv[0]) * n0[0] + bfhi(qv[0]) * n0[1] + bflo(qv[1]) * n0[2] + bfhi(qv[1]) * n0[3]
                        + bflo(qv[2]) * n1[0] + bfhi(qv[2]) * n1[1] + bflo(qv[3]) * n1[2] + bfhi(qv[3]) * n1[3]; }
                t_qn[lq] = qn;
            }
        }
        {
#pragma unroll
            for (int r = 0; r < 16; ++r) st[r] *= a_s;
            const float f = bbs * kscale;
            f32x16 nacc;
#pragma unroll
            for (int r = 0; r < 16; ++r) nacc[r] = 0.f;
            bf16x8 ones;
#pragma unroll
            for (int j = 0; j < 8; ++j) ones[j] = (short)0x3f80;
#pragma unroll
            for (int kb2 = 0; kb2 < 2; ++kb2) {
                bf16x4 tk[4][2], tv[4][2];
                tr_col4(Ks, RS_N, 64 * kb2, 32 * kbw, lane, tk);
                tr_col4(Vs, RS_X, 64 * kb2, 32 * ebw, lane, tv);
#pragma unroll
                for (int k4 = 0; k4 < 4; ++k4) {
                    const int l0 = 16 * (4 * kb2 + k4) + 8 * (lane >> 5);
                    f32x4 w0 = *(const LAS f32x4*)(t_we + l0), w1 = *(const LAS f32x4*)(t_we + l0 + 4);
#pragma unroll
                    for (int j = 0; j < 4; ++j) { w0[j] *= f; w1[j] *= f; }
                    const bf16x8 ka = scale_frag(tr_join(tk[k4][0], tk[k4][1]), w0, w1);
                    st = mfma32(ka, tr_join(tv[k4][0], tv[k4][1]), st);
                    if (ebw == 0) nacc = mfma32(ka, ones, nacc);
                }
            }
            if (ebw == 0 && (lane & 31) == 0) {
#pragma unroll
                for (int gq = 0; gq < 4; ++gq)
#pragma unroll
                    for (int j = 0; j < 4; ++j) t_nc[32 * kbw + 8 * gq + 4 * (lane >> 5) + j] = nacc[4 * gq + j];
            }
        }
        __syncthreads();
        if (tid < 128) t_n[tid] = a_s * t_n[tid] + t_nc[tid];
        {
            const int eb = wave >> 2, lb = wave & 3;
            f32x16 acc;
#pragma unroll
            for (int r = 0; r < 16; ++r) acc[r] = 0.f;
#pragma unroll
            for (int kk = 0; kk < 8; ++kk) acc = mfma32(frag_row(Ct, RS_N, 32 * eb, 16 * kk, lane), frag_row(Qs, RS_N, 32 * lb, 16 * kk, lane), acc);
            const int l = 32 * lb + (lane & 31);
            const float wi = t_wi[l];
#pragma unroll
            for (int r = 0; r < 16; ++r) acc[r] *= wi;
            float rsum = 0.f;
            for (int sb = 0; sb <= lb; ++sb) {
                bf16x4 t2[2][2];
                const bf16x8 m0 = frag_row(Sm, RS_N, 32 * lb, 32 * sb, lane), m1 = frag_row(Sm, RS_N, 32 * lb, 32 * sb + 16, lane);
                rsum += t_rs[sb * 128 + l];
                tr_col2(Vs, RS_X, 32 * sb, 32 * eb, lane, t2);
                acc = mfma32(tr_join(t2[0][0], t2[0][1]), m0, acc);
                acc = mfma32(tr_join(t2[1][0], t2[1][1]), m1, acc);
            }
            float den = rsum + t_qn[l] * wi;
            den = fmaxf(fabsf(den), t_em[l]);
            const float inv = 1.f / den;
            bf16* hp = SCb + (size_t)scan_row<NB>(b, d, ch * 128 + l) * 4096 + 2048 + d * 1024 + hh * 256 + ev * 64 + 32 * eb + 4 * (lane >> 5);
#pragma unroll
            for (int gq = 0; gq < 4; ++gq) { u32x2 o; o[0] = pk2(acc[4 * gq] * inv, acc[4 * gq + 1] * inv); o[1] = pk2(acc[4 * gq + 2] * inv, acc[4 * gq + 3] * inv); *(u32x2*)(hp + 8 * gq) = o; }
        }
        __syncthreads();
    }
#undef ML_LOAD
}

template <int NB>
__device__ __forceinline__ void phase_scan(const bf16* PROJ, const unsigned char* tab, const bf16* XBC, bf16* SCb, LAS unsigned char* lds, int mode = 3) {
    const int G = gridDim.x;
    if (mode & 1) for (int item = blockIdx.x; item < NB * 32; item += G) { const int b = item / 32, d = (item >> 4) & 1, h = item & 15;
        ssd_item<NB>(XBC, tab, SCb, b, d, h, lds); }
    const int v = (blockIdx.x + G - (NB * 32) % G) % G;
    if (mode & 2) for (int it = v; it < NB * 32; it += G) { const int b = it / 32, d = (it >> 4) & 1, hh = (it >> 2) & 3, ev = it & 3;
        mlstm_item<NB>(PROJ, tab, SCb, b, d, hh, ev, lds); }
}

template <int NB>
__device__ __forceinline__ void phase_mixer_out(const In& in, const bf16* PROJ, const bf16* XBC, bf16* SCb) {
    constexpr int T = NB * (SEQ + CTXL);
    const int lane = otid() & 63, wave = otid() >> 6;
    for (int row = blockIdx.x * NWAVE + wave; row < T; row += gridDim.x * NWAVE) {
        bf16* sc = SCb + (size_t)row * 4096;
        const bf16* pr = PROJ + (size_t)row * PROJW;
        float yv[16], hv[16], ss = 0.f, hs[2] = {0.f, 0.f};
#pragma unroll
        for (int i = 0; i < 2; ++i) { const int c = lane * 8 + 512 * i;
            const u32x4 y0 = *(const u32x4*)(sc + c), y1 = *(const u32x4*)(sc + 1024 + c), h0 = *(const u32x4*)(sc + 2048 + c), h1 = *(const u32x4*)(sc + 3072 + c);
            const u32x4 xs = *(const u32x4*)(XBC + (size_t)row * 1536 + c), z = *(const u32x4*)(pr + PC_Z + c);
            const float dk = in.ssd_d[c >> 6];
#pragma unroll
            for (int j = 0; j < 4; ++j) {
                float a0 = bflo(y0[j]) + bflo(y1[j]) + dk * bflo(xs[j]), a1 = bfhi(y0[j]) + bfhi(y1[j]) + dk * bfhi(xs[j]);
                a0 *= siluf(bflo(z[j])); a1 *= siluf(bfhi(z[j]));
                yv[8 * i + 2 * j] = a0; yv[8 * i + 2 * j + 1] = a1; ss += a0 * a0 + a1 * a1;
                const float b0 = bflo(h0[j]) + bflo(h1[j]), b1 = bfhi(h0[j]) + bfhi(h1[j]);
                hv[8 * i + 2 * j] = b0; hv[8 * i + 2 * j + 1] = b1; hs[i] += b0 * b0 + b1 * b1; } }
        ss = wave_sum(ss);
        const float rs = rsqrtf(ss * (1.f / 1024.f) + 1e-6f);
#pragma unroll
        for (int i = 0; i < 2; ++i) {
#pragma unroll
            for (int o = 16; o > 0; o >>= 1) hs[i] += __shfl_xor(hs[i], o);
            hs[i] = rsqrtf(hs[i] * (1.f / 256.f) + 1e-6f); }
        __builtin_amdgcn_s_waitcnt(0);
#pragma unroll
        for (int i = 0; i < 2; ++i) { const int c = lane * 8 + 512 * i;
            const u32x4 ov = *(const u32x4*)(pr + PC_O + c);
            u32x4 oy, oh;
#pragma unroll
            for (int j = 0; j < 4; ++j) {
                oy[j] = pk2(yv[8 * i + 2 * j] * rs * in.ssd_norm_w[c + 2 * j], yv[8 * i + 2 * j + 1] * rs * in.ssd_norm_w[c + 2 * j + 1]);
                oh[j] = pk2(hv[8 * i + 2 * j] * hs[i] * in.ml_norm_w[c + 2 * j] * sigmf(bflo(ov[j])), hv[8 * i + 2 * j + 1] * hs[i] * in.ml_norm_w[c + 2 * j + 1] * sigmf(bfhi(ov[j]))); }
            *(u32x4*)(sc + c) = oy; *(u32x4*)(sc + 1024 + c) = oh; }
    }
}

template <int NB>
__device__ __forceinline__ void phase_outproj(const bf16* A, int lda, int K, const bf16* Wt, int nrows, const float* xl, const float* xc, const float* modl, float* Xout,
                                              LAS unsigned char* lds) {
    constexpr int TL = NB * SEQ;
    const int MT = nrows / 256;
    for (int r = 0; r * (int)gridDim.x < MT * 8; ++r) {
        const int u = xcd_unit(r); if (u >= MT * 8) continue;
        int mt, nt; unit_tile(u, MT, 8, mt, nt);
        const bf16* arow[4];
#pragma unroll
        for (int i = 0; i < 4; ++i) arow[i] = A + (size_t)(mt * 256 + (otid() >> 3) + 64 * i) * lda;
        gemm_tile(arow, Wt + (size_t)nt * 128 * K, K, K, lds, [&](const f32x16 (&acc)[2][2], int wm, int wn, int lane) { stage_f32_128(acc, lds, wm, wn, lane); });
        __syncthreads();
        {
            const float* mv = modl + (size_t)mod_row<NB>(mt * 256) * 6144 + 2 * 1024 + nt * 128;
            const int t = otid(), piece = t & 31;
            const f32x4 m2 = *(const f32x4*)(mv + piece * 4);
#pragma unroll 4
            for (int it = 0; it < 16; ++it) { const int rl = it * 16 + (t >> 5), row = mt * 256 + rl;
                const f32x4 a = *(const LAS f32x4*)(lds + rl * CST_F32 + piece * 16);
                const float* srcp = (row < TL ? xl + (size_t)row * D : xc + (size_t)(row - TL) * D) + nt * 128 + piece * 4;
                const f32x4 xv = *(const f32x4*)srcp;
                f32x4 o;
#pragma unroll
                for (int j = 0; j < 4; ++j) o[j] = xv[j] + m2[j] * a[j];
                *(f32x4*)(Xout + (size_t)row * D + nt * 128 + piece * 4) = o; }
        }
        __syncthreads();
    }
}
}
namespace fx {
__device__ __forceinline__ int moe_prefix(const int* cnt, LAS int* pre  ) {
    __syncthreads();
    if (otid() < 64) {
        const int lane = otid();
        int v = lane < 32 ? (cnt[lane * 64] + 255) >> 8 : 0;
#pragma unroll
        for (int o = 1; o < 32; o <<= 1) { const int t = __shfl_up(v, o); if (lane >= o) v += t; }
        if (lane < 32) pre[lane + 1] = v;
        if (lane == 0) pre[0] = 0;
    }
    __syncthreads();
    return pre[32];
}
__device__ __forceinline__ int moe_find(const LAS int* pre, int t) { int e = 0;
#pragma unroll
    for (int i = 1; i < 32; ++i) e += (t >= pre[i]) ? 1 : 0;
    return e; }

__device__ __forceinline__ void phase_moe_up(const bf16* H2, const bf16* Wgu, const int* cnt, const int* list, int cap, const float* route_w, bf16* ACT, LAS unsigned char* lds) {
    LAS int* pre = (LAS int*)(lds + GEMM_LDS);
    const int ntile = moe_prefix(cnt, pre);
    for (int r = 0; r * (int)gridDim.x < ntile * 8; ++r) {
        const int u = xcd_unit(r); if (u >= ntile * 8) continue;
        const int t = u >> 3, nt = u & 7, e = moe_find(pre, t), mt = t - pre[e], ce = cnt[e * 64];
        const int* le = list + (size_t)e * cap + mt * 256;
        const int nvalid = ce - mt * 256;
        const bf16* arow[4];
#pragma unroll
        for (int i = 0; i < 4; ++i) { const int r = (otid() >> 3) + 64 * i; const int ent = le[r < nvalid ? r : 0]; arow[i] = H2 + (size_t)(ent >> 1) * D; }
        gemm_tile(arow, Wgu + (size_t)e * 1024 * 1024 + (size_t)nt * 128 * 1024, 1024, 1024, lds, [&](const f32x16 (&acc)[2][2], int wm, int wn, int lane) {
#pragma unroll
            for (int mi = 0; mi < 2; ++mi) { const int r = wm * 64 + mi * 32 + (lane & 31);
                const float w = r < nvalid ? route_w[le[r]] : 0.f;
                LAS unsigned char* rp = lds + r * CST_BF64 + (wn * 32 + 4 * (lane >> 5)) * 2;
#pragma unroll
                for (int g = 0; g < 4; ++g) { float v[4];
#pragma unroll
                    for (int j = 0; j < 4; ++j) v[j] = siluf(acc[mi][0][4 * g + j]) * acc[mi][1][4 * g + j] * w;
                    u32x2 o; o[0] = pk2(v[0], v[1]); o[1] = pk2(v[2], v[3]); *(LAS u32x2*)(rp + 8 * g * 2) = o; } }
        });
        __syncthreads();
        flush_bf16_64(lds, [&](int r) -> bf16* { return r < nvalid ? ACT + (size_t)le[r] * 512 + nt * 64 : nullptr; });
        __syncthreads();
    }
}
__device__ __forceinline__ void phase_moe_down(const bf16* ACT, const bf16* Wd, const int* cnt, const int* list, int cap, bf16* Y2, LAS unsigned char* lds) {
    LAS int* pre = (LAS int*)(lds + GEMM_LDS);
    const int ntile = moe_prefix(cnt, pre);
    for (int r = 0; r * (int)gridDim.x < ntile * 8; ++r) {
        const int u = xcd_unit(r); if (u >= ntile * 8) continue;
        const int t = u >> 3, nt = u & 7, e = moe_find(pre, t), mt = t - pre[e], ce = cnt[e * 64];
        const int* le = list + (size_t)e * cap + mt * 256;
        const int nvalid = ce - mt * 256;
        const bf16* arow[4];
#pragma unroll
        for (int i = 0; i < 4; ++i) { const int r = (otid() >> 3) + 64 * i; const int ent = le[r < nvalid ? r : 0]; arow[i] = ACT + (size_t)ent * 512; }
        gemm_tile(arow, Wd + (size_t)e * 1024 * 512 + (size_t)nt * 128 * 512, 512, 512, lds, [&](const f32x16 (&acc)[2][2], int wm, int wn, int lane) { stage_bf16_128(acc, lds, wm, wn, lane); });
        __syncthreads();
        flush_bf16_128(lds, [&](int r) -> bf16* { return r < nvalid ? Y2 + (size_t)le[r] * D + nt * 128 : nullptr; });
        __syncthreads();
    }
}

template <int NB>
__device__ __forceinline__ void phase_qkv(const bf16* H, const bf16* Wt, const float* qn, const float* kn, bf16* QKV, LAS unsigned char* lds) {
    constexpr int T = NB * (SEQ + CTXL), MT = T / 256;
    for (int r = 0; r * (int)gridDim.x < MT * 24; ++r) {
        const int u = xcd_unit(r); if (u >= MT * 24) continue;
        int mt, nt; unit_tile(u, MT, 24, mt, nt);
        const bf16* arow[4];
#pragma unroll
        for (int i = 0; i < 4; ++i) arow[i] = H + (size_t)(mt * 256 + (otid() >> 3) + 64 * i) * D;
        gemm_tile(arow, Wt + (size_t)nt * 128 * D, D, D, lds, [&](const f32x16 (&acc)[2][2], int wm, int wn, int lane) {
            const int which = nt >> 3;
#pragma unroll
            for (int mi = 0; mi < 2; ++mi) {
                float rs = 1.f;
                if (which < 2) { float ss = 0.f;
#pragma unroll
                    for (int ni = 0; ni < 2; ++ni)
#pragma unroll
                        for (int r = 0; r < 16; ++r) ss += acc[mi][ni][r] * acc[mi][ni][r];
                    ss += __shfl_xor(ss, 32);
                    rs = rsqrtf(ss * (1.f / 64.f) + 1e-6f) * (which == 0 ? 0.125f : 1.f); }
                const float* nwp = which == 0 ? qn : kn;
                LAS unsigned char* rp = lds + (wm * 64 + mi * 32 + (lane & 31)) * CST_BF + (wn * 64 + 4 * (lane >> 5)) * 2;
#pragma unroll
                for (int ni = 0; ni < 2; ++ni)
#pragma unroll
                    for (int g = 0; g < 4; ++g) { float v[4];
#pragma unroll
                        for (int j = 0; j < 4; ++j) { v[j] = acc[mi][ni][4 * g + j]; if (which < 2) v[j] *= rs * nwp[ni * 32 + 8 * g + 4 * (lane >> 5) + j]; }
                        u32x2 o; o[0] = pk2(v[0], v[1]); o[1] = pk2(v[2], v[3]); *(LAS u32x2*)(rp + (ni * 32 + 8 * g) * 2) = o; } }
        });
        __syncthreads();
        flush_bf16_128(lds, [&](int r) { return QKV + (size_t)(mt * 256 + r) * 3072 + nt * 128; });
        __syncthreads();
    }
}

__device__ __forceinline__ bf16x8 frag16_row(const LAS unsigned char* T, int RS, int r0, int c0, int lane) {
    return *(const LAS bf16x8*)(T + (r0 + (lane & 15)) * RS + (c0 + 8 * (lane >> 4)) * 2);
}
__device__ __forceinline__ bf16x8 frag16_vt(const LAS unsigned char* T, int RS, int kb, int c0, int lane) {
    const int g4 = lane >> 4, q = (lane & 15) >> 2, p = lane & 3;
    const unsigned a0 = (unsigned)(size_t)(T + (kb + 4 * g4 + q) * RS + (c0 + 4 * p) * 2);
    const unsigned a1 = a0 + 16 * RS;
    bf16x4 v0, v1;
    asm volatile("ds_read_b64_tr_b16 %0, %2\n\tds_read_b64_tr_b16 %1, %3\n\ts_waitcnt lgkmcnt(0)" : "=&v"(v0), "=&v"(v1) : "v"(a0), "v"(a1) : "memory");
    bf16x8 r; r[0] = v0[0]; r[1] = v0[1]; r[2] = v0[2]; r[3] = v0[3]; r[4] = v1[0]; r[5] = v1[1]; r[6] = v1[2]; r[7] = v1[3];
    return r;
}

template <bool LOCAL>
__device__ __forceinline__ void attn_group(const LAS unsigned char* Kt, const LAS unsigned char* Vt, int kb, int hsel, int lane, int g4,
                                           const bf16x8& q0, const bf16x8& q1, f32x4 (&oacc)[4], float& l_run,
                                           int cs, int c, int brow  , const LAS float* rp) {
    f32x4 s[2];
#pragma unroll
    for (int sb = 0; sb < 2; ++sb) { s[sb] = (f32x4){0.f, 0.f, 0.f, 0.f};
        s[sb] = mfma16(frag16_row(Kt, RS_N, kb + 16 * sb, hsel * 64, lane), q0, s[sb]);
        s[sb] = mfma16(frag16_row(Kt, RS_N, kb + 16 * sb, hsel * 64 + 32, lane), q1, s[sb]); }
    float ps = 0.f; float p[8];
#pragma unroll
    for (int sb = 0; sb < 2; ++sb)
#pragma unroll
        for (int j = 0; j < 4; ++j) {
            float e;
            if (LOCAL) { const int kc = kb + 16 * sb + 4 * g4 + j; const bool ok = kc >= cs && kc < cs + 16;
                e = ok ? __expf(s[sb][j] + rp[hsel * 465 + (ok ? brow + (kc - c + 15) : 0)] - 8.f) : 0.f; }
            else e = __expf(s[sb][j] - 8.f);
            p[4 * sb + j] = e; ps += e; }
    l_run += ps;
    u32x4 pu; pu[0] = pk2(p[0], p[1]); pu[1] = pk2(p[2], p[3]); pu[2] = pk2(p[4], p[5]); pu[3] = pk2(p[6], p[7]);
    const bf16x8 pf = __builtin_bit_cast(bf16x8, pu);
    bf16x4 tv[4][2];
    {
        const int q = (lane & 15) >> 2, p4 = lane & 3;
        const unsigned a = (unsigned)(size_t)(Vt + (kb + 4 * g4 + q) * RS_N + (hsel * 64 + 4 * p4) * 2);
        tr8(a, a + 16 * RS_N, a + 32, a + 32 + 16 * RS_N, a + 64, a + 64 + 16 * RS_N, a + 96, a + 96 + 16 * RS_N,
            tv[0][0], tv[0][1], tv[1][0], tv[1][1], tv[2][0], tv[2][1], tv[3][0], tv[3][1]);
    }
#pragma unroll
    for (int db = 0; db < 4; ++db) oacc[db] = mfma16(tr_join(tv[db][0], tv[db][1]), pf, oacc[db]);
}

constexpr int ATT_QR = 2;
template <int NB>
__device__ __forceinline__ void phase_attn(const bf16* QKV, const float* rpb, bf16* AO, LAS unsigned char* lds) {
    constexpr int TL = NB * SEQ;
    constexpr int TILE = 64 * RS_N;
    const int tid = otid(), lane = tid & 63, wave = tid >> 6, w = wave & 3, hsel = wave >> 2;
    const int qi = lane & 15, g4 = lane >> 4;
    LAS float* rp = (LAS float*)(lds + 4 * TILE);
    constexpr int QR = ATT_QR, NRG = 64 / QR;
    for (int u = blockIdx.x; u < NB * NRG * 8; u += gridDim.x) {
        const int hp = u & 7, rg = (u >> 3) % NRG, b = (u >> 3) / NRG;
        const int head = 2 * hp + hsel;
        int R0 = QR * rg - 4; R0 = R0 < 0 ? 0 : (R0 > 56 ? 56 : R0);
        int R1 = QR * rg + QR - 1 - 4; R1 = (R1 < 0 ? 0 : (R1 > 56 ? 56 : R1)) + 7;
        const int nloc = R1 - R0 + 1, nit = nloc + 4;
        __syncthreads();
        for (int i = tid; i < 2 * 465; i += NTHR) rp[i] = rpb[(size_t)(2 * hp) * 465 + i];
        const int c = 16 * w + qi;
        int cs = c - 8; cs = cs < 0 ? 0 : (cs > 48 ? 48 : cs);
        const int kbw = w == 0 ? 0 : (w == 1 ? 8 : (w == 2 ? 24 : 32));
        bf16x8 q0[QR], q1[QR]; f32x4 oacc[QR][4]; float l_run[QR];
#pragma unroll
        for (int qr = 0; qr < QR; ++qr) {
            const size_t qrow = (size_t)b * SEQ + (QR * rg + qr) * 64 + c;
            q0[qr] = *(const bf16x8*)(QKV + qrow * 3072 + head * 64 + 8 * g4); q1[qr] = *(const bf16x8*)(QKV + qrow * 3072 + head * 64 + 32 + 8 * g4);
#pragma unroll
            for (int i = 0; i < 4; ++i) oacc[qr][i] = (f32x4){0.f, 0.f, 0.f, 0.f};
            l_run[qr] = 0.f; }
        u32x4 sk[2], sv[2];
#define AT_LOAD(it) do { \
        _Pragma("unroll") for (int i = 0; i < 2; ++i) { const int idx = tid + 512 * i, key = idx >> 4, ch = idx & 15; \
            const size_t krow = (it) < nloc ? (size_t)b * SEQ + (size_t)(R0 + (it)) * 64 + key : (size_t)TL + (size_t)b * CTXL + ((it) - nloc) * 64 + key; \
            const bf16* kp = QKV + krow * 3072 + 1024 + hp * 128 + ch * 8; sk[i] = *(const u32x4*)kp; sv[i] = *(const u32x4*)(kp + 1024); } } while (0)
#define AT_STORE(buf) do { LAS unsigned char* kt_ = lds + (buf) * 2 * TILE; \
        _Pragma("unroll") for (int i = 0; i < 2; ++i) { const int idx = tid + 512 * i, key = idx >> 4, ch = idx & 15; \
            *(LAS u32x4*)(kt_ + key * RS_N + ch * 16) = sk[i]; *(LAS u32x4*)(kt_ + TILE + key * RS_N + ch * 16) = sv[i]; } } while (0)
        AT_LOAD(0);
        AT_STORE(0);
        __syncthreads();
        for (int it = 0; it < nit; ++it) {
            const LAS unsigned char* Kt = lds + (it & 1) * 2 * TILE; const LAS unsigned char* Vt = Kt + TILE;
            if (it + 1 < nit) AT_LOAD(it + 1);
            if (it < nloc) {
                const int kr = R0 + it;
#pragma unroll
                for (int qr = 0; qr < QR; ++qr) { const int r = QR * rg + qr; int r0 = r - 4; r0 = r0 < 0 ? 0 : (r0 > 56 ? 56 : r0);
                    if (kr >= r0 && kr < r0 + 8)
                        attn_group<true>(Kt, Vt, kbw, hsel, lane, g4, q0[qr], q1[qr], oacc[qr], l_run[qr], cs, c, (kr - r + 7) * 31, rp); }
            } else {
#pragma unroll
                for (int qr = 0; qr < QR; ++qr) {
                    attn_group<false>(Kt, Vt, 0, hsel, lane, g4, q0[qr], q1[qr], oacc[qr], l_run[qr], 0, 0, 0, rp);
                    attn_group<false>(Kt, Vt, 32, hsel, lane, g4, q0[qr], q1[qr], oacc[qr], l_run[qr], 0, 0, 0, rp); }
            }
            if (it + 1 < nit) AT_STORE((it + 1) & 1);
            __syncthreads();
        }
#undef AT_LOAD
#undef AT_STORE
#pragma unroll
        for (int qr = 0; qr < QR; ++qr) {
            float l = l_run[qr]; l += __shfl_xor(l, 16); l += __shfl_xor(l, 32);
            const float inv = 1.f / l;
            const size_t qrow = (size_t)b * SEQ + (QR * rg + qr) * 64 + c;
            bf16* op = AO + qrow * D + head * 64 + 4 * g4;
#pragma unroll
            for (int db = 0; db < 4; ++db) { u32x2 o; o[0] = pk2(oacc[qr][db][0] * inv, oacc[qr][db][1] * inv); o[1] = pk2(oacc[qr][db][2] * inv, oacc[qr][db][3] * inv); *(u32x2*)(op + 16 * db) = o; }
        }
    }
}
}
#define XB_TMO      128
#define XB_XCNT(j)  (256  + 64 * (j))
#define XB_XSUB(j)  (1280 + 64 * (j))
#define XB_XGEN(j)  (2304 + 64 * (j))
#define XB_TOP      3328
#define XB_TOPGEN   3392
#define XCD_BAR_WORDS 3456
#define XB_SPIN_CAP (1u << 18)

__device__ __forceinline__ unsigned xb_ld(unsigned* p)              { return __hip_atomic_load(p, __ATOMIC_RELAXED, __HIP_MEMORY_SCOPE_AGENT); }
__device__ __forceinline__ unsigned xb_add(unsigned* p, unsigned v) { return __hip_atomic_fetch_add(p, v, __ATOMIC_RELAXED, __HIP_MEMORY_SCOPE_AGENT); }
__device__ __forceinline__ unsigned xb_xcc_id() { return (unsigned)__builtin_amdgcn_s_getreg((3 << 11) | 20) & 0xFu; }
#define XB_SPIN(cond, bar) do { unsigned _sp = 0; while (cond) { __builtin_amdgcn_s_sleep(1); \
    if ((++_sp & 255u) == 0u) { if (xb_ld(&(bar)[XB_TMO])) break; if (_sp > XB_SPIN_CAP) { atomicAdd(&(bar)[XB_TMO], 1u); break; } } } } while (0)

struct XcdBarrier {
    unsigned* bar; unsigned x;
    volatile LAS unsigned* st;
};

__device__ __forceinline__ XcdBarrier xcd_barrier_post(unsigned* bar, volatile LAS unsigned* st) {
    XcdBarrier b; b.bar = bar; b.x = xb_xcc_id(); b.st = st;
    if (threadIdx.x == 0) (void)xb_add(&bar[XB_XCNT(b.x)], 1u);
    return b;
}
__device__ __forceinline__ void xcd_barrier_complete(unsigned* bar, unsigned x, unsigned& nloc, unsigned& nx) {
    const unsigned G = gridDim.x * gridDim.y * gridDim.z;
    unsigned sum, cnt, mine, sp = 0u;
    for (;;) {
        sum = 0u; cnt = 0u; mine = 0u;
#pragma unroll
        for (unsigned j = 0; j < 16; ++j) { const unsigned c = xb_ld(&bar[XB_XCNT(j)]); sum += c; cnt += (c > 0u) ? 1u : 0u; mine = (j == x) ? c : mine; }
        if (sum == G) break;
        __builtin_amdgcn_s_sleep(1);
        if ((++sp & 255u) == 0u) { if (xb_ld(&bar[XB_TMO])) break; if (sp > XB_SPIN_CAP) { atomicAdd(&bar[XB_TMO], 1u); break; } }
    }
    nloc = mine > 0u ? mine : 1u; nx = cnt > 0u ? cnt : 1u;
}

__device__ __forceinline__ void xcd_barrier(const XcdBarrier& b) {
    asm volatile("s_waitcnt vmcnt(0)" ::: "memory");
    __syncthreads();
    if (threadIdx.x == 0) {
        unsigned* bar = b.bar;
        __builtin_amdgcn_s_waitcnt(0);
        unsigned nloc = b.st[0], nx = b.st[1];
        if (nloc == 0u) { xcd_barrier_complete(bar, b.x, nloc, nx); b.st[0] = nloc; b.st[1] = nx; }
        const unsigned old = xb_add(&bar[XB_XSUB(b.x)], 1u);
        const unsigned gen = old / nloc;
        if (old + 1u == (gen + 1u) * nloc) {
            __builtin_amdgcn_fence(__ATOMIC_RELEASE, "agent");
            asm volatile("s_waitcnt vmcnt(0)" ::: "memory");
            const unsigned og = xb_add(&bar[XB_TOP], 1u);
            const unsigned tg = og / nx;
            if (og + 1u == (tg + 1u) * nx) xb_add(&bar[XB_TOPGEN], 1u);
            else XB_SPIN(xb_ld(&bar[XB_TOPGEN]) == tg, bar);
            __builtin_amdgcn_fence(__ATOMIC_ACQUIRE, "agent");
            xb_add(&bar[XB_XGEN(b.x)], 1u);
            asm volatile("s_waitcnt vmcnt(0)" ::: "memory");
        } else {
            XB_SPIN(xb_ld(&bar[XB_XGEN(b.x)]) == gen, bar);
            __builtin_amdgcn_fence(__ATOMIC_ACQUIRE, "agent");
            asm volatile("s_waitcnt vmcnt(0)" ::: "memory");
        }
    }
    __syncthreads();
}
namespace mk {
using namespace fx;
constexpr int NB = 4;
typedef Plan<NB> PL;

__global__ void __launch_bounds__(512, 2) k_mega(P p) {
    extern __shared__ __attribute__((aligned(16))) unsigned char lds_raw[];
    LAS unsigned char* lds = (LAS unsigned char*)lds_raw;
    unsigned char* ws = p.ws;
    const In& in = p.in;
    LAS unsigned* xbw = (LAS unsigned*)(lds + LDS_BYTES - 16);
    if (threadIdx.x == 0) { xbw[0] = 0u; xbw[1] = 0u; xbw[2] = 0u; xbw[3] = 0u; }
    __syncthreads();
    XcdBarrier bar = xcd_barrier_post((unsigned*)(ws + PL::CTL_BAR), (volatile LAS unsigned*)xbw);
    float* modv = (float*)(ws + PL::MODV);
    const float* mod0 = modv; const float* mod1 = modv + 5 * 6144;
    bf16* H = (bf16*)(ws + PL::H);
    int* cnt0 = (int*)(ws + PL::CTL_CNT); int* cnt1 = cnt0 + 32 * 64;
    int* list = (int*)(ws + PL::LIST); float* rw = (float*)(ws + PL::RW);
    bf16* wmoe0 = (bf16*)(ws + PL::W_MOE0); bf16* wmoe1 = (bf16*)(ws + PL::W_MOE1);
    const size_t GU = (size_t)32 * 1024 * 1024;
    float* X1 = (float*)(ws + PL::X1); float* X2 = (float*)(ws + PL::X2); float* X3 = (float*)(ws + PL::X3);
#ifndef REPMASK
#define REPMASK 0
#endif
#ifndef XBAR
#define XBAR 0
#endif
#define PH(k, ...) { __VA_ARGS__; xcd_barrier(bar); if ((REPMASK >> (k)) & 1) { __VA_ARGS__; xcd_barrier(bar); } }
    PH(0, conv_small_weights(in, ws, PL::W_IN, PL::W_OUT, PL::W_QKV, PL::W_NAO, lds); mod_vectors(in, modv, lds); conv_moe_weights(in, 0, wmoe0, wmoe0 + GU, lds))
    for (int i = 0; i < XBAR; ++i) xcd_barrier(bar);
    PH(1, rows_phase<NB, false, false, true, false>(in.x, in.ctx, PL::T, nullptr, mod0, mod0, nullptr, nullptr, in.norm1_w, 0, 1, H,
                                              nullptr, nullptr, nullptr, nullptr, nullptr, nullptr, nullptr, 0, lds))
    phase_inproj<NB>(H, (const bf16*)(ws + PL::W_IN), (bf16*)(ws + PL::PROJ), (float*)(ws + PL::GATES), lds);
    xcd_barrier(bar);
#ifdef GVAR
    phase_inproj_v<NB, GVAR>(H, (const bf16*)(ws + PL::W_IN), (bf16*)(ws + PL::PROJ), (float*)(ws + PL::GATES), lds, p.out == nullptr);
    xcd_barrier(bar);
#endif
    PH(3, phase_tables<NB>(in, (const float*)(ws + PL::GATES), ws + PL::H, lds); phase_conv<NB>((const bf16*)(ws + PL::PROJ), in.ab_conv_w, in.ab_conv_b, (bf16*)(ws + PL::XBC)))
    phase_scan<NB>((const bf16*)(ws + PL::PROJ), ws + PL::H, (const bf16*)(ws + PL::XBC), (bf16*)(ws + PL::SC), lds);
    xcd_barrier(bar);
#ifdef SCANMODE
    phase_scan<NB>((const bf16*)(ws + PL::PROJ), ws + PL::H, (const bf16*)(ws + PL::XBC), (bf16*)(ws + PL::SC), lds, p.out ? SCANMODE : 3);
    xcd_barrier(bar);
#endif
    phase_mixer_out<NB>(in, (const bf16*)(ws + PL::PROJ), (const bf16*)(ws + PL::XBC), (bf16*)(ws + PL::SC));
    xcd_barrier(bar);
    PH(6, phase_outproj<NB>((const bf16*)(ws + PL::SC), 4096, 2048, (const bf16*)(ws + PL::W_OUT), PL::T, in.x, in.ctx, mod0, X1, lds))
    rows_phase<NB, false, false, true, true>(X1, X1 + PL::TL * D, PL::T, nullptr, mod0, mod0, nullptr, nullptr, in.norm2_w, 3, 4, H,
        in.moe_w_group, in.moe_b_group, in.moe_w_expert, in.moe_b_expert, rw, cnt0, list, (int)PL::T, lds);
    PH(7, conv_moe_weights(in, 1, wmoe1, wmoe1 + GU, lds))
    PH(8, phase_moe_up(H, wmoe0, cnt0, list, (int)PL::T, rw, (bf16*)(ws + PL::ACT), lds))
    PH(9, phase_moe_down((const bf16*)(ws + PL::ACT), wmoe0 + GU, cnt0, list, (int)PL::T, (bf16*)(ws + PL::Y2), lds))
    PH(10, rows_phase<NB, true, true, true, false>(X1, X1 + PL::TL * D, PL::T, (const bf16*)(ws + PL::Y2), mod0, mod1, X2, nullptr, in.norm1_w + 1024, 0, 1, H,
        nullptr, nullptr, nullptr, nullptr, nullptr, nullptr, nullptr, 0, lds))
    PH(11, phase_qkv<NB>(H, (const bf16*)(ws + PL::W_QKV), in.na_q_norm, in.na_k_norm, (bf16*)(ws + PL::QKV), lds))
    PH(12, phase_attn<NB>((const bf16*)(ws + PL::QKV), in.na_rpb, (bf16*)(ws + PL::AO), lds))
    PH(13, phase_outproj<NB>((const bf16*)(ws + PL::AO), 1024, 1024, (const bf16*)(ws + PL::W_NAO), PL::TL, X2, X2 + PL::TL * D, mod1, X3, lds))
    rows_phase<NB, false, false, true, true>(X3, X3, PL::TL, nullptr, mod1, mod1, nullptr, nullptr, in.norm2_w + 1024, 3, 4, H,
        in.moe_w_group + 1024 * 4, in.moe_b_group + 4, in.moe_w_expert + 1024 * 32, in.moe_b_expert + 32, rw, cnt1, list, (int)PL::T, lds);
    xcd_barrier(bar);
    PH(15, phase_moe_up(H, wmoe1, cnt1, list, (int)PL::T, rw, (bf16*)(ws + PL::ACT), lds))
    PH(16, phase_moe_down((const bf16*)(ws + PL::ACT), wmoe1 + GU, cnt1, list, (int)PL::T, (bf16*)(ws + PL::Y2), lds))
    rows_phase<NB, true, false, false, false>(X3, X3, PL::TL, (const bf16*)(ws + PL::Y2), mod1, mod1, nullptr, p.out, nullptr, 0, 0, nullptr,
        nullptr, nullptr, nullptr, nullptr, nullptr, nullptr, nullptr, 0, lds);
    if ((REPMASK >> 17) & 1) { xcd_barrier(bar); rows_phase<NB, true, false, false, false>(X3, X3, PL::TL, (const bf16*)(ws + PL::Y2), mod1, mod1, nullptr, p.out, nullptr, 0, 0, nullptr,
        nullptr, nullptr, nullptr, nullptr, nullptr, nullptr, nullptr, 0, lds); }
#undef PH
}
__global__ void k_fill(float* q, size_t n, float v) { size_t i = (size_t)blockIdx.x * 256 + threadIdx.x; if (i < n) q[i] = v; }
}

extern "C" void kernel_launch(void* const* d_in, const int* in_sizes, int n_in, void* d_out, int out_size, void* d_ws, size_t ws_size, hipStream_t stream) {
    static int grid = 0;
    if (grid == 0) {
        int dev = 0, cus = 0, per_cu = 0;
        (void)hipGetDevice(&dev);
        (void)hipDeviceGetAttribute(&cus, hipDeviceAttributeMultiprocessorCount, dev);
        if (hipFuncSetAttribute((const void*)mk::k_mega, hipFuncAttributeMaxDynamicSharedMemorySize, fx::LDS_BYTES) != hipSuccess) { grid = -1; }
        else {
            if (hipOccupancyMaxActiveBlocksPerMultiprocessor(&per_cu, (const void*)mk::k_mega, 512, fx::LDS_BYTES) != hipSuccess) per_cu = 0;
            (void)hipGetLastError();
            grid = per_cu >= 1 ? cus : -1;
        }
    }
    if (grid < 0 || n_in != 31 || mk::PL::END > ws_size) { mk::k_fill<<<(out_size + 255) / 256, 256, 0, stream>>>((float*)d_out, (size_t)out_size, 2.f); return; }
    (void)hipMemsetAsync((unsigned char*)d_ws + mk::PL::CTL, 0, mk::PL::CTL_BYTES, stream);
    fx::P fp;
    { const float** q = (const float**)&fp.in; for (int i = 0; i < 31; ++i) q[i] = (const float*)d_in[i]; }
    fp.ws = (unsigned char*)d_ws; fp.out = (float*)d_out;
    hipLaunchKernelGGL(mk::k_mega, dim3(grid), dim3(512), fx::LDS_BYTES, stream, fp);
}
```

```cpp
#include <hip/hip_runtime.h>
#include <cstdio>
#include <cstdint>
namespace fx {
#define LAS __attribute__((address_space(3)))
typedef unsigned short bf16;
typedef short bf16x8 __attribute__((ext_vector_type(8)));
typedef short bf16x4 __attribute__((ext_vector_type(4)));
typedef float f32x16 __attribute__((ext_vector_type(16)));
typedef float f32x4 __attribute__((ext_vector_type(4)));
typedef unsigned u32x4 __attribute__((ext_vector_type(4)));
typedef unsigned u32x2 __attribute__((ext_vector_type(2)));
constexpr int NTHR = 512, NWAVE = 8;
constexpr int D = 1024, SEQ = 4096, CTXL = 256;
constexpr int PROJW = 5632, NIN = 5760;
constexpr int PC_Z = 0, PC_XBC = 1024, PC_Q = 2560, PC_K = 3072, PC_V = 3584, PC_O = 4608;
constexpr int LDS_BYTES = 152 * 1024;

__device__ __forceinline__ int otid() { int t = threadIdx.x; asm volatile("" : "+v"(t)); return t; }
__device__ __forceinline__ float bf2f(bf16 v) { return __uint_as_float((unsigned)v << 16); }
__device__ __forceinline__ float bflo(unsigned u) { return __uint_as_float(u << 16); }
__device__ __forceinline__ float bfhi(unsigned u) { return __uint_as_float(u & 0xffff0000u); }
typedef __bf16 bf16x2_t __attribute__((ext_vector_type(2)));
typedef float f32x2_t __attribute__((ext_vector_type(2)));
__device__ __forceinline__ unsigned pk2(float lo, float hi) { const f32x2_t v = {lo, hi}; return __builtin_bit_cast(unsigned, __builtin_convertvector(v, bf16x2_t)); }
__device__ __forceinline__ float siluf(float v) { return v / (1.f + __expf(-v)); }
__device__ __forceinline__ float sigmf(float v) { return 1.f / (1.f + __expf(-v)); }
__device__ __forceinline__ float softplusf(float v) { return v > 20.f ? v : log1pf(__expf(v)); }
__device__ __forceinline__ float logsigf(float v) { return fminf(v, 0.f) - log1pf(__expf(-fabsf(v))); }
__device__ __forceinline__ float wave_sum(float v) {
#pragma unroll
    for (int o = 32; o > 0; o >>= 1) v += __shfl_xor(v, o);
    return v;
}
__device__ __forceinline__ float wave_max(float v) {
#pragma unroll
    for (int o = 32; o > 0; o >>= 1) v = fmaxf(v, __shfl_xor(v, o));
    return v;
}
__device__ __forceinline__ f32x16 mfma32(bf16x8 a, bf16x8 b, f32x16 c) { return __builtin_amdgcn_mfma_f32_32x32x16_bf16(a, b, c, 0, 0, 0); }
__device__ __forceinline__ f32x4 mfma16(bf16x8 a, bf16x8 b, f32x4 c) { return __builtin_amdgcn_mfma_f32_16x16x32_bf16(a, b, c, 0, 0, 0); }

__device__ __forceinline__ bf16x8 frag_row(const LAS unsigned char* T, int RS, int r0, int k0, int lane) {
    return *(const LAS bf16x8*)(T + (r0 + (lane & 31)) * RS + (k0 + 8 * (lane >> 5)) * 2);
}
__device__ __forceinline__ bf16x8 frag_col(const LAS unsigned char* T, int RS, int k0, int c0, int lane) {
    const int h = lane >> 5, blk = (lane >> 4) & 1, q = (lane & 15) >> 2, p = lane & 3;
    const unsigned a0 = (unsigned)(size_t)(T + (k0 + 8 * h + q) * RS + (c0 + 16 * blk + 4 * p) * 2);
    const unsigned a1 = a0 + 4 * RS;
    bf16x4 v0, v1;
    asm volatile("ds_read_b64_tr_b16 %0, %2\n\tds_read_b64_tr_b16 %1, %3\n\ts_waitcnt lgkmcnt(0)" : "=&v"(v0), "=&v"(v1) : "v"(a0), "v"(a1) : "memory");
    bf16x8 r; r[0] = v0[0]; r[1] = v0[1]; r[2] = v0[2]; r[3] = v0[3]; r[4] = v1[0]; r[5] = v1[1]; r[6] = v1[2]; r[7] = v1[3];
    return r;
}

struct In {
    const float *x, *c, *ctx, *c_ctx, *norm1_w, *norm2_w, *mod_w, *mod_b, *ab_w_in, *ab_conv_w, *ab_conv_b, *ssd_a_log, *ssd_dt_bias, *ssd_d,
        *ssd_norm_w, *ml_i_bias, *ml_f_bias, *ml_norm_w, *ab_w_out, *na_w_qkv, *na_q_norm, *na_k_norm, *na_rpb, *na_w_out,
        *moe_w_group, *moe_b_group, *moe_w_expert, *moe_b_expert, *moe_w_gate, *moe_w_up, *moe_w_down;
};

constexpr size_t cmax(size_t a, size_t b) { return a > b ? a : b; }
constexpr size_t al256(size_t x) { return (x + 255) & ~(size_t)255; }

template <int NB> struct Plan {
    static constexpr size_t TL = (size_t)NB * SEQ, TC = (size_t)NB * CTXL, T = TL + TC;
    static constexpr size_t CTL = 0;
    static constexpr size_t CTL_BAR = 0, CTL_CNT = 16384  , CTL_BYTES = 32768;
    static constexpr size_t MODV = CTL + CTL_BYTES;
    static constexpr size_t RW = MODV + al256(2 * 5 * 6144 * 4);
    static constexpr size_t LIST = RW + al256(2 * T * 4);
    static constexpr size_t W_IN = LIST + al256(32 * T * 4);
    static constexpr size_t W_OUT = W_IN + (size_t)NIN * 1024 * 2;
    static constexpr size_t W_QKV = W_OUT + (size_t)1024 * 2048 * 2;
    static constexpr size_t W_NAO = W_QKV + (size_t)3072 * 1024 * 2;
    static constexpr size_t ARENA = W_NAO + (size_t)1024 * 1024 * 2;
    static constexpr size_t MOEW = (size_t)32 * 1024 * 1024 * 2 + (size_t)32 * 1024 * 512 * 2;
    static constexpr size_t SZ_B = al256(T * 1024 * 2);
    static constexpr size_t SZ_A = al256(cmax(MOEW, cmax(T * 3072 * 2, T * 1024 * 4)));
    static constexpr size_t SZ_X = al256(T * 1024 * 4);
    static constexpr size_t SZ_C = al256(cmax(T * PROJW * 2 + T * 64 * 4, SZ_X + MOEW));
    static constexpr size_t SZ_D = al256(T * 1536 * 2);
    static constexpr size_t SZ_E = al256(T * 4096 * 2);
    static constexpr size_t RB = ARENA, RA = RB + SZ_B, RC = RA + SZ_A, RD = RC + SZ_C, RE = RD + SZ_D, END = RE + SZ_E;
    static constexpr size_t H = RB;
    static constexpr size_t W_MOE0 = RA;
    static constexpr size_t QKV = RA;
    static constexpr size_t X3 = RA;
    static constexpr size_t PROJ = RC;
    static constexpr size_t GATES = RC + T * PROJW * 2;
    static constexpr size_t X1 = RC;
    static constexpr size_t W_MOE1 = RC + SZ_X;
    static constexpr size_t XBC = RD;
    static constexpr size_t ACT = RD;
    static constexpr size_t AO = RD;
    static constexpr size_t SC = RE;
    static constexpr size_t Y2 = RE;
    static constexpr size_t X2 = RE + al256(2 * T * 1024 * 2);
    static_assert(2 * T * 1024 * 2 + T * 1024 * 4 <= SZ_E, "E");
    static_assert(T * 3072 * 2 <= SZ_A + SZ_X, "QKV spill");
};

struct P { In in; unsigned char* ws; float* out; };

template <int NB> __device__ __forceinline__ int mod_row(int row) { return row < NB * SEQ ? row / SEQ : 4; }

template <class ColPtr>
__device__ __forceinline__ void tconv_unit(ColPtr colptr, int ld_src, bf16* dst, int K, int k0, int n0, int ndst, LAS unsigned char* lds) {
    LAS float* tl = (LAS float*)lds;
    const int tid = otid();
    {
        const int n4 = (tid & 63) * 4, kb = tid >> 6;
        const float* sp = colptr(n0 + n4);
        f32x4 v[8];
#pragma unroll
        for (int i = 0; i < 8; ++i) v[i] = sp ? *(const f32x4*)(sp + (size_t)(k0 + kb + 8 * i) * ld_src) : (f32x4){0.f, 0.f, 0.f, 0.f};
#pragma unroll
        for (int i = 0; i < 8; ++i) *(LAS f32x4*)(tl + (kb + 8 * i) * 260 + n4) = v[i];
    }
    __syncthreads();
    {
        const int n = tid >> 1, half = tid & 1;
        if (n0 + n < ndst) {
            float v[32];
#pragma unroll
            for (int j = 0; j < 32; ++j) v[j] = tl[(half * 32 + j) * 260 + n];
            bf16* dp = dst + (size_t)(n0 + n) * K + k0 + half * 32;
#pragma unroll
            for (int q = 0; q < 4; ++q) { u32x4 o; o[0] = pk2(v[8 * q], v[8 * q + 1]); o[1] = pk2(v[8 * q + 2], v[8 * q + 3]); o[2] = pk2(v[8 * q + 4], v[8 * q + 5]); o[3] = pk2(v[8 * q + 6], v[8 * q + 7]);
                *(u32x4*)(dp + 8 * q) = o; }
        }
    }
    __syncthreads();
}

__device__ __forceinline__ int map_in(int n) { return n < 2560 ? n : (n < 5632 ? n + 32 : (n < 5664 ? n - 3072 : (n < 5680 ? n : -1))); }

__device__ __forceinline__ void conv_small_weights(const In& in, unsigned char* ws, size_t o_in, size_t o_out, size_t o_qkv, size_t o_nao, LAS unsigned char* lds) {
    const int total = 368 + 128 + 192 + 64;
    for (int u = blockIdx.x; u < total; u += gridDim.x) {
        if (u < 368) { const int kt = u % 16, nt = u / 16; const float* w = in.ab_w_in;
            tconv_unit([&](int n) -> const float* { const int c = n < NIN ? map_in(n) : -1; return c >= 0 ? w + c : nullptr; }, 5680, (bf16*)(ws + o_in), 1024, kt * 64, nt * 256, NIN, lds); }
        else if (u < 496) { const int v = u - 368, kt = v % 32, nt = v / 32; const float* w = in.ab_w_out;
            tconv_unit([&](int n) { return w + n; }, 1024, (bf16*)(ws + o_out), 2048, kt * 64, nt * 256, 1024, lds); }
        else if (u < 688) { const int v = u - 496, kt = v % 16, nt = v / 16; const float* w = in.na_w_qkv;
            tconv_unit([&](int n) { return w + n; }, 3072, (bf16*)(ws + o_qkv), 1024, kt * 64, nt * 256, 3072, lds); }
        else { const int v = u - 688, kt = v % 16, nt = v / 16; const float* w = in.na_w_out;
            tconv_unit([&](int n) { return w + n; }, 1024, (bf16*)(ws + o_nao), 1024, kt * 64, nt * 256, 1024, lds); }
    }
}

constexpr int MOE_CONV_UNITS = 3072;
__device__ __forceinline__ void conv_moe_weights(const In& in, int layer, bf16* wgu, bf16* wd, LAS unsigned char* lds, int begin = 0, int end = MOE_CONV_UNITS, int rank = -1, int stride = 0) {
    if (rank < 0) { rank = blockIdx.x; stride = gridDim.x; }
    const size_t wsz = (size_t)1024 * 512;
    for (int u = begin + rank; u < end; u += stride) {
        if (u < 2048) {
            const int e = u >> 6, v = u & 63, kt = v & 15, nt = v >> 4;
            const float* g = in.moe_w_gate + ((size_t)layer * 32 + e) * wsz; const float* up = in.moe_w_up + ((size_t)layer * 32 + e) * wsz;
            tconv_unit([&](int n) { const int f = (n >> 8) * 128 + (n & 127); return ((n & 128) ? up : g) + f; }, 512, wgu + (size_t)e * 1024 * 1024, 1024, kt * 64, nt * 256, 1024, lds);
        } else {
            const int w = u - 2048, e = w >> 5, v = w & 31, kt = v & 7, nt = v >> 3;
            const float* dsrc = in.moe_w_down + ((size_t)layer * 32 + e) * wsz;
            tconv_unit([&](int n) { return dsrc + n; }, 1024, wd + (size_t)e * 1024 * 512, 512, kt * 64, nt * 256, 1024, lds);
        }
    }
}

__device__ __forceinline__ void mod_vectors(const In& in, float* modv, LAS unsigned char* lds) {
    LAS float* sc = (LAS float*)lds;
    LAS float* red = sc + 5 * 1024;
    const int tid = otid();
    for (int i = tid; i < 5 * 1024; i += NTHR) { const int r = i >> 10, k = i & 1023; const float v = r < 4 ? in.c[r * 1024 + k] : in.c_ctx[k]; sc[i] = siluf(v); }
    __syncthreads();
    const int col = tid & 31, kq = tid >> 5;
    for (int u = blockIdx.x; u < 2 * 192; u += gridDim.x) {
        const int layer = u / 192, c0 = (u % 192) * 32;
        const float* w = in.mod_w + (size_t)layer * 1024 * 6144 + c0 + col;
        float a0 = 0.f, a1 = 0.f, a2 = 0.f, a3 = 0.f, a4 = 0.f;
#pragma unroll 8
        for (int j = 0; j < 64; ++j) { const int k = kq + 16 * j; const float wv = w[(size_t)k * 6144];
            a0 += sc[k] * wv; a1 += sc[1024 + k] * wv; a2 += sc[2048 + k] * wv; a3 += sc[3072 + k] * wv; a4 += sc[4096 + k] * wv; }
        red[(0 * 16 + kq) * 32 + col] = a0; red[(1 * 16 + kq) * 32 + col] = a1; red[(2 * 16 + kq) * 32 + col] = a2;
        red[(3 * 16 + kq) * 32 + col] = a3; red[(4 * 16 + kq) * 32 + col] = a4;
        __syncthreads();
        if (tid < 160) { const int r = tid >> 5, cc = tid & 31; float s = 0.f;
#pragma unroll
            for (int q = 0; q < 16; ++q) s += red[(r * 16 + q) * 32 + cc];
            modv[((size_t)layer * 5 + r) * 6144 + c0 + cc] = s + in.mod_b[layer * 6144 + c0 + cc]; }
        __syncthreads();
    }
}

template <int NB, bool COMBINE, bool XOUT, bool NORM, bool ROUTER>
__device__ __forceinline__ void rows_phase(const float* xl, const float* xc, int nrows, const bf16* y2, const float* modc  , const float* modl  ,
                                           float* xout, float* out_final, const float* nw, int shift_i, int scale_i, bf16* hout,
                                           const float* wg, const float* bg, const float* we, const float* be, float* route_w, int* cnt, int* list, int cap,
                                           LAS unsigned char* lds) {
    constexpr int TL = NB * SEQ;
    const int tid = otid(), lane = tid & 63, wave = tid >> 6;
    LAS float* wt = (LAS float*)lds;
    LAS int* lcnt = (LAS int*)(lds + 36 * 1024 * 4); LAS int* lbase = lcnt + 32; LAS int* rinfo = lcnt + 64;
    if (ROUTER) {
        if (tid < 32) lcnt[tid] = 0;
        for (int i = tid; i < 4 * 1024; i += NTHR) wt[(i & 3) * 1024 + (i >> 2)] = wg[i];
        for (int i = tid; i < 32 * 1024; i += NTHR) wt[(4 + (i & 31)) * 1024 + (i >> 5)] = we[i];
        __syncthreads();
    }
    int lrow = wave;
    for (int row = blockIdx.x * NWAVE + wave; row < nrows; row += gridDim.x * NWAVE, lrow += NWAVE) {
        const float* src = row < TL ? xl + (size_t)row * D : xc + (size_t)(row - TL) * D;
        const float* mv = modl + (size_t)mod_row<NB>(row) * 6144;
        const float* mvc = modc + (size_t)mod_row<NB>(row) * 6144;
        f32x4 v[4];
#pragma unroll
        for (int i = 0; i < 4; ++i) v[i] = *(const f32x4*)(src + lane * 4 + 256 * i);
        if (COMBINE) {
#pragma unroll
            for (int i = 0; i < 4; ++i) { const int c = lane * 4 + 256 * i;
                const u32x2 ya = *(const u32x2*)(y2 + (size_t)(2 * row) * D + c), yb = *(const u32x2*)(y2 + (size_t)(2 * row + 1) * D + c);
                const f32x4 m5 = *(const f32x4*)(mvc + 5 * 1024 + c);
                v[i][0] += m5[0] * (bflo(ya[0]) + bflo(yb[0])); v[i][1] += m5[1] * (bfhi(ya[0]) + bfhi(yb[0]));
                v[i][2] += m5[2] * (bflo(ya[1]) + bflo(yb[1])); v[i][3] += m5[3] * (bfhi(ya[1]) + bfhi(yb[1])); }
            if (XOUT) {
#pragma unroll
                for (int i = 0; i < 4; ++i) *(f32x4*)(xout + (size_t)row * D + lane * 4 + 256 * i) = v[i]; }
            if (out_final) {
#pragma unroll
                for (int i = 0; i < 4; ++i) *(f32x4*)(out_final + (size_t)row * D + lane * 4 + 256 * i) = v[i]; }
        }
        if (NORM) {
            float ss = 0.f;
#pragma unroll
            for (int i = 0; i < 4; ++i) ss += v[i][0] * v[i][0] + v[i][1] * v[i][1] + v[i][2] * v[i][2] + v[i][3] * v[i][3];
            ss = wave_sum(ss);
            const float rs = rsqrtf(ss * (1.f / D) + 1e-6f);
            f32x4 hv[4];
#pragma unroll
            for (int i = 0; i < 4; ++i) { const int c = lane * 4 + 256 * i;
                const f32x4 w4 = *(const f32x4*)(nw + c), sc4 = *(const f32x4*)(mv + scale_i * 1024 + c), sh4 = *(const f32x4*)(mv + shift_i * 1024 + c);
#pragma unroll
                for (int j = 0; j < 4; ++j) hv[i][j] = v[i][j] * rs * w4[j] * (1.f + sc4[j]) + sh4[j];
                u32x2 o; o[0] = pk2(hv[i][0], hv[i][1]); o[1] = pk2(hv[i][2], hv[i][3]);
                *(u32x2*)(hout + (size_t)row * D + c) = o; }
            if (ROUTER) {
                float lg[4];
#pragma unroll
                for (int j = 0; j < 4; ++j) { float a = 0.f;
#pragma unroll
                    for (int i = 0; i < 4; ++i) { const f32x4 w4 = *(const LAS f32x4*)(wt + j * 1024 + lane * 4 + 256 * i);
                        a += hv[i][0] * w4[0] + hv[i][1] * w4[1] + hv[i][2] * w4[2] + hv[i][3] * w4[3]; }
                    lg[j] = wave_sum(a) + bg[j]; }
                int gi = 0; float gm = lg[0];
#pragma unroll
                for (int j = 1; j < 4; ++j) if (lg[j] > gm) { gm = lg[j]; gi = j; }
                float gs = 0.f;
#pragma unroll
                for (int j = 0; j < 4; ++j) gs += __expf(lg[j] - gm);
                const float gprob = 1.f / gs;
                float le[8];
#pragma unroll
                for (int j = 0; j < 8; ++j) { float a = 0.f; const LAS float* wr = wt + (4 + gi * 8 + j) * 1024 + lane * 4;
#pragma unroll
                    for (int i = 0; i < 4; ++i) { const f32x4 w4 = *(const LAS f32x4*)(wr + 256 * i);
                        a += hv[i][0] * w4[0] + hv[i][1] * w4[1] + hv[i][2] * w4[2] + hv[i][3] * w4[3]; }
                    le[j] = wave_sum(a) + be[gi * 8 + j]; }
                int e0 = 0; float m0 = le[0];
#pragma unroll
                for (int j = 1; j < 8; ++j) if (le[j] > m0) { m0 = le[j]; e0 = j; }
                int e1 = 0; float m1 = -3.0e38f;
#pragma unroll
                for (int j = 0; j < 8; ++j) if (j != e0 && le[j] > m1) { m1 = le[j]; e1 = j; }
                const float p1 = __expf(m1 - m0);
                if (lane == 0) {
                    const int ge0 = gi * 8 + e0, ge1 = gi * 8 + e1;
                    route_w[2 * row] = gprob / (1.f + p1); route_w[2 * row + 1] = gprob * p1 / (1.f + p1);
                    const int s0 = atomicAdd((int*)&lcnt[ge0], 1), s1 = atomicAdd((int*)&lcnt[ge1], 1);
                    rinfo[2 * lrow] = (ge0 << 16) | s0; rinfo[2 * lrow + 1] = (ge1 << 16) | s1;
                }
            }
        }
    }
    if (ROUTER) {
        __syncthreads();
        if (tid < 32) { const int c = lcnt[tid]; lbase[tid] = c ? atomicAdd(&cnt[tid * 64], c) : 0; }
        __syncthreads();
        int lrow = wave;
        for (int row = blockIdx.x * NWAVE + wave; row < nrows; row += gridDim.x * NWAVE, lrow += NWAVE) {
            if (lane < 2) { const int ri = rinfo[2 * lrow + lane], ge = ri >> 16, sl = ri & 0xffff; list[(size_t)ge * cap + lbase[ge] + sl] = 2 * row + lane; }
        }
        __syncthreads();
    }
}

__device__ __forceinline__ int xcd_unit(int r) { const int G = gridDim.x, bx = blockIdx.x; return G == 256 ? ((r * 8 + (bx & 7)) * 32 + (bx >> 3)) : r * G + bx; }
__device__ __forceinline__ void unit_tile(int u, int MT, int NT, int& mt, int& nt) {
    if ((MT & 3) == 0) { const int band = u / (4 * NT), w = u - band * 4 * NT; nt = w >> 2; mt = band * 4 + (w & 3); }
    else { mt = u / NT; nt = u - mt * NT; }
}
constexpr int GEMM_STAGE = 256 * 128 + 128 * 128;
constexpr int GEMM_LDS = 3 * GEMM_STAGE;
__device__ __forceinline__ int sw_off(int row, int chunk) { return row * 128 + ((chunk ^ ((row >> 1) & 7)) << 4); }

struct BRowId { __device__ __forceinline__ int operator()(int r) const { return r; } };
template <int VAR = 0, class Epi, class BRow = BRowId>
__device__ __forceinline__ void gemm_tile(const bf16* const (&arow)[4], const bf16* bt  , int ldb, int K, LAS unsigned char* lds, Epi&& epi, BRow brow = BRow()) {
    const int tid = otid(), lane = tid & 63, wave = tid >> 6, wm = wave >> 1, wn = wave & 1;
    const int r8 = tid >> 3;
    const int schunk = (lane & 7) ^ ((r8 >> 1) & 7);
    const bf16* ga[4]; const bf16* gb[2];
#pragma unroll
    for (int i = 0; i < 4; ++i) ga[i] = arow[i] + schunk * 8;
#pragma unroll
    for (int i = 0; i < 2; ++i) gb[i] = bt + (size_t)brow(r8 + 64 * i) * ldb + schunk * 8;
    f32x16 acc[2][2];
#pragma unroll
    for (int mi = 0; mi < 2; ++mi)
#pragma unroll
        for (int ni = 0; ni < 2; ++ni)
#pragma unroll
            for (int r = 0; r < 16; ++r) acc[mi][ni][r] = 0.f;
#define G_DMA(t, st) do { LAS unsigned char* sa_ = lds + (st) * GEMM_STAGE + wave * 1024 + lane * 16; \
    _Pragma("unroll") for (int i = 0; i < 4; ++i) __builtin_amdgcn_global_load_lds((const unsigned*)(ga[i] + (t) * 64), (LAS unsigned*)(sa_ + i * 8192), 16, 0, 0); \
    _Pragma("unroll") for (int i = 0; i < 2; ++i) __builtin_amdgcn_global_load_lds((const unsigned*)(gb[i] + (t) * 64), (LAS unsigned*)(sa_ + 256 * 128 + i * 8192), 16, 0, 0); } while (0)
    const int KT = K >> 6;
    G_DMA(0, 0);
    G_DMA(1, 1);
    asm volatile("s_waitcnt vmcnt(6)" ::: "memory");
    __builtin_amdgcn_s_barrier();
    asm volatile("" ::: "memory");
    int st = 0;
    for (int kt = 0; kt < KT; ++kt) {
        const int st2 = st >= 1 ? st - 1 : 2;
        if (VAR != 2) { if (kt + 2 < KT) G_DMA(kt + 2, st2); }
        const LAS unsigned char* sa = lds + st * GEMM_STAGE; const LAS unsigned char* sb = sa + 256 * 128;
        bf16x8 af[2], bfr[2];
        if (VAR == 1) {
#pragma unroll
            for (int mi = 0; mi < 2; ++mi) af[mi] = *(const LAS bf16x8*)(sa + sw_off(wm * 64 + mi * 32 + (lane & 31), (lane >> 5)));
#pragma unroll
            for (int ni = 0; ni < 2; ++ni) bfr[ni] = *(const LAS bf16x8*)(sb + sw_off(wn * 64 + ni * 32 + (lane & 31), (lane >> 5)));
        }
#pragma unroll
        for (int kk = 0; kk < 4; ++kk) {
            if (VAR != 1) {
#pragma unroll
            for (int mi = 0; mi < 2; ++mi) af[mi] = *(const LAS bf16x8*)(sa + sw_off(wm * 64 + mi * 32 + (lane & 31), 2 * kk + (lane >> 5)));
#pragma unroll
            for (int ni = 0; ni < 2; ++ni) bfr[ni] = *(const LAS bf16x8*)(sb + sw_off(wn * 64 + ni * 32 + (lane & 31), 2 * kk + (lane >> 5)));
            }
            if (VAR == 3) {
#pragma unroll
                for (int mi = 0; mi < 2; ++mi) acc[mi][0][kk] += __builtin_bit_cast(f32x4, af[mi])[0] + __builtin_bit_cast(f32x4, bfr[mi])[1];
            } else {
#pragma unroll
            for (int mi = 0; mi < 2; ++mi)
#pragma unroll
                for (int ni = 0; ni < 2; ++ni) acc[mi][ni] = mfma32(bfr[ni], af[mi], acc[mi][ni]);
            }
        }
        if (kt + 2 < KT) asm volatile("s_waitcnt vmcnt(6)" ::: "memory"); else asm volatile("s_waitcnt vmcnt(0)" ::: "memory");
        __builtin_amdgcn_s_barrier();
        asm volatile("" ::: "memory");
        st = st == 2 ? 0 : st + 1;
    }
#undef G_DMA
    epi(acc, wm, wn, lane);
}

constexpr int CST_BF = 272, CST_BF64 = 144, CST_F32 = 528;
__device__ __forceinline__ void stage_bf16_128(const f32x16 (&acc)[2][2], LAS unsigned char* lds, int wm, int wn, int lane) {
#pragma unroll
    for (int mi = 0; mi < 2; ++mi) { LAS unsigned char* rp = lds + (wm * 64 + mi * 32 + (lane & 31)) * CST_BF + (wn * 64 + 4 * (lane >> 5)) * 2;
#pragma unroll
        for (int ni = 0; ni < 2; ++ni)
#pragma unroll
            for (int g = 0; g < 4; ++g) { u32x2 o; o[0] = pk2(acc[mi][ni][4 * g], acc[mi][ni][4 * g + 1]); o[1] = pk2(acc[mi][ni][4 * g + 2], acc[mi][ni][4 * g + 3]);
                *(LAS u32x2*)(rp + (ni * 32 + 8 * g) * 2) = o; } }
}
template <class RowPtr>
__device__ __forceinline__ void flush_bf16_128(const LAS unsigned char* lds, RowPtr&& rowptr) {
    const int t = otid();
#pragma unroll
    for (int it = 0; it < 8; ++it) { const int row = it * 32 + (t >> 4), piece = t & 15;
        const u32x4 v = *(const LAS u32x4*)(lds + row * CST_BF + piece * 16);
        bf16* dst = rowptr(row);
        if (dst) __builtin_nontemporal_store(v, (u32x4*)(dst + piece * 8)); }
}
template <class RowPtr>
__device__ __forceinline__ void flush_bf16_64(const LAS unsigned char* lds, RowPtr&& rowptr) {
    const int t = otid();
#pragma unroll
    for (int it = 0; it < 4; ++it) { const int row = it * 64 + (t >> 3), piece = t & 7;
        const u32x4 v = *(const LAS u32x4*)(lds + row * CST_BF64 + piece * 16);
        bf16* dst = rowptr(row);
        if (dst) __builtin_nontemporal_store(v, (u32x4*)(dst + piece * 8)); }
}
__device__ __forceinline__ void stage_f32_128(const f32x16 (&acc)[2][2], LAS unsigned char* lds, int wm, int wn, int lane) {
#pragma unroll
    for (int mi = 0; mi < 2; ++mi) { LAS unsigned char* rp = lds + (wm * 64 + mi * 32 + (lane & 31)) * CST_F32 + (wn * 64 + 4 * (lane >> 5)) * 4;
#pragma unroll
        for (int ni = 0; ni < 2; ++ni)
#pragma unroll
            for (int g = 0; g < 4; ++g) { f32x4 o; o[0] = acc[mi][ni][4 * g]; o[1] = acc[mi][ni][4 * g + 1]; o[2] = acc[mi][ni][4 * g + 2]; o[3] = acc[mi][ni][4 * g + 3];
                *(LAS f32x4*)(rp + (ni * 32 + 8 * g) * 4) = o; } }
}

template <int NB, int VAR = 0>
__device__ __forceinline__ void phase_inproj_v(const bf16* H, const bf16* Wt, bf16* PROJ, float* GATES, LAS unsigned char* lds, bool dostore = true) {
    constexpr int T = NB * (SEQ + CTXL), MT = T / 256, NT_ = NIN / 128;
    for (int r = 0; r * (int)gridDim.x < MT * NT_; ++r) {
        const int u = xcd_unit(r); if (u >= MT * NT_) continue;
        int mt, nt; unit_tile(u, MT, NT_, mt, nt);
        const bf16* arow[4];
#pragma unroll
        for (int i = 0; i < 4; ++i) arow[i] = H + (size_t)(mt * 256 + (otid() >> 3) + 64 * i) * D;
        gemm_tile<VAR>(arow, Wt + (size_t)nt * 128 * D, D, D, lds, [&](const f32x16 (&acc)[2][2], int wm, int wn, int lane) {
            if (!dostore) return;
            if (nt < NT_ - 1) stage_bf16_128(acc, lds, wm, wn, lane);
            else if (wn == 0) {
#pragma unroll
                for (int mi = 0; mi < 2; ++mi) { const int row = mt * 256 + wm * 64 + mi * 32 + (lane & 31);
#pragma unroll
                    for (int ni = 0; ni < 2; ++ni)
#pragma unroll
                        for (int g = 0; g < 4; ++g) { f32x4 o; o[0] = acc[mi][ni][4 * g]; o[1] = acc[mi][ni][4 * g + 1]; o[2] = acc[mi][ni][4 * g + 2]; o[3] = acc[mi][ni][4 * g + 3];
                            *(f32x4*)(GATES + (size_t)row * 64 + ni * 32 + 8 * g + 4 * (lane >> 5)) = o; } } }
        });
        if (dostore && nt < NT_ - 1) {
            __syncthreads();
            flush_bf16_128(lds, [&](int r) { return PROJ + (size_t)(mt * 256 + r) * PROJW + nt * 128; });
        }
        __syncthreads();
    }
}

template <int NB> __device__ __forceinline__ void phase_inproj(const bf16* H, const bf16* Wt, bf16* PROJ, float* GATES, LAS unsigned char* lds) { phase_inproj_v<NB, 0>(H, Wt, PROJ, GATES, lds, true); }

template <int NB>
__device__ __forceinline__ void phase_conv(const bf16* PROJ, const float* cw, const float* cb, bf16* XBC) {
    constexpr int TL = NB * SEQ, T = NB * (SEQ + CTXL);
    for (size_t it = (size_t)blockIdx.x * NTHR + otid(); it < (size_t)T * 192; it += (size_t)gridDim.x * NTHR) {
        const int row = (int)(it / 192), c0 = (int)(it % 192) * 8;
        int t, L;
        if (row < TL) { t = row % SEQ; L = SEQ; } else { t = (row - TL) % CTXL; L = CTXL; }
        const bf16* p = PROJ + (size_t)row * PROJW + PC_XBC + c0;
        const u32x4 cur = *(const u32x4*)p;
        u32x4 prv = {0u, 0u, 0u, 0u}, nxt = {0u, 0u, 0u, 0u};
        if (t > 0) prv = *(const u32x4*)(p - PROJW);
        if (t < L - 1) nxt = *(const u32x4*)(p + PROJW);
        float o[8];
#pragma unroll
        for (int j = 0; j < 4; ++j) {
            const int c = c0 + 2 * j;
            o[2 * j] = bflo(prv[j]) * cw[c] + bflo(cur[j]) * cw[1536 + c] + bflo(nxt[j]) * cw[3072 + c] + cb[c];
            o[2 * j + 1] = bfhi(prv[j]) * cw[c + 1] + bfhi(cur[j]) * cw[1536 + c + 1] + bfhi(nxt[j]) * cw[3072 + c + 1] + cb[c + 1];
        }
        u32x4 r; r[0] = pk2(siluf(o[0]), siluf(o[1])); r[1] = pk2(siluf(o[2]), siluf(o[3])); r[2] = pk2(siluf(o[4]), siluf(o[5])); r[3] = pk2(siluf(o[6]), siluf(o[7]));
        *(u32x4*)(XBC + (size_t)row * 1536 + c0) = r;
    }
}
}
namespace fx {
constexpr int RS_X = 144, RS_N = 272;

template <int NB> __device__ __forceinline__ int scan_row(int b, int d, int step) {
    if (step < CTXL) return NB * SEQ + b * CTXL + (d ? CTXL - 1 - step : step);
    step -= CTXL; return b * SEQ + (d ? SEQ - 1 - step : step);
}
__device__ __forceinline__ bf16x8 scale_frag(bf16x8 v, f32x4 w0, f32x4 w1) {
    const u32x4 u = __builtin_bit_cast(u32x4, v);
    u32x4 o;
    o[0] = pk2(bflo(u[0]) * w0[0], bfhi(u[0]) * w0[1]); o[1] = pk2(bflo(u[1]) * w0[2], bfhi(u[1]) * w0[3]);
    o[2] = pk2(bflo(u[2]) * w1[0], bfhi(u[2]) * w1[1]); o[3] = pk2(bflo(u[3]) * w1[2], bfhi(u[3]) * w1[3]);
    return __builtin_bit_cast(bf16x8, o);
}

__device__ __forceinline__ unsigned tr_addr(const LAS unsigned char* T, int RS, int k0, int c0, int lane) {
    const int h = lane >> 5, blk = (lane >> 4) & 1, q = (lane & 15) >> 2, p = lane & 3;
    return (unsigned)(size_t)(T + (k0 + 8 * h + q) * RS + (c0 + 16 * blk + 4 * p) * 2);
}
__device__ __forceinline__ void tr8(unsigned a0, unsigned a1, unsigned a2, unsigned a3, unsigned a4, unsigned a5, unsigned a6, unsigned a7,
                                    bf16x4& v0, bf16x4& v1, bf16x4& v2, bf16x4& v3, bf16x4& v4, bf16x4& v5, bf16x4& v6, bf16x4& v7) {
    asm volatile("ds_read_b64_tr_b16 %0, %8\n\tds_read_b64_tr_b16 %1, %9\n\tds_read_b64_tr_b16 %2, %10\n\tds_read_b64_tr_b16 %3, %11\n\t"
                 "ds_read_b64_tr_b16 %4, %12\n\tds_read_b64_tr_b16 %5, %13\n\tds_read_b64_tr_b16 %6, %14\n\tds_read_b64_tr_b16 %7, %15\n\ts_waitcnt lgkmcnt(0)"
                 : "=&v"(v0), "=&v"(v1), "=&v"(v2), "=&v"(v3), "=&v"(v4), "=&v"(v5), "=&v"(v6), "=&v"(v7)
                 : "v"(a0), "v"(a1), "v"(a2), "v"(a3), "v"(a4), "v"(a5), "v"(a6), "v"(a7) : "memory");
}
__device__ __forceinline__ void tr4(unsigned a0, unsigned a1, unsigned a2, unsigned a3, bf16x4& v0, bf16x4& v1, bf16x4& v2, bf16x4& v3) {
    asm volatile("ds_read_b64_tr_b16 %0, %4\n\tds_read_b64_tr_b16 %1, %5\n\tds_read_b64_tr_b16 %2, %6\n\tds_read_b64_tr_b16 %3, %7\n\ts_waitcnt lgkmcnt(0)"
                 : "=&v"(v0), "=&v"(v1), "=&v"(v2), "=&v"(v3) : "v"(a0), "v"(a1), "v"(a2), "v"(a3) : "memory");
}
__device__ __forceinline__ bf16x8 tr_join(bf16x4 v0, bf16x4 v1) { bf16x8 r; r[0] = v0[0]; r[1] = v0[1]; r[2] = v0[2]; r[3] = v0[3]; r[4] = v1[0]; r[5] = v1[1]; r[6] = v1[2]; r[7] = v1[3]; return r; }
__device__ __forceinline__ void tr_col4(const LAS unsigned char* T, int RS, int k0, int c0, int lane, bf16x4 (&t)[4][2]) {
    const unsigned a = tr_addr(T, RS, k0, c0, lane);
    tr8(a, a + 4 * RS, a + 16 * RS, a + 20 * RS, a + 32 * RS, a + 36 * RS, a + 48 * RS, a + 52 * RS, t[0][0], t[0][1], t[1][0], t[1][1], t[2][0], t[2][1], t[3][0], t[3][1]);
}
__device__ __forceinline__ void tr_col2(const LAS unsigned char* T, int RS, int k0, int c0, int lane, bf16x4 (&t)[2][2]) {
    const unsigned a = tr_addr(T, RS, k0, c0, lane);
    tr4(a, a + 4 * RS, a + 16 * RS, a + 20 * RS, t[0][0], t[0][1], t[1][0], t[1][1]);
}

constexpr int NSTEP = SEQ + CTXL;
template <int NB> struct ScanTab {
    static constexpr size_t SSD_TAB = 0, ML_TAB = SSD_TAB + (size_t)NB * 32 * NSTEP * 16, SSD_DEC = ML_TAB + (size_t)NB * 8 * NSTEP * 32,
                            ML_CH = SSD_DEC + (size_t)NB * 32 * 34 * 4, END = ML_CH + (size_t)NB * 8 * 34 * 8;
};
template <int NB>
__device__ __forceinline__ void phase_tables(const In& in, const float* GATES, unsigned char* tab, LAS unsigned char* lds) {
    typedef ScanTab<NB> ST;
    const int tid = otid(), lane = tid & 63, wave = tid >> 6;
    LAS float* l_g = (LAS float*)lds; LAS float* l_ml = l_g + 68; LAS float* l_mr = l_g + 136;
    for (int job = blockIdx.x; job < NB * 40; job += gridDim.x) {
        if (job < NB * 32) {
            const int b = job >> 5, d = (job >> 4) & 1, h = job & 15;
            const float a = -__expf(in.ssd_a_log[d * 16 + h]), dtb = in.ssd_dt_bias[d * 16 + h];
            f32x4* T4 = (f32x4*)(tab + ST::SSD_TAB) + (size_t)job * NSTEP; float* DEC = (float*)(tab + ST::SSD_DEC) + job * 34;
            for (int ch = wave; ch < 34; ch += NWAVE) {
                const float dt0 = softplusf(GATES[(size_t)scan_row<NB>(b, d, ch * 128 + lane) * 64 + d * 16 + h] + dtb);
                const float dt1 = softplusf(GATES[(size_t)scan_row<NB>(b, d, ch * 128 + 64 + lane) * 64 + d * 16 + h] + dtb);
                float v0 = dt0 * a, v1 = dt1 * a;
#pragma unroll
                for (int o = 1; o < 64; o <<= 1) { const float t0 = __shfl_up(v0, o), t1 = __shfl_up(v1, o); if (lane >= o) { v0 += t0; v1 += t1; } }
                v1 += __shfl(v0, 63);
                const float tot = __shfl(v1, 63);
                T4[ch * 128 + lane] = (f32x4){v0, dt0, dt0 * __expf(tot - v0), __expf(v0)};
                T4[ch * 128 + 64 + lane] = (f32x4){v1, dt1, dt1 * __expf(tot - v1), __expf(v1)};
                if (lane == 0) DEC[ch] = __expf(tot);
            }
        } else {
            const int j2 = job - NB * 32, b = j2 >> 3, d = (j2 >> 2) & 1, hh = j2 & 3;
            const float ib = in.ml_i_bias[d * 4 + hh], fb = in.ml_f_bias[d * 4 + hh];
            f32x4* T4 = (f32x4*)(tab + ST::ML_TAB) + (size_t)j2 * NSTEP * 2; float* CH = (float*)(tab + ST::ML_CH) + j2 * 34 * 2;
            float s_li[5][2], s_bc[5][2], s_mi[5][2], s_we[5][2];
            __syncthreads();
#pragma unroll
            for (int k = 0; k < 5; ++k) { const int ch = wave + 8 * k;
#pragma unroll
                for (int q = 0; q < 2; ++q) { s_li[k][q] = 0.f; s_bc[k][q] = 0.f; s_mi[k][q] = 0.f; s_we[k][q] = 0.f; }
                if (ch < 34) {
                    const float* g0 = GATES + (size_t)scan_row<NB>(b, d, ch * 128 + lane) * 64; const float* g1 = GATES + (size_t)scan_row<NB>(b, d, ch * 128 + 64 + lane) * 64;
                    const float li0 = g0[32 + d * 4 + hh] + ib, li1 = g1[32 + d * 4 + hh] + ib;
                    float bc0 = logsigf(g0[40 + d * 4 + hh] + fb), bc1 = logsigf(g1[40 + d * 4 + hh] + fb);
#pragma unroll
                    for (int o = 1; o < 64; o <<= 1) { const float t0 = __shfl_up(bc0, o), t1 = __shfl_up(bc1, o); if (lane >= o) { bc0 += t0; bc1 += t1; } }
                    bc1 += __shfl(bc0, 63);
                    float pm0 = li0 - bc0, pm1 = li1 - bc1;
#pragma unroll
                    for (int o = 1; o < 64; o <<= 1) { const float t0 = __shfl_up(pm0, o), t1 = __shfl_up(pm1, o); if (lane >= o) { pm0 = fmaxf(pm0, t0); pm1 = fmaxf(pm1, t1); } }
                    pm1 = fmaxf(pm1, __shfl(pm0, 63));
                    const float gtot = __shfl(bc1, 63);
                    const float ae0 = gtot - bc0 + li0, ae1 = gtot - bc1 + li1;
                    const float m_loc = wave_max(fmaxf(ae0, ae1));
                    s_li[k][0] = li0; s_li[k][1] = li1; s_bc[k][0] = bc0; s_bc[k][1] = bc1; s_mi[k][0] = bc0 + pm0; s_mi[k][1] = bc1 + pm1;
                    s_we[k][0] = __expf(ae0 - m_loc); s_we[k][1] = __expf(ae1 - m_loc);
                    if (lane == 0) { l_g[ch] = gtot; l_ml[ch] = m_loc; }
                } }
            __syncthreads();
            if (tid == 0) { float m = 0.f;
                for (int ch = 0; ch < 34; ++ch) { const float g = l_g[ch], ml = l_ml[ch], mn = fmaxf(g + m, ml);
                    l_mr[ch] = m; CH[2 * ch] = __expf(g + m - mn); CH[2 * ch + 1] = __expf(ml - mn); m = mn; } }
            __syncthreads();
#pragma unroll
            for (int k = 0; k < 5; ++k) { const int ch = wave + 8 * k;
                if (ch < 34) {
#pragma unroll
                    for (int q = 0; q < 2; ++q) {
                        const float m_inter = s_bc[k][q] + l_mr[ch], mt = fmaxf(s_mi[k][q], m_inter);
                        T4[(size_t)(ch * 128 + 64 * q + lane) * 2] = (f32x4){s_bc[k][q] - mt, s_li[k][q] - s_bc[k][q], __expf(m_inter - mt), s_we[k][q]};
                        T4[(size_t)(ch * 128 + 64 * q + lane) * 2 + 1] = (f32x4){__expf(-mt), 0.f, 0.f, 0.f}; }
                } }
        }
    }
}

template <int NB>
__device__ __forceinline__ void ssd_item(const bf16* XBC, const unsigned char* tab, bf16* SCb, int b, int d, int h, LAS unsigned char* lds) {
    typedef ScanTab<NB> ST;
    const int tid = otid(), lane = tid & 63, wave = tid >> 6, g = h >> 3, combo = b * 32 + d * 16 + h;
    LAS unsigned char* Xs = lds; LAS unsigned char* Bs = lds + 18432; LAS unsigned char* Cs = lds + 53248;
    LAS unsigned char* Ss = lds + 88064; LAS unsigned char* Ms = lds + 105472;
    LAS float* acs = (LAS float*)(lds + 140288); LAS float* dtv = acs + 128; LAS float* wv = acs + 256; LAS float* eav = acs + 384;
    const f32x4* T4 = (const f32x4*)(tab + ST::SSD_TAB) + (size_t)combo * NSTEP; const float* DEC = (const float*)(tab + ST::SSD_DEC) + combo * 34;
    f32x16 st;
#pragma unroll
    for (int r = 0; r < 16; ++r) st[r] = 0.f;
    constexpr int NCH = (CTXL + SEQ) / 128;
    u32x4 rx[2], rb[4], rc[4]; f32x4 rt = {0.f, 0.f, 0.f, 0.f}; float rdec = 0.f;
#define SSD_LOAD(ch) do { \
    _Pragma("unroll") for (int i = 0; i < 2; ++i) { const int idx = tid + 512 * i, l = idx >> 3, c = idx & 7; \
        rx[i] = *(const u32x4*)(XBC + (size_t)scan_row<NB>(b, d, (ch) * 128 + l) * 1536 + h * 64 + c * 8); } \
    _Pragma("unroll") for (int i = 0; i < 4; ++i) { const int idx = tid + 512 * i, l = idx >> 4, c = idx & 15; \
        const bf16* rp = XBC + (size_t)scan_row<NB>(b, d, (ch) * 128 + l) * 1536 + 1024 + g * 128 + c * 8; \
        rb[i] = *(const u32x4*)rp; rc[i] = *(const u32x4*)(rp + 256); } \
    if (tid < 128) rt = T4[(ch) * 128 + tid]; \
    rdec = DEC[ch]; } while (0)
    SSD_LOAD(0);
    const int pbw = wave >> 2, nbw = wave & 3;
    for (int ch = 0; ch < NCH; ++ch) {
#pragma unroll
        for (int i = 0; i < 2; ++i) { const int idx = tid + 512 * i, l = idx >> 3, c = idx & 7; *(LAS u32x4*)(Xs + l * RS_X + c * 16) = rx[i]; }
#pragma unroll
        for (int i = 0; i < 4; ++i) { const int idx = tid + 512 * i, l = idx >> 4, c = idx & 15;
            *(LAS u32x4*)(Bs + l * RS_N + c * 16) = rb[i]; *(LAS u32x4*)(Cs + l * RS_N + c * 16) = rc[i]; }
        if (tid < 128) { acs[tid] = rt[0]; dtv[tid] = rt[1]; wv[tid] = rt[2]; eav[tid] = rt[3]; }
        const float dec = rdec;
        {
            const int pp = 32 * pbw + (lane & 31);
#pragma unroll
            for (int gq = 0; gq < 4; ++gq) { u32x2 o; o[0] = pk2(st[4 * gq], st[4 * gq + 1]); o[1] = pk2(st[4 * gq + 2], st[4 * gq + 3]);
                *(LAS u32x2*)(Ss + pp * RS_N + (32 * nbw + 8 * gq + 4 * (lane >> 5)) * 2) = o; }
        }
        __syncthreads();
        if (ch + 1 < NCH) SSD_LOAD(ch + 1);
        {
            const int lbA = wave >> 1, sbp = wave & 1;
            const int l = 32 * lbA + (lane & 31);
            const float al = acs[l];
#pragma unroll
            for (int q = 0; q < 2; ++q) { const int sb = 2 * sbp + q;
                if (sb <= lbA) {
                    f32x16 cb;
#pragma unroll
                    for (int r = 0; r < 16; ++r) cb[r] = 0.f;
#pragma unroll
                    for (int kk = 0; kk < 8; ++kk) cb = mfma32(frag_row(Bs, RS_N, 32 * sb, 16 * kk, lane), frag_row(Cs, RS_N, 32 * lbA, 16 * kk, lane), cb);
#pragma unroll
                    for (int gq = 0; gq < 4; ++gq) { const int s0 = 32 * sb + 8 * gq + 4 * (lane >> 5);
                        const f32x4 as4 = *(const LAS f32x4*)(acs + s0), dt4 = *(const LAS f32x4*)(dtv + s0);
                        float m[4];
#pragma unroll
                        for (int j = 0; j < 4; ++j) m[j] = (s0 + j <= l) ? cb[4 * gq + j] * __expf(fminf(al - as4[j], 0.f)) * dt4[j] : 0.f;
                        u32x2 o; o[0] = pk2(m[0], m[1]); o[1] = pk2(m[2], m[3]);
                        *(LAS u32x2*)(Ms + l * RS_N + s0 * 2) = o; } } }
        }
        {
#pragma unroll
            for (int r = 0; r < 16; ++r) st[r] *= dec;
#pragma unroll
            for (int kb = 0; kb < 2; ++kb) {
                bf16x4 tx[4][2], tb[4][2];
                tr_col4(Xs, RS_X, 64 * kb, 32 * pbw, lane, tx);
                tr_col4(Bs, RS_N, 64 * kb, 32 * nbw, lane, tb);
#pragma unroll
                for (int k4 = 0; k4 < 4; ++k4) {
                    const int l0 = 16 * (4 * kb + k4) + 8 * (lane >> 5);
                    const f32x4 w0 = *(const LAS f32x4*)(wv + l0), w1 = *(const LAS f32x4*)(wv + l0 + 4);
                    st = mfma32(tr_join(tb[k4][0], tb[k4][1]), scale_frag(tr_join(tx[k4][0], tx[k4][1]), w0, w1), st);
                }
            }
        }
        __syncthreads();
        {
            const int pb = wave >> 2, lb = wave & 3;
            f32x16 acc;
#pragma unroll
            for (int r = 0; r < 16; ++r) acc[r] = 0.f;
#pragma unroll
            for (int kk = 0; kk < 8; ++kk) acc = mfma32(frag_row(Ss, RS_N, 32 * pb, 16 * kk, lane), frag_row(Cs, RS_N, 32 * lb, 16 * kk, lane), acc);
            const int l = 32 * lb + (lane & 31);
            const float ea = eav[l];
#pragma unroll
            for (int r = 0; r < 16; ++r) acc[r] *= ea;
            for (int sb = 0; sb <= lb; ++sb) {
                bf16x4 t2[2][2];
                const bf16x8 m0 = frag_row(Ms, RS_N, 32 * lb, 32 * sb, lane), m1 = frag_row(Ms, RS_N, 32 * lb, 32 * sb + 16, lane);
                tr_col2(Xs, RS_X, 32 * sb, 32 * pb, lane, t2);
                acc = mfma32(tr_join(t2[0][0], t2[0][1]), m0, acc);
                acc = mfma32(tr_join(t2[1][0], t2[1][1]), m1, acc);
            }
            bf16* yp = SCb + (size_t)scan_row<NB>(b, d, ch * 128 + l) * 4096 + d * 1024 + h * 64 + 32 * pb + 4 * (lane >> 5);
#pragma unroll
            for (int gq = 0; gq < 4; ++gq) { u32x2 o; o[0] = pk2(acc[4 * gq], acc[4 * gq + 1]); o[1] = pk2(acc[4 * gq + 2], acc[4 * gq + 3]); *(u32x2*)(yp + 8 * gq) = o; }
        }
        __syncthreads();
    }
#undef SSD_LOAD
}

template <int NB>
__device__ __forceinline__ void mlstm_item(const bf16* PROJ, const unsigned char* tab, bf16* SCb, int b, int d, int hh, int ev, LAS unsigned char* lds) {
    typedef ScanTab<NB> ST;
    const int tid = otid(), lane = tid & 63, wave = tid >> 6, combo = b * 8 + d * 4 + hh;
    LAS unsigned char* Qs = lds; LAS unsigned char* Ks = lds + 34816; LAS unsigned char* Vs = lds + 69632;
    LAS unsigned char* Ct = lds + 88064; LAS unsigned char* Sm = lds + 105472;
    LAS float* tb = (LAS float*)(lds + 140288);
    LAS float* t_u = tb, *t_v = tb + 128, *t_wi = tb + 256, *t_we = tb + 384, *t_em = tb + 512, *t_qn = tb + 640, *t_n = tb + 768, *t_nc = tb + 896, *t_rs = tb + 1024  ;
    const f32x4* T4 = (const f32x4*)(tab + ST::ML_TAB) + (size_t)combo * NSTEP * 2; const float* CH = (const float*)(tab + ST::ML_CH) + combo * 34 * 2;
    const float kscale = 0.08838834764831845f;
    f32x16 st;
#pragma unroll
    for (int r = 0; r < 16; ++r) st[r] = 0.f;
    if (tid < 128) t_n[tid] = 0.f;
    constexpr int NCH = (CTXL + SEQ) / 128;
    const int kbw = wave & 3, ebw = wave >> 2;
    u32x4 rq[4], rk[4], rv[2]; f32x4 rt = {0.f, 0.f, 0.f, 0.f}; float ras = 0.f, rbb = 0.f;
#define ML_LOAD(ch) do { \
    _Pragma("unroll") for (int i = 0; i < 4; ++i) { const int idx = tid + 512 * i, l = idx >> 4, c = idx & 15; \
        const bf16* rp = PROJ + (size_t)scan_row<NB>(b, d, (ch) * 128 + l) * PROJW + hh * 128 + c * 8; \
        rq[i] = *(const u32x4*)(rp + PC_Q); rk[i] = *(const u32x4*)(rp + PC_K); } \
    _Pragma("unroll") for (int i = 0; i < 2; ++i) { const int idx = tid + 512 * i, l = idx >> 3, c = idx & 7; \
        rv[i] = *(const u32x4*)(PROJ + (size_t)scan_row<NB>(b, d, (ch) * 128 + l) * PROJW + PC_V + hh * 256 + ev * 64 + c * 8); } \
    if (tid < 256) rt = T4[(size_t)(ch) * 256 + tid]; \
    ras = CH[2 * (ch)]; rbb = CH[2 * (ch) + 1]; } while (0)
    ML_LOAD(0);
    for (int ch = 0; ch < NCH; ++ch) {
#pragma unroll
        for (int i = 0; i < 4; ++i) { const int idx = tid + 512 * i, l = idx >> 4, c = idx & 15;
            *(LAS u32x4*)(Qs + l * RS_N + c * 16) = rq[i]; *(LAS u32x4*)(Ks + l * RS_N + c * 16) = rk[i]; }
#pragma unroll
        for (int i = 0; i < 2; ++i) { const int idx = tid + 512 * i, l = idx >> 3, c = idx & 7; *(LAS u32x4*)(Vs + l * RS_X + c * 16) = rv[i]; }
        if (tid < 256) { const int l = tid >> 1; if (tid & 1) t_em[l] = rt[0]; else { t_u[l] = rt[0]; t_v[l] = rt[1]; t_wi[l] = rt[2]; t_we[l] = rt[3]; } }
        const float a_s = ras, bbs = rbb;
        {
            const int ee = 32 * ebw + (lane & 31);
#pragma unroll
            for (int gq = 0; gq < 4; ++gq) { u32x2 o; o[0] = pk2(st[4 * gq], st[4 * gq + 1]); o[1] = pk2(st[4 * gq + 2], st[4 * gq + 3]);
                *(LAS u32x2*)(Ct + ee * RS_N + (32 * kbw + 8 * gq + 4 * (lane >> 5)) * 2) = o; }
        }
        __syncthreads();
        if (ch + 1 < NCH) ML_LOAD(ch + 1);
        {
            const int lbA = wave >> 1, sbp = wave & 1;
            const int l = 32 * lbA + (lane & 31);
            const float ul = t_u[l];
#pragma unroll
            for (int q = 0; q < 2; ++q) { const int sb = 2 * sbp + q;
                if (sb <= lbA) {
                    f32x16 cb;
#pragma unroll
                    for (int r = 0; r < 16; ++r) cb[r] = 0.f;
#pragma unroll
                    for (int kk = 0; kk < 8; ++kk) cb = mfma32(frag_row(Ks, RS_N, 32 * sb, 16 * kk, lane), frag_row(Qs, RS_N, 32 * lbA, 16 * kk, lane), cb);
                    float rsum = 0.f;
#pragma unroll
                    for (int gq = 0; gq < 4; ++gq) { const int s0 = 32 * sb + 8 * gq + 4 * (lane >> 5);
                        const f32x4 v4 = *(const LAS f32x4*)(t_v + s0);
                        float m[4];
#pragma unroll
                        for (int j = 0; j < 4; ++j) { m[j] = (s0 + j <= l) ? cb[4 * gq + j] * kscale * __expf(fminf(ul + v4[j], 0.f)) : 0.f; rsum += m[j]; }
                        u32x2 o; o[0] = pk2(m[0], m[1]); o[1] = pk2(m[2], m[3]);
                        *(LAS u32x2*)(Sm + l * RS_N + s0 * 2) = o; }
                    rsum += __shfl_xor(rsum, 32);
                    if (lane < 32) t_rs[sb * 128 + l] = rsum;
                } }
            if (wave == 1 || wave == 3) {
                const int lq = (wave == 1 ? 0 : 64) + lane;
                float qn = 0.f;
#pragma unroll 4
                for (int c = 0; c < 16; ++c) { const u32x4 qv = *(const LAS u32x4*)(Qs + lq * RS_N + c * 16);
                    const f32x4 n0 = *(const LAS f32x4*)(t_n + c * 8), n1 = *(const LAS f32x4*)(t_n + c * 8 + 4);
                    qn += bflo(qv[0]) * n0[0] + bfhi(qv[0]) * n0[1] + bflo(qv[1]) * n0[2] + bfhi(qv[1]) * n0[3]
                        + bflo(qv[2]) * n1[0] + bfhi(qv[2]) * n1[1] + bflo(qv[3]) * n1[2] + bfhi(qv[3]) * n1[3]; }
                t_qn[lq] = qn;
            }
        }
        {
#pragma unroll
            for (int r = 0; r < 16; ++r) st[r] *= a_s;
            const float f = bbs * kscale;
            f32x16 nacc;
#pragma unroll
            for (int r = 0; r < 16; ++r) nacc[r] = 0.f;
            bf16x8 ones;
#pragma unroll
            for (int j = 0; j < 8; ++j) ones[j] = (short)0x3f80;
#pragma unroll
            for (int kb2 = 0; kb2 < 2; ++kb2) {
                bf16x4 tk[4][2], tv[4][2];
                tr_col4(Ks, RS_N, 64 * kb2, 32 * kbw, lane, tk);
                tr_col4(Vs, RS_X, 64 * kb2, 32 * ebw, lane, tv);
#pragma unroll
                for (int k4 = 0; k4 < 4; ++k4) {
                    const int l0 = 16 * (4 * kb2 + k4) + 8 * (lane >> 5);
                    f32x4 w0 = *(const LAS f32x4*)(t_we + l0), w1 = *(const LAS f32x4*)(t_we + l0 + 4);
#pragma unroll
                    for (int j = 0; j < 4; ++j) { w0[j] *= f; w1[j] *= f; }
                    const bf16x8 ka = scale_frag(tr_join(tk[k4][0], tk[k4][1]), w0, w1);
                    st = mfma32(ka, tr_join(tv[k4][0], tv[k4][1]), st);
                    if (ebw == 0) nacc = mfma32(ka, ones, nacc);
                }
            }
            if (ebw == 0 && (lane & 31) == 0) {
#pragma unroll
                for (int gq = 0; gq < 4; ++gq)
#pragma unroll
                    for (int j = 0; j < 4; ++j) t_nc[32 * kbw + 8 * gq + 4 * (lane >> 5) + j] = nacc[4 * gq + j];
            }
        }
        __syncthreads();
        if (tid < 128) t_n[tid] = a_s * t_n[tid] + t_nc[tid];
        {
            const int eb = wave >> 2, lb = wave & 3;
            f32x16 acc;
#pragma unroll
            for (int r = 0; r < 16; ++r) acc[r] = 0.f;
#pragma unroll
            for (int kk = 0; kk < 8; ++kk) acc = mfma32(frag_row(Ct, RS_N, 32 * eb, 16 * kk, lane), frag_row(Qs, RS_N, 32 * lb, 16 * kk, lane), acc);
            const int l = 32 * lb + (lane & 31);
            const float wi = t_wi[l];
#pragma unroll
            for (int r = 0; r < 16; ++r) acc[r] *= wi;
            float rsum = 0.f;
            for (int sb = 0; sb <= lb; ++sb) {
                bf16x4 t2[2][2];
                const bf16x8 m0 = frag_row(Sm, RS_N, 32 * lb, 32 * sb, lane), m1 = frag_row(Sm, RS_N, 32 * lb, 32 * sb + 16, lane);
                rsum += t_rs[sb * 128 + l];
                tr_col2(Vs, RS_X, 32 * sb, 32 * eb, lane, t2);
                acc = mfma32(tr_join(t2[0][0], t2[0][1]), m0, acc);
                acc = mfma32(tr_join(t2[1][0], t2[1][1]), m1, acc);
            }
            float den = rsum + t_qn[l] * wi;
            den = fmaxf(fabsf(den), t_em[l]);
            const float inv = 1.f / den;
            bf16* hp = SCb + (size_t)scan_row<NB>(b, d, ch * 128 + l) * 4096 + 2048 + d * 1024 + hh * 256 + ev * 64 + 32 * eb + 4 * (lane >> 5);
#pragma unroll
            for (int gq = 0; gq < 4; ++gq) { u32x2 o; o[0] = pk2(acc[4 * gq] * inv, acc[4 * gq + 1] * inv); o[1] = pk2(acc[4 * gq + 2] * inv, acc[4 * gq + 3] * inv); *(u32x2*)(hp + 8 * gq) = o; }
        }
        __syncthreads();
    }
#undef ML_LOAD
}

template <int NB>
__device__ __forceinline__ void phase_scan(const bf16* PROJ, const unsigned char* tab, const bf16* XBC, bf16* SCb, LAS unsigned char* lds, int mode = 3) {
    const int G = gridDim.x;
    if (mode & 1) for (int item = blockIdx.x; item < NB * 32; item += G) { const int b = item / 32, d = (item >> 4) & 1, h = item & 15;
        ssd_item<NB>(XBC, tab, SCb, b, d, h, lds); }
    const int v = (blockIdx.x + G - (NB * 32) % G) % G;
    if (mode & 2) for (int it = v; it < NB * 32; it += G) { const int b = it / 32, d = (it >> 4) & 1, hh = (it >> 2) & 3, ev = it & 3;
        mlstm_item<NB>(PROJ, tab, SCb, b, d, hh, ev, lds); }
}

template <int NB>
__device__ __forceinline__ void phase_mixer_out(const In& in, const bf16* PROJ, const bf16* XBC, bf16* SCb, bf16* scratch_out = nullptr) {
    constexpr int T = NB * (SEQ + CTXL);
    const int lane = otid() & 63, wave = otid() >> 6;
    for (int row = blockIdx.x * NWAVE + wave; row < T; row += gridDim.x * NWAVE) {
        bf16* sc = SCb + (size_t)row * 4096;
        const bf16* pr = PROJ + (size_t)row * PROJW;
        float yv[16], hv[16], ss = 0.f, hs[2] = {0.f, 0.f};
#pragma unroll
        for (int i = 0; i < 2; ++i) { const int c = lane * 8 + 512 * i;
            const u32x4 y0 = *(const u32x4*)(sc + c), y1 = *(const u32x4*)(sc + 1024 + c), h0 = *(const u32x4*)(sc + 2048 + c), h1 = *(const u32x4*)(sc + 3072 + c);
            const u32x4 xs = *(const u32x4*)(XBC + (size_t)row * 1536 + c), z = *(const u32x4*)(pr + PC_Z + c);
            const float dk = in.ssd_d[c >> 6];
#pragma unroll
            for (int j = 0; j < 4; ++j) {
                float a0 = bflo(y0[j]) + bflo(y1[j]) + dk * bflo(xs[j]), a1 = bfhi(y0[j]) + bfhi(y1[j]) + dk * bfhi(xs[j]);
                a0 *= siluf(bflo(z[j])); a1 *= siluf(bfhi(z[j]));
                yv[8 * i + 2 * j] = a0; yv[8 * i + 2 * j + 1] = a1; ss += a0 * a0 + a1 * a1;
                const float b0 = bflo(h0[j]) + bflo(h1[j]), b1 = bfhi(h0[j]) + bfhi(h1[j]);
                hv[8 * i + 2 * j] = b0; hv[8 * i + 2 * j + 1] = b1; hs[i] += b0 * b0 + b1 * b1; } }
        ss = wave_sum(ss);
        const float rs = rsqrtf(ss * (1.f / 1024.f) + 1e-6f);
#pragma unroll
        for (int i = 0; i < 2; ++i) {
#pragma unroll
            for (int o = 16; o > 0; o >>= 1) hs[i] += __shfl_xor(hs[i], o);
            hs[i] = rsqrtf(hs[i] * (1.f / 256.f) + 1e-6f); }
        __builtin_amdgcn_s_waitcnt(0);
#pragma unroll
        for (int i = 0; i < 2; ++i) { const int c = lane * 8 + 512 * i;
            const u32x4 ov = *(const u32x4*)(pr + PC_O + c);
            u32x4 oy, oh;
#pragma unroll
            for (int j = 0; j < 4; ++j) {
                oy[j] = pk2(yv[8 * i + 2 * j] * rs * in.ssd_norm_w[c + 2 * j], yv[8 * i + 2 * j + 1] * rs * in.ssd_norm_w[c + 2 * j + 1]);
                oh[j] = pk2(hv[8 * i + 2 * j] * hs[i] * in.ml_norm_w[c + 2 * j] * sigmf(bflo(ov[j])), hv[8 * i + 2 * j + 1] * hs[i] * in.ml_norm_w[c + 2 * j + 1] * sigmf(bfhi(ov[j]))); }
            bf16* dstp = scratch_out ? scratch_out + (size_t)row * 2048 : sc;
            *(u32x4*)(dstp + c) = oy; *(u32x4*)(dstp + 1024 + c) = oh; }
    }
}

template <int NB, class Idle>
__device__ __forceinline__ void phase_outproj(const bf16* A, int lda, int K, const bf16* Wt, int nrows, const float* xl, const float* xc, const float* modl, float* Xout,
                                              LAS unsigned char* lds, Idle&& idle) {
    constexpr int TL = NB * SEQ;
    const int MT = nrows / 256;
    for (int r = 0; r * (int)gridDim.x < MT * 8; ++r) {
        const int u = xcd_unit(r);
        if (u >= MT * 8) {
            idle(u - MT * 8, (r + 1) * (int)gridDim.x - MT * 8); continue; }
        int mt, nt; unit_tile(u, MT, 8, mt, nt);
        const bf16* arow[4];
#pragma unroll
        for (int i = 0; i < 4; ++i) arow[i] = A + (size_t)(mt * 256 + (otid() >> 3) + 64 * i) * lda;
        gemm_tile(arow, Wt + (size_t)nt * 128 * K, K, K, lds, [&](const f32x16 (&acc)[2][2], int wm, int wn, int lane) { stage_f32_128(acc, lds, wm, wn, lane); });
        __syncthreads();
        {
            const float* mv = modl + (size_t)mod_row<NB>(mt * 256) * 6144 + 2 * 1024 + nt * 128;
            const int t = otid(), piece = t & 31;
            const f32x4 m2 = *(const f32x4*)(mv + piece * 4);
#pragma unroll 4
            for (int it = 0; it < 16; ++it) { const int rl = it * 16 + (t >> 5), row = mt * 256 + rl;
                const f32x4 a = *(const LAS f32x4*)(lds + rl * CST_F32 + piece * 16);
                const float* srcp = (row < TL ? xl + (size_t)row * D : xc + (size_t)(row - TL) * D) + nt * 128 + piece * 4;
                const f32x4 xv = *(const f32x4*)srcp;
                f32x4 o;
#pragma unroll
                for (int j = 0; j < 4; ++j) o[j] = xv[j] + m2[j] * a[j];
                __builtin_nontemporal_store(o, (f32x4*)(Xout + (size_t)row * D + nt * 128 + piece * 4)); }
        }
        __syncthreads();
    }
}
}
namespace fx {
__device__ __forceinline__ int moe_prefix(const int* cnt, LAS int* pre  ) {
    __syncthreads();
    if (otid() < 64) {
        const int lane = otid();
        int v = lane < 32 ? (cnt[lane * 64] + 255) >> 8 : 0;
#pragma unroll
        for (int o = 1; o < 32; o <<= 1) { const int t = __shfl_up(v, o); if (lane >= o) v += t; }
        if (lane < 32) pre[lane + 1] = v;
        if (lane == 0) pre[0] = 0;
    }
    __syncthreads();
    return pre[32];
}
__device__ __forceinline__ int moe_find(const LAS int* pre, int t) { int e = 0;
#pragma unroll
    for (int i = 1; i < 32; ++i) e += (t >= pre[i]) ? 1 : 0;
    return e; }

__device__ __forceinline__ void phase_moe_up(const bf16* H2, const bf16* Wgu, const int* cnt, const int* list, int cap, const float* route_w, bf16* ACT, LAS unsigned char* lds) {
    LAS int* pre = (LAS int*)(lds + GEMM_LDS);
    const int ntile = moe_prefix(cnt, pre);
    for (int r = 0; r * (int)gridDim.x < ntile * 8; ++r) {
        const int u = xcd_unit(r); if (u >= ntile * 8) continue;
        const int t = u >> 3, nt = u & 7, e = moe_find(pre, t), mt = t - pre[e], ce = cnt[e * 64];
        const int* le = list + (size_t)e * cap + mt * 256;
        const int nvalid = ce - mt * 256;
        const bf16* arow[4];
#pragma unroll
        for (int i = 0; i < 4; ++i) { const int r = (otid() >> 3) + 64 * i; const int ent = le[r < nvalid ? r : 0]; arow[i] = H2 + (size_t)(ent >> 1) * D; }
        gemm_tile(arow, Wgu + (size_t)e * 1024 * 1024 + (size_t)nt * 128 * 1024, 1024, 1024, lds, [&](const f32x16 (&acc)[2][2], int wm, int wn, int lane) {
#pragma unroll
            for (int mi = 0; mi < 2; ++mi) { const int r = wm * 64 + mi * 32 + (lane & 31);
                const float w = r < nvalid ? route_w[le[r]] : 0.f;
                LAS unsigned char* rp = lds + r * CST_BF64 + (wn * 32 + 4 * (lane >> 5)) * 2;
#pragma unroll
                for (int g = 0; g < 4; ++g) { float v[4];
#pragma unroll
                    for (int j = 0; j < 4; ++j) v[j] = siluf(acc[mi][0][4 * g + j]) * acc[mi][1][4 * g + j] * w;
                    u32x2 o; o[0] = pk2(v[0], v[1]); o[1] = pk2(v[2], v[3]); *(LAS u32x2*)(rp + 8 * g * 2) = o; } }
        });
        __syncthreads();
        flush_bf16_64(lds, [&](int r) -> bf16* { return r < nvalid ? ACT + (size_t)le[r] * 512 + nt * 64 : nullptr; });
        __syncthreads();
    }
}
__device__ __forceinline__ void phase_moe_down(const bf16* ACT, const bf16* Wd, const int* cnt, const int* list, int cap, bf16* Y2, LAS unsigned char* lds) {
    LAS int* pre = (LAS int*)(lds + GEMM_LDS);
    const int ntile = moe_prefix(cnt, pre);
    for (int r = 0; r * (int)gridDim.x < ntile * 8; ++r) {
        const int u = xcd_unit(r); if (u >= ntile * 8) continue;
        const int t = u >> 3, nt = u & 7, e = moe_find(pre, t), mt = t - pre[e], ce = cnt[e * 64];
        const int* le = list + (size_t)e * cap + mt * 256;
        const int nvalid = ce - mt * 256;
        const bf16* arow[4];
#pragma unroll
        for (int i = 0; i < 4; ++i) { const int r = (otid() >> 3) + 64 * i; const int ent = le[r < nvalid ? r : 0]; arow[i] = ACT + (size_t)ent * 512; }
        gemm_tile(arow, Wd + (size_t)e * 1024 * 512 + (size_t)nt * 128 * 512, 512, 512, lds, [&](const f32x16 (&acc)[2][2], int wm, int wn, int lane) { stage_bf16_128(acc, lds, wm, wn, lane); });
        __syncthreads();
        flush_bf16_128(lds, [&](int r) -> bf16* { return r < nvalid ? Y2 + (size_t)le[r] * D + nt * 128 : nullptr; });
        __syncthreads();
    }
}

template <int NB>
__device__ __forceinline__ void phase_qkv(const bf16* H, const bf16* Wt, const float* qn, const float* kn, bf16* QKV, LAS unsigned char* lds) {
    constexpr int T = NB * (SEQ + CTXL), MT = T / 256;
    for (int r = 0; r * (int)gridDim.x < MT * 24; ++r) {
        const int u = xcd_unit(r); if (u >= MT * 24) continue;
        int mt, nt; unit_tile(u, MT, 24, mt, nt);
        const bf16* arow[4];
#pragma unroll
        for (int i = 0; i < 4; ++i) arow[i] = H + (size_t)(mt * 256 + (otid() >> 3) + 64 * i) * D;
        gemm_tile(arow, Wt + (size_t)nt * 128 * D, D, D, lds, [&](const f32x16 (&acc)[2][2], int wm, int wn, int lane) {
            const int which = nt >> 3;
#pragma unroll
            for (int mi = 0; mi < 2; ++mi) {
                float rs = 1.f;
                if (which < 2) { float ss = 0.f;
#pragma unroll
                    for (int ni = 0; ni < 2; ++ni)
#pragma unroll
                        for (int r = 0; r < 16; ++r) ss += acc[mi][ni][r] * acc[mi][ni][r];
                    ss += __shfl_xor(ss, 32);
                    rs = rsqrtf(ss * (1.f / 64.f) + 1e-6f) * (which == 0 ? 0.125f : 1.f); }
                const float* nwp = which == 0 ? qn : kn;
                LAS unsigned char* rp = lds + (wm * 64 + mi * 32 + (lane & 31)) * CST_BF + (wn * 64 + 4 * (lane >> 5)) * 2;
#pragma unroll
                for (int ni = 0; ni < 2; ++ni)
#pragma unroll
                    for (int g = 0; g < 4; ++g) { float v[4];
#pragma unroll
                        for (int j = 0; j < 4; ++j) { v[j] = acc[mi][ni][4 * g + j]; if (which < 2) v[j] *= rs * nwp[ni * 32 + 8 * g + 4 * (lane >> 5) + j]; }
                        u32x2 o; o[0] = pk2(v[0], v[1]); o[1] = pk2(v[2], v[3]); *(LAS u32x2*)(rp + (ni * 32 + 8 * g) * 2) = o; } }
        });
        __syncthreads();
        flush_bf16_128(lds, [&](int r) { return QKV + (size_t)(mt * 256 + r) * 3072 + nt * 128; });
        __syncthreads();
    }
}

__device__ __forceinline__ bf16x8 frag16_row(const LAS unsigned char* T, int RS, int r0, int c0, int lane) {
    return *(const LAS bf16x8*)(T + (r0 + (lane & 15)) * RS + (c0 + 8 * (lane >> 4)) * 2);
}
__device__ __forceinline__ bf16x8 frag16_vt(const LAS unsigned char* T, int RS, int kb, int c0, int lane) {
    const int g4 = lane >> 4, q = (lane & 15) >> 2, p = lane & 3;
    const unsigned a0 = (unsigned)(size_t)(T + (kb + 4 * g4 + q) * RS + (c0 + 4 * p) * 2);
    const unsigned a1 = a0 + 16 * RS;
    bf16x4 v0, v1;
    asm volatile("ds_read_b64_tr_b16 %0, %2\n\tds_read_b64_tr_b16 %1, %3\n\ts_waitcnt lgkmcnt(0)" : "=&v"(v0), "=&v"(v1) : "v"(a0), "v"(a1) : "memory");
    bf16x8 r; r[0] = v0[0]; r[1] = v0[1]; r[2] = v0[2]; r[3] = v0[3]; r[4] = v1[0]; r[5] = v1[1]; r[6] = v1[2]; r[7] = v1[3];
    return r;
}

template <bool LOCAL>
__device__ __forceinline__ void attn_group(const LAS unsigned char* Kt, const LAS unsigned char* Vt, int kb, int hsel, int lane, int g4,
                                           const bf16x8& q0, const bf16x8& q1, f32x4 (&oacc)[4], float& l_run,
                                           int cs, int c, int brow  , const LAS float* rp) {
    f32x4 s[2];
#pragma unroll
    for (int sb = 0; sb < 2; ++sb) { s[sb] = (f32x4){0.f, 0.f, 0.f, 0.f};
        s[sb] = mfma16(frag16_row(Kt, RS_N, kb + 16 * sb, hsel * 64, lane), q0, s[sb]);
        s[sb] = mfma16(frag16_row(Kt, RS_N, kb + 16 * sb, hsel * 64 + 32, lane), q1, s[sb]); }
    float ps = 0.f; float p[8];
#pragma unroll
    for (int sb = 0; sb < 2; ++sb)
#pragma unroll
        for (int j = 0; j < 4; ++j) {
            float e;
            if (LOCAL) { const int kc = kb + 16 * sb + 4 * g4 + j; const bool ok = kc >= cs && kc < cs + 16;
                e = ok ? __expf(s[sb][j] + rp[hsel * 465 + (ok ? brow + (kc - c + 15) : 0)] - 8.f) : 0.f; }
            else e = __expf(s[sb][j] - 8.f);
            p[4 * sb + j] = e; ps += e; }
    l_run += ps;
    u32x4 pu; pu[0] = pk2(p[0], p[1]); pu[1] = pk2(p[2], p[3]); pu[2] = pk2(p[4], p[5]); pu[3] = pk2(p[6], p[7]);
    const bf16x8 pf = __builtin_bit_cast(bf16x8, pu);
    bf16x4 tv[4][2];
    {
        const int q = (lane & 15) >> 2, p4 = lane & 3;
        const unsigned a = (unsigned)(size_t)(Vt + (kb + 4 * g4 + q) * RS_N + (hsel * 64 + 4 * p4) * 2);
        tr8(a, a + 16 * RS_N, a + 32, a + 32 + 16 * RS_N, a + 64, a + 64 + 16 * RS_N, a + 96, a + 96 + 16 * RS_N,
            tv[0][0], tv[0][1], tv[1][0], tv[1][1], tv[2][0], tv[2][1], tv[3][0], tv[3][1]);
    }
#pragma unroll
    for (int db = 0; db < 4; ++db) oacc[db] = mfma16(tr_join(tv[db][0], tv[db][1]), pf, oacc[db]);
}

template <bool LOCAL>
__device__ __forceinline__ void attn_group2(const LAS unsigned char* Kt, const LAS unsigned char* Vt, int kb, int hsel, int lane, int g4,
                                            const bf16x8 (&q0)[2], const bf16x8 (&q1)[2], f32x4 (&oacc)[2][4], float (&l_run)[2],
                                            int cs, int c, int brow0, int brow1, const LAS float* rp) {
    bf16x8 kf[2][2];
#pragma unroll
    for (int sb = 0; sb < 2; ++sb) { kf[sb][0] = frag16_row(Kt, RS_N, kb + 16 * sb, hsel * 64, lane); kf[sb][1] = frag16_row(Kt, RS_N, kb + 16 * sb, hsel * 64 + 32, lane); }
    f32x4 s[2][2];
#pragma unroll
    for (int qr = 0; qr < 2; ++qr)
#pragma unroll
        for (int sb = 0; sb < 2; ++sb) { s[qr][sb] = (f32x4){0.f, 0.f, 0.f, 0.f};
            s[qr][sb] = mfma16(kf[sb][0], q0[qr], s[qr][sb]); s[qr][sb] = mfma16(kf[sb][1], q1[qr], s[qr][sb]); }
    bf16x8 pf[2];
#pragma unroll
    for (int qr = 0; qr < 2; ++qr) {
        float ps = 0.f; float p[8];
        const int brow = qr ? brow1 : brow0;
#pragma unroll
        for (int sb = 0; sb < 2; ++sb)
#pragma unroll
            for (int j = 0; j < 4; ++j) {
                float e;
                if (LOCAL) { const int kc = kb + 16 * sb + 4 * g4 + j; const bool ok = kc >= cs && kc < cs + 16;
                    const float bv = rp[hsel * 465 + (ok ? brow + (kc - c + 15) : 0)];
                    const float ex = __expf(s[qr][sb][j] + bv - 8.f);
                    e = ok ? ex : 0.f; }
                else e = __expf(s[qr][sb][j] - 8.f);
                p[4 * sb + j] = e; ps += e; }
        l_run[qr] += ps;
        u32x4 pu; pu[0] = pk2(p[0], p[1]); pu[1] = pk2(p[2], p[3]); pu[2] = pk2(p[4], p[5]); pu[3] = pk2(p[6], p[7]);
        pf[qr] = __builtin_bit_cast(bf16x8, pu);
    }
    bf16x4 tv[4][2];
    {
        const int q = (lane & 15) >> 2, p4 = lane & 3;
        const unsigned a = (unsigned)(size_t)(Vt + (kb + 4 * g4 + q) * RS_N + (hsel * 64 + 4 * p4) * 2);
        tr8(a, a + 16 * RS_N, a + 32, a + 32 + 16 * RS_N, a + 64, a + 64 + 16 * RS_N, a + 96, a + 96 + 16 * RS_N,
            tv[0][0], tv[0][1], tv[1][0], tv[1][1], tv[2][0], tv[2][1], tv[3][0], tv[3][1]);
    }
#pragma unroll
    for (int db = 0; db < 4; ++db) { const bf16x8 vf = tr_join(tv[db][0], tv[db][1]);
        oacc[0][db] = mfma16(vf, pf[0], oacc[0][db]); oacc[1][db] = mfma16(vf, pf[1], oacc[1][db]); }
}

constexpr int ATT_QR = 2;
template <int NB>
__device__ __forceinline__ void phase_attn(const bf16* QKV, const float* rpb, bf16* AO, LAS unsigned char* lds) {
    constexpr int TL = NB * SEQ;
    constexpr int TILE = 64 * RS_N;
    const int tid = otid(), lane = tid & 63, wave = tid >> 6, w = wave & 3, hsel = wave >> 2;
    const int qi = lane & 15, g4 = lane >> 4;
    LAS float* rp = (LAS float*)(lds + 4 * TILE);
    constexpr int QR = ATT_QR, NRG = 64 / QR;
    for (int u = blockIdx.x; u < NB * NRG * 8; u += gridDim.x) {
        const int hp = u & 7, rg = (u >> 3) % NRG, b = (u >> 3) / NRG;
        const int head = 2 * hp + hsel;
        int R0 = QR * rg - 4; R0 = R0 < 0 ? 0 : (R0 > 56 ? 56 : R0);
        int R1 = QR * rg + QR - 1 - 4; R1 = (R1 < 0 ? 0 : (R1 > 56 ? 56 : R1)) + 7;
        const int nloc = R1 - R0 + 1, nit = nloc + 4;
        __syncthreads();
        for (int i = tid; i < 2 * 465; i += NTHR) rp[i] = rpb[(size_t)(2 * hp) * 465 + i];
        const int c = 16 * w + qi;
        int cs = c - 8; cs = cs < 0 ? 0 : (cs > 48 ? 48 : cs);
        const int kbw = w == 0 ? 0 : (w == 1 ? 8 : (w == 2 ? 24 : 32));
        bf16x8 q0[QR], q1[QR]; f32x4 oacc[QR][4]; float l_run[QR];
#pragma unroll
        for (int qr = 0; qr < QR; ++qr) {
            const size_t qrow = (size_t)b * SEQ + (QR * rg + qr) * 64 + c;
            q0[qr] = *(const bf16x8*)(QKV + qrow * 3072 + head * 64 + 8 * g4); q1[qr] = *(const bf16x8*)(QKV + qrow * 3072 + head * 64 + 32 + 8 * g4);
#pragma unroll
            for (int i = 0; i < 4; ++i) oacc[qr][i] = (f32x4){0.f, 0.f, 0.f, 0.f};
            l_run[qr] = 0.f; }
        u32x4 sk[2], sv[2];
#define AT_LOAD(it) do { \
        _Pragma("unroll") for (int i = 0; i < 2; ++i) { const int idx = tid + 512 * i, key = idx >> 4, ch = idx & 15; \
            const size_t krow = (it) < nloc ? (size_t)b * SEQ + (size_t)(R0 + (it)) * 64 + key : (size_t)TL + (size_t)b * CTXL + ((it) - nloc) * 64 + key; \
            const bf16* kp = QKV + krow * 3072 + 1024 + hp * 128 + ch * 8; sk[i] = *(const u32x4*)kp; sv[i] = *(const u32x4*)(kp + 1024); } } while (0)
#define AT_STORE(buf) do { LAS unsigned char* kt_ = lds + (buf) * 2 * TILE; \
        _Pragma("unroll") for (int i = 0; i < 2; ++i) { const int idx = tid + 512 * i, key = idx >> 4, ch = idx & 15; \
            *(LAS u32x4*)(kt_ + key * RS_N + ch * 16) = sk[i]; *(LAS u32x4*)(kt_ + TILE + key * RS_N + ch * 16) = sv[i]; } } while (0)
        AT_LOAD(0);
        AT_STORE(0);
        __syncthreads();
        for (int it = 0; it < nit; ++it) {
            const LAS unsigned char* Kt = lds + (it & 1) * 2 * TILE; const LAS unsigned char* Vt = Kt + TILE;
            if (it + 1 < nit) AT_LOAD(it + 1);
            if (it < nloc) {
                const int kr = R0 + it;
                static_assert(QR == 2, "attn_group2 pairs two query rows");
                const int ra = QR * rg, rb = ra + 1;
                int r0a = ra - 4; r0a = r0a < 0 ? 0 : (r0a > 56 ? 56 : r0a);
                int r0b = rb - 4; r0b = r0b < 0 ? 0 : (r0b > 56 ? 56 : r0b);
                const bool ina = kr >= r0a && kr < r0a + 8, inb = kr >= r0b && kr < r0b + 8;
                if (ina && inb) attn_group2<true>(Kt, Vt, kbw, hsel, lane, g4, q0, q1, oacc, l_run, cs, c, (kr - ra + 7) * 31, (kr - rb + 7) * 31, rp);
                else if (ina) attn_group<true>(Kt, Vt, kbw, hsel, lane, g4, q0[0], q1[0], oacc[0], l_run[0], cs, c, (kr - ra + 7) * 31, rp);
                else if (inb) attn_group<true>(Kt, Vt, kbw, hsel, lane, g4, q0[1], q1[1], oacc[1], l_run[1], cs, c, (kr - rb + 7) * 31, rp);
            } else {
                attn_group2<false>(Kt, Vt, 0, hsel, lane, g4, q0, q1, oacc, l_run, 0, 0, 0, 0, rp);
                attn_group2<false>(Kt, Vt, 32, hsel, lane, g4, q0, q1, oacc, l_run, 0, 0, 0, 0, rp);
            }
            if (it + 1 < nit) AT_STORE((it + 1) & 1);
            __syncthreads();
        }
#undef AT_LOAD
#undef AT_STORE
#pragma unroll
        for (int qr = 0; qr < QR; ++qr) {
            float l = l_run[qr]; l += __shfl_xor(l, 16); l += __shfl_xor(l, 32);
            const float inv = 1.f / l;
            const size_t qrow = (size_t)b * SEQ + (QR * rg + qr) * 64 + c;
            bf16* op = AO + qrow * D + head * 64 + 4 * g4;
#pragma unroll
            for (int db = 0; db < 4; ++db) { u32x2 o; o[0] = pk2(oacc[qr][db][0] * inv, oacc[qr][db][1] * inv); o[1] = pk2(oacc[qr][db][2] * inv, oacc[qr][db][3] * inv); *(u32x2*)(op + 16 * db) = o; }
        }
    }
}
}
namespace fx {
namespace g8 {
constexpr int BM = 256, BK = 64, HALF = 128, HTB = HALF * BK * 2, STAGE_BYTES = 8 * HTB;
__device__ __forceinline__ int lds_byte(int r, int c) { const int st = (r >> 4) * 2 + (c >> 5), rr = r & 15, cc = c & 31, ob = rr * 64 + cc * 2; return st * 1024 + (ob ^ (((ob >> 9) & 1) << 5)); }
__device__ __forceinline__ void stage_rc(int b, int& R, int& C) { const int st = b / 1024, sb = b % 1024, swz = sb ^ (((sb >> 9) & 1) << 5); R = (st >> 1) * 16 + swz / 64; C = (st & 1) * 32 + (swz % 64) / 2; }
__device__ __forceinline__ int perm32(int rho) { const int n = rho >> 4, i = rho & 15; return 8 * (i >> 2) + 4 * n + (i & 3); }
struct Unit { int pm, pn, i0; const int* p; };

template <class Epi, class Sched>
__device__ __forceinline__ void gemm_phase(LAS unsigned char* lds, int K, const Sched& S, const Epi& E) {
    const int tid = otid(), wid = __builtin_amdgcn_readfirstlane(tid >> 6), lane = tid & 63, wr = wid >> 2, wc = wid & 3, fr = lane & 15, fq = lane >> 4;
    const int nt = K / BK;
    int Rr[2], Cc[2]; unsigned voffB[2];
#pragma unroll
    for (int i = 0; i < 2; ++i) { int R, C; stage_rc(tid * 16 + i * 8192, R, C); Rr[i] = R; Cc[i] = C;
        const int Rb = Epi::PERM ? ((R & ~31) + perm32(R & 31)) : R; voffB[i] = (unsigned)(Rb * K + C) * 2u; }
    const size_t kstep = (size_t)(BK * 2);
    const size_t hstepB = (size_t)HALF * K * 2;
    const unsigned ldsw = (unsigned)wid * 1024u;
    const int aoff = lds_byte(wr * 64 + fr, fq * 8), boff = lds_byte(wc * 32 + fr, fq * 8);
#define G8_SA(b, h) (((b) * 2 + (h)) * HTB)
#define G8_SB(b, h) ((4 + (b) * 2 + (h)) * HTB)
#define G8_STAGE_B(bufoff, gbase) do { _Pragma("unroll") for (int _i = 0; _i < 2; ++_i) \
        __builtin_amdgcn_global_load_lds((const unsigned*)((const char*)(gbase) + voffB[_i]), (LAS unsigned*)(lds + (bufoff) + ldsw + _i * 8192), 16, 0, 0); } while (0)
#define G8_STAGE_A(bufoff, gbase, o0, o1) do { \
        __builtin_amdgcn_global_load_lds((const unsigned*)((const char*)(gbase) + (o0)), (LAS unsigned*)(lds + (bufoff) + ldsw), 16, 0, 0); \
        __builtin_amdgcn_global_load_lds((const unsigned*)((const char*)(gbase) + (o1)), (LAS unsigned*)(lds + (bufoff) + ldsw + 8192), 16, 0, 0); } while (0)
#define G8_LDA(dst, b, h) do { _Pragma("unroll") for (int m = 0; m < 4; ++m) _Pragma("unroll") for (int k = 0; k < 2; ++k) dst[m][k] = *(const LAS bf16x8*)(lds + G8_SA(b, h) + aoff + m * 2048 + k * 1024); } while (0)
#define G8_LDB(dst, b, h) do { _Pragma("unroll") for (int n = 0; n < 2; ++n) _Pragma("unroll") for (int k = 0; k < 2; ++k) dst[n][k] = *(const LAS bf16x8*)(lds + G8_SB(b, h) + boff + n * 2048 + k * 1024); } while (0)
#define G8_MMA(ai, bj, At, Bt) do { __builtin_amdgcn_s_setprio(1); _Pragma("unroll") for (int m = 0; m < 4; ++m) _Pragma("unroll") for (int n = 0; n < 2; ++n) _Pragma("unroll") for (int k = 0; k < 2; ++k) \
        acc[ai][bj][m][n] = __builtin_amdgcn_mfma_f32_16x16x32_bf16(Bt[n][k], At[m][k], acc[ai][bj][m][n], 0, 0, 0); __builtin_amdgcn_s_setprio(0); } while (0)
#define G8_WAIT_V(n) asm volatile("s_waitcnt vmcnt(" #n ")" ::: "memory")
#define G8_WAIT_L(n) asm volatile("s_waitcnt lgkmcnt(" #n ")" ::: "memory")
#define G8_BAR __builtin_amdgcn_s_barrier()
#define G8_SCHED __builtin_amdgcn_sched_barrier(0)
    Unit cur, nxt; int ui = 0;
    if (!S.next(0, cur)) return;
    f32x4 acc[2][2][4][2];
#pragma unroll
    for (int a = 0; a < 2; ++a)
#pragma unroll
        for (int b = 0; b < 2; ++b)
#pragma unroll
            for (int m = 0; m < 4; ++m)
#pragma unroll
                for (int n = 0; n < 2; ++n) acc[a][b][m][n] = (f32x4){0.f, 0.f, 0.f, 0.f};
    bf16x8 At[4][2], B0[2][2], B1[2][2];
    unsigned oaC[2][2], oaN[2][2]; const char* cAb; const char* cB; const char* nAb; const char* nB;
    S.src(cur, Rr, Cc, oaC, cAb, cB);
    G8_STAGE_B(G8_SB(0, 0), cB); G8_STAGE_A(G8_SA(0, 0), cAb, oaC[0][0], oaC[0][1]); G8_STAGE_B(G8_SB(0, 1), cB + hstepB); G8_STAGE_A(G8_SA(0, 1), cAb, oaC[1][0], oaC[1][1]);
    if (wr == 1) G8_BAR;
    G8_WAIT_V(4); G8_BAR;
    G8_STAGE_B(G8_SB(1, 0), cB + kstep); G8_STAGE_A(G8_SA(1, 0), cAb + kstep, oaC[0][0], oaC[0][1]); G8_STAGE_B(G8_SB(1, 1), cB + hstepB + kstep);
    G8_WAIT_V(6); G8_BAR;
    for (;;) {
        const bool has_next = S.next(ui + 1, nxt);
        if (has_next) S.src(nxt, Rr, Cc, oaN, nAb, nB);
        else { nAb = cAb; nB = cB;
#pragma unroll
            for (int h = 0; h < 2; ++h)
#pragma unroll
                for (int i = 0; i < 2; ++i) oaN[h][i] = oaC[h][i]; }
        for (int t = 0; t < nt; t += 2) {
            const bool last = (t == nt - 2);
            const char* a1 = cAb + (size_t)(t + 1) * kstep;
            const char* a2 = last ? nAb : cAb + (size_t)(t + 2) * kstep; const char* b2 = last ? nB : cB + (size_t)(t + 2) * kstep;
            const char* a3 = a2 + kstep; const char* b3 = b2 + kstep;
            const unsigned o00 = last ? oaN[0][0] : oaC[0][0], o01 = last ? oaN[0][1] : oaC[0][1], o10 = last ? oaN[1][0] : oaC[1][0], o11 = last ? oaN[1][1] : oaC[1][1];
            G8_LDB(B0, 0, 0); G8_SCHED; G8_LDA(At, 0, 0); G8_STAGE_A(G8_SA(1, 1), a1, oaC[1][0], oaC[1][1]);
            G8_WAIT_L(8); G8_BAR; G8_WAIT_L(0); G8_MMA(0, 0, At, B0); G8_BAR; G8_SCHED;
            G8_LDB(B1, 0, 1); G8_STAGE_B(G8_SB(0, 0), b2);
            G8_BAR; G8_WAIT_L(0); G8_MMA(0, 1, At, B1); G8_BAR;
            G8_LDA(At, 0, 1); G8_STAGE_A(G8_SA(0, 0), a2, o00, o01);
            G8_BAR; G8_WAIT_L(0); G8_MMA(1, 0, At, B0); G8_BAR; G8_SCHED;
            G8_STAGE_B(G8_SB(0, 1), b2 + hstepB);
            G8_WAIT_V(6); G8_BAR; G8_MMA(1, 1, At, B1); G8_BAR;
            G8_LDB(B0, 1, 0); G8_SCHED; G8_LDA(At, 1, 0); G8_STAGE_A(G8_SA(0, 1), a2, o10, o11);
            G8_WAIT_L(8); G8_BAR; G8_WAIT_L(0); G8_MMA(0, 0, At, B0); G8_BAR; G8_SCHED;
            G8_LDB(B1, 1, 1); G8_STAGE_B(G8_SB(1, 0), b3);
            G8_BAR; G8_WAIT_L(0); G8_MMA(0, 1, At, B1); G8_BAR;
            G8_LDA(At, 1, 1); G8_STAGE_A(G8_SA(1, 0), a3, o00, o01);
            G8_BAR; G8_WAIT_L(0); G8_MMA(1, 0, At, B0); G8_BAR; G8_SCHED;
            G8_STAGE_B(G8_SB(1, 1), b3 + hstepB);
            G8_WAIT_V(6); G8_BAR; G8_MMA(1, 1, At, B1); G8_BAR;
        }
        E(acc, cur, wr, wc, fr, fq);
        if (!has_next) break;
#pragma unroll
        for (int a = 0; a < 2; ++a)
#pragma unroll
            for (int b = 0; b < 2; ++b)
#pragma unroll
                for (int m = 0; m < 4; ++m)
#pragma unroll
                    for (int n = 0; n < 2; ++n) acc[a][b][m][n] = (f32x4){0.f, 0.f, 0.f, 0.f};
        cur = nxt; cAb = nAb; cB = nB; ++ui;
#pragma unroll
        for (int h = 0; h < 2; ++h)
#pragma unroll
            for (int i = 0; i < 2; ++i) oaC[h][i] = oaN[h][i];
    }
    G8_WAIT_V(0);
    if (wr == 0) G8_BAR;
    G8_BAR;
#undef G8_SA
#undef G8_SB
#undef G8_STAGE_A
#undef G8_STAGE_B
#undef G8_LDA
#undef G8_LDB
#undef G8_MMA
#undef G8_WAIT_V
#undef G8_WAIT_L
#undef G8_BAR
#undef G8_SCHED
}

struct DenseSched {
    const bf16* A; int lda; const bf16* Bt; int K; int MT, NT; int F;
    __device__ __forceinline__ bool next(int i, Unit& u) const { const int G = gridDim.x; if (i >= F || i * G >= MT * NT) return false; const int ul = xcd_unit(i); if (ul >= MT * NT) return false;
        int mt, nt_; unit_tile(ul, MT, NT, mt, nt_); u.pm = mt; u.pn = nt_; u.i0 = 0; u.p = nullptr; return true; }
    __device__ __forceinline__ void src(const Unit& u, const int (&R)[2], const int (&C)[2], unsigned (&oa)[2][2], const char*& abase, const char*& bbase) const {
        abase = (const char*)(A + (size_t)u.pm * 256 * lda); bbase = (const char*)(Bt + (size_t)u.pn * 256 * K);
#pragma unroll
        for (int h = 0; h < 2; ++h)
#pragma unroll
            for (int i = 0; i < 2; ++i) oa[h][i] = (unsigned)((128 * h + R[i]) * lda + C[i]) * 2u; }
};
}

struct EpiProj {
    static constexpr bool PERM = true;
    bf16* O; int ldc;
    __device__ __forceinline__ void operator()(const f32x4 (&acc)[2][2][4][2], const g8::Unit& u, int wr, int wc, int fr, int fq) const {
        const int row0 = u.pm * 256 + wr * 64 + fr, col0 = u.pn * 256 + wc * 32 + 8 * fq;
#pragma unroll
        for (int ai = 0; ai < 2; ++ai)
#pragma unroll
            for (int m = 0; m < 4; ++m) { bf16* rowp = O + (size_t)(row0 + ai * 128 + m * 16) * ldc + col0;
#pragma unroll
                for (int bj = 0; bj < 2; ++bj) { const f32x4 v0 = acc[ai][bj][m][0], v1 = acc[ai][bj][m][1];
                    u32x4 w; w[0] = pk2(v0[0], v0[1]); w[1] = pk2(v0[2], v0[3]); w[2] = pk2(v1[0], v1[1]); w[3] = pk2(v1[2], v1[3]);
                    *(u32x4*)(rowp + bj * 128) = w; } }
    }
};
template <int NB>
__device__ __forceinline__ void phase_inproj8(const bf16* H, const bf16* Wt, bf16* PROJ, float* GATES, LAS unsigned char* lds) {
    constexpr int T = NB * (SEQ + CTXL), MT = T / 256;
    g8::DenseSched S{H, D, Wt, D, MT, PROJW / 256, 1 << 20};
    EpiProj E{PROJ, PROJW};
    g8::gemm_phase(lds, D, S, E);
    for (int mt = blockIdx.x; mt < MT; mt += gridDim.x) {
        const bf16* arow[4];
#pragma unroll
        for (int i = 0; i < 4; ++i) arow[i] = H + (size_t)(mt * 256 + (otid() >> 3) + 64 * i) * D;
        gemm_tile(arow, Wt + (size_t)PROJW * D, D, D, lds, [&](const f32x16 (&acc)[2][2], int wm, int wn, int lane) {
            if (wn == 0) {
#pragma unroll
                for (int mi = 0; mi < 2; ++mi) { const int row = mt * 256 + wm * 64 + mi * 32 + (lane & 31);
#pragma unroll
                    for (int ni = 0; ni < 2; ++ni)
#pragma unroll
                        for (int g = 0; g < 4; ++g) { f32x4 o; o[0] = acc[mi][ni][4 * g]; o[1] = acc[mi][ni][4 * g + 1]; o[2] = acc[mi][ni][4 * g + 2]; o[3] = acc[mi][ni][4 * g + 3];
                            *(f32x4*)(GATES + (size_t)row * 64 + ni * 32 + 8 * g + 4 * (lane >> 5)) = o; } } }
        });
        __syncthreads();
    }
}
template <int NB> struct EpiResid {
    static constexpr bool PERM = false;
    const float* xl; const float* xc; const float* modl; float* Xout;
    __device__ __forceinline__ void operator()(const f32x4 (&acc)[2][2][4][2], const g8::Unit& u, int wr, int wc, int fr, int fq) const {
        constexpr int TL = NB * SEQ;
        const float* mv = modl + (size_t)mod_row<NB>(u.pm * 256) * 6144 + 2 * 1024;
        const int col0 = u.pn * 256 + wc * 32 + 4 * fq;
#pragma unroll
        for (int ai = 0; ai < 2; ++ai)
#pragma unroll
            for (int m = 0; m < 4; ++m) { const int row = u.pm * 256 + ai * 128 + wr * 64 + m * 16 + fr;
                const float* srcp = (row < TL ? xl + (size_t)row * D : xc + (size_t)(row - TL) * D) + col0;
                float* dstp = Xout + (size_t)row * D + col0;
#pragma unroll
                for (int bj = 0; bj < 2; ++bj)
#pragma unroll
                    for (int n = 0; n < 2; ++n) { const int co = bj * 128 + n * 16;
                        const f32x4 xv = *(const f32x4*)(srcp + co), m2 = *(const f32x4*)(mv + col0 + co);
                        f32x4 o;
#pragma unroll
                        for (int j = 0; j < 4; ++j) o[j] = xv[j] + m2[j] * acc[ai][bj][m][n][j];
                        *(f32x4*)(dstp + co) = o; } }
    }
};
template <int NB, class Idle>
__device__ __forceinline__ void phase_outproj8(const bf16* A, int lda, int K, const bf16* Wt, int nrows, const float* xl, const float* xc, const float* modl, float* Xout, LAS unsigned char* lds, Idle&& idle) {
    constexpr int TL = NB * SEQ;
    const int MT = nrows / 256, U = MT * 4, G = gridDim.x, F = U / G, R = U - F * G;
    if (F > 0) { g8::DenseSched S{A, lda, Wt, K, MT, 4, F}; EpiResid<NB> E{xl, xc, modl, Xout}; g8::gemm_phase(lds, K, S, E); }
    for (int r = 0; r * G < 2 * R; ++r) {
        const int hu = r * G + (int)blockIdx.x;
        if (hu >= 2 * R) { idle(hu - 2 * R, (r + 1) * G - 2 * R); continue; }
        int mt, nt2; unit_tile(F * G + (hu >> 1), MT, 4, mt, nt2);
        const int nt = 2 * nt2 + (hu & 1);
        const bf16* arow[4];
#pragma unroll
        for (int i = 0; i < 4; ++i) arow[i] = A + (size_t)(mt * 256 + (otid() >> 3) + 64 * i) * lda;
        gemm_tile(arow, Wt + (size_t)nt * 128 * K, K, K, lds, [&](const f32x16 (&acc)[2][2], int wm, int wn, int lane) { stage_f32_128(acc, lds, wm, wn, lane); });
        __syncthreads();
        {
            const float* mv = modl + (size_t)mod_row<NB>(mt * 256) * 6144 + 2 * 1024 + nt * 128;
            const int t = otid(), piece = t & 31;
            const f32x4 m2 = *(const f32x4*)(mv + piece * 4);
#pragma unroll 4
            for (int it = 0; it < 16; ++it) { const int rl = it * 16 + (t >> 5), row = mt * 256 + rl;
                const f32x4 a = *(const LAS f32x4*)(lds + rl * CST_F32 + piece * 16);
                const float* srcp = (row < TL ? xl + (size_t)row * D : xc + (size_t)(row - TL) * D) + nt * 128 + piece * 4;
                const f32x4 xv = *(const f32x4*)srcp;
                f32x4 o;
#pragma unroll
                for (int j = 0; j < 4; ++j) o[j] = xv[j] + m2[j] * a[j];
                __builtin_nontemporal_store(o, (f32x4*)(Xout + (size_t)row * D + nt * 128 + piece * 4)); }
        }
        __syncthreads();
    }
}
template <bool UP> struct MoeSched {
    const bf16* Abuf; const bf16* W; const int* cnt; const int* list; int cap; const LAS int* pre; int ntile; int F;
    static constexpr int KK = UP ? 1024 : 512;
    __device__ __forceinline__ bool next(int i, g8::Unit& u) const { const int G = gridDim.x; if (i >= F) return false; const int ul = xcd_unit(i); if (ul >= ntile * 4) return false;
        const int t = ul >> 2, e = moe_find(pre, t), mt = t - pre[e]; u.pm = e; u.pn = ul & 3; u.i0 = cnt[e * 64] - mt * 256; u.p = list + (size_t)e * cap + mt * 256; return true; }
    __device__ __forceinline__ void src(const g8::Unit& u, const int (&R)[2], const int (&C)[2], unsigned (&oa)[2][2], const char*& abase, const char*& bbase) const {
        abase = (const char*)Abuf; bbase = (const char*)(W + (size_t)u.pm * 1024 * KK + (size_t)u.pn * 256 * KK);
#pragma unroll
        for (int h = 0; h < 2; ++h)
#pragma unroll
            for (int i = 0; i < 2; ++i) { const int r = 128 * h + R[i]; const int ent = u.p[r < u.i0 ? r : 0];
                oa[h][i] = (unsigned)((UP ? (ent >> 1) * 1024 : ent * 512) + C[i]) * 2u; } }
};
struct EpiMoeUp8 {
    static constexpr bool PERM = true;
    const float* route_w; bf16* ACT;
    __device__ __forceinline__ void operator()(const f32x4 (&acc)[2][2][4][2], const g8::Unit& u, int wr, int wc, int fr, int fq) const {
#pragma unroll
        for (int ai = 0; ai < 2; ++ai)
#pragma unroll
            for (int m = 0; m < 4; ++m) { const int r = ai * 128 + wr * 64 + m * 16 + fr;
                if (r < u.i0) { const int ent = u.p[r]; const float w = route_w[ent];
                    float v[8];
#pragma unroll
                    for (int n = 0; n < 2; ++n)
#pragma unroll
                        for (int j = 0; j < 4; ++j) v[4 * n + j] = siluf(acc[ai][0][m][n][j]) * acc[ai][1][m][n][j] * w;
                    u32x4 o; o[0] = pk2(v[0], v[1]); o[1] = pk2(v[2], v[3]); o[2] = pk2(v[4], v[5]); o[3] = pk2(v[6], v[7]);
                    *(u32x4*)(ACT + (size_t)ent * 512 + u.pn * 128 + wc * 32 + 8 * fq) = o; } }
    }
};
struct EpiMoeDown8 {
    static constexpr bool PERM = true;
    bf16* Y2;
    __device__ __forceinline__ void operator()(const f32x4 (&acc)[2][2][4][2], const g8::Unit& u, int wr, int wc, int fr, int fq) const {
#pragma unroll
        for (int ai = 0; ai < 2; ++ai)
#pragma unroll
            for (int m = 0; m < 4; ++m) { const int r = ai * 128 + wr * 64 + m * 16 + fr;
                if (r < u.i0) { bf16* rowp = Y2 + (size_t)u.p[r] * D + u.pn * 256 + wc * 32 + 8 * fq;
#pragma unroll
                    for (int bj = 0; bj < 2; ++bj) { const f32x4 v0 = acc[ai][bj][m][0], v1 = acc[ai][bj][m][1];
                        u32x4 o; o[0] = pk2(v0[0], v0[1]); o[1] = pk2(v0[2], v0[3]); o[2] = pk2(v1[0], v1[1]); o[3] = pk2(v1[2], v1[3]);
                        *(u32x4*)(rowp + bj * 128) = o; } } }
    }
};
struct BRowGU { int s; __device__ __forceinline__ int operator()(int r) const { return ((r >> 5) & 1) * 128 + 64 * s + (r >> 6) * 32 + (r & 31); } };

__device__ __forceinline__ void phase_moe_up8(const bf16* H2, const bf16* Wgu, const int* cnt, const int* list, int cap, const float* route_w, bf16* ACT, LAS unsigned char* lds) {
    LAS int* pre = (LAS int*)(lds + GEMM_LDS);
    const int ntile = moe_prefix(cnt, pre);
    const int G = gridDim.x, U = ntile * 4, F = U / G, R = U - F * G;
    if (F > 0) { MoeSched<true> S{H2, Wgu, cnt, list, cap, pre, ntile, F}; EpiMoeUp8 E{route_w, ACT}; g8::gemm_phase(lds, 1024, S, E); }
    for (int r = 0; r * G < 2 * R; ++r) {
        const int hu = r * G + (int)blockIdx.x; if (hu >= 2 * R) continue;
        const int ul = F * G + (hu >> 1), s = hu & 1, t = ul >> 2, pn = ul & 3, e = moe_find(pre, t), mt = t - pre[e], ce = cnt[e * 64];
        const int* le = list + (size_t)e * cap + mt * 256;
        const int nvalid = ce - mt * 256;
        const bf16* arow[4];
#pragma unroll
        for (int i = 0; i < 4; ++i) { const int rr = (otid() >> 3) + 64 * i; const int ent = le[rr < nvalid ? rr : 0]; arow[i] = H2 + (size_t)(ent >> 1) * D; }
        gemm_tile(arow, Wgu + (size_t)e * 1024 * 1024 + (size_t)pn * 256 * 1024, 1024, 1024, lds, [&](const f32x16 (&acc)[2][2], int wm, int wn, int lane) {
#pragma unroll
            for (int mi = 0; mi < 2; ++mi) { const int rr = wm * 64 + mi * 32 + (lane & 31);
                const float w = rr < nvalid ? route_w[le[rr]] : 0.f;
                LAS unsigned char* rp = lds + rr * CST_BF64 + (wn * 32 + 4 * (lane >> 5)) * 2;
#pragma unroll
                for (int g = 0; g < 4; ++g) { float v[4];
#pragma unroll
                    for (int j = 0; j < 4; ++j) v[j] = siluf(acc[mi][0][4 * g + j]) * acc[mi][1][4 * g + j] * w;
                    u32x2 o; o[0] = pk2(v[0], v[1]); o[1] = pk2(v[2], v[3]); *(LAS u32x2*)(rp + 8 * g * 2) = o; } }
        }, BRowGU{s});
        __syncthreads();
        flush_bf16_64(lds, [&](int rr) -> bf16* { return rr < nvalid ? ACT + (size_t)le[rr] * 512 + pn * 128 + 64 * s : nullptr; });
        __syncthreads();
    }
}
__device__ __forceinline__ void phase_moe_down8(const bf16* ACT, const bf16* Wd, const int* cnt, const int* list, int cap, bf16* Y2, LAS unsigned char* lds) {
    LAS int* pre = (LAS int*)(lds + GEMM_LDS);
    const int ntile = moe_prefix(cnt, pre);
    const int G = gridDim.x, U = ntile * 4, F = U / G, R = U - F * G;
    if (F > 0) { MoeSched<false> S{ACT, Wd, cnt, list, cap, pre, ntile, F}; EpiMoeDown8 E{Y2}; g8::gemm_phase(lds, 512, S, E); }
    for (int r = 0; r * G < 2 * R; ++r) {
        const int hu = r * G + (int)blockIdx.x; if (hu >= 2 * R) continue;
        const int ul = F * G + (hu >> 1), t = ul >> 2, nt = 2 * (ul & 3) + (hu & 1), e = moe_find(pre, t), mt = t - pre[e], ce = cnt[e * 64];
        const int* le = list + (size_t)e * cap + mt * 256;
        const int nvalid = ce - mt * 256;
        const bf16* arow[4];
#pragma unroll
        for (int i = 0; i < 4; ++i) { const int rr = (otid() >> 3) + 64 * i; const int ent = le[rr < nvalid ? rr : 0]; arow[i] = ACT + (size_t)ent * 512; }
        gemm_tile(arow, Wd + (size_t)e * 1024 * 512 + (size_t)nt * 128 * 512, 512, 512, lds, [&](const f32x16 (&acc)[2][2], int wm, int wn, int lane) { stage_bf16_128(acc, lds, wm, wn, lane); });
        __syncthreads();
        flush_bf16_128(lds, [&](int rr) -> bf16* { return rr < nvalid ? Y2 + (size_t)le[rr] * D + nt * 128 : nullptr; });
        __syncthreads();
    }
}
}
#define XB_TMO      128
#define XB_XCNT(j)  (256  + 64 * (j))
#define XB_XSUB(j)  (1280 + 64 * (j))
#define XB_XGEN(j)  (2304 + 64 * (j))
#define XB_TOP      3328
#define XB_TOPGEN   3392
#define XCD_BAR_WORDS 3456
#define XB_SPIN_CAP (1u << 18)

__device__ __forceinline__ unsigned xb_ld(unsigned* p)              { return __hip_atomic_load(p, __ATOMIC_RELAXED, __HIP_MEMORY_SCOPE_AGENT); }
__device__ __forceinline__ unsigned xb_add(unsigned* p, unsigned v) { return __hip_atomic_fetch_add(p, v, __ATOMIC_RELAXED, __HIP_MEMORY_SCOPE_AGENT); }
__device__ __forceinline__ unsigned xb_xcc_id() { return (unsigned)__builtin_amdgcn_s_getreg((3 << 11) | 20) & 0xFu; }
#define XB_SPIN(cond, bar) do { unsigned _sp = 0; while (cond) { __builtin_amdgcn_s_sleep(1); \
    if ((++_sp & 255u) == 0u) { if (xb_ld(&(bar)[XB_TMO])) break; if (_sp > XB_SPIN_CAP) { atomicAdd(&(bar)[XB_TMO], 1u); break; } } } } while (0)

struct XcdBarrier {
    unsigned* bar; unsigned x;
    volatile LAS unsigned* st;
};

__device__ __forceinline__ XcdBarrier xcd_barrier_post(unsigned* bar, volatile LAS unsigned* st) {
    XcdBarrier b; b.bar = bar; b.x = xb_xcc_id(); b.st = st;
    if (threadIdx.x == 0) (void)xb_add(&bar[XB_XCNT(b.x)], 1u);
    return b;
}
__device__ __forceinline__ void xcd_barrier_complete(unsigned* bar, unsigned x, unsigned& nloc, unsigned& nx) {
    const unsigned G = gridDim.x * gridDim.y * gridDim.z;
    unsigned sum, cnt, mine, sp = 0u;
    for (;;) {
        sum = 0u; cnt = 0u; mine = 0u;
#pragma unroll
        for (unsigned j = 0; j < 16; ++j) { const unsigned c = xb_ld(&bar[XB_XCNT(j)]); sum += c; cnt += (c > 0u) ? 1u : 0u; mine = (j == x) ? c : mine; }
        if (sum == G) break;
        __builtin_amdgcn_s_sleep(1);
        if ((++sp & 255u) == 0u) { if (xb_ld(&bar[XB_TMO])) break; if (sp > XB_SPIN_CAP) { atomicAdd(&bar[XB_TMO], 1u); break; } }
    }
    nloc = mine > 0u ? mine : 1u; nx = cnt > 0u ? cnt : 1u;
}

__device__ __forceinline__ void xcd_barrier(const XcdBarrier& b) {
    asm volatile("s_waitcnt vmcnt(0)" ::: "memory");
    __syncthreads();
    if (threadIdx.x == 0) {
        unsigned* bar = b.bar;
        __builtin_amdgcn_s_waitcnt(0);
        unsigned nloc = b.st[0], nx = b.st[1];
        if (nloc == 0u) { xcd_barrier_complete(bar, b.x, nloc, nx); b.st[0] = nloc; b.st[1] = nx; }
        const unsigned old = xb_add(&bar[XB_XSUB(b.x)], 1u);
        const unsigned gen = old / nloc;
        if (old + 1u == (gen + 1u) * nloc) {
            __builtin_amdgcn_fence(__ATOMIC_RELEASE, "agent");
            asm volatile("s_waitcnt vmcnt(0)" ::: "memory");
            const unsigned og = xb_add(&bar[XB_TOP], 1u);
            const unsigned tg = og / nx;
            if (og + 1u == (tg + 1u) * nx) xb_add(&bar[XB_TOPGEN], 1u);
            else XB_SPIN(xb_ld(&bar[XB_TOPGEN]) == tg, bar);
            __builtin_amdgcn_fence(__ATOMIC_ACQUIRE, "agent");
            xb_add(&bar[XB_XGEN(b.x)], 1u);
            asm volatile("s_waitcnt vmcnt(0)" ::: "memory");
        } else {
            XB_SPIN(xb_ld(&bar[XB_XGEN(b.x)]) == gen, bar);
            __builtin_amdgcn_fence(__ATOMIC_ACQUIRE, "agent");
            asm volatile("s_waitcnt vmcnt(0)" ::: "memory");
        }
    }
    __syncthreads();
}
namespace mk {
using namespace fx;
constexpr int NB = 4;
typedef Plan<NB> PL;

__global__ void __launch_bounds__(512, 2) k_mega(P p) {
    extern __shared__ __attribute__((aligned(16))) unsigned char lds_raw[];
    LAS unsigned char* lds = (LAS unsigned char*)lds_raw;
    unsigned char* ws = p.ws;
    const In& in = p.in;
    LAS unsigned* xbw = (LAS unsigned*)(lds + LDS_BYTES - 16);
    if (threadIdx.x == 0) { xbw[0] = 0u; xbw[1] = 0u; xbw[2] = 0u; xbw[3] = 0u; }
    __syncthreads();
    XcdBarrier bar = xcd_barrier_post((unsigned*)(ws + PL::CTL_BAR), (volatile LAS unsigned*)xbw);
    float* modv = (float*)(ws + PL::MODV);
    const float* mod0 = modv; const float* mod1 = modv + 5 * 6144;
    bf16* H = (bf16*)(ws + PL::H);
    int* cnt0 = (int*)(ws + PL::CTL_CNT); int* cnt1 = cnt0 + 32 * 64;
    int* list = (int*)(ws + PL::LIST); float* rw = (float*)(ws + PL::RW);
    bf16* wmoe0 = (bf16*)(ws + PL::W_MOE0); bf16* wmoe1 = (bf16*)(ws + PL::W_MOE1);
    const size_t GU = (size_t)32 * 1024 * 1024;
    float* X1 = (float*)(ws + PL::X1); float* X2 = (float*)(ws + PL::X2); float* X3 = (float*)(ws + PL::X3);
#ifndef MOE1_EARLY
#define MOE1_EARLY 1792
#endif
#ifndef REPMASK
#define REPMASK 0
#endif
#ifndef XBAR
#define XBAR 0
#endif
#define PH(k, ...) { __VA_ARGS__; xcd_barrier(bar); if ((REPMASK >> (k)) & 1) { __VA_ARGS__; xcd_barrier(bar); } }
    PH(0, conv_small_weights(in, ws, PL::W_IN, PL::W_OUT, PL::W_QKV, PL::W_NAO, lds); mod_vectors(in, modv, lds); conv_moe_weights(in, 0, wmoe0, wmoe0 + GU, lds))
    for (int i = 0; i < XBAR; ++i) xcd_barrier(bar);
    PH(1, rows_phase<NB, false, false, true, false>(in.x, in.ctx, PL::T, nullptr, mod0, mod0, nullptr, nullptr, in.norm1_w, 0, 1, H,
                                              nullptr, nullptr, nullptr, nullptr, nullptr, nullptr, nullptr, 0, lds))
    phase_inproj8<NB>(H, (const bf16*)(ws + PL::W_IN), (bf16*)(ws + PL::PROJ), (float*)(ws + PL::GATES), lds);
    xcd_barrier(bar);
#ifdef GVAR
    phase_inproj_v<NB, GVAR>(H, (const bf16*)(ws + PL::W_IN), (bf16*)(ws + PL::PROJ), (float*)(ws + PL::GATES), lds, p.out == nullptr);
    xcd_barrier(bar);
#endif
    PH(3, phase_tables<NB>(in, (const float*)(ws + PL::GATES), ws + PL::H, lds); phase_conv<NB>((const bf16*)(ws + PL::PROJ), in.ab_conv_w, in.ab_conv_b, (bf16*)(ws + PL::XBC)))
    phase_scan<NB>((const bf16*)(ws + PL::PROJ), ws + PL::H, (const bf16*)(ws + PL::XBC), (bf16*)(ws + PL::SC), lds);
    xcd_barrier(bar);
#ifdef SCANMODE
    phase_scan<NB>((const bf16*)(ws + PL::PROJ), ws + PL::H, (const bf16*)(ws + PL::XBC), (bf16*)(ws + PL::SC), lds, p.out ? SCANMODE : 3);
    xcd_barrier(bar);
#endif
#ifdef REP5
    phase_mixer_out<NB>(in, (const bf16*)(ws + PL::PROJ), (const bf16*)(ws + PL::XBC), (bf16*)(ws + PL::SC), (bf16*)(ws + PL::W_MOE1));
    xcd_barrier(bar);
#endif
    phase_mixer_out<NB>(in, (const bf16*)(ws + PL::PROJ), (const bf16*)(ws + PL::XBC), (bf16*)(ws + PL::SC));
    xcd_barrier(bar);
    PH(6, phase_outproj8<NB>((const bf16*)(ws + PL::SC), 4096, 2048, (const bf16*)(ws + PL::W_OUT), PL::T, in.x, in.ctx, mod0, X1, lds,
        [&](int rank, int nidle) { conv_moe_weights(in, 1, wmoe1, wmoe1 + GU, lds, 0, MOE1_EARLY, rank, nidle); }))
    rows_phase<NB, false, false, true, true>(X1, X1 + PL::TL * D, PL::T, nullptr, mod0, mod0, nullptr, nullptr, in.norm2_w, 3, 4, H,
        in.moe_w_group, in.moe_b_group, in.moe_w_expert, in.moe_b_expert, rw, cnt0, list, (int)PL::T, lds);
    PH(7, conv_moe_weights(in, 1, wmoe1, wmoe1 + GU, lds, MOE1_EARLY, MOE_CONV_UNITS))
    PH(8, phase_moe_up8(H, wmoe0, cnt0, list, (int)PL::T, rw, (bf16*)(ws + PL::ACT), lds))
    PH(9, phase_moe_down8((const bf16*)(ws + PL::ACT), wmoe0 + GU, cnt0, list, (int)PL::T, (bf16*)(ws + PL::Y2), lds))
    PH(10, rows_phase<NB, true, true, true, false>(X1, X1 + PL::TL * D, PL::T, (const bf16*)(ws + PL::Y2), mod0, mod1, X2, nullptr, in.norm1_w + 1024, 0, 1, H,
        nullptr, nullptr, nullptr, nullptr, nullptr, nullptr, nullptr, 0, lds))
    PH(11, phase_qkv<NB>(H, (const bf16*)(ws + PL::W_QKV), in.na_q_norm, in.na_k_norm, (bf16*)(ws + PL::QKV), lds))
    PH(12, phase_attn<NB>((const bf16*)(ws + PL::QKV), in.na_rpb, (bf16*)(ws + PL::AO), lds))
    PH(13, phase_outproj8<NB>((const bf16*)(ws + PL::AO), 1024, 1024, (const bf16*)(ws + PL::W_NAO), PL::TL, X2, X2 + PL::TL * D, mod1, X3, lds, [](int, int) {}))
    rows_phase<NB, false, false, true, true>(X3, X3, PL::TL, nullptr, mod1, mod1, nullptr, nullptr, in.norm2_w + 1024, 3, 4, H,
        in.moe_w_group + 1024 * 4, in.moe_b_group + 4, in.moe_w_expert + 1024 * 32, in.moe_b_expert + 32, rw, cnt1, list, (int)PL::T, lds);
    xcd_barrier(bar);
    PH(15, phase_moe_up8(H, wmoe1, cnt1, list, (int)PL::T, rw, (bf16*)(ws + PL::ACT), lds))
    PH(16, phase_moe_down8((const bf16*)(ws + PL::ACT), wmoe1 + GU, cnt1, list, (int)PL::T, (bf16*)(ws + PL::Y2), lds))
    rows_phase<NB, true, false, false, false>(X3, X3, PL::TL, (const bf16*)(ws + PL::Y2), mod1, mod1, nullptr, p.out, nullptr, 0, 0, nullptr,
        nullptr, nullptr, nullptr, nullptr, nullptr, nullptr, nullptr, 0, lds);
    if ((REPMASK >> 17) & 1) { xcd_barrier(bar); rows_phase<NB, true, false, false, false>(X3, X3, PL::TL, (const bf16*)(ws + PL::Y2), mod1, mod1, nullptr, p.out, nullptr, 0, 0, nullptr,
        nullptr, nullptr, nullptr, nullptr, nullptr, nullptr, nullptr, 0, lds); }
#undef PH
}
__global__ void k_fill(float* q, size_t n, float v) { size_t i = (size_t)blockIdx.x * 256 + threadIdx.x; if (i < n) q[i] = v; }
}

extern "C" void kernel_launch(void* const* d_in, const int* in_sizes, int n_in, void* d_out, int out_size, void* d_ws, size_t ws_size, hipStream_t stream) {
    static int grid = 0;
    if (grid == 0) {
        int dev = 0, cus = 0, per_cu = 0;
        (void)hipGetDevice(&dev);
        (void)hipDeviceGetAttribute(&cus, hipDeviceAttributeMultiprocessorCount, dev);
        if (hipFuncSetAttribute((const void*)mk::k_mega, hipFuncAttributeMaxDynamicSharedMemorySize, fx::LDS_BYTES) != hipSuccess) { grid = -1; }
        else {
            if (hipOccupancyMaxActiveBlocksPerMultiprocessor(&per_cu, (const void*)mk::k_mega, 512, fx::LDS_BYTES) != hipSuccess) per_cu = 0;
            (void)hipGetLastError();
            grid = per_cu >= 1 ? cus : -1;
        }
    }
    if (grid < 0 || n_in != 31 || mk::PL::END > ws_size) { mk::k_fill<<<(out_size + 255) / 256, 256, 0, stream>>>((float*)d_out, (size_t)out_size, 2.f); return; }
    (void)hipMemsetAsync((unsigned char*)d_ws + mk::PL::CTL, 0, mk::PL::CTL_BYTES, stream);
    fx::P fp;
    { const float** q = (const float**)&fp.in; for (int i = 0; i < 31; ++i) q[i] = (const float*)d_in[i]; }
    fp.ws = (unsigned char*)d_ws; fp.out = (float*)d_out;
    hipLaunchKernelGGL(mk::k_mega, dim3(grid), dim3(512), fx::LDS_BYTES, stream, fp);
}
```

```cpp
#include <hip/hip_runtime.h>
#include <cstdio>
#include <cstdint>
namespace fx {
#define LAS __attribute__((address_space(3)))
typedef unsigned short bf16;
typedef short bf16x8 __attribute__((ext_vector_type(8)));
typedef short bf16x4 __attribute__((ext_vector_type(4)));
typedef float f32x16 __attribute__((ext_vector_type(16)));
typedef float f32x4 __attribute__((ext_vector_type(4)));
typedef unsigned u32x4 __attribute__((ext_vector_type(4)));
typedef unsigned u32x2 __attribute__((ext_vector_type(2)));
constexpr int NTHR = 512, NWAVE = 8;
constexpr int D = 1024, SEQ = 4096, CTXL = 256;
constexpr int PROJW = 5632, NIN = 5760;
constexpr int PC_Z = 0, PC_XBC = 1024, PC_Q = 2560, PC_K = 3072, PC_V = 3584, PC_O = 4608;
constexpr int LDS_BYTES = 152 * 1024;

__device__ __forceinline__ int otid() { int t = threadIdx.x; asm volatile("" : "+v"(t)); return t; }
__device__ __forceinline__ float bf2f(bf16 v) { return __uint_as_float((unsigned)v << 16); }
__device__ __forceinline__ float bflo(unsigned u) { return __uint_as_float(u << 16); }
__device__ __forceinline__ float bfhi(unsigned u) { return __uint_as_float(u & 0xffff0000u); }
typedef __bf16 bf16x2_t __attribute__((ext_vector_type(2)));
typedef float f32x2_t __attribute__((ext_vector_type(2)));
__device__ __forceinline__ unsigned pk2(float lo, float hi) { const f32x2_t v = {lo, hi}; return __builtin_bit_cast(unsigned, __builtin_convertvector(v, bf16x2_t)); }
__device__ __forceinline__ float siluf(float v) { return v / (1.f + __expf(-v)); }
__device__ __forceinline__ float sigmf(float v) { return 1.f / (1.f + __expf(-v)); }
__device__ __forceinline__ float softplusf(float v) { return v > 20.f ? v : log1pf(__expf(v)); }
__device__ __forceinline__ float logsigf(float v) { return fminf(v, 0.f) - log1pf(__expf(-fabsf(v))); }
__device__ __forceinline__ float wave_sum(float v) {
#pragma unroll
    for (int o = 32; o > 0; o >>= 1) v += __shfl_xor(v, o);
    return v;
}
__device__ __forceinline__ float wave_max(float v) {
#pragma unroll
    for (int o = 32; o > 0; o >>= 1) v = fmaxf(v, __shfl_xor(v, o));
    return v;
}
__device__ __forceinline__ f32x16 mfma32(bf16x8 a, bf16x8 b, f32x16 c) { return __builtin_amdgcn_mfma_f32_32x32x16_bf16(a, b, c, 0, 0, 0); }
__device__ __forceinline__ f32x4 mfma16(bf16x8 a, bf16x8 b, f32x4 c) { return __builtin_amdgcn_mfma_f32_16x16x32_bf16(a, b, c, 0, 0, 0); }

__device__ __forceinline__ bf16x8 frag_row(const LAS unsigned char* T, int RS, int r0, int k0, int lane) {
    return *(const LAS bf16x8*)(T + (r0 + (lane & 31)) * RS + (k0 + 8 * (lane >> 5)) * 2);
}
__device__ __forceinline__ bf16x8 frag_col(const LAS unsigned char* T, int RS, int k0, int c0, int lane) {
    const int h = lane >> 5, blk = (lane >> 4) & 1, q = (lane & 15) >> 2, p = lane & 3;
    const unsigned a0 = (unsigned)(size_t)(T + (k0 + 8 * h + q) * RS + (c0 + 16 * blk + 4 * p) * 2);
    const unsigned a1 = a0 + 4 * RS;
    bf16x4 v0, v1;
    asm volatile("ds_read_b64_tr_b16 %0, %2\n\tds_read_b64_tr_b16 %1, %3\n\ts_waitcnt lgkmcnt(0)" : "=&v"(v0), "=&v"(v1) : "v"(a0), "v"(a1) : "memory");
    bf16x8 r; r[0] = v0[0]; r[1] = v0[1]; r[2] = v0[2]; r[3] = v0[3]; r[4] = v1[0]; r[5] = v1[1]; r[6] = v1[2]; r[7] = v1[3];
    return r;
}

struct In {
    const float *x, *c, *ctx, *c_ctx, *norm1_w, *norm2_w, *mod_w, *mod_b, *ab_w_in, *ab_conv_w, *ab_conv_b, *ssd_a_log, *ssd_dt_bias, *ssd_d,
        *ssd_norm_w, *ml_i_bias, *ml_f_bias, *ml_norm_w, *ab_w_out, *na_w_qkv, *na_q_norm, *na_k_norm, *na_rpb, *na_w_out,
        *moe_w_group, *moe_b_group, *moe_w_expert, *moe_b_expert, *moe_w_gate, *moe_w_up, *moe_w_down;
};

constexpr size_t cmax(size_t a, size_t b) { return a > b ? a : b; }
constexpr size_t al256(size_t x) { return (x + 255) & ~(size_t)255; }

template <int NB> struct Plan {
    static constexpr size_t TL = (size_t)NB * SEQ, TC = (size_t)NB * CTXL, T = TL + TC;
    static constexpr size_t CTL = 0;
    static constexpr size_t CTL_BAR = 0, CTL_CNT = 16384  , CTL_BYTES = 32768;
    static constexpr size_t MODV = CTL + CTL_BYTES;
    static constexpr size_t RW = MODV + al256(2 * 5 * 6144 * 4);
    static constexpr size_t LIST = RW + al256(2 * T * 4);
    static constexpr size_t W_IN = LIST + al256(32 * T * 4);
    static constexpr size_t W_OUT = W_IN + (size_t)NIN * 1024 * 2;
    static constexpr size_t W_QKV = W_OUT + (size_t)1024 * 2048 * 2;
    static constexpr size_t W_NAO = W_QKV + (size_t)3072 * 1024 * 2;
    static constexpr size_t ARENA = W_NAO + (size_t)1024 * 1024 * 2;
    static constexpr size_t MOEW = (size_t)32 * 1024 * 1024 * 2 + (size_t)32 * 1024 * 512 * 2;
    static constexpr size_t SZ_B = al256(T * 1024 * 2);
    static constexpr size_t SZ_A = al256(cmax(MOEW, cmax(T * 3072 * 2, T * 1024 * 4)));
    static constexpr size_t SZ_X = al256(T * 1024 * 4);
    static constexpr size_t SZ_C = al256(cmax(T * PROJW * 2 + T * 64 * 4, SZ_X + MOEW));
    static constexpr size_t SZ_D = al256(T * 1536 * 2);
    static constexpr size_t SZ_E = al256(T * 4096 * 2);
    static constexpr size_t RB = ARENA, RA = RB + SZ_B, RC = RA + SZ_A, RD = RC + SZ_C, RE = RD + SZ_D, END = RE + SZ_E;
    static constexpr size_t H = RB;
    static constexpr size_t W_MOE0 = RA;
    static constexpr size_t QKV = RA;
    static constexpr size_t X3 = RA;
    static constexpr size_t PROJ = RC;
    static constexpr size_t GATES = RC + T * PROJW * 2;
    static constexpr size_t X1 = RC;
    static constexpr size_t W_MOE1 = RC + SZ_X;
    static constexpr size_t XBC = RD;
    static constexpr size_t ACT = RD;
    static constexpr size_t AO = RD;
    static constexpr size_t SC = RE;
    static constexpr size_t Y2 = RE;
    static constexpr size_t X2 = RE + al256(2 * T * 1024 * 2);
    static_assert(2 * T * 1024 * 2 + T * 1024 * 4 <= SZ_E, "E");
    static_assert(T * 3072 * 2 <= SZ_A + SZ_X, "QKV spill");
};

struct P { In in; unsigned char* ws; float* out; };

template <int NB> __device__ __forceinline__ int mod_row(int row) { return row < NB * SEQ ? row / SEQ : 4; }

template <class ColPtr>
__device__ __forceinline__ void tconv_unit(ColPtr colptr, int ld_src, bf16* dst, int K, int k0, int n0, int ndst, LAS unsigned char* lds) {
    LAS float* tl = (LAS float*)lds;
    const int tid = otid();
    {
        const int n4 = (tid & 63) * 4, kb = tid >> 6;
        const float* sp = colptr(n0 + n4);
        f32x4 v[8];
#pragma unroll
        for (int i = 0; i < 8; ++i) v[i] = sp ? *(const f32x4*)(sp + (size_t)(k0 + kb + 8 * i) * ld_src) : (f32x4){0.f, 0.f, 0.f, 0.f};
#pragma unroll
        for (int i = 0; i < 8; ++i) *(LAS f32x4*)(tl + (kb + 8 * i) * 260 + n4) = v[i];
    }
    __syncthreads();
    {
        const int n = tid >> 1, half = tid & 1;
        if (n0 + n < ndst) {
            float v[32];
#pragma unroll
            for (int j = 0; j < 32; ++j) v[j] = tl[(half * 32 + j) * 260 + n];
            bf16* dp = dst + (size_t)(n0 + n) * K + k0 + half * 32;
#pragma unroll
            for (int q = 0; q < 4; ++q) { u32x4 o; o[0] = pk2(v[8 * q], v[8 * q + 1]); o[1] = pk2(v[8 * q + 2], v[8 * q + 3]); o[2] = pk2(v[8 * q + 4], v[8 * q + 5]); o[3] = pk2(v[8 * q + 6], v[8 * q + 7]);
                *(u32x4*)(dp + 8 * q) = o; }
        }
    }
    __syncthreads();
}

__device__ __forceinline__ int map_in(int n) { return n < 2560 ? n : (n < 5632 ? n + 32 : (n < 5664 ? n - 3072 : (n < 5680 ? n : -1))); }

__device__ __forceinline__ void conv_small_weights(const In& in, unsigned char* ws, size_t o_in, size_t o_out, size_t o_qkv, size_t o_nao, LAS unsigned char* lds) {
    const int total = 368 + 128 + 192 + 64;
    for (int u = blockIdx.x; u < total; u += gridDim.x) {
        if (u < 368) { const int kt = u % 16, nt = u / 16; const float* w = in.ab_w_in;
            tconv_unit([&](int n) -> const float* { const int c = n < NIN ? map_in(n) : -1; return c >= 0 ? w + c : nullptr; }, 5680, (bf16*)(ws + o_in), 1024, kt * 64, nt * 256, NIN, lds); }
        else if (u < 496) { const int v = u - 368, kt = v % 32, nt = v / 32; const float* w = in.ab_w_out;
            tconv_unit([&](int n) { return w + n; }, 1024, (bf16*)(ws + o_out), 2048, kt * 64, nt * 256, 1024, lds); }
        else if (u < 688) { const int v = u - 496, kt = v % 16, nt = v / 16; const float* w = in.na_w_qkv;
            tconv_unit([&](int n) { return w + n; }, 3072, (bf16*)(ws + o_qkv), 1024, kt * 64, nt * 256, 3072, lds); }
        else { const int v = u - 688, kt = v % 16, nt = v / 16; const float* w = in.na_w_out;
            tconv_unit([&](int n) { return w + n; }, 1024, (bf16*)(ws + o_nao), 1024, kt * 64, nt * 256, 1024, lds); }
    }
}

constexpr int MOE_CONV_UNITS = 3072;
__device__ __forceinline__ void conv_moe_weights(const In& in, int layer, bf16* wgu, bf16* wd, LAS unsigned char* lds, int begin = 0, int end = MOE_CONV_UNITS, int rank = -1, int stride = 0) {
    if (rank < 0) { rank = blockIdx.x; stride = gridDim.x; }
    const size_t wsz = (size_t)1024 * 512;
    for (int u = begin + rank; u < end; u += stride) {
        if (u < 2048) {
            const int e = u >> 6, v = u & 63, kt = v & 15, nt = v >> 4;
            const float* g = in.moe_w_gate + ((size_t)layer * 32 + e) * wsz; const float* up = in.moe_w_up + ((size_t)layer * 32 + e) * wsz;
            tconv_unit([&](int n) { const int f = (n >> 8) * 128 + (n & 127); return ((n & 128) ? up : g) + f; }, 512, wgu + (size_t)e * 1024 * 1024, 1024, kt * 64, nt * 256, 1024, lds);
        } else {
            const int w = u - 2048, e = w >> 5, v = w & 31, kt = v & 7, nt = v >> 3;
            const float* dsrc = in.moe_w_down + ((size_t)layer * 32 + e) * wsz;
            tconv_unit([&](int n) { return dsrc + n; }, 1024, wd + (size_t)e * 1024 * 512, 512, kt * 64, nt * 256, 1024, lds);
        }
    }
}

__device__ __forceinline__ void mod_vectors(const In& in, float* modv, LAS unsigned char* lds) {
    LAS float* sc = (LAS float*)lds;
    LAS float* red = sc + 5 * 1024;
    const int tid = otid();
    for (int i = tid; i < 5 * 1024; i += NTHR) { const int r = i >> 10, k = i & 1023; const float v = r < 4 ? in.c[r * 1024 + k] : in.c_ctx[k]; sc[i] = siluf(v); }
    __syncthreads();
    const int col = tid & 31, kq = tid >> 5;
    for (int u = blockIdx.x; u < 2 * 192; u += gridDim.x) {
        const int layer = u / 192, c0 = (u % 192) * 32;
        const float* w = in.mod_w + (size_t)layer * 1024 * 6144 + c0 + col;
        float a0 = 0.f, a1 = 0.f, a2 = 0.f, a3 = 0.f, a4 = 0.f;
#pragma unroll 8
        for (int j = 0; j < 64; ++j) { const int k = kq + 16 * j; const float wv = w[(size_t)k * 6144];
            a0 += sc[k] * wv; a1 += sc[1024 + k] * wv; a2 += sc[2048 + k] * wv; a3 += sc[3072 + k] * wv; a4 += sc[4096 + k] * wv; }
        red[(0 * 16 + kq) * 32 + col] = a0; red[(1 * 16 + kq) * 32 + col] = a1; red[(2 * 16 + kq) * 32 + col] = a2;
        red[(3 * 16 + kq) * 32 + col] = a3; red[(4 * 16 + kq) * 32 + col] = a4;
        __syncthreads();
        if (tid < 160) { const int r = tid >> 5, cc = tid & 31; float s = 0.f;
#pragma unroll
            for (int q = 0; q < 16; ++q) s += red[(r * 16 + q) * 32 + cc];
            modv[((size_t)layer * 5 + r) * 6144 + c0 + cc] = s + in.mod_b[layer * 6144 + c0 + cc]; }
        __syncthreads();
    }
}

template <int NB, bool COMBINE, bool XOUT, bool NORM, bool ROUTER>
__device__ __forceinline__ void rows_phase(const float* xl, const float* xc, int nrows, const bf16* y2, const float* modc  , const float* modl  ,
                                           float* xout, float* out_final, const float* nw, int shift_i, int scale_i, bf16* hout,
                                           const float* wg, const float* bg, const float* we, const float* be, float* route_w, int* cnt, int* list, int cap,
                                           LAS unsigned char* lds) {
    constexpr int TL = NB * SEQ;
    const int tid = otid(), lane = tid & 63, wave = tid >> 6;
    LAS float* wt = (LAS float*)lds;
    LAS int* lcnt = (LAS int*)(lds + 36 * 1024 * 4); LAS int* lbase = lcnt + 32; LAS int* rinfo = lcnt + 64;
    if (ROUTER) {
        if (tid < 32) lcnt[tid] = 0;
        for (int i = tid; i < 4 * 1024; i += NTHR) wt[(i & 3) * 1024 + (i >> 2)] = wg[i];
        for (int i = tid; i < 32 * 1024; i += NTHR) wt[(4 + (i & 31)) * 1024 + (i >> 5)] = we[i];
        __syncthreads();
    }
    int lrow = wave;
    for (int row = blockIdx.x * NWAVE + wave; row < nrows; row += gridDim.x * NWAVE, lrow += NWAVE) {
        const float* src = row < TL ? xl + (size_t)row * D : xc + (size_t)(row - TL) * D;
        const float* mv = modl + (size_t)mod_row<NB>(row) * 6144;
        const float* mvc = modc + (size_t)mod_row<NB>(row) * 6144;
        f32x4 v[4];
#pragma unroll
        for (int i = 0; i < 4; ++i) v[i] = *(const f32x4*)(src + lane * 4 + 256 * i);
        if (COMBINE) {
#pragma unroll
            for (int i = 0; i < 4; ++i) { const int c = lane * 4 + 256 * i;
                const u32x2 ya = *(const u32x2*)(y2 + (size_t)(2 * row) * D + c), yb = *(const u32x2*)(y2 + (size_t)(2 * row + 1) * D + c);
                const f32x4 m5 = *(const f32x4*)(mvc + 5 * 1024 + c);
                v[i][0] += m5[0] * (bflo(ya[0]) + bflo(yb[0])); v[i][1] += m5[1] * (bfhi(ya[0]) + bfhi(yb[0]));
                v[i][2] += m5[2] * (bflo(ya[1]) + bflo(yb[1])); v[i][3] += m5[3] * (bfhi(ya[1]) + bfhi(yb[1])); }
            if (XOUT) {
#pragma unroll
                for (int i = 0; i < 4; ++i) *(f32x4*)(xout + (size_t)row * D + lane * 4 + 256 * i) = v[i]; }
            if (out_final) {
#pragma unroll
                for (int i = 0; i < 4; ++i) *(f32x4*)(out_final + (size_t)row * D + lane * 4 + 256 * i) = v[i]; }
        }
        if (NORM) {
            float ss = 0.f;
#pragma unroll
            for (int i = 0; i < 4; ++i) ss += v[i][0] * v[i][0] + v[i][1] * v[i][1] + v[i][2] * v[i][2] + v[i][3] * v[i][3];
            ss = wave_sum(ss);
            const float rs = rsqrtf(ss * (1.f / D) + 1e-6f);
            f32x4 hv[4];
#pragma unroll
            for (int i = 0; i < 4; ++i) { const int c = lane * 4 + 256 * i;
                const f32x4 w4 = *(const f32x4*)(nw + c), sc4 = *(const f32x4*)(mv + scale_i * 1024 + c), sh4 = *(const f32x4*)(mv + shift_i * 1024 + c);
#pragma unroll
                for (int j = 0; j < 4; ++j) hv[i][j] = v[i][j] * rs * w4[j] * (1.f + sc4[j]) + sh4[j];
                u32x2 o; o[0] = pk2(hv[i][0], hv[i][1]); o[1] = pk2(hv[i][2], hv[i][3]);
                *(u32x2*)(hout + (size_t)row * D + c) = o; }
            if (ROUTER) {
                float lg[4];
#pragma unroll
                for (int j = 0; j < 4; ++j) { float a = 0.f;
#pragma unroll
                    for (int i = 0; i < 4; ++i) { const f32x4 w4 = *(const LAS f32x4*)(wt + j * 1024 + lane * 4 + 256 * i);
                        a += hv[i][0] * w4[0] + hv[i][1] * w4[1] + hv[i][2] * w4[2] + hv[i][3] * w4[3]; }
                    lg[j] = wave_sum(a) + bg[j]; }
                int gi = 0; float gm = lg[0];
#pragma unroll
                for (int j = 1; j < 4; ++j) if (lg[j] > gm) { gm = lg[j]; gi = j; }
                float gs = 0.f;
#pragma unroll
                for (int j = 0; j < 4; ++j) gs += __expf(lg[j] - gm);
                const float gprob = 1.f / gs;
                float le[8];
#pragma unroll
                for (int j = 0; j < 8; ++j) { float a = 0.f; const LAS float* wr = wt + (4 + gi * 8 + j) * 1024 + lane * 4;
#pragma unroll
                    for (int i = 0; i < 4; ++i) { const f32x4 w4 = *(const LAS f32x4*)(wr + 256 * i);
                        a += hv[i][0] * w4[0] + hv[i][1] * w4[1] + hv[i][2] * w4[2] + hv[i][3] * w4[3]; }
                    le[j] = wave_sum(a) + be[gi * 8 + j]; }
                int e0 = 0; float m0 = le[0];
#pragma unroll
                for (int j = 1; j < 8; ++j) if (le[j] > m0) { m0 = le[j]; e0 = j; }
                int e1 = 0; float m1 = -3.0e38f;
#pragma unroll
                for (int j = 0; j < 8; ++j) if (j != e0 && le[j] > m1) { m1 = le[j]; e1 = j; }
                const float p1 = __expf(m1 - m0);
                if (lane == 0) {
                    const int ge0 = gi * 8 + e0, ge1 = gi * 8 + e1;
                    route_w[2 * row] = gprob / (1.f + p1); route_w[2 * row + 1] = gprob * p1 / (1.f + p1);
                    const int s0 = atomicAdd((int*)&lcnt[ge0], 1), s1 = atomicAdd((int*)&lcnt[ge1], 1);
                    rinfo[2 * lrow] = (ge0 << 16) | s0; rinfo[2 * lrow + 1] = (ge1 << 16) | s1;
                }
            }
        }
    }
    if (ROUTER) {
        __syncthreads();
        if (tid < 32) { const int c = lcnt[tid]; lbase[tid] = c ? atomicAdd(&cnt[tid * 64], c) : 0; }
        __syncthreads();
        int lrow = wave;
        for (int row = blockIdx.x * NWAVE + wave; row < nrows; row += gridDim.x * NWAVE, lrow += NWAVE) {
            if (lane < 2) { const int ri = rinfo[2 * lrow + lane], ge = ri >> 16, sl = ri & 0xffff; list[(size_t)ge * cap + lbase[ge] + sl] = 2 * row + lane; }
        }
        __syncthreads();
    }
}

__device__ __forceinline__ int xcd_unit(int r) { const int G = gridDim.x, bx = blockIdx.x; return G == 256 ? ((r * 8 + (bx & 7)) * 32 + (bx >> 3)) : r * G + bx; }
__device__ __forceinline__ void unit_tile(int u, int MT, int NT, int& mt, int& nt) {
    if ((MT & 3) == 0) { const int band = u / (4 * NT), w = u - band * 4 * NT; nt = w >> 2; mt = band * 4 + (w & 3); }
    else { mt = u / NT; nt = u - mt * NT; }
}
constexpr int GEMM_STAGE = 256 * 128 + 128 * 128;
constexpr int GEMM_LDS = 3 * GEMM_STAGE;
__device__ __forceinline__ int sw_off(int row, int chunk) { return row * 128 + ((chunk ^ ((row >> 1) & 7)) << 4); }

struct BRowId { __device__ __forceinline__ int operator()(int r) const { return r; } };
template <int VAR = 0, class Epi, class BRow = BRowId>
__device__ __forceinline__ void gemm_tile(const bf16* const (&arow)[4], const bf16* bt  , int ldb, int K, LAS unsigned char* lds, Epi&& epi, BRow brow = BRow()) {
    const int tid = otid(), lane = tid & 63, wave = tid >> 6, wm = wave >> 1, wn = wave & 1;
    const int r8 = tid >> 3;
    const int schunk = (lane & 7) ^ ((r8 >> 1) & 7);
    const bf16* ga[4]; const bf16* gb[2];
#pragma unroll
    for (int i = 0; i < 4; ++i) ga[i] = arow[i] + schunk * 8;
#pragma unroll
    for (int i = 0; i < 2; ++i) gb[i] = bt + (size_t)brow(r8 + 64 * i) * ldb + schunk * 8;
    f32x16 acc[2][2];
#pragma unroll
    for (int mi = 0; mi < 2; ++mi)
#pragma unroll
        for (int ni = 0; ni < 2; ++ni)
#pragma unroll
            for (int r = 0; r < 16; ++r) acc[mi][ni][r] = 0.f;
#define G_DMA(t, st) do { LAS unsigned char* sa_ = lds + (st) * GEMM_STAGE + wave * 1024 + lane * 16; \
    _Pragma("unroll") for (int i = 0; i < 4; ++i) __builtin_amdgcn_global_load_lds((const unsigned*)(ga[i] + (t) * 64), (LAS unsigned*)(sa_ + i * 8192), 16, 0, 0); \
    _Pragma("unroll") for (int i = 0; i < 2; ++i) __builtin_amdgcn_global_load_lds((const unsigned*)(gb[i] + (t) * 64), (LAS unsigned*)(sa_ + 256 * 128 + i * 8192), 16, 0, 0); } while (0)
    const int KT = K >> 6;
    G_DMA(0, 0);
    G_DMA(1, 1);
    asm volatile("s_waitcnt vmcnt(6)" ::: "memory");
    __builtin_amdgcn_s_barrier();
    asm volatile("" ::: "memory");
    int st = 0;
    for (int kt = 0; kt < KT; ++kt) {
        const int st2 = st >= 1 ? st - 1 : 2;
        if (VAR != 2) { if (kt + 2 < KT) G_DMA(kt + 2, st2); }
        const LAS unsigned char* sa = lds + st * GEMM_STAGE; const LAS unsigned char* sb = sa + 256 * 128;
        bf16x8 af[2], bfr[2];
        if (VAR == 1) {
#pragma unroll
            for (int mi = 0; mi < 2; ++mi) af[mi] = *(const LAS bf16x8*)(sa + sw_off(wm * 64 + mi * 32 + (lane & 31), (lane >> 5)));
#pragma unroll
            for (int ni = 0; ni < 2; ++ni) bfr[ni] = *(const LAS bf16x8*)(sb + sw_off(wn * 64 + ni * 32 + (lane & 31), (lane >> 5)));
        }
#pragma unroll
        for (int kk = 0; kk < 4; ++kk) {
            if (VAR != 1) {
#pragma unroll
            for (int mi = 0; mi < 2; ++mi) af[mi] = *(const LAS bf16x8*)(sa + sw_off(wm * 64 + mi * 32 + (lane & 31), 2 * kk + (lane >> 5)));
#pragma unroll
            for (int ni = 0; ni < 2; ++ni) bfr[ni] = *(const LAS bf16x8*)(sb + sw_off(wn * 64 + ni * 32 + (lane & 31), 2 * kk + (lane >> 5)));
            }
            if (VAR == 3) {
#pragma unroll
                for (int mi = 0; mi < 2; ++mi) acc[mi][0][kk] += __builtin_bit_cast(f32x4, af[mi])[0] + __builtin_bit_cast(f32x4, bfr[mi])[1];
            } else {
#pragma unroll
            for (int mi = 0; mi < 2; ++mi)
#pragma unroll
                for (int ni = 0; ni < 2; ++ni) acc[mi][ni] = mfma32(bfr[ni], af[mi], acc[mi][ni]);
            }
        }
        if (kt + 2 < KT) asm volatile("s_waitcnt vmcnt(6)" ::: "memory"); else asm volatile("s_waitcnt vmcnt(0)" ::: "memory");
        __builtin_amdgcn_s_barrier();
        asm volatile("" ::: "memory");
        st = st == 2 ? 0 : st + 1;
    }
#undef G_DMA
    epi(acc, wm, wn, lane);
}

constexpr int CST_BF = 272, CST_BF64 = 144, CST_F32 = 528;
__device__ __forceinline__ void stage_bf16_128(const f32x16 (&acc)[2][2], LAS unsigned char* lds, int wm, int wn, int lane) {
#pragma unroll
    for (int mi = 0; mi < 2; ++mi) { LAS unsigned char* rp = lds + (wm * 64 + mi * 32 + (lane & 31)) * CST_BF + (wn * 64 + 4 * (lane >> 5)) * 2;
#pragma unroll
        for (int ni = 0; ni < 2; ++ni)
#pragma unroll
            for (int g = 0; g < 4; ++g) { u32x2 o; o[0] = pk2(acc[mi][ni][4 * g], acc[mi][ni][4 * g + 1]); o[1] = pk2(acc[mi][ni][4 * g + 2], acc[mi][ni][4 * g + 3]);
                *(LAS u32x2*)(rp + (ni * 32 + 8 * g) * 2) = o; } }
}
template <class RowPtr>
__device__ __forceinline__ void flush_bf16_128(const LAS unsigned char* lds, RowPtr&& rowptr) {
    const int t = otid();
#pragma unroll
    for (int it = 0; it < 8; ++it) { const int row = it * 32 + (t >> 4), piece = t & 15;
        const u32x4 v = *(const LAS u32x4*)(lds + row * CST_BF + piece * 16);
        bf16* dst = rowptr(row);
        if (dst) __builtin_nontemporal_store(v, (u32x4*)(dst + piece * 8)); }
}
template <class RowPtr>
__device__ __forceinline__ void flush_bf16_64(const LAS unsigned char* lds, RowPtr&& rowptr) {
    const int t = otid();
#pragma unroll
    for (int it = 0; it < 4; ++it) { const int row = it * 64 + (t >> 3), piece = t & 7;
        const u32x4 v = *(const LAS u32x4*)(lds + row * CST_BF64 + piece * 16);
        bf16* dst = rowptr(row);
        if (dst) __builtin_nontemporal_store(v, (u32x4*)(dst + piece * 8)); }
}
__device__ __forceinline__ void stage_f32_128(const f32x16 (&acc)[2][2], LAS unsigned char* lds, int wm, int wn, int lane) {
#pragma unroll
    for (int mi = 0; mi < 2; ++mi) { LAS unsigned char* rp = lds + (wm * 64 + mi * 32 + (lane & 31)) * CST_F32 + (wn * 64 + 4 * (lane >> 5)) * 4;
#pragma unroll
        for (int ni = 0; ni < 2; ++ni)
#pragma unroll
            for (int g = 0; g < 4; ++g) { f32x4 o; o[0] = acc[mi][ni][4 * g]; o[1] = acc[mi][ni][4 * g + 1]; o[2] = acc[mi][ni][4 * g + 2]; o[3] = acc[mi][ni][4 * g + 3];
                *(LAS f32x4*)(rp + (ni * 32 + 8 * g) * 4) = o; } }
}

template <int NB, int VAR = 0>
__device__ __forceinline__ void phase_inproj_v(const bf16* H, const bf16* Wt, bf16* PROJ, float* GATES, LAS unsigned char* lds, bool dostore = true) {
    constexpr int T = NB * (SEQ + CTXL), MT = T / 256, NT_ = NIN / 128;
    for (int r = 0; r * (int)gridDim.x < MT * NT_; ++r) {
        const int u = xcd_unit(r); if (u >= MT * NT_) continue;
        int mt, nt; unit_tile(u, MT, NT_, mt, nt);
        const bf16* arow[4];
#pragma unroll
        for (int i = 0; i < 4; ++i) arow[i] = H + (size_t)(mt * 256 + (otid() >> 3) + 64 * i) * D;
        gemm_tile<VAR>(arow, Wt + (size_t)nt * 128 * D, D, D, lds, [&](const f32x16 (&acc)[2][2], int wm, int wn, int lane) {
            if (!dostore) return;
            if (nt < NT_ - 1) stage_bf16_128(acc, lds, wm, wn, lane);
            else if (wn == 0) {
#pragma unroll
                for (int mi = 0; mi < 2; ++mi) { const int row = mt * 256 + wm * 64 + mi * 32 + (lane & 31);
#pragma unroll
                    for (int ni = 0; ni < 2; ++ni)
#pragma unroll
                        for (int g = 0; g < 4; ++g) { f32x4 o; o[0] = acc[mi][ni][4 * g]; o[1] = acc[mi][ni][4 * g + 1]; o[2] = acc[mi][ni][4 * g + 2]; o[3] = acc[mi][ni][4 * g + 3];
                            *(f32x4*)(GATES + (size_t)row * 64 + ni * 32 + 8 * g + 4 * (lane >> 5)) = o; } } }
        });
        if (dostore && nt < NT_ - 1) {
            __syncthreads();
            flush_bf16_128(lds, [&](int r) { return PROJ + (size_t)(mt * 256 + r) * PROJW + nt * 128; });
        }
        __syncthreads();
    }
}

template <int NB> __device__ __forceinline__ void phase_inproj(const bf16* H, const bf16* Wt, bf16* PROJ, float* GATES, LAS unsigned char* lds) { phase_inproj_v<NB, 0>(H, Wt, PROJ, GATES, lds, true); }

template <int NB>
__device__ __forceinline__ void phase_conv(const bf16* PROJ, const float* cw, const float* cb, bf16* XBC) {
    constexpr int TL = NB * SEQ, T = NB * (SEQ + CTXL);
    for (size_t it = (size_t)blockIdx.x * NTHR + otid(); it < (size_t)T * 192; it += (size_t)gridDim.x * NTHR) {
        const int row = (int)(it / 192), c0 = (int)(it % 192) * 8;
        int t, L;
        if (row < TL) { t = row % SEQ; L = SEQ; } else { t = (row - TL) % CTXL; L = CTXL; }
        const bf16* p = PROJ + (size_t)row * PROJW + PC_XBC + c0;
        const u32x4 cur = *(const u32x4*)p;
        u32x4 prv = {0u, 0u, 0u, 0u}, nxt = {0u, 0u, 0u, 0u};
        if (t > 0) prv = *(const u32x4*)(p - PROJW);
        if (t < L - 1) nxt = *(const u32x4*)(p + PROJW);
        float o[8];
#pragma unroll
        for (int j = 0; j < 4; ++j) {
            const int c = c0 + 2 * j;
            o[2 * j] = bflo(prv[j]) * cw[c] + bflo(cur[j]) * cw[1536 + c] + bflo(nxt[j]) * cw[3072 + c] + cb[c];
            o[2 * j + 1] = bfhi(prv[j]) * cw[c + 1] + bfhi(cur[j]) * cw[1536 + c + 1] + bfhi(nxt[j]) * cw[3072 + c + 1] + cb[c + 1];
        }
        u32x4 r; r[0] = pk2(siluf(o[0]), siluf(o[1])); r[1] = pk2(siluf(o[2]), siluf(o[3])); r[2] = pk2(siluf(o[4]), siluf(o[5])); r[3] = pk2(siluf(o[6]), siluf(o[7]));
        *(u32x4*)(XBC + (size_t)row * 1536 + c0) = r;
    }
}
}
namespace fx {
constexpr int RS_X = 144, RS_N = 272;

template <int NB> __device__ __forceinline__ int scan_row(int b, int d, int step) {
    if (step < CTXL) return NB * SEQ + b * CTXL + (d ? CTXL - 1 - step : step);
    step -= CTXL; return b * SEQ + (d ? SEQ - 1 - step : step);
}
__device__ __forceinline__ bf16x8 scale_frag(bf16x8 v, f32x4 w0, f32x4 w1) {
    const u32x4 u = __builtin_bit_cast(u32x4, v);
    u32x4 o;
    o[0] = pk2(bflo(u[0]) * w0[0], bfhi(u[0]) * w0[1]); o[1] = pk2(bflo(u[1]) * w0[2], bfhi(u[1]) * w0[3]);
    o[2] = pk2(bflo(u[2]) * w1[0], bfhi(u[2]) * w1[1]); o[3] = pk2(bflo(u[3]) * w1[2], bfhi(u[3]) * w1[3]);
    return __builtin_bit_cast(bf16x8, o);
}

__device__ __forceinline__ unsigned tr_addr(const LAS unsigned char* T, int RS, int k0, int c0, int lane) {
    const int h = lane >> 5, blk = (lane >> 4) & 1, q = (lane & 15) >> 2, p = lane & 3;
    return (unsigned)(size_t)(T + (k0 + 8 * h + q) * RS + (c0 + 16 * blk + 4 * p) * 2);
}
__device__ __forceinline__ void tr8(unsigned a0, unsigned a1, unsigned a2, unsigned a3, unsigned a4, unsigned a5, unsigned a6, unsigned a7,
                                    bf16x4& v0, bf16x4& v1, bf16x4& v2, bf16x4& v3, bf16x4& v4, bf16x4& v5, bf16x4& v6, bf16x4& v7) {
    asm volatile("ds_read_b64_tr_b16 %0, %8\n\tds_read_b64_tr_b16 %1, %9\n\tds_read_b64_tr_b16 %2, %10\n\tds_read_b64_tr_b16 %3, %11\n\t"
                 "ds_read_b64_tr_b16 %4, %12\n\tds_read_b64_tr_b16 %5, %13\n\tds_read_b64_tr_b16 %6, %14\n\tds_read_b64_tr_b16 %7, %15\n\ts_waitcnt lgkmcnt(0)"
                 : "=&v"(v0), "=&v"(v1), "=&v"(v2), "=&v"(v3), "=&v"(v4), "=&v"(v5), "=&v"(v6), "=&v"(v7)
                 : "v"(a0), "v"(a1), "v"(a2), "v"(a3), "v"(a4), "v"(a5), "v"(a6), "v"(a7) : "memory");
}
__device__ __forceinline__ void tr4(unsigned a0, unsigned a1, unsigned a2, unsigned a3, bf16x4& v0, bf16x4& v1, bf16x4& v2, bf16x4& v3) {
    asm volatile("ds_read_b64_tr_b16 %0, %4\n\tds_read_b64_tr_b16 %1, %5\n\tds_read_b64_tr_b16 %2, %6\n\tds_read_b64_tr_b16 %3, %7\n\ts_waitcnt lgkmcnt(0)"
                 : "=&v"(v0), "=&v"(v1), "=&v"(v2), "=&v"(v3) : "v"(a0), "v"(a1), "v"(a2), "v"(a3) : "memory");
}
__device__ __forceinline__ bf16x8 tr_join(bf16x4 v0, bf16x4 v1) { bf16x8 r; r[0] = v0[0]; r[1] = v0[1]; r[2] = v0[2]; r[3] = v0[3]; r[4] = v1[0]; r[5] = v1[1]; r[6] = v1[2]; r[7] = v1[3]; return r; }
__device__ __forceinline__ void tr_col4(const LAS unsigned char* T, int RS, int k0, int c0, int lane, bf16x4 (&t)[4][2]) {
    const unsigned a = tr_addr(T, RS, k0, c0, lane);
    tr8(a, a + 4 * RS, a + 16 * RS, a + 20 * RS, a + 32 * RS, a + 36 * RS, a + 48 * RS, a + 52 * RS, t[0][0], t[0][1], t[1][0], t[1][1], t[2][0], t[2][1], t[3][0], t[3][1]);
}
__device__ __forceinline__ void tr_col2(const LAS unsigned char* T, int RS, int k0, int c0, int lane, bf16x4 (&t)[2][2]) {
    const unsigned a = tr_addr(T, RS, k0, c0, lane);
    tr4(a, a + 4 * RS, a + 16 * RS, a + 20 * RS, t[0][0], t[0][1], t[1][0], t[1][1]);
}

constexpr int NSTEP = SEQ + CTXL;
template <int NB> struct ScanTab {
    static constexpr size_t SSD_TAB = 0, ML_TAB = SSD_TAB + (size_t)NB * 32 * NSTEP * 16, SSD_DEC = ML_TAB + (size_t)NB * 8 * NSTEP * 32,
                            ML_CH = SSD_DEC + (size_t)NB * 32 * 34 * 4, END = ML_CH + (size_t)NB * 8 * 34 * 8;
};
template <int NB>
__device__ __forceinline__ void phase_tables(const In& in, const float* GATES, unsigned char* tab, LAS unsigned char* lds) {
    typedef ScanTab<NB> ST;
    const int tid = otid(), lane = tid & 63, wave = tid >> 6;
    LAS float* l_g = (LAS float*)lds; LAS float* l_ml = l_g + 68; LAS float* l_mr = l_g + 136;
    for (int job = blockIdx.x; job < NB * 40; job += gridDim.x) {
        if (job < NB * 32) {
            const int b = job >> 5, d = (job >> 4) & 1, h = job & 15;
            const float a = -__expf(in.ssd_a_log[d * 16 + h]), dtb = in.ssd_dt_bias[d * 16 + h];
            f32x4* T4 = (f32x4*)(tab + ST::SSD_TAB) + (size_t)job * NSTEP; float* DEC = (float*)(tab + ST::SSD_DEC) + job * 34;
            for (int ch = wave; ch < 34; ch += NWAVE) {
                const float dt0 = softplusf(GATES[(size_t)scan_row<NB>(b, d, ch * 128 + lane) * 64 + d * 16 + h] + dtb);
                const float dt1 = softplusf(GATES[(size_t)scan_row<NB>(b, d, ch * 128 + 64 + lane) * 64 + d * 16 + h] + dtb);
                float v0 = dt0 * a, v1 = dt1 * a;
#pragma unroll
                for (int o = 1; o < 64; o <<= 1) { const float t0 = __shfl_up(v0, o), t1 = __shfl_up(v1, o); if (lane >= o) { v0 += t0; v1 += t1; } }
                v1 += __shfl(v0, 63);
                const float tot = __shfl(v1, 63);
                T4[ch * 128 + lane] = (f32x4){v0, dt0, dt0 * __expf(tot - v0), __expf(v0)};
                T4[ch * 128 + 64 + lane] = (f32x4){v1, dt1, dt1 * __expf(tot - v1), __expf(v1)};
                if (lane == 0) DEC[ch] = __expf(tot);
            }
        } else {
            const int j2 = job - NB * 32, b = j2 >> 3, d = (j2 >> 2) & 1, hh = j2 & 3;
            const float ib = in.ml_i_bias[d * 4 + hh], fb = in.ml_f_bias[d * 4 + hh];
            f32x4* T4 = (f32x4*)(tab + ST::ML_TAB) + (size_t)j2 * NSTEP * 2; float* CH = (float*)(tab + ST::ML_CH) + j2 * 34 * 2;
            float s_li[5][2], s_bc[5][2], s_mi[5][2], s_we[5][2];
            __syncthreads();
#pragma unroll
            for (int k = 0; k < 5; ++k) { const int ch = wave + 8 * k;
#pragma unroll
                for (int q = 0; q < 2; ++q) { s_li[k][q] = 0.f; s_bc[k][q] = 0.f; s_mi[k][q] = 0.f; s_we[k][q] = 0.f; }
                if (ch < 34) {
                    const float* g0 = GATES + (size_t)scan_row<NB>(b, d, ch * 128 + lane) * 64; const float* g1 = GATES + (size_t)scan_row<NB>(b, d, ch * 128 + 64 + lane) * 64;
                    const float li0 = g0[32 + d * 4 + hh] + ib, li1 = g1[32 + d * 4 + hh] + ib;
                    float bc0 = logsigf(g0[40 + d * 4 + hh] + fb), bc1 = logsigf(g1[40 + d * 4 + hh] + fb);
#pragma unroll
                    for (int o = 1; o < 64; o <<= 1) { const float t0 = __shfl_up(bc0, o), t1 = __shfl_up(bc1, o); if (lane >= o) { bc0 += t0; bc1 += t1; } }
                    bc1 += __shfl(bc0, 63);
                    float pm0 = li0 - bc0, pm1 = li1 - bc1;
#pragma unroll
                    for (int o = 1; o < 64; o <<= 1) { const float t0 = __shfl_up(pm0, o), t1 = __shfl_up(pm1, o); if (lane >= o) { pm0 = fmaxf(pm0, t0); pm1 = fmaxf(pm1, t1); } }
                    pm1 = fmaxf(pm1, __shfl(pm0, 63));
                    const float gtot = __shfl(bc1, 63);
                    const float ae0 = gtot - bc0 + li0, ae1 = gtot - bc1 + li1;
                    const float m_loc = wave_max(fmaxf(ae0, ae1));
                    s_li[k][0] = li0; s_li[k][1] = li1; s_bc[k][0] = bc0; s_bc[k][1] = bc1; s_mi[k][0] = bc0 + pm0; s_mi[k][1] = bc1 + pm1;
                    s_we[k][0] = __expf(ae0 - m_loc); s_we[k][1] = __expf(ae1 - m_loc);
                    if (lane == 0) { l_g[ch] = gtot; l_ml[ch] = m_loc; }
                } }
            __syncthreads();
            if (tid == 0) { float m = 0.f;
                for (int ch = 0; ch < 34; ++ch) { const float g = l_g[ch], ml = l_ml[ch], mn = fmaxf(g + m, ml);
                    l_mr[ch] = m; CH[2 * ch] = __expf(g + m - mn); CH[2 * ch + 1] = __expf(ml - mn); m = mn; } }
            __syncthreads();
#pragma unroll
            for (int k = 0; k < 5; ++k) { const int ch = wave + 8 * k;
                if (ch < 34) {
#pragma unroll
                    for (int q = 0; q < 2; ++q) {
                        const float m_inter = s_bc[k][q] + l_mr[ch], mt = fmaxf(s_mi[k][q], m_inter);
                        T4[(size_t)(ch * 128 + 64 * q + lane) * 2] = (f32x4){s_bc[k][q] - mt, s_li[k][q] - s_bc[k][q], __expf(m_inter - mt), s_we[k][q]};
                        T4[(size_t)(ch * 128 + 64 * q + lane) * 2 + 1] = (f32x4){__expf(-mt), 0.f, 0.f, 0.f}; }
                } }
        }
    }
}

template <int NB>
__device__ __forceinline__ void ssd_item(const bf16* XBC, const unsigned char* tab, bf16* SCb, int b, int d, int h, LAS unsigned char* lds) {
    typedef ScanTab<NB> ST;
    const int tid = otid(), lane = tid & 63, wave = tid >> 6, g = h >> 3, combo = b * 32 + d * 16 + h;
    LAS unsigned char* Xs = lds; LAS unsigned char* Bs = lds + 18432; LAS unsigned char* Cs = lds + 53248;
    LAS unsigned char* Ss = lds + 88064; LAS unsigned char* Ms = lds + 105472;
    LAS float* acs = (LAS float*)(lds + 140288); LAS float* dtv = acs + 128; LAS float* wv = acs + 256; LAS float* eav = acs + 384;
    const f32x4* T4 = (const f32x4*)(tab + ST::SSD_TAB) + (size_t)combo * NSTEP; const float* DEC = (const float*)(tab + ST::SSD_DEC) + combo * 34;
    f32x16 st;
#pragma unroll
    for (int r = 0; r < 16; ++r) st[r] = 0.f;
    constexpr int NCH = (CTXL + SEQ) / 128;
    u32x4 rx[2], rb[4], rc[4]; f32x4 rt = {0.f, 0.f, 0.f, 0.f}; float rdec = 0.f;
#define SSD_LOAD(ch) do { \
    _Pragma("unroll") for (int i = 0; i < 2; ++i) { const int idx = tid + 512 * i, l = idx >> 3, c = idx & 7; \
        rx[i] = *(const u32x4*)(XBC + (size_t)scan_row<NB>(b, d, (ch) * 128 + l) * 1536 + h * 64 + c * 8); } \
    _Pragma("unroll") for (int i = 0; i < 4; ++i) { const int idx = tid + 512 * i, l = idx >> 4, c = idx & 15; \
        const bf16* rp = XBC + (size_t)scan_row<NB>(b, d, (ch) * 128 + l) * 1536 + 1024 + g * 128 + c * 8; \
        rb[i] = *(const u32x4*)rp; rc[i] = *(const u32x4*)(rp + 256); } \
    if (tid < 128) rt = T4[(ch) * 128 + tid]; \
    rdec = DEC[ch]; } while (0)
    SSD_LOAD(0);
    const int pbw = wave >> 2, nbw = wave & 3;
    for (int ch = 0; ch < NCH; ++ch) {
#pragma unroll
        for (int i = 0; i < 2; ++i) { const int idx = tid + 512 * i, l = idx >> 3, c = idx & 7; *(LAS u32x4*)(Xs + l * RS_X + c * 16) = rx[i]; }
#pragma unroll
        for (int i = 0; i < 4; ++i) { const int idx = tid + 512 * i, l = idx >> 4, c = idx & 15;
            *(LAS u32x4*)(Bs + l * RS_N + c * 16) = rb[i]; *(LAS u32x4*)(Cs + l * RS_N + c * 16) = rc[i]; }
        if (tid < 128) { acs[tid] = rt[0]; dtv[tid] = rt[1]; wv[tid] = rt[2]; eav[tid] = rt[3]; }
        const float dec = rdec;
        {
            const int pp = 32 * pbw + (lane & 31);
#pragma unroll
            for (int gq = 0; gq < 4; ++gq) { u32x2 o; o[0] = pk2(st[4 * gq], st[4 * gq + 1]); o[1] = pk2(st[4 * gq + 2], st[4 * gq + 3]);
                *(LAS u32x2*)(Ss + pp * RS_N + (32 * nbw + 8 * gq + 4 * (lane >> 5)) * 2) = o; }
        }
        __syncthreads();
        if (ch + 1 < NCH) SSD_LOAD(ch + 1);
        {
            const int lbA = wave >> 1, sbp = wave & 1;
            const int l = 32 * lbA + (lane & 31);
            const float al = acs[l];
#pragma unroll
            for (int q = 0; q < 2; ++q) { const int sb = 2 * sbp + q;
                if (sb <= lbA) {
                    f32x16 cb;
#pragma unroll
                    for (int r = 0; r < 16; ++r) cb[r] = 0.f;
#pragma unroll
                    for (int kk = 0; kk < 8; ++kk) cb = mfma32(frag_row(Bs, RS_N, 32 * sb, 16 * kk, lane), frag_row(Cs, RS_N, 32 * lbA, 16 * kk, lane), cb);
#pragma unroll
                    for (int gq = 0; gq < 4; ++gq) { const int s0 = 32 * sb + 8 * gq + 4 * (lane >> 5);
                        const f32x4 as4 = *(const LAS f32x4*)(acs + s0), dt4 = *(const LAS f32x4*)(dtv + s0);
                        float m[4];
#pragma unroll
                        for (int j = 0; j < 4; ++j) m[j] = (s0 + j <= l) ? cb[4 * gq + j] * __expf(fminf(al - as4[j], 0.f)) * dt4[j] : 0.f;
                        u32x2 o; o[0] = pk2(m[0], m[1]); o[1] = pk2(m[2], m[3]);
                        *(LAS u32x2*)(Ms + l * RS_N + s0 * 2) = o; } } }
        }
        {
#pragma unroll
            for (int r = 0; r < 16; ++r) st[r] *= dec;
#pragma unroll
            for (int kb = 0; kb < 2; ++kb) {
                bf16x4 tx[4][2], tb[4][2];
                tr_col4(Xs, RS_X, 64 * kb, 32 * pbw, lane, tx);
                tr_col4(Bs, RS_N, 64 * kb, 32 * nbw, lane, tb);
#pragma unroll
                for (int k4 = 0; k4 < 4; ++k4) {
                    const int l0 = 16 * (4 * kb + k4) + 8 * (lane >> 5);
                    const f32x4 w0 = *(const LAS f32x4*)(wv + l0), w1 = *(const LAS f32x4*)(wv + l0 + 4);
                    st = mfma32(tr_join(tb[k4][0], tb[k4][1]), scale_frag(tr_join(tx[k4][0], tx[k4][1]), w0, w1), st);
                }
            }
        }
        __syncthreads();
        {
            const int pb = wave >> 2, lb = wave & 3;
            f32x16 acc;
#pragma unroll
            for (int r = 0; r < 16; ++r) acc[r] = 0.f;
#pragma unroll
            for (int kk = 0; kk < 8; ++kk) acc = mfma32(frag_row(Ss, RS_N, 32 * pb, 16 * kk, lane), frag_row(Cs, RS_N, 32 * lb, 16 * kk, lane), acc);
            const int l = 32 * lb + (lane & 31);
            const float ea = eav[l];
#pragma unroll
            for (int r = 0; r < 16; ++r) acc[r] *= ea;
            for (int sb = 0; sb <= lb; ++sb) {
                bf16x4 t2[2][2];
                const bf16x8 m0 = frag_row(Ms, RS_N, 32 * lb, 32 * sb, lane), m1 = frag_row(Ms, RS_N, 32 * lb, 32 * sb + 16, lane);
                tr_col2(Xs, RS_X, 32 * sb, 32 * pb, lane, t2);
                acc = mfma32(tr_join(t2[0][0], t2[0][1]), m0, acc);
                acc = mfma32(tr_join(t2[1][0], t2[1][1]), m1, acc);
            }
            bf16* yp = SCb + (size_t)scan_row<NB>(b, d, ch * 128 + l) * 4096 + d * 1024 + h * 64 + 32 * pb + 4 * (lane >> 5);
#pragma unroll
            for (int gq = 0; gq < 4; ++gq) { u32x2 o; o[0] = pk2(acc[4 * gq], acc[4 * gq + 1]); o[1] = pk2(acc[4 * gq + 2], acc[4 * gq + 3]); *(u32x2*)(yp + 8 * gq) = o; }
        }
        __syncthreads();
    }
#undef SSD_LOAD
}

template <int NB>
__device__ __forceinline__ void mlstm_item(const bf16* PROJ, const unsigned char* tab, bf16* SCb, int b, int d, int hh, int ev, LAS unsigned char* lds) {
    typedef ScanTab<NB> ST;
    const int tid = otid(), lane = tid & 63, wave = tid >> 6, combo = b * 8 + d * 4 + hh;
    LAS unsigned char* Qs = lds; LAS unsigned char* Ks = lds + 34816; LAS unsigned char* Vs = lds + 69632;
    LAS unsigned char* Ct = lds + 88064; LAS unsigned char* Sm = lds + 105472;
    LAS float* tb = (LAS float*)(lds + 140288);
    LAS float* t_u = tb, *t_v = tb + 128, *t_wi = tb + 256, *t_we = tb + 384, *t_em = tb + 512, *t_qn = tb + 640, *t_n = tb + 768, *t_nc = tb + 896, *t_rs = tb + 1024  ;
    const f32x4* T4 = (const f32x4*)(tab + ST::ML_TAB) + (size_t)combo * NSTEP * 2; const float* CH = (const float*)(tab + ST::ML_CH) + combo * 34 * 2;
    const float kscale = 0.08838834764831845f;
    f32x16 st;
#pragma unroll
    for (int r = 0; r < 16; ++r) st[r] = 0.f;
    if (tid < 128) t_n[tid] = 0.f;
    constexpr int NCH = (CTXL + SEQ) / 128;
    const int kbw = wave & 3, ebw = wave >> 2;
    u32x4 rq[4], rk[4], rv[2]; f32x4 rt = {0.f, 0.f, 0.f, 0.f}; float ras = 0.f, rbb = 0.f;
#define ML_LOAD(ch) do { \
    _Pragma("unroll") for (int i = 0; i < 4; ++i) { const int idx = tid + 512 * i, l = idx >> 4, c = idx & 15; \
        const bf16* rp = PROJ + (size_t)scan_row<NB>(b, d, (ch) * 128 + l) * PROJW + hh * 128 + c * 8; \
        rq[i] = *(const u32x4*)(rp + PC_Q); rk[i] = *(const u32x4*)(rp + PC_K); } \
    _Pragma("unroll") for (int i = 0; i < 2; ++i) { const int idx = tid + 512 * i, l = idx >> 3, c = idx & 7; \
        rv[i] = *(const u32x4*)(PROJ + (size_t)scan_row<NB>(b, d, (ch) * 128 + l) * PROJW + PC_V + hh * 256 + ev * 64 + c * 8); } \
    if (tid < 256) rt = T4[(size_t)(ch) * 256 + tid]; \
    ras = CH[2 * (ch)]; rbb = CH[2 * (ch) + 1]; } while (0)
    ML_LOAD(0);
    for (int ch = 0; ch < NCH; ++ch) {
#pragma unroll
        for (int i = 0; i < 4; ++i) { const int idx = tid + 512 * i, l = idx >> 4, c = idx & 15;
            *(LAS u32x4*)(Qs + l * RS_N + c * 16) = rq[i]; *(LAS u32x4*)(Ks + l * RS_N + c * 16) = rk[i]; }
#pragma unroll
        for (int i = 0; i < 2; ++i) { const int idx = tid + 512 * i, l = idx >> 3, c = idx & 7; *(LAS u32x4*)(Vs + l * RS_X + c * 16) = rv[i]; }
        if (tid < 256) { const int l = tid >> 1; if (tid & 1) t_em[l] = rt[0]; else { t_u[l] = rt[0]; t_v[l] = rt[1]; t_wi[l] = rt[2]; t_we[l] = rt[3]; } }
        const float a_s = ras, bbs = rbb;
        {
            const int ee = 32 * ebw + (lane & 31);
#pragma unroll
            for (int gq = 0; gq < 4; ++gq) { u32x2 o; o[0] = pk2(st[4 * gq], st[4 * gq + 1]); o[1] = pk2(st[4 * gq + 2], st[4 * gq + 3]);
                *(LAS u32x2*)(Ct + ee * RS_N + (32 * kbw + 8 * gq + 4 * (lane >> 5)) * 2) = o; }
        }
        __syncthreads();
        if (ch + 1 < NCH) ML_LOAD(ch + 1);
        {
            const int lbA = wave >> 1, sbp = wave & 1;
            const int l = 32 * lbA + (lane & 31);
            const float ul = t_u[l];
#pragma unroll
            for (int q = 0; q < 2; ++q) { const int sb = 2 * sbp + q;
                if (sb <= lbA) {
                    f32x16 cb;
#pragma unroll
                    for (int r = 0; r < 16; ++r) cb[r] = 0.f;
#pragma unroll
                    for (int kk = 0; kk < 8; ++kk) cb = mfma32(frag_row(Ks, RS_N, 32 * sb, 16 * kk, lane), frag_row(Qs, RS_N, 32 * lbA, 16 * kk, lane), cb);
                    float rsum = 0.f;
#pragma unroll
                    for (int gq = 0; gq < 4; ++gq) { const int s0 = 32 * sb + 8 * gq + 4 * (lane >> 5);
                        const f32x4 v4 = *(const LAS f32x4*)(t_v + s0);
                        float m[4];
#pragma unroll
                        for (int j = 0; j < 4; ++j) { m[j] = (s0 + j <= l) ? cb[4 * gq + j] * kscale * __expf(fminf(ul + v4[j], 0.f)) : 0.f; rsum += m[j]; }
                        u32x2 o; o[0] = pk2(m[0], m[1]); o[1] = pk2(m[2], m[3]);
                        *(LAS u32x2*)(Sm + l * RS_N + s0 * 2) = o; }
                    rsum += __shfl_xor(rsum, 32);
                    if (lane < 32) t_rs[sb * 128 + l] = rsum;
                } }
            if (wave == 1 || wave == 3) {
                const int lq = (wave == 1 ? 0 : 64) + lane;
                float qn = 0.f;
#pragma unroll 4
                for (int c = 0; c < 16; ++c) { const u32x4 qv = *(const LAS u32x4*)(Qs + lq * RS_N + c * 16);
                    const f32x4 n0 = *(const LAS f32x4*)(t_n + c * 8), n1 = *(const LAS f32x4*)(t_n + c * 8 + 4);
                    qn += bflo(qv[0]) * n0[0] + bfhi(qv[0]) * n0[1] + bflo(qv[1]) * n0[2] + bfhi(qv[1]) * n0[3]
                        + bflo(qv[2]) * n1[0] + bfhi(qv[2]) * n1[1] + bflo(qv[3]) * n1[2] + bfhi(qv[3]) * n1[3]; }
                t_qn[lq] = qn;
            }
        }
        {
#pragma unroll
            for (int r = 0; r < 16; ++r) st[r] *= a_s;
            const float f = bbs * kscale;
            f32x16 nacc;
#pragma unroll
            for (int r = 0; r < 16; ++r) nacc[r] = 0.f;
            bf16x8 ones;
#pragma unroll
            for (int j = 0; j < 8; ++j) ones[j] = (short)0x3f80;
#pragma unroll
            for (int kb2 = 0; kb2 < 2; ++kb2) {
                bf16x4 tk[4][2], tv[4][2];
                tr_col4(Ks, RS_N, 64 * kb2, 32 * kbw, lane, tk);
                tr_col4(Vs, RS_X, 64 * kb2, 32 * ebw, lane, tv);
#pragma unroll
                for (int k4 = 0; k4 < 4; ++k4) {
                    const int l0 = 16 * (4 * kb2 + k4) + 8 * (lane >> 5);
                    f32x4 w0 = *(const LAS f32x4*)(t_we + l0), w1 = *(const LAS f32x4*)(t_we + l0 + 4);
#pragma unroll
                    for (int j = 0; j < 4; ++j) { w0[j] *= f; w1[j] *= f; }
                    const bf16x8 ka = scale_frag(tr_join(tk[k4][0], tk[k4][1]), w0, w1);
                    st = mfma32(ka, tr_join(tv[k4][0], tv[k4][1]), st);
                    if (ebw == 0) nacc = mfma32(ka, ones, nacc);
                }
            }
            if (ebw == 0 && (lane & 31) == 0) {
#pragma unroll
                for (int gq = 0; gq < 4; ++gq)
#pragma unroll
                    for (int j = 0; j < 4; ++j) t_nc[32 * kbw + 8 * gq + 4 * (lane >> 5) + j] = nacc[4 * gq + j];
            }
        }
        __syncthreads();
        if (tid < 128) t_n[tid] = a_s * t_n[tid] + t_nc[tid];
        {
            const int eb = wave >> 2, lb = wave & 3;
            f32x16 acc;
#pragma unroll
            for (int r = 0; r < 16; ++r) acc[r] = 0.f;
#pragma unroll
            for (int kk = 0; kk < 8; ++kk) acc = mfma32(frag_row(Ct, RS_N, 32 * eb, 16 * kk, lane), frag_row(Qs, RS_N, 32 * lb, 16 * kk, lane), acc);
            const int l = 32 * lb + (lane & 31);
            const float wi = t_wi[l];
#pragma unroll
            for (int r = 0; r < 16; ++r) acc[r] *= wi;
            float rsum = 0.f;
            for (int sb = 0; sb <= lb; ++sb) {
                bf16x4 t2[2][2];
                const bf16x8 m0 = frag_row(Sm, RS_N, 32 * lb, 32 * sb, lane), m1 = frag_row(Sm, RS_N, 32 * lb, 32 * sb + 16, lane);
                rsum += t_rs[sb * 128 + l];
                tr_col2(Vs, RS_X, 32 * sb, 32 * eb, lane, t2);
                acc = mfma32(tr_join(t2[0][0], t2[0][1]), m0, acc);
                acc = mfma32(tr_join(t2[1][0], t2[1][1]), m1, acc);
            }
            float den = rsum + t_qn[l] * wi;
            den = fmaxf(fabsf(den), t_em[l]);
            const float inv = 1.f / den;
            bf16* hp = SCb + (size_t)scan_row<NB>(b, d, ch * 128 + l) * 4096 + 2048 + d * 1024 + hh * 256 + ev * 64 + 32 * eb + 4 * (lane >> 5);
#pragma unroll
            for (int gq = 0; gq < 4; ++gq) { u32x2 o; o[0] = pk2(acc[4 * gq] * inv, acc[4 * gq + 1] * inv); o[1] = pk2(acc[4 * gq + 2] * inv, acc[4 * gq + 3] * inv); *(u32x2*)(hp + 8 * gq) = o; }
        }
        __syncthreads();
    }
#undef ML_LOAD
}

template <int NB>
__device__ __forceinline__ void phase_scan(const bf16* PROJ, const unsigned char* tab, const bf16* XBC, bf16* SCb, LAS unsigned char* lds, int mode = 3) {
    const int G = gridDim.x, bi = blockIdx.x;
    if (NB == 4 && G == 256) {
        const int x = bi & 7, y = bi >> 3;
        if (y < 16) { if (mode & 1) { const int q = x + 8 * (y >> 3), hh = y & 7; ssd_item<NB>(XBC, tab, SCb, q >> 2, (q >> 1) & 1, (q & 1) * 8 + hh, lds); } }
        else { if (mode & 2) { const int y2 = y - 16, c = x + 8 * (y2 >> 2), ev = y2 & 3; mlstm_item<NB>(PROJ, tab, SCb, c >> 3, (c >> 2) & 1, c & 3, ev, lds); } }
        return;
    }
    if (mode & 1) for (int item = bi; item < NB * 32; item += G) { const int b = item / 32, d = (item >> 4) & 1, h = item & 15;
        ssd_item<NB>(XBC, tab, SCb, b, d, h, lds); }
    const int v = (bi + G - (NB * 32) % G) % G;
    if (mode & 2) for (int it = v; it < NB * 32; it += G) { const int b = it / 32, d = (it >> 4) & 1, hh = (it >> 2) & 3, ev = it & 3;
        mlstm_item<NB>(PROJ, tab, SCb, b, d, hh, ev, lds); }
}

template <int NB>
__device__ __forceinline__ void phase_mixer_out(const In& in, const bf16* PROJ, const bf16* XBC, bf16* SCb, bf16* scratch_out = nullptr) {
    constexpr int T = NB * (SEQ + CTXL);
    const int lane = otid() & 63, wave = otid() >> 6;
    for (int row = blockIdx.x * NWAVE + wave; row < T; row += gridDim.x * NWAVE) {
        bf16* sc = SCb + (size_t)row * 4096;
        const bf16* pr = PROJ + (size_t)row * PROJW;
        float yv[16], hv[16], ss = 0.f, hs[2] = {0.f, 0.f};
#pragma unroll
        for (int i = 0; i < 2; ++i) { const int c = lane * 8 + 512 * i;
            const u32x4 y0 = *(const u32x4*)(sc + c), y1 = *(const u32x4*)(sc + 1024 + c), h0 = *(const u32x4*)(sc + 2048 + c), h1 = *(const u32x4*)(sc + 3072 + c);
            const u32x4 xs = *(const u32x4*)(XBC + (size_t)row * 1536 + c), z = *(const u32x4*)(pr + PC_Z + c);
            const float dk = in.ssd_d[c >> 6];
#pragma unroll
            for (int j = 0; j < 4; ++j) {
                float a0 = bflo(y0[j]) + bflo(y1[j]) + dk * bflo(xs[j]), a1 = bfhi(y0[j]) + bfhi(y1[j]) + dk * bfhi(xs[j]);
                a0 *= siluf(bflo(z[j])); a1 *= siluf(bfhi(z[j]));
                yv[8 * i + 2 * j] = a0; yv[8 * i + 2 * j + 1] = a1; ss += a0 * a0 + a1 * a1;
                const float b0 = bflo(h0[j]) + bflo(h1[j]), b1 = bfhi(h0[j]) + bfhi(h1[j]);
                hv[8 * i + 2 * j] = b0; hv[8 * i + 2 * j + 1] = b1; hs[i] += b0 * b0 + b1 * b1; } }
        ss = wave_sum(ss);
        const float rs = rsqrtf(ss * (1.f / 1024.f) + 1e-6f);
#pragma unroll
        for (int i = 0; i < 2; ++i) {
#pragma unroll
            for (int o = 16; o > 0; o >>= 1) hs[i] += __shfl_xor(hs[i], o);
            hs[i] = rsqrtf(hs[i] * (1.f / 256.f) + 1e-6f); }
        __builtin_amdgcn_s_waitcnt(0);
#pragma unroll
        for (int i = 0; i < 2; ++i) { const int c = lane * 8 + 512 * i;
            const u32x4 ov = *(const u32x4*)(pr + PC_O + c);
            u32x4 oy, oh;
#pragma unroll
            for (int j = 0; j < 4; ++j) {
                oy[j] = pk2(yv[8 * i + 2 * j] * rs * in.ssd_norm_w[c + 2 * j], yv[8 * i + 2 * j + 1] * rs * in.ssd_norm_w[c + 2 * j + 1]);
                oh[j] = pk2(hv[8 * i + 2 * j] * hs[i] * in.ml_norm_w[c + 2 * j] * sigmf(bflo(ov[j])), hv[8 * i + 2 * j + 1] * hs[i] * in.ml_norm_w[c + 2 * j + 1] * sigmf(bfhi(ov[j]))); }
            bf16* dstp = scratch_out ? scratch_out + (size_t)row * 2048 : sc;
            *(u32x4*)(dstp + c) = oy; *(u32x4*)(dstp + 1024 + c) = oh; }
    }
}

template <int NB, class Idle>
__device__ __forceinline__ void phase_outproj(const bf16* A, int lda, int K, const bf16* Wt, int nrows, const float* xl, const float* xc, const float* modl, float* Xout,
                                              LAS unsigned char* lds, Idle&& idle) {
    constexpr int TL = NB * SEQ;
    const int MT = nrows / 256;
    for (int r = 0; r * (int)gridDim.x < MT * 8; ++r) {
        const int u = xcd_unit(r);
        if (u >= MT * 8) {
            idle(u - MT * 8, (r + 1) * (int)gridDim.x - MT * 8); continue; }
        int mt, nt; unit_tile(u, MT, 8, mt, nt);
        const bf16* arow[4];
#pragma unroll
        for (int i = 0; i < 4; ++i) arow[i] = A + (size_t)(mt * 256 + (otid() >> 3) + 64 * i) * lda;
        gemm_tile(arow, Wt + (size_t)nt * 128 * K, K, K, lds, [&](const f32x16 (&acc)[2][2], int wm, int wn, int lane) { stage_f32_128(acc, lds, wm, wn, lane); });
        __syncthreads();
        {
            const float* mv = modl + (size_t)mod_row<NB>(mt * 256) * 6144 + 2 * 1024 + nt * 128;
            const int t = otid(), piece = t & 31;
            const f32x4 m2 = *(const f32x4*)(mv + piece * 4);
#pragma unroll 4
            for (int it = 0; it < 16; ++it) { const int rl = it * 16 + (t >> 5), row = mt * 256 + rl;
                const f32x4 a = *(const LAS f32x4*)(lds + rl * CST_F32 + piece * 16);
                const float* srcp = (row < TL ? xl + (size_t)row * D : xc + (size_t)(row - TL) * D) + nt * 128 + piece * 4;
                const f32x4 xv = *(const f32x4*)srcp;
                f32x4 o;
#pragma unroll
                for (int j = 0; j < 4; ++j) o[j] = xv[j] + m2[j] * a[j];
                __builtin_nontemporal_store(o, (f32x4*)(Xout + (size_t)row * D + nt * 128 + piece * 4)); }
        }
        __syncthreads();
    }
}
}
namespace fx {
__device__ __forceinline__ int moe_prefix(const int* cnt, LAS int* pre  ) {
    __syncthreads();
    if (otid() < 64) {
        const int lane = otid();
        int v = lane < 32 ? (cnt[lane * 64] + 255) >> 8 : 0;
#pragma unroll
        for (int o = 1; o < 32; o <<= 1) { const int t = __shfl_up(v, o); if (lane >= o) v += t; }
        if (lane < 32) pre[lane + 1] = v;
        if (lane == 0) pre[0] = 0;
    }
    __syncthreads();
    return pre[32];
}
__device__ __forceinline__ int moe_find(const LAS int* pre, int t) { int e = 0;
#pragma unroll
    for (int i = 1; i < 32; ++i) e += (t >= pre[i]) ? 1 : 0;
    return e; }

__device__ __forceinline__ void phase_moe_up(const bf16* H2, const bf16* Wgu, const int* cnt, const int* list, int cap, const float* route_w, bf16* ACT, LAS unsigned char* lds) {
    LAS int* pre = (LAS int*)(lds + GEMM_LDS);
    const int ntile = moe_prefix(cnt, pre);
    for (int r = 0; r * (int)gridDim.x < ntile * 8; ++r) {
        const int u = xcd_unit(r); if (u >= ntile * 8) continue;
        const int t = u >> 3, nt = u & 7, e = moe_find(pre, t), mt = t - pre[e], ce = cnt[e * 64];
        const int* le = list + (size_t)e * cap + mt * 256;
        const int nvalid = ce - mt * 256;
        const bf16* arow[4];
#pragma unroll
        for (int i = 0; i < 4; ++i) { const int r = (otid() >> 3) + 64 * i; const int ent = le[r < nvalid ? r : 0]; arow[i] = H2 + (size_t)(ent >> 1) * D; }
        gemm_tile(arow, Wgu + (size_t)e * 1024 * 1024 + (size_t)nt * 128 * 1024, 1024, 1024, lds, [&](const f32x16 (&acc)[2][2], int wm, int wn, int lane) {
#pragma unroll
            for (int mi = 0; mi < 2; ++mi) { const int r = wm * 64 + mi * 32 + (lane & 31);
                const float w = r < nvalid ? route_w[le[r]] : 0.f;
                LAS unsigned char* rp = lds + r * CST_BF64 + (wn * 32 + 4 * (lane >> 5)) * 2;
#pragma unroll
                for (int g = 0; g < 4; ++g) { float v[4];
#pragma unroll
                    for (int j = 0; j < 4; ++j) v[j] = siluf(acc[mi][0][4 * g + j]) * acc[mi][1][4 * g + j] * w;
                    u32x2 o; o[0] = pk2(v[0], v[1]); o[1] = pk2(v[2], v[3]); *(LAS u32x2*)(rp + 8 * g * 2) = o; } }
        });
        __syncthreads();
        flush_bf16_64(lds, [&](int r) -> bf16* { return r < nvalid ? ACT + (size_t)le[r] * 512 + nt * 64 : nullptr; });
        __syncthreads();
    }
}
__device__ __forceinline__ void phase_moe_down(const bf16* ACT, const bf16* Wd, const int* cnt, const int* list, int cap, bf16* Y2, LAS unsigned char* lds) {
    LAS int* pre = (LAS int*)(lds + GEMM_LDS);
    const int ntile = moe_prefix(cnt, pre);
    for (int r = 0; r * (int)gridDim.x < ntile * 8; ++r) {
        const int u = xcd_unit(r); if (u >= ntile * 8) continue;
        const int t = u >> 3, nt = u & 7, e = moe_find(pre, t), mt = t - pre[e], ce = cnt[e * 64];
        const int* le = list + (size_t)e * cap + mt * 256;
        const int nvalid = ce - mt * 256;
        const bf16* arow[4];
#pragma unroll
        for (int i = 0; i < 4; ++i) { const int r = (otid() >> 3) + 64 * i; const int ent = le[r < nvalid ? r : 0]; arow[i] = ACT + (size_t)ent * 512; }
        gemm_tile(arow, Wd + (size_t)e * 1024 * 512 + (size_t)nt * 128 * 512, 512, 512, lds, [&](const f32x16 (&acc)[2][2], int wm, int wn, int lane) { stage_bf16_128(acc, lds, wm, wn, lane); });
        __syncthreads();
        flush_bf16_128(lds, [&](int r) -> bf16* { return r < nvalid ? Y2 + (size_t)le[r] * D + nt * 128 : nullptr; });
        __syncthreads();
    }
}

template <int NB>
__device__ __forceinline__ void phase_qkv(const bf16* H, const bf16* Wt, const float* qn, const float* kn, bf16* QKV, LAS unsigned char* lds) {
    constexpr int T = NB * (SEQ + CTXL), MT = T / 256;
    for (int r = 0; r * (int)gridDim.x < MT * 24; ++r) {
        const int u = xcd_unit(r); if (u >= MT * 24) continue;
        int mt, nt; unit_tile(u, MT, 24, mt, nt);
        const bf16* arow[4];
#pragma unroll
        for (int i = 0; i < 4; ++i) arow[i] = H + (size_t)(mt * 256 + (otid() >> 3) + 64 * i) * D;
        gemm_tile(arow, Wt + (size_t)nt * 128 * D, D, D, lds, [&](const f32x16 (&acc)[2][2], int wm, int wn, int lane) {
            const int which = nt >> 3;
#pragma unroll
            for (int mi = 0; mi < 2; ++mi) {
                float rs = 1.f;
                if (which < 2) { float ss = 0.f;
#pragma unroll
                    for (int ni = 0; ni < 2; ++ni)
#pragma unroll
                        for (int r = 0; r < 16; ++r) ss += acc[mi][ni][r] * acc[mi][ni][r];
                    ss += __shfl_xor(ss, 32);
                    rs = rsqrtf(ss * (1.f / 64.f) + 1e-6f) * (which == 0 ? 0.125f : 1.f); }
                const float* nwp = which == 0 ? qn : kn;
                LAS unsigned char* rp = lds + (wm * 64 + mi * 32 + (lane & 31)) * CST_BF + (wn * 64 + 4 * (lane >> 5)) * 2;
#pragma unroll
                for (int ni = 0; ni < 2; ++ni)
#pragma unroll
                    for (int g = 0; g < 4; ++g) { float v[4];
#pragma unroll
                        for (int j = 0; j < 4; ++j) { v[j] = acc[mi][ni][4 * g + j]; if (which < 2) v[j] *= rs * nwp[ni * 32 + 8 * g + 4 * (lane >> 5) + j]; }
                        u32x2 o; o[0] = pk2(v[0], v[1]); o[1] = pk2(v[2], v[3]); *(LAS u32x2*)(rp + (ni * 32 + 8 * g) * 2) = o; } }
        });
        __syncthreads();
        flush_bf16_128(lds, [&](int r) { return QKV + (size_t)(mt * 256 + r) * 3072 + nt * 128; });
        __syncthreads();
    }
}

__device__ __forceinline__ bf16x8 frag16_row(const LAS unsigned char* T, int RS, int r0, int c0, int lane) {
    return *(const LAS bf16x8*)(T + (r0 + (lane & 15)) * RS + (c0 + 8 * (lane >> 4)) * 2);
}
__device__ __forceinline__ bf16x8 frag16_vt(const LAS unsigned char* T, int RS, int kb, int c0, int lane) {
    const int g4 = lane >> 4, q = (lane & 15) >> 2, p = lane & 3;
    const unsigned a0 = (unsigned)(size_t)(T + (kb + 4 * g4 + q) * RS + (c0 + 4 * p) * 2);
    const unsigned a1 = a0 + 16 * RS;
    bf16x4 v0, v1;
    asm volatile("ds_read_b64_tr_b16 %0, %2\n\tds_read_b64_tr_b16 %1, %3\n\ts_waitcnt lgkmcnt(0)" : "=&v"(v0), "=&v"(v1) : "v"(a0), "v"(a1) : "memory");
    bf16x8 r; r[0] = v0[0]; r[1] = v0[1]; r[2] = v0[2]; r[3] = v0[3]; r[4] = v1[0]; r[5] = v1[1]; r[6] = v1[2]; r[7] = v1[3];
    return r;
}

template <bool LOCAL>
__device__ __forceinline__ void attn_group(const LAS unsigned char* Kt, const LAS unsigned char* Vt, int kb, int hsel, int lane, int g4,
                                           const bf16x8& q0, const bf16x8& q1, f32x4 (&oacc)[4], float& l_run,
                                           int cs, int c, int brow  , const LAS float* rp) {
    f32x4 s[2];
#pragma unroll
    for (int sb = 0; sb < 2; ++sb) { s[sb] = (f32x4){0.f, 0.f, 0.f, 0.f};
        s[sb] = mfma16(frag16_row(Kt, RS_N, kb + 16 * sb, hsel * 64, lane), q0, s[sb]);
        s[sb] = mfma16(frag16_row(Kt, RS_N, kb + 16 * sb, hsel * 64 + 32, lane), q1, s[sb]); }
    float ps = 0.f; float p[8];
#pragma unroll
    for (int sb = 0; sb < 2; ++sb)
#pragma unroll
        for (int j = 0; j < 4; ++j) {
            float e;
            if (LOCAL) { const int kc = kb + 16 * sb + 4 * g4 + j; const bool ok = kc >= cs && kc < cs + 16;
                e = ok ? __expf(s[sb][j] + rp[hsel * 465 + (ok ? brow + (kc - c + 15) : 0)] - 8.f) : 0.f; }
            else e = __expf(s[sb][j] - 8.f);
            p[4 * sb + j] = e; ps += e; }
    l_run += ps;
    u32x4 pu; pu[0] = pk2(p[0], p[1]); pu[1] = pk2(p[2], p[3]); pu[2] = pk2(p[4], p[5]); pu[3] = pk2(p[6], p[7]);
    const bf16x8 pf = __builtin_bit_cast(bf16x8, pu);
    bf16x4 tv[4][2];
    {
        const int q = (lane & 15) >> 2, p4 = lane & 3;
        const unsigned a = (unsigned)(size_t)(Vt + (kb + 4 * g4 + q) * RS_N + (hsel * 64 + 4 * p4) * 2);
        tr8(a, a + 16 * RS_N, a + 32, a + 32 + 16 * RS_N, a + 64, a + 64 + 16 * RS_N, a + 96, a + 96 + 16 * RS_N,
            tv[0][0], tv[0][1], tv[1][0], tv[1][1], tv[2][0], tv[2][1], tv[3][0], tv[3][1]);
    }
#pragma unroll
    for (int db = 0; db < 4; ++db) oacc[db] = mfma16(tr_join(tv[db][0], tv[db][1]), pf, oacc[db]);
}

template <bool LOCAL>
__device__ __forceinline__ void attn_group2(const LAS unsigned char* Kt, const LAS unsigned char* Vt, int kb, int hsel, int lane, int g4,
                                            const bf16x8 (&q0)[2], const bf16x8 (&q1)[2], f32x4 (&oacc)[2][4], float (&l_run)[2],
                                            int cs, int c, int brow0, int brow1, const LAS float* rp) {
    bf16x8 kf[2][2];
#pragma unroll
    for (int sb = 0; sb < 2; ++sb) { kf[sb][0] = frag16_row(Kt, RS_N, kb + 16 * sb, hsel * 64, lane); kf[sb][1] = frag16_row(Kt, RS_N, kb + 16 * sb, hsel * 64 + 32, lane); }
    f32x4 s[2][2];
#pragma unroll
    for (int qr = 0; qr < 2; ++qr)
#pragma unroll
        for (int sb = 0; sb < 2; ++sb) { s[qr][sb] = (f32x4){0.f, 0.f, 0.f, 0.f};
            s[qr][sb] = mfma16(kf[sb][0], q0[qr], s[qr][sb]); s[qr][sb] = mfma16(kf[sb][1], q1[qr], s[qr][sb]); }
    bf16x8 pf[2];
#pragma unroll
    for (int qr = 0; qr < 2; ++qr) {
        float ps = 0.f; float p[8];
        const int brow = qr ? brow1 : brow0;
#pragma unroll
        for (int sb = 0; sb < 2; ++sb)
#pragma unroll
            for (int j = 0; j < 4; ++j) {
                float e;
                if (LOCAL) { const int kc = kb + 16 * sb + 4 * g4 + j; const bool ok = kc >= cs && kc < cs + 16;
                    const float bv = rp[hsel * 465 + (ok ? brow + (kc - c + 15) : 0)];
                    const float ex = __expf(s[qr][sb][j] + bv - 8.f);
                    e = ok ? ex : 0.f; }
                else e = __expf(s[qr][sb][j] - 8.f);
                p[4 * sb + j] = e; ps += e; }
        l_run[qr] += ps;
        u32x4 pu; pu[0] = pk2(p[0], p[1]); pu[1] = pk2(p[2], p[3]); pu[2] = pk2(p[4], p[5]); pu[3] = pk2(p[6], p[7]);
        pf[qr] = __builtin_bit_cast(bf16x8, pu);
    }
    bf16x4 tv[4][2];
    {
        const int q = (lane & 15) >> 2, p4 = lane & 3;
        const unsigned a = (unsigned)(size_t)(Vt + (kb + 4 * g4 + q) * RS_N + (hsel * 64 + 4 * p4) * 2);
        tr8(a, a + 16 * RS_N, a + 32, a + 32 + 16 * RS_N, a + 64, a + 64 + 16 * RS_N, a + 96, a + 96 + 16 * RS_N,
            tv[0][0], tv[0][1], tv[1][0], tv[1][1], tv[2][0], tv[2][1], tv[3][0], tv[3][1]);
    }
#pragma unroll
    for (int db = 0; db < 4; ++db) { const bf16x8 vf = tr_join(tv[db][0], tv[db][1]);
        oacc[0][db] = mfma16(vf, pf[0], oacc[0][db]); oacc[1][db] = mfma16(vf, pf[1], oacc[1][db]); }
}

constexpr int ATT_QR = 2;
template <int NB>
__device__ __forceinline__ void phase_attn(const bf16* QKV, const float* rpb, bf16* AO, LAS unsigned char* lds) {
    constexpr int TL = NB * SEQ;
    constexpr int TILE = 64 * RS_N;
    const int tid = otid(), lane = tid & 63, wave = tid >> 6, w = wave & 3, hsel = wave >> 2;
    const int qi = lane & 15, g4 = lane >> 4;
    LAS float* rp = (LAS float*)(lds + 4 * TILE);
    constexpr int QR = ATT_QR, NRG = 64 / QR;
    for (int u = blockIdx.x; u < NB * NRG * 8; u += gridDim.x) {
        const int hp = u & 7, rg = (u >> 3) % NRG, b = (u >> 3) / NRG;
        const int head = 2 * hp + hsel;
        int R0 = QR * rg - 4; R0 = R0 < 0 ? 0 : (R0 > 56 ? 56 : R0);
        int R1 = QR * rg + QR - 1 - 4; R1 = (R1 < 0 ? 0 : (R1 > 56 ? 56 : R1)) + 7;
        const int nloc = R1 - R0 + 1, nit = nloc + 4;
        __syncthreads();
        for (int i = tid; i < 2 * 465; i += NTHR) rp[i] = rpb[(size_t)(2 * hp) * 465 + i];
        const int c = 16 * w + qi;
        int cs = c - 8; cs = cs < 0 ? 0 : (cs > 48 ? 48 : cs);
        const int kbw = w == 0 ? 0 : (w == 1 ? 8 : (w == 2 ? 24 : 32));
        bf16x8 q0[QR], q1[QR]; f32x4 oacc[QR][4]; float l_run[QR];
#pragma unroll
        for (int qr = 0; qr < QR; ++qr) {
            const size_t qrow = (size_t)b * SEQ + (QR * rg + qr) * 64 + c;
            q0[qr] = *(const bf16x8*)(QKV + qrow * 3072 + head * 64 + 8 * g4); q1[qr] = *(const bf16x8*)(QKV + qrow * 3072 + head * 64 + 32 + 8 * g4);
#pragma unroll
            for (int i = 0; i < 4; ++i) oacc[qr][i] = (f32x4){0.f, 0.f, 0.f, 0.f};
            l_run[qr] = 0.f; }
        u32x4 sk[2], sv[2];
#define AT_LOAD(it) do { \
        _Pragma("unroll") for (int i = 0; i < 2; ++i) { const int idx = tid + 512 * i, key = idx >> 4, ch = idx & 15; \
            const size_t krow = (it) < nloc ? (size_t)b * SEQ + (size_t)(R0 + (it)) * 64 + key : (size_t)TL + (size_t)b * CTXL + ((it) - nloc) * 64 + key; \
            const bf16* kp = QKV + krow * 3072 + 1024 + hp * 128 + ch * 8; sk[i] = *(const u32x4*)kp; sv[i] = *(const u32x4*)(kp + 1024); } } while (0)
#define AT_STORE(buf) do { LAS unsigned char* kt_ = lds + (buf) * 2 * TILE; \
        _Pragma("unroll") for (int i = 0; i < 2; ++i) { const int idx = tid + 512 * i, key = idx >> 4, ch = idx & 15; \
            *(LAS u32x4*)(kt_ + key * RS_N + ch * 16) = sk[i]; *(LAS u32x4*)(kt_ + TILE + key * RS_N + ch * 16) = sv[i]; } } while (0)
        AT_LOAD(0);
        AT_STORE(0);
        __syncthreads();
        for (int it = 0; it < nit; ++it) {
            const LAS unsigned char* Kt = lds + (it & 1) * 2 * TILE; const LAS unsigned char* Vt = Kt + TILE;
            if (it + 1 < nit) AT_LOAD(it + 1);
            if (it < nloc) {
                const int kr = R0 + it;
                static_assert(QR == 2, "attn_group2 pairs two query rows");
                const int ra = QR * rg, rb = ra + 1;
                int r0a = ra - 4; r0a = r0a < 0 ? 0 : (r0a > 56 ? 56 : r0a);
                int r0b = rb - 4; r0b = r0b < 0 ? 0 : (r0b > 56 ? 56 : r0b);
                const bool ina = kr >= r0a && kr < r0a + 8, inb = kr >= r0b && kr < r0b + 8;
                if (ina && inb) attn_group2<true>(Kt, Vt, kbw, hsel, lane, g4, q0, q1, oacc, l_run, cs, c, (kr - ra + 7) * 31, (kr - rb + 7) * 31, rp);
                else if (ina) attn_group<true>(Kt, Vt, kbw, hsel, lane, g4, q0[0], q1[0], oacc[0], l_run[0], cs, c, (kr - ra + 7) * 31, rp);
                else if (inb) attn_group<true>(Kt, Vt, kbw, hsel, lane, g4, q0[1], q1[1], oacc[1], l_run[1], cs, c, (kr - rb + 7) * 31, rp);
            } else {
                attn_group2<false>(Kt, Vt, 0, hsel, lane, g4, q0, q1, oacc, l_run, 0, 0, 0, 0, rp);
                attn_group2<false>(Kt, Vt, 32, hsel, lane, g4, q0, q1, oacc, l_run, 0, 0, 0, 0, rp);
            }
            if (it + 1 < nit) AT_STORE((it + 1) & 1);
            __syncthreads();
        }
#undef AT_LOAD
#undef AT_STORE
#pragma unroll
        for (int qr = 0; qr < QR; ++qr) {
            float l = l_run[qr]; l += __shfl_xor(l, 16); l += __shfl_xor(l, 32);
            const float inv = 1.f / l;
            const size_t qrow = (size_t)b * SEQ + (QR * rg + qr) * 64 + c;
            bf16* op = AO + qrow * D + head * 64 + 4 * g4;
#pragma unroll
            for (int db = 0; db < 4; ++db) { u32x2 o; o[0] = pk2(oacc[qr][db][0] * inv, oacc[qr][db][1] * inv); o[1] = pk2(oacc[qr][db][2] * inv, oacc[qr][db][3] * inv); *(u32x2*)(op + 16 * db) = o; }
        }
    }
}
}
namespace fx {
namespace g8 {
constexpr int BM = 256, BK = 64, HALF = 128, HTB = HALF * BK * 2, STAGE_BYTES = 8 * HTB;
__device__ __forceinline__ int lds_byte(int r, int c) { const int st = (r >> 4) * 2 + (c >> 5), rr = r & 15, cc = c & 31, ob = rr * 64 + cc * 2; return st * 1024 + (ob ^ (((ob >> 9) & 1) << 5)); }
__device__ __forceinline__ void stage_rc(int b, int& R, int& C) { const int st = b / 1024, sb = b % 1024, swz = sb ^ (((sb >> 9) & 1) << 5); R = (st >> 1) * 16 + swz / 64; C = (st & 1) * 32 + (swz % 64) / 2; }
__device__ __forceinline__ int perm32(int rho) { const int n = rho >> 4, i = rho & 15; return 8 * (i >> 2) + 4 * n + (i & 3); }
struct Unit { int pm, pn, i0; const int* p; };

template <class Epi, class Sched>
__device__ __forceinline__ void gemm_phase(LAS unsigned char* lds, int K, const Sched& S, const Epi& E) {
    const int tid = otid(), wid = __builtin_amdgcn_readfirstlane(tid >> 6), lane = tid & 63, wr = wid >> 2, wc = wid & 3, fr = lane & 15, fq = lane >> 4;
    const int nt = K / BK;
    int Rr[2], Cc[2]; unsigned voffB[2];
#pragma unroll
    for (int i = 0; i < 2; ++i) { int R, C; stage_rc(tid * 16 + i * 8192, R, C); Rr[i] = R; Cc[i] = C;
        const int Rb = Epi::PERM ? ((R & ~31) + perm32(R & 31)) : R; voffB[i] = (unsigned)(Rb * K + C) * 2u; }
    const size_t kstep = (size_t)(BK * 2);
    const size_t hstepB = (size_t)HALF * K * 2;
    const unsigned ldsw = (unsigned)wid * 1024u;
    const int aoff = lds_byte(wr * 64 + fr, fq * 8), boff = lds_byte(wc * 32 + fr, fq * 8);
#define G8_SA(b, h) (((b) * 2 + (h)) * HTB)
#define G8_SB(b, h) ((4 + (b) * 2 + (h)) * HTB)
#define G8_STAGE_B(bufoff, gbase) do { _Pragma("unroll") for (int _i = 0; _i < 2; ++_i) \
        __builtin_amdgcn_global_load_lds((const unsigned*)((const char*)(gbase) + voffB[_i]), (LAS unsigned*)(lds + (bufoff) + ldsw + _i * 8192), 16, 0, 0); } while (0)
#define G8_STAGE_A(bufoff, gbase, o0, o1) do { \
        __builtin_amdgcn_global_load_lds((const unsigned*)((const char*)(gbase) + (o0)), (LAS unsigned*)(lds + (bufoff) + ldsw), 16, 0, 0); \
        __builtin_amdgcn_global_load_lds((const unsigned*)((const char*)(gbase) + (o1)), (LAS unsigned*)(lds + (bufoff) + ldsw + 8192), 16, 0, 0); } while (0)
#define G8_LDA(dst, b, h) do { _Pragma("unroll") for (int m = 0; m < 4; ++m) _Pragma("unroll") for (int k = 0; k < 2; ++k) dst[m][k] = *(const LAS bf16x8*)(lds + G8_SA(b, h) + aoff + m * 2048 + k * 1024); } while (0)
#define G8_LDB(dst, b, h) do { _Pragma("unroll") for (int n = 0; n < 2; ++n) _Pragma("unroll") for (int k = 0; k < 2; ++k) dst[n][k] = *(const LAS bf16x8*)(lds + G8_SB(b, h) + boff + n * 2048 + k * 1024); } while (0)
#define G8_MMA(ai, bj, At, Bt) do { __builtin_amdgcn_s_setprio(1); _Pragma("unroll") for (int m = 0; m < 4; ++m) _Pragma("unroll") for (int n = 0; n < 2; ++n) _Pragma("unroll") for (int k = 0; k < 2; ++k) \
        acc[ai][bj][m][n] = __builtin_amdgcn_mfma_f32_16x16x32_bf16(Bt[n][k], At[m][k], acc[ai][bj][m][n], 0, 0, 0); __builtin_amdgcn_s_setprio(0); } while (0)
#define G8_WAIT_V(n) asm volatile("s_waitcnt vmcnt(" #n ")" ::: "memory")
#define G8_WAIT_L(n) asm volatile("s_waitcnt lgkmcnt(" #n ")" ::: "memory")
#define G8_BAR __builtin_amdgcn_s_barrier()
#define G8_SCHED __builtin_amdgcn_sched_barrier(0)
    Unit cur, nxt; int ui = 0;
    if (!S.next(0, cur)) return;
    f32x4 acc[2][2][4][2];
#pragma unroll
    for (int a = 0; a < 2; ++a)
#pragma unroll
        for (int b = 0; b < 2; ++b)
#pragma unroll
            for (int m = 0; m < 4; ++m)
#pragma unroll
                for (int n = 0; n < 2; ++n) acc[a][b][m][n] = (f32x4){0.f, 0.f, 0.f, 0.f};
    bf16x8 At[4][2], B0[2][2], B1[2][2];
    unsigned oaC[2][2], oaN[2][2]; const char* cAb; const char* cB; const char* nAb; const char* nB;
    S.src(cur, Rr, Cc, oaC, cAb, cB);
    G8_STAGE_B(G8_SB(0, 0), cB); G8_STAGE_A(G8_SA(0, 0), cAb, oaC[0][0], oaC[0][1]); G8_STAGE_B(G8_SB(0, 1), cB + hstepB); G8_STAGE_A(G8_SA(0, 1), cAb, oaC[1][0], oaC[1][1]);
    if (wr == 1) G8_BAR;
    G8_WAIT_V(4); G8_BAR;
    G8_STAGE_B(G8_SB(1, 0), cB + kstep); G8_STAGE_A(G8_SA(1, 0), cAb + kstep, oaC[0][0], oaC[0][1]); G8_STAGE_B(G8_SB(1, 1), cB + hstepB + kstep);
    G8_WAIT_V(6); G8_BAR;
    for (;;) {
        const bool has_next = S.next(ui + 1, nxt);
        if (has_next) S.src(nxt, Rr, Cc, oaN, nAb, nB);
        else { nAb = cAb; nB = cB;
#pragma unroll
            for (int h = 0; h < 2; ++h)
#pragma unroll
                for (int i = 0; i < 2; ++i) oaN[h][i] = oaC[h][i]; }
        for (int t = 0; t < nt; t += 2) {
            const bool last = (t == nt - 2);
            const char* a1 = cAb + (size_t)(t + 1) * kstep;
            const char* a2 = last ? nAb : cAb + (size_t)(t + 2) * kstep; const char* b2 = last ? nB : cB + (size_t)(t + 2) * kstep;
            const char* a3 = a2 + kstep; const char* b3 = b2 + kstep;
            const unsigned o00 = last ? oaN[0][0] : oaC[0][0], o01 = last ? oaN[0][1] : oaC[0][1], o10 = last ? oaN[1][0] : oaC[1][0], o11 = last ? oaN[1][1] : oaC[1][1];
            G8_LDB(B0, 0, 0); G8_SCHED; G8_LDA(At, 0, 0); G8_STAGE_A(G8_SA(1, 1), a1, oaC[1][0], oaC[1][1]);
            G8_WAIT_L(8); G8_BAR; G8_WAIT_L(0); G8_MMA(0, 0, At, B0); G8_BAR; G8_SCHED;
            G8_LDB(B1, 0, 1); G8_STAGE_B(G8_SB(0, 0), b2);
            G8_BAR; G8_WAIT_L(0); G8_MMA(0, 1, At, B1); G8_BAR;
            G8_LDA(At, 0, 1); G8_STAGE_A(G8_SA(0, 0), a2, o00, o01);
            G8_BAR; G8_WAIT_L(0); G8_MMA(1, 0, At, B0); G8_BAR; G8_SCHED;
            G8_STAGE_B(G8_SB(0, 1), b2 + hstepB);
            G8_WAIT_V(6); G8_BAR; G8_MMA(1, 1, At, B1); G8_BAR;
            G8_LDB(B0, 1, 0); G8_SCHED; G8_LDA(At, 1, 0); G8_STAGE_A(G8_SA(0, 1), a2, o10, o11);
            G8_WAIT_L(8); G8_BAR; G8_WAIT_L(0); G8_MMA(0, 0, At, B0); G8_BAR; G8_SCHED;
            G8_LDB(B1, 1, 1); G8_STAGE_B(G8_SB(1, 0), b3);
            G8_BAR; G8_WAIT_L(0); G8_MMA(0, 1, At, B1); G8_BAR;
            G8_LDA(At, 1, 1); G8_STAGE_A(G8_SA(1, 0), a3, o00, o01);
            G8_BAR; G8_WAIT_L(0); G8_MMA(1, 0, At, B0); G8_BAR; G8_SCHED;
            G8_STAGE_B(G8_SB(1, 1), b3 + hstepB);
            G8_WAIT_V(6); G8_BAR; G8_MMA(1, 1, At, B1); G8_BAR;
        }
        E(acc, cur, wr, wc, fr, fq);
        if (!has_next) break;
#pragma unroll
        for (int a = 0; a < 2; ++a)
#pragma unroll
            for (int b = 0; b < 2; ++b)
#pragma unroll
                for (int m = 0; m < 4; ++m)
#pragma unroll
                    for (int n = 0; n < 2; ++n) acc[a][b][m][n] = (f32x4){0.f, 0.f, 0.f, 0.f};
        cur = nxt; cAb = nAb; cB = nB; ++ui;
#pragma unroll
        for (int h = 0; h < 2; ++h)
#pragma unroll
            for (int i = 0; i < 2; ++i) oaC[h][i] = oaN[h][i];
    }
    G8_WAIT_V(0);
    if (wr == 0) G8_BAR;
    G8_BAR;
#undef G8_SA
#undef G8_SB
#undef G8_STAGE_A
#undef G8_STAGE_B
#undef G8_LDA
#undef G8_LDB
#undef G8_MMA
#undef G8_WAIT_V
#undef G8_WAIT_L
#undef G8_BAR
#undef G8_SCHED
}

struct DenseSched {
    const bf16* A; int lda; const bf16* Bt; int K; int MT, NT; int F;
    __device__ __forceinline__ bool next(int i, Unit& u) const { const int G = gridDim.x; if (i >= F || i * G >= MT * NT) return false; const int ul = xcd_unit(i); if (ul >= MT * NT) return false;
        int mt, nt_; unit_tile(ul, MT, NT, mt, nt_); u.pm = mt; u.pn = nt_; u.i0 = 0; u.p = nullptr; return true; }
    __device__ __forceinline__ void src(const Unit& u, const int (&R)[2], const int (&C)[2], unsigned (&oa)[2][2], const char*& abase, const char*& bbase) const {
        abase = (const char*)(A + (size_t)u.pm * 256 * lda); bbase = (const char*)(Bt + (size_t)u.pn * 256 * K);
#pragma unroll
        for (int h = 0; h < 2; ++h)
#pragma unroll
            for (int i = 0; i < 2; ++i) oa[h][i] = (unsigned)((128 * h + R[i]) * lda + C[i]) * 2u; }
};
}

struct EpiProj {
    static constexpr bool PERM = true;
    bf16* O; int ldc;
    __device__ __forceinline__ void operator()(const f32x4 (&acc)[2][2][4][2], const g8::Unit& u, int wr, int wc, int fr, int fq) const {
        const int row0 = u.pm * 256 + wr * 64 + fr, col0 = u.pn * 256 + wc * 32 + 8 * fq;
#pragma unroll
        for (int ai = 0; ai < 2; ++ai)
#pragma unroll
            for (int m = 0; m < 4; ++m) { bf16* rowp = O + (size_t)(row0 + ai * 128 + m * 16) * ldc + col0;
#pragma unroll
                for (int bj = 0; bj < 2; ++bj) { const f32x4 v0 = acc[ai][bj][m][0], v1 = acc[ai][bj][m][1];
                    u32x4 w; w[0] = pk2(v0[0], v0[1]); w[1] = pk2(v0[2], v0[3]); w[2] = pk2(v1[0], v1[1]); w[3] = pk2(v1[2], v1[3]);
                    *(u32x4*)(rowp + bj * 128) = w; } }
    }
};
template <int NB>
__device__ __forceinline__ void phase_inproj8(const bf16* H, const bf16* Wt, bf16* PROJ, float* GATES, LAS unsigned char* lds) {
    constexpr int T = NB * (SEQ + CTXL), MT = T / 256;
    g8::DenseSched S{H, D, Wt, D, MT, PROJW / 256, 1 << 20};
    EpiProj E{PROJ, PROJW};
    g8::gemm_phase(lds, D, S, E);
    for (int mt = blockIdx.x; mt < MT; mt += gridDim.x) {
        const bf16* arow[4];
#pragma unroll
        for (int i = 0; i < 4; ++i) arow[i] = H + (size_t)(mt * 256 + (otid() >> 3) + 64 * i) * D;
        gemm_tile(arow, Wt + (size_t)PROJW * D, D, D, lds, [&](const f32x16 (&acc)[2][2], int wm, int wn, int lane) {
            if (wn == 0) {
#pragma unroll
                for (int mi = 0; mi < 2; ++mi) { const int row = mt * 256 + wm * 64 + mi * 32 + (lane & 31);
#pragma unroll
                    for (int ni = 0; ni < 2; ++ni)
#pragma unroll
                        for (int g = 0; g < 4; ++g) { f32x4 o; o[0] = acc[mi][ni][4 * g]; o[1] = acc[mi][ni][4 * g + 1]; o[2] = acc[mi][ni][4 * g + 2]; o[3] = acc[mi][ni][4 * g + 3];
                            *(f32x4*)(GATES + (size_t)row * 64 + ni * 32 + 8 * g + 4 * (lane >> 5)) = o; } } }
        });
        __syncthreads();
    }
}
template <int NB> struct EpiResid {
    static constexpr bool PERM = false;
    const float* xl; const float* xc; const float* modl; float* Xout;
    __device__ __forceinline__ void operator()(const f32x4 (&acc)[2][2][4][2], const g8::Unit& u, int wr, int wc, int fr, int fq) const {
        constexpr int TL = NB * SEQ;
        const float* mv = modl + (size_t)mod_row<NB>(u.pm * 256) * 6144 + 2 * 1024;
        const int col0 = u.pn * 256 + wc * 32 + 4 * fq;
#pragma unroll
        for (int ai = 0; ai < 2; ++ai)
#pragma unroll
            for (int m = 0; m < 4; ++m) { const int row = u.pm * 256 + ai * 128 + wr * 64 + m * 16 + fr;
                const float* srcp = (row < TL ? xl + (size_t)row * D : xc + (size_t)(row - TL) * D) + col0;
                float* dstp = Xout + (size_t)row * D + col0;
#pragma unroll
                for (int bj = 0; bj < 2; ++bj)
#pragma unroll
                    for (int n = 0; n < 2; ++n) { const int co = bj * 128 + n * 16;
                        const f32x4 xv = *(const f32x4*)(srcp + co), m2 = *(const f32x4*)(mv + col0 + co);
                        f32x4 o;
#pragma unroll
                        for (int j = 0; j < 4; ++j) o[j] = xv[j] + m2[j] * acc[ai][bj][m][n][j];
                        *(f32x4*)(dstp + co) = o; } }
    }
};
template <int NB, class Idle>
__device__ __forceinline__ void phase_outproj8(const bf16* A, int lda, int K, const bf16* Wt, int nrows, const float* xl, const float* xc, const float* modl, float* Xout, LAS unsigned char* lds, Idle&& idle) {
    constexpr int TL = NB * SEQ;
    const int MT = nrows / 256, U = MT * 4, G = gridDim.x, F = U / G, R = U - F * G;
    if (F > 0) { g8::DenseSched S{A, lda, Wt, K, MT, 4, F}; EpiResid<NB> E{xl, xc, modl, Xout}; g8::gemm_phase(lds, K, S, E); }
    for (int r = 0; r * G < 2 * R; ++r) {
        const int hu = r * G + (int)blockIdx.x;
        if (hu >= 2 * R) { idle(hu - 2 * R, (r + 1) * G - 2 * R); continue; }
        int mt, nt2; unit_tile(F * G + (hu >> 1), MT, 4, mt, nt2);
        const int nt = 2 * nt2 + (hu & 1);
        const bf16* arow[4];
#pragma unroll
        for (int i = 0; i < 4; ++i) arow[i] = A + (size_t)(mt * 256 + (otid() >> 3) + 64 * i) * lda;
        gemm_tile(arow, Wt + (size_t)nt * 128 * K, K, K, lds, [&](const f32x16 (&acc)[2][2], int wm, int wn, int lane) { stage_f32_128(acc, lds, wm, wn, lane); });
        __syncthreads();
        {
            const float* mv = modl + (size_t)mod_row<NB>(mt * 256) * 6144 + 2 * 1024 + nt * 128;
            const int t = otid(), piece = t & 31;
            const f32x4 m2 = *(const f32x4*)(mv + piece * 4);
#pragma unroll 4
            for (int it = 0; it < 16; ++it) { const int rl = it * 16 + (t >> 5), row = mt * 256 + rl;
                const f32x4 a = *(const LAS f32x4*)(lds + rl * CST_F32 + piece * 16);
                const float* srcp = (row < TL ? xl + (size_t)row * D : xc + (size_t)(row - TL) * D) + nt * 128 + piece * 4;
                const f32x4 xv = *(const f32x4*)srcp;
                f32x4 o;
#pragma unroll
                for (int j = 0; j < 4; ++j) o[j] = xv[j] + m2[j] * a[j];
                __builtin_nontemporal_store(o, (f32x4*)(Xout + (size_t)row * D + nt * 128 + piece * 4)); }
        }
        __syncthreads();
    }
}
template <bool UP> struct MoeSched {
    const bf16* Abuf; const bf16* W; const int* cnt; const int* list; int cap; const LAS int* pre; int ntile; int F;
    static constexpr int KK = UP ? 1024 : 512;
    __device__ __forceinline__ bool next(int i, g8::Unit& u) const { const int G = gridDim.x; if (i >= F) return false; const int ul = xcd_unit(i); if (ul >= ntile * 4) return false;
        const int t = ul >> 2, e = moe_find(pre, t), mt = t - pre[e]; u.pm = e; u.pn = ul & 3; u.i0 = cnt[e * 64] - mt * 256; u.p = list + (size_t)e * cap + mt * 256; return true; }
    __device__ __forceinline__ void src(const g8::Unit& u, const int (&R)[2], const int (&C)[2], unsigned (&oa)[2][2], const char*& abase, const char*& bbase) const {
        abase = (const char*)Abuf; bbase = (const char*)(W + (size_t)u.pm * 1024 * KK + (size_t)u.pn * 256 * KK);
#pragma unroll
        for (int h = 0; h < 2; ++h)
#pragma unroll
            for (int i = 0; i < 2; ++i) { const int r = 128 * h + R[i]; const int ent = u.p[r < u.i0 ? r : 0];
                oa[h][i] = (unsigned)((UP ? (ent >> 1) * 1024 : ent * 512) + C[i]) * 2u; } }
};
struct EpiMoeUp8 {
    static constexpr bool PERM = true;
    const float* route_w; bf16* ACT;
    __device__ __forceinline__ void operator()(const f32x4 (&acc)[2][2][4][2], const g8::Unit& u, int wr, int wc, int fr, int fq) const {
#pragma unroll
        for (int ai = 0; ai < 2; ++ai)
#pragma unroll
            for (int m = 0; m < 4; ++m) { const int r = ai * 128 + wr * 64 + m * 16 + fr;
                if (r < u.i0) { const int ent = u.p[r]; const float w = route_w[ent];
                    float v[8];
#pragma unroll
                    for (int n = 0; n < 2; ++n)
#pragma unroll
                        for (int j = 0; j < 4; ++j) v[4 * n + j] = siluf(acc[ai][0][m][n][j]) * acc[ai][1][m][n][j] * w;
                    u32x4 o; o[0] = pk2(v[0], v[1]); o[1] = pk2(v[2], v[3]); o[2] = pk2(v[4], v[5]); o[3] = pk2(v[6], v[7]);
                    *(u32x4*)(ACT + (size_t)ent * 512 + u.pn * 128 + wc * 32 + 8 * fq) = o; } }
    }
};
struct EpiMoeDown8 {
    static constexpr bool PERM = true;
    bf16* Y2;
    __device__ __forceinline__ void operator()(const f32x4 (&acc)[2][2][4][2], const g8::Unit& u, int wr, int wc, int fr, int fq) const {
#pragma unroll
        for (int ai = 0; ai < 2; ++ai)
#pragma unroll
            for (int m = 0; m < 4; ++m) { const int r = ai * 128 + wr * 64 + m * 16 + fr;
                if (r < u.i0) { bf16* rowp = Y2 + (size_t)u.p[r] * D + u.pn * 256 + wc * 32 + 8 * fq;
#pragma unroll
                    for (int bj = 0; bj < 2; ++bj) { const f32x4 v0 = acc[ai][bj][m][0], v1 = acc[ai][bj][m][1];
                        u32x4 o; o[0] = pk2(v0[0], v0[1]); o[1] = pk2(v0[2], v0[3]); o[2] = pk2(v1[0], v1[1]); o[3] = pk2(v1[2], v1[3]);
                        *(u32x4*)(rowp + bj * 128) = o; } } }
    }
};
struct BRowGU { int s; __device__ __forceinline__ int operator()(int r) const { return ((r >> 5) & 1) * 128 + 64 * s + (r >> 6) * 32 + (r & 31); } };

__device__ __forceinline__ void phase_moe_up8(const bf16* H2, const bf16* Wgu, const int* cnt, const int* list, int cap, const float* route_w, bf16* ACT, LAS unsigned char* lds) {
    LAS int* pre = (LAS int*)(lds + GEMM_LDS);
    const int ntile = moe_prefix(cnt, pre);
    const int G = gridDim.x, U = ntile * 4, F = U / G, R = U - F * G;
    if (F > 0) { MoeSched<true> S{H2, Wgu, cnt, list, cap, pre, ntile, F}; EpiMoeUp8 E{route_w, ACT}; g8::gemm_phase(lds, 1024, S, E); }
    for (int r = 0; r * G < 2 * R; ++r) {
        const int hu = r * G + (int)blockIdx.x; if (hu >= 2 * R) continue;
        const int ul = F * G + (hu >> 1), s = hu & 1, t = ul >> 2, pn = ul & 3, e = moe_find(pre, t), mt = t - pre[e], ce = cnt[e * 64];
        const int* le = list + (size_t)e * cap + mt * 256;
        const int nvalid = ce - mt * 256;
        const bf16* arow[4];
#pragma unroll
        for (int i = 0; i < 4; ++i) { const int rr = (otid() >> 3) + 64 * i; const int ent = le[rr < nvalid ? rr : 0]; arow[i] = H2 + (size_t)(ent >> 1) * D; }
        gemm_tile(arow, Wgu + (size_t)e * 1024 * 1024 + (size_t)pn * 256 * 1024, 1024, 1024, lds, [&](const f32x16 (&acc)[2][2], int wm, int wn, int lane) {
#pragma unroll
            for (int mi = 0; mi < 2; ++mi) { const int rr = wm * 64 + mi * 32 + (lane & 31);
                const float w = rr < nvalid ? route_w[le[rr]] : 0.f;
                LAS unsigned char* rp = lds + rr * CST_BF64 + (wn * 32 + 4 * (lane >> 5)) * 2;
#pragma unroll
                for (int g = 0; g < 4; ++g) { float v[4];
#pragma unroll
                    for (int j = 0; j < 4; ++j) v[j] = siluf(acc[mi][0][4 * g + j]) * acc[mi][1][4 * g + j] * w;
                    u32x2 o; o[0] = pk2(v[0], v[1]); o[1] = pk2(v[2], v[3]); *(LAS u32x2*)(rp + 8 * g * 2) = o; } }
        }, BRowGU{s});
        __syncthreads();
        flush_bf16_64(lds, [&](int rr) -> bf16* { return rr < nvalid ? ACT + (size_t)le[rr] * 512 + pn * 128 + 64 * s : nullptr; });
        __syncthreads();
    }
}
__device__ __forceinline__ void phase_moe_down8(const bf16* ACT, const bf16* Wd, const int* cnt, const int* list, int cap, bf16* Y2, LAS unsigned char* lds) {
    LAS int* pre = (LAS int*)(lds + GEMM_LDS);
    const int ntile = moe_prefix(cnt, pre);
    const int G = gridDim.x, U = ntile * 4, F = U / G, R = U - F * G;
    if (F > 0) { MoeSched<false> S{ACT, Wd, cnt, list, cap, pre, ntile, F}; EpiMoeDown8 E{Y2}; g8::gemm_phase(lds, 512, S, E); }
    for (int r = 0; r * G < 2 * R; ++r) {
        const int hu = r * G + (int)blockIdx.x; if (hu >= 2 * R) continue;
        const int ul = F * G + (hu >> 1), t = ul >> 2, nt = 2 * (ul & 3) + (hu & 1), e = moe_find(pre, t), mt = t - pre[e], ce = cnt[e * 64];
        const int* le = list + (size_t)e * cap + mt * 256;
        const int nvalid = ce - mt * 256;
        const bf16* arow[4];
#pragma unroll
        for (int i = 0; i < 4; ++i) { const int rr = (otid() >> 3) + 64 * i; const int ent = le[rr < nvalid ? rr : 0]; arow[i] = ACT + (size_t)ent * 512; }
        gemm_tile(arow, Wd + (size_t)e * 1024 * 512 + (size_t)nt * 128 * 512, 512, 512, lds, [&](const f32x16 (&acc)[2][2], int wm, int wn, int lane) { stage_bf16_128(acc, lds, wm, wn, lane); });
        __syncthreads();
        flush_bf16_128(lds, [&](int rr) -> bf16* { return rr < nvalid ? Y2 + (size_t)le[rr] * D + nt * 128 : nullptr; });
        __syncthreads();
    }
}
struct EpiQKV8 {
    static constexpr bool PERM = true;
    const float* qn; const float* kn; bf16* QKV; LAS float* xbuf;
    __device__ __forceinline__ void operator()(const f32x4 (&acc)[2][2][4][2], const g8::Unit& u, int wr, int wc, int fr, int fq) const {
        const int which = u.pn >> 2, wid = wr * 4 + wc;
        float rs[2][4][2];
        if (which < 2) {
#pragma unroll
            for (int ai = 0; ai < 2; ++ai)
#pragma unroll
                for (int m = 0; m < 4; ++m)
#pragma unroll
                    for (int bj = 0; bj < 2; ++bj) { float ss = 0.f;
#pragma unroll
                        for (int n = 0; n < 2; ++n)
#pragma unroll
                            for (int j = 0; j < 4; ++j) ss += acc[ai][bj][m][n][j] * acc[ai][bj][m][n][j];
                        ss += __shfl_xor(ss, 16); ss += __shfl_xor(ss, 32);
                        rs[ai][m][bj] = ss;
                        if (fq == 0) xbuf[(wid * 16 + (ai * 4 + m) * 2 + bj) * 16 + fr] = ss; }
        }
        asm volatile("s_waitcnt lgkmcnt(0)" ::: "memory");
        __builtin_amdgcn_s_barrier();
        asm volatile("" ::: "memory");
        const float* nwp = which == 0 ? qn : kn;
        const int hc = (wc & 1) * 32 + 8 * fq;
#pragma unroll
        for (int ai = 0; ai < 2; ++ai)
#pragma unroll
            for (int m = 0; m < 4; ++m) { const int row = u.pm * 256 + ai * 128 + wr * 64 + m * 16 + fr;
                bf16* rowp = QKV + (size_t)row * 3072 + u.pn * 256 + wc * 32 + 8 * fq;
#pragma unroll
                for (int bj = 0; bj < 2; ++bj) { f32x4 v0 = acc[ai][bj][m][0], v1 = acc[ai][bj][m][1];
                    if (which < 2) {
                        const float tot = rs[ai][m][bj] + xbuf[((wid ^ 1) * 16 + (ai * 4 + m) * 2 + bj) * 16 + fr];
                        const float sc = rsqrtf(tot * (1.f / 64.f) + 1e-6f) * (which == 0 ? 0.125f : 1.f);
                        const f32x4 w0 = *(const f32x4*)(nwp + hc), w1 = *(const f32x4*)(nwp + hc + 4);
#pragma unroll
                        for (int j = 0; j < 4; ++j) { v0[j] *= sc * w0[j]; v1[j] *= sc * w1[j]; } }
                    u32x4 o; o[0] = pk2(v0[0], v0[1]); o[1] = pk2(v0[2], v0[3]); o[2] = pk2(v1[0], v1[1]); o[3] = pk2(v1[2], v1[3]);
                    *(u32x4*)(rowp + bj * 128) = o; } }
    }
};
template <int NB>
__device__ __forceinline__ void phase_qkv8(const bf16* H, const bf16* Wt, const float* qn, const float* kn, bf16* QKV, LAS unsigned char* lds) {
    constexpr int T = NB * (SEQ + CTXL), MT = T / 256, U = MT * 12;
    const int G = gridDim.x, F = U / G, R = U - F * G;
    if (F > 0) { g8::DenseSched S{H, D, Wt, D, MT, 12, F}; EpiQKV8 E{qn, kn, QKV, (LAS float*)(lds + g8::STAGE_BYTES)}; g8::gemm_phase(lds, D, S, E); }
    for (int r = 0; r * G < 2 * R; ++r) {
        const int hu = r * G + (int)blockIdx.x; if (hu >= 2 * R) continue;
        int mt, nt2; unit_tile(F * G + (hu >> 1), MT, 12, mt, nt2);
        const int nt = 2 * nt2 + (hu & 1);
        const bf16* arow[4];
#pragma unroll
        for (int i = 0; i < 4; ++i) arow[i] = H + (size_t)(mt * 256 + (otid() >> 3) + 64 * i) * D;
        gemm_tile(arow, Wt + (size_t)nt * 128 * D, D, D, lds, [&](const f32x16 (&acc)[2][2], int wm, int wn, int lane) {
            const int which = nt >> 3;
#pragma unroll
            for (int mi = 0; mi < 2; ++mi) {
                float rsv = 1.f;
                if (which < 2) { float ss = 0.f;
#pragma unroll
                    for (int ni = 0; ni < 2; ++ni)
#pragma unroll
                        for (int q = 0; q < 16; ++q) ss += acc[mi][ni][q] * acc[mi][ni][q];
                    ss += __shfl_xor(ss, 32);
                    rsv = rsqrtf(ss * (1.f / 64.f) + 1e-6f) * (which == 0 ? 0.125f : 1.f); }
                const float* nwp = which == 0 ? qn : kn;
                LAS unsigned char* rp = lds + (wm * 64 + mi * 32 + (lane & 31)) * CST_BF + (wn * 64 + 4 * (lane >> 5)) * 2;
#pragma unroll
                for (int ni = 0; ni < 2; ++ni)
#pragma unroll
                    for (int g = 0; g < 4; ++g) { float v[4];
#pragma unroll
                        for (int j = 0; j < 4; ++j) { v[j] = acc[mi][ni][4 * g + j]; if (which < 2) v[j] *= rsv * nwp[ni * 32 + 8 * g + 4 * (lane >> 5) + j]; }
                        u32x2 o; o[0] = pk2(v[0], v[1]); o[1] = pk2(v[2], v[3]); *(LAS u32x2*)(rp + (ni * 32 + 8 * g) * 2) = o; } }
        });
        __syncthreads();
        flush_bf16_128(lds, [&](int rr) { return QKV + (size_t)(mt * 256 + rr) * 3072 + nt * 128; });
        __syncthreads();
    }
}
}
#define XB_TMO      128
#define XB_XCNT(j)  (256  + 64 * (j))
#define XB_XSUB(j)  (1280 + 64 * (j))
#define XB_XGEN(j)  (2304 + 64 * (j))
#define XB_TOP      3328
#define XB_TOPGEN   3392
#define XCD_BAR_WORDS 3456
#define XB_SPIN_CAP (1u << 18)

__device__ __forceinline__ unsigned xb_ld(unsigned* p)              { return __hip_atomic_load(p, __ATOMIC_RELAXED, __HIP_MEMORY_SCOPE_AGENT); }
__device__ __forceinline__ unsigned xb_add(unsigned* p, unsigned v) { return __hip_atomic_fetch_add(p, v, __ATOMIC_RELAXED, __HIP_MEMORY_SCOPE_AGENT); }
__device__ __forceinline__ unsigned xb_xcc_id() { return (unsigned)__builtin_amdgcn_s_getreg((3 << 11) | 20) & 0xFu; }
#define XB_SPIN(cond, bar) do { unsigned _sp = 0; while (cond) { __builtin_amdgcn_s_sleep(1); \
    if ((++_sp & 255u) == 0u) { if (xb_ld(&(bar)[XB_TMO])) break; if (_sp > XB_SPIN_CAP) { atomicAdd(&(bar)[XB_TMO], 1u); break; } } } } while (0)

struct XcdBarrier {
    unsigned* bar; unsigned x;
    volatile LAS unsigned* st;
};

__device__ __forceinline__ XcdBarrier xcd_barrier_post(unsigned* bar, volatile LAS unsigned* st) {
    XcdBarrier b; b.bar = bar; b.x = xb_xcc_id(); b.st = st;
    if (threadIdx.x == 0) (void)xb_add(&bar[XB_XCNT(b.x)], 1u);
    return b;
}
__device__ __forceinline__ void xcd_barrier_complete(unsigned* bar, unsigned x, unsigned& nloc, unsigned& nx) {
    const unsigned G = gridDim.x * gridDim.y * gridDim.z;
    unsigned sum, cnt, mine, sp = 0u;
    for (;;) {
        sum = 0u; cnt = 0u; mine = 0u;
#pragma unroll
        for (unsigned j = 0; j < 16; ++j) { const unsigned c = xb_ld(&bar[XB_XCNT(j)]); sum += c; cnt += (c > 0u) ? 1u : 0u; mine = (j == x) ? c : mine; }
        if (sum == G) break;
        __builtin_amdgcn_s_sleep(1);
        if ((++sp & 255u) == 0u) { if (xb_ld(&bar[XB_TMO])) break; if (sp > XB_SPIN_CAP) { atomicAdd(&bar[XB_TMO], 1u); break; } }
    }
    nloc = mine > 0u ? mine : 1u; nx = cnt > 0u ? cnt : 1u;
}

__device__ __forceinline__ void xcd_barrier(const XcdBarrier& b) {
    asm volatile("s_waitcnt vmcnt(0)" ::: "memory");
    __syncthreads();
    if (threadIdx.x == 0) {
        unsigned* bar = b.bar;
        __builtin_amdgcn_s_waitcnt(0);
        unsigned nloc = b.st[0], nx = b.st[1];
        if (nloc == 0u) { xcd_barrier_complete(bar, b.x, nloc, nx); b.st[0] = nloc; b.st[1] = nx; }
        const unsigned old = xb_add(&bar[XB_XSUB(b.x)], 1u);
        const unsigned gen = old / nloc;
        if (old + 1u == (gen + 1u) * nloc) {
            __builtin_amdgcn_fence(__ATOMIC_RELEASE, "agent");
            asm volatile("s_waitcnt vmcnt(0)" ::: "memory");
            const unsigned og = xb_add(&bar[XB_TOP], 1u);
            const unsigned tg = og / nx;
            if (og + 1u == (tg + 1u) * nx) xb_add(&bar[XB_TOPGEN], 1u);
            else XB_SPIN(xb_ld(&bar[XB_TOPGEN]) == tg, bar);
            __builtin_amdgcn_fence(__ATOMIC_ACQUIRE, "agent");
            xb_add(&bar[XB_XGEN(b.x)], 1u);
            asm volatile("s_waitcnt vmcnt(0)" ::: "memory");
        } else {
            XB_SPIN(xb_ld(&bar[XB_XGEN(b.x)]) == gen, bar);
            __builtin_amdgcn_fence(__ATOMIC_ACQUIRE, "agent");
            asm volatile("s_waitcnt vmcnt(0)" ::: "memory");
        }
    }
    __syncthreads();
}
namespace mk {
using namespace fx;
constexpr int NB = 4;
typedef Plan<NB> PL;

__global__ void __launch_bounds__(512, 2) k_mega(P p) {
    extern __shared__ __attribute__((aligned(16))) unsigned char lds_raw[];
    LAS unsigned char* lds = (LAS unsigned char*)lds_raw;
    unsigned char* ws = p.ws;
    const In& in = p.in;
    LAS unsigned* xbw = (LAS unsigned*)(lds + LDS_BYTES - 16);
    if (threadIdx.x == 0) { xbw[0] = 0u; xbw[1] = 0u; xbw[2] = 0u; xbw[3] = 0u; }
    __syncthreads();
    XcdBarrier bar = xcd_barrier_post((unsigned*)(ws + PL::CTL_BAR), (volatile LAS unsigned*)xbw);
    float* modv = (float*)(ws + PL::MODV);
    const float* mod0 = modv; const float* mod1 = modv + 5 * 6144;
    bf16* H = (bf16*)(ws + PL::H);
    int* cnt0 = (int*)(ws + PL::CTL_CNT); int* cnt1 = cnt0 + 32 * 64;
    int* list = (int*)(ws + PL::LIST); float* rw = (float*)(ws + PL::RW);
    bf16* wmoe0 = (bf16*)(ws + PL::W_MOE0); bf16* wmoe1 = (bf16*)(ws + PL::W_MOE1);
    const size_t GU = (size_t)32 * 1024 * 1024;
    float* X1 = (float*)(ws + PL::X1); float* X2 = (float*)(ws + PL::X2); float* X3 = (float*)(ws + PL::X3);
#ifndef MOE1_EARLY
#define MOE1_EARLY 1792
#endif
#ifndef REPMASK
#define REPMASK 0
#endif
#ifndef XBAR
#define XBAR 0
#endif
#define PH(k, ...) { __VA_ARGS__; xcd_barrier(bar); if ((REPMASK >> (k)) & 1) { __VA_ARGS__; xcd_barrier(bar); } }
    PH(0, conv_small_weights(in, ws, PL::W_IN, PL::W_OUT, PL::W_QKV, PL::W_NAO, lds); mod_vectors(in, modv, lds); conv_moe_weights(in, 0, wmoe0, wmoe0 + GU, lds))
    for (int i = 0; i < XBAR; ++i) xcd_barrier(bar);
    PH(1, rows_phase<NB, false, false, true, false>(in.x, in.ctx, PL::T, nullptr, mod0, mod0, nullptr, nullptr, in.norm1_w, 0, 1, H,
                                              nullptr, nullptr, nullptr, nullptr, nullptr, nullptr, nullptr, 0, lds))
    phase_inproj8<NB>(H, (const bf16*)(ws + PL::W_IN), (bf16*)(ws + PL::PROJ), (float*)(ws + PL::GATES), lds);
    xcd_barrier(bar);
#ifdef GVAR
    phase_inproj_v<NB, GVAR>(H, (const bf16*)(ws + PL::W_IN), (bf16*)(ws + PL::PROJ), (float*)(ws + PL::GATES), lds, p.out == nullptr);
    xcd_barrier(bar);
#endif
    PH(3, phase_tables<NB>(in, (const float*)(ws + PL::GATES), ws + PL::H, lds); phase_conv<NB>((const bf16*)(ws + PL::PROJ), in.ab_conv_w, in.ab_conv_b, (bf16*)(ws + PL::XBC)))
    phase_scan<NB>((const bf16*)(ws + PL::PROJ), ws + PL::H, (const bf16*)(ws + PL::XBC), (bf16*)(ws + PL::SC), lds);
    xcd_barrier(bar);
#ifdef SCANMODE
    phase_scan<NB>((const bf16*)(ws + PL::PROJ), ws + PL::H, (const bf16*)(ws + PL::XBC), (bf16*)(ws + PL::SC), lds, p.out ? SCANMODE : 3);
    xcd_barrier(bar);
#endif
#ifdef REP5
    phase_mixer_out<NB>(in, (const bf16*)(ws + PL::PROJ), (const bf16*)(ws + PL::XBC), (bf16*)(ws + PL::SC), (bf16*)(ws + PL::W_MOE1));
    xcd_barrier(bar);
#endif
    phase_mixer_out<NB>(in, (const bf16*)(ws + PL::PROJ), (const bf16*)(ws + PL::XBC), (bf16*)(ws + PL::SC));
    xcd_barrier(bar);
    PH(6, phase_outproj8<NB>((const bf16*)(ws + PL::SC), 4096, 2048, (const bf16*)(ws + PL::W_OUT), PL::T, in.x, in.ctx, mod0, X1, lds,
        [&](int rank, int nidle) { conv_moe_weights(in, 1, wmoe1, wmoe1 + GU, lds, 0, MOE1_EARLY, rank, nidle); }))
    rows_phase<NB, false, false, true, true>(X1, X1 + PL::TL * D, PL::T, nullptr, mod0, mod0, nullptr, nullptr, in.norm2_w, 3, 4, H,
        in.moe_w_group, in.moe_b_group, in.moe_w_expert, in.moe_b_expert, rw, cnt0, list, (int)PL::T, lds);
    PH(7, conv_moe_weights(in, 1, wmoe1, wmoe1 + GU, lds, MOE1_EARLY, MOE_CONV_UNITS))
    PH(8, phase_moe_up8(H, wmoe0, cnt0, list, (int)PL::T, rw, (bf16*)(ws + PL::ACT), lds))
    PH(9, phase_moe_down8((const bf16*)(ws + PL::ACT), wmoe0 + GU, cnt0, list, (int)PL::T, (bf16*)(ws + PL::Y2), lds))
    PH(10, rows_phase<NB, true, true, true, false>(X1, X1 + PL::TL * D, PL::T, (const bf16*)(ws + PL::Y2), mod0, mod1, X2, nullptr, in.norm1_w + 1024, 0, 1, H,
        nullptr, nullptr, nullptr, nullptr, nullptr, nullptr, nullptr, 0, lds))
    PH(11, phase_qkv8<NB>(H, (const bf16*)(ws + PL::W_QKV), in.na_q_norm, in.na_k_norm, (bf16*)(ws + PL::QKV), lds))
    PH(12, phase_attn<NB>((const bf16*)(ws + PL::QKV), in.na_rpb, (bf16*)(ws + PL::AO), lds))
    PH(13, phase_outproj8<NB>((const bf16*)(ws + PL::AO), 1024, 1024, (const bf16*)(ws + PL::W_NAO), PL::TL, X2, X2 + PL::TL * D, mod1, X3, lds, [](int, int) {}))
    rows_phase<NB, false, false, true, true>(X3, X3, PL::TL, nullptr, mod1, mod1, nullptr, nullptr, in.norm2_w + 1024, 3, 4, H,
        in.moe_w_group + 1024 * 4, in.moe_b_group + 4, in.moe_w_expert + 1024 * 32, in.moe_b_expert + 32, rw, cnt1, list, (int)PL::T, lds);
    xcd_barrier(bar);
    PH(15, phase_moe_up8(H, wmoe1, cnt1, list, (int)PL::T, rw, (bf16*)(ws + PL::ACT), lds))
    PH(16, phase_moe_down8((const bf16*)(ws + PL::ACT), wmoe1 + GU, cnt1, list, (int)PL::T, (bf16*)(ws + PL::Y2), lds))
    rows_phase<NB, true, false, false, false>(X3, X3, PL::TL, (const bf16*)(ws + PL::Y2), mod1, mod1, nullptr, p.out, nullptr, 0, 0, nullptr,
        nullptr, nullptr, nullptr, nullptr, nullptr, nullptr, nullptr, 0, lds);
    if ((REPMASK >> 17) & 1) { xcd_barrier(bar); rows_phase<NB, true, false, false, false>(X3, X3, PL::TL, (const bf16*)(ws + PL::Y2), mod1, mod1, nullptr, p.out, nullptr, 0, 0, nullptr,
        nullptr, nullptr, nullptr, nullptr, nullptr, nullptr, nullptr, 0, lds); }
#undef PH
}
__global__ void k_fill(float* q, size_t n, float v) { size_t i = (size_t)blockIdx.x * 256 + threadIdx.x; if (i < n) q[i] = v; }
}

extern "C" void kernel_launch(void* const* d_in, const int* in_sizes, int n_in, void* d_out, int out_size, void* d_ws, size_t ws_size, hipStream_t stream) {
    static int grid = 0;
    if (grid == 0) {
        int dev = 0, cus = 0, per_cu = 0;
        (void)hipGetDevice(&dev);
        (void)hipDeviceGetAttribute(&cus, hipDeviceAttributeMultiprocessorCount, dev);
        if (hipFuncSetAttribute((const void*)mk::k_mega, hipFuncAttributeMaxDynamicSharedMemorySize, fx::LDS_BYTES) != hipSuccess) { grid = -1; }
        else {
            if (hipOccupancyMaxActiveBlocksPerMultiprocessor(&per_cu, (const void*)mk::k_mega, 512, fx::LDS_BYTES) != hipSuccess) per_cu = 0;
            (void)hipGetLastError();
            grid = per_cu >= 1 ? cus : -1;
        }
    }
    if (grid < 0 || n_in != 31 || mk::PL::END > ws_size) { mk::k_fill<<<(out_size + 255) / 256, 256, 0, stream>>>((float*)d_out, (size_t)out_size, 2.f); return; }
    (void)hipMemsetAsync((unsigned char*)d_ws + mk::PL::CTL, 0, mk::PL::CTL_BYTES, stream);
    fx::P fp;
    { const float** q = (const float**)&fp.in; for (int i = 0; i < 31; ++i) q[i] = (const float*)d_in[i]; }
    fp.ws = (unsigned char*)d_ws; fp.out = (float*)d_out;
    hipLaunchKernelGGL(mk::k_mega, dim3(grid), dim3(512), fx::LDS_BYTES, stream, fp);
}
```

```cpp
#include <hip/hip_runtime.h>
#include <cstdio>
#include <cstdint>
namespace fx {
#define LAS __attribute__((address_space(3)))
typedef unsigned short bf16;
typedef short bf16x8 __attribute__((ext_vector_type(8)));
typedef short bf16x4 __attribute__((ext_vector_type(4)));
typedef float f32x16 __attribute__((ext_vector_type(16)));
typedef float f32x4 __attribute__((ext_vector_type(4)));
typedef unsigned u32x4 __attribute__((ext_vector_type(4)));
typedef unsigned u32x2 __attribute__((ext_vector_type(2)));
constexpr int NTHR = 512, NWAVE = 8;
constexpr int D = 1024, SEQ = 4096, CTXL = 256;
constexpr int PROJW = 5632, NIN = 5760;
constexpr int PC_Z = 0, PC_XBC = 1024, PC_Q = 2560, PC_K = 3072, PC_V = 3584, PC_O = 4608;
constexpr int LDS_BYTES = 152 * 1024;

__device__ __forceinline__ int otid() { int t = threadIdx.x; asm volatile("" : "+v"(t)); return t; }
__device__ __forceinline__ float bf2f(bf16 v) { return __uint_as_float((unsigned)v << 16); }
__device__ __forceinline__ float bflo(unsigned u) { return __uint_as_float(u << 16); }
__device__ __forceinline__ float bfhi(unsigned u) { return __uint_as_float(u & 0xffff0000u); }
typedef __bf16 bf16x2_t __attribute__((ext_vector_type(2)));
typedef float f32x2_t __attribute__((ext_vector_type(2)));
__device__ __forceinline__ unsigned pk2(float lo, float hi) { const f32x2_t v = {lo, hi}; return __builtin_bit_cast(unsigned, __builtin_convertvector(v, bf16x2_t)); }
__device__ __forceinline__ float siluf(float v) { return v / (1.f + __expf(-v)); }
__device__ __forceinline__ float sigmf(float v) { return 1.f / (1.f + __expf(-v)); }
__device__ __forceinline__ float softplusf(float v) { return v > 20.f ? v : log1pf(__expf(v)); }
__device__ __forceinline__ float logsigf(float v) { return fminf(v, 0.f) - log1pf(__expf(-fabsf(v))); }
__device__ __forceinline__ float wave_sum(float v) {
#pragma unroll
    for (int o = 32; o > 0; o >>= 1) v += __shfl_xor(v, o);
    return v;
}
__device__ __forceinline__ float wave_max(float v) {
#pragma unroll
    for (int o = 32; o > 0; o >>= 1) v = fmaxf(v, __shfl_xor(v, o));
    return v;
}
__device__ __forceinline__ f32x16 mfma32(bf16x8 a, bf16x8 b, f32x16 c) { return __builtin_amdgcn_mfma_f32_32x32x16_bf16(a, b, c, 0, 0, 0); }
__device__ __forceinline__ f32x4 mfma16(bf16x8 a, bf16x8 b, f32x4 c) { return __builtin_amdgcn_mfma_f32_16x16x32_bf16(a, b, c, 0, 0, 0); }

__device__ __forceinline__ bf16x8 frag_row(const LAS unsigned char* T, int RS, int r0, int k0, int lane) {
    return *(const LAS bf16x8*)(T + (r0 + (lane & 31)) * RS + (k0 + 8 * (lane >> 5)) * 2);
}
__device__ __forceinline__ bf16x8 frag_col(const LAS unsigned char* T, int RS, int k0, int c0, int lane) {
    const int h = lane >> 5, blk = (lane >> 4) & 1, q = (lane & 15) >> 2, p = lane & 3;
    const unsigned a0 = (unsigned)(size_t)(T + (k0 + 8 * h + q) * RS + (c0 + 16 * blk + 4 * p) * 2);
    const unsigned a1 = a0 + 4 * RS;
    bf16x4 v0, v1;
    asm volatile("ds_read_b64_tr_b16 %0, %2\n\tds_read_b64_tr_b16 %1, %3\n\ts_waitcnt lgkmcnt(0)" : "=&v"(v0), "=&v"(v1) : "v"(a0), "v"(a1) : "memory");
    bf16x8 r; r[0] = v0[0]; r[1] = v0[1]; r[2] = v0[2]; r[3] = v0[3]; r[4] = v1[0]; r[5] = v1[1]; r[6] = v1[2]; r[7] = v1[3];
    return r;
}

struct In {
    const float *x, *c, *ctx, *c_ctx, *norm1_w, *norm2_w, *mod_w, *mod_b, *ab_w_in, *ab_conv_w, *ab_conv_b, *ssd_a_log, *ssd_dt_bias, *ssd_d,
        *ssd_norm_w, *ml_i_bias, *ml_f_bias, *ml_norm_w, *ab_w_out, *na_w_qkv, *na_q_norm, *na_k_norm, *na_rpb, *na_w_out,
        *moe_w_group, *moe_b_group, *moe_w_expert, *moe_b_expert, *moe_w_gate, *moe_w_up, *moe_w_down;
};

constexpr size_t cmax(size_t a, size_t b) { return a > b ? a : b; }
constexpr size_t al256(size_t x) { return (x + 255) & ~(size_t)255; }

template <int NB> struct Plan {
    static constexpr size_t TL = (size_t)NB * SEQ, TC = (size_t)NB * CTXL, T = TL + TC;
    static constexpr size_t CTL = 0;
    static constexpr size_t CTL_BAR = 0, CTL_CNT = 16384  , CTL_BYTES = 32768;
    static constexpr size_t MODV = CTL + CTL_BYTES;
    static constexpr size_t RW = MODV + al256(2 * 5 * 6144 * 4);
    static constexpr size_t LIST = RW + al256(2 * T * 4);
    static constexpr size_t W_IN = LIST + al256(32 * T * 4);
    static constexpr size_t W_OUT = W_IN + (size_t)NIN * 1024 * 2;
    static constexpr size_t W_QKV = W_OUT + (size_t)1024 * 2048 * 2;
    static constexpr size_t W_NAO = W_QKV + (size_t)3072 * 1024 * 2;
    static constexpr size_t ARENA = W_NAO + (size_t)1024 * 1024 * 2;
    static constexpr size_t MOEW = (size_t)32 * 1024 * 1024 * 2 + (size_t)32 * 1024 * 512 * 2;
    static constexpr size_t SZ_B = al256(T * 1024 * 2);
    static constexpr size_t SZ_A = al256(cmax(MOEW, cmax(T * 3072 * 2, T * 1024 * 4)));
    static constexpr size_t SZ_X = al256(T * 1024 * 4);
    static constexpr size_t SZ_C = al256(cmax(T * PROJW * 2 + T * 64 * 4, SZ_X + MOEW));
    static constexpr size_t SZ_D = al256(T * 1536 * 2);
    static constexpr size_t SZ_E = al256(T * 4096 * 2);
    static constexpr size_t RB = ARENA, RA = RB + SZ_B, RC = RA + SZ_A, RD = RC + SZ_C, RE = RD + SZ_D, END = RE + SZ_E;
    static constexpr size_t H = RB;
    static constexpr size_t W_MOE0 = RA;
    static constexpr size_t QKV = RA;
    static constexpr size_t X3 = RA;
    static constexpr size_t PROJ = RC;
    static constexpr size_t GATES = RC + T * PROJW * 2;
    static constexpr size_t X1 = RC;
    static constexpr size_t W_MOE1 = RC + SZ_X;
    static constexpr size_t XBC = RD;
    static constexpr size_t ACT = RD;
    static constexpr size_t AO = RD;
    static constexpr size_t SC = RE;
    static constexpr size_t Y2 = RE;
    static constexpr size_t X2 = RE + al256(2 * T * 1024 * 2);
    static_assert(2 * T * 1024 * 2 + T * 1024 * 4 <= SZ_E, "E");
    static_assert(T * 3072 * 2 <= SZ_A + SZ_X, "QKV spill");
};

struct P { In in; unsigned char* ws; float* out; };

template <int NB> __device__ __forceinline__ int mod_row(int row) { return row < NB * SEQ ? row / SEQ : 4; }

template <class ColPtr>
__device__ __forceinline__ void tconv_unit(ColPtr colptr, int ld_src, bf16* dst, int K, int k0, int n0, int ndst, LAS unsigned char* lds) {
    LAS float* tl = (LAS float*)lds;
    const int tid = otid();
    {
        const int n4 = (tid & 63) * 4, kb = tid >> 6;
        const float* sp = colptr(n0 + n4);
        f32x4 v[8];
#pragma unroll
        for (int i = 0; i < 8; ++i) v[i] = sp ? *(const f32x4*)(sp + (size_t)(k0 + kb + 8 * i) * ld_src) : (f32x4){0.f, 0.f, 0.f, 0.f};
#pragma unroll
        for (int i = 0; i < 8; ++i) *(LAS f32x4*)(tl + (kb + 8 * i) * 260 + n4) = v[i];
    }
    __syncthreads();
    {
        const int n = tid >> 1, half = tid & 1;
        if (n0 + n < ndst) {
            float v[32];
#pragma unroll
            for (int j = 0; j < 32; ++j) v[j] = tl[(half * 32 + j) * 260 + n];
            bf16* dp = dst + (size_t)(n0 + n) * K + k0 + half * 32;
#pragma unroll
            for (int q = 0; q < 4; ++q) { u32x4 o; o[0] = pk2(v[8 * q], v[8 * q + 1]); o[1] = pk2(v[8 * q + 2], v[8 * q + 3]); o[2] = pk2(v[8 * q + 4], v[8 * q + 5]); o[3] = pk2(v[8 * q + 6], v[8 * q + 7]);
                *(u32x4*)(dp + 8 * q) = o; }
        }
    }
    __syncthreads();
}

__device__ __forceinline__ int map_in(int n) { return n < 2560 ? n : (n < 5632 ? n + 32 : (n < 5664 ? n - 3072 : (n < 5680 ? n : -1))); }

__device__ __forceinline__ void conv_small_weights(const In& in, unsigned char* ws, size_t o_in, size_t o_out, size_t o_qkv, size_t o_nao, LAS unsigned char* lds) {
    const int total = 368 + 128 + 192 + 64;
    for (int u = blockIdx.x; u < total; u += gridDim.x) {
        if (u < 368) { const int kt = u % 16, nt = u / 16; const float* w = in.ab_w_in;
            tconv_unit([&](int n) -> const float* { const int c = n < NIN ? map_in(n) : -1; return c >= 0 ? w + c : nullptr; }, 5680, (bf16*)(ws + o_in), 1024, kt * 64, nt * 256, NIN, lds); }
        else if (u < 496) { const int v = u - 368, kt = v % 32, nt = v / 32; const float* w = in.ab_w_out;
            tconv_unit([&](int n) { return w + n; }, 1024, (bf16*)(ws + o_out), 2048, kt * 64, nt * 256, 1024, lds); }
        else if (u < 688) { const int v = u - 496, kt = v % 16, nt = v / 16; const float* w = in.na_w_qkv;
            tconv_unit([&](int n) { return w + n; }, 3072, (bf16*)(ws + o_qkv), 1024, kt * 64, nt * 256, 3072, lds); }
        else { const int v = u - 688, kt = v % 16, nt = v / 16; const float* w = in.na_w_out;
            tconv_unit([&](int n) { return w + n; }, 1024, (bf16*)(ws + o_nao), 1024, kt * 64, nt * 256, 1024, lds); }
    }
}

constexpr int MOE_CONV_UNITS = 3072;
__device__ __forceinline__ void conv_moe_weights(const In& in, int layer, bf16* wgu, bf16* wd, LAS unsigned char* lds, int begin = 0, int end = MOE_CONV_UNITS, int rank = -1, int stride = 0) {
    if (rank < 0) { rank = blockIdx.x; stride = gridDim.x; }
    const size_t wsz = (size_t)1024 * 512;
    for (int u = begin + rank; u < end; u += stride) {
        if (u < 2048) {
            const int e = u >> 6, v = u & 63, kt = v & 15, nt = v >> 4;
            const float* g = in.moe_w_gate + ((size_t)layer * 32 + e) * wsz; const float* up = in.moe_w_up + ((size_t)layer * 32 + e) * wsz;
            tconv_unit([&](int n) { const int f = (n >> 8) * 128 + (n & 127); return ((n & 128) ? up : g) + f; }, 512, wgu + (size_t)e * 1024 * 1024, 1024, kt * 64, nt * 256, 1024, lds);
        } else {
            const int w = u - 2048, e = w >> 5, v = w & 31, kt = v & 7, nt = v >> 3;
            const float* dsrc = in.moe_w_down + ((size_t)layer * 32 + e) * wsz;
            tconv_unit([&](int n) { return dsrc + n; }, 1024, wd + (size_t)e * 1024 * 512, 512, kt * 64, nt * 256, 1024, lds);
        }
    }
}

__device__ __forceinline__ void mod_vectors(const In& in, float* modv, LAS unsigned char* lds) {
    LAS float* sc = (LAS float*)lds;
    LAS float* red = sc + 5 * 1024;
    const int tid = otid();
    for (int i = tid; i < 5 * 1024; i += NTHR) { const int r = i >> 10, k = i & 1023; const float v = r < 4 ? in.c[r * 1024 + k] : in.c_ctx[k]; sc[i] = siluf(v); }
    __syncthreads();
    const int col = tid & 31, kq = tid >> 5;
    for (int u = blockIdx.x; u < 2 * 192; u += gridDim.x) {
        const int layer = u / 192, c0 = (u % 192) * 32;
        const float* w = in.mod_w + (size_t)layer * 1024 * 6144 + c0 + col;
        float a0 = 0.f, a1 = 0.f, a2 = 0.f, a3 = 0.f, a4 = 0.f;
#pragma unroll 8
        for (int j = 0; j < 64; ++j) { const int k = kq + 16 * j; const float wv = w[(size_t)k * 6144];
            a0 += sc[k] * wv; a1 += sc[1024 + k] * wv; a2 += sc[2048 + k] * wv; a3 += sc[3072 + k] * wv; a4 += sc[4096 + k] * wv; }
        red[(0 * 16 + kq) * 32 + col] = a0; red[(1 * 16 + kq) * 32 + col] = a1; red[(2 * 16 + kq) * 32 + col] = a2;
        red[(3 * 16 + kq) * 32 + col] = a3; red[(4 * 16 + kq) * 32 + col] = a4;
        __syncthreads();
        if (tid < 160) { const int r = tid >> 5, cc = tid & 31; float s = 0.f;
#pragma unroll
            for (int q = 0; q < 16; ++q) s += red[(r * 16 + q) * 32 + cc];
            modv[((size_t)layer * 5 + r) * 6144 + c0 + cc] = s + in.mod_b[layer * 6144 + c0 + cc]; }
        __syncthreads();
    }
}

template <int NB, bool COMBINE, bool XOUT, bool NORM, bool ROUTER, bool XBF = false>
__device__ __forceinline__ void rows_phase(const float* xl, const float* xc, int nrows, const bf16* y2, const float* modc  , const float* modl  ,
                                           float* xout, float* out_final, const float* nw, int shift_i, int scale_i, bf16* hout,
                                           const float* wg, const float* bg, const float* we, const float* be, float* route_w, int* cnt, int* list, int cap,
                                           LAS unsigned char* lds) {
    constexpr int TL = NB * SEQ;
    const int tid = otid(), lane = tid & 63, wave = tid >> 6;
    LAS float* wt = (LAS float*)lds;
    constexpr int WTS = 1028;
    LAS int* lcnt = (LAS int*)(lds + 36 * WTS * 4); LAS int* lbase = lcnt + 32; LAS int* rinfo = lcnt + 64;
    if (ROUTER) {
        if (tid < 32) lcnt[tid] = 0;
        for (int i = tid; i < 4 * 1024; i += NTHR) wt[(i & 3) * WTS + (i >> 2)] = wg[i];
        for (int i = tid; i < 32 * 1024; i += NTHR) wt[(4 + (i & 31)) * WTS + (i >> 5)] = we[i];
        __syncthreads();
    }
    int lrow = wave;
    for (int row = blockIdx.x * NWAVE + wave; row < nrows; row += gridDim.x * NWAVE, lrow += NWAVE) {
        const size_t soff = row < TL ? (size_t)row * D : (size_t)(row - TL) * D;
        const float* src = (row < TL ? xl : xc) + (XBF ? 0 : soff);
        const float* mv = modl + (size_t)mod_row<NB>(row) * 6144;
        const float* mvc = modc + (size_t)mod_row<NB>(row) * 6144;
        f32x4 v[4];
#pragma unroll
        for (int i = 0; i < 4; ++i) {
            if (XBF) { const u32x2 t2 = *(const u32x2*)((const bf16*)src + soff + lane * 4 + 256 * i); v[i] = (f32x4){bflo(t2[0]), bfhi(t2[0]), bflo(t2[1]), bfhi(t2[1])}; }
            else v[i] = *(const f32x4*)(src + lane * 4 + 256 * i); }
        if (COMBINE) {
#pragma unroll
            for (int i = 0; i < 4; ++i) { const int c = lane * 4 + 256 * i;
                const u32x2 ya = *(const u32x2*)(y2 + (size_t)(2 * row) * D + c), yb = *(const u32x2*)(y2 + (size_t)(2 * row + 1) * D + c);
                const f32x4 m5 = *(const f32x4*)(mvc + 5 * 1024 + c);
                v[i][0] += m5[0] * (bflo(ya[0]) + bflo(yb[0])); v[i][1] += m5[1] * (bfhi(ya[0]) + bfhi(yb[0]));
                v[i][2] += m5[2] * (bflo(ya[1]) + bflo(yb[1])); v[i][3] += m5[3] * (bfhi(ya[1]) + bfhi(yb[1])); }
            if (XOUT) {
#pragma unroll
                for (int i = 0; i < 4; ++i) {
                    if (XBF) { u32x2 o2; o2[0] = pk2(v[i][0], v[i][1]); o2[1] = pk2(v[i][2], v[i][3]); *(u32x2*)((bf16*)xout + (size_t)row * D + lane * 4 + 256 * i) = o2;
                        v[i] = (f32x4){bflo(o2[0]), bfhi(o2[0]), bflo(o2[1]), bfhi(o2[1])}; }
                    else *(f32x4*)(xout + (size_t)row * D + lane * 4 + 256 * i) = v[i]; } }
            if (out_final) {
#pragma unroll
                for (int i = 0; i < 4; ++i) *(f32x4*)(out_final + (size_t)row * D + lane * 4 + 256 * i) = v[i]; }
        }
        if (NORM) {
            float ss = 0.f;
#pragma unroll
            for (int i = 0; i < 4; ++i) ss += v[i][0] * v[i][0] + v[i][1] * v[i][1] + v[i][2] * v[i][2] + v[i][3] * v[i][3];
            ss = wave_sum(ss);
            const float rs = rsqrtf(ss * (1.f / D) + 1e-6f);
            f32x4 hv[4];
#pragma unroll
            for (int i = 0; i < 4; ++i) { const int c = lane * 4 + 256 * i;
                const f32x4 w4 = *(const f32x4*)(nw + c), sc4 = *(const f32x4*)(mv + scale_i * 1024 + c), sh4 = *(const f32x4*)(mv + shift_i * 1024 + c);
#pragma unroll
                for (int j = 0; j < 4; ++j) hv[i][j] = v[i][j] * rs * w4[j] * (1.f + sc4[j]) + sh4[j];
                u32x2 o; o[0] = pk2(hv[i][0], hv[i][1]); o[1] = pk2(hv[i][2], hv[i][3]);
                *(u32x2*)(hout + (size_t)row * D + c) = o; }
            if (ROUTER) {
                float lg[4];
#pragma unroll
                for (int j = 0; j < 4; ++j) { float a = 0.f;
#pragma unroll
                    for (int i = 0; i < 4; ++i) { const f32x4 w4 = *(const LAS f32x4*)(wt + j * WTS + lane * 4 + 256 * i);
                        a += hv[i][0] * w4[0] + hv[i][1] * w4[1] + hv[i][2] * w4[2] + hv[i][3] * w4[3]; }
                    lg[j] = wave_sum(a) + bg[j]; }
                int gi = 0; float gm = lg[0];
#pragma unroll
                for (int j = 1; j < 4; ++j) if (lg[j] > gm) { gm = lg[j]; gi = j; }
                float gs = 0.f;
#pragma unroll
                for (int j = 0; j < 4; ++j) gs += __expf(lg[j] - gm);
                const float gprob = 1.f / gs;
                float le[8];
#pragma unroll
                for (int j = 0; j < 8; ++j) { float a = 0.f; const LAS float* wr = wt + (4 + gi * 8 + j) * WTS + lane * 4;
#pragma unroll
                    for (int i = 0; i < 4; ++i) { const f32x4 w4 = *(const LAS f32x4*)(wr + 256 * i);
                        a += hv[i][0] * w4[0] + hv[i][1] * w4[1] + hv[i][2] * w4[2] + hv[i][3] * w4[3]; }
                    le[j] = wave_sum(a) + be[gi * 8 + j]; }
                int e0 = 0; float m0 = le[0];
#pragma unroll
                for (int j = 1; j < 8; ++j) if (le[j] > m0) { m0 = le[j]; e0 = j; }
                int e1 = 0; float m1 = -3.0e38f;
#pragma unroll
                for (int j = 0; j < 8; ++j) if (j != e0 && le[j] > m1) { m1 = le[j]; e1 = j; }
                const float p1 = __expf(m1 - m0);
                if (lane == 0) {
                    const int ge0 = gi * 8 + e0, ge1 = gi * 8 + e1;
                    route_w[2 * row] = gprob / (1.f + p1); route_w[2 * row + 1] = gprob * p1 / (1.f + p1);
                    const int s0 = atomicAdd((int*)&lcnt[ge0], 1), s1 = atomicAdd((int*)&lcnt[ge1], 1);
                    rinfo[2 * lrow] = (ge0 << 16) | s0; rinfo[2 * lrow + 1] = (ge1 << 16) | s1;
                }
            }
        }
    }
    if (ROUTER) {
        __syncthreads();
        if (tid < 32) { const int c = lcnt[tid]; lbase[tid] = c ? atomicAdd(&cnt[tid * 64], c) : 0; }
        __syncthreads();
        int lrow = wave;
        for (int row = blockIdx.x * NWAVE + wave; row < nrows; row += gridDim.x * NWAVE, lrow += NWAVE) {
            if (lane < 2) { const int ri = rinfo[2 * lrow + lane], ge = ri >> 16, sl = ri & 0xffff; list[(size_t)ge * cap + lbase[ge] + sl] = 2 * row + lane; }
        }
        __syncthreads();
    }
}

__device__ __forceinline__ int xcd_unit(int r) { const int G = gridDim.x, bx = blockIdx.x; return G == 256 ? ((r * 8 + (bx & 7)) * 32 + (bx >> 3)) : r * G + bx; }
__device__ __forceinline__ void unit_tile(int u, int MT, int NT, int& mt, int& nt) {
    if ((MT & 3) == 0) { const int band = u / (4 * NT), w = u - band * 4 * NT; nt = w >> 2; mt = band * 4 + (w & 3); }
    else { mt = u / NT; nt = u - mt * NT; }
}
constexpr int GEMM_STAGE = 256 * 128 + 128 * 128;
constexpr int GEMM_LDS = 3 * GEMM_STAGE;
__device__ __forceinline__ int sw_off(int row, int chunk) { return row * 128 + ((chunk ^ ((row >> 1) & 7)) << 4); }

struct BRowId { __device__ __forceinline__ int operator()(int r) const { return r; } };
template <int VAR = 0, class Epi, class BRow = BRowId>
__device__ __forceinline__ void gemm_tile(const bf16* const (&arow)[4], const bf16* bt  , int ldb, int K, LAS unsigned char* lds, Epi&& epi, BRow brow = BRow()) {
    const int tid = otid(), lane = tid & 63, wave = tid >> 6, wm = wave >> 1, wn = wave & 1;
    const int r8 = tid >> 3;
    const int schunk = (lane & 7) ^ ((r8 >> 1) & 7);
    const bf16* ga[4]; const bf16* gb[2];
#pragma unroll
    for (int i = 0; i < 4; ++i) ga[i] = arow[i] + schunk * 8;
#pragma unroll
    for (int i = 0; i < 2; ++i) gb[i] = bt + (size_t)brow(r8 + 64 * i) * ldb + schunk * 8;
    f32x16 acc[2][2];
#pragma unroll
    for (int mi = 0; mi < 2; ++mi)
#pragma unroll
        for (int ni = 0; ni < 2; ++ni)
#pragma unroll
            for (int r = 0; r < 16; ++r) acc[mi][ni][r] = 0.f;
#define G_DMA(t, st) do { LAS unsigned char* sa_ = lds + (st) * GEMM_STAGE + wave * 1024 + lane * 16; \
    _Pragma("unroll") for (int i = 0; i < 4; ++i) __builtin_amdgcn_global_load_lds((const unsigned*)(ga[i] + (t) * 64), (LAS unsigned*)(sa_ + i * 8192), 16, 0, 0); \
    _Pragma("unroll") for (int i = 0; i < 2; ++i) __builtin_amdgcn_global_load_lds((const unsigned*)(gb[i] + (t) * 64), (LAS unsigned*)(sa_ + 256 * 128 + i * 8192), 16, 0, 0); } while (0)
    const int KT = K >> 6;
    G_DMA(0, 0);
    G_DMA(1, 1);
    asm volatile("s_waitcnt vmcnt(6)" ::: "memory");
    __builtin_amdgcn_s_barrier();
    asm volatile("" ::: "memory");
    int st = 0;
    for (int kt = 0; kt < KT; ++kt) {
        const int st2 = st >= 1 ? st - 1 : 2;
        if (VAR != 2) { if (kt + 2 < KT) G_DMA(kt + 2, st2); }
        const LAS unsigned char* sa = lds + st * GEMM_STAGE; const LAS unsigned char* sb = sa + 256 * 128;
        bf16x8 af[2], bfr[2];
        if (VAR == 1) {
#pragma unroll
            for (int mi = 0; mi < 2; ++mi) af[mi] = *(const LAS bf16x8*)(sa + sw_off(wm * 64 + mi * 32 + (lane & 31), (lane >> 5)));
#pragma unroll
            for (int ni = 0; ni < 2; ++ni) bfr[ni] = *(const LAS bf16x8*)(sb + sw_off(wn * 64 + ni * 32 + (lane & 31), (lane >> 5)));
        }
#pragma unroll
        for (int kk = 0; kk < 4; ++kk) {
            if (VAR != 1) {
#pragma unroll
            for (int mi = 0; mi < 2; ++mi) af[mi] = *(const LAS bf16x8*)(sa + sw_off(wm * 64 + mi * 32 + (lane & 31), 2 * kk + (lane >> 5)));
#pragma unroll
            for (int ni = 0; ni < 2; ++ni) bfr[ni] = *(const LAS bf16x8*)(sb + sw_off(wn * 64 + ni * 32 + (lane & 31), 2 * kk + (lane >> 5)));
            }
            if (VAR == 3) {
#pragma unroll
                for (int mi = 0; mi < 2; ++mi) acc[mi][0][kk] += __builtin_bit_cast(f32x4, af[mi])[0] + __builtin_bit_cast(f32x4, bfr[mi])[1];
            } else {
#pragma unroll
            for (int mi = 0; mi < 2; ++mi)
#pragma unroll
                for (int ni = 0; ni < 2; ++ni) acc[mi][ni] = mfma32(bfr[ni], af[mi], acc[mi][ni]);
            }
        }
        if (kt + 2 < KT) asm volatile("s_waitcnt vmcnt(6)" ::: "memory"); else asm volatile("s_waitcnt vmcnt(0)" ::: "memory");
        __builtin_amdgcn_s_barrier();
        asm volatile("" ::: "memory");
        st = st == 2 ? 0 : st + 1;
    }
#undef G_DMA
    epi(acc, wm, wn, lane);
}

constexpr int CST_BF = 272, CST_BF64 = 144, CST_F32 = 528;
__device__ __forceinline__ void stage_bf16_128(const f32x16 (&acc)[2][2], LAS unsigned char* lds, int wm, int wn, int lane) {
#pragma unroll
    for (int mi = 0; mi < 2; ++mi) { LAS unsigned char* rp = lds + (wm * 64 + mi * 32 + (lane & 31)) * CST_BF + (wn * 64 + 4 * (lane >> 5)) * 2;
#pragma unroll
        for (int ni = 0; ni < 2; ++ni)
#pragma unroll
            for (int g = 0; g < 4; ++g) { u32x2 o; o[0] = pk2(acc[mi][ni][4 * g], acc[mi][ni][4 * g + 1]); o[1] = pk2(acc[mi][ni][4 * g + 2], acc[mi][ni][4 * g + 3]);
                *(LAS u32x2*)(rp + (ni * 32 + 8 * g) * 2) = o; } }
}
template <class RowPtr>
__device__ __forceinline__ void flush_bf16_128(const LAS unsigned char* lds, RowPtr&& rowptr) {
    const int t = otid();
#pragma unroll
    for (int it = 0; it < 8; ++it) { const int row = it * 32 + (t >> 4), piece = t & 15;
        const u32x4 v = *(const LAS u32x4*)(lds + row * CST_BF + piece * 16);
        bf16* dst = rowptr(row);
        if (dst) __builtin_nontemporal_store(v, (u32x4*)(dst + piece * 8)); }
}
template <class RowPtr>
__device__ __forceinline__ void flush_bf16_64(const LAS unsigned char* lds, RowPtr&& rowptr) {
    const int t = otid();
#pragma unroll
    for (int it = 0; it < 4; ++it) { const int row = it * 64 + (t >> 3), piece = t & 7;
        const u32x4 v = *(const LAS u32x4*)(lds + row * CST_BF64 + piece * 16);
        bf16* dst = rowptr(row);
        if (dst) __builtin_nontemporal_store(v, (u32x4*)(dst + piece * 8)); }
}
__device__ __forceinline__ void stage_f32_128(const f32x16 (&acc)[2][2], LAS unsigned char* lds, int wm, int wn, int lane) {
#pragma unroll
    for (int mi = 0; mi < 2; ++mi) { LAS unsigned char* rp = lds + (wm * 64 + mi * 32 + (lane & 31)) * CST_F32 + (wn * 64 + 4 * (lane >> 5)) * 4;
#pragma unroll
        for (int ni = 0; ni < 2; ++ni)
#pragma unroll
            for (int g = 0; g < 4; ++g) { f32x4 o; o[0] = acc[mi][ni][4 * g]; o[1] = acc[mi][ni][4 * g + 1]; o[2] = acc[mi][ni][4 * g + 2]; o[3] = acc[mi][ni][4 * g + 3];
                *(LAS f32x4*)(rp + (ni * 32 + 8 * g) * 4) = o; } }
}

template <int NB, int VAR = 0>
__device__ __forceinline__ void phase_inproj_v(const bf16* H, const bf16* Wt, bf16* PROJ, float* GATES, LAS unsigned char* lds, bool dostore = true) {
    constexpr int T = NB * (SEQ + CTXL), MT = T / 256, NT_ = NIN / 128;
    for (int r = 0; r * (int)gridDim.x < MT * NT_; ++r) {
        const int u = xcd_unit(r); if (u >= MT * NT_) continue;
        int mt, nt; unit_tile(u, MT, NT_, mt, nt);
        const bf16* arow[4];
#pragma unroll
        for (int i = 0; i < 4; ++i) arow[i] = H + (size_t)(mt * 256 + (otid() >> 3) + 64 * i) * D;
        gemm_tile<VAR>(arow, Wt + (size_t)nt * 128 * D, D, D, lds, [&](const f32x16 (&acc)[2][2], int wm, int wn, int lane) {
            if (!dostore) return;
            if (nt < NT_ - 1) stage_bf16_128(acc, lds, wm, wn, lane);
            else if (wn == 0) {
#pragma unroll
                for (int mi = 0; mi < 2; ++mi) { const int row = mt * 256 + wm * 64 + mi * 32 + (lane & 31);
#pragma unroll
                    for (int ni = 0; ni < 2; ++ni)
#pragma unroll
                        for (int g = 0; g < 4; ++g) { f32x4 o; o[0] = acc[mi][ni][4 * g]; o[1] = acc[mi][ni][4 * g + 1]; o[2] = acc[mi][ni][4 * g + 2]; o[3] = acc[mi][ni][4 * g + 3];
                            *(f32x4*)(GATES + (size_t)row * 64 + ni * 32 + 8 * g + 4 * (lane >> 5)) = o; } } }
        });
        if (dostore && nt < NT_ - 1) {
            __syncthreads();
            flush_bf16_128(lds, [&](int r) { return PROJ + (size_t)(mt * 256 + r) * PROJW + nt * 128; });
        }
        __syncthreads();
    }
}

template <int NB> __device__ __forceinline__ void phase_inproj(const bf16* H, const bf16* Wt, bf16* PROJ, float* GATES, LAS unsigned char* lds) { phase_inproj_v<NB, 0>(H, Wt, PROJ, GATES, lds, true); }

template <int NB>
__device__ __forceinline__ void phase_conv(const bf16* PROJ, const float* cw, const float* cb, bf16* XBC) {
    constexpr int TL = NB * SEQ, T = NB * (SEQ + CTXL);
    for (size_t it = (size_t)blockIdx.x * NTHR + otid(); it < (size_t)T * 192; it += (size_t)gridDim.x * NTHR) {
        const int row = (int)(it / 192), c0 = (int)(it % 192) * 8;
        int t, L;
        if (row < TL) { t = row % SEQ; L = SEQ; } else { t = (row - TL) % CTXL; L = CTXL; }
        const bf16* p = PROJ + (size_t)row * PROJW + PC_XBC + c0;
        const u32x4 cur = *(const u32x4*)p;
        u32x4 prv = {0u, 0u, 0u, 0u}, nxt = {0u, 0u, 0u, 0u};
        if (t > 0) prv = *(const u32x4*)(p - PROJW);
        if (t < L - 1) nxt = *(const u32x4*)(p + PROJW);
        float o[8];
#pragma unroll
        for (int j = 0; j < 4; ++j) {
            const int c = c0 + 2 * j;
            o[2 * j] = bflo(prv[j]) * cw[c] + bflo(cur[j]) * cw[1536 + c] + bflo(nxt[j]) * cw[3072 + c] + cb[c];
            o[2 * j + 1] = bfhi(prv[j]) * cw[c + 1] + bfhi(cur[j]) * cw[1536 + c + 1] + bfhi(nxt[j]) * cw[3072 + c + 1] + cb[c + 1];
        }
        u32x4 r; r[0] = pk2(siluf(o[0]), siluf(o[1])); r[1] = pk2(siluf(o[2]), siluf(o[3])); r[2] = pk2(siluf(o[4]), siluf(o[5])); r[3] = pk2(siluf(o[6]), siluf(o[7]));
        *(u32x4*)(XBC + (size_t)row * 1536 + c0) = r;
    }
}
}
namespace fx {
constexpr int RS_X = 144, RS_N = 272;

template <int NB> __device__ __forceinline__ int scan_row(int b, int d, int step) {
    if (step < CTXL) return NB * SEQ + b * CTXL + (d ? CTXL - 1 - step : step);
    step -= CTXL; return b * SEQ + (d ? SEQ - 1 - step : step);
}
__device__ __forceinline__ bf16x8 scale_frag(bf16x8 v, f32x4 w0, f32x4 w1) {
    const u32x4 u = __builtin_bit_cast(u32x4, v);
    u32x4 o;
    o[0] = pk2(bflo(u[0]) * w0[0], bfhi(u[0]) * w0[1]); o[1] = pk2(bflo(u[1]) * w0[2], bfhi(u[1]) * w0[3]);
    o[2] = pk2(bflo(u[2]) * w1[0], bfhi(u[2]) * w1[1]); o[3] = pk2(bflo(u[3]) * w1[2], bfhi(u[3]) * w1[3]);
    return __builtin_bit_cast(bf16x8, o);
}

__device__ __forceinline__ unsigned tr_addr(const LAS unsigned char* T, int RS, int k0, int c0, int lane) {
    const int h = lane >> 5, blk = (lane >> 4) & 1, q = (lane & 15) >> 2, p = lane & 3;
    return (unsigned)(size_t)(T + (k0 + 8 * h + q) * RS + (c0 + 16 * blk + 4 * p) * 2);
}
__device__ __forceinline__ void tr8(unsigned a0, unsigned a1, unsigned a2, unsigned a3, unsigned a4, unsigned a5, unsigned a6, unsigned a7,
                                    bf16x4& v0, bf16x4& v1, bf16x4& v2, bf16x4& v3, bf16x4& v4, bf16x4& v5, bf16x4& v6, bf16x4& v7) {
    asm volatile("ds_read_b64_tr_b16 %0, %8\n\tds_read_b64_tr_b16 %1, %9\n\tds_read_b64_tr_b16 %2, %10\n\tds_read_b64_tr_b16 %3, %11\n\t"
                 "ds_read_b64_tr_b16 %4, %12\n\tds_read_b64_tr_b16 %5, %13\n\tds_read_b64_tr_b16 %6, %14\n\tds_read_b64_tr_b16 %7, %15\n\ts_waitcnt lgkmcnt(0)"
                 : "=&v"(v0), "=&v"(v1), "=&v"(v2), "=&v"(v3), "=&v"(v4), "=&v"(v5), "=&v"(v6), "=&v"(v7)
                 : "v"(a0), "v"(a1), "v"(a2), "v"(a3), "v"(a4), "v"(a5), "v"(a6), "v"(a7) : "memory");
}
__device__ __forceinline__ void tr4(unsigned a0, unsigned a1, unsigned a2, unsigned a3, bf16x4& v0, bf16x4& v1, bf16x4& v2, bf16x4& v3) {
    asm volatile("ds_read_b64_tr_b16 %0, %4\n\tds_read_b64_tr_b16 %1, %5\n\tds_read_b64_tr_b16 %2, %6\n\tds_read_b64_tr_b16 %3, %7\n\ts_waitcnt lgkmcnt(0)"
                 : "=&v"(v0), "=&v"(v1), "=&v"(v2), "=&v"(v3) : "v"(a0), "v"(a1), "v"(a2), "v"(a3) : "memory");
}
__device__ __forceinline__ bf16x8 tr_join(bf16x4 v0, bf16x4 v1) { bf16x8 r; r[0] = v0[0]; r[1] = v0[1]; r[2] = v0[2]; r[3] = v0[3]; r[4] = v1[0]; r[5] = v1[1]; r[6] = v1[2]; r[7] = v1[3]; return r; }
__device__ __forceinline__ void tr_col4(const LAS unsigned char* T, int RS, int k0, int c0, int lane, bf16x4 (&t)[4][2]) {
    const unsigned a = tr_addr(T, RS, k0, c0, lane);
    tr8(a, a + 4 * RS, a + 16 * RS, a + 20 * RS, a + 32 * RS, a + 36 * RS, a + 48 * RS, a + 52 * RS, t[0][0], t[0][1], t[1][0], t[1][1], t[2][0], t[2][1], t[3][0], t[3][1]);
}
__device__ __forceinline__ void tr_col2(const LAS unsigned char* T, int RS, int k0, int c0, int lane, bf16x4 (&t)[2][2]) {
    const unsigned a = tr_addr(T, RS, k0, c0, lane);
    tr4(a, a + 4 * RS, a + 16 * RS, a + 20 * RS, t[0][0], t[0][1], t[1][0], t[1][1]);
}

constexpr int NSTEP = SEQ + CTXL;
template <int NB> struct ScanTab {
    static constexpr size_t SSD_TAB = 0, ML_TAB = SSD_TAB + (size_t)NB * 32 * NSTEP * 16, SSD_DEC = ML_TAB + (size_t)NB * 8 * NSTEP * 32,
                            ML_CH = SSD_DEC + (size_t)NB * 32 * 34 * 4, END = ML_CH + (size_t)NB * 8 * 34 * 8;
};
template <int NB>
__device__ __forceinline__ void phase_tables(const In& in, const float* GATES, unsigned char* tab, LAS unsigned char* lds) {
    typedef ScanTab<NB> ST;
    const int tid = otid(), lane = tid & 63, wave = tid >> 6;
    LAS float* l_g = (LAS float*)lds; LAS float* l_ml = l_g + 68; LAS float* l_mr = l_g + 136;
    for (int job = blockIdx.x; job < NB * 40; job += gridDim.x) {
        if (job < NB * 32) {
            const int b = job >> 5, d = (job >> 4) & 1, h = job & 15;
            const float a = -__expf(in.ssd_a_log[d * 16 + h]), dtb = in.ssd_dt_bias[d * 16 + h];
            f32x4* T4 = (f32x4*)(tab + ST::SSD_TAB) + (size_t)job * NSTEP; float* DEC = (float*)(tab + ST::SSD_DEC) + job * 34;
            for (int ch = wave; ch < 34; ch += NWAVE) {
                const float dt0 = softplusf(GATES[(size_t)scan_row<NB>(b, d, ch * 128 + lane) * 64 + d * 16 + h] + dtb);
                const float dt1 = softplusf(GATES[(size_t)scan_row<NB>(b, d, ch * 128 + 64 + lane) * 64 + d * 16 + h] + dtb);
                float v0 = dt0 * a, v1 = dt1 * a;
#pragma unroll
                for (int o = 1; o < 64; o <<= 1) { const float t0 = __shfl_up(v0, o), t1 = __shfl_up(v1, o); if (lane >= o) { v0 += t0; v1 += t1; } }
                v1 += __shfl(v0, 63);
                const float tot = __shfl(v1, 63);
                T4[ch * 128 + lane] = (f32x4){v0, dt0, dt0 * __expf(tot - v0), __expf(v0)};
                T4[ch * 128 + 64 + lane] = (f32x4){v1, dt1, dt1 * __expf(tot - v1), __expf(v1)};
                if (lane == 0) DEC[ch] = __expf(tot);
            }
        } else {
            const int j2 = job - NB * 32, b = j2 >> 3, d = (j2 >> 2) & 1, hh = j2 & 3;
            const float ib = in.ml_i_bias[d * 4 + hh], fb = in.ml_f_bias[d * 4 + hh];
            f32x4* T4 = (f32x4*)(tab + ST::ML_TAB) + (size_t)j2 * NSTEP * 2; float* CH = (float*)(tab + ST::ML_CH) + j2 * 34 * 2;
            float s_li[5][2], s_bc[5][2], s_mi[5][2], s_we[5][2];
            __syncthreads();
#pragma unroll
            for (int k = 0; k < 5; ++k) { const int ch = wave + 8 * k;
#pragma unroll
                for (int q = 0; q < 2; ++q) { s_li[k][q] = 0.f; s_bc[k][q] = 0.f; s_mi[k][q] = 0.f; s_we[k][q] = 0.f; }
                if (ch < 34) {
                    const float* g0 = GATES + (size_t)scan_row<NB>(b, d, ch * 128 + lane) * 64; const float* g1 = GATES + (size_t)scan_row<NB>(b, d, ch * 128 + 64 + lane) * 64;
                    const float li0 = g0[32 + d * 4 + hh] + ib, li1 = g1[32 + d * 4 + hh] + ib;
                    float bc0 = logsigf(g0[40 + d * 4 + hh] + fb), bc1 = logsigf(g1[40 + d * 4 + hh] + fb);
#pragma unroll
                    for (int o = 1; o < 64; o <<= 1) { const float t0 = __shfl_up(bc0, o), t1 = __shfl_up(bc1, o); if (lane >= o) { bc0 += t0; bc1 += t1; } }
                    bc1 += __shfl(bc0, 63);
                    float pm0 = li0 - bc0, pm1 = li1 - bc1;
#pragma unroll
                    for (int o = 1; o < 64; o <<= 1) { const float t0 = __shfl_up(pm0, o), t1 = __shfl_up(pm1, o); if (lane >= o) { pm0 = fmaxf(pm0, t0); pm1 = fmaxf(pm1, t1); } }
                    pm1 = fmaxf(pm1, __shfl(pm0, 63));
                    const float gtot = __shfl(bc1, 63);
                    const float ae0 = gtot - bc0 + li0, ae1 = gtot - bc1 + li1;
                    const float m_loc = wave_max(fmaxf(ae0, ae1));
                    s_li[k][0] = li0; s_li[k][1] = li1; s_bc[k][0] = bc0; s_bc[k][1] = bc1; s_mi[k][0] = bc0 + pm0; s_mi[k][1] = bc1 + pm1;
                    s_we[k][0] = __expf(ae0 - m_loc); s_we[k][1] = __expf(ae1 - m_loc);
                    if (lane == 0) { l_g[ch] = gtot; l_ml[ch] = m_loc; }
                } }
            __syncthreads();
            if (tid == 0) { float m = 0.f;
                for (int ch = 0; ch < 34; ++ch) { const float g = l_g[ch], ml = l_ml[ch], mn = fmaxf(g + m, ml);
                    l_mr[ch] = m; CH[2 * ch] = __expf(g + m - mn); CH[2 * ch + 1] = __expf(ml - mn); m = mn; } }
            __syncthreads();
#pragma unroll
            for (int k = 0; k < 5; ++k) { const int ch = wave + 8 * k;
                if (ch < 34) {
#pragma unroll
                    for (int q = 0; q < 2; ++q) {
                        const float m_inter = s_bc[k][q] + l_mr[ch], mt = fmaxf(s_mi[k][q], m_inter);
                        T4[(size_t)(ch * 128 + 64 * q + lane) * 2] = (f32x4){__expf(s_bc[k][q] - mt), __expf(s_li[k][q] - s_bc[k][q]), __expf(m_inter - mt), s_we[k][q]};
                        T4[(size_t)(ch * 128 + 64 * q + lane) * 2 + 1] = (f32x4){__expf(-mt), 0.f, 0.f, 0.f}; }
                } }
        }
    }
}

template <int NB>
__device__ __forceinline__ void ssd_item(const bf16* XBC, const unsigned char* tab, bf16* SCb, int b, int d, int h, LAS unsigned char* lds) {
    typedef ScanTab<NB> ST;
    const int tid = otid(), lane = tid & 63, wave = tid >> 6, g = h >> 3, combo = b * 32 + d * 16 + h;
    LAS unsigned char* Xs = lds; LAS unsigned char* Bs = lds + 18432; LAS unsigned char* Cs = lds + 53248;
    LAS unsigned char* Ss = lds + 88064; LAS unsigned char* Ms = lds + 105472;
    LAS float* acs = (LAS float*)(lds + 140288); LAS float* dtv = acs + 128; LAS float* wv = acs + 256; LAS float* eav = acs + 384;
    const f32x4* T4 = (const f32x4*)(tab + ST::SSD_TAB) + (size_t)combo * NSTEP; const float* DEC = (const float*)(tab + ST::SSD_DEC) + combo * 34;
    f32x16 st;
#pragma unroll
    for (int r = 0; r < 16; ++r) st[r] = 0.f;
    constexpr int NCH = (CTXL + SEQ) / 128;
    u32x4 rx[2], rb[4], rc[4]; f32x4 rt = {0.f, 0.f, 0.f, 0.f}; float rdec = 0.f;
#define SSD_LOAD(ch) do { \
    _Pragma("unroll") for (int i = 0; i < 2; ++i) { const int idx = tid + 512 * i, l = idx >> 3, c = idx & 7; \
        rx[i] = *(const u32x4*)(XBC + (size_t)scan_row<NB>(b, d, (ch) * 128 + l) * 1536 + h * 64 + c * 8); } \
    _Pragma("unroll") for (int i = 0; i < 4; ++i) { const int idx = tid + 512 * i, l = idx >> 4, c = idx & 15; \
        const bf16* rp = XBC + (size_t)scan_row<NB>(b, d, (ch) * 128 + l) * 1536 + 1024 + g * 128 + c * 8; \
        rb[i] = *(const u32x4*)rp; rc[i] = *(const u32x4*)(rp + 256); } \
    if (tid < 128) rt = T4[(ch) * 128 + tid]; \
    rdec = DEC[ch]; } while (0)
    SSD_LOAD(0);
    const int pbw = wave >> 2, nbw = wave & 3;
    for (int ch = 0; ch < NCH; ++ch) {
#pragma unroll
        for (int i = 0; i < 2; ++i) { const int idx = tid + 512 * i, l = idx >> 3, c = idx & 7; *(LAS u32x4*)(Xs + l * RS_X + c * 16) = rx[i]; }
#pragma unroll
        for (int i = 0; i < 4; ++i) { const int idx = tid + 512 * i, l = idx >> 4, c = idx & 15;
            *(LAS u32x4*)(Bs + l * RS_N + c * 16) = rb[i]; *(LAS u32x4*)(Cs + l * RS_N + c * 16) = rc[i]; }
        if (tid < 128) { acs[tid] = rt[0]; dtv[tid] = rt[1]; wv[tid] = rt[2]; eav[tid] = rt[3]; }
        const float dec = rdec;
        {
            const int pp = 32 * pbw + (lane & 31);
#pragma unroll
            for (int gq = 0; gq < 4; ++gq) { u32x2 o; o[0] = pk2(st[4 * gq], st[4 * gq + 1]); o[1] = pk2(st[4 * gq + 2], st[4 * gq + 3]);
                *(LAS u32x2*)(Ss + pp * RS_N + (32 * nbw + 8 * gq + 4 * (lane >> 5)) * 2) = o; }
        }
        __syncthreads();
        if (ch + 1 < NCH) SSD_LOAD(ch + 1);
        {
            const int lbA = wave >> 1, sbp = wave & 1;
            const int l = 32 * lbA + (lane & 31);
            const float al = acs[l];
#pragma unroll
            for (int q = 0; q < 2; ++q) { const int sb = 2 * sbp + q;
                if (sb <= lbA) {
                    f32x16 cb;
#pragma unroll
                    for (int r = 0; r < 16; ++r) cb[r] = 0.f;
#pragma unroll
                    for (int kk = 0; kk < 8; ++kk) cb = mfma32(frag_row(Bs, RS_N, 32 * sb, 16 * kk, lane), frag_row(Cs, RS_N, 32 * lbA, 16 * kk, lane), cb);
#pragma unroll
                    for (int gq = 0; gq < 4; ++gq) { const int s0 = 32 * sb + 8 * gq + 4 * (lane >> 5);
                        const f32x4 as4 = *(const LAS f32x4*)(acs + s0), dt4 = *(const LAS f32x4*)(dtv + s0);
                        float m[4];
#pragma unroll
                        for (int j = 0; j < 4; ++j) m[j] = (s0 + j <= l) ? cb[4 * gq + j] * __expf(fminf(al - as4[j], 0.f)) * dt4[j] : 0.f;
                        u32x2 o; o[0] = pk2(m[0], m[1]); o[1] = pk2(m[2], m[3]);
                        *(LAS u32x2*)(Ms + l * RS_N + s0 * 2) = o; } } }
        }
        {
#pragma unroll
            for (int r = 0; r < 16; ++r) st[r] *= dec;
#pragma unroll
            for (int kb = 0; kb < 2; ++kb) {
                bf16x4 tx[4][2], tb[4][2];
                tr_col4(Xs, RS_X, 64 * kb, 32 * pbw, lane, tx);
                tr_col4(Bs, RS_N, 64 * kb, 32 * nbw, lane, tb);
#pragma unroll
                for (int k4 = 0; k4 < 4; ++k4) {
                    const int l0 = 16 * (4 * kb + k4) + 8 * (lane >> 5);
                    const f32x4 w0 = *(const LAS f32x4*)(wv + l0), w1 = *(const LAS f32x4*)(wv + l0 + 4);
                    st = mfma32(tr_join(tb[k4][0], tb[k4][1]), scale_frag(tr_join(tx[k4][0], tx[k4][1]), w0, w1), st);
                }
            }
        }
        __syncthreads();
        {
            const int pb = wave >> 2, lb = wave & 3;
            f32x16 acc;
#pragma unroll
            for (int r = 0; r < 16; ++r) acc[r] = 0.f;
#pragma unroll
            for (int kk = 0; kk < 8; ++kk) acc = mfma32(frag_row(Ss, RS_N, 32 * pb, 16 * kk, lane), frag_row(Cs, RS_N, 32 * lb, 16 * kk, lane), acc);
            const int l = 32 * lb + (lane & 31);
            const float ea = eav[l];
#pragma unroll
            for (int r = 0; r < 16; ++r) acc[r] *= ea;
            for (int sb = 0; sb <= lb; ++sb) {
                bf16x4 t2[2][2];
                const bf16x8 m0 = frag_row(Ms, RS_N, 32 * lb, 32 * sb, lane), m1 = frag_row(Ms, RS_N, 32 * lb, 32 * sb + 16, lane);
                tr_col2(Xs, RS_X, 32 * sb, 32 * pb, lane, t2);
                acc = mfma32(tr_join(t2[0][0], t2[0][1]), m0, acc);
                acc = mfma32(tr_join(t2[1][0], t2[1][1]), m1, acc);
            }
            bf16* yp = SCb + (size_t)scan_row<NB>(b, d, ch * 128 + l) * 4096 + d * 1024 + h * 64 + 32 * pb + 4 * (lane >> 5);
#pragma unroll
            for (int gq = 0; gq < 4; ++gq) { u32x2 o; o[0] = pk2(acc[4 * gq], acc[4 * gq + 1]); o[1] = pk2(acc[4 * gq + 2], acc[4 * gq + 3]); *(u32x2*)(yp + 8 * gq) = o; }
        }
        __syncthreads();
    }
#undef SSD_LOAD
}

template <int NB>
__device__ __forceinline__ void mlstm_item(const bf16* PROJ, const unsigned char* tab, bf16* SCb, int b, int d, int hh, int ev, LAS unsigned char* lds) {
    typedef ScanTab<NB> ST;
    const int tid = otid(), lane = tid & 63, wave = tid >> 6, combo = b * 8 + d * 4 + hh;
    LAS unsigned char* Qs = lds; LAS unsigned char* Ks = lds + 34816; LAS unsigned char* Vs = lds + 69632;
    LAS unsigned char* Ct = lds + 88064; LAS unsigned char* Sm = lds + 105472;
    LAS float* tb = (LAS float*)(lds + 140288);
    LAS float* t_u = tb, *t_v = tb + 128, *t_wi = tb + 256, *t_we = tb + 384, *t_em = tb + 512, *t_qn = tb + 640, *t_n = tb + 768, *t_nc = tb + 896, *t_rs = tb + 1024  ;
    const f32x4* T4 = (const f32x4*)(tab + ST::ML_TAB) + (size_t)combo * NSTEP * 2; const float* CH = (const float*)(tab + ST::ML_CH) + combo * 34 * 2;
    const float kscale = 0.08838834764831845f;
    f32x16 st;
#pragma unroll
    for (int r = 0; r < 16; ++r) st[r] = 0.f;
    if (tid < 128) t_n[tid] = 0.f;
    constexpr int NCH = (CTXL + SEQ) / 128;
    const int kbw = wave & 3, ebw = wave >> 2;
    u32x4 rq[4], rk[4], rv[2]; f32x4 rt = {0.f, 0.f, 0.f, 0.f}; float ras = 0.f, rbb = 0.f;
#define ML_LOAD(ch) do { \
    _Pragma("unroll") for (int i = 0; i < 4; ++i) { const int idx = tid + 512 * i, l = idx >> 4, c = idx & 15; \
        const bf16* rp = PROJ + (size_t)scan_row<NB>(b, d, (ch) * 128 + l) * PROJW + hh * 128 + c * 8; \
        rq[i] = *(const u32x4*)(rp + PC_Q); rk[i] = *(const u32x4*)(rp + PC_K); } \
    _Pragma("unroll") for (int i = 0; i < 2; ++i) { const int idx = tid + 512 * i, l = idx >> 3, c = idx & 7; \
        rv[i] = *(const u32x4*)(PROJ + (size_t)scan_row<NB>(b, d, (ch) * 128 + l) * PROJW + PC_V + hh * 256 + ev * 64 + c * 8); } \
    if (tid < 256) rt = T4[(size_t)(ch) * 256 + tid]; \
    ras = CH[2 * (ch)]; rbb = CH[2 * (ch) + 1]; } while (0)
    ML_LOAD(0);
    for (int ch = 0; ch < NCH; ++ch) {
#pragma unroll
        for (int i = 0; i < 4; ++i) { const int idx = tid + 512 * i, l = idx >> 4, c = idx & 15;
            *(LAS u32x4*)(Qs + l * RS_N + c * 16) = rq[i]; *(LAS u32x4*)(Ks + l * RS_N + c * 16) = rk[i]; }
#pragma unroll
        for (int i = 0; i < 2; ++i) { const int idx = tid + 512 * i, l = idx >> 3, c = idx & 7; *(LAS u32x4*)(Vs + l * RS_X + c * 16) = rv[i]; }
        if (tid < 256) { const int l = tid >> 1; if (tid & 1) t_em[l] = rt[0]; else { t_u[l] = rt[0]; t_v[l] = rt[1]; t_wi[l] = rt[2]; t_we[l] = rt[3]; } }
        const float a_s = ras, bbs = rbb;
        {
            const int ee = 32 * ebw + (lane & 31);
#pragma unroll
            for (int gq = 0; gq < 4; ++gq) { u32x2 o; o[0] = pk2(st[4 * gq], st[4 * gq + 1]); o[1] = pk2(st[4 * gq + 2], st[4 * gq + 3]);
                *(LAS u32x2*)(Ct + ee * RS_N + (32 * kbw + 8 * gq + 4 * (lane >> 5)) * 2) = o; }
        }
        __syncthreads();
        if (ch + 1 < NCH) ML_LOAD(ch + 1);
        {
            const int lbA = wave >> 1, sbp = wave & 1;
            const int l = 32 * lbA + (lane & 31);
            const float ul = t_u[l] * kscale;
#pragma unroll
            for (int q = 0; q < 2; ++q) { const int sb = 2 * sbp + q;
                if (sb <= lbA) {
                    f32x16 cb;
#pragma unroll
                    for (int r = 0; r < 16; ++r) cb[r] = 0.f;
#pragma unroll
                    for (int kk = 0; kk < 8; ++kk) cb = mfma32(frag_row(Ks, RS_N, 32 * sb, 16 * kk, lane), frag_row(Qs, RS_N, 32 * lbA, 16 * kk, lane), cb);
                    float rsum = 0.f;
#pragma unroll
                    for (int gq = 0; gq < 4; ++gq) { const int s0 = 32 * sb + 8 * gq + 4 * (lane >> 5);
                        const f32x4 v4 = *(const LAS f32x4*)(t_v + s0);
                        float m[4];
#pragma unroll
                        for (int j = 0; j < 4; ++j) { m[j] = (s0 + j <= l) ? cb[4 * gq + j] * ul * v4[j] : 0.f; rsum += m[j]; }
                        u32x2 o; o[0] = pk2(m[0], m[1]); o[1] = pk2(m[2], m[3]);
                        *(LAS u32x2*)(Sm + l * RS_N + s0 * 2) = o; }
                    rsum += __shfl_xor(rsum, 32);
                    if (lane < 32) t_rs[sb * 128 + l] = rsum;
                } }
            if (wave == 1 || wave == 3) {
                const int lq = (wave == 1 ? 0 : 64) + lane;
                float qn = 0.f;
#pragma unroll 4
                for (int c = 0; c < 16; ++c) { const u32x4 qv = *(const LAS u32x4*)(Qs + lq * RS_N + c * 16);
                    const f32x4 n0 = *(const LAS f32x4*)(t_n + c * 8), n1 = *(const LAS f32x4*)(t_n + c * 8 + 4);
                    qn += bflo(qv[0]) * n0[0] + bfhi(qv[0]) * n0[1] + bflo(qv[1]) * n0[2] + bfhi(qv[1]) * n0[3]
                        + bflo(qv[2]) * n1[0] + bfhi(qv[2]) * n1[1] + bflo(qv[3]) * n1[2] + bfhi(qv[3]) * n1[3]; }
                t_qn[lq] = qn;
            }
        }
        {
#pragma unroll
            for (int r = 0; r < 16; ++r) st[r] *= a_s;
            const float f = bbs * kscale;
            f32x16 nacc;
#pragma unroll
            for (int r = 0; r < 16; ++r) nacc[r] = 0.f;
            bf16x8 ones;
#pragma unroll
            for (int j = 0; j < 8; ++j) ones[j] = (short)0x3f80;
#pragma unroll
            for (int kb2 = 0; kb2 < 2; ++kb2) {
                bf16x4 tk[4][2], tv[4][2];
                tr_col4(Ks, RS_N, 64 * kb2, 32 * kbw, lane, tk);
                tr_col4(Vs, RS_X, 64 * kb2, 32 * ebw, lane, tv);
#pragma unroll
                for (int k4 = 0; k4 < 4; ++k4) {
                    const int l0 = 16 * (4 * kb2 + k4) + 8 * (lane >> 5);
                    f32x4 w0 = *(const LAS f32x4*)(t_we + l0), w1 = *(const LAS f32x4*)(t_we + l0 + 4);
#pragma unroll
                    for (int j = 0; j < 4; ++j) { w0[j] *= f; w1[j] *= f; }
                    const bf16x8 ka = scale_frag(tr_join(tk[k4][0], tk[k4][1]), w0, w1);
                    st = mfma32(ka, tr_join(tv[k4][0], tv[k4][1]), st);
                    if (ebw == 0) nacc = mfma32(ka, ones, nacc);
                }
            }
            if (ebw == 0 && (lane & 31) == 0) {
#pragma unroll
                for (int gq = 0; gq < 4; ++gq)
#pragma unroll
                    for (int j = 0; j < 4; ++j) t_nc[32 * kbw + 8 * gq + 4 * (lane >> 5) + j] = nacc[4 * gq + j];
            }
        }
        __syncthreads();
        if (tid < 128) t_n[tid] = a_s * t_n[tid] + t_nc[tid];
        {
            const int eb = wave >> 2, lb = wave & 3;
            f32x16 acc;
#pragma unroll
            for (int r = 0; r < 16; ++r) acc[r] = 0.f;
#pragma unroll
            for (int kk = 0; kk < 8; ++kk) acc = mfma32(frag_row(Ct, RS_N, 32 * eb, 16 * kk, lane), frag_row(Qs, RS_N, 32 * lb, 16 * kk, lane), acc);
            const int l = 32 * lb + (lane & 31);
            const float wi = t_wi[l];
#pragma unroll
            for (int r = 0; r < 16; ++r) acc[r] *= wi;
            float rsum = 0.f;
            for (int sb = 0; sb <= lb; ++sb) {
                bf16x4 t2[2][2];
                const bf16x8 m0 = frag_row(Sm, RS_N, 32 * lb, 32 * sb, lane), m1 = frag_row(Sm, RS_N, 32 * lb, 32 * sb + 16, lane);
                rsum += t_rs[sb * 128 + l];
                tr_col2(Vs, RS_X, 32 * sb, 32 * eb, lane, t2);
                acc = mfma32(tr_join(t2[0][0], t2[0][1]), m0, acc);
                acc = mfma32(tr_join(t2[1][0], t2[1][1]), m1, acc);
            }
            float den = rsum + t_qn[l] * wi;
            den = fmaxf(fabsf(den), t_em[l]);
            const float inv = 1.f / den;
            bf16* hp = SCb + (size_t)scan_row<NB>(b, d, ch * 128 + l) * 4096 + 2048 + d * 1024 + hh * 256 + ev * 64 + 32 * eb + 4 * (lane >> 5);
#pragma unroll
            for (int gq = 0; gq < 4; ++gq) { u32x2 o; o[0] = pk2(acc[4 * gq] * inv, acc[4 * gq + 1] * inv); o[1] = pk2(acc[4 * gq + 2] * inv, acc[4 * gq + 3] * inv); *(u32x2*)(hp + 8 * gq) = o; }
        }
        __syncthreads();
    }
#undef ML_LOAD
}

template <int NB>
__device__ __forceinline__ void phase_scan(const bf16* PROJ, const unsigned char* tab, const bf16* XBC, bf16* SCb, LAS unsigned char* lds, int mode = 3) {
    const int G = gridDim.x, bi = blockIdx.x;
    if (NB == 4 && G == 256) {
        const int x = bi & 7, y = bi >> 3;
        if (y < 16) { if (mode & 1) { const int q = x + 8 * (y >> 3), hh = y & 7; ssd_item<NB>(XBC, tab, SCb, q >> 2, (q >> 1) & 1, (q & 1) * 8 + hh, lds); } }
        else { if (mode & 2) { const int y2 = y - 16, c = x + 8 * (y2 >> 2), ev = y2 & 3; mlstm_item<NB>(PROJ, tab, SCb, c >> 3, (c >> 2) & 1, c & 3, ev, lds); } }
        return;
    }
    if (mode & 1) for (int item = bi; item < NB * 32; item += G) { const int b = item / 32, d = (item >> 4) & 1, h = item & 15;
        ssd_item<NB>(XBC, tab, SCb, b, d, h, lds); }
    const int v = (bi + G - (NB * 32) % G) % G;
    if (mode & 2) for (int it = v; it < NB * 32; it += G) { const int b = it / 32, d = (it >> 4) & 1, hh = (it >> 2) & 3, ev = it & 3;
        mlstm_item<NB>(PROJ, tab, SCb, b, d, hh, ev, lds); }
}

template <int NB>
__device__ __forceinline__ void phase_mixer_out(const In& in, const bf16* PROJ, const bf16* XBC, bf16* SCb, bf16* scratch_out = nullptr) {
    constexpr int T = NB * (SEQ + CTXL);
    const int lane = otid() & 63, wave = otid() >> 6;
    for (int row = blockIdx.x * NWAVE + wave; row < T; row += gridDim.x * NWAVE) {
        bf16* sc = SCb + (size_t)row * 4096;
        const bf16* pr = PROJ + (size_t)row * PROJW;
        float yv[16], hv[16], ss = 0.f, hs[2] = {0.f, 0.f};
#pragma unroll
        for (int i = 0; i < 2; ++i) { const int c = lane * 8 + 512 * i;
            const u32x4 y0 = *(const u32x4*)(sc + c), y1 = *(const u32x4*)(sc + 1024 + c), h0 = *(const u32x4*)(sc + 2048 + c), h1 = *(const u32x4*)(sc + 3072 + c);
            const u32x4 xs = *(const u32x4*)(XBC + (size_t)row * 1536 + c), z = *(const u32x4*)(pr + PC_Z + c);
            const float dk = in.ssd_d[c >> 6];
#pragma unroll
            for (int j = 0; j < 4; ++j) {
                float a0 = bflo(y0[j]) + bflo(y1[j]) + dk * bflo(xs[j]), a1 = bfhi(y0[j]) + bfhi(y1[j]) + dk * bfhi(xs[j]);
                a0 *= siluf(bflo(z[j])); a1 *= siluf(bfhi(z[j]));
                yv[8 * i + 2 * j] = a0; yv[8 * i + 2 * j + 1] = a1; ss += a0 * a0 + a1 * a1;
                const float b0 = bflo(h0[j]) + bflo(h1[j]), b1 = bfhi(h0[j]) + bfhi(h1[j]);
                hv[8 * i + 2 * j] = b0; hv[8 * i + 2 * j + 1] = b1; hs[i] += b0 * b0 + b1 * b1; } }
        ss = wave_sum(ss);
        const float rs = rsqrtf(ss * (1.f / 1024.f) + 1e-6f);
#pragma unroll
        for (int i = 0; i < 2; ++i) {
#pragma unroll
            for (int o = 16; o > 0; o >>= 1) hs[i] += __shfl_xor(hs[i], o);
            hs[i] = rsqrtf(hs[i] * (1.f / 256.f) + 1e-6f); }
        __builtin_amdgcn_s_waitcnt(0);
#pragma unroll
        for (int i = 0; i < 2; ++i) { const int c = lane * 8 + 512 * i;
            const u32x4 ov = *(const u32x4*)(pr + PC_O + c);
            u32x4 oy, oh;
#pragma unroll
            for (int j = 0; j < 4; ++j) {
                oy[j] = pk2(yv[8 * i + 2 * j] * rs * in.ssd_norm_w[c + 2 * j], yv[8 * i + 2 * j + 1] * rs * in.ssd_norm_w[c + 2 * j + 1]);
                oh[j] = pk2(hv[8 * i + 2 * j] * hs[i] * in.ml_norm_w[c + 2 * j] * sigmf(bflo(ov[j])), hv[8 * i + 2 * j + 1] * hs[i] * in.ml_norm_w[c + 2 * j + 1] * sigmf(bfhi(ov[j]))); }
            bf16* dstp = scratch_out ? scratch_out + (size_t)row * 2048 : sc;
            *(u32x4*)(dstp + c) = oy; *(u32x4*)(dstp + 1024 + c) = oh; }
    }
}

template <int NB, class Idle>
__device__ __forceinline__ void phase_outproj(const bf16* A, int lda, int K, const bf16* Wt, int nrows, const float* xl, const float* xc, const float* modl, float* Xout,
                                              LAS unsigned char* lds, Idle&& idle) {
    constexpr int TL = NB * SEQ;
    const int MT = nrows / 256;
    for (int r = 0; r * (int)gridDim.x < MT * 8; ++r) {
        const int u = xcd_unit(r);
        if (u >= MT * 8) {
            idle(u - MT * 8, (r + 1) * (int)gridDim.x - MT * 8); continue; }
        int mt, nt; unit_tile(u, MT, 8, mt, nt);
        const bf16* arow[4];
#pragma unroll
        for (int i = 0; i < 4; ++i) arow[i] = A + (size_t)(mt * 256 + (otid() >> 3) + 64 * i) * lda;
        gemm_tile(arow, Wt + (size_t)nt * 128 * K, K, K, lds, [&](const f32x16 (&acc)[2][2], int wm, int wn, int lane) { stage_f32_128(acc, lds, wm, wn, lane); });
        __syncthreads();
        {
            const float* mv = modl + (size_t)mod_row<NB>(mt * 256) * 6144 + 2 * 1024 + nt * 128;
            const int t = otid(), piece = t & 31;
            const f32x4 m2 = *(const f32x4*)(mv + piece * 4);
#pragma unroll 4
            for (int it = 0; it < 16; ++it) { const int rl = it * 16 + (t >> 5), row = mt * 256 + rl;
                const f32x4 a = *(const LAS f32x4*)(lds + rl * CST_F32 + piece * 16);
                const float* srcp = (row < TL ? xl + (size_t)row * D : xc + (size_t)(row - TL) * D) + nt * 128 + piece * 4;
                const f32x4 xv = *(const f32x4*)srcp;
                f32x4 o;
#pragma unroll
                for (int j = 0; j < 4; ++j) o[j] = xv[j] + m2[j] * a[j];
                __builtin_nontemporal_store(o, (f32x4*)(Xout + (size_t)row * D + nt * 128 + piece * 4)); }
        }
        __syncthreads();
    }
}
}
namespace fx {
__device__ __forceinline__ int moe_prefix(const int* cnt, LAS int* pre  ) {
    __syncthreads();
    if (otid() < 64) {
        const int lane = otid();
        int v = lane < 32 ? (cnt[lane * 64] + 255) >> 8 : 0;
#pragma unroll
        for (int o = 1; o < 32; o <<= 1) { const int t = __shfl_up(v, o); if (lane >= o) v += t; }
        if (lane < 32) pre[lane + 1] = v;
        if (lane == 0) pre[0] = 0;
    }
    __syncthreads();
    return pre[32];
}
__device__ __forceinline__ int moe_find(const LAS int* pre, int t) { int e = 0;
#pragma unroll
    for (int i = 1; i < 32; ++i) e += (t >= pre[i]) ? 1 : 0;
    return e; }

__device__ __forceinline__ void phase_moe_up(const bf16* H2, const bf16* Wgu, const int* cnt, const int* list, int cap, const float* route_w, bf16* ACT, LAS unsigned char* lds) {
    LAS int* pre = (LAS int*)(lds + GEMM_LDS);
    const int ntile = moe_prefix(cnt, pre);
    for (int r = 0; r * (int)gridDim.x < ntile * 8; ++r) {
        const int u = xcd_unit(r); if (u >= ntile * 8) continue;
        const int t = u >> 3, nt = u & 7, e = moe_find(pre, t), mt = t - pre[e], ce = cnt[e * 64];
        const int* le = list + (size_t)e * cap + mt * 256;
        const int nvalid = ce - mt * 256;
        const bf16* arow[4];
#pragma unroll
        for (int i = 0; i < 4; ++i) { const int r = (otid() >> 3) + 64 * i; const int ent = le[r < nvalid ? r : 0]; arow[i] = H2 + (size_t)(ent >> 1) * D; }
        gemm_tile(arow, Wgu + (size_t)e * 1024 * 1024 + (size_t)nt * 128 * 1024, 1024, 1024, lds, [&](const f32x16 (&acc)[2][2], int wm, int wn, int lane) {
#pragma unroll
            for (int mi = 0; mi < 2; ++mi) { const int r = wm * 64 + mi * 32 + (lane & 31);
                const float w = r < nvalid ? route_w[le[r]] : 0.f;
                LAS unsigned char* rp = lds + r * CST_BF64 + (wn * 32 + 4 * (lane >> 5)) * 2;
#pragma unroll
                for (int g = 0; g < 4; ++g) { float v[4];
#pragma unroll
                    for (int j = 0; j < 4; ++j) v[j] = siluf(acc[mi][0][4 * g + j]) * acc[mi][1][4 * g + j] * w;
                    u32x2 o; o[0] = pk2(v[0], v[1]); o[1] = pk2(v[2], v[3]); *(LAS u32x2*)(rp + 8 * g * 2) = o; } }
        });
        __syncthreads();
        flush_bf16_64(lds, [&](int r) -> bf16* { return r < nvalid ? ACT + (size_t)le[r] * 512 + nt * 64 : nullptr; });
        __syncthreads();
    }
}
__device__ __forceinline__ void phase_moe_down(const bf16* ACT, const bf16* Wd, const int* cnt, const int* list, int cap, bf16* Y2, LAS unsigned char* lds) {
    LAS int* pre = (LAS int*)(lds + GEMM_LDS);
    const int ntile = moe_prefix(cnt, pre);
    for (int r = 0; r * (int)gridDim.x < ntile * 8; ++r) {
        const int u = xcd_unit(r); if (u >= ntile * 8) continue;
        const int t = u >> 3, nt = u & 7, e = moe_find(pre, t), mt = t - pre[e], ce = cnt[e * 64];
        const int* le = list + (size_t)e * cap + mt * 256;
        const int nvalid = ce - mt * 256;
        const bf16* arow[4];
#pragma unroll
        for (int i = 0; i < 4; ++i) { const int r = (otid() >> 3) + 64 * i; const int ent = le[r < nvalid ? r : 0]; arow[i] = ACT + (size_t)ent * 512; }
        gemm_tile(arow, Wd + (size_t)e * 1024 * 512 + (size_t)nt * 128 * 512, 512, 512, lds, [&](const f32x16 (&acc)[2][2], int wm, int wn, int lane) { stage_bf16_128(acc, lds, wm, wn, lane); });
        __syncthreads();
        flush_bf16_128(lds, [&](int r) -> bf16* { return r < nvalid ? Y2 + (size_t)le[r] * D + nt * 128 : nullptr; });
        __syncthreads();
    }
}

template <int NB>
__device__ __forceinline__ void phase_qkv(const bf16* H, const bf16* Wt, const float* qn, const float* kn, bf16* QKV, LAS unsigned char* lds) {
    constexpr int T = NB * (SEQ + CTXL), MT = T / 256;
    for (int r = 0; r * (int)gridDim.x < MT * 24; ++r) {
        const int u = xcd_unit(r); if (u >= MT * 24) continue;
        int mt, nt; unit_tile(u, MT, 24, mt, nt);
        const bf16* arow[4];
#pragma unroll
        for (int i = 0; i < 4; ++i) arow[i] = H + (size_t)(mt * 256 + (otid() >> 3) + 64 * i) * D;
        gemm_tile(arow, Wt + (size_t)nt * 128 * D, D, D, lds, [&](const f32x16 (&acc)[2][2], int wm, int wn, int lane) {
            const int which = nt >> 3;
#pragma unroll
            for (int mi = 0; mi < 2; ++mi) {
                float rs = 1.f;
                if (which < 2) { float ss = 0.f;
#pragma unroll
                    for (int ni = 0; ni < 2; ++ni)
#pragma unroll
                        for (int r = 0; r < 16; ++r) ss += acc[mi][ni][r] * acc[mi][ni][r];
                    ss += __shfl_xor(ss, 32);
                    rs = rsqrtf(ss * (1.f / 64.f) + 1e-6f) * (which == 0 ? 0.125f : 1.f); }
                const float* nwp = which == 0 ? qn : kn;
                LAS unsigned char* rp = lds + (wm * 64 + mi * 32 + (lane & 31)) * CST_BF + (wn * 64 + 4 * (lane >> 5)) * 2;
#pragma unroll
                for (int ni = 0; ni < 2; ++ni)
#pragma unroll
                    for (int g = 0; g < 4; ++g) { float v[4];
#pragma unroll
                        for (int j = 0; j < 4; ++j) { v[j] = acc[mi][ni][4 * g + j]; if (which < 2) v[j] *= rs * nwp[ni * 32 + 8 * g + 4 * (lane >> 5) + j]; }
                        u32x2 o; o[0] = pk2(v[0], v[1]); o[1] = pk2(v[2], v[3]); *(LAS u32x2*)(rp + (ni * 32 + 8 * g) * 2) = o; } }
        });
        __syncthreads();
        flush_bf16_128(lds, [&](int r) { return QKV + (size_t)(mt * 256 + r) * 3072 + nt * 128; });
        __syncthreads();
    }
}

__device__ __forceinline__ bf16x8 frag16_row(const LAS unsigned char* T, int RS, int r0, int c0, int lane) {
    return *(const LAS bf16x8*)(T + (r0 + (lane & 15)) * RS + (c0 + 8 * (lane >> 4)) * 2);
}
__device__ __forceinline__ bf16x8 frag16_vt(const LAS unsigned char* T, int RS, int kb, int c0, int lane) {
    const int g4 = lane >> 4, q = (lane & 15) >> 2, p = lane & 3;
    const unsigned a0 = (unsigned)(size_t)(T + (kb + 4 * g4 + q) * RS + (c0 + 4 * p) * 2);
    const unsigned a1 = a0 + 16 * RS;
    bf16x4 v0, v1;
    asm volatile("ds_read_b64_tr_b16 %0, %2\n\tds_read_b64_tr_b16 %1, %3\n\ts_waitcnt lgkmcnt(0)" : "=&v"(v0), "=&v"(v1) : "v"(a0), "v"(a1) : "memory");
    bf16x8 r; r[0] = v0[0]; r[1] = v0[1]; r[2] = v0[2]; r[3] = v0[3]; r[4] = v1[0]; r[5] = v1[1]; r[6] = v1[2]; r[7] = v1[3];
    return r;
}

template <bool LOCAL>
__device__ __forceinline__ void attn_group(const LAS unsigned char* Kt, const LAS unsigned char* Vt, int koff, int kb, int hsel, int lane, int g4,
                                           const bf16x8& q0, const bf16x8& q1, f32x4 (&oacc)[4], float& l_run,
                                           int cs, int c, int brow  , const LAS float* rp) {
    f32x4 s[2];
#pragma unroll
    for (int sb = 0; sb < 2; ++sb) { s[sb] = (f32x4){0.f, 0.f, 0.f, 0.f};
        s[sb] = mfma16(frag16_row(Kt, RS_N, koff + kb + 16 * sb, hsel * 64, lane), q0, s[sb]);
        s[sb] = mfma16(frag16_row(Kt, RS_N, koff + kb + 16 * sb, hsel * 64 + 32, lane), q1, s[sb]); }
    float ps = 0.f; float p[8];
#pragma unroll
    for (int sb = 0; sb < 2; ++sb)
#pragma unroll
        for (int j = 0; j < 4; ++j) {
            float e;
            if (LOCAL) { const int kc = kb + 16 * sb + 4 * g4 + j; const bool ok = kc >= cs && kc < cs + 16;
                e = ok ? __expf(s[sb][j] + rp[hsel * 465 + (ok ? brow + (kc - c + 15) : 0)] - 8.f) : 0.f; }
            else e = __expf(s[sb][j] - 8.f);
            p[4 * sb + j] = e; ps += e; }
    l_run += ps;
    u32x4 pu; pu[0] = pk2(p[0], p[1]); pu[1] = pk2(p[2], p[3]); pu[2] = pk2(p[4], p[5]); pu[3] = pk2(p[6], p[7]);
    const bf16x8 pf = __builtin_bit_cast(bf16x8, pu);
    bf16x4 tv[4][2];
    {
        const int q = (lane & 15) >> 2, p4 = lane & 3;
        const unsigned a = (unsigned)(size_t)(Vt + (koff + kb + 4 * g4 + q) * RS_N + (hsel * 64 + 4 * p4) * 2);
        tr8(a, a + 16 * RS_N, a + 32, a + 32 + 16 * RS_N, a + 64, a + 64 + 16 * RS_N, a + 96, a + 96 + 16 * RS_N,
            tv[0][0], tv[0][1], tv[1][0], tv[1][1], tv[2][0], tv[2][1], tv[3][0], tv[3][1]);
    }
#pragma unroll
    for (int db = 0; db < 4; ++db) oacc[db] = mfma16(tr_join(tv[db][0], tv[db][1]), pf, oacc[db]);
}

template <bool LOCAL>
__device__ __forceinline__ void attn_group2(const LAS unsigned char* Kt, const LAS unsigned char* Vt, int koff, int kb, int hsel, int lane, int g4,
                                            const bf16x8 (&q0)[2], const bf16x8 (&q1)[2], f32x4 (&oacc)[2][4], float (&l_run)[2],
                                            int cs, int c, int brow0, int brow1, const LAS float* rp) {
    bf16x8 kf[2][2];
#pragma unroll
    for (int sb = 0; sb < 2; ++sb) { kf[sb][0] = frag16_row(Kt, RS_N, koff + kb + 16 * sb, hsel * 64, lane); kf[sb][1] = frag16_row(Kt, RS_N, koff + kb + 16 * sb, hsel * 64 + 32, lane); }
    f32x4 s[2][2];
#pragma unroll
    for (int qr = 0; qr < 2; ++qr)
#pragma unroll
        for (int sb = 0; sb < 2; ++sb) { s[qr][sb] = (f32x4){0.f, 0.f, 0.f, 0.f};
            s[qr][sb] = mfma16(kf[sb][0], q0[qr], s[qr][sb]); s[qr][sb] = mfma16(kf[sb][1], q1[qr], s[qr][sb]); }
    bf16x8 pf[2];
#pragma unroll
    for (int qr = 0; qr < 2; ++qr) {
        float ps = 0.f; float p[8];
        const int brow = qr ? brow1 : brow0;
#pragma unroll
        for (int sb = 0; sb < 2; ++sb)
#pragma unroll
            for (int j = 0; j < 4; ++j) {
                float e;
                if (LOCAL) { const int kc = kb + 16 * sb + 4 * g4 + j; const bool ok = kc >= cs && kc < cs + 16;
                    const float bv = rp[hsel * 465 + (ok ? brow + (kc - c + 15) : 0)];
                    const float ex = __expf(s[qr][sb][j] + bv - 8.f);
                    e = ok ? ex : 0.f; }
                else e = __expf(s[qr][sb][j] - 8.f);
                p[4 * sb + j] = e; ps += e; }
        l_run[qr] += ps;
        u32x4 pu; pu[0] = pk2(p[0], p[1]); pu[1] = pk2(p[2], p[3]); pu[2] = pk2(p[4], p[5]); pu[3] = pk2(p[6], p[7]);
        pf[qr] = __builtin_bit_cast(bf16x8, pu);
    }
    bf16x4 tv[4][2];
    {
        const int q = (lane & 15) >> 2, p4 = lane & 3;
        const unsigned a = (unsigned)(size_t)(Vt + (koff + kb + 4 * g4 + q) * RS_N + (hsel * 64 + 4 * p4) * 2);
        tr8(a, a + 16 * RS_N, a + 32, a + 32 + 16 * RS_N, a + 64, a + 64 + 16 * RS_N, a + 96, a + 96 + 16 * RS_N,
            tv[0][0], tv[0][1], tv[1][0], tv[1][1], tv[2][0], tv[2][1], tv[3][0], tv[3][1]);
    }
#pragma unroll
    for (int db = 0; db < 4; ++db) { const bf16x8 vf = tr_join(tv[db][0], tv[db][1]);
        oacc[0][db] = mfma16(vf, pf[0], oacc[0][db]); oacc[1][db] = mfma16(vf, pf[1], oacc[1][db]); }
}

constexpr int ATT_QR = 2;
template <int NB>
__device__ __forceinline__ void phase_attn(const bf16* QKV, const float* rpb, bf16* AO, LAS unsigned char* lds) {
    constexpr int TL = NB * SEQ;
    constexpr int TILE = 128 * RS_N;
    const int tid = otid(), lane = tid & 63, wave = tid >> 6, w = wave & 3, hsel = wave >> 2;
    const int qi = lane & 15, g4 = lane >> 4;
    LAS float* rp = (LAS float*)(lds + 4 * TILE);
    constexpr int QR = ATT_QR, NRG = 64 / QR;
    for (int u = blockIdx.x; u < NB * NRG * 8; u += gridDim.x) {
        const int hp = u & 7, rg = (u >> 3) % NRG, b = (u >> 3) / NRG;
        const int head = 2 * hp + hsel;
        int R0 = QR * rg - 4; R0 = R0 < 0 ? 0 : (R0 > 56 ? 56 : R0);
        int R1 = QR * rg + QR - 1 - 4; R1 = (R1 < 0 ? 0 : (R1 > 56 ? 56 : R1)) + 7;
        const int nloc = R1 - R0 + 1, nl2 = (nloc + 1) >> 1, nit = nl2 + 2;
        __syncthreads();
        for (int i = tid; i < 2 * 465; i += NTHR) rp[i] = rpb[(size_t)(2 * hp) * 465 + i];
        const int c = 16 * w + qi;
        int cs = c - 8; cs = cs < 0 ? 0 : (cs > 48 ? 48 : cs);
        const int kbw = w == 0 ? 0 : (w == 1 ? 8 : (w == 2 ? 24 : 32));
        bf16x8 q0[QR], q1[QR]; f32x4 oacc[QR][4]; float l_run[QR];
#pragma unroll
        for (int qr = 0; qr < QR; ++qr) {
            const size_t qrow = (size_t)b * SEQ + (QR * rg + qr) * 64 + c;
            q0[qr] = *(const bf16x8*)(QKV + qrow * 3072 + head * 64 + 8 * g4); q1[qr] = *(const bf16x8*)(QKV + qrow * 3072 + head * 64 + 32 + 8 * g4);
#pragma unroll
            for (int i = 0; i < 4; ++i) oacc[qr][i] = (f32x4){0.f, 0.f, 0.f, 0.f};
            l_run[qr] = 0.f; }
        u32x4 sk[4], sv[4];
#define AT_LOAD(it) do { \
        _Pragma("unroll") for (int i = 0; i < 4; ++i) { const int idx = tid + 512 * i, key = idx >> 4, ch = idx & 15; \
            int kr_ = R0 + 2 * (it) + (key >> 6); kr_ = kr_ > 63 ? 63 : kr_; \
            const size_t krow = (it) < nl2 ? (size_t)b * SEQ + (size_t)kr_ * 64 + (key & 63) : (size_t)TL + (size_t)b * CTXL + ((it) - nl2) * 128 + key; \
            const bf16* kp = QKV + krow * 3072 + 1024 + hp * 128 + ch * 8; sk[i] = *(const u32x4*)kp; sv[i] = *(const u32x4*)(kp + 1024); } } while (0)
#define AT_STORE(buf) do { LAS unsigned char* kt_ = lds + (buf) * 2 * TILE; \
        _Pragma("unroll") for (int i = 0; i < 4; ++i) { const int idx = tid + 512 * i, key = idx >> 4, ch = idx & 15; \
            *(LAS u32x4*)(kt_ + key * RS_N + ch * 16) = sk[i]; *(LAS u32x4*)(kt_ + TILE + key * RS_N + ch * 16) = sv[i]; } } while (0)
        AT_LOAD(0);
        AT_STORE(0);
        __syncthreads();
        for (int it = 0; it < nit; ++it) {
            const LAS unsigned char* Kt = lds + (it & 1) * 2 * TILE; const LAS unsigned char* Vt = Kt + TILE;
            if (it + 1 < nit) AT_LOAD(it + 1);
            if (it < nl2) {
                static_assert(QR == 2, "attn_group2 pairs two query rows");
                const int ra = QR * rg, rb = ra + 1;
                int r0a = ra - 4; r0a = r0a < 0 ? 0 : (r0a > 56 ? 56 : r0a);
                int r0b = rb - 4; r0b = r0b < 0 ? 0 : (r0b > 56 ? 56 : r0b);
#pragma unroll 1
                for (int sub = 0; sub < 2; ++sub) {
                    const int kr = R0 + 2 * it + sub;
                    const bool ina = kr >= r0a && kr < r0a + 8, inb = kr >= r0b && kr < r0b + 8;
                    if (ina && inb) attn_group2<true>(Kt, Vt, 64 * sub, kbw, hsel, lane, g4, q0, q1, oacc, l_run, cs, c, (kr - ra + 7) * 31, (kr - rb + 7) * 31, rp);
                    else if (ina) attn_group<true>(Kt, Vt, 64 * sub, kbw, hsel, lane, g4, q0[0], q1[0], oacc[0], l_run[0], cs, c, (kr - ra + 7) * 31, rp);
                    else if (inb) attn_group<true>(Kt, Vt, 64 * sub, kbw, hsel, lane, g4, q0[1], q1[1], oacc[1], l_run[1], cs, c, (kr - rb + 7) * 31, rp);
                }
            } else {
#pragma unroll 1
                for (int g = 0; g < 4; ++g) attn_group2<false>(Kt, Vt, 0, 32 * g, hsel, lane, g4, q0, q1, oacc, l_run, 0, 0, 0, 0, rp);
            }
            if (it + 1 < nit) AT_STORE((it + 1) & 1);
            __syncthreads();
        }
#undef AT_LOAD
#undef AT_STORE
#pragma unroll
        for (int qr = 0; qr < QR; ++qr) {
            float l = l_run[qr]; l += __shfl_xor(l, 16); l += __shfl_xor(l, 32);
            const float inv = 1.f / l;
            const size_t qrow = (size_t)b * SEQ + (QR * rg + qr) * 64 + c;
            bf16* op = AO + qrow * D + head * 64 + 4 * g4;
#pragma unroll
            for (int db = 0; db < 4; ++db) { u32x2 o; o[0] = pk2(oacc[qr][db][0] * inv, oacc[qr][db][1] * inv); o[1] = pk2(oacc[qr][db][2] * inv, oacc[qr][db][3] * inv); *(u32x2*)(op + 16 * db) = o; }
        }
    }
}
}
namespace fx {
namespace g8 {
constexpr int BM = 256, BK = 64, HALF = 128, HTB = HALF * BK * 2, STAGE_BYTES = 8 * HTB;
__device__ __forceinline__ int lds_byte(int r, int c) { const int st = (r >> 4) * 2 + (c >> 5), rr = r & 15, cc = c & 31, ob = rr * 64 + cc * 2; return st * 1024 + (ob ^ (((ob >> 9) & 1) << 5)); }
__device__ __forceinline__ void stage_rc(int b, int& R, int& C) { const int st = b / 1024, sb = b % 1024, swz = sb ^ (((sb >> 9) & 1) << 5); R = (st >> 1) * 16 + swz / 64; C = (st & 1) * 32 + (swz % 64) / 2; }
__device__ __forceinline__ int perm32(int rho) { const int n = rho >> 4, i = rho & 15; return 8 * (i >> 2) + 4 * n + (i & 3); }
struct Unit { int pm, pn, i0; const int* p; };

template <class Epi, class Sched>
__device__ __forceinline__ void gemm_phase(LAS unsigned char* lds, int K, const Sched& S, const Epi& E) {
    const int tid = otid(), wid = __builtin_amdgcn_readfirstlane(tid >> 6), lane = tid & 63, wr = wid >> 2, wc = wid & 3, fr = lane & 15, fq = lane >> 4;
    const int nt = K / BK;
    int Rr[2], Cc[2]; unsigned voffB[2];
#pragma unroll
    for (int i = 0; i < 2; ++i) { int R, C; stage_rc(tid * 16 + i * 8192, R, C); Rr[i] = R; Cc[i] = C;
        const int Rb = Epi::PERM ? ((R & ~31) + perm32(R & 31)) : R; voffB[i] = (unsigned)(Rb * K + C) * 2u; }
    const size_t kstep = (size_t)(BK * 2);
    const size_t hstepB = (size_t)HALF * K * 2;
    const unsigned ldsw = (unsigned)wid * 1024u;
    const int aoff = lds_byte(wr * 64 + fr, fq * 8), boff = lds_byte(wc * 32 + fr, fq * 8);
#define G8_SA(b, h) (((b) * 2 + (h)) * HTB)
#define G8_SB(b, h) ((4 + (b) * 2 + (h)) * HTB)
#define G8_STAGE_B(bufoff, gbase) do { _Pragma("unroll") for (int _i = 0; _i < 2; ++_i) \
        __builtin_amdgcn_global_load_lds((const unsigned*)((const char*)(gbase) + voffB[_i]), (LAS unsigned*)(lds + (bufoff) + ldsw + _i * 8192), 16, 0, 0); } while (0)
#define G8_STAGE_A(bufoff, gbase, o0, o1) do { \
        __builtin_amdgcn_global_load_lds((const unsigned*)((const char*)(gbase) + (o0)), (LAS unsigned*)(lds + (bufoff) + ldsw), 16, 0, 0); \
        __builtin_amdgcn_global_load_lds((const unsigned*)((const char*)(gbase) + (o1)), (LAS unsigned*)(lds + (bufoff) + ldsw + 8192), 16, 0, 0); } while (0)
#define G8_LDA(dst, b, h) do { _Pragma("unroll") for (int m = 0; m < 4; ++m) _Pragma("unroll") for (int k = 0; k < 2; ++k) dst[m][k] = *(const LAS bf16x8*)(lds + G8_SA(b, h) + aoff + m * 2048 + k * 1024); } while (0)
#define G8_LDB(dst, b, h) do { _Pragma("unroll") for (int n = 0; n < 2; ++n) _Pragma("unroll") for (int k = 0; k < 2; ++k) dst[n][k] = *(const LAS bf16x8*)(lds + G8_SB(b, h) + boff + n * 2048 + k * 1024); } while (0)
#define G8_MMA(ai, bj, At, Bt) do { __builtin_amdgcn_s_setprio(1); _Pragma("unroll") for (int m = 0; m < 4; ++m) _Pragma("unroll") for (int n = 0; n < 2; ++n) _Pragma("unroll") for (int k = 0; k < 2; ++k) \
        acc[ai][bj][m][n] = __builtin_amdgcn_mfma_f32_16x16x32_bf16(Bt[n][k], At[m][k], acc[ai][bj][m][n], 0, 0, 0); __builtin_amdgcn_s_setprio(0); } while (0)
#define G8_WAIT_V(n) asm volatile("s_waitcnt vmcnt(" #n ")" ::: "memory")
#define G8_WAIT_L(n) asm volatile("s_waitcnt lgkmcnt(" #n ")" ::: "memory")
#define G8_BAR __builtin_amdgcn_s_barrier()
#define G8_SCHED __builtin_amdgcn_sched_barrier(0)
    Unit cur, nxt; int ui = 0;
    if (!S.next(0, cur)) return;
    f32x4 acc[2][2][4][2];
#pragma unroll
    for (int a = 0; a < 2; ++a)
#pragma unroll
        for (int b = 0; b < 2; ++b)
#pragma unroll
            for (int m = 0; m < 4; ++m)
#pragma unroll
                for (int n = 0; n < 2; ++n) acc[a][b][m][n] = (f32x4){0.f, 0.f, 0.f, 0.f};
    bf16x8 At[4][2], B0[2][2], B1[2][2];
    unsigned oaC[2][2], oaN[2][2]; const char* cAb; const char* cB; const char* nAb; const char* nB;
    S.src(cur, Rr, Cc, oaC, cAb, cB);
    G8_STAGE_B(G8_SB(0, 0), cB); G8_STAGE_A(G8_SA(0, 0), cAb, oaC[0][0], oaC[0][1]); G8_STAGE_B(G8_SB(0, 1), cB + hstepB); G8_STAGE_A(G8_SA(0, 1), cAb, oaC[1][0], oaC[1][1]);
    if (wr == 1) G8_BAR;
    G8_WAIT_V(4); G8_BAR;
    G8_STAGE_B(G8_SB(1, 0), cB + kstep); G8_STAGE_A(G8_SA(1, 0), cAb + kstep, oaC[0][0], oaC[0][1]); G8_STAGE_B(G8_SB(1, 1), cB + hstepB + kstep);
    G8_WAIT_V(6); G8_BAR;
    for (;;) {
        const bool has_next = S.next(ui + 1, nxt);
        if (has_next) S.src(nxt, Rr, Cc, oaN, nAb, nB);
        else { nAb = cAb; nB = cB;
#pragma unroll
            for (int h = 0; h < 2; ++h)
#pragma unroll
                for (int i = 0; i < 2; ++i) oaN[h][i] = oaC[h][i]; }
        for (int t = 0; t < nt; t += 2) {
            const bool last = (t == nt - 2);
            const char* a1 = cAb + (size_t)(t + 1) * kstep;
            const char* a2 = last ? nAb : cAb + (size_t)(t + 2) * kstep; const char* b2 = last ? nB : cB + (size_t)(t + 2) * kstep;
            const char* a3 = a2 + kstep; const char* b3 = b2 + kstep;
            const unsigned o00 = last ? oaN[0][0] : oaC[0][0], o01 = last ? oaN[0][1] : oaC[0][1], o10 = last ? oaN[1][0] : oaC[1][0], o11 = last ? oaN[1][1] : oaC[1][1];
            G8_LDB(B0, 0, 0); G8_SCHED; G8_LDA(At, 0, 0); G8_STAGE_A(G8_SA(1, 1), a1, oaC[1][0], oaC[1][1]);
            G8_WAIT_L(8); G8_BAR; G8_WAIT_L(0); G8_MMA(0, 0, At, B0); G8_BAR; G8_SCHED;
            G8_LDB(B1, 0, 1); G8_STAGE_B(G8_SB(0, 0), b2);
            G8_BAR; G8_WAIT_L(0); G8_MMA(0, 1, At, B1); G8_BAR;
            G8_LDA(At, 0, 1); G8_STAGE_A(G8_SA(0, 0), a2, o00, o01);
            G8_BAR; G8_WAIT_L(0); G8_MMA(1, 0, At, B0); G8_BAR; G8_SCHED;
            G8_STAGE_B(G8_SB(0, 1), b2 + hstepB);
            G8_WAIT_V(6); G8_BAR; G8_MMA(1, 1, At, B1); G8_BAR;
            G8_LDB(B0, 1, 0); G8_SCHED; G8_LDA(At, 1, 0); G8_STAGE_A(G8_SA(0, 1), a2, o10, o11);
            G8_WAIT_L(8); G8_BAR; G8_WAIT_L(0); G8_MMA(0, 0, At, B0); G8_BAR; G8_SCHED;
            G8_LDB(B1, 1, 1); G8_STAGE_B(G8_SB(1, 0), b3);
            G8_BAR; G8_WAIT_L(0); G8_MMA(0, 1, At, B1); G8_BAR;
            G8_LDA(At, 1, 1); G8_STAGE_A(G8_SA(1, 0), a3, o00, o01);
            G8_BAR; G8_WAIT_L(0); G8_MMA(1, 0, At, B0); G8_BAR; G8_SCHED;
            G8_STAGE_B(G8_SB(1, 1), b3 + hstepB);
            G8_WAIT_V(6); G8_BAR; G8_MMA(1, 1, At, B1); G8_BAR;
        }
        E(acc, cur, wr, wc, fr, fq);
        if (!has_next) break;
#pragma unroll
        for (int a = 0; a < 2; ++a)
#pragma unroll
            for (int b = 0; b < 2; ++b)
#pragma unroll
                for (int m = 0; m < 4; ++m)
#pragma unroll
                    for (int n = 0; n < 2; ++n) acc[a][b][m][n] = (f32x4){0.f, 0.f, 0.f, 0.f};
        cur = nxt; cAb = nAb; cB = nB; ++ui;
#pragma unroll
        for (int h = 0; h < 2; ++h)
#pragma unroll
            for (int i = 0; i < 2; ++i) oaC[h][i] = oaN[h][i];
    }
    G8_WAIT_V(0);
    if (wr == 0) G8_BAR;
    G8_BAR;
#undef G8_SA
#undef G8_SB
#undef G8_STAGE_A
#undef G8_STAGE_B
#undef G8_LDA
#undef G8_LDB
#undef G8_MMA
#undef G8_WAIT_V
#undef G8_WAIT_L
#undef G8_BAR
#undef G8_SCHED
}

struct DenseSched {
    const bf16* A; int lda; const bf16* Bt; int K; int MT, NT; int F;
    __device__ __forceinline__ bool next(int i, Unit& u) const { const int G = gridDim.x; if (i >= F || i * G >= MT * NT) return false; const int ul = xcd_unit(i); if (ul >= MT * NT) return false;
        int mt, nt_; unit_tile(ul, MT, NT, mt, nt_); u.pm = mt; u.pn = nt_; u.i0 = 0; u.p = nullptr; return true; }
    __device__ __forceinline__ void src(const Unit& u, const int (&R)[2], const int (&C)[2], unsigned (&oa)[2][2], const char*& abase, const char*& bbase) const {
        abase = (const char*)(A + (size_t)u.pm * 256 * lda); bbase = (const char*)(Bt + (size_t)u.pn * 256 * K);
#pragma unroll
        for (int h = 0; h < 2; ++h)
#pragma unroll
            for (int i = 0; i < 2; ++i) oa[h][i] = (unsigned)((128 * h + R[i]) * lda + C[i]) * 2u; }
};
}

struct EpiProj {
    static constexpr bool PERM = true;
    bf16* O; int ldc;
    __device__ __forceinline__ void operator()(const f32x4 (&acc)[2][2][4][2], const g8::Unit& u, int wr, int wc, int fr, int fq) const {
        const int row0 = u.pm * 256 + wr * 64 + fr, col0 = u.pn * 256 + wc * 32 + 8 * fq;
#pragma unroll
        for (int ai = 0; ai < 2; ++ai)
#pragma unroll
            for (int m = 0; m < 4; ++m) { bf16* rowp = O + (size_t)(row0 + ai * 128 + m * 16) * ldc + col0;
#pragma unroll
                for (int bj = 0; bj < 2; ++bj) { const f32x4 v0 = acc[ai][bj][m][0], v1 = acc[ai][bj][m][1];
                    u32x4 w; w[0] = pk2(v0[0], v0[1]); w[1] = pk2(v0[2], v0[3]); w[2] = pk2(v1[0], v1[1]); w[3] = pk2(v1[2], v1[3]);
                    *(u32x4*)(rowp + bj * 128) = w; } }
    }
};
template <int NB>
__device__ __forceinline__ void phase_inproj8(const bf16* H, const bf16* Wt, bf16* PROJ, float* GATES, LAS unsigned char* lds) {
    constexpr int T = NB * (SEQ + CTXL), MT = T / 256;
    g8::DenseSched S{H, D, Wt, D, MT, PROJW / 256, 1 << 20};
    EpiProj E{PROJ, PROJW};
    g8::gemm_phase(lds, D, S, E);
    for (int mt = blockIdx.x; mt < MT; mt += gridDim.x) {
        const bf16* arow[4];
#pragma unroll
        for (int i = 0; i < 4; ++i) arow[i] = H + (size_t)(mt * 256 + (otid() >> 3) + 64 * i) * D;
        gemm_tile(arow, Wt + (size_t)PROJW * D, D, D, lds, [&](const f32x16 (&acc)[2][2], int wm, int wn, int lane) {
            if (wn == 0) {
#pragma unroll
                for (int mi = 0; mi < 2; ++mi) { const int row = mt * 256 + wm * 64 + mi * 32 + (lane & 31);
#pragma unroll
                    for (int ni = 0; ni < 2; ++ni)
#pragma unroll
                        for (int g = 0; g < 4; ++g) { f32x4 o; o[0] = acc[mi][ni][4 * g]; o[1] = acc[mi][ni][4 * g + 1]; o[2] = acc[mi][ni][4 * g + 2]; o[3] = acc[mi][ni][4 * g + 3];
                            *(f32x4*)(GATES + (size_t)row * 64 + ni * 32 + 8 * g + 4 * (lane >> 5)) = o; } } }
        });
        __syncthreads();
    }
}
template <int NB, bool XIN_BF> struct EpiResid {
    static constexpr bool PERM = true;
    const float* xl; const float* xc; const float* modl; bf16* Xout;
    __device__ __forceinline__ void operator()(const f32x4 (&acc)[2][2][4][2], const g8::Unit& u, int wr, int wc, int fr, int fq) const {
        constexpr int TL = NB * SEQ;
        const float* mv = modl + (size_t)mod_row<NB>(u.pm * 256) * 6144 + 2 * 1024;
        const int col0 = u.pn * 256 + wc * 32 + 8 * fq;
#pragma unroll
        for (int ai = 0; ai < 2; ++ai)
#pragma unroll
            for (int m = 0; m < 4; ++m) { const int row = u.pm * 256 + ai * 128 + wr * 64 + m * 16 + fr;
                const size_t soff = (row < TL ? (size_t)row * D : (size_t)(row - TL) * D) + col0;
                bf16* dstp = Xout + (size_t)row * D + col0;
#pragma unroll
                for (int bj = 0; bj < 2; ++bj) { const int co = bj * 128;
                    f32x4 x0, x1;
                    if (XIN_BF) { const u32x4 t4 = *(const u32x4*)((const bf16*)(row < TL ? xl : xc) + soff + co);
                        x0 = (f32x4){bflo(t4[0]), bfhi(t4[0]), bflo(t4[1]), bfhi(t4[1])}; x1 = (f32x4){bflo(t4[2]), bfhi(t4[2]), bflo(t4[3]), bfhi(t4[3])}; }
                    else { const float* sp = (row < TL ? xl : xc) + soff + co; x0 = *(const f32x4*)sp; x1 = *(const f32x4*)(sp + 4); }
                    const f32x4 m0 = *(const f32x4*)(mv + col0 + co), m1 = *(const f32x4*)(mv + col0 + co + 4);
                    float o[8];
#pragma unroll
                    for (int j = 0; j < 4; ++j) { o[j] = x0[j] + m0[j] * acc[ai][bj][m][0][j]; o[4 + j] = x1[j] + m1[j] * acc[ai][bj][m][1][j]; }
                    u32x4 w; w[0] = pk2(o[0], o[1]); w[1] = pk2(o[2], o[3]); w[2] = pk2(o[4], o[5]); w[3] = pk2(o[6], o[7]);
                    *(u32x4*)(dstp + co) = w; } }
    }
};
template <int NB, bool XIN_BF, class Idle>
__device__ __forceinline__ void phase_outproj8(const bf16* A, int lda, int K, const bf16* Wt, int nrows, const float* xl, const float* xc, const float* modl, bf16* Xout, LAS unsigned char* lds, Idle&& idle) {
    constexpr int TL = NB * SEQ;
    const int MT = nrows / 256, U = MT * 4, G = gridDim.x, F = U / G, R = U - F * G;
    if (F > 0) { g8::DenseSched S{A, lda, Wt, K, MT, 4, F}; EpiResid<NB, XIN_BF> E{xl, xc, modl, Xout}; g8::gemm_phase(lds, K, S, E); }
    for (int r = 0; r * G < 2 * R; ++r) {
        const int hu = r * G + (int)blockIdx.x;
        if (hu >= 2 * R) { idle(hu - 2 * R, (r + 1) * G - 2 * R); continue; }
        int mt, nt2; unit_tile(F * G + (hu >> 1), MT, 4, mt, nt2);
        const int nt = 2 * nt2 + (hu & 1);
        const bf16* arow[4];
#pragma unroll
        for (int i = 0; i < 4; ++i) arow[i] = A + (size_t)(mt * 256 + (otid() >> 3) + 64 * i) * lda;
        gemm_tile(arow, Wt + (size_t)nt * 128 * K, K, K, lds, [&](const f32x16 (&acc)[2][2], int wm, int wn, int lane) { stage_f32_128(acc, lds, wm, wn, lane); });
        __syncthreads();
        {
            const float* mv = modl + (size_t)mod_row<NB>(mt * 256) * 6144 + 2 * 1024 + nt * 128;
            const int t = otid(), piece = t & 31;
            const f32x4 m2 = *(const f32x4*)(mv + piece * 4);
#pragma unroll 4
            for (int it = 0; it < 16; ++it) { const int rl = it * 16 + (t >> 5), row = mt * 256 + rl;
                const f32x4 a = *(const LAS f32x4*)(lds + rl * CST_F32 + piece * 16);
                const size_t soff = (row < TL ? (size_t)row * D : (size_t)(row - TL) * D) + nt * 128 + piece * 4;
                f32x4 xv;
                if (XIN_BF) { const u32x2 t2 = *(const u32x2*)((const bf16*)(row < TL ? xl : xc) + soff); xv = (f32x4){bflo(t2[0]), bfhi(t2[0]), bflo(t2[1]), bfhi(t2[1])}; }
                else xv = *(const f32x4*)((row < TL ? xl : xc) + soff);
                u32x2 o2; o2[0] = pk2(xv[0] + m2[0] * a[0], xv[1] + m2[1] * a[1]); o2[1] = pk2(xv[2] + m2[2] * a[2], xv[3] + m2[3] * a[3]);
                *(u32x2*)(Xout + (size_t)row * D + nt * 128 + piece * 4) = o2; }
        }
        __syncthreads();
    }
}
template <bool UP> struct MoeSched {
    const bf16* Abuf; const bf16* W; const int* cnt; const int* list; int cap; const LAS int* pre; int ntile; int F;
    static constexpr int KK = UP ? 1024 : 512;
    __device__ __forceinline__ bool next(int i, g8::Unit& u) const { const int G = gridDim.x; if (i >= F) return false; const int ul = xcd_unit(i); if (ul >= ntile * 4) return false;
        const int t = ul >> 2, e = moe_find(pre, t), mt = t - pre[e]; u.pm = e; u.pn = ul & 3; u.i0 = cnt[e * 64] - mt * 256; u.p = list + (size_t)e * cap + mt * 256; return true; }
    __device__ __forceinline__ void src(const g8::Unit& u, const int (&R)[2], const int (&C)[2], unsigned (&oa)[2][2], const char*& abase, const char*& bbase) const {
        abase = (const char*)Abuf; bbase = (const char*)(W + (size_t)u.pm * 1024 * KK + (size_t)u.pn * 256 * KK);
#pragma unroll
        for (int h = 0; h < 2; ++h)
#pragma unroll
            for (int i = 0; i < 2; ++i) { const int r = 128 * h + R[i]; const int ent = u.p[r < u.i0 ? r : 0];
                oa[h][i] = (unsigned)((UP ? (ent >> 1) * 1024 : ent * 512) + C[i]) * 2u; } }
};
struct EpiMoeUp8 {
    static constexpr bool PERM = true;
    const float* route_w; bf16* ACT;
    __device__ __forceinline__ void operator()(const f32x4 (&acc)[2][2][4][2], const g8::Unit& u, int wr, int wc, int fr, int fq) const {
#pragma unroll
        for (int ai = 0; ai < 2; ++ai)
#pragma unroll
            for (int m = 0; m < 4; ++m) { const int r = ai * 128 + wr * 64 + m * 16 + fr;
                if (r < u.i0) { const int ent = u.p[r]; const float w = route_w[ent];
                    float v[8];
#pragma unroll
                    for (int n = 0; n < 2; ++n)
#pragma unroll
                        for (int j = 0; j < 4; ++j) v[4 * n + j] = siluf(acc[ai][0][m][n][j]) * acc[ai][1][m][n][j] * w;
                    u32x4 o; o[0] = pk2(v[0], v[1]); o[1] = pk2(v[2], v[3]); o[2] = pk2(v[4], v[5]); o[3] = pk2(v[6], v[7]);
                    *(u32x4*)(ACT + (size_t)ent * 512 + u.pn * 128 + wc * 32 + 8 * fq) = o; } }
    }
};
struct EpiMoeDown8 {
    static constexpr bool PERM = true;
    bf16* Y2;
    __device__ __forceinline__ void operator()(const f32x4 (&acc)[2][2][4][2], const g8::Unit& u, int wr, int wc, int fr, int fq) const {
#pragma unroll
        for (int ai = 0; ai < 2; ++ai)
#pragma unroll
            for (int m = 0; m < 4; ++m) { const int r = ai * 128 + wr * 64 + m * 16 + fr;
                if (r < u.i0) { bf16* rowp = Y2 + (size_t)u.p[r] * D + u.pn * 256 + wc * 32 + 8 * fq;
#pragma unroll
                    for (int bj = 0; bj < 2; ++bj) { const f32x4 v0 = acc[ai][bj][m][0], v1 = acc[ai][bj][m][1];
                        u32x4 o; o[0] = pk2(v0[0], v0[1]); o[1] = pk2(v0[2], v0[3]); o[2] = pk2(v1[0], v1[1]); o[3] = pk2(v1[2], v1[3]);
                        *(u32x4*)(rowp + bj * 128) = o; } } }
    }
};
struct BRowGU { int s; __device__ __forceinline__ int operator()(int r) const { return ((r >> 5) & 1) * 128 + 64 * s + (r >> 6) * 32 + (r & 31); } };

__device__ __forceinline__ void phase_moe_up8(const bf16* H2, const bf16* Wgu, const int* cnt, const int* list, int cap, const float* route_w, bf16* ACT, LAS unsigned char* lds) {
    LAS int* pre = (LAS int*)(lds + GEMM_LDS);
    const int ntile = moe_prefix(cnt, pre);
    const int G = gridDim.x, U = ntile * 4, F = U / G, R = U - F * G;
    if (F > 0) { MoeSched<true> S{H2, Wgu, cnt, list, cap, pre, ntile, F}; EpiMoeUp8 E{route_w, ACT}; g8::gemm_phase(lds, 1024, S, E); }
    for (int r = 0; r * G < 2 * R; ++r) {
        const int hu = r * G + (int)blockIdx.x; if (hu >= 2 * R) continue;
        const int ul = F * G + (hu >> 1), s = hu & 1, t = ul >> 2, pn = ul & 3, e = moe_find(pre, t), mt = t - pre[e], ce = cnt[e * 64];
        const int* le = list + (size_t)e * cap + mt * 256;
        const int nvalid = ce - mt * 256;
        const bf16* arow[4];
#pragma unroll
        for (int i = 0; i < 4; ++i) { const int rr = (otid() >> 3) + 64 * i; const int ent = le[rr < nvalid ? rr : 0]; arow[i] = H2 + (size_t)(ent >> 1) * D; }
        gemm_tile(arow, Wgu + (size_t)e * 1024 * 1024 + (size_t)pn * 256 * 1024, 1024, 1024, lds, [&](const f32x16 (&acc)[2][2], int wm, int wn, int lane) {
#pragma unroll
            for (int mi = 0; mi < 2; ++mi) { const int rr = wm * 64 + mi * 32 + (lane & 31);
                const float w = rr < nvalid ? route_w[le[rr]] : 0.f;
                LAS unsigned char* rp = lds + rr * CST_BF64 + (wn * 32 + 4 * (lane >> 5)) * 2;
#pragma unroll
                for (int g = 0; g < 4; ++g) { float v[4];
#pragma unroll
                    for (int j = 0; j < 4; ++j) v[j] = siluf(acc[mi][0][4 * g + j]) * acc[mi][1][4 * g + j] * w;
                    u32x2 o; o[0] = pk2(v[0], v[1]); o[1] = pk2(v[2], v[3]); *(LAS u32x2*)(rp + 8 * g * 2) = o; } }
        }, BRowGU{s});
        __syncthreads();
        flush_bf16_64(lds, [&](int rr) -> bf16* { return rr < nvalid ? ACT + (size_t)le[rr] * 512 + pn * 128 + 64 * s : nullptr; });
        __syncthreads();
    }
}
__device__ __forceinline__ void phase_moe_down8(const bf16* ACT, const bf16* Wd, const int* cnt, const int* list, int cap, bf16* Y2, LAS unsigned char* lds) {
    LAS int* pre = (LAS int*)(lds + GEMM_LDS);
    const int ntile = moe_prefix(cnt, pre);
    const int G = gridDim.x, U = ntile * 4, F = U / G, R = U - F * G;
    if (F > 0) { MoeSched<false> S{ACT, Wd, cnt, list, cap, pre, ntile, F}; EpiMoeDown8 E{Y2}; g8::gemm_phase(lds, 512, S, E); }
    for (int r = 0; r * G < 2 * R; ++r) {
        const int hu = r * G + (int)blockIdx.x; if (hu >= 2 * R) continue;
        const int ul = F * G + (hu >> 1), t = ul >> 2, nt = 2 * (ul & 3) + (hu & 1), e = moe_find(pre, t), mt = t - pre[e], ce = cnt[e * 64];
        const int* le = list + (size_t)e * cap + mt * 256;
        const int nvalid = ce - mt * 256;
        const bf16* arow[4];
#pragma unroll
        for (int i = 0; i < 4; ++i) { const int rr = (otid() >> 3) + 64 * i; const int ent = le[rr < nvalid ? rr : 0]; arow[i] = ACT + (size_t)ent * 512; }
        gemm_tile(arow, Wd + (size_t)e * 1024 * 512 + (size_t)nt * 128 * 512, 512, 512, lds, [&](const f32x16 (&acc)[2][2], int wm, int wn, int lane) { stage_bf16_128(acc, lds, wm, wn, lane); });
        __syncthreads();
        flush_bf16_128(lds, [&](int rr) -> bf16* { return rr < nvalid ? Y2 + (size_t)le[rr] * D + nt * 128 : nullptr; });
        __syncthreads();
    }
}
struct EpiQKV8 {
    static constexpr bool PERM = true;
    const float* qn; const float* kn; bf16* QKV; LAS float* xbuf;
    __device__ __forceinline__ void operator()(const f32x4 (&acc)[2][2][4][2], const g8::Unit& u, int wr, int wc, int fr, int fq) const {
        const int which = u.pn >> 2, wid = wr * 4 + wc;
        float rs[2][4][2];
        if (which < 2) {
#pragma unroll
            for (int ai = 0; ai < 2; ++ai)
#pragma unroll
                for (int m = 0; m < 4; ++m)
#pragma unroll
                    for (int bj = 0; bj < 2; ++bj) { float ss = 0.f;
#pragma unroll
                        for (int n = 0; n < 2; ++n)
#pragma unroll
                            for (int j = 0; j < 4; ++j) ss += acc[ai][bj][m][n][j] * acc[ai][bj][m][n][j];
                        ss += __shfl_xor(ss, 16); ss += __shfl_xor(ss, 32);
                        rs[ai][m][bj] = ss;
                        if (fq == 0) xbuf[(wid * 16 + (ai * 4 + m) * 2 + bj) * 16 + fr] = ss; }
        }
        asm volatile("s_waitcnt lgkmcnt(0)" ::: "memory");
        __builtin_amdgcn_s_barrier();
        asm volatile("" ::: "memory");
        const float* nwp = which == 0 ? qn : kn;
        const int hc = (wc & 1) * 32 + 8 * fq;
#pragma unroll
        for (int ai = 0; ai < 2; ++ai)
#pragma unroll
            for (int m = 0; m < 4; ++m) { const int row = u.pm * 256 + ai * 128 + wr * 64 + m * 16 + fr;
                bf16* rowp = QKV + (size_t)row * 3072 + u.pn * 256 + wc * 32 + 8 * fq;
#pragma unroll
                for (int bj = 0; bj < 2; ++bj) { f32x4 v0 = acc[ai][bj][m][0], v1 = acc[ai][bj][m][1];
                    if (which < 2) {
                        const float tot = rs[ai][m][bj] + xbuf[((wid ^ 1) * 16 + (ai * 4 + m) * 2 + bj) * 16 + fr];
                        const float sc = rsqrtf(tot * (1.f / 64.f) + 1e-6f) * (which == 0 ? 0.125f : 1.f);
                        const f32x4 w0 = *(const f32x4*)(nwp + hc), w1 = *(const f32x4*)(nwp + hc + 4);
#pragma unroll
                        for (int j = 0; j < 4; ++j) { v0[j] *= sc * w0[j]; v1[j] *= sc * w1[j]; } }
                    u32x4 o; o[0] = pk2(v0[0], v0[1]); o[1] = pk2(v0[2], v0[3]); o[2] = pk2(v1[0], v1[1]); o[3] = pk2(v1[2], v1[3]);
                    *(u32x4*)(rowp + bj * 128) = o; } }
    }
};
template <int NB>
__device__ __forceinline__ void phase_qkv8(const bf16* H, const bf16* Wt, const float* qn, const float* kn, bf16* QKV, LAS unsigned char* lds) {
    constexpr int T = NB * (SEQ + CTXL), MT = T / 256, U = MT * 12;
    const int G = gridDim.x, F = U / G, R = U - F * G;
    if (F > 0) { g8::DenseSched S{H, D, Wt, D, MT, 12, F}; EpiQKV8 E{qn, kn, QKV, (LAS float*)(lds + g8::STAGE_BYTES)}; g8::gemm_phase(lds, D, S, E); }
    for (int r = 0; r * G < 2 * R; ++r) {
        const int hu = r * G + (int)blockIdx.x; if (hu >= 2 * R) continue;
        int mt, nt2; unit_tile(F * G + (hu >> 1), MT, 12, mt, nt2);
        const int nt = 2 * nt2 + (hu & 1);
        const bf16* arow[4];
#pragma unroll
        for (int i = 0; i < 4; ++i) arow[i] = H + (size_t)(mt * 256 + (otid() >> 3) + 64 * i) * D;
        gemm_tile(arow, Wt + (size_t)nt * 128 * D, D, D, lds, [&](const f32x16 (&acc)[2][2], int wm, int wn, int lane) {
            const int which = nt >> 3;
#pragma unroll
            for (int mi = 0; mi < 2; ++mi) {
                float rsv = 1.f;
                if (which < 2) { float ss = 0.f;
#pragma unroll
                    for (int ni = 0; ni < 2; ++ni)
#pragma unroll
                        for (int q = 0; q < 16; ++q) ss += acc[mi][ni][q] * acc[mi][ni][q];
                    ss += __shfl_xor(ss, 32);
                    rsv = rsqrtf(ss * (1.f / 64.f) + 1e-6f) * (which == 0 ? 0.125f : 1.f); }
                const float* nwp = which == 0 ? qn : kn;
                LAS unsigned char* rp = lds + (wm * 64 + mi * 32 + (lane & 31)) * CST_BF + (wn * 64 + 4 * (lane >> 5)) * 2;
#pragma unroll
                for (int ni = 0; ni < 2; ++ni)
#pragma unroll
                    for (int g = 0; g < 4; ++g) { float v[4];
#pragma unroll
                        for (int j = 0; j < 4; ++j) { v[j] = acc[mi][ni][4 * g + j]; if (which < 2) v[j] *= rsv * nwp[ni * 32 + 8 * g + 4 * (lane >> 5) + j]; }
                        u32x2 o; o[0] = pk2(v[0], v[1]); o[1] = pk2(v[2], v[3]); *(LAS u32x2*)(rp + (ni * 32 + 8 * g) * 2) = o; } }
        });
        __syncthreads();
        flush_bf16_128(lds, [&](int rr) { return QKV + (size_t)(mt * 256 + rr) * 3072 + nt * 128; });
        __syncthreads();
    }
}
}
#define XB_TMO      128
#define XB_XCNT(j)  (256  + 64 * (j))
#define XB_XSUB(j)  (1280 + 64 * (j))
#define XB_XGEN(j)  (2304 + 64 * (j))
#define XB_TOP      3328
#define XB_TOPGEN   3392
#define XCD_BAR_WORDS 3456
#define XB_SPIN_CAP (1u << 18)

__device__ __forceinline__ unsigned xb_ld(unsigned* p)              { return __hip_atomic_load(p, __ATOMIC_RELAXED, __HIP_MEMORY_SCOPE_AGENT); }
__device__ __forceinline__ unsigned xb_add(unsigned* p, unsigned v) { return __hip_atomic_fetch_add(p, v, __ATOMIC_RELAXED, __HIP_MEMORY_SCOPE_AGENT); }
__device__ __forceinline__ unsigned xb_xcc_id() { return (unsigned)__builtin_amdgcn_s_getreg((3 << 11) | 20) & 0xFu; }
#define XB_SPIN(cond, bar) do { unsigned _sp = 0; while (cond) { __builtin_amdgcn_s_sleep(1); \
    if ((++_sp & 255u) == 0u) { if (xb_ld(&(bar)[XB_TMO])) break; if (_sp > XB_SPIN_CAP) { atomicAdd(&(bar)[XB_TMO], 1u); break; } } } } while (0)

struct XcdBarrier {
    unsigned* bar; unsigned x;
    volatile LAS unsigned* st;
};

__device__ __forceinline__ XcdBarrier xcd_barrier_post(unsigned* bar, volatile LAS unsigned* st) {
    XcdBarrier b; b.bar = bar; b.x = xb_xcc_id(); b.st = st;
    if (threadIdx.x == 0) (void)xb_add(&bar[XB_XCNT(b.x)], 1u);
    return b;
}
__device__ __forceinline__ void xcd_barrier_complete(unsigned* bar, unsigned x, unsigned& nloc, unsigned& nx) {
    const unsigned G = gridDim.x * gridDim.y * gridDim.z;
    unsigned sum, cnt, mine, sp = 0u;
    for (;;) {
        sum = 0u; cnt = 0u; mine = 0u;
#pragma unroll
        for (unsigned j = 0; j < 16; ++j) { const unsigned c = xb_ld(&bar[XB_XCNT(j)]); sum += c; cnt += (c > 0u) ? 1u : 0u; mine = (j == x) ? c : mine; }
        if (sum == G) break;
        __builtin_amdgcn_s_sleep(1);
        if ((++sp & 255u) == 0u) { if (xb_ld(&bar[XB_TMO])) break; if (sp > XB_SPIN_CAP) { atomicAdd(&bar[XB_TMO], 1u); break; } }
    }
    nloc = mine > 0u ? mine : 1u; nx = cnt > 0u ? cnt : 1u;
}

__device__ __forceinline__ void xcd_barrier(const XcdBarrier& b) {
    asm volatile("s_waitcnt vmcnt(0)" ::: "memory");
    __syncthreads();
    if (threadIdx.x == 0) {
        unsigned* bar = b.bar;
        __builtin_amdgcn_s_waitcnt(0);
        unsigned nloc = b.st[0], nx = b.st[1];
        if (nloc == 0u) { xcd_barrier_complete(bar, b.x, nloc, nx); b.st[0] = nloc; b.st[1] = nx; }
        const unsigned old = xb_add(&bar[XB_XSUB(b.x)], 1u);
        const unsigned gen = old / nloc;
        if (old + 1u == (gen + 1u) * nloc) {
            __builtin_amdgcn_fence(__ATOMIC_RELEASE, "agent");
            asm volatile("s_waitcnt vmcnt(0)" ::: "memory");
            const unsigned og = xb_add(&bar[XB_TOP], 1u);
            const unsigned tg = og / nx;
            if (og + 1u == (tg + 1u) * nx) xb_add(&bar[XB_TOPGEN], 1u);
            else XB_SPIN(xb_ld(&bar[XB_TOPGEN]) == tg, bar);
            __builtin_amdgcn_fence(__ATOMIC_ACQUIRE, "agent");
            xb_add(&bar[XB_XGEN(b.x)], 1u);
            asm volatile("s_waitcnt vmcnt(0)" ::: "memory");
        } else {
            XB_SPIN(xb_ld(&bar[XB_XGEN(b.x)]) == gen, bar);
            __builtin_amdgcn_fence(__ATOMIC_ACQUIRE, "agent");
            asm volatile("s_waitcnt vmcnt(0)" ::: "memory");
        }
    }
    __syncthreads();
}
namespace mk {
using namespace fx;
constexpr int NB = 4;
typedef Plan<NB> PL;

__global__ void __launch_bounds__(512, 2) k_mega(P p) {
    extern __shared__ __attribute__((aligned(16))) unsigned char lds_raw[];
    LAS unsigned char* lds = (LAS unsigned char*)lds_raw;
    unsigned char* ws = p.ws;
    const In& in = p.in;
    LAS unsigned* xbw = (LAS unsigned*)(lds + LDS_BYTES - 16);
    if (threadIdx.x == 0) { xbw[0] = 0u; xbw[1] = 0u; xbw[2] = 0u; xbw[3] = 0u; }
    __syncthreads();
    XcdBarrier bar = xcd_barrier_post((unsigned*)(ws + PL::CTL_BAR), (volatile LAS unsigned*)xbw);
    float* modv = (float*)(ws + PL::MODV);
    const float* mod0 = modv; const float* mod1 = modv + 5 * 6144;
    bf16* H = (bf16*)(ws + PL::H);
    int* cnt0 = (int*)(ws + PL::CTL_CNT); int* cnt1 = cnt0 + 32 * 64;
    int* list = (int*)(ws + PL::LIST); float* rw = (float*)(ws + PL::RW);
    bf16* wmoe0 = (bf16*)(ws + PL::W_MOE0); bf16* wmoe1 = (bf16*)(ws + PL::W_MOE1);
    const size_t GU = (size_t)32 * 1024 * 1024;
    float* X1 = (float*)(ws + PL::X1); float* X2 = (float*)(ws + PL::X2); float* X3 = (float*)(ws + PL::X3);
    const float* X1c = (const float*)((const bf16*)X1 + PL::TL * D); const float* X2c = (const float*)((const bf16*)X2 + PL::TL * D);
#ifndef MOE1_EARLY
#define MOE1_EARLY 1792
#endif
#ifndef REPMASK
#define REPMASK 0
#endif
#ifndef XBAR
#define XBAR 0
#endif
#define PH(k, ...) { __VA_ARGS__; xcd_barrier(bar); if ((REPMASK >> (k)) & 1) { __VA_ARGS__; xcd_barrier(bar); } }
    PH(0, conv_small_weights(in, ws, PL::W_IN, PL::W_OUT, PL::W_QKV, PL::W_NAO, lds); mod_vectors(in, modv, lds); conv_moe_weights(in, 0, wmoe0, wmoe0 + GU, lds))
    for (int i = 0; i < XBAR; ++i) xcd_barrier(bar);
    PH(1, rows_phase<NB, false, false, true, false>(in.x, in.ctx, PL::T, nullptr, mod0, mod0, nullptr, nullptr, in.norm1_w, 0, 1, H,
                                              nullptr, nullptr, nullptr, nullptr, nullptr, nullptr, nullptr, 0, lds))
    phase_inproj8<NB>(H, (const bf16*)(ws + PL::W_IN), (bf16*)(ws + PL::PROJ), (float*)(ws + PL::GATES), lds);
    xcd_barrier(bar);
#ifdef GVAR
    phase_inproj_v<NB, GVAR>(H, (const bf16*)(ws + PL::W_IN), (bf16*)(ws + PL::PROJ), (float*)(ws + PL::GATES), lds, p.out == nullptr);
    xcd_barrier(bar);
#endif
    PH(3, phase_tables<NB>(in, (const float*)(ws + PL::GATES), ws + PL::H, lds); phase_conv<NB>((const bf16*)(ws + PL::PROJ), in.ab_conv_w, in.ab_conv_b, (bf16*)(ws + PL::XBC)))
    phase_scan<NB>((const bf16*)(ws + PL::PROJ), ws + PL::H, (const bf16*)(ws + PL::XBC), (bf16*)(ws + PL::SC), lds);
    xcd_barrier(bar);
#ifdef SCANMODE
    phase_scan<NB>((const bf16*)(ws + PL::PROJ), ws + PL::H, (const bf16*)(ws + PL::XBC), (bf16*)(ws + PL::SC), lds, p.out ? SCANMODE : 3);
    xcd_barrier(bar);
#endif
#ifdef REP5
    phase_mixer_out<NB>(in, (const bf16*)(ws + PL::PROJ), (const bf16*)(ws + PL::XBC), (bf16*)(ws + PL::SC), (bf16*)(ws + PL::W_MOE1));
    xcd_barrier(bar);
#endif
    phase_mixer_out<NB>(in, (const bf16*)(ws + PL::PROJ), (const bf16*)(ws + PL::XBC), (bf16*)(ws + PL::SC));
    xcd_barrier(bar);
    PH(6, phase_outproj8<NB, false>((const bf16*)(ws + PL::SC), 4096, 2048, (const bf16*)(ws + PL::W_OUT), PL::T, in.x, in.ctx, mod0, (bf16*)X1, lds,
        [&](int rank, int nidle) { conv_moe_weights(in, 1, wmoe1, wmoe1 + GU, lds, 0, MOE1_EARLY, rank, nidle); }))
    rows_phase<NB, false, false, true, true, true>(X1, X1c, PL::T, nullptr, mod0, mod0, nullptr, nullptr, in.norm2_w, 3, 4, H,
        in.moe_w_group, in.moe_b_group, in.moe_w_expert, in.moe_b_expert, rw, cnt0, list, (int)PL::T, lds);
    PH(7, conv_moe_weights(in, 1, wmoe1, wmoe1 + GU, lds, MOE1_EARLY, MOE_CONV_UNITS))
    PH(8, phase_moe_up8(H, wmoe0, cnt0, list, (int)PL::T, rw, (bf16*)(ws + PL::ACT), lds))
    PH(9, phase_moe_down8((const bf16*)(ws + PL::ACT), wmoe0 + GU, cnt0, list, (int)PL::T, (bf16*)(ws + PL::Y2), lds))
    PH(10, rows_phase<NB, true, true, true, false, true>(X1, X1c, PL::T, (const bf16*)(ws + PL::Y2), mod0, mod1, X2, nullptr, in.norm1_w + 1024, 0, 1, H,
        nullptr, nullptr, nullptr, nullptr, nullptr, nullptr, nullptr, 0, lds))
    PH(11, phase_qkv8<NB>(H, (const bf16*)(ws + PL::W_QKV), in.na_q_norm, in.na_k_norm, (bf16*)(ws + PL::QKV), lds))
    PH(12, phase_attn<NB>((const bf16*)(ws + PL::QKV), in.na_rpb, (bf16*)(ws + PL::AO), lds))
    PH(13, phase_outproj8<NB, true>((const bf16*)(ws + PL::AO), 1024, 1024, (const bf16*)(ws + PL::W_NAO), PL::TL, X2, X2c, mod1, (bf16*)X3, lds, [](int, int) {}))
    rows_phase<NB, false, false, true, true, true>(X3, X3, PL::TL, nullptr, mod1, mod1, nullptr, nullptr, in.norm2_w + 1024, 3, 4, H,
        in.moe_w_group + 1024 * 4, in.moe_b_group + 4, in.moe_w_expert + 1024 * 32, in.moe_b_expert + 32, rw, cnt1, list, (int)PL::T, lds);
    xcd_barrier(bar);
    PH(15, phase_moe_up8(H, wmoe1, cnt1, list, (int)PL::T, rw, (bf16*)(ws + PL::ACT), lds))
    PH(16, phase_moe_down8((const bf16*)(ws + PL::ACT), wmoe1 + GU, cnt1, list, (int)PL::T, (bf16*)(ws + PL::Y2), lds))
    rows_phase<NB, true, false, false, false, true>(X3, X3, PL::TL, (const bf16*)(ws + PL::Y2), mod1, mod1, nullptr, p.out, nullptr, 0, 0, nullptr,
        nullptr, nullptr, nullptr, nullptr, nullptr, nullptr, nullptr, 0, lds);
    if ((REPMASK >> 17) & 1) { xcd_barrier(bar); rows_phase<NB, true, false, false, false, true>(X3, X3, PL::TL, (const bf16*)(ws + PL::Y2), mod1, mod1, nullptr, p.out, nullptr, 0, 0, nullptr,
        nullptr, nullptr, nullptr, nullptr, nullptr, nullptr, nullptr, 0, lds); }
#undef PH
}
__global__ void k_fill(float* q, size_t n, float v) { size_t i = (size_t)blockIdx.x * 256 + threadIdx.x; if (i < n) q[i] = v; }
}

extern "C" void kernel_launch(void* const* d_in, const int* in_sizes, int n_in, void* d_out, int out_size, void* d_ws, size_t ws_size, hipStream_t stream) {
    static int grid = 0;
    if (grid == 0) {
        int dev = 0, cus = 0, per_cu = 0;
        (void)hipGetDevice(&dev);
        (void)hipDeviceGetAttribute(&cus, hipDeviceAttributeMultiprocessorCount, dev);
        if (hipFuncSetAttribute((const void*)mk::k_mega, hipFuncAttributeMaxDynamicSharedMemorySize, fx::LDS_BYTES) != hipSuccess) { grid = -1; }
        else {
            if (hipOccupancyMaxActiveBlocksPerMultiprocessor(&per_cu, (const void*)mk::k_mega, 512, fx::LDS_BYTES) != hipSuccess) per_cu = 0;
            (void)hipGetLastError();
            grid = per_cu >= 1 ? cus : -1;
        }
    }
    if (grid < 0 || n_in != 31 || mk::PL::END > ws_size) { mk::k_fill<<<(out_size + 255) / 256, 256, 0, stream>>>((float*)d_out, (size_t)out_size, 2.f); return; }
    (void)hipMemsetAsync((unsigned char*)d_ws + mk::PL::CTL, 0, mk::PL::CTL_BYTES, stream);
    fx::P fp;
    { const float** q = (const float**)&fp.in; for (int i = 0; i < 31; ++i) q[i] = (const float*)d_in[i]; }
    fp.ws = (unsigned char*)d_ws; fp.out = (float*)d_out;
    hipLaunchKernelGGL(mk::k_mega, dim3(grid), dim3(512), fx::LDS_BYTES, stream, fp);
}
```

```cpp
#include <hip/hip_runtime.h>
#include <cstdio>
#include <cstdint>
namespace fx {
#define LAS __attribute__((address_space(3)))
typedef unsigned short bf16;
typedef short bf16x8 __attribute__((ext_vector_type(8)));
typedef short bf16x4 __attribute__((ext_vector_type(4)));
typedef float f32x16 __attribute__((ext_vector_type(16)));
typedef float f32x4 __attribute__((ext_vector_type(4)));
typedef unsigned u32x4 __attribute__((ext_vector_type(4)));
typedef unsigned u32x2 __attribute__((ext_vector_type(2)));
constexpr int NTHR = 512, NWAVE = 8;
constexpr int D = 1024, SEQ = 4096, CTXL = 256;
constexpr int PROJW = 5632, NIN = 5760;
constexpr int PC_Z = 0, PC_XBC = 1024, PC_Q = 2560, PC_K = 3072, PC_V = 3584, PC_O = 4608;
constexpr int LDS_BYTES = 152 * 1024;

__device__ __forceinline__ int otid() { int t = threadIdx.x; asm volatile("" : "+v"(t)); return t; }
__device__ __forceinline__ float bf2f(bf16 v) { return __uint_as_float((unsigned)v << 16); }
__device__ __forceinline__ float bflo(unsigned u) { return __uint_as_float(u << 16); }
__device__ __forceinline__ float bfhi(unsigned u) { return __uint_as_float(u & 0xffff0000u); }
typedef __bf16 bf16x2_t __attribute__((ext_vector_type(2)));
typedef float f32x2_t __attribute__((ext_vector_type(2)));
__device__ __forceinline__ unsigned pk2(float lo, float hi) { const f32x2_t v = {lo, hi}; return __builtin_bit_cast(unsigned, __builtin_convertvector(v, bf16x2_t)); }
__device__ __forceinline__ float siluf(float v) { return v / (1.f + __expf(-v)); }
__device__ __forceinline__ float sigmf(float v) { return 1.f / (1.f + __expf(-v)); }
__device__ __forceinline__ float softplusf(float v) { return v > 20.f ? v : log1pf(__expf(v)); }
__device__ __forceinline__ float logsigf(float v) { return fminf(v, 0.f) - log1pf(__expf(-fabsf(v))); }
__device__ __forceinline__ float wave_sum(float v) {
#pragma unroll
    for (int o = 32; o > 0; o >>= 1) v += __shfl_xor(v, o);
    return v;
}
__device__ __forceinline__ float wave_max(float v) {
#pragma unroll
    for (int o = 32; o > 0; o >>= 1) v = fmaxf(v, __shfl_xor(v, o));
    return v;
}
__device__ __forceinline__ float rdlane(float v, int l) { return __int_as_float(__builtin_amdgcn_readlane(__float_as_int(v), l)); }
__device__ __forceinline__ void wave_sum4(float (&a)[4], int lane) {
    const bool h5 = (lane & 32) != 0, h4 = (lane & 16) != 0;
    float b0, b1;
    { const float s0 = h5 ? a[0] : a[2], s1 = h5 ? a[1] : a[3]; const float r0 = __shfl_xor(s0, 32), r1 = __shfl_xor(s1, 32);
      b0 = (h5 ? a[2] : a[0]) + r0; b1 = (h5 ? a[3] : a[1]) + r1; }
    float c = (h4 ? b1 : b0) + __shfl_xor(h4 ? b0 : b1, 16);
#pragma unroll
    for (int o = 8; o > 0; o >>= 1) c += __shfl_xor(c, o);
    a[0] = rdlane(c, 0); a[1] = rdlane(c, 16); a[2] = rdlane(c, 32); a[3] = rdlane(c, 48);
}
__device__ __forceinline__ void wave_sum8(float (&a)[8], int lane) {
    const bool h5 = (lane & 32) != 0, h4 = (lane & 16) != 0, h3 = (lane & 8) != 0;
    float b[4];
#pragma unroll
    for (int k = 0; k < 4; ++k) { const float snd = h5 ? a[k] : a[k + 4]; b[k] = (h5 ? a[k + 4] : a[k]) + __shfl_xor(snd, 32); }
    float c[2];
#pragma unroll
    for (int k = 0; k < 2; ++k) { const float snd = h4 ? b[k] : b[k + 2]; c[k] = (h4 ? b[k + 2] : b[k]) + __shfl_xor(snd, 16); }
    float d = (h3 ? c[1] : c[0]) + __shfl_xor(h3 ? c[0] : c[1], 8);
#pragma unroll
    for (int o = 4; o > 0; o >>= 1) d += __shfl_xor(d, o);
#pragma unroll
    for (int k = 0; k < 8; ++k) a[k] = rdlane(d, 8 * k);
}
__device__ __forceinline__ f32x16 mfma32(bf16x8 a, bf16x8 b, f32x16 c) { return __builtin_amdgcn_mfma_f32_32x32x16_bf16(a, b, c, 0, 0, 0); }
__device__ __forceinline__ f32x4 mfma16(bf16x8 a, bf16x8 b, f32x4 c) { return __builtin_amdgcn_mfma_f32_16x16x32_bf16(a, b, c, 0, 0, 0); }

__device__ __forceinline__ bf16x8 frag_row(const LAS unsigned char* T, int RS, int r0, int k0, int lane) {
    return *(const LAS bf16x8*)(T + (r0 + (lane & 31)) * RS + (k0 + 8 * (lane >> 5)) * 2);
}
__device__ __forceinline__ bf16x8 frag_col(const LAS unsigned char* T, int RS, int k0, int c0, int lane) {
    const int h = lane >> 5, blk = (lane >> 4) & 1, q = (lane & 15) >> 2, p = lane & 3;
    const unsigned a0 = (unsigned)(size_t)(T + (k0 + 8 * h + q) * RS + (c0 + 16 * blk + 4 * p) * 2);
    const unsigned a1 = a0 + 4 * RS;
    bf16x4 v0, v1;
    asm volatile("ds_read_b64_tr_b16 %0, %2\n\tds_read_b64_tr_b16 %1, %3\n\ts_waitcnt lgkmcnt(0)" : "=&v"(v0), "=&v"(v1) : "v"(a0), "v"(a1) : "memory");
    bf16x8 r; r[0] = v0[0]; r[1] = v0[1]; r[2] = v0[2]; r[3] = v0[3]; r[4] = v1[0]; r[5] = v1[1]; r[6] = v1[2]; r[7] = v1[3];
    return r;
}

struct In {
    const float *x, *c, *ctx, *c_ctx, *norm1_w, *norm2_w, *mod_w, *mod_b, *ab_w_in, *ab_conv_w, *ab_conv_b, *ssd_a_log, *ssd_dt_bias, *ssd_d,
        *ssd_norm_w, *ml_i_bias, *ml_f_bias, *ml_norm_w, *ab_w_out, *na_w_qkv, *na_q_norm, *na_k_norm, *na_rpb, *na_w_out,
        *moe_w_group, *moe_b_group, *moe_w_expert, *moe_b_expert, *moe_w_gate, *moe_w_up, *moe_w_down;
};

constexpr size_t cmax(size_t a, size_t b) { return a > b ? a : b; }
constexpr size_t al256(size_t x) { return (x + 255) & ~(size_t)255; }

template <int NB> struct Plan {
    static constexpr size_t TL = (size_t)NB * SEQ, TC = (size_t)NB * CTXL, T = TL + TC;
    static constexpr size_t CTL = 0;
    static constexpr size_t CTL_BAR = 0, CTL_CNT = 16384  , CTL_BYTES = 32768;
    static constexpr size_t MODV = CTL + CTL_BYTES;
    static constexpr size_t RW = MODV + al256(2 * 5 * 6144 * 4);
    static constexpr size_t LIST = RW + al256(2 * T * 4);
    static constexpr size_t W_IN = LIST + al256(32 * T * 4);
    static constexpr size_t W_OUT = W_IN + (size_t)NIN * 1024 * 2;
    static constexpr size_t W_QKV = W_OUT + (size_t)1024 * 2048 * 2;
    static constexpr size_t W_NAO = W_QKV + (size_t)3072 * 1024 * 2;
    static constexpr size_t ARENA = W_NAO + (size_t)1024 * 1024 * 2;
    static constexpr size_t MOEW = (size_t)32 * 1024 * 1024 * 2 + (size_t)32 * 1024 * 512 * 2;
    static constexpr size_t SZ_B = al256(T * 1024 * 2);
    static constexpr size_t SZ_A = al256(cmax(MOEW, cmax(T * 3072 * 2, T * 1024 * 4)));
    static constexpr size_t SZ_X = al256(T * 1024 * 4);
    static constexpr size_t SZ_C = al256(cmax(T * PROJW * 2 + T * 64 * 4, SZ_X + MOEW));
    static constexpr size_t SZ_D = al256(T * 1536 * 2);
    static constexpr size_t SZ_E = al256(T * 4096 * 2);
    static constexpr size_t RB = ARENA, RA = RB + SZ_B, RC = RA + SZ_A, RD = RC + SZ_C, RE = RD + SZ_D, END = RE + SZ_E;
    static constexpr size_t H = RB;
    static constexpr size_t W_MOE0 = RA;
    static constexpr size_t QKV = RA;
    static constexpr size_t X3 = RA;
    static constexpr size_t PROJ = RC;
    static constexpr size_t GATES = RC + T * PROJW * 2;
    static constexpr size_t X1 = RC;
    static constexpr size_t W_MOE1 = RC + SZ_X;
    static constexpr size_t XBC = RD;
    static constexpr size_t ACT = RD;
    static constexpr size_t AO = RD;
    static constexpr size_t SC = RE;
    static constexpr size_t Y2 = RE;
    static constexpr size_t X2 = RE + al256(2 * T * 1024 * 2);
    static_assert(2 * T * 1024 * 2 + T * 1024 * 4 <= SZ_E, "E");
    static_assert(T * 3072 * 2 <= SZ_A + SZ_X, "QKV spill");
};

struct P { In in; unsigned char* ws; float* out; };

template <int NB> __device__ __forceinline__ int mod_row(int row) { return row < NB * SEQ ? row / SEQ : 4; }

template <class ColPtr>
__device__ __forceinline__ void tconv_unit(ColPtr colptr, int ld_src, bf16* dst, int K, int k0, int n0, int ndst, LAS unsigned char* lds) {
    LAS float* tl = (LAS float*)lds;
    const int tid = otid();
    {
        const int n4 = (tid & 63) * 4, kb = tid >> 6;
        const float* sp = colptr(n0 + n4);
        f32x4 v[8];
#pragma unroll
        for (int i = 0; i < 8; ++i) v[i] = sp ? *(const f32x4*)(sp + (size_t)(k0 + kb + 8 * i) * ld_src) : (f32x4){0.f, 0.f, 0.f, 0.f};
#pragma unroll
        for (int i = 0; i < 8; ++i) *(LAS f32x4*)(tl + (kb + 8 * i) * 260 + n4) = v[i];
    }
    __syncthreads();
    {
        const int n = tid >> 1, half = tid & 1;
        if (n0 + n < ndst) {
            float v[32];
#pragma unroll
            for (int j = 0; j < 32; ++j) v[j] = tl[(half * 32 + j) * 260 + n];
            bf16* dp = dst + (size_t)(n0 + n) * K + k0 + half * 32;
#pragma unroll
            for (int q = 0; q < 4; ++q) { u32x4 o; o[0] = pk2(v[8 * q], v[8 * q + 1]); o[1] = pk2(v[8 * q + 2], v[8 * q + 3]); o[2] = pk2(v[8 * q + 4], v[8 * q + 5]); o[3] = pk2(v[8 * q + 6], v[8 * q + 7]);
                *(u32x4*)(dp + 8 * q) = o; }
        }
    }
    __syncthreads();
}

__device__ __forceinline__ int map_in(int n) { return n < 2560 ? n : (n < 5632 ? n + 32 : (n < 5664 ? n - 3072 : (n < 5680 ? n : -1))); }

__device__ __forceinline__ void conv_small_weights(const In& in, unsigned char* ws, size_t o_in, size_t o_out, size_t o_qkv, size_t o_nao, LAS unsigned char* lds) {
    const int total = 368 + 128 + 192 + 64;
    for (int u = blockIdx.x; u < total; u += gridDim.x) {
        if (u < 368) { const int kt = u % 16, nt = u / 16; const float* w = in.ab_w_in;
            tconv_unit([&](int n) -> const float* { const int c = n < NIN ? map_in(n) : -1; return c >= 0 ? w + c : nullptr; }, 5680, (bf16*)(ws + o_in), 1024, kt * 64, nt * 256, NIN, lds); }
        else if (u < 496) { const int v = u - 368, kt = v % 32, nt = v / 32; const float* w = in.ab_w_out;
            tconv_unit([&](int n) { return w + n; }, 1024, (bf16*)(ws + o_out), 2048, kt * 64, nt * 256, 1024, lds); }
        else if (u < 688) { const int v = u - 496, kt = v % 16, nt = v / 16; const float* w = in.na_w_qkv;
            tconv_unit([&](int n) { return w + n; }, 3072, (bf16*)(ws + o_qkv), 1024, kt * 64, nt * 256, 3072, lds); }
        else { const int v = u - 688, kt = v % 16, nt = v / 16; const float* w = in.na_w_out;
            tconv_unit([&](int n) { return w + n; }, 1024, (bf16*)(ws + o_nao), 1024, kt * 64, nt * 256, 1024, lds); }
    }
}

constexpr int MOE_CONV_UNITS = 3072;
__device__ __forceinline__ void conv_moe_weights(const In& in, int layer, bf16* wgu, bf16* wd, LAS unsigned char* lds, int begin = 0, int end = MOE_CONV_UNITS, int rank = -1, int stride = 0) {
    if (rank < 0) { rank = blockIdx.x; stride = gridDim.x; }
    const size_t wsz = (size_t)1024 * 512;
    for (int u = begin + rank; u < end; u += stride) {
        if (u < 2048) {
            const int e = u >> 6, v = u & 63, kt = v & 15, nt = v >> 4;
            const float* g = in.moe_w_gate + ((size_t)layer * 32 + e) * wsz; const float* up = in.moe_w_up + ((size_t)layer * 32 + e) * wsz;
            tconv_unit([&](int n) { const int f = (n >> 8) * 128 + (n & 127); return ((n & 128) ? up : g) + f; }, 512, wgu + (size_t)e * 1024 * 1024, 1024, kt * 64, nt * 256, 1024, lds);
        } else {
            const int w = u - 2048, e = w >> 5, v = w & 31, kt = v & 7, nt = v >> 3;
            const float* dsrc = in.moe_w_down + ((size_t)layer * 32 + e) * wsz;
            tconv_unit([&](int n) { return dsrc + n; }, 1024, wd + (size_t)e * 1024 * 512, 512, kt * 64, nt * 256, 1024, lds);
        }
    }
}

__device__ __forceinline__ void mod_vectors(const In& in, float* modv, LAS unsigned char* lds) {
    LAS float* sc = (LAS float*)lds;
    LAS float* red = sc + 5 * 1024;
    const int tid = otid();
    for (int i = tid; i < 5 * 1024; i += NTHR) { const int r = i >> 10, k = i & 1023; const float v = r < 4 ? in.c[r * 1024 + k] : in.c_ctx[k]; sc[i] = siluf(v); }
    __syncthreads();
    const int col = tid & 31, kq = tid >> 5;
    for (int u = blockIdx.x; u < 2 * 192; u += gridDim.x) {
        const int layer = u / 192, c0 = (u % 192) * 32;
        const float* w = in.mod_w + (size_t)layer * 1024 * 6144 + c0 + col;
        float a0 = 0.f, a1 = 0.f, a2 = 0.f, a3 = 0.f, a4 = 0.f;
#pragma unroll 8
        for (int j = 0; j < 64; ++j) { const int k = kq + 16 * j; const float wv = w[(size_t)k * 6144];
            a0 += sc[k] * wv; a1 += sc[1024 + k] * wv; a2 += sc[2048 + k] * wv; a3 += sc[3072 + k] * wv; a4 += sc[4096 + k] * wv; }
        red[(0 * 16 + kq) * 32 + col] = a0; red[(1 * 16 + kq) * 32 + col] = a1; red[(2 * 16 + kq) * 32 + col] = a2;
        red[(3 * 16 + kq) * 32 + col] = a3; red[(4 * 16 + kq) * 32 + col] = a4;
        __syncthreads();
        if (tid < 160) { const int r = tid >> 5, cc = tid & 31; float s = 0.f;
#pragma unroll
            for (int q = 0; q < 16; ++q) s += red[(r * 16 + q) * 32 + cc];
            modv[((size_t)layer * 5 + r) * 6144 + c0 + cc] = s + in.mod_b[layer * 6144 + c0 + cc]; }
        __syncthreads();
    }
}

template <int NB, bool COMBINE, bool XOUT, bool NORM, bool ROUTER, bool XBF = false>
__device__ __forceinline__ void rows_phase(const float* xl, const float* xc, int nrows, const bf16* y2, const float* modc  , const float* modl  ,
                                           float* xout, float* out_final, const float* nw, int shift_i, int scale_i, bf16* hout,
                                           const float* wg, const float* bg, const float* we, const float* be, float* route_w, int* cnt, int* list, int cap,
                                           LAS unsigned char* lds) {
    constexpr int TL = NB * SEQ;
    const int tid = otid(), lane = tid & 63, wave = tid >> 6;
    LAS float* wt = (LAS float*)lds;
    constexpr int WTS = 1028;
    LAS int* lcnt = (LAS int*)(lds + 36 * WTS * 4); LAS int* lbase = lcnt + 32; LAS int* rinfo = lcnt + 64;
    if (ROUTER) {
        if (tid < 32) lcnt[tid] = 0;
        for (int i = tid; i < 4 * 1024; i += NTHR) wt[(i & 3) * WTS + (i >> 2)] = wg[i];
        for (int i = tid; i < 32 * 1024; i += NTHR) wt[(4 + (i & 31)) * WTS + (i >> 5)] = we[i];
        __syncthreads();
    }
    int lrow = wave;
    for (int row = blockIdx.x * NWAVE + wave; row < nrows; row += gridDim.x * NWAVE, lrow += NWAVE) {
        const size_t soff = row < TL ? (size_t)row * D : (size_t)(row - TL) * D;
        const float* src = (row < TL ? xl : xc) + (XBF ? 0 : soff);
        const float* mv = modl + (size_t)mod_row<NB>(row) * 6144;
        const float* mvc = modc + (size_t)mod_row<NB>(row) * 6144;
        f32x4 v[4];
#pragma unroll
        for (int i = 0; i < 4; ++i) {
            if (XBF) { const u32x2 t2 = *(const u32x2*)((const bf16*)src + soff + lane * 4 + 256 * i); v[i] = (f32x4){bflo(t2[0]), bfhi(t2[0]), bflo(t2[1]), bfhi(t2[1])}; }
            else v[i] = *(const f32x4*)(src + lane * 4 + 256 * i); }
        if (COMBINE) {
#pragma unroll
            for (int i = 0; i < 4; ++i) { const int c = lane * 4 + 256 * i;
                const u32x2 ya = *(const u32x2*)(y2 + (size_t)(2 * row) * D + c), yb = *(const u32x2*)(y2 + (size_t)(2 * row + 1) * D + c);
                const f32x4 m5 = *(const f32x4*)(mvc + 5 * 1024 + c);
                v[i][0] += m5[0] * (bflo(ya[0]) + bflo(yb[0])); v[i][1] += m5[1] * (bfhi(ya[0]) + bfhi(yb[0]));
                v[i][2] += m5[2] * (bflo(ya[1]) + bflo(yb[1])); v[i][3] += m5[3] * (bfhi(ya[1]) + bfhi(yb[1])); }
            if (XOUT) {
#pragma unroll
                for (int i = 0; i < 4; ++i) {
                    if (XBF) { u32x2 o2; o2[0] = pk2(v[i][0], v[i][1]); o2[1] = pk2(v[i][2], v[i][3]); *(u32x2*)((bf16*)xout + (size_t)row * D + lane * 4 + 256 * i) = o2;
                        v[i] = (f32x4){bflo(o2[0]), bfhi(o2[0]), bflo(o2[1]), bfhi(o2[1])}; }
                    else *(f32x4*)(xout + (size_t)row * D + lane * 4 + 256 * i) = v[i]; } }
            if (out_final) {
#pragma unroll
                for (int i = 0; i < 4; ++i) *(f32x4*)(out_final + (size_t)row * D + lane * 4 + 256 * i) = v[i]; }
        }
        if (NORM) {
            float ss = 0.f;
#pragma unroll
            for (int i = 0; i < 4; ++i) ss += v[i][0] * v[i][0] + v[i][1] * v[i][1] + v[i][2] * v[i][2] + v[i][3] * v[i][3];
            ss = wave_sum(ss);
            const float rs = rsqrtf(ss * (1.f / D) + 1e-6f);
            f32x4 hv[4];
#pragma unroll
            for (int i = 0; i < 4; ++i) { const int c = lane * 4 + 256 * i;
                const f32x4 w4 = *(const f32x4*)(nw + c), sc4 = *(const f32x4*)(mv + scale_i * 1024 + c), sh4 = *(const f32x4*)(mv + shift_i * 1024 + c);
#pragma unroll
                for (int j = 0; j < 4; ++j) hv[i][j] = v[i][j] * rs * w4[j] * (1.f + sc4[j]) + sh4[j];
                u32x2 o; o[0] = pk2(hv[i][0], hv[i][1]); o[1] = pk2(hv[i][2], hv[i][3]);
                *(u32x2*)(hout + (size_t)row * D + c) = o; }
            if (ROUTER) {
                float lg[4];
#pragma unroll
                for (int j = 0; j < 4; ++j) { float a = 0.f;
#pragma unroll
                    for (int i = 0; i < 4; ++i) { const f32x4 w4 = *(const LAS f32x4*)(wt + j * WTS + lane * 4 + 256 * i);
                        a += hv[i][0] * w4[0] + hv[i][1] * w4[1] + hv[i][2] * w4[2] + hv[i][3] * w4[3]; }
                    lg[j] = a; }
                wave_sum4(lg, lane);
#pragma unroll
                for (int j = 0; j < 4; ++j) lg[j] += bg[j];
                int gi = 0; float gm = lg[0];
#pragma unroll
                for (int j = 1; j < 4; ++j) if (lg[j] > gm) { gm = lg[j]; gi = j; }
                float gs = 0.f;
#pragma unroll
                for (int j = 0; j < 4; ++j) gs += __expf(lg[j] - gm);
                const float gprob = 1.f / gs;
                float le[8];
#pragma unroll
                for (int j = 0; j < 8; ++j) { float a = 0.f; const LAS float* wr = wt + (4 + gi * 8 + j) * WTS + lane * 4;
#pragma unroll
                    for (int i = 0; i < 4; ++i) { const f32x4 w4 = *(const LAS f32x4*)(wr + 256 * i);
                        a += hv[i][0] * w4[0] + hv[i][1] * w4[1] + hv[i][2] * w4[2] + hv[i][3] * w4[3]; }
                    le[j] = a; }
                wave_sum8(le, lane);
#pragma unroll
                for (int j = 0; j < 8; ++j) le[j] += be[gi * 8 + j];
                int e0 = 0; float m0 = le[0];
#pragma unroll
                for (int j = 1; j < 8; ++j) if (le[j] > m0) { m0 = le[j]; e0 = j; }
                int e1 = 0; float m1 = -3.0e38f;
#pragma unroll
                for (int j = 0; j < 8; ++j) if (j != e0 && le[j] > m1) { m1 = le[j]; e1 = j; }
                const float p1 = __expf(m1 - m0);
                if (lane == 0) {
                    const int ge0 = gi * 8 + e0, ge1 = gi * 8 + e1;
                    route_w[2 * row] = gprob / (1.f + p1); route_w[2 * row + 1] = gprob * p1 / (1.f + p1);
                    const int s0 = atomicAdd((int*)&lcnt[ge0], 1), s1 = atomicAdd((int*)&lcnt[ge1], 1);
                    rinfo[2 * lrow] = (ge0 << 16) | s0; rinfo[2 * lrow + 1] = (ge1 << 16) | s1;
                }
            }
        }
    }
    if (ROUTER) {
        __syncthreads();
        if (tid < 32) { const int c = lcnt[tid]; lbase[tid] = c ? atomicAdd(&cnt[tid * 64], c) : 0; }
        __syncthreads();
        int lrow = wave;
        for (int row = blockIdx.x * NWAVE + wave; row < nrows; row += gridDim.x * NWAVE, lrow += NWAVE) {
            if (lane < 2) { const int ri = rinfo[2 * lrow + lane], ge = ri >> 16, sl = ri & 0xffff; list[(size_t)ge * cap + lbase[ge] + sl] = 2 * row + lane; }
        }
        __syncthreads();
    }
}

__device__ __forceinline__ int xcd_unit(int r) { const int G = gridDim.x, bx = blockIdx.x; return G == 256 ? ((r * 8 + (bx & 7)) * 32 + (bx >> 3)) : r * G + bx; }
__device__ __forceinline__ void unit_tile(int u, int MT, int NT, int& mt, int& nt) {
    if ((MT & 3) == 0) { const int band = u / (4 * NT), w = u - band * 4 * NT; nt = w >> 2; mt = band * 4 + (w & 3); }
    else { mt = u / NT; nt = u - mt * NT; }
}
constexpr int GEMM_STAGE = 256 * 128 + 128 * 128;
constexpr int GEMM_LDS = 3 * GEMM_STAGE;
__device__ __forceinline__ int sw_off(int row, int chunk) { return row * 128 + ((chunk ^ ((row >> 1) & 7)) << 4); }

struct BRowId { __device__ __forceinline__ int operator()(int r) const { return r; } };
template <int VAR = 0, class Epi, class BRow = BRowId>
__device__ __forceinline__ void gemm_tile(const bf16* const (&arow)[4], const bf16* bt  , int ldb, int K, LAS unsigned char* lds, Epi&& epi, BRow brow = BRow()) {
    const int tid = otid(), lane = tid & 63, wave = tid >> 6, wm = wave >> 1, wn = wave & 1;
    const int r8 = tid >> 3;
    const int schunk = (lane & 7) ^ ((r8 >> 1) & 7);
    const bf16* ga[4]; const bf16* gb[2];
#pragma unroll
    for (int i = 0; i < 4; ++i) ga[i] = arow[i] + schunk * 8;
#pragma unroll
    for (int i = 0; i < 2; ++i) gb[i] = bt + (size_t)brow(r8 + 64 * i) * ldb + schunk * 8;
    f32x16 acc[2][2];
#pragma unroll
    for (int mi = 0; mi < 2; ++mi)
#pragma unroll
        for (int ni = 0; ni < 2; ++ni)
#pragma unroll
            for (int r = 0; r < 16; ++r) acc[mi][ni][r] = 0.f;
#define G_DMA(t, st) do { LAS unsigned char* sa_ = lds + (st) * GEMM_STAGE + wave * 1024 + lane * 16; \
    _Pragma("unroll") for (int i = 0; i < 4; ++i) __builtin_amdgcn_global_load_lds((const unsigned*)(ga[i] + (t) * 64), (LAS unsigned*)(sa_ + i * 8192), 16, 0, 0); \
    _Pragma("unroll") for (int i = 0; i < 2; ++i) __builtin_amdgcn_global_load_lds((const unsigned*)(gb[i] + (t) * 64), (LAS unsigned*)(sa_ + 256 * 128 + i * 8192), 16, 0, 0); } while (0)
    const int KT = K >> 6;
    G_DMA(0, 0);
    G_DMA(1, 1);
    asm volatile("s_waitcnt vmcnt(6)" ::: "memory");
    __builtin_amdgcn_s_barrier();
    asm volatile("" ::: "memory");
    int st = 0;
    for (int kt = 0; kt < KT; ++kt) {
        const int st2 = st >= 1 ? st - 1 : 2;
        if (VAR != 2) { if (kt + 2 < KT) G_DMA(kt + 2, st2); }
        const LAS unsigned char* sa = lds + st * GEMM_STAGE; const LAS unsigned char* sb = sa + 256 * 128;
        bf16x8 af[2], bfr[2];
        if (VAR == 1) {
#pragma unroll
            for (int mi = 0; mi < 2; ++mi) af[mi] = *(const LAS bf16x8*)(sa + sw_off(wm * 64 + mi * 32 + (lane & 31), (lane >> 5)));
#pragma unroll
            for (int ni = 0; ni < 2; ++ni) bfr[ni] = *(const LAS bf16x8*)(sb + sw_off(wn * 64 + ni * 32 + (lane & 31), (lane >> 5)));
        }
#pragma unroll
        for (int kk = 0; kk < 4; ++kk) {
            if (VAR != 1) {
#pragma unroll
            for (int mi = 0; mi < 2; ++mi) af[mi] = *(const LAS bf16x8*)(sa + sw_off(wm * 64 + mi * 32 + (lane & 31), 2 * kk + (lane >> 5)));
#pragma unroll
            for (int ni = 0; ni < 2; ++ni) bfr[ni] = *(const LAS bf16x8*)(sb + sw_off(wn * 64 + ni * 32 + (lane & 31), 2 * kk + (lane >> 5)));
            }
            if (VAR == 3) {
#pragma unroll
                for (int mi = 0; mi < 2; ++mi) acc[mi][0][kk] += __builtin_bit_cast(f32x4, af[mi])[0] + __builtin_bit_cast(f32x4, bfr[mi])[1];
            } else {
#pragma unroll
            for (int mi = 0; mi < 2; ++mi)
#pragma unroll
                for (int ni = 0; ni < 2; ++ni) acc[mi][ni] = mfma32(bfr[ni], af[mi], acc[mi][ni]);
            }
        }
        if (kt + 2 < KT) asm volatile("s_waitcnt vmcnt(6)" ::: "memory"); else asm volatile("s_waitcnt vmcnt(0)" ::: "memory");
        __builtin_amdgcn_s_barrier();
        asm volatile("" ::: "memory");
        st = st == 2 ? 0 : st + 1;
    }
#undef G_DMA
    epi(acc, wm, wn, lane);
}

constexpr int CST_BF = 272, CST_BF64 = 144, CST_F32 = 528;
__device__ __forceinline__ void stage_bf16_128(const f32x16 (&acc)[2][2], LAS unsigned char* lds, int wm, int wn, int lane) {
#pragma unroll
    for (int mi = 0; mi < 2; ++mi) { LAS unsigned char* rp = lds + (wm * 64 + mi * 32 + (lane & 31)) * CST_BF + (wn * 64 + 4 * (lane >> 5)) * 2;
#pragma unroll
        for (int ni = 0; ni < 2; ++ni)
#pragma unroll
            for (int g = 0; g < 4; ++g) { u32x2 o; o[0] = pk2(acc[mi][ni][4 * g], acc[mi][ni][4 * g + 1]); o[1] = pk2(acc[mi][ni][4 * g + 2], acc[mi][ni][4 * g + 3]);
                *(LAS u32x2*)(rp + (ni * 32 + 8 * g) * 2) = o; } }
}
template <class RowPtr>
__device__ __forceinline__ void flush_bf16_128(const LAS unsigned char* lds, RowPtr&& rowptr) {
    const int t = otid();
#pragma unroll
    for (int it = 0; it < 8; ++it) { const int row = it * 32 + (t >> 4), piece = t & 15;
        const u32x4 v = *(const LAS u32x4*)(lds + row * CST_BF + piece * 16);
        bf16* dst = rowptr(row);
        if (dst) __builtin_nontemporal_store(v, (u32x4*)(dst + piece * 8)); }
}
template <class RowPtr>
__device__ __forceinline__ void flush_bf16_64(const LAS unsigned char* lds, RowPtr&& rowptr) {
    const int t = otid();
#pragma unroll
    for (int it = 0; it < 4; ++it) { const int row = it * 64 + (t >> 3), piece = t & 7;
        const u32x4 v = *(const LAS u32x4*)(lds + row * CST_BF64 + piece * 16);
        bf16* dst = rowptr(row);
        if (dst) __builtin_nontemporal_store(v, (u32x4*)(dst + piece * 8)); }
}
__device__ __forceinline__ void stage_f32_128(const f32x16 (&acc)[2][2], LAS unsigned char* lds, int wm, int wn, int lane) {
#pragma unroll
    for (int mi = 0; mi < 2; ++mi) { LAS unsigned char* rp = lds + (wm * 64 + mi * 32 + (lane & 31)) * CST_F32 + (wn * 64 + 4 * (lane >> 5)) * 4;
#pragma unroll
        for (int ni = 0; ni < 2; ++ni)
#pragma unroll
            for (int g = 0; g < 4; ++g) { f32x4 o; o[0] = acc[mi][ni][4 * g]; o[1] = acc[mi][ni][4 * g + 1]; o[2] = acc[mi][ni][4 * g + 2]; o[3] = acc[mi][ni][4 * g + 3];
                *(LAS f32x4*)(rp + (ni * 32 + 8 * g) * 4) = o; } }
}

template <int NB, int VAR = 0>
__device__ __forceinline__ void phase_inproj_v(const bf16* H, const bf16* Wt, bf16* PROJ, float* GATES, LAS unsigned char* lds, bool dostore = true) {
    constexpr int T = NB * (SEQ + CTXL), MT = T / 256, NT_ = NIN / 128;
    for (int r = 0; r * (int)gridDim.x < MT * NT_; ++r) {
        const int u = xcd_unit(r); if (u >= MT * NT_) continue;
        int mt, nt; unit_tile(u, MT, NT_, mt, nt);
        const bf16* arow[4];
#pragma unroll
        for (int i = 0; i < 4; ++i) arow[i] = H + (size_t)(mt * 256 + (otid() >> 3) + 64 * i) * D;
        gemm_tile<VAR>(arow, Wt + (size_t)nt * 128 * D, D, D, lds, [&](const f32x16 (&acc)[2][2], int wm, int wn, int lane) {
            if (!dostore) return;
            if (nt < NT_ - 1) stage_bf16_128(acc, lds, wm, wn, lane);
            else if (wn == 0) {
#pragma unroll
                for (int mi = 0; mi < 2; ++mi) { const int row = mt * 256 + wm * 64 + mi * 32 + (lane & 31);
#pragma unroll
                    for (int ni = 0; ni < 2; ++ni)
#pragma unroll
                        for (int g = 0; g < 4; ++g) { f32x4 o; o[0] = acc[mi][ni][4 * g]; o[1] = acc[mi][ni][4 * g + 1]; o[2] = acc[mi][ni][4 * g + 2]; o[3] = acc[mi][ni][4 * g + 3];
                            *(f32x4*)(GATES + (size_t)row * 64 + ni * 32 + 8 * g + 4 * (lane >> 5)) = o; } } }
        });
        if (dostore && nt < NT_ - 1) {
            __syncthreads();
            flush_bf16_128(lds, [&](int r) { return PROJ + (size_t)(mt * 256 + r) * PROJW + nt * 128; });
        }
        __syncthreads();
    }
}

template <int NB> __device__ __forceinline__ void phase_inproj(const bf16* H, const bf16* Wt, bf16* PROJ, float* GATES, LAS unsigned char* lds) { phase_inproj_v<NB, 0>(H, Wt, PROJ, GATES, lds, true); }

template <int NB>
__device__ __forceinline__ void phase_conv(const bf16* PROJ, const float* cw, const float* cb, bf16* XBC) {
    constexpr int TL = NB * SEQ, T = NB * (SEQ + CTXL);
    for (size_t it = (size_t)blockIdx.x * NTHR + otid(); it < (size_t)T * 192; it += (size_t)gridDim.x * NTHR) {
        const int row = (int)(it / 192), c0 = (int)(it % 192) * 8;
        int t, L;
        if (row < TL) { t = row % SEQ; L = SEQ; } else { t = (row - TL) % CTXL; L = CTXL; }
        const bf16* p = PROJ + (size_t)row * PROJW + PC_XBC + c0;
        const u32x4 cur = *(const u32x4*)p;
        u32x4 prv = {0u, 0u, 0u, 0u}, nxt = {0u, 0u, 0u, 0u};
        if (t > 0) prv = *(const u32x4*)(p - PROJW);
        if (t < L - 1) nxt = *(const u32x4*)(p + PROJW);
        float o[8];
#pragma unroll
        for (int j = 0; j < 4; ++j) {
            const int c = c0 + 2 * j;
            o[2 * j] = bflo(prv[j]) * cw[c] + bflo(cur[j]) * cw[1536 + c] + bflo(nxt[j]) * cw[3072 + c] + cb[c];
            o[2 * j + 1] = bfhi(prv[j]) * cw[c + 1] + bfhi(cur[j]) * cw[1536 + c + 1] + bfhi(nxt[j]) * cw[3072 + c + 1] + cb[c + 1];
        }
        u32x4 r; r[0] = pk2(siluf(o[0]), siluf(o[1])); r[1] = pk2(siluf(o[2]), siluf(o[3])); r[2] = pk2(siluf(o[4]), siluf(o[5])); r[3] = pk2(siluf(o[6]), siluf(o[7]));
        *(u32x4*)(XBC + (size_t)row * 1536 + c0) = r;
    }
}
}
namespace fx {
constexpr int RS_X = 144, RS_N = 272;

template <int NB> __device__ __forceinline__ int scan_row(int b, int d, int step) {
    if (step < CTXL) return NB * SEQ + b * CTXL + (d ? CTXL - 1 - step : step);
    step -= CTXL; return b * SEQ + (d ? SEQ - 1 - step : step);
}
__device__ __forceinline__ bf16x8 scale_frag(bf16x8 v, f32x4 w0, f32x4 w1) {
    const u32x4 u = __builtin_bit_cast(u32x4, v);
    u32x4 o;
    o[0] = pk2(bflo(u[0]) * w0[0], bfhi(u[0]) * w0[1]); o[1] = pk2(bflo(u[1]) * w0[2], bfhi(u[1]) * w0[3]);
    o[2] = pk2(bflo(u[2]) * w1[0], bfhi(u[2]) * w1[1]); o[3] = pk2(bflo(u[3]) * w1[2], bfhi(u[3]) * w1[3]);
    return __builtin_bit_cast(bf16x8, o);
}

__device__ __forceinline__ unsigned tr_addr(const LAS unsigned char* T, int RS, int k0, int c0, int lane) {
    const int h = lane >> 5, blk = (lane >> 4) & 1, q = (lane & 15) >> 2, p = lane & 3;
    return (unsigned)(size_t)(T + (k0 + 8 * h + q) * RS + (c0 + 16 * blk + 4 * p) * 2);
}
__device__ __forceinline__ void tr8(unsigned a0, unsigned a1, unsigned a2, unsigned a3, unsigned a4, unsigned a5, unsigned a6, unsigned a7,
                                    bf16x4& v0, bf16x4& v1, bf16x4& v2, bf16x4& v3, bf16x4& v4, bf16x4& v5, bf16x4& v6, bf16x4& v7) {
    asm volatile("ds_read_b64_tr_b16 %0, %8\n\tds_read_b64_tr_b16 %1, %9\n\tds_read_b64_tr_b16 %2, %10\n\tds_read_b64_tr_b16 %3, %11\n\t"
                 "ds_read_b64_tr_b16 %4, %12\n\tds_read_b64_tr_b16 %5, %13\n\tds_read_b64_tr_b16 %6, %14\n\tds_read_b64_tr_b16 %7, %15\n\ts_waitcnt lgkmcnt(0)"
                 : "=&v"(v0), "=&v"(v1), "=&v"(v2), "=&v"(v3), "=&v"(v4), "=&v"(v5), "=&v"(v6), "=&v"(v7)
                 : "v"(a0), "v"(a1), "v"(a2), "v"(a3), "v"(a4), "v"(a5), "v"(a6), "v"(a7) : "memory");
}
__device__ __forceinline__ void tr4(unsigned a0, unsigned a1, unsigned a2, unsigned a3, bf16x4& v0, bf16x4& v1, bf16x4& v2, bf16x4& v3) {
    asm volatile("ds_read_b64_tr_b16 %0, %4\n\tds_read_b64_tr_b16 %1, %5\n\tds_read_b64_tr_b16 %2, %6\n\tds_read_b64_tr_b16 %3, %7\n\ts_waitcnt lgkmcnt(0)"
                 : "=&v"(v0), "=&v"(v1), "=&v"(v2), "=&v"(v3) : "v"(a0), "v"(a1), "v"(a2), "v"(a3) : "memory");
}
__device__ __forceinline__ bf16x8 tr_join(bf16x4 v0, bf16x4 v1) { bf16x8 r; r[0] = v0[0]; r[1] = v0[1]; r[2] = v0[2]; r[3] = v0[3]; r[4] = v1[0]; r[5] = v1[1]; r[6] = v1[2]; r[7] = v1[3]; return r; }
__device__ __forceinline__ void tr_col4(const LAS unsigned char* T, int RS, int k0, int c0, int lane, bf16x4 (&t)[4][2]) {
    const unsigned a = tr_addr(T, RS, k0, c0, lane);
    tr8(a, a + 4 * RS, a + 16 * RS, a + 20 * RS, a + 32 * RS, a + 36 * RS, a + 48 * RS, a + 52 * RS, t[0][0], t[0][1], t[1][0], t[1][1], t[2][0], t[2][1], t[3][0], t[3][1]);
}
__device__ __forceinline__ void tr_col2(const LAS unsigned char* T, int RS, int k0, int c0, int lane, bf16x4 (&t)[2][2]) {
    const unsigned a = tr_addr(T, RS, k0, c0, lane);
    tr4(a, a + 4 * RS, a + 16 * RS, a + 20 * RS, t[0][0], t[0][1], t[1][0], t[1][1]);
}

constexpr int NSTEP = SEQ + CTXL;
template <int NB> struct ScanTab {
    static constexpr size_t SSD_TAB = 0, ML_TAB = SSD_TAB + (size_t)NB * 32 * NSTEP * 16, SSD_DEC = ML_TAB + (size_t)NB * 8 * NSTEP * 32,
                            ML_CH = SSD_DEC + (size_t)NB * 32 * 34 * 4, END = ML_CH + (size_t)NB * 8 * 34 * 8;
};
template <int NB>
__device__ __forceinline__ void phase_tables(const In& in, const float* GATES, unsigned char* tab, LAS unsigned char* lds) {
    typedef ScanTab<NB> ST;
    const int tid = otid(), lane = tid & 63, wave = tid >> 6;
    LAS float* l_g = (LAS float*)lds; LAS float* l_ml = l_g + 68; LAS float* l_mr = l_g + 136;
    for (int job = blockIdx.x; job < NB * 40; job += gridDim.x) {
        if (job < NB * 32) {
            const int b = job >> 5, d = (job >> 4) & 1, h = job & 15;
            const float a = -__expf(in.ssd_a_log[d * 16 + h]), dtb = in.ssd_dt_bias[d * 16 + h];
            f32x4* T4 = (f32x4*)(tab + ST::SSD_TAB) + (size_t)job * NSTEP; float* DEC = (float*)(tab + ST::SSD_DEC) + job * 34;
            for (int ch = wave; ch < 34; ch += NWAVE) {
                const float dt0 = softplusf(GATES[(size_t)scan_row<NB>(b, d, ch * 128 + lane) * 64 + d * 16 + h] + dtb);
                const float dt1 = softplusf(GATES[(size_t)scan_row<NB>(b, d, ch * 128 + 64 + lane) * 64 + d * 16 + h] + dtb);
                float v0 = dt0 * a, v1 = dt1 * a;
#pragma unroll
                for (int o = 1; o < 64; o <<= 1) { const float t0 = __shfl_up(v0, o), t1 = __shfl_up(v1, o); if (lane >= o) { v0 += t0; v1 += t1; } }
                v1 += __shfl(v0, 63);
                const float tot = __shfl(v1, 63);
                T4[ch * 128 + lane] = (f32x4){v0, dt0, dt0 * __expf(tot - v0), __expf(v0)};
                T4[ch * 128 + 64 + lane] = (f32x4){v1, dt1, dt1 * __expf(tot - v1), __expf(v1)};
                if (lane == 0) DEC[ch] = __expf(tot);
            }
        } else {
            const int j2 = job - NB * 32, b = j2 >> 3, d = (j2 >> 2) & 1, hh = j2 & 3;
            const float ib = in.ml_i_bias[d * 4 + hh], fb = in.ml_f_bias[d * 4 + hh];
            f32x4* T4 = (f32x4*)(tab + ST::ML_TAB) + (size_t)j2 * NSTEP * 2; float* CH = (float*)(tab + ST::ML_CH) + j2 * 34 * 2;
            float s_li[5][2], s_bc[5][2], s_mi[5][2], s_we[5][2];
            __syncthreads();
#pragma unroll
            for (int k = 0; k < 5; ++k) { const int ch = wave + 8 * k;
#pragma unroll
                for (int q = 0; q < 2; ++q) { s_li[k][q] = 0.f; s_bc[k][q] = 0.f; s_mi[k][q] = 0.f; s_we[k][q] = 0.f; }
                if (ch < 34) {
                    const float* g0 = GATES + (size_t)scan_row<NB>(b, d, ch * 128 + lane) * 64; const float* g1 = GATES + (size_t)scan_row<NB>(b, d, ch * 128 + 64 + lane) * 64;
                    const float li0 = g0[32 + d * 4 + hh] + ib, li1 = g1[32 + d * 4 + hh] + ib;
                    float bc0 = logsigf(g0[40 + d * 4 + hh] + fb), bc1 = logsigf(g1[40 + d * 4 + hh] + fb);
#pragma unroll
                    for (int o = 1; o < 64; o <<= 1) { const float t0 = __shfl_up(bc0, o), t1 = __shfl_up(bc1, o); if (lane >= o) { bc0 += t0; bc1 += t1; } }
                    bc1 += __shfl(bc0, 63);
                    float pm0 = li0 - bc0, pm1 = li1 - bc1;
#pragma unroll
                    for (int o = 1; o < 64; o <<= 1) { const float t0 = __shfl_up(pm0, o), t1 = __shfl_up(pm1, o); if (lane >= o) { pm0 = fmaxf(pm0, t0); pm1 = fmaxf(pm1, t1); } }
                    pm1 = fmaxf(pm1, __shfl(pm0, 63));
                    const float gtot = __shfl(bc1, 63);
                    const float ae0 = gtot - bc0 + li0, ae1 = gtot - bc1 + li1;
                    const float m_loc = wave_max(fmaxf(ae0, ae1));
                    s_li[k][0] = li0; s_li[k][1] = li1; s_bc[k][0] = bc0; s_bc[k][1] = bc1; s_mi[k][0] = bc0 + pm0; s_mi[k][1] = bc1 + pm1;
                    s_we[k][0] = __expf(ae0 - m_loc); s_we[k][1] = __expf(ae1 - m_loc);
                    if (lane == 0) { l_g[ch] = gtot; l_ml[ch] = m_loc; }
                } }
            __syncthreads();
            if (tid == 0) { float m = 0.f;
                for (int ch = 0; ch < 34; ++ch) { const float g = l_g[ch], ml = l_ml[ch], mn = fmaxf(g + m, ml);
                    l_mr[ch] = m; CH[2 * ch] = __expf(g + m - mn); CH[2 * ch + 1] = __expf(ml - mn); m = mn; } }
            __syncthreads();
#pragma unroll
            for (int k = 0; k < 5; ++k) { const int ch = wave + 8 * k;
                if (ch < 34) {
#pragma unroll
                    for (int q = 0; q < 2; ++q) {
                        const float m_inter = s_bc[k][q] + l_mr[ch], mt = fmaxf(s_mi[k][q], m_inter);
                        T4[(size_t)(ch * 128 + 64 * q + lane) * 2] = (f32x4){__expf(s_bc[k][q] - mt), __expf(s_li[k][q] - s_bc[k][q]), __expf(m_inter - mt), s_we[k][q]};
                        T4[(size_t)(ch * 128 + 64 * q + lane) * 2 + 1] = (f32x4){__expf(-mt), 0.f, 0.f, 0.f}; }
                } }
        }
    }
}

template <int NB>
__device__ __forceinline__ void ssd_item(const bf16* XBC, const unsigned char* tab, bf16* SCb, int b, int d, int h, LAS unsigned char* lds) {
    typedef ScanTab<NB> ST;
    const int tid = otid(), lane = tid & 63, wave = tid >> 6, g = h >> 3, combo = b * 32 + d * 16 + h;
    LAS unsigned char* Xs = lds; LAS unsigned char* Bs = lds + 18432; LAS unsigned char* Cs = lds + 53248;
    LAS unsigned char* Ss = lds + 88064; LAS unsigned char* Ms = lds + 105472;
    LAS float* acs = (LAS float*)(lds + 140288); LAS float* dtv = acs + 128; LAS float* wv = acs + 256; LAS float* eav = acs + 384;
    const f32x4* T4 = (const f32x4*)(tab + ST::SSD_TAB) + (size_t)combo * NSTEP; const float* DEC = (const float*)(tab + ST::SSD_DEC) + combo * 34;
    f32x16 st;
#pragma unroll
    for (int r = 0; r < 16; ++r) st[r] = 0.f;
    constexpr int NCH = (CTXL + SEQ) / 128;
    u32x4 rx[2], rb[4], rc[4]; f32x4 rt = {0.f, 0.f, 0.f, 0.f}; float rdec = 0.f;
#define SSD_LOAD(ch) do { \
    _Pragma("unroll") for (int i = 0; i < 2; ++i) { const int idx = tid + 512 * i, l = idx >> 3, c = idx & 7; \
        rx[i] = *(const u32x4*)(XBC + (size_t)scan_row<NB>(b, d, (ch) * 128 + l) * 1536 + h * 64 + c * 8); } \
    _Pragma("unroll") for (int i = 0; i < 4; ++i) { const int idx = tid + 512 * i, l = idx >> 4, c = idx & 15; \
        const bf16* rp = XBC + (size_t)scan_row<NB>(b, d, (ch) * 128 + l) * 1536 + 1024 + g * 128 + c * 8; \
        rb[i] = *(const u32x4*)rp; rc[i] = *(const u32x4*)(rp + 256); } \
    if (tid < 128) rt = T4[(ch) * 128 + tid]; \
    rdec = DEC[ch]; } while (0)
    SSD_LOAD(0);
    const int pbw = wave >> 2, nbw = wave & 3;
    for (int ch = 0; ch < NCH; ++ch) {
#pragma unroll
        for (int i = 0; i < 2; ++i) { const int idx = tid + 512 * i, l = idx >> 3, c = idx & 7; *(LAS u32x4*)(Xs + l * RS_X + c * 16) = rx[i]; }
#pragma unroll
        for (int i = 0; i < 4; ++i) { const int idx = tid + 512 * i, l = idx >> 4, c = idx & 15;
            *(LAS u32x4*)(Bs + l * RS_N + c * 16) = rb[i]; *(LAS u32x4*)(Cs + l * RS_N + c * 16) = rc[i]; }
        if (tid < 128) { acs[tid] = rt[0]; dtv[tid] = rt[1]; wv[tid] = rt[2]; eav[tid] = rt[3]; }
        const float dec = rdec;
        {
            const int pp = 32 * pbw + (lane & 31);
#pragma unroll
            for (int gq = 0; gq < 4; ++gq) { u32x2 o; o[0] = pk2(st[4 * gq], st[4 * gq + 1]); o[1] = pk2(st[4 * gq + 2], st[4 * gq + 3]);
                *(LAS u32x2*)(Ss + pp * RS_N + (32 * nbw + 8 * gq + 4 * (lane >> 5)) * 2) = o; }
        }
        __syncthreads();
        if (ch + 1 < NCH) SSD_LOAD(ch + 1);
        {
            const int lbA = wave >> 1, sbp = wave & 1;
            const int l = 32 * lbA + (lane & 31);
            const float al = acs[l];
#pragma unroll
            for (int q = 0; q < 2; ++q) { const int sb = 2 * sbp + q;
                if (sb <= lbA) {
                    f32x16 cb;
#pragma unroll
                    for (int r = 0; r < 16; ++r) cb[r] = 0.f;
#pragma unroll
                    for (int kk = 0; kk < 8; ++kk) cb = mfma32(frag_row(Bs, RS_N, 32 * sb, 16 * kk, lane), frag_row(Cs, RS_N, 32 * lbA, 16 * kk, lane), cb);
#pragma unroll
                    for (int gq = 0; gq < 4; ++gq) { const int s0 = 32 * sb + 8 * gq + 4 * (lane >> 5);
                        const f32x4 as4 = *(const LAS f32x4*)(acs + s0), dt4 = *(const LAS f32x4*)(dtv + s0);
                        float m[4];
#pragma unroll
                        for (int j = 0; j < 4; ++j) m[j] = (s0 + j <= l) ? cb[4 * gq + j] * __expf(fminf(al - as4[j], 0.f)) * dt4[j] : 0.f;
                        u32x2 o; o[0] = pk2(m[0], m[1]); o[1] = pk2(m[2], m[3]);
                        *(LAS u32x2*)(Ms + l * RS_N + s0 * 2) = o; } } }
        }
        {
#pragma unroll
            for (int r = 0; r < 16; ++r) st[r] *= dec;
#pragma unroll
            for (int kb = 0; kb < 2; ++kb) {
                bf16x4 tx[4][2], tb[4][2];
                tr_col4(Xs, RS_X, 64 * kb, 32 * pbw, lane, tx);
                tr_col4(Bs, RS_N, 64 * kb, 32 * nbw, lane, tb);
#pragma unroll
                for (int k4 = 0; k4 < 4; ++k4) {
                    const int l0 = 16 * (4 * kb + k4) + 8 * (lane >> 5);
                    const f32x4 w0 = *(const LAS f32x4*)(wv + l0), w1 = *(const LAS f32x4*)(wv + l0 + 4);
                    st = mfma32(tr_join(tb[k4][0], tb[k4][1]), scale_frag(tr_join(tx[k4][0], tx[k4][1]), w0, w1), st);
                }
            }
        }
        __syncthreads();
        {
            const int pb = wave >> 2, lb = wave & 3;
            f32x16 acc;
#pragma unroll
            for (int r = 0; r < 16; ++r) acc[r] = 0.f;
#pragma unroll
            for (int kk = 0; kk < 8; ++kk) acc = mfma32(frag_row(Ss, RS_N, 32 * pb, 16 * kk, lane), frag_row(Cs, RS_N, 32 * lb, 16 * kk, lane), acc);
            const int l = 32 * lb + (lane & 31);
            const float ea = eav[l];
#pragma unroll
            for (int r = 0; r < 16; ++r) acc[r] *= ea;
            for (int sb = 0; sb <= lb; ++sb) {
                bf16x4 t2[2][2];
                const bf16x8 m0 = frag_row(Ms, RS_N, 32 * lb, 32 * sb, lane), m1 = frag_row(Ms, RS_N, 32 * lb, 32 * sb + 16, lane);
                tr_col2(Xs, RS_X, 32 * sb, 32 * pb, lane, t2);
                acc = mfma32(tr_join(t2[0][0], t2[0][1]), m0, acc);
                acc = mfma32(tr_join(t2[1][0], t2[1][1]), m1, acc);
            }
            bf16* yp = SCb + (size_t)scan_row<NB>(b, d, ch * 128 + l) * 4096 + d * 1024 + h * 64 + 32 * pb + 4 * (lane >> 5);
#pragma unroll
            for (int gq = 0; gq < 4; ++gq) { u32x2 o; o[0] = pk2(acc[4 * gq], acc[4 * gq + 1]); o[1] = pk2(acc[4 * gq + 2], acc[4 * gq + 3]); *(u32x2*)(yp + 8 * gq) = o; }
        }
        __syncthreads();
    }
#undef SSD_LOAD
}

template <int NB>
__device__ __forceinline__ void mlstm_item(const bf16* PROJ, const unsigned char* tab, bf16* SCb, int b, int d, int hh, int ev, LAS unsigned char* lds) {
    typedef ScanTab<NB> ST;
    const int tid = otid(), lane = tid & 63, wave = tid >> 6, combo = b * 8 + d * 4 + hh;
    LAS unsigned char* Qs = lds; LAS unsigned char* Ks = lds + 34816; LAS unsigned char* Vs = lds + 69632;
    LAS unsigned char* Ct = lds + 88064; LAS unsigned char* Sm = lds + 105472;
    LAS float* tb = (LAS float*)(lds + 140288);
    LAS float* t_u = tb, *t_v = tb + 128, *t_wi = tb + 256, *t_we = tb + 384, *t_em = tb + 512, *t_qn = tb + 640, *t_n = tb + 768, *t_nc = tb + 896, *t_rs = tb + 1024  ;
    const f32x4* T4 = (const f32x4*)(tab + ST::ML_TAB) + (size_t)combo * NSTEP * 2; const float* CH = (const float*)(tab + ST::ML_CH) + combo * 34 * 2;
    const float kscale = 0.08838834764831845f;
    f32x16 st;
#pragma unroll
    for (int r = 0; r < 16; ++r) st[r] = 0.f;
    if (tid < 128) t_n[tid] = 0.f;
    constexpr int NCH = (CTXL + SEQ) / 128;
    const int kbw = wave & 3, ebw = wave >> 2;
    u32x4 rq[4], rk[4], rv[2]; f32x4 rt = {0.f, 0.f, 0.f, 0.f}; float ras = 0.f, rbb = 0.f;
#define ML_LOAD(ch) do { \
    _Pragma("unroll") for (int i = 0; i < 4; ++i) { const int idx = tid + 512 * i, l = idx >> 4, c = idx & 15; \
        const bf16* rp = PROJ + (size_t)scan_row<NB>(b, d, (ch) * 128 + l) * PROJW + hh * 128 + c * 8; \
        rq[i] = *(const u32x4*)(rp + PC_Q); rk[i] = *(const u32x4*)(rp + PC_K); } \
    _Pragma("unroll") for (int i = 0; i < 2; ++i) { const int idx = tid + 512 * i, l = idx >> 3, c = idx & 7; \
        rv[i] = *(const u32x4*)(PROJ + (size_t)scan_row<NB>(b, d, (ch) * 128 + l) * PROJW + PC_V + hh * 256 + ev * 64 + c * 8); } \
    if (tid < 256) rt = T4[(size_t)(ch) * 256 + tid]; \
    ras = CH[2 * (ch)]; rbb = CH[2 * (ch) + 1]; } while (0)
    ML_LOAD(0);
    for (int ch = 0; ch < NCH; ++ch) {
#pragma unroll
        for (int i = 0; i < 4; ++i) { const int idx = tid + 512 * i, l = idx >> 4, c = idx & 15;
            *(LAS u32x4*)(Qs + l * RS_N + c * 16) = rq[i]; *(LAS u32x4*)(Ks + l * RS_N + c * 16) = rk[i]; }
#pragma unroll
        for (int i = 0; i < 2; ++i) { const int idx = tid + 512 * i, l = idx >> 3, c = idx & 7; *(LAS u32x4*)(Vs + l * RS_X + c * 16) = rv[i]; }
        if (tid < 256) { const int l = tid >> 1; if (tid & 1) t_em[l] = rt[0]; else { t_u[l] = rt[0]; t_v[l] = rt[1]; t_wi[l] = rt[2]; t_we[l] = rt[3]; } }
        const float a_s = ras, bbs = rbb;
        {
            const int ee = 32 * ebw + (lane & 31);
#pragma unroll
            for (int gq = 0; gq < 4; ++gq) { u32x2 o; o[0] = pk2(st[4 * gq], st[4 * gq + 1]); o[1] = pk2(st[4 * gq + 2], st[4 * gq + 3]);
                *(LAS u32x2*)(Ct + ee * RS_N + (32 * kbw + 8 * gq + 4 * (lane >> 5)) * 2) = o; }
        }
        __syncthreads();
        if (ch + 1 < NCH) ML_LOAD(ch + 1);
        {
            const int lbA = wave >> 1, sbp = wave & 1;
            const int l = 32 * lbA + (lane & 31);
            const float ul = t_u[l] * kscale;
#pragma unroll
            for (int q = 0; q < 2; ++q) { const int sb = 2 * sbp + q;
                if (sb <= lbA) {
                    f32x16 cb;
#pragma unroll
                    for (int r = 0; r < 16; ++r) cb[r] = 0.f;
#pragma unroll
                    for (int kk = 0; kk < 8; ++kk) cb = mfma32(frag_row(Ks, RS_N, 32 * sb, 16 * kk, lane), frag_row(Qs, RS_N, 32 * lbA, 16 * kk, lane), cb);
                    float rsum = 0.f;
#pragma unroll
                    for (int gq = 0; gq < 4; ++gq) { const int s0 = 32 * sb + 8 * gq + 4 * (lane >> 5);
                        const f32x4 v4 = *(const LAS f32x4*)(t_v + s0);
                        float m[4];
#pragma unroll
                        for (int j = 0; j < 4; ++j) { m[j] = (s0 + j <= l) ? cb[4 * gq + j] * ul * v4[j] : 0.f; rsum += m[j]; }
                        u32x2 o; o[0] = pk2(m[0], m[1]); o[1] = pk2(m[2], m[3]);
                        *(LAS u32x2*)(Sm + l * RS_N + s0 * 2) = o; }
                    rsum += __shfl_xor(rsum, 32);
                    if (lane < 32) t_rs[sb * 128 + l] = rsum;
                } }
            if (wave == 1 || wave == 3) {
                const int lq = (wave == 1 ? 0 : 64) + lane;
                float qn = 0.f;
#pragma unroll 4
                for (int c = 0; c < 16; ++c) { const u32x4 qv = *(const LAS u32x4*)(Qs + lq * RS_N + c * 16);
                    const f32x4 n0 = *(const LAS f32x4*)(t_n + c * 8), n1 = *(const LAS f32x4*)(t_n + c * 8 + 4);
                    qn += bflo(qv[0]) * n0[0] + bfhi(qv[0]) * n0[1] + bflo(qv[1]) * n0[2] + bfhi(qv[1]) * n0[3]
                        + bflo(qv[2]) * n1[0] + bfhi(qv[2]) * n1[1] + bflo(qv[3]) * n1[2] + bfhi(qv[3]) * n1[3]; }
                t_qn[lq] = qn;
            }
        }
        {
#pragma unroll
            for (int r = 0; r < 16; ++r) st[r] *= a_s;
            const float f = bbs * kscale;
            f32x16 nacc;
#pragma unroll
            for (int r = 0; r < 16; ++r) nacc[r] = 0.f;
            bf16x8 ones;
#pragma unroll
            for (int j = 0; j < 8; ++j) ones[j] = (short)0x3f80;
#pragma unroll
            for (int kb2 = 0; kb2 < 2; ++kb2) {
                bf16x4 tk[4][2], tv[4][2];
                tr_col4(Ks, RS_N, 64 * kb2, 32 * kbw, lane, tk);
                tr_col4(Vs, RS_X, 64 * kb2, 32 * ebw, lane, tv);
#pragma unroll
                for (int k4 = 0; k4 < 4; ++k4) {
                    const int l0 = 16 * (4 * kb2 + k4) + 8 * (lane >> 5);
                    f32x4 w0 = *(const LAS f32x4*)(t_we + l0), w1 = *(const LAS f32x4*)(t_we + l0 + 4);
#pragma unroll
                    for (int j = 0; j < 4; ++j) { w0[j] *= f; w1[j] *= f; }
                    const bf16x8 ka = scale_frag(tr_join(tk[k4][0], tk[k4][1]), w0, w1);
                    st = mfma32(ka, tr_join(tv[k4][0], tv[k4][1]), st);
                    if (ebw == 0) nacc = mfma32(ka, ones, nacc);
                }
            }
            if (ebw == 0 && (lane & 31) == 0) {
#pragma unroll
                for (int gq = 0; gq < 4; ++gq)
#pragma unroll
                    for (int j = 0; j < 4; ++j) t_nc[32 * kbw + 8 * gq + 4 * (lane >> 5) + j] = nacc[4 * gq + j];
            }
        }
        __syncthreads();
        if (tid < 128) t_n[tid] = a_s * t_n[tid] + t_nc[tid];
        {
            const int eb = wave >> 2, lb = wave & 3;
            f32x16 acc;
#pragma unroll
            for (int r = 0; r < 16; ++r) acc[r] = 0.f;
#pragma unroll
            for (int kk = 0; kk < 8; ++kk) acc = mfma32(frag_row(Ct, RS_N, 32 * eb, 16 * kk, lane), frag_row(Qs, RS_N, 32 * lb, 16 * kk, lane), acc);
            const int l = 32 * lb + (lane & 31);
            const float wi = t_wi[l];
#pragma unroll
            for (int r = 0; r < 16; ++r) acc[r] *= wi;
            float rsum = 0.f;
            for (int sb = 0; sb <= lb; ++sb) {
                bf16x4 t2[2][2];
                const bf16x8 m0 = frag_row(Sm, RS_N, 32 * lb, 32 * sb, lane), m1 = frag_row(Sm, RS_N, 32 * lb, 32 * sb + 16, lane);
                rsum += t_rs[sb * 128 + l];
                tr_col2(Vs, RS_X, 32 * sb, 32 * eb, lane, t2);
                acc = mfma32(tr_join(t2[0][0], t2[0][1]), m0, acc);
                acc = mfma32(tr_join(t2[1][0], t2[1][1]), m1, acc);
            }
            float den = rsum + t_qn[l] * wi;
            den = fmaxf(fabsf(den), t_em[l]);
            const float inv = 1.f / den;
            bf16* hp = SCb + (size_t)scan_row<NB>(b, d, ch * 128 + l) * 4096 + 2048 + d * 1024 + hh * 256 + ev * 64 + 32 * eb + 4 * (lane >> 5);
#pragma unroll
            for (int gq = 0; gq < 4; ++gq) { u32x2 o; o[0] = pk2(acc[4 * gq] * inv, acc[4 * gq + 1] * inv); o[1] = pk2(acc[4 * gq + 2] * inv, acc[4 * gq + 3] * inv); *(u32x2*)(hp + 8 * gq) = o; }
        }
        __syncthreads();
    }
#undef ML_LOAD
}

template <int NB>
__device__ __forceinline__ void phase_scan(const bf16* PROJ, const unsigned char* tab, const bf16* XBC, bf16* SCb, LAS unsigned char* lds, int mode = 3) {
    const int G = gridDim.x, bi = blockIdx.x;
    if (NB == 4 && G == 256) {
        const int x = bi & 7, y = bi >> 3;
        if (y < 16) { if (mode & 1) { const int q = x + 8 * (y >> 3), hh = y & 7; ssd_item<NB>(XBC, tab, SCb, q >> 2, (q >> 1) & 1, (q & 1) * 8 + hh, lds); } }
        else { if (mode & 2) { const int y2 = y - 16, c = x + 8 * (y2 >> 2), ev = y2 & 3; mlstm_item<NB>(PROJ, tab, SCb, c >> 3, (c >> 2) & 1, c & 3, ev, lds); } }
        return;
    }
    if (mode & 1) for (int item = bi; item < NB * 32; item += G) { const int b = item / 32, d = (item >> 4) & 1, h = item & 15;
        ssd_item<NB>(XBC, tab, SCb, b, d, h, lds); }
    const int v = (bi + G - (NB * 32) % G) % G;
    if (mode & 2) for (int it = v; it < NB * 32; it += G) { const int b = it / 32, d = (it >> 4) & 1, hh = (it >> 2) & 3, ev = it & 3;
        mlstm_item<NB>(PROJ, tab, SCb, b, d, hh, ev, lds); }
}

template <int NB>
__device__ __forceinline__ void phase_mixer_out(const In& in, const bf16* PROJ, const bf16* XBC, bf16* SCb, bf16* scratch_out = nullptr) {
    constexpr int T = NB * (SEQ + CTXL);
    const int lane = otid() & 63, wave = otid() >> 6;
    for (int row = blockIdx.x * NWAVE + wave; row < T; row += gridDim.x * NWAVE) {
        bf16* sc = SCb + (size_t)row * 4096;
        const bf16* pr = PROJ + (size_t)row * PROJW;
        float yv[16], hv[16], ss = 0.f, hs[2] = {0.f, 0.f};
#pragma unroll
        for (int i = 0; i < 2; ++i) { const int c = lane * 8 + 512 * i;
            const u32x4 y0 = *(const u32x4*)(sc + c), y1 = *(const u32x4*)(sc + 1024 + c), h0 = *(const u32x4*)(sc + 2048 + c), h1 = *(const u32x4*)(sc + 3072 + c);
            const u32x4 xs = *(const u32x4*)(XBC + (size_t)row * 1536 + c), z = *(const u32x4*)(pr + PC_Z + c);
            const float dk = in.ssd_d[c >> 6];
#pragma unroll
            for (int j = 0; j < 4; ++j) {
                float a0 = bflo(y0[j]) + bflo(y1[j]) + dk * bflo(xs[j]), a1 = bfhi(y0[j]) + bfhi(y1[j]) + dk * bfhi(xs[j]);
                a0 *= siluf(bflo(z[j])); a1 *= siluf(bfhi(z[j]));
                yv[8 * i + 2 * j] = a0; yv[8 * i + 2 * j + 1] = a1; ss += a0 * a0 + a1 * a1;
                const float b0 = bflo(h0[j]) + bflo(h1[j]), b1 = bfhi(h0[j]) + bfhi(h1[j]);
                hv[8 * i + 2 * j] = b0; hv[8 * i + 2 * j + 1] = b1; hs[i] += b0 * b0 + b1 * b1; } }
        ss = wave_sum(ss);
        const float rs = rsqrtf(ss * (1.f / 1024.f) + 1e-6f);
#pragma unroll
        for (int i = 0; i < 2; ++i) {
#pragma unroll
            for (int o = 16; o > 0; o >>= 1) hs[i] += __shfl_xor(hs[i], o);
            hs[i] = rsqrtf(hs[i] * (1.f / 256.f) + 1e-6f); }
        __builtin_amdgcn_s_waitcnt(0);
#pragma unroll
        for (int i = 0; i < 2; ++i) { const int c = lane * 8 + 512 * i;
            const u32x4 ov = *(const u32x4*)(pr + PC_O + c);
            u32x4 oy, oh;
#pragma unroll
            for (int j = 0; j < 4; ++j) {
                oy[j] = pk2(yv[8 * i + 2 * j] * rs * in.ssd_norm_w[c + 2 * j], yv[8 * i + 2 * j + 1] * rs * in.ssd_norm_w[c + 2 * j + 1]);
                oh[j] = pk2(hv[8 * i + 2 * j] * hs[i] * in.ml_norm_w[c + 2 * j] * sigmf(bflo(ov[j])), hv[8 * i + 2 * j + 1] * hs[i] * in.ml_norm_w[c + 2 * j + 1] * sigmf(bfhi(ov[j]))); }
            bf16* dstp = scratch_out ? scratch_out + (size_t)row * 2048 : sc;
            *(u32x4*)(dstp + c) = oy; *(u32x4*)(dstp + 1024 + c) = oh; }
    }
}

template <int NB, class Idle>
__device__ __forceinline__ void phase_outproj(const bf16* A, int lda, int K, const bf16* Wt, int nrows, const float* xl, const float* xc, const float* modl, float* Xout,
                                              LAS unsigned char* lds, Idle&& idle) {
    constexpr int TL = NB * SEQ;
    const int MT = nrows / 256;
    for (int r = 0; r * (int)gridDim.x < MT * 8; ++r) {
        const int u = xcd_unit(r);
        if (u >= MT * 8) {
            idle(u - MT * 8, (r + 1) * (int)gridDim.x - MT * 8); continue; }
        int mt, nt; unit_tile(u, MT, 8, mt, nt);
        const bf16* arow[4];
#pragma unroll
        for (int i = 0; i < 4; ++i) arow[i] = A + (size_t)(mt * 256 + (otid() >> 3) + 64 * i) * lda;
        gemm_tile(arow, Wt + (size_t)nt * 128 * K, K, K, lds, [&](const f32x16 (&acc)[2][2], int wm, int wn, int lane) { stage_f32_128(acc, lds, wm, wn, lane); });
        __syncthreads();
        {
            const float* mv = modl + (size_t)mod_row<NB>(mt * 256) * 6144 + 2 * 1024 + nt * 128;
            const int t = otid(), piece = t & 31;
            const f32x4 m2 = *(const f32x4*)(mv + piece * 4);
#pragma unroll 4
            for (int it = 0; it < 16; ++it) { const int rl = it * 16 + (t >> 5), row = mt * 256 + rl;
                const f32x4 a = *(const LAS f32x4*)(lds + rl * CST_F32 + piece * 16);
                const float* srcp = (row < TL ? xl + (size_t)row * D : xc + (size_t)(row - TL) * D) + nt * 128 + piece * 4;
                const f32x4 xv = *(const f32x4*)srcp;
                f32x4 o;
#pragma unroll
                for (int j = 0; j < 4; ++j) o[j] = xv[j] + m2[j] * a[j];
                __builtin_nontemporal_store(o, (f32x4*)(Xout + (size_t)row * D + nt * 128 + piece * 4)); }
        }
        __syncthreads();
    }
}
}
namespace fx {
__device__ __forceinline__ int moe_prefix(const int* cnt, LAS int* pre  ) {
    __syncthreads();
    if (otid() < 64) {
        const int lane = otid();
        int v = lane < 32 ? (cnt[lane * 64] + 255) >> 8 : 0;
#pragma unroll
        for (int o = 1; o < 32; o <<= 1) { const int t = __shfl_up(v, o); if (lane >= o) v += t; }
        if (lane < 32) pre[lane + 1] = v;
        if (lane == 0) pre[0] = 0;
    }
    __syncthreads();
    return pre[32];
}
__device__ __forceinline__ int moe_find(const LAS int* pre, int t) { int e = 0;
#pragma unroll
    for (int i = 1; i < 32; ++i) e += (t >= pre[i]) ? 1 : 0;
    return e; }

__device__ __forceinline__ void phase_moe_up(const bf16* H2, const bf16* Wgu, const int* cnt, const int* list, int cap, const float* route_w, bf16* ACT, LAS unsigned char* lds) {
    LAS int* pre = (LAS int*)(lds + GEMM_LDS);
    const int ntile = moe_prefix(cnt, pre);
    for (int r = 0; r * (int)gridDim.x < ntile * 8; ++r) {
        const int u = xcd_unit(r); if (u >= ntile * 8) continue;
        const int t = u >> 3, nt = u & 7, e = moe_find(pre, t), mt = t - pre[e], ce = cnt[e * 64];
        const int* le = list + (size_t)e * cap + mt * 256;
        const int nvalid = ce - mt * 256;
        const bf16* arow[4];
#pragma unroll
        for (int i = 0; i < 4; ++i) { const int r = (otid() >> 3) + 64 * i; const int ent = le[r < nvalid ? r : 0]; arow[i] = H2 + (size_t)(ent >> 1) * D; }
        gemm_tile(arow, Wgu + (size_t)e * 1024 * 1024 + (size_t)nt * 128 * 1024, 1024, 1024, lds, [&](const f32x16 (&acc)[2][2], int wm, int wn, int lane) {
#pragma unroll
            for (int mi = 0; mi < 2; ++mi) { const int r = wm * 64 + mi * 32 + (lane & 31);
                const float w = r < nvalid ? route_w[le[r]] : 0.f;
                LAS unsigned char* rp = lds + r * CST_BF64 + (wn * 32 + 4 * (lane >> 5)) * 2;
#pragma unroll
                for (int g = 0; g < 4; ++g) { float v[4];
#pragma unroll
                    for (int j = 0; j < 4; ++j) v[j] = siluf(acc[mi][0][4 * g + j]) * acc[mi][1][4 * g + j] * w;
                    u32x2 o; o[0] = pk2(v[0], v[1]); o[1] = pk2(v[2], v[3]); *(LAS u32x2*)(rp + 8 * g * 2) = o; } }
        });
        __syncthreads();
        flush_bf16_64(lds, [&](int r) -> bf16* { return r < nvalid ? ACT + (size_t)le[r] * 512 + nt * 64 : nullptr; });
        __syncthreads();
    }
}
__device__ __forceinline__ void phase_moe_down(const bf16* ACT, const bf16* Wd, const int* cnt, const int* list, int cap, bf16* Y2, LAS unsigned char* lds) {
    LAS int* pre = (LAS int*)(lds + GEMM_LDS);
    const int ntile = moe_prefix(cnt, pre);
    for (int r = 0; r * (int)gridDim.x < ntile * 8; ++r) {
        const int u = xcd_unit(r); if (u >= ntile * 8) continue;
        const int t = u >> 3, nt = u & 7, e = moe_find(pre, t), mt = t - pre[e], ce = cnt[e * 64];
        const int* le = list + (size_t)e * cap + mt * 256;
        const int nvalid = ce - mt * 256;
        const bf16* arow[4];
#pragma unroll
        for (int i = 0; i < 4; ++i) { const int r = (otid() >> 3) + 64 * i; const int ent = le[r < nvalid ? r : 0]; arow[i] = ACT + (size_t)ent * 512; }
        gemm_tile(arow, Wd + (size_t)e * 1024 * 512 + (size_t)nt * 128 * 512, 512, 512, lds, [&](const f32x16 (&acc)[2][2], int wm, int wn, int lane) { stage_bf16_128(acc, lds, wm, wn, lane); });
        __syncthreads();
        flush_bf16_128(lds, [&](int r) -> bf16* { return r < nvalid ? Y2 + (size_t)le[r] * D + nt * 128 : nullptr; });
        __syncthreads();
    }
}

template <int NB>
__device__ __forceinline__ void phase_qkv(const bf16* H, const bf16* Wt, const float* qn, const float* kn, bf16* QKV, LAS unsigned char* lds) {
    constexpr int T = NB * (SEQ + CTXL), MT = T / 256;
    for (int r = 0; r * (int)gridDim.x < MT * 24; ++r) {
        const int u = xcd_unit(r); if (u >= MT * 24) continue;
        int mt, nt; unit_tile(u, MT, 24, mt, nt);
        const bf16* arow[4];
#pragma unroll
        for (int i = 0; i < 4; ++i) arow[i] = H + (size_t)(mt * 256 + (otid() >> 3) + 64 * i) * D;
        gemm_tile(arow, Wt + (size_t)nt * 128 * D, D, D, lds, [&](const f32x16 (&acc)[2][2], int wm, int wn, int lane) {
            const int which = nt >> 3;
#pragma unroll
            for (int mi = 0; mi < 2; ++mi) {
                float rs = 1.f;
                if (which < 2) { float ss = 0.f;
#pragma unroll
                    for (int ni = 0; ni < 2; ++ni)
#pragma unroll
                        for (int r = 0; r < 16; ++r) ss += acc[mi][ni][r] * acc[mi][ni][r];
                    ss += __shfl_xor(ss, 32);
                    rs = rsqrtf(ss * (1.f / 64.f) + 1e-6f) * (which == 0 ? 0.125f : 1.f); }
                const float* nwp = which == 0 ? qn : kn;
                LAS unsigned char* rp = lds + (wm * 64 + mi * 32 + (lane & 31)) * CST_BF + (wn * 64 + 4 * (lane >> 5)) * 2;
#pragma unroll
                for (int ni = 0; ni < 2; ++ni)
#pragma unroll
                    for (int g = 0; g < 4; ++g) { float v[4];
#pragma unroll
                        for (int j = 0; j < 4; ++j) { v[j] = acc[mi][ni][4 * g + j]; if (which < 2) v[j] *= rs * nwp[ni * 32 + 8 * g + 4 * (lane >> 5) + j]; }
                        u32x2 o; o[0] = pk2(v[0], v[1]); o[1] = pk2(v[2], v[3]); *(LAS u32x2*)(rp + (ni * 32 + 8 * g) * 2) = o; } }
        });
        __syncthreads();
        flush_bf16_128(lds, [&](int r) { return QKV + (size_t)(mt * 256 + r) * 3072 + nt * 128; });
        __syncthreads();
    }
}

__device__ __forceinline__ bf16x8 frag16_row(const LAS unsigned char* T, int RS, int r0, int c0, int lane) {
    return *(const LAS bf16x8*)(T + (r0 + (lane & 15)) * RS + (c0 + 8 * (lane >> 4)) * 2);
}
__device__ __forceinline__ bf16x8 frag16_vt(const LAS unsigned char* T, int RS, int kb, int c0, int lane) {
    const int g4 = lane >> 4, q = (lane & 15) >> 2, p = lane & 3;
    const unsigned a0 = (unsigned)(size_t)(T + (kb + 4 * g4 + q) * RS + (c0 + 4 * p) * 2);
    const unsigned a1 = a0 + 16 * RS;
    bf16x4 v0, v1;
    asm volatile("ds_read_b64_tr_b16 %0, %2\n\tds_read_b64_tr_b16 %1, %3\n\ts_waitcnt lgkmcnt(0)" : "=&v"(v0), "=&v"(v1) : "v"(a0), "v"(a1) : "memory");
    bf16x8 r; r[0] = v0[0]; r[1] = v0[1]; r[2] = v0[2]; r[3] = v0[3]; r[4] = v1[0]; r[5] = v1[1]; r[6] = v1[2]; r[7] = v1[3];
    return r;
}

template <bool LOCAL>
__device__ __forceinline__ void attn_group(const LAS unsigned char* Kt, const LAS unsigned char* Vt, int koff, int kb, int hsel, int lane, int g4,
                                           const bf16x8& q0, const bf16x8& q1, f32x4 (&oacc)[4], float& l_run,
                                           int cs, int c, int brow  , const LAS float* rp) {
    f32x4 s[2];
#pragma unroll
    for (int sb = 0; sb < 2; ++sb) { s[sb] = (f32x4){0.f, 0.f, 0.f, 0.f};
        s[sb] = mfma16(frag16_row(Kt, RS_N, koff + kb + 16 * sb, hsel * 64, lane), q0, s[sb]);
        s[sb] = mfma16(frag16_row(Kt, RS_N, koff + kb + 16 * sb, hsel * 64 + 32, lane), q1, s[sb]); }
    float ps = 0.f; float p[8];
#pragma unroll
    for (int sb = 0; sb < 2; ++sb)
#pragma unroll
        for (int j = 0; j < 4; ++j) {
            float e;
            if (LOCAL) { const int kc = kb + 16 * sb + 4 * g4 + j; const bool ok = kc >= cs && kc < cs + 16;
                e = ok ? __expf(s[sb][j] + rp[hsel * 465 + (ok ? brow + (kc - c + 15) : 0)] - 8.f) : 0.f; }
            else e = __expf(s[sb][j] - 8.f);
            p[4 * sb + j] = e; ps += e; }
    l_run += ps;
    u32x4 pu; pu[0] = pk2(p[0], p[1]); pu[1] = pk2(p[2], p[3]); pu[2] = pk2(p[4], p[5]); pu[3] = pk2(p[6], p[7]);
    const bf16x8 pf = __builtin_bit_cast(bf16x8, pu);
    bf16x4 tv[4][2];
    {
        const int q = (lane & 15) >> 2, p4 = lane & 3;
        const unsigned a = (unsigned)(size_t)(Vt + (koff + kb + 4 * g4 + q) * RS_N + (hsel * 64 + 4 * p4) * 2);
        tr8(a, a + 16 * RS_N, a + 32, a + 32 + 16 * RS_N, a + 64, a + 64 + 16 * RS_N, a + 96, a + 96 + 16 * RS_N,
            tv[0][0], tv[0][1], tv[1][0], tv[1][1], tv[2][0], tv[2][1], tv[3][0], tv[3][1]);
    }
#pragma unroll
    for (int db = 0; db < 4; ++db) oacc[db] = mfma16(tr_join(tv[db][0], tv[db][1]), pf, oacc[db]);
}

template <bool LOCAL>
__device__ __forceinline__ void attn_group2(const LAS unsigned char* Kt, const LAS unsigned char* Vt, int koff, int kb, int hsel, int lane, int g4,
                                            const bf16x8 (&q0)[2], const bf16x8 (&q1)[2], f32x4 (&oacc)[2][4], float (&l_run)[2],
                                            int cs, int c, int brow0, int brow1, const LAS float* rp) {
    bf16x8 kf[2][2];
#pragma unroll
    for (int sb = 0; sb < 2; ++sb) { kf[sb][0] = frag16_row(Kt, RS_N, koff + kb + 16 * sb, hsel * 64, lane); kf[sb][1] = frag16_row(Kt, RS_N, koff + kb + 16 * sb, hsel * 64 + 32, lane); }
    f32x4 s[2][2];
#pragma unroll
    for (int qr = 0; qr < 2; ++qr)
#pragma unroll
        for (int sb = 0; sb < 2; ++sb) { s[qr][sb] = (f32x4){0.f, 0.f, 0.f, 0.f};
            s[qr][sb] = mfma16(kf[sb][0], q0[qr], s[qr][sb]); s[qr][sb] = mfma16(kf[sb][1], q1[qr], s[qr][sb]); }
    bf16x8 pf[2];
#pragma unroll
    for (int qr = 0; qr < 2; ++qr) {
        float ps = 0.f; float p[8];
        const int brow = qr ? brow1 : brow0;
#pragma unroll
        for (int sb = 0; sb < 2; ++sb)
#pragma unroll
            for (int j = 0; j < 4; ++j) {
                float e;
                if (LOCAL) { const int kc = kb + 16 * sb + 4 * g4 + j; const bool ok = kc >= cs && kc < cs + 16;
                    const float bv = rp[hsel * 465 + (ok ? brow + (kc - c + 15) : 0)];
                    const float ex = __expf(s[qr][sb][j] + bv - 8.f);
                    e = ok ? ex : 0.f; }
                else e = __expf(s[qr][sb][j] - 8.f);
                p[4 * sb + j] = e; ps += e; }
        l_run[qr] += ps;
        u32x4 pu; pu[0] = pk2(p[0], p[1]); pu[1] = pk2(p[2], p[3]); pu[2] = pk2(p[4], p[5]); pu[3] = pk2(p[6], p[7]);
        pf[qr] = __builtin_bit_cast(bf16x8, pu);
    }
    bf16x4 tv[4][2];
    {
        const int q = (lane & 15) >> 2, p4 = lane & 3;
        const unsigned a = (unsigned)(size_t)(Vt + (koff + kb + 4 * g4 + q) * RS_N + (hsel * 64 + 4 * p4) * 2);
        tr8(a, a + 16 * RS_N, a + 32, a + 32 + 16 * RS_N, a + 64, a + 64 + 16 * RS_N, a + 96, a + 96 + 16 * RS_N,
            tv[0][0], tv[0][1], tv[1][0], tv[1][1], tv[2][0], tv[2][1], tv[3][0], tv[3][1]);
    }
#pragma unroll
    for (int db = 0; db < 4; ++db) { const bf16x8 vf = tr_join(tv[db][0], tv[db][1]);
        oacc[0][db] = mfma16(vf, pf[0], oacc[0][db]); oacc[1][db] = mfma16(vf, pf[1], oacc[1][db]); }
}

constexpr int ATT_QR = 2;
template <int NB>
__device__ __forceinline__ void phase_attn(const bf16* QKV, const float* rpb, bf16* AO, LAS unsigned char* lds) {
    constexpr int TL = NB * SEQ;
    constexpr int TILE = 128 * RS_N;
    const int tid = otid(), lane = tid & 63, wave = tid >> 6, w = wave & 3, hsel = wave >> 2;
    const int qi = lane & 15, g4 = lane >> 4;
    LAS float* rp = (LAS float*)(lds + 4 * TILE);
    constexpr int QR = ATT_QR, NRG = 64 / QR;
    for (int u = blockIdx.x; u < NB * NRG * 8; u += gridDim.x) {
        const int hp = u & 7, rg = (u >> 3) % NRG, b = (u >> 3) / NRG;
        const int head = 2 * hp + hsel;
        int R0 = QR * rg - 4; R0 = R0 < 0 ? 0 : (R0 > 56 ? 56 : R0);
        int R1 = QR * rg + QR - 1 - 4; R1 = (R1 < 0 ? 0 : (R1 > 56 ? 56 : R1)) + 7;
        const int nloc = R1 - R0 + 1, nl2 = (nloc + 1) >> 1, nit = nl2 + 2;
        __syncthreads();
        for (int i = tid; i < 2 * 465; i += NTHR) rp[i] = rpb[(size_t)(2 * hp) * 465 + i];
        const int c = 16 * w + qi;
        int cs = c - 8; cs = cs < 0 ? 0 : (cs > 48 ? 48 : cs);
        const int kbw = w == 0 ? 0 : (w == 1 ? 8 : (w == 2 ? 24 : 32));
        bf16x8 q0[QR], q1[QR]; f32x4 oacc[QR][4]; float l_run[QR];
#pragma unroll
        for (int qr = 0; qr < QR; ++qr) {
            const size_t qrow = (size_t)b * SEQ + (QR * rg + qr) * 64 + c;
            q0[qr] = *(const bf16x8*)(QKV + qrow * 3072 + head * 64 + 8 * g4); q1[qr] = *(const bf16x8*)(QKV + qrow * 3072 + head * 64 + 32 + 8 * g4);
#pragma unroll
            for (int i = 0; i < 4; ++i) oacc[qr][i] = (f32x4){0.f, 0.f, 0.f, 0.f};
            l_run[qr] = 0.f; }
        u32x4 sk[4], sv[4];
#define AT_LOAD(it) do { \
        _Pragma("unroll") for (int i = 0; i < 4; ++i) { const int idx = tid + 512 * i, key = idx >> 4, ch = idx & 15; \
            int kr_ = R0 + 2 * (it) + (key >> 6); kr_ = kr_ > 63 ? 63 : kr_; \
            const size_t krow = (it) < nl2 ? (size_t)b * SEQ + (size_t)kr_ * 64 + (key & 63) : (size_t)TL + (size_t)b * CTXL + ((it) - nl2) * 128 + key; \
            const bf16* kp = QKV + krow * 3072 + 1024 + hp * 128 + ch * 8; sk[i] = *(const u32x4*)kp; sv[i] = *(const u32x4*)(kp + 1024); } } while (0)
#define AT_STORE(buf) do { LAS unsigned char* kt_ = lds + (buf) * 2 * TILE; \
        _Pragma("unroll") for (int i = 0; i < 4; ++i) { const int idx = tid + 512 * i, key = idx >> 4, ch = idx & 15; \
            *(LAS u32x4*)(kt_ + key * RS_N + ch * 16) = sk[i]; *(LAS u32x4*)(kt_ + TILE + key * RS_N + ch * 16) = sv[i]; } } while (0)
        AT_LOAD(0);
        AT_STORE(0);
        __syncthreads();
        for (int it = 0; it < nit; ++it) {
            const LAS unsigned char* Kt = lds + (it & 1) * 2 * TILE; const LAS unsigned char* Vt = Kt + TILE;
            if (it + 1 < nit) AT_LOAD(it + 1);
            if (it < nl2) {
                static_assert(QR == 2, "attn_group2 pairs two query rows");
                const int ra = QR * rg, rb = ra + 1;
                int r0a = ra - 4; r0a = r0a < 0 ? 0 : (r0a > 56 ? 56 : r0a);
                int r0b = rb - 4; r0b = r0b < 0 ? 0 : (r0b > 56 ? 56 : r0b);
#pragma unroll 1
                for (int sub = 0; sub < 2; ++sub) {
                    const int kr = R0 + 2 * it + sub;
                    const bool ina = kr >= r0a && kr < r0a + 8, inb = kr >= r0b && kr < r0b + 8;
                    if (ina && inb) attn_group2<true>(Kt, Vt, 64 * sub, kbw, hsel, lane, g4, q0, q1, oacc, l_run, cs, c, (kr - ra + 7) * 31, (kr - rb + 7) * 31, rp);
                    else if (ina) attn_group<true>(Kt, Vt, 64 * sub, kbw, hsel, lane, g4, q0[0], q1[0], oacc[0], l_run[0], cs, c, (kr - ra + 7) * 31, rp);
                    else if (inb) attn_group<true>(Kt, Vt, 64 * sub, kbw, hsel, lane, g4, q0[1], q1[1], oacc[1], l_run[1], cs, c, (kr - rb + 7) * 31, rp);
                }
            } else {
#pragma unroll 1
                for (int g = 0; g < 4; ++g) attn_group2<false>(Kt, Vt, 0, 32 * g, hsel, lane, g4, q0, q1, oacc, l_run, 0, 0, 0, 0, rp);
            }
            if (it + 1 < nit) AT_STORE((it + 1) & 1);
            __syncthreads();
        }
#undef AT_LOAD
#undef AT_STORE
#pragma unroll
        for (int qr = 0; qr < QR; ++qr) {
            float l = l_run[qr]; l += __shfl_xor(l, 16); l += __shfl_xor(l, 32);
            const float inv = 1.f / l;
            const size_t qrow = (size_t)b * SEQ + (QR * rg + qr) * 64 + c;
            bf16* op = AO + qrow * D + head * 64 + 4 * g4;
#pragma unroll
            for (int db = 0; db < 4; ++db) { u32x2 o; o[0] = pk2(oacc[qr][db][0] * inv, oacc[qr][db][1] * inv); o[1] = pk2(oacc[qr][db][2] * inv, oacc[qr][db][3] * inv); *(u32x2*)(op + 16 * db) = o; }
        }
    }
}
}
namespace fx {
namespace g8 {
constexpr int BM = 256, BK = 64, HALF = 128, HTB = HALF * BK * 2, STAGE_BYTES = 8 * HTB;
__device__ __forceinline__ int lds_byte(int r, int c) { const int st = (r >> 4) * 2 + (c >> 5), rr = r & 15, cc = c & 31, ob = rr * 64 + cc * 2; return st * 1024 + (ob ^ (((ob >> 9) & 1) << 5)); }
__device__ __forceinline__ void stage_rc(int b, int& R, int& C) { const int st = b / 1024, sb = b % 1024, swz = sb ^ (((sb >> 9) & 1) << 5); R = (st >> 1) * 16 + swz / 64; C = (st & 1) * 32 + (swz % 64) / 2; }
__device__ __forceinline__ int perm32(int rho) { const int n = rho >> 4, i = rho & 15; return 8 * (i >> 2) + 4 * n + (i & 3); }
struct Unit { int pm, pn, i0; const int* p; };

template <class Epi, class Sched>
__device__ __forceinline__ void gemm_phase(LAS unsigned char* lds, int K, const Sched& S, const Epi& E) {
    const int tid = otid(), wid = __builtin_amdgcn_readfirstlane(tid >> 6), lane = tid & 63, wr = wid >> 2, wc = wid & 3, fr = lane & 15, fq = lane >> 4;
    const int nt = K / BK;
    int Rr[2], Cc[2]; unsigned voffB[2];
#pragma unroll
    for (int i = 0; i < 2; ++i) { int R, C; stage_rc(tid * 16 + i * 8192, R, C); Rr[i] = R; Cc[i] = C;
        const int Rb = Epi::PERM ? ((R & ~31) + perm32(R & 31)) : R; voffB[i] = (unsigned)(Rb * K + C) * 2u; }
    const size_t kstep = (size_t)(BK * 2);
    const size_t hstepB = (size_t)HALF * K * 2;
    const unsigned ldsw = (unsigned)wid * 1024u;
    const int aoff = lds_byte(wr * 64 + fr, fq * 8), boff = lds_byte(wc * 32 + fr, fq * 8);
#define G8_SA(b, h) (((b) * 2 + (h)) * HTB)
#define G8_SB(b, h) ((4 + (b) * 2 + (h)) * HTB)
#define G8_STAGE_B(bufoff, gbase) do { _Pragma("unroll") for (int _i = 0; _i < 2; ++_i) \
        __builtin_amdgcn_global_load_lds((const unsigned*)((const char*)(gbase) + voffB[_i]), (LAS unsigned*)(lds + (bufoff) + ldsw + _i * 8192), 16, 0, 0); } while (0)
#define G8_STAGE_A(bufoff, gbase, o0, o1) do { \
        __builtin_amdgcn_global_load_lds((const unsigned*)((const char*)(gbase) + (o0)), (LAS unsigned*)(lds + (bufoff) + ldsw), 16, 0, 0); \
        __builtin_amdgcn_global_load_lds((const unsigned*)((const char*)(gbase) + (o1)), (LAS unsigned*)(lds + (bufoff) + ldsw + 8192), 16, 0, 0); } while (0)
#define G8_LDA(dst, b, h) do { _Pragma("unroll") for (int m = 0; m < 4; ++m) _Pragma("unroll") for (int k = 0; k < 2; ++k) dst[m][k] = *(const LAS bf16x8*)(lds + G8_SA(b, h) + aoff + m * 2048 + k * 1024); } while (0)
#define G8_LDB(dst, b, h) do { _Pragma("unroll") for (int n = 0; n < 2; ++n) _Pragma("unroll") for (int k = 0; k < 2; ++k) dst[n][k] = *(const LAS bf16x8*)(lds + G8_SB(b, h) + boff + n * 2048 + k * 1024); } while (0)
#define G8_MMA(ai, bj, At, Bt) do { __builtin_amdgcn_s_setprio(1); _Pragma("unroll") for (int m = 0; m < 4; ++m) _Pragma("unroll") for (int n = 0; n < 2; ++n) _Pragma("unroll") for (int k = 0; k < 2; ++k) \
        acc[ai][bj][m][n] = __builtin_amdgcn_mfma_f32_16x16x32_bf16(Bt[n][k], At[m][k], acc[ai][bj][m][n], 0, 0, 0); __builtin_amdgcn_s_setprio(0); } while (0)
#define G8_WAIT_V(n) asm volatile("s_waitcnt vmcnt(" #n ")" ::: "memory")
#define G8_WAIT_L(n) asm volatile("s_waitcnt lgkmcnt(" #n ")" ::: "memory")
#define G8_BAR __builtin_amdgcn_s_barrier()
#define G8_SCHED __builtin_amdgcn_sched_barrier(0)
    Unit cur, nxt; int ui = 0;
    if (!S.next(0, cur)) return;
    f32x4 acc[2][2][4][2];
#pragma unroll
    for (int a = 0; a < 2; ++a)
#pragma unroll
        for (int b = 0; b < 2; ++b)
#pragma unroll
            for (int m = 0; m < 4; ++m)
#pragma unroll
                for (int n = 0; n < 2; ++n) acc[a][b][m][n] = (f32x4){0.f, 0.f, 0.f, 0.f};
    bf16x8 At[4][2], B0[2][2], B1[2][2];
    unsigned oaC[2][2], oaN[2][2]; const char* cAb; const char* cB; const char* nAb; const char* nB;
    S.src(cur, Rr, Cc, oaC, cAb, cB);
    G8_STAGE_B(G8_SB(0, 0), cB); G8_STAGE_A(G8_SA(0, 0), cAb, oaC[0][0], oaC[0][1]); G8_STAGE_B(G8_SB(0, 1), cB + hstepB); G8_STAGE_A(G8_SA(0, 1), cAb, oaC[1][0], oaC[1][1]);
    if (wr == 1) G8_BAR;
    G8_WAIT_V(4); G8_BAR;
    G8_STAGE_B(G8_SB(1, 0), cB + kstep); G8_STAGE_A(G8_SA(1, 0), cAb + kstep, oaC[0][0], oaC[0][1]); G8_STAGE_B(G8_SB(1, 1), cB + hstepB + kstep);
    G8_WAIT_V(6); G8_BAR;
    for (;;) {
        const bool has_next = S.next(ui + 1, nxt);
        if (has_next) S.src(nxt, Rr, Cc, oaN, nAb, nB);
        else { nAb = cAb; nB = cB;
#pragma unroll
            for (int h = 0; h < 2; ++h)
#pragma unroll
                for (int i = 0; i < 2; ++i) oaN[h][i] = oaC[h][i]; }
        for (int t = 0; t < nt; t += 2) {
            const bool last = (t == nt - 2);
            const char* a1 = cAb + (size_t)(t + 1) * kstep;
            const char* a2 = last ? nAb : cAb + (size_t)(t + 2) * kstep; const char* b2 = last ? nB : cB + (size_t)(t + 2) * kstep;
            const char* a3 = a2 + kstep; const char* b3 = b2 + kstep;
            const unsigned o00 = last ? oaN[0][0] : oaC[0][0], o01 = last ? oaN[0][1] : oaC[0][1], o10 = last ? oaN[1][0] : oaC[1][0], o11 = last ? oaN[1][1] : oaC[1][1];
            G8_LDB(B0, 0, 0); G8_SCHED; G8_LDA(At, 0, 0); G8_STAGE_A(G8_SA(1, 1), a1, oaC[1][0], oaC[1][1]);
            G8_WAIT_L(8); G8_BAR; G8_WAIT_L(0); G8_MMA(0, 0, At, B0); G8_BAR; G8_SCHED;
            G8_LDB(B1, 0, 1); G8_STAGE_B(G8_SB(0, 0), b2);
            G8_BAR; G8_WAIT_L(0); G8_MMA(0, 1, At, B1); G8_BAR;
            G8_LDA(At, 0, 1); G8_STAGE_A(G8_SA(0, 0), a2, o00, o01);
            G8_BAR; G8_WAIT_L(0); G8_MMA(1, 0, At, B0); G8_BAR; G8_SCHED;
            G8_STAGE_B(G8_SB(0, 1), b2 + hstepB);
            G8_WAIT_V(6); G8_BAR; G8_MMA(1, 1, At, B1); G8_BAR;
            G8_LDB(B0, 1, 0); G8_SCHED; G8_LDA(At, 1, 0); G8_STAGE_A(G8_SA(0, 1), a2, o10, o11);
            G8_WAIT_L(8); G8_BAR; G8_WAIT_L(0); G8_MMA(0, 0, At, B0); G8_BAR; G8_SCHED;
            G8_LDB(B1, 1, 1); G8_STAGE_B(G8_SB(1, 0), b3);
            G8_BAR; G8_WAIT_L(0); G8_MMA(0, 1, At, B1); G8_BAR;
            G8_LDA(At, 1, 1); G8_STAGE_A(G8_SA(1, 0), a3, o00, o01);
            G8_BAR; G8_WAIT_L(0); G8_MMA(1, 0, At, B0); G8_BAR; G8_SCHED;
            G8_STAGE_B(G8_SB(1, 1), b3 + hstepB);
            G8_WAIT_V(6); G8_BAR; G8_MMA(1, 1, At, B1); G8_BAR;
        }
        E(acc, cur, wr, wc, fr, fq);
        if (!has_next) break;
#pragma unroll
        for (int a = 0; a < 2; ++a)
#pragma unroll
            for (int b = 0; b < 2; ++b)
#pragma unroll
                for (int m = 0; m < 4; ++m)
#pragma unroll
                    for (int n = 0; n < 2; ++n) acc[a][b][m][n] = (f32x4){0.f, 0.f, 0.f, 0.f};
        cur = nxt; cAb = nAb; cB = nB; ++ui;
#pragma unroll
        for (int h = 0; h < 2; ++h)
#pragma unroll
            for (int i = 0; i < 2; ++i) oaC[h][i] = oaN[h][i];
    }
    G8_WAIT_V(0);
    if (wr == 0) G8_BAR;
    G8_BAR;
#undef G8_SA
#undef G8_SB
#undef G8_STAGE_A
#undef G8_STAGE_B
#undef G8_LDA
#undef G8_LDB
#undef G8_MMA
#undef G8_WAIT_V
#undef G8_WAIT_L
#undef G8_BAR
#undef G8_SCHED
}

struct DenseSched {
    const bf16* A; int lda; const bf16* Bt; int K; int MT, NT; int F;
    __device__ __forceinline__ bool next(int i, Unit& u) const { const int G = gridDim.x; if (i >= F || i * G >= MT * NT) return false; const int ul = xcd_unit(i); if (ul >= MT * NT) return false;
        int mt, nt_; unit_tile(ul, MT, NT, mt, nt_); u.pm = mt; u.pn = nt_; u.i0 = 0; u.p = nullptr; return true; }
    __device__ __forceinline__ void src(const Unit& u, const int (&R)[2], const int (&C)[2], unsigned (&oa)[2][2], const char*& abase, const char*& bbase) const {
        abase = (const char*)(A + (size_t)u.pm * 256 * lda); bbase = (const char*)(Bt + (size_t)u.pn * 256 * K);
#pragma unroll
        for (int h = 0; h < 2; ++h)
#pragma unroll
            for (int i = 0; i < 2; ++i) oa[h][i] = (unsigned)((128 * h + R[i]) * lda + C[i]) * 2u; }
};
}

struct EpiProj {
    static constexpr bool PERM = true;
    bf16* O; int ldc;
    __device__ __forceinline__ void operator()(const f32x4 (&acc)[2][2][4][2], const g8::Unit& u, int wr, int wc, int fr, int fq) const {
        const int row0 = u.pm * 256 + wr * 64 + fr, col0 = u.pn * 256 + wc * 32 + 8 * fq;
#pragma unroll
        for (int ai = 0; ai < 2; ++ai)
#pragma unroll
            for (int m = 0; m < 4; ++m) { bf16* rowp = O + (size_t)(row0 + ai * 128 + m * 16) * ldc + col0;
#pragma unroll
                for (int bj = 0; bj < 2; ++bj) { const f32x4 v0 = acc[ai][bj][m][0], v1 = acc[ai][bj][m][1];
                    u32x4 w; w[0] = pk2(v0[0], v0[1]); w[1] = pk2(v0[2], v0[3]); w[2] = pk2(v1[0], v1[1]); w[3] = pk2(v1[2], v1[3]);
                    *(u32x4*)(rowp + bj * 128) = w; } }
    }
};
template <int NB>
__device__ __forceinline__ void phase_inproj8(const bf16* H, const bf16* Wt, bf16* PROJ, float* GATES, LAS unsigned char* lds) {
    constexpr int T = NB * (SEQ + CTXL), MT = T / 256;
    g8::DenseSched S{H, D, Wt, D, MT, PROJW / 256, 1 << 20};
    EpiProj E{PROJ, PROJW};
    g8::gemm_phase(lds, D, S, E);
    for (int mt = blockIdx.x; mt < MT; mt += gridDim.x) {
        const bf16* arow[4];
#pragma unroll
        for (int i = 0; i < 4; ++i) arow[i] = H + (size_t)(mt * 256 + (otid() >> 3) + 64 * i) * D;
        gemm_tile(arow, Wt + (size_t)PROJW * D, D, D, lds, [&](const f32x16 (&acc)[2][2], int wm, int wn, int lane) {
            if (wn == 0) {
#pragma unroll
                for (int mi = 0; mi < 2; ++mi) { const int row = mt * 256 + wm * 64 + mi * 32 + (lane & 31);
#pragma unroll
                    for (int ni = 0; ni < 2; ++ni)
#pragma unroll
                        for (int g = 0; g < 4; ++g) { f32x4 o; o[0] = acc[mi][ni][4 * g]; o[1] = acc[mi][ni][4 * g + 1]; o[2] = acc[mi][ni][4 * g + 2]; o[3] = acc[mi][ni][4 * g + 3];
                            *(f32x4*)(GATES + (size_t)row * 64 + ni * 32 + 8 * g + 4 * (lane >> 5)) = o; } } }
        });
        __syncthreads();
    }
}
template <int NB, bool XIN_BF> struct EpiResid {
    static constexpr bool PERM = true;
    const float* xl; const float* xc; const float* modl; bf16* Xout;
    __device__ __forceinline__ void operator()(const f32x4 (&acc)[2][2][4][2], const g8::Unit& u, int wr, int wc, int fr, int fq) const {
        constexpr int TL = NB * SEQ;
        const float* mv = modl + (size_t)mod_row<NB>(u.pm * 256) * 6144 + 2 * 1024;
        const int col0 = u.pn * 256 + wc * 32 + 8 * fq;
#pragma unroll
        for (int ai = 0; ai < 2; ++ai)
#pragma unroll
            for (int m = 0; m < 4; ++m) { const int row = u.pm * 256 + ai * 128 + wr * 64 + m * 16 + fr;
                const size_t soff = (row < TL ? (size_t)row * D : (size_t)(row - TL) * D) + col0;
                bf16* dstp = Xout + (size_t)row * D + col0;
#pragma unroll
                for (int bj = 0; bj < 2; ++bj) { const int co = bj * 128;
                    f32x4 x0, x1;
                    if (XIN_BF) { const u32x4 t4 = *(const u32x4*)((const bf16*)(row < TL ? xl : xc) + soff + co);
                        x0 = (f32x4){bflo(t4[0]), bfhi(t4[0]), bflo(t4[1]), bfhi(t4[1])}; x1 = (f32x4){bflo(t4[2]), bfhi(t4[2]), bflo(t4[3]), bfhi(t4[3])}; }
                    else { const float* sp = (row < TL ? xl : xc) + soff + co; x0 = *(const f32x4*)sp; x1 = *(const f32x4*)(sp + 4); }
                    const f32x4 m0 = *(const f32x4*)(mv + col0 + co), m1 = *(const f32x4*)(mv + col0 + co + 4);
                    float o[8];
#pragma unroll
                    for (int j = 0; j < 4; ++j) { o[j] = x0[j] + m0[j] * acc[ai][bj][m][0][j]; o[4 + j] = x1[j] + m1[j] * acc[ai][bj][m][1][j]; }
                    u32x4 w; w[0] = pk2(o[0], o[1]); w[1] = pk2(o[2], o[3]); w[2] = pk2(o[4], o[5]); w[3] = pk2(o[6], o[7]);
                    *(u32x4*)(dstp + co) = w; } }
    }
};
template <int NB, bool XIN_BF, class Idle>
__device__ __forceinline__ void phase_outproj8(const bf16* A, int lda, int K, const bf16* Wt, int nrows, const float* xl, const float* xc, const float* modl, bf16* Xout, LAS unsigned char* lds, Idle&& idle) {
    constexpr int TL = NB * SEQ;
    const int MT = nrows / 256, U = MT * 4, G = gridDim.x, F = U / G, R = U - F * G;
    if (F > 0) { g8::DenseSched S{A, lda, Wt, K, MT, 4, F}; EpiResid<NB, XIN_BF> E{xl, xc, modl, Xout}; g8::gemm_phase(lds, K, S, E); }
    for (int r = 0; r * G < 2 * R; ++r) {
        const int hu = r * G + (int)blockIdx.x;
        if (hu >= 2 * R) { idle(hu - 2 * R, (r + 1) * G - 2 * R); continue; }
        int mt, nt2; unit_tile(F * G + (hu >> 1), MT, 4, mt, nt2);
        const int nt = 2 * nt2 + (hu & 1);
        const bf16* arow[4];
#pragma unroll
        for (int i = 0; i < 4; ++i) arow[i] = A + (size_t)(mt * 256 + (otid() >> 3) + 64 * i) * lda;
        gemm_tile(arow, Wt + (size_t)nt * 128 * K, K, K, lds, [&](const f32x16 (&acc)[2][2], int wm, int wn, int lane) { stage_f32_128(acc, lds, wm, wn, lane); });
        __syncthreads();
        {
            const float* mv = modl + (size_t)mod_row<NB>(mt * 256) * 6144 + 2 * 1024 + nt * 128;
            const int t = otid(), piece = t & 31;
            const f32x4 m2 = *(const f32x4*)(mv + piece * 4);
#pragma unroll 4
            for (int it = 0; it < 16; ++it) { const int rl = it * 16 + (t >> 5), row = mt * 256 + rl;
                const f32x4 a = *(const LAS f32x4*)(lds + rl * CST_F32 + piece * 16);
                const size_t soff = (row < TL ? (size_t)row * D : (size_t)(row - TL) * D) + nt * 128 + piece * 4;
                f32x4 xv;
                if (XIN_BF) { const u32x2 t2 = *(const u32x2*)((const bf16*)(row < TL ? xl : xc) + soff); xv = (f32x4){bflo(t2[0]), bfhi(t2[0]), bflo(t2[1]), bfhi(t2[1])}; }
                else xv = *(const f32x4*)((row < TL ? xl : xc) + soff);
                u32x2 o2; o2[0] = pk2(xv[0] + m2[0] * a[0], xv[1] + m2[1] * a[1]); o2[1] = pk2(xv[2] + m2[2] * a[2], xv[3] + m2[3] * a[3]);
                *(u32x2*)(Xout + (size_t)row * D + nt * 128 + piece * 4) = o2; }
        }
        __syncthreads();
    }
}
template <bool UP> struct MoeSched {
    const bf16* Abuf; const bf16* W; const int* cnt; const int* list; int cap; const LAS int* pre; int ntile; int F;
    static constexpr int KK = UP ? 1024 : 512;
    __device__ __forceinline__ bool next(int i, g8::Unit& u) const { const int G = gridDim.x; if (i >= F) return false; const int ul = xcd_unit(i); if (ul >= ntile * 4) return false;
        const int t = ul >> 2, e = moe_find(pre, t), mt = t - pre[e]; u.pm = e; u.pn = ul & 3; u.i0 = cnt[e * 64] - mt * 256; u.p = list + (size_t)e * cap + mt * 256; return true; }
    __device__ __forceinline__ void src(const g8::Unit& u, const int (&R)[2], const int (&C)[2], unsigned (&oa)[2][2], const char*& abase, const char*& bbase) const {
        abase = (const char*)Abuf; bbase = (const char*)(W + (size_t)u.pm * 1024 * KK + (size_t)u.pn * 256 * KK);
#pragma unroll
        for (int h = 0; h < 2; ++h)
#pragma unroll
            for (int i = 0; i < 2; ++i) { const int r = 128 * h + R[i]; const int ent = u.p[r < u.i0 ? r : 0];
                oa[h][i] = (unsigned)((UP ? (ent >> 1) * 1024 : ent * 512) + C[i]) * 2u; } }
};
struct EpiMoeUp8 {
    static constexpr bool PERM = true;
    const float* route_w; bf16* ACT;
    __device__ __forceinline__ void operator()(const f32x4 (&acc)[2][2][4][2], const g8::Unit& u, int wr, int wc, int fr, int fq) const {
#pragma unroll
        for (int ai = 0; ai < 2; ++ai)
#pragma unroll
            for (int m = 0; m < 4; ++m) { const int r = ai * 128 + wr * 64 + m * 16 + fr;
                if (r < u.i0) { const int ent = u.p[r]; const float w = route_w[ent];
                    float v[8];
#pragma unroll
                    for (int n = 0; n < 2; ++n)
#pragma unroll
                        for (int j = 0; j < 4; ++j) v[4 * n + j] = siluf(acc[ai][0][m][n][j]) * acc[ai][1][m][n][j] * w;
                    u32x4 o; o[0] = pk2(v[0], v[1]); o[1] = pk2(v[2], v[3]); o[2] = pk2(v[4], v[5]); o[3] = pk2(v[6], v[7]);
                    *(u32x4*)(ACT + (size_t)ent * 512 + u.pn * 128 + wc * 32 + 8 * fq) = o; } }
    }
};
struct EpiMoeDown8 {
    static constexpr bool PERM = true;
    bf16* Y2;
    __device__ __forceinline__ void operator()(const f32x4 (&acc)[2][2][4][2], const g8::Unit& u, int wr, int wc, int fr, int fq) const {
#pragma unroll
        for (int ai = 0; ai < 2; ++ai)
#pragma unroll
            for (int m = 0; m < 4; ++m) { const int r = ai * 128 + wr * 64 + m * 16 + fr;
                if (r < u.i0) { bf16* rowp = Y2 + (size_t)u.p[r] * D + u.pn * 256 + wc * 32 + 8 * fq;
#pragma unroll
                    for (int bj = 0; bj < 2; ++bj) { const f32x4 v0 = acc[ai][bj][m][0], v1 = acc[ai][bj][m][1];
                        u32x4 o; o[0] = pk2(v0[0], v0[1]); o[1] = pk2(v0[2], v0[3]); o[2] = pk2(v1[0], v1[1]); o[3] = pk2(v1[2], v1[3]);
                        *(u32x4*)(rowp + bj * 128) = o; } } }
    }
};
struct BRowGU { int s; __device__ __forceinline__ int operator()(int r) const { return ((r >> 5) & 1) * 128 + 64 * s + (r >> 6) * 32 + (r & 31); } };

__device__ __forceinline__ void phase_moe_up8(const bf16* H2, const bf16* Wgu, const int* cnt, const int* list, int cap, const float* route_w, bf16* ACT, LAS unsigned char* lds) {
    LAS int* pre = (LAS int*)(lds + GEMM_LDS);
    const int ntile = moe_prefix(cnt, pre);
    const int G = gridDim.x, U = ntile * 4, F = U / G, R = U - F * G;
    if (F > 0) { MoeSched<true> S{H2, Wgu, cnt, list, cap, pre, ntile, F}; EpiMoeUp8 E{route_w, ACT}; g8::gemm_phase(lds, 1024, S, E); }
    for (int r = 0; r * G < 2 * R; ++r) {
        const int hu = r * G + (int)blockIdx.x; if (hu >= 2 * R) continue;
        const int ul = F * G + (hu >> 1), s = hu & 1, t = ul >> 2, pn = ul & 3, e = moe_find(pre, t), mt = t - pre[e], ce = cnt[e * 64];
        const int* le = list + (size_t)e * cap + mt * 256;
        const int nvalid = ce - mt * 256;
        const bf16* arow[4];
#pragma unroll
        for (int i = 0; i < 4; ++i) { const int rr = (otid() >> 3) + 64 * i; const int ent = le[rr < nvalid ? rr : 0]; arow[i] = H2 + (size_t)(ent >> 1) * D; }
        gemm_tile(arow, Wgu + (size_t)e * 1024 * 1024 + (size_t)pn * 256 * 1024, 1024, 1024, lds, [&](const f32x16 (&acc)[2][2], int wm, int wn, int lane) {
#pragma unroll
            for (int mi = 0; mi < 2; ++mi) { const int rr = wm * 64 + mi * 32 + (lane & 31);
                const float w = rr < nvalid ? route_w[le[rr]] : 0.f;
                LAS unsigned char* rp = lds + rr * CST_BF64 + (wn * 32 + 4 * (lane >> 5)) * 2;
#pragma unroll
                for (int g = 0; g < 4; ++g) { float v[4];
#pragma unroll
                    for (int j = 0; j < 4; ++j) v[j] = siluf(acc[mi][0][4 * g + j]) * acc[mi][1][4 * g + j] * w;
                    u32x2 o; o[0] = pk2(v[0], v[1]); o[1] = pk2(v[2], v[3]); *(LAS u32x2*)(rp + 8 * g * 2) = o; } }
        }, BRowGU{s});
        __syncthreads();
        flush_bf16_64(lds, [&](int rr) -> bf16* { return rr < nvalid ? ACT + (size_t)le[rr] * 512 + pn * 128 + 64 * s : nullptr; });
        __syncthreads();
    }
}
__device__ __forceinline__ void phase_moe_down8(const bf16* ACT, const bf16* Wd, const int* cnt, const int* list, int cap, bf16* Y2, LAS unsigned char* lds) {
    LAS int* pre = (LAS int*)(lds + GEMM_LDS);
    const int ntile = moe_prefix(cnt, pre);
    const int G = gridDim.x, U = ntile * 4, F = U / G, R = U - F * G;
    if (F > 0) { MoeSched<false> S{ACT, Wd, cnt, list, cap, pre, ntile, F}; EpiMoeDown8 E{Y2}; g8::gemm_phase(lds, 512, S, E); }
    for (int r = 0; r * G < 2 * R; ++r) {
        const int hu = r * G + (int)blockIdx.x; if (hu >= 2 * R) continue;
        const int ul = F * G + (hu >> 1), t = ul >> 2, nt = 2 * (ul & 3) + (hu & 1), e = moe_find(pre, t), mt = t - pre[e], ce = cnt[e * 64];
        const int* le = list + (size_t)e * cap + mt * 256;
        const int nvalid = ce - mt * 256;
        const bf16* arow[4];
#pragma unroll
        for (int i = 0; i < 4; ++i) { const int rr = (otid() >> 3) + 64 * i; const int ent = le[rr < nvalid ? rr : 0]; arow[i] = ACT + (size_t)ent * 512; }
        gemm_tile(arow, Wd + (size_t)e * 1024 * 512 + (size_t)nt * 128 * 512, 512, 512, lds, [&](const f32x16 (&acc)[2][2], int wm, int wn, int lane) { stage_bf16_128(acc, lds, wm, wn, lane); });
        __syncthreads();
        flush_bf16_128(lds, [&](int rr) -> bf16* { return rr < nvalid ? Y2 + (size_t)le[rr] * D + nt * 128 : nullptr; });
        __syncthreads();
    }
}
struct EpiQKV8 {
    static constexpr bool PERM = true;
    const float* qn; const float* kn; bf16* QKV; LAS float* xbuf;
    __device__ __forceinline__ void operator()(const f32x4 (&acc)[2][2][4][2], const g8::Unit& u, int wr, int wc, int fr, int fq) const {
        const int which = u.pn >> 2, wid = wr * 4 + wc;
        float rs[2][4][2];
        if (which < 2) {
#pragma unroll
            for (int ai = 0; ai < 2; ++ai)
#pragma unroll
                for (int m = 0; m < 4; ++m)
#pragma unroll
                    for (int bj = 0; bj < 2; ++bj) { float ss = 0.f;
#pragma unroll
                        for (int n = 0; n < 2; ++n)
#pragma unroll
                            for (int j = 0; j < 4; ++j) ss += acc[ai][bj][m][n][j] * acc[ai][bj][m][n][j];
                        ss += __shfl_xor(ss, 16); ss += __shfl_xor(ss, 32);
                        rs[ai][m][bj] = ss;
                        if (fq == 0) xbuf[(wid * 16 + (ai * 4 + m) * 2 + bj) * 16 + fr] = ss; }
        }
        asm volatile("s_waitcnt lgkmcnt(0)" ::: "memory");
        __builtin_amdgcn_s_barrier();
        asm volatile("" ::: "memory");
        const float* nwp = which == 0 ? qn : kn;
        const int hc = (wc & 1) * 32 + 8 * fq;
#pragma unroll
        for (int ai = 0; ai < 2; ++ai)
#pragma unroll
            for (int m = 0; m < 4; ++m) { const int row = u.pm * 256 + ai * 128 + wr * 64 + m * 16 + fr;
                bf16* rowp = QKV + (size_t)row * 3072 + u.pn * 256 + wc * 32 + 8 * fq;
#pragma unroll
                for (int bj = 0; bj < 2; ++bj) { f32x4 v0 = acc[ai][bj][m][0], v1 = acc[ai][bj][m][1];
                    if (which < 2) {
                        const float tot = rs[ai][m][bj] + xbuf[((wid ^ 1) * 16 + (ai * 4 + m) * 2 + bj) * 16 + fr];
                        const float sc = rsqrtf(tot * (1.f / 64.f) + 1e-6f) * (which == 0 ? 0.125f : 1.f);
                        const f32x4 w0 = *(const f32x4*)(nwp + hc), w1 = *(const f32x4*)(nwp + hc + 4);
#pragma unroll
                        for (int j = 0; j < 4; ++j) { v0[j] *= sc * w0[j]; v1[j] *= sc * w1[j]; } }
                    u32x4 o; o[0] = pk2(v0[0], v0[1]); o[1] = pk2(v0[2], v0[3]); o[2] = pk2(v1[0], v1[1]); o[3] = pk2(v1[2], v1[3]);
                    *(u32x4*)(rowp + bj * 128) = o; } }
    }
};
template <int NB>
__device__ __forceinline__ void phase_qkv8(const bf16* H, const bf16* Wt, const float* qn, const float* kn, bf16* QKV, LAS unsigned char* lds) {
    constexpr int T = NB * (SEQ + CTXL), MT = T / 256, U = MT * 12;
    const int G = gridDim.x, F = U / G, R = U - F * G;
    if (F > 0) { g8::DenseSched S{H, D, Wt, D, MT, 12, F}; EpiQKV8 E{qn, kn, QKV, (LAS float*)(lds + g8::STAGE_BYTES)}; g8::gemm_phase(lds, D, S, E); }
    for (int r = 0; r * G < 2 * R; ++r) {
        const int hu = r * G + (int)blockIdx.x; if (hu >= 2 * R) continue;
        int mt, nt2; unit_tile(F * G + (hu >> 1), MT, 12, mt, nt2);
        const int nt = 2 * nt2 + (hu & 1);
        const bf16* arow[4];
#pragma unroll
        for (int i = 0; i < 4; ++i) arow[i] = H + (size_t)(mt * 256 + (otid() >> 3) + 64 * i) * D;
        gemm_tile(arow, Wt + (size_t)nt * 128 * D, D, D, lds, [&](const f32x16 (&acc)[2][2], int wm, int wn, int lane) {
            const int which = nt >> 3;
#pragma unroll
            for (int mi = 0; mi < 2; ++mi) {
                float rsv = 1.f;
                if (which < 2) { float ss = 0.f;
#pragma unroll
                    for (int ni = 0; ni < 2; ++ni)
#pragma unroll
                        for (int q = 0; q < 16; ++q) ss += acc[mi][ni][q] * acc[mi][ni][q];
                    ss += __shfl_xor(ss, 32);
                    rsv = rsqrtf(ss * (1.f / 64.f) + 1e-6f) * (which == 0 ? 0.125f : 1.f); }
                const float* nwp = which == 0 ? qn : kn;
                LAS unsigned char* rp = lds + (wm * 64 + mi * 32 + (lane & 31)) * CST_BF + (wn * 64 + 4 * (lane >> 5)) * 2;
#pragma unroll
                for (int ni = 0; ni < 2; ++ni)
#pragma unroll
                    for (int g = 0; g < 4; ++g) { float v[4];
#pragma unroll
                        for (int j = 0; j < 4; ++j) { v[j] = acc[mi][ni][4 * g + j]; if (which < 2) v[j] *= rsv * nwp[ni * 32 + 8 * g + 4 * (lane >> 5) + j]; }
                        u32x2 o; o[0] = pk2(v[0], v[1]); o[1] = pk2(v[2], v[3]); *(LAS u32x2*)(rp + (ni * 32 + 8 * g) * 2) = o; } }
        });
        __syncthreads();
        flush_bf16_128(lds, [&](int rr) { return QKV + (size_t)(mt * 256 + rr) * 3072 + nt * 128; });
        __syncthreads();
    }
}
}
#define XB_TMO      128
#define XB_XCNT(j)  (256  + 64 * (j))
#define XB_XSUB(j)  (1280 + 64 * (j))
#define XB_XGEN(j)  (2304 + 64 * (j))
#define XB_TOP      3328
#define XB_TOPGEN   3392
#define XCD_BAR_WORDS 3456
#define XB_SPIN_CAP (1u << 18)

__device__ __forceinline__ unsigned xb_ld(unsigned* p)              { return __hip_atomic_load(p, __ATOMIC_RELAXED, __HIP_MEMORY_SCOPE_AGENT); }
__device__ __forceinline__ unsigned xb_add(unsigned* p, unsigned v) { return __hip_atomic_fetch_add(p, v, __ATOMIC_RELAXED, __HIP_MEMORY_SCOPE_AGENT); }
__device__ __forceinline__ unsigned xb_xcc_id() { return (unsigned)__builtin_amdgcn_s_getreg((3 << 11) | 20) & 0xFu; }
#define XB_SPIN(cond, bar) do { unsigned _sp = 0; while (cond) { __builtin_amdgcn_s_sleep(1); \
    if ((++_sp & 255u) == 0u) { if (xb_ld(&(bar)[XB_TMO])) break; if (_sp > XB_SPIN_CAP) { atomicAdd(&(bar)[XB_TMO], 1u); break; } } } } while (0)

struct XcdBarrier {
    unsigned* bar; unsigned x;
    volatile LAS unsigned* st;
};

__device__ __forceinline__ XcdBarrier xcd_barrier_post(unsigned* bar, volatile LAS unsigned* st) {
    XcdBarrier b; b.bar = bar; b.x = xb_xcc_id(); b.st = st;
    if (threadIdx.x == 0) (void)xb_add(&bar[XB_XCNT(b.x)], 1u);
    return b;
}
__device__ __forceinline__ void xcd_barrier_complete(unsigned* bar, unsigned x, unsigned& nloc, unsigned& nx) {
    const unsigned G = gridDim.x * gridDim.y * gridDim.z;
    unsigned sum, cnt, mine, sp = 0u;
    for (;;) {
        sum = 0u; cnt = 0u; mine = 0u;
#pragma unroll
        for (unsigned j = 0; j < 16; ++j) { const unsigned c = xb_ld(&bar[XB_XCNT(j)]); sum += c; cnt += (c > 0u) ? 1u : 0u; mine = (j == x) ? c : mine; }
        if (sum == G) break;
        __builtin_amdgcn_s_sleep(1);
        if ((++sp & 255u) == 0u) { if (xb_ld(&bar[XB_TMO])) break; if (sp > XB_SPIN_CAP) { atomicAdd(&bar[XB_TMO], 1u); break; } }
    }
    nloc = mine > 0u ? mine : 1u; nx = cnt > 0u ? cnt : 1u;
}

__device__ __forceinline__ void xcd_barrier(const XcdBarrier& b) {
    asm volatile("s_waitcnt vmcnt(0)" ::: "memory");
    __syncthreads();
    if (threadIdx.x == 0) {
        unsigned* bar = b.bar;
        __builtin_amdgcn_s_waitcnt(0);
        unsigned nloc = b.st[0], nx = b.st[1];
        if (nloc == 0u) { xcd_barrier_complete(bar, b.x, nloc, nx); b.st[0] = nloc; b.st[1] = nx; }
        const unsigned old = xb_add(&bar[XB_XSUB(b.x)], 1u);
        const unsigned gen = old / nloc;
        if (old + 1u == (gen + 1u) * nloc) {
            __builtin_amdgcn_fence(__ATOMIC_RELEASE, "agent");
            asm volatile("s_waitcnt vmcnt(0)" ::: "memory");
            const unsigned og = xb_add(&bar[XB_TOP], 1u);
            const unsigned tg = og / nx;
            if (og + 1u == (tg + 1u) * nx) xb_add(&bar[XB_TOPGEN], 1u);
            else XB_SPIN(xb_ld(&bar[XB_TOPGEN]) == tg, bar);
            __builtin_amdgcn_fence(__ATOMIC_ACQUIRE, "agent");
            xb_add(&bar[XB_XGEN(b.x)], 1u);
            asm volatile("s_waitcnt vmcnt(0)" ::: "memory");
        } else {
            XB_SPIN(xb_ld(&bar[XB_XGEN(b.x)]) == gen, bar);
            __builtin_amdgcn_fence(__ATOMIC_ACQUIRE, "agent");
            asm volatile("s_waitcnt vmcnt(0)" ::: "memory");
        }
    }
    __syncthreads();
}
namespace mk {
using namespace fx;
constexpr int NB = 4;
typedef Plan<NB> PL;

__global__ void __launch_bounds__(512, 2) k_mega(P p) {
    extern __shared__ __attribute__((aligned(16))) unsigned char lds_raw[];
    LAS unsigned char* lds = (LAS unsigned char*)lds_raw;
    unsigned char* ws = p.ws;
    const In& in = p.in;
    LAS unsigned* xbw = (LAS unsigned*)(lds + LDS_BYTES - 16);
    if (threadIdx.x == 0) { xbw[0] = 0u; xbw[1] = 0u; xbw[2] = 0u; xbw[3] = 0u; }
    __syncthreads();
    XcdBarrier bar = xcd_barrier_post((unsigned*)(ws + PL::CTL_BAR), (volatile LAS unsigned*)xbw);
    float* modv = (float*)(ws + PL::MODV);
    const float* mod0 = modv; const float* mod1 = modv + 5 * 6144;
    bf16* H = (bf16*)(ws + PL::H);
    int* cnt0 = (int*)(ws + PL::CTL_CNT); int* cnt1 = cnt0 + 32 * 64;
    int* list = (int*)(ws + PL::LIST); float* rw = (float*)(ws + PL::RW);
    bf16* wmoe0 = (bf16*)(ws + PL::W_MOE0); bf16* wmoe1 = (bf16*)(ws + PL::W_MOE1);
    const size_t GU = (size_t)32 * 1024 * 1024;
    float* X1 = (float*)(ws + PL::X1); float* X2 = (float*)(ws + PL::X2); float* X3 = (float*)(ws + PL::X3);
    const float* X1c = (const float*)((const bf16*)X1 + PL::TL * D); const float* X2c = (const float*)((const bf16*)X2 + PL::TL * D);
#ifndef MOE1_EARLY
#define MOE1_EARLY 1792
#endif
#ifndef REPMASK
#define REPMASK 0
#endif
#ifndef XBAR
#define XBAR 0
#endif
#define PH(k, ...) { __VA_ARGS__; xcd_barrier(bar); if ((REPMASK >> (k)) & 1) { __VA_ARGS__; xcd_barrier(bar); } }
    PH(0, conv_small_weights(in, ws, PL::W_IN, PL::W_OUT, PL::W_QKV, PL::W_NAO, lds); mod_vectors(in, modv, lds); conv_moe_weights(in, 0, wmoe0, wmoe0 + GU, lds))
    for (int i = 0; i < XBAR; ++i) xcd_barrier(bar);
    PH(1, rows_phase<NB, false, false, true, false>(in.x, in.ctx, PL::T, nullptr, mod0, mod0, nullptr, nullptr, in.norm1_w, 0, 1, H,
                                              nullptr, nullptr, nullptr, nullptr, nullptr, nullptr, nullptr, 0, lds))
    phase_inproj8<NB>(H, (const bf16*)(ws + PL::W_IN), (bf16*)(ws + PL::PROJ), (float*)(ws + PL::GATES), lds);
    xcd_barrier(bar);
#ifdef GVAR
    phase_inproj_v<NB, GVAR>(H, (const bf16*)(ws + PL::W_IN), (bf16*)(ws + PL::PROJ), (float*)(ws + PL::GATES), lds, p.out == nullptr);
    xcd_barrier(bar);
#endif
    PH(3, phase_tables<NB>(in, (const float*)(ws + PL::GATES), ws + PL::H, lds); phase_conv<NB>((const bf16*)(ws + PL::PROJ), in.ab_conv_w, in.ab_conv_b, (bf16*)(ws + PL::XBC)))
    phase_scan<NB>((const bf16*)(ws + PL::PROJ), ws + PL::H, (const bf16*)(ws + PL::XBC), (bf16*)(ws + PL::SC), lds);
    xcd_barrier(bar);
#ifdef SCANMODE
    phase_scan<NB>((const bf16*)(ws + PL::PROJ), ws + PL::H, (const bf16*)(ws + PL::XBC), (bf16*)(ws + PL::SC), lds, p.out ? SCANMODE : 3);
    xcd_barrier(bar);
#endif
#ifdef REP5
    phase_mixer_out<NB>(in, (const bf16*)(ws + PL::PROJ), (const bf16*)(ws + PL::XBC), (bf16*)(ws + PL::SC), (bf16*)(ws + PL::W_MOE1));
    xcd_barrier(bar);
#endif
    phase_mixer_out<NB>(in, (const bf16*)(ws + PL::PROJ), (const bf16*)(ws + PL::XBC), (bf16*)(ws + PL::SC));
    xcd_barrier(bar);
    PH(6, phase_outproj8<NB, false>((const bf16*)(ws + PL::SC), 4096, 2048, (const bf16*)(ws + PL::W_OUT), PL::T, in.x, in.ctx, mod0, (bf16*)X1, lds,
        [&](int rank, int nidle) { conv_moe_weights(in, 1, wmoe1, wmoe1 + GU, lds, 0, MOE1_EARLY, rank, nidle); }))
    rows_phase<NB, false, false, true, true, true>(X1, X1c, PL::T, nullptr, mod0, mod0, nullptr, nullptr, in.norm2_w, 3, 4, H,
        in.moe_w_group, in.moe_b_group, in.moe_w_expert, in.moe_b_expert, rw, cnt0, list, (int)PL::T, lds);
    PH(7, conv_moe_weights(in, 1, wmoe1, wmoe1 + GU, lds, MOE1_EARLY, MOE_CONV_UNITS))
    PH(8, phase_moe_up8(H, wmoe0, cnt0, list, (int)PL::T, rw, (bf16*)(ws + PL::ACT), lds))
    PH(9, phase_moe_down8((const bf16*)(ws + PL::ACT), wmoe0 + GU, cnt0, list, (int)PL::T, (bf16*)(ws + PL::Y2), lds))
    PH(10, rows_phase<NB, true, true, true, false, true>(X1, X1c, PL::T, (const bf16*)(ws + PL::Y2), mod0, mod1, X2, nullptr, in.norm1_w + 1024, 0, 1, H,
        nullptr, nullptr, nullptr, nullptr, nullptr, nullptr, nullptr, 0, lds))
    PH(11, phase_qkv8<NB>(H, (const bf16*)(ws + PL::W_QKV), in.na_q_norm, in.na_k_norm, (bf16*)(ws + PL::QKV), lds))
    PH(12, phase_attn<NB>((const bf16*)(ws + PL::QKV), in.na_rpb, (bf16*)(ws + PL::AO), lds))
    PH(13, phase_outproj8<NB, true>((const bf16*)(ws + PL::AO), 1024, 1024, (const bf16*)(ws + PL::W_NAO), PL::TL, X2, X2c, mod1, (bf16*)X3, lds, [](int, int) {}))
    rows_phase<NB, false, false, true, true, true>(X3, X3, PL::TL, nullptr, mod1, mod1, nullptr, nullptr, in.norm2_w + 1024, 3, 4, H,
        in.moe_w_group + 1024 * 4, in.moe_b_group + 4, in.moe_w_expert + 1024 * 32, in.moe_b_expert + 32, rw, cnt1, list, (int)PL::T, lds);
    xcd_barrier(bar);
    PH(15, phase_moe_up8(H, wmoe1, cnt1, list, (int)PL::T, rw, (bf16*)(ws + PL::ACT), lds))
    PH(16, phase_moe_down8((const bf16*)(ws + PL::ACT), wmoe1 + GU, cnt1, list, (int)PL::T, (bf16*)(ws + PL::Y2), lds))
    rows_phase<NB, true, false, false, false, true>(X3, X3, PL::TL, (const bf16*)(ws + PL::Y2), mod1, mod1, nullptr, p.out, nullptr, 0, 0, nullptr,
        nullptr, nullptr, nullptr, nullptr, nullptr, nullptr, nullptr, 0, lds);
    if ((REPMASK >> 17) & 1) { xcd_barrier(bar); rows_phase<NB, true, false, false, false, true>(X3, X3, PL::TL, (const bf16*)(ws + PL::Y2), mod1, mod1, nullptr, p.out, nullptr, 0, 0, nullptr,
        nullptr, nullptr, nullptr, nullptr, nullptr, nullptr, nullptr, 0, lds); }
#undef PH
}
__global__ void k_fill(float* q, size_t n, float v) { size_t i = (size_t)blockIdx.x * 256 + threadIdx.x; if (i < n) q[i] = v; }
}

extern "C" void kernel_launch(void* const* d_in, const int* in_sizes, int n_in, void* d_out, int out_size, void* d_ws, size_t ws_size, hipStream_t stream) {
    static int grid = 0;
    if (grid == 0) {
        int dev = 0, cus = 0, per_cu = 0;
        (void)hipGetDevice(&dev);
        (void)hipDeviceGetAttribute(&cus, hipDeviceAttributeMultiprocessorCount, dev);
        if (hipFuncSetAttribute((const void*)mk::k_mega, hipFuncAttributeMaxDynamicSharedMemorySize, fx::LDS_BYTES) != hipSuccess) { grid = -1; }
        else {
            if (hipOccupancyMaxActiveBlocksPerMultiprocessor(&per_cu, (const void*)mk::k_mega, 512, fx::LDS_BYTES) != hipSuccess) per_cu = 0;
            (void)hipGetLastError();
            grid = per_cu >= 1 ? cus : -1;
        }
    }
    if (grid < 0 || n_in != 31 || mk::PL::END > ws_size) { mk::k_fill<<<(out_size + 255) / 256, 256, 0, stream>>>((float*)d_out, (size_t)out_size, 2.f); return; }
    (void)hipMemsetAsync((unsigned char*)d_ws + mk::PL::CTL, 0, mk::PL::CTL_BYTES, stream);
    fx::P fp;
    { const float** q = (const float**)&fp.in; for (int i = 0; i < 31; ++i) q[i] = (const float*)d_in[i]; }
    fp.ws = (unsigned char*)d_ws; fp.out = (float*)d_out;
    hipLaunchKernelGGL(mk::k_mega, dim3(grid), dim3(512), fx::LDS_BYTES, stream, fp);
}
```

```cpp
#include <hip/hip_runtime.h>
#include <cstdio>
#include <cstdint>
namespace fx {
#define LAS __attribute__((address_space(3)))
typedef unsigned short bf16;
typedef short bf16x8 __attribute__((ext_vector_type(8)));
typedef short bf16x4 __attribute__((ext_vector_type(4)));
typedef float f32x16 __attribute__((ext_vector_type(16)));
typedef float f32x4 __attribute__((ext_vector_type(4)));
typedef unsigned u32x4 __attribute__((ext_vector_type(4)));
typedef unsigned u32x2 __attribute__((ext_vector_type(2)));
constexpr int NTHR = 512, NWAVE = 8;
constexpr int D = 1024, SEQ = 4096, CTXL = 256;
constexpr int PROJW = 5632, NIN = 5760;
constexpr int PC_Z = 0, PC_XBC = 1024, PC_Q = 2560, PC_K = 3072, PC_V = 3584, PC_O = 4608;
constexpr int LDS_BYTES = 152 * 1024;

__device__ __forceinline__ int otid() { int t = threadIdx.x; asm volatile("" : "+v"(t)); return t; }
__device__ __forceinline__ float bf2f(bf16 v) { return __uint_as_float((unsigned)v << 16); }
__device__ __forceinline__ float bflo(unsigned u) { return __uint_as_float(u << 16); }
__device__ __forceinline__ float bfhi(unsigned u) { return __uint_as_float(u & 0xffff0000u); }
typedef __bf16 bf16x2_t __attribute__((ext_vector_type(2)));
typedef float f32x2_t __attribute__((ext_vector_type(2)));
__device__ __forceinline__ unsigned pk2(float lo, float hi) { const f32x2_t v = {lo, hi}; return __builtin_bit_cast(unsigned, __builtin_convertvector(v, bf16x2_t)); }
__device__ __forceinline__ float siluf(float v) { return v / (1.f + __expf(-v)); }
__device__ __forceinline__ float sigmf(float v) { return 1.f / (1.f + __expf(-v)); }
__device__ __forceinline__ float softplusf(float v) { return v > 20.f ? v : log1pf(__expf(v)); }
__device__ __forceinline__ float logsigf(float v) { return fminf(v, 0.f) - log1pf(__expf(-fabsf(v))); }
__device__ __forceinline__ float wave_sum(float v) {
#pragma unroll
    for (int o = 32; o > 0; o >>= 1) v += __shfl_xor(v, o);
    return v;
}
__device__ __forceinline__ float wave_max(float v) {
#pragma unroll
    for (int o = 32; o > 0; o >>= 1) v = fmaxf(v, __shfl_xor(v, o));
    return v;
}
__device__ __forceinline__ float rdlane(float v, int l) { return __int_as_float(__builtin_amdgcn_readlane(__float_as_int(v), l)); }
__device__ __forceinline__ void wave_sum4(float (&a)[4], int lane) {
    const bool h5 = (lane & 32) != 0, h4 = (lane & 16) != 0;
    float b0, b1;
    { const float s0 = h5 ? a[0] : a[2], s1 = h5 ? a[1] : a[3]; const float r0 = __shfl_xor(s0, 32), r1 = __shfl_xor(s1, 32);
      b0 = (h5 ? a[2] : a[0]) + r0; b1 = (h5 ? a[3] : a[1]) + r1; }
    float c = (h4 ? b1 : b0) + __shfl_xor(h4 ? b0 : b1, 16);
#pragma unroll
    for (int o = 8; o > 0; o >>= 1) c += __shfl_xor(c, o);
    a[0] = rdlane(c, 0); a[1] = rdlane(c, 16); a[2] = rdlane(c, 32); a[3] = rdlane(c, 48);
}
__device__ __forceinline__ void wave_sum8(float (&a)[8], int lane) {
    const bool h5 = (lane & 32) != 0, h4 = (lane & 16) != 0, h3 = (lane & 8) != 0;
    float b[4];
#pragma unroll
    for (int k = 0; k < 4; ++k) { const float snd = h5 ? a[k] : a[k + 4]; b[k] = (h5 ? a[k + 4] : a[k]) + __shfl_xor(snd, 32); }
    float c[2];
#pragma unroll
    for (int k = 0; k < 2; ++k) { const float snd = h4 ? b[k] : b[k + 2]; c[k] = (h4 ? b[k + 2] : b[k]) + __shfl_xor(snd, 16); }
    float d = (h3 ? c[1] : c[0]) + __shfl_xor(h3 ? c[0] : c[1], 8);
#pragma unroll
    for (int o = 4; o > 0; o >>= 1) d += __shfl_xor(d, o);
#pragma unroll
    for (int k = 0; k < 8; ++k) a[k] = rdlane(d, 8 * k);
}
__device__ __forceinline__ f32x16 mfma32(bf16x8 a, bf16x8 b, f32x16 c) { return __builtin_amdgcn_mfma_f32_32x32x16_bf16(a, b, c, 0, 0, 0); }
__device__ __forceinline__ f32x4 mfma16(bf16x8 a, bf16x8 b, f32x4 c) { return __builtin_amdgcn_mfma_f32_16x16x32_bf16(a, b, c, 0, 0, 0); }

__device__ __forceinline__ bf16x8 frag_row(const LAS unsigned char* T, int RS, int r0, int k0, int lane) {
    return *(const LAS bf16x8*)(T + (r0 + (lane & 31)) * RS + (k0 + 8 * (lane >> 5)) * 2);
}
__device__ __forceinline__ bf16x8 frag_col(const LAS unsigned char* T, int RS, int k0, int c0, int lane) {
    const int h = lane >> 5, blk = (lane >> 4) & 1, q = (lane & 15) >> 2, p = lane & 3;
    const unsigned a0 = (unsigned)(size_t)(T + (k0 + 8 * h + q) * RS + (c0 + 16 * blk + 4 * p) * 2);
    const unsigned a1 = a0 + 4 * RS;
    bf16x4 v0, v1;
    asm volatile("ds_read_b64_tr_b16 %0, %2\n\tds_read_b64_tr_b16 %1, %3\n\ts_waitcnt lgkmcnt(0)" : "=&v"(v0), "=&v"(v1) : "v"(a0), "v"(a1) : "memory");
    bf16x8 r; r[0] = v0[0]; r[1] = v0[1]; r[2] = v0[2]; r[3] = v0[3]; r[4] = v1[0]; r[5] = v1[1]; r[6] = v1[2]; r[7] = v1[3];
    return r;
}

struct In {
    const float *x, *c, *ctx, *c_ctx, *norm1_w, *norm2_w, *mod_w, *mod_b, *ab_w_in, *ab_conv_w, *ab_conv_b, *ssd_a_log, *ssd_dt_bias, *ssd_d,
        *ssd_norm_w, *ml_i_bias, *ml_f_bias, *ml_norm_w, *ab_w_out, *na_w_qkv, *na_q_norm, *na_k_norm, *na_rpb, *na_w_out,
        *moe_w_group, *moe_b_group, *moe_w_expert, *moe_b_expert, *moe_w_gate, *moe_w_up, *moe_w_down;
};

constexpr size_t cmax(size_t a, size_t b) { return a > b ? a : b; }
constexpr size_t al256(size_t x) { return (x + 255) & ~(size_t)255; }

template <int NB> struct Plan {
    static constexpr size_t TL = (size_t)NB * SEQ, TC = (size_t)NB * CTXL, T = TL + TC;
    static constexpr size_t CTL = 0;
    static constexpr size_t CTL_BAR = 0, CTL_CNT = 16384  , CTL_BYTES = 32768;
    static constexpr size_t MODV = CTL + CTL_BYTES;
    static constexpr size_t RW = MODV + al256(2 * 5 * 6144 * 4);
    static constexpr size_t LIST = RW + al256(2 * T * 4);
    static constexpr size_t W_IN = LIST + al256(32 * T * 4);
    static constexpr size_t W_OUT = W_IN + (size_t)NIN * 1024 * 2;
    static constexpr size_t W_QKV = W_OUT + (size_t)1024 * 2048 * 2;
    static constexpr size_t W_NAO = W_QKV + (size_t)3072 * 1024 * 2;
    static constexpr size_t ARENA = W_NAO + (size_t)1024 * 1024 * 2;
    static constexpr size_t MOEW = (size_t)32 * 1024 * 1024 * 2 + (size_t)32 * 1024 * 512 * 2;
    static constexpr size_t SZ_B = al256(T * 1024 * 2);
    static constexpr size_t SZ_A = al256(cmax(MOEW, cmax(T * 3072 * 2, T * 1024 * 4)));
    static constexpr size_t SZ_X = al256(T * 1024 * 4);
    static constexpr size_t SZ_C = al256(cmax(T * PROJW * 2 + T * 64 * 4, SZ_X + MOEW));
    static constexpr size_t SZ_D = al256(T * 1536 * 2);
    static constexpr size_t SZ_E = al256(T * 4096 * 2);
    static constexpr size_t RB = ARENA, RA = RB + SZ_B, RC = RA + SZ_A, RD = RC + SZ_C, RE = RD + SZ_D, END = RE + SZ_E;
    static constexpr size_t H = RB;
    static constexpr size_t W_MOE0 = RA;
    static constexpr size_t QKV = RA;
    static constexpr size_t X3 = RA;
    static constexpr size_t PROJ = RC;
    static constexpr size_t GATES = RC + T * PROJW * 2;
    static constexpr size_t X1 = RC;
    static constexpr size_t W_MOE1 = RC + SZ_X;
    static constexpr size_t XBC = RD;
    static constexpr size_t ACT = RD;
    static constexpr size_t AO = RD;
    static constexpr size_t SC = RE;
    static constexpr size_t Y2 = RE;
    static constexpr size_t X2 = RE + al256(2 * T * 1024 * 2);
    static_assert(2 * T * 1024 * 2 + T * 1024 * 4 <= SZ_E, "E");
    static_assert(T * 3072 * 2 <= SZ_A + SZ_X, "QKV spill");
};

struct P { In in; unsigned char* ws; float* out; };

template <int NB> __device__ __forceinline__ int mod_row(int row) { return row < NB * SEQ ? row / SEQ : 4; }

template <class ColPtr>
__device__ __forceinline__ void tconv_unit(ColPtr colptr, int ld_src, bf16* dst, int K, int k0, int n0, int ndst, LAS unsigned char* lds) {
    LAS float* tl = (LAS float*)lds;
    const int tid = otid();
    {
        const int n4 = (tid & 63) * 4, kb = tid >> 6;
        const float* sp = colptr(n0 + n4);
        f32x4 v[8];
#pragma unroll
        for (int i = 0; i < 8; ++i) v[i] = sp ? *(const f32x4*)(sp + (size_t)(k0 + kb + 8 * i) * ld_src) : (f32x4){0.f, 0.f, 0.f, 0.f};
#pragma unroll
        for (int i = 0; i < 8; ++i) *(LAS f32x4*)(tl + (kb + 8 * i) * 260 + n4) = v[i];
    }
    __syncthreads();
    {
        const int n = tid >> 1, half = tid & 1;
        if (n0 + n < ndst) {
            float v[32];
#pragma unroll
            for (int j = 0; j < 32; ++j) v[j] = tl[(half * 32 + j) * 260 + n];
            bf16* dp = dst + (size_t)(n0 + n) * K + k0 + half * 32;
#pragma unroll
            for (int q = 0; q < 4; ++q) { u32x4 o; o[0] = pk2(v[8 * q], v[8 * q + 1]); o[1] = pk2(v[8 * q + 2], v[8 * q + 3]); o[2] = pk2(v[8 * q + 4], v[8 * q + 5]); o[3] = pk2(v[8 * q + 6], v[8 * q + 7]);
                *(u32x4*)(dp + 8 * q) = o; }
        }
    }
    __syncthreads();
}

__device__ __forceinline__ int map_in(int n) { return n < 2560 ? n : (n < 5632 ? n + 32 : (n < 5664 ? n - 3072 : (n < 5680 ? n : -1))); }

__device__ __forceinline__ void conv_small_weights(const In& in, unsigned char* ws, size_t o_in, size_t o_out, size_t o_qkv, size_t o_nao, LAS unsigned char* lds) {
    const int total = 368 + 128 + 192 + 64;
    for (int u = blockIdx.x; u < total; u += gridDim.x) {
        if (u < 368) { const int kt = u % 16, nt = u / 16; const float* w = in.ab_w_in;
            tconv_unit([&](int n) -> const float* { const int c = n < NIN ? map_in(n) : -1; return c >= 0 ? w + c : nullptr; }, 5680, (bf16*)(ws + o_in), 1024, kt * 64, nt * 256, NIN, lds); }
        else if (u < 496) { const int v = u - 368, kt = v % 32, nt = v / 32; const float* w = in.ab_w_out;
            tconv_unit([&](int n) { return w + n; }, 1024, (bf16*)(ws + o_out), 2048, kt * 64, nt * 256, 1024, lds); }
        else if (u < 688) { const int v = u - 496, kt = v % 16, nt = v / 16; const float* w = in.na_w_qkv;
            tconv_unit([&](int n) { return w + n; }, 3072, (bf16*)(ws + o_qkv), 1024, kt * 64, nt * 256, 3072, lds); }
        else { const int v = u - 688, kt = v % 16, nt = v / 16; const float* w = in.na_w_out;
            tconv_unit([&](int n) { return w + n; }, 1024, (bf16*)(ws + o_nao), 1024, kt * 64, nt * 256, 1024, lds); }
    }
}

constexpr int MOE_CONV_UNITS = 3072;
__device__ __forceinline__ void conv_moe_weights(const In& in, int layer, bf16* wgu, bf16* wd, LAS unsigned char* lds, int begin = 0, int end = MOE_CONV_UNITS, int rank = -1, int stride = 0) {
    if (rank < 0) { rank = blockIdx.x; stride = gridDim.x; }
    const size_t wsz = (size_t)1024 * 512;
    for (int u = begin + rank; u < end; u += stride) {
        if (u < 2048) {
            const int e = u >> 6, v = u & 63, kt = v & 15, nt = v >> 4;
            const float* g = in.moe_w_gate + ((size_t)layer * 32 + e) * wsz; const float* up = in.moe_w_up + ((size_t)layer * 32 + e) * wsz;
            tconv_unit([&](int n) { const int f = (n >> 8) * 128 + (n & 127); return ((n & 128) ? up : g) + f; }, 512, wgu + (size_t)e * 1024 * 1024, 1024, kt * 64, nt * 256, 1024, lds);
        } else {
            const int w = u - 2048, e = w >> 5, v = w & 31, kt = v & 7, nt = v >> 3;
            const float* dsrc = in.moe_w_down + ((size_t)layer * 32 + e) * wsz;
            tconv_unit([&](int n) { return dsrc + n; }, 1024, wd + (size_t)e * 1024 * 512, 512, kt * 64, nt * 256, 1024, lds);
        }
    }
}

__device__ __forceinline__ void mod_vectors(const In& in, float* modv, LAS unsigned char* lds) {
    LAS float* sc = (LAS float*)lds;
    LAS float* red = sc + 5 * 1024;
    const int tid = otid();
    for (int i = tid; i < 5 * 1024; i += NTHR) { const int r = i >> 10, k = i & 1023; const float v = r < 4 ? in.c[r * 1024 + k] : in.c_ctx[k]; sc[i] = siluf(v); }
    __syncthreads();
    const int col = tid & 31, kq = tid >> 5;
    for (int u = blockIdx.x; u < 2 * 192; u += gridDim.x) {
        const int layer = u / 192, c0 = (u % 192) * 32;
        const float* w = in.mod_w + (size_t)layer * 1024 * 6144 + c0 + col;
        float a0 = 0.f, a1 = 0.f, a2 = 0.f, a3 = 0.f, a4 = 0.f;
#pragma unroll 8
        for (int j = 0; j < 64; ++j) { const int k = kq + 16 * j; const float wv = w[(size_t)k * 6144];
            a0 += sc[k] * wv; a1 += sc[1024 + k] * wv; a2 += sc[2048 + k] * wv; a3 += sc[3072 + k] * wv; a4 += sc[4096 + k] * wv; }
        red[(0 * 16 + kq) * 32 + col] = a0; red[(1 * 16 + kq) * 32 + col] = a1; red[(2 * 16 + kq) * 32 + col] = a2;
        red[(3 * 16 + kq) * 32 + col] = a3; red[(4 * 16 + kq) * 32 + col] = a4;
        __syncthreads();
        if (tid < 160) { const int r = tid >> 5, cc = tid & 31; float s = 0.f;
#pragma unroll
            for (int q = 0; q < 16; ++q) s += red[(r * 16 + q) * 32 + cc];
            modv[((size_t)layer * 5 + r) * 6144 + c0 + cc] = s + in.mod_b[layer * 6144 + c0 + cc]; }
        __syncthreads();
    }
}

template <int NB, bool COMBINE, bool XOUT, bool NORM, bool ROUTER, bool XBF = false>
__device__ __forceinline__ void rows_phase(const float* xl, const float* xc, int nrows, const bf16* y2, const float* modc  , const float* modl  ,
                                           float* xout, float* out_final, const float* nw, int shift_i, int scale_i, bf16* hout,
                                           const float* wg, const float* bg, const float* we, const float* be, float* route_w, int* cnt, int* list, int cap,
                                           LAS unsigned char* lds) {
    constexpr int TL = NB * SEQ;
    const int tid = otid(), lane = tid & 63, wave = tid >> 6;
    LAS float* wt = (LAS float*)lds;
    constexpr int WTS = 1028;
    LAS int* lcnt = (LAS int*)(lds + 36 * WTS * 4); LAS int* lbase = lcnt + 32; LAS int* rinfo = lcnt + 64;
    if (ROUTER) {
        if (tid < 32) lcnt[tid] = 0;
        for (int i = tid; i < 4 * 1024; i += NTHR) wt[(i & 3) * WTS + (i >> 2)] = wg[i];
        for (int i = tid; i < 32 * 1024; i += NTHR) wt[(4 + (i & 31)) * WTS + (i >> 5)] = we[i];
        __syncthreads();
    }
    int lrow = wave;
    for (int row = blockIdx.x * NWAVE + wave; row < nrows; row += gridDim.x * NWAVE, lrow += NWAVE) {
        const size_t soff = row < TL ? (size_t)row * D : (size_t)(row - TL) * D;
        const float* src = (row < TL ? xl : xc) + (XBF ? 0 : soff);
        const float* mv = modl + (size_t)mod_row<NB>(row) * 6144;
        const float* mvc = modc + (size_t)mod_row<NB>(row) * 6144;
        f32x4 v[4];
#pragma unroll
        for (int i = 0; i < 4; ++i) {
            if (XBF) { const u32x2 t2 = *(const u32x2*)((const bf16*)src + soff + lane * 4 + 256 * i); v[i] = (f32x4){bflo(t2[0]), bfhi(t2[0]), bflo(t2[1]), bfhi(t2[1])}; }
            else v[i] = *(const f32x4*)(src + lane * 4 + 256 * i); }
        if (COMBINE) {
#pragma unroll
            for (int i = 0; i < 4; ++i) { const int c = lane * 4 + 256 * i;
                const u32x2 ya = *(const u32x2*)(y2 + (size_t)(2 * row) * D + c), yb = *(const u32x2*)(y2 + (size_t)(2 * row + 1) * D + c);
                const f32x4 m5 = *(const f32x4*)(mvc + 5 * 1024 + c);
                v[i][0] += m5[0] * (bflo(ya[0]) + bflo(yb[0])); v[i][1] += m5[1] * (bfhi(ya[0]) + bfhi(yb[0]));
                v[i][2] += m5[2] * (bflo(ya[1]) + bflo(yb[1])); v[i][3] += m5[3] * (bfhi(ya[1]) + bfhi(yb[1])); }
            if (XOUT) {
#pragma unroll
                for (int i = 0; i < 4; ++i) {
                    if (XBF) { u32x2 o2; o2[0] = pk2(v[i][0], v[i][1]); o2[1] = pk2(v[i][2], v[i][3]); *(u32x2*)((bf16*)xout + (size_t)row * D + lane * 4 + 256 * i) = o2;
                        v[i] = (f32x4){bflo(o2[0]), bfhi(o2[0]), bflo(o2[1]), bfhi(o2[1])}; }
                    else *(f32x4*)(xout + (size_t)row * D + lane * 4 + 256 * i) = v[i]; } }
            if (out_final) {
#pragma unroll
                for (int i = 0; i < 4; ++i) *(f32x4*)(out_final + (size_t)row * D + lane * 4 + 256 * i) = v[i]; }
        }
        if (NORM) {
            float ss = 0.f;
#pragma unroll
            for (int i = 0; i < 4; ++i) ss += v[i][0] * v[i][0] + v[i][1] * v[i][1] + v[i][2] * v[i][2] + v[i][3] * v[i][3];
            ss = wave_sum(ss);
            const float rs = rsqrtf(ss * (1.f / D) + 1e-6f);
            f32x4 hv[4];
#pragma unroll
            for (int i = 0; i < 4; ++i) { const int c = lane * 4 + 256 * i;
                const f32x4 w4 = *(const f32x4*)(nw + c), sc4 = *(const f32x4*)(mv + scale_i * 1024 + c), sh4 = *(const f32x4*)(mv + shift_i * 1024 + c);
#pragma unroll
                for (int j = 0; j < 4; ++j) hv[i][j] = v[i][j] * rs * w4[j] * (1.f + sc4[j]) + sh4[j];
                u32x2 o; o[0] = pk2(hv[i][0], hv[i][1]); o[1] = pk2(hv[i][2], hv[i][3]);
                *(u32x2*)(hout + (size_t)row * D + c) = o; }
            if (ROUTER) {
                float lg[4];
#pragma unroll
                for (int j = 0; j < 4; ++j) { float a = 0.f;
#pragma unroll
                    for (int i = 0; i < 4; ++i) { const f32x4 w4 = *(const LAS f32x4*)(wt + j * WTS + lane * 4 + 256 * i);
                        a += hv[i][0] * w4[0] + hv[i][1] * w4[1] + hv[i][2] * w4[2] + hv[i][3] * w4[3]; }
                    lg[j] = a; }
                wave_sum4(lg, lane);
#pragma unroll
                for (int j = 0; j < 4; ++j) lg[j] += bg[j];
                int gi = 0; float gm = lg[0];
#pragma unroll
                for (int j = 1; j < 4; ++j) if (lg[j] > gm) { gm = lg[j]; gi = j; }
                float gs = 0.f;
#pragma unroll
                for (int j = 0; j < 4; ++j) gs += __expf(lg[j] - gm);
                const float gprob = 1.f / gs;
                float le[8];
#pragma unroll
                for (int j = 0; j < 8; ++j) { float a = 0.f; const LAS float* wr = wt + (4 + gi * 8 + j) * WTS + lane * 4;
#pragma unroll
                    for (int i = 0; i < 4; ++i) { const f32x4 w4 = *(const LAS f32x4*)(wr + 256 * i);
                        a += hv[i][0] * w4[0] + hv[i][1] * w4[1] + hv[i][2] * w4[2] + hv[i][3] * w4[3]; }
                    le[j] = a; }
                wave_sum8(le, lane);
#pragma unroll
                for (int j = 0; j < 8; ++j) le[j] += be[gi * 8 + j];
                int e0 = 0; float m0 = le[0];
#pragma unroll
                for (int j = 1; j < 8; ++j) if (le[j] > m0) { m0 = le[j]; e0 = j; }
                int e1 = 0; float m1 = -3.0e38f;
#pragma unroll
                for (int j = 0; j < 8; ++j) if (j != e0 && le[j] > m1) { m1 = le[j]; e1 = j; }
                const float p1 = __expf(m1 - m0);
                if (lane == 0) {
                    const int ge0 = gi * 8 + e0, ge1 = gi * 8 + e1;
                    route_w[2 * row] = gprob / (1.f + p1); route_w[2 * row + 1] = gprob * p1 / (1.f + p1);
                    const int s0 = atomicAdd((int*)&lcnt[ge0], 1), s1 = atomicAdd((int*)&lcnt[ge1], 1);
                    rinfo[2 * lrow] = (ge0 << 16) | s0; rinfo[2 * lrow + 1] = (ge1 << 16) | s1;
                }
            }
        }
    }
    if (ROUTER) {
        __syncthreads();
        if (tid < 32) { const int c = lcnt[tid]; lbase[tid] = c ? atomicAdd(&cnt[tid * 64], c) : 0; }
        __syncthreads();
        int lrow = wave;
        for (int row = blockIdx.x * NWAVE + wave; row < nrows; row += gridDim.x * NWAVE, lrow += NWAVE) {
            if (lane < 2) { const int ri = rinfo[2 * lrow + lane], ge = ri >> 16, sl = ri & 0xffff; list[(size_t)ge * cap + lbase[ge] + sl] = 2 * row + lane; }
        }
        __syncthreads();
    }
}

__device__ __forceinline__ int xcd_unit(int r) { const int G = gridDim.x, bx = blockIdx.x; return G == 256 ? ((r * 8 + (bx & 7)) * 32 + (bx >> 3)) : r * G + bx; }
__device__ __forceinline__ void unit_tile(int u, int MT, int NT, int& mt, int& nt) {
    if ((MT & 3) == 0) { const int band = u / (4 * NT), w = u - band * 4 * NT; nt = w >> 2; mt = band * 4 + (w & 3); }
    else { mt = u / NT; nt = u - mt * NT; }
}
constexpr int GEMM_STAGE = 256 * 128 + 128 * 128;
constexpr int GEMM_LDS = 3 * GEMM_STAGE;
__device__ __forceinline__ int sw_off(int row, int chunk) { return row * 128 + ((chunk ^ ((row >> 1) & 7)) << 4); }

struct BRowId { __device__ __forceinline__ int operator()(int r) const { return r; } };
template <int VAR = 0, class Epi, class BRow = BRowId>
__device__ __forceinline__ void gemm_tile(const bf16* const (&arow)[4], const bf16* bt  , int ldb, int K, LAS unsigned char* lds, Epi&& epi, BRow brow = BRow()) {
    const int tid = otid(), lane = tid & 63, wave = tid >> 6, wm = wave >> 1, wn = wave & 1;
    const int r8 = tid >> 3;
    const int schunk = (lane & 7) ^ ((r8 >> 1) & 7);
    const bf16* ga[4]; const bf16* gb[2];
#pragma unroll
    for (int i = 0; i < 4; ++i) ga[i] = arow[i] + schunk * 8;
#pragma unroll
    for (int i = 0; i < 2; ++i) gb[i] = bt + (size_t)brow(r8 + 64 * i) * ldb + schunk * 8;
    f32x16 acc[2][2];
#pragma unroll
    for (int mi = 0; mi < 2; ++mi)
#pragma unroll
        for (int ni = 0; ni < 2; ++ni)
#pragma unroll
            for (int r = 0; r < 16; ++r) acc[mi][ni][r] = 0.f;
#define G_DMA(t, st) do { LAS unsigned char* sa_ = lds + (st) * GEMM_STAGE + wave * 1024 + lane * 16; \
    _Pragma("unroll") for (int i = 0; i < 4; ++i) __builtin_amdgcn_global_load_lds((const unsigned*)(ga[i] + (t) * 64), (LAS unsigned*)(sa_ + i * 8192), 16, 0, 0); \
    _Pragma("unroll") for (int i = 0; i < 2; ++i) __builtin_amdgcn_global_load_lds((const unsigned*)(gb[i] + (t) * 64), (LAS unsigned*)(sa_ + 256 * 128 + i * 8192), 16, 0, 0); } while (0)
    const int KT = K >> 6;
    G_DMA(0, 0);
    G_DMA(1, 1);
    asm volatile("s_waitcnt vmcnt(6)" ::: "memory");
    __builtin_amdgcn_s_barrier();
    asm volatile("" ::: "memory");
    int st = 0;
    for (int kt = 0; kt < KT; ++kt) {
        const int st2 = st >= 1 ? st - 1 : 2;
        if (VAR != 2) { if (kt + 2 < KT) G_DMA(kt + 2, st2); }
        const LAS unsigned char* sa = lds + st * GEMM_STAGE; const LAS unsigned char* sb = sa + 256 * 128;
        bf16x8 af[2], bfr[2];
        if (VAR == 1) {
#pragma unroll
            for (int mi = 0; mi < 2; ++mi) af[mi] = *(const LAS bf16x8*)(sa + sw_off(wm * 64 + mi * 32 + (lane & 31), (lane >> 5)));
#pragma unroll
            for (int ni = 0; ni < 2; ++ni) bfr[ni] = *(const LAS bf16x8*)(sb + sw_off(wn * 64 + ni * 32 + (lane & 31), (lane >> 5)));
        }
#pragma unroll
        for (int kk = 0; kk < 4; ++kk) {
            if (VAR != 1) {
#pragma unroll
            for (int mi = 0; mi < 2; ++mi) af[mi] = *(const LAS bf16x8*)(sa + sw_off(wm * 64 + mi * 32 + (lane & 31), 2 * kk + (lane >> 5)));
#pragma unroll
            for (int ni = 0; ni < 2; ++ni) bfr[ni] = *(const LAS bf16x8*)(sb + sw_off(wn * 64 + ni * 32 + (lane & 31), 2 * kk + (lane >> 5)));
            }
            if (VAR == 3) {
#pragma unroll
                for (int mi = 0; mi < 2; ++mi) acc[mi][0][kk] += __builtin_bit_cast(f32x4, af[mi])[0] + __builtin_bit_cast(f32x4, bfr[mi])[1];
            } else {
#pragma unroll
            for (int mi = 0; mi < 2; ++mi)
#pragma unroll
                for (int ni = 0; ni < 2; ++ni) acc[mi][ni] = mfma32(bfr[ni], af[mi], acc[mi][ni]);
            }
        }
        if (kt + 2 < KT) asm volatile("s_waitcnt vmcnt(6)" ::: "memory"); else asm volatile("s_waitcnt vmcnt(0)" ::: "memory");
        __builtin_amdgcn_s_barrier();
        asm volatile("" ::: "memory");
        st = st == 2 ? 0 : st + 1;
    }
#undef G_DMA
    epi(acc, wm, wn, lane);
}

constexpr int CST_BF = 272, CST_BF64 = 144, CST_F32 = 528;
__device__ __forceinline__ void stage_bf16_128(const f32x16 (&acc)[2][2], LAS unsigned char* lds, int wm, int wn, int lane) {
#pragma unroll
    for (int mi = 0; mi < 2; ++mi) { LAS unsigned char* rp = lds + (wm * 64 + mi * 32 + (lane & 31)) * CST_BF + (wn * 64 + 4 * (lane >> 5)) * 2;
#pragma unroll
        for (int ni = 0; ni < 2; ++ni)
#pragma unroll
            for (int g = 0; g < 4; ++g) { u32x2 o; o[0] = pk2(acc[mi][ni][4 * g], acc[mi][ni][4 * g + 1]); o[1] = pk2(acc[mi][ni][4 * g + 2], acc[mi][ni][4 * g + 3]);
                *(LAS u32x2*)(rp + (ni * 32 + 8 * g) * 2) = o; } }
}
template <class RowPtr>
__device__ __forceinline__ void flush_bf16_128(const LAS unsigned char* lds, RowPtr&& rowptr) {
    const int t = otid();
#pragma unroll
    for (int it = 0; it < 8; ++it) { const int row = it * 32 + (t >> 4), piece = t & 15;
        const u32x4 v = *(const LAS u32x4*)(lds + row * CST_BF + piece * 16);
        bf16* dst = rowptr(row);
        if (dst) __builtin_nontemporal_store(v, (u32x4*)(dst + piece * 8)); }
}
template <class RowPtr>
__device__ __forceinline__ void flush_bf16_64(const LAS unsigned char* lds, RowPtr&& rowptr) {
    const int t = otid();
#pragma unroll
    for (int it = 0; it < 4; ++it) { const int row = it * 64 + (t >> 3), piece = t & 7;
        const u32x4 v = *(const LAS u32x4*)(lds + row * CST_BF64 + piece * 16);
        bf16* dst = rowptr(row);
        if (dst) __builtin_nontemporal_store(v, (u32x4*)(dst + piece * 8)); }
}
__device__ __forceinline__ void stage_f32_128(const f32x16 (&acc)[2][2], LAS unsigned char* lds, int wm, int wn, int lane) {
#pragma unroll
    for (int mi = 0; mi < 2; ++mi) { LAS unsigned char* rp = lds + (wm * 64 + mi * 32 + (lane & 31)) * CST_F32 + (wn * 64 + 4 * (lane >> 5)) * 4;
#pragma unroll
        for (int ni = 0; ni < 2; ++ni)
#pragma unroll
            for (int g = 0; g < 4; ++g) { f32x4 o; o[0] = acc[mi][ni][4 * g]; o[1] = acc[mi][ni][4 * g + 1]; o[2] = acc[mi][ni][4 * g + 2]; o[3] = acc[mi][ni][4 * g + 3];
                *(LAS f32x4*)(rp + (ni * 32 + 8 * g) * 4) = o; } }
}

template <int NB, int VAR = 0>
__device__ __forceinline__ void phase_inproj_v(const bf16* H, const bf16* Wt, bf16* PROJ, float* GATES, LAS unsigned char* lds, bool dostore = true) {
    constexpr int T = NB * (SEQ + CTXL), MT = T / 256, NT_ = NIN / 128;
    for (int r = 0; r * (int)gridDim.x < MT * NT_; ++r) {
        const int u = xcd_unit(r); if (u >= MT * NT_) continue;
        int mt, nt; unit_tile(u, MT, NT_, mt, nt);
        const bf16* arow[4];
#pragma unroll
        for (int i = 0; i < 4; ++i) arow[i] = H + (size_t)(mt * 256 + (otid() >> 3) + 64 * i) * D;
        gemm_tile<VAR>(arow, Wt + (size_t)nt * 128 * D, D, D, lds, [&](const f32x16 (&acc)[2][2], int wm, int wn, int lane) {
            if (!dostore) return;
            if (nt < NT_ - 1) stage_bf16_128(acc, lds, wm, wn, lane);
            else if (wn == 0) {
#pragma unroll
                for (int mi = 0; mi < 2; ++mi) { const int row = mt * 256 + wm * 64 + mi * 32 + (lane & 31);
#pragma unroll
                    for (int ni = 0; ni < 2; ++ni)
#pragma unroll
                        for (int g = 0; g < 4; ++g) { f32x4 o; o[0] = acc[mi][ni][4 * g]; o[1] = acc[mi][ni][4 * g + 1]; o[2] = acc[mi][ni][4 * g + 2]; o[3] = acc[mi][ni][4 * g + 3];
                            *(f32x4*)(GATES + (size_t)row * 64 + ni * 32 + 8 * g + 4 * (lane >> 5)) = o; } } }
        });
        if (dostore && nt < NT_ - 1) {
            __syncthreads();
            flush_bf16_128(lds, [&](int r) { return PROJ + (size_t)(mt * 256 + r) * PROJW + nt * 128; });
        }
        __syncthreads();
    }
}

template <int NB> __device__ __forceinline__ void phase_inproj(const bf16* H, const bf16* Wt, bf16* PROJ, float* GATES, LAS unsigned char* lds) { phase_inproj_v<NB, 0>(H, Wt, PROJ, GATES, lds, true); }

template <int NB>
__device__ __forceinline__ void phase_conv(const bf16* PROJ, const float* cw, const float* cb, bf16* XBC) {
    constexpr int TL = NB * SEQ, T = NB * (SEQ + CTXL);
    for (size_t it = (size_t)blockIdx.x * NTHR + otid(); it < (size_t)T * 192; it += (size_t)gridDim.x * NTHR) {
        const int row = (int)(it / 192), c0 = (int)(it % 192) * 8;
        int t, L;
        if (row < TL) { t = row % SEQ; L = SEQ; } else { t = (row - TL) % CTXL; L = CTXL; }
        const bf16* p = PROJ + (size_t)row * PROJW + PC_XBC + c0;
        const u32x4 cur = *(const u32x4*)p;
        u32x4 prv = {0u, 0u, 0u, 0u}, nxt = {0u, 0u, 0u, 0u};
        if (t > 0) prv = *(const u32x4*)(p - PROJW);
        if (t < L - 1) nxt = *(const u32x4*)(p + PROJW);
        float o[8];
#pragma unroll
        for (int j = 0; j < 4; ++j) {
            const int c = c0 + 2 * j;
            o[2 * j] = bflo(prv[j]) * cw[c] + bflo(cur[j]) * cw[1536 + c] + bflo(nxt[j]) * cw[3072 + c] + cb[c];
            o[2 * j + 1] = bfhi(prv[j]) * cw[c + 1] + bfhi(cur[j]) * cw[1536 + c + 1] + bfhi(nxt[j]) * cw[3072 + c + 1] + cb[c + 1];
        }
        u32x4 r; r[0] = pk2(siluf(o[0]), siluf(o[1])); r[1] = pk2(siluf(o[2]), siluf(o[3])); r[2] = pk2(siluf(o[4]), siluf(o[5])); r[3] = pk2(siluf(o[6]), siluf(o[7]));
        *(u32x4*)(XBC + (size_t)row * 1536 + c0) = r;
    }
}
}
namespace fx {
constexpr int RS_X = 144, RS_N = 272;

template <int NB> __device__ __forceinline__ int scan_row(int b, int d, int step) {
    if (step < CTXL) return NB * SEQ + b * CTXL + (d ? CTXL - 1 - step : step);
    step -= CTXL; return b * SEQ + (d ? SEQ - 1 - step : step);
}
__device__ __forceinline__ bf16x8 scale_frag(bf16x8 v, f32x4 w0, f32x4 w1) {
    const u32x4 u = __builtin_bit_cast(u32x4, v);
    u32x4 o;
    o[0] = pk2(bflo(u[0]) * w0[0], bfhi(u[0]) * w0[1]); o[1] = pk2(bflo(u[1]) * w0[2], bfhi(u[1]) * w0[3]);
    o[2] = pk2(bflo(u[2]) * w1[0], bfhi(u[2]) * w1[1]); o[3] = pk2(bflo(u[3]) * w1[2], bfhi(u[3]) * w1[3]);
    return __builtin_bit_cast(bf16x8, o);
}

__device__ __forceinline__ unsigned tr_addr(const LAS unsigned char* T, int RS, int k0, int c0, int lane) {
    const int h = lane >> 5, blk = (lane >> 4) & 1, q = (lane & 15) >> 2, p = lane & 3;
    return (unsigned)(size_t)(T + (k0 + 8 * h + q) * RS + (c0 + 16 * blk + 4 * p) * 2);
}
__device__ __forceinline__ void tr8(unsigned a0, unsigned a1, unsigned a2, unsigned a3, unsigned a4, unsigned a5, unsigned a6, unsigned a7,
                                    bf16x4& v0, bf16x4& v1, bf16x4& v2, bf16x4& v3, bf16x4& v4, bf16x4& v5, bf16x4& v6, bf16x4& v7) {
    asm volatile("ds_read_b64_tr_b16 %0, %8\n\tds_read_b64_tr_b16 %1, %9\n\tds_read_b64_tr_b16 %2, %10\n\tds_read_b64_tr_b16 %3, %11\n\t"
                 "ds_read_b64_tr_b16 %4, %12\n\tds_read_b64_tr_b16 %5, %13\n\tds_read_b64_tr_b16 %6, %14\n\tds_read_b64_tr_b16 %7, %15\n\ts_waitcnt lgkmcnt(0)"
                 : "=&v"(v0), "=&v"(v1), "=&v"(v2), "=&v"(v3), "=&v"(v4), "=&v"(v5), "=&v"(v6), "=&v"(v7)
                 : "v"(a0), "v"(a1), "v"(a2), "v"(a3), "v"(a4), "v"(a5), "v"(a6), "v"(a7) : "memory");
}
__device__ __forceinline__ void tr4(unsigned a0, unsigned a1, unsigned a2, unsigned a3, bf16x4& v0, bf16x4& v1, bf16x4& v2, bf16x4& v3) {
    asm volatile("ds_read_b64_tr_b16 %0, %4\n\tds_read_b64_tr_b16 %1, %5\n\tds_read_b64_tr_b16 %2, %6\n\tds_read_b64_tr_b16 %3, %7\n\ts_waitcnt lgkmcnt(0)"
                 : "=&v"(v0), "=&v"(v1), "=&v"(v2), "=&v"(v3) : "v"(a0), "v"(a1), "v"(a2), "v"(a3) : "memory");
}
__device__ __forceinline__ bf16x8 tr_join(bf16x4 v0, bf16x4 v1) { bf16x8 r; r[0] = v0[0]; r[1] = v0[1]; r[2] = v0[2]; r[3] = v0[3]; r[4] = v1[0]; r[5] = v1[1]; r[6] = v1[2]; r[7] = v1[3]; return r; }
__device__ __forceinline__ void tr_col4(const LAS unsigned char* T, int RS, int k0, int c0, int lane, bf16x4 (&t)[4][2]) {
    const unsigned a = tr_addr(T, RS, k0, c0, lane);
    tr8(a, a + 4 * RS, a + 16 * RS, a + 20 * RS, a + 32 * RS, a + 36 * RS, a + 48 * RS, a + 52 * RS, t[0][0], t[0][1], t[1][0], t[1][1], t[2][0], t[2][1], t[3][0], t[3][1]);
}
__device__ __forceinline__ void tr_col2(const LAS unsigned char* T, int RS, int k0, int c0, int lane, bf16x4 (&t)[2][2]) {
    const unsigned a = tr_addr(T, RS, k0, c0, lane);
    tr4(a, a + 4 * RS, a + 16 * RS, a + 20 * RS, t[0][0], t[0][1], t[1][0], t[1][1]);
}

constexpr int NSTEP = SEQ + CTXL;
template <int NB> struct ScanTab {
    static constexpr size_t SSD_TAB = 0, ML_TAB = SSD_TAB + (size_t)NB * 32 * NSTEP * 16, SSD_DEC = ML_TAB + (size_t)NB * 8 * NSTEP * 32,
                            ML_CH = SSD_DEC + (size_t)NB * 32 * 34 * 4, END = ML_CH + (size_t)NB * 8 * 34 * 8;
};
template <int NB>
__device__ __forceinline__ void phase_tables(const In& in, const float* GATES, unsigned char* tab, LAS unsigned char* lds) {
    typedef ScanTab<NB> ST;
    const int tid = otid(), lane = tid & 63, wave = tid >> 6;
    LAS float* l_g = (LAS float*)lds; LAS float* l_ml = l_g + 68; LAS float* l_mr = l_g + 136;
    for (int job = blockIdx.x; job < NB * 40; job += gridDim.x) {
        if (job < NB * 32) {
            const int b = job >> 5, d = (job >> 4) & 1, h = job & 15;
            const float a = -__expf(in.ssd_a_log[d * 16 + h]), dtb = in.ssd_dt_bias[d * 16 + h];
            f32x4* T4 = (f32x4*)(tab + ST::SSD_TAB) + (size_t)job * NSTEP; float* DEC = (float*)(tab + ST::SSD_DEC) + job * 34;
            for (int ch = wave; ch < 34; ch += NWAVE) {
                const float dt0 = softplusf(GATES[(size_t)scan_row<NB>(b, d, ch * 128 + lane) * 64 + d * 16 + h] + dtb);
                const float dt1 = softplusf(GATES[(size_t)scan_row<NB>(b, d, ch * 128 + 64 + lane) * 64 + d * 16 + h] + dtb);
                float v0 = dt0 * a, v1 = dt1 * a;
#pragma unroll
                for (int o = 1; o < 64; o <<= 1) { const float t0 = __shfl_up(v0, o), t1 = __shfl_up(v1, o); if (lane >= o) { v0 += t0; v1 += t1; } }
                v1 += __shfl(v0, 63);
                const float tot = __shfl(v1, 63);
                T4[ch * 128 + lane] = (f32x4){v0, dt0, dt0 * __expf(tot - v0), __expf(v0)};
                T4[ch * 128 + 64 + lane] = (f32x4){v1, dt1, dt1 * __expf(tot - v1), __expf(v1)};
                if (lane == 0) DEC[ch] = __expf(tot);
            }
        } else {
            const int j2 = job - NB * 32, b = j2 >> 3, d = (j2 >> 2) & 1, hh = j2 & 3;
            const float ib = in.ml_i_bias[d * 4 + hh], fb = in.ml_f_bias[d * 4 + hh];
            f32x4* T4 = (f32x4*)(tab + ST::ML_TAB) + (size_t)j2 * NSTEP * 2; float* CH = (float*)(tab + ST::ML_CH) + j2 * 34 * 2;
            float s_li[5][2], s_bc[5][2], s_mi[5][2], s_we[5][2];
            __syncthreads();
#pragma unroll
            for (int k = 0; k < 5; ++k) { const int ch = wave + 8 * k;
#pragma unroll
                for (int q = 0; q < 2; ++q) { s_li[k][q] = 0.f; s_bc[k][q] = 0.f; s_mi[k][q] = 0.f; s_we[k][q] = 0.f; }
                if (ch < 34) {
                    const float* g0 = GATES + (size_t)scan_row<NB>(b, d, ch * 128 + lane) * 64; const float* g1 = GATES + (size_t)scan_row<NB>(b, d, ch * 128 + 64 + lane) * 64;
                    const float li0 = g0[32 + d * 4 + hh] + ib, li1 = g1[32 + d * 4 + hh] + ib;
                    float bc0 = logsigf(g0[40 + d * 4 + hh] + fb), bc1 = logsigf(g1[40 + d * 4 + hh] + fb);
#pragma unroll
                    for (int o = 1; o < 64; o <<= 1) { const float t0 = __shfl_up(bc0, o), t1 = __shfl_up(bc1, o); if (lane >= o) { bc0 += t0; bc1 += t1; } }
                    bc1 += __shfl(bc0, 63);
                    float pm0 = li0 - bc0, pm1 = li1 - bc1;
#pragma unroll
                    for (int o = 1; o < 64; o <<= 1) { const float t0 = __shfl_up(pm0, o), t1 = __shfl_up(pm1, o); if (lane >= o) { pm0 = fmaxf(pm0, t0); pm1 = fmaxf(pm1, t1); } }
                    pm1 = fmaxf(pm1, __shfl(pm0, 63));
                    const float gtot = __shfl(bc1, 63);
                    const float ae0 = gtot - bc0 + li0, ae1 = gtot - bc1 + li1;
                    const float m_loc = wave_max(fmaxf(ae0, ae1));
                    s_li[k][0] = li0; s_li[k][1] = li1; s_bc[k][0] = bc0; s_bc[k][1] = bc1; s_mi[k][0] = bc0 + pm0; s_mi[k][1] = bc1 + pm1;
                    s_we[k][0] = __expf(ae0 - m_loc); s_we[k][1] = __expf(ae1 - m_loc);
                    if (lane == 0) { l_g[ch] = gtot; l_ml[ch] = m_loc; }
                } }
            __syncthreads();
            if (tid == 0) { float m = 0.f;
                for (int ch = 0; ch < 34; ++ch) { const float g = l_g[ch], ml = l_ml[ch], mn = fmaxf(g + m, ml);
                    l_mr[ch] = m; CH[2 * ch] = __expf(g + m - mn); CH[2 * ch + 1] = __expf(ml - mn); m = mn; } }
            __syncthreads();
#pragma unroll
            for (int k = 0; k < 5; ++k) { const int ch = wave + 8 * k;
                if (ch < 34) {
#pragma unroll
                    for (int q = 0; q < 2; ++q) {
                        const float m_inter = s_bc[k][q] + l_mr[ch], mt = fmaxf(s_mi[k][q], m_inter);
                        T4[(size_t)(ch * 128 + 64 * q + lane) * 2] = (f32x4){__expf(s_bc[k][q] - mt), __expf(s_li[k][q] - s_bc[k][q]), __expf(m_inter - mt), s_we[k][q]};
                        T4[(size_t)(ch * 128 + 64 * q + lane) * 2 + 1] = (f32x4){__expf(-mt), 0.f, 0.f, 0.f}; }
                } }
        }
    }
}

template <int NB>
__device__ __forceinline__ void ssd_item(const bf16* XBC, const unsigned char* tab, bf16* SCb, int b, int d, int h, LAS unsigned char* lds) {
    typedef ScanTab<NB> ST;
    const int tid = otid(), lane = tid & 63, wave = tid >> 6, g = h >> 3, combo = b * 32 + d * 16 + h;
    LAS unsigned char* Xs = lds; LAS unsigned char* Bs = lds + 18432; LAS unsigned char* Cs = lds + 53248;
    LAS unsigned char* Ss = lds + 88064; LAS unsigned char* Ms = lds + 105472;
    LAS float* acs = (LAS float*)(lds + 140288); LAS float* dtv = acs + 128; LAS float* wv = acs + 256; LAS float* eav = acs + 384;
    const f32x4* T4 = (const f32x4*)(tab + ST::SSD_TAB) + (size_t)combo * NSTEP; const float* DEC = (const float*)(tab + ST::SSD_DEC) + combo * 34;
    f32x16 st;
#pragma unroll
    for (int r = 0; r < 16; ++r) st[r] = 0.f;
    constexpr int NCH = (CTXL + SEQ) / 128;
    u32x4 rx[2], rb[4], rc[4]; f32x4 rt = {0.f, 0.f, 0.f, 0.f}; float rdec = 0.f;
#define SSD_LOAD(ch) do { \
    _Pragma("unroll") for (int i = 0; i < 2; ++i) { const int idx = tid + 512 * i, l = idx >> 3, c = idx & 7; \
        rx[i] = *(const u32x4*)(XBC + (size_t)scan_row<NB>(b, d, (ch) * 128 + l) * 1536 + h * 64 + c * 8); } \
    _Pragma("unroll") for (int i = 0; i < 4; ++i) { const int idx = tid + 512 * i, l = idx >> 4, c = idx & 15; \
        const bf16* rp = XBC + (size_t)scan_row<NB>(b, d, (ch) * 128 + l) * 1536 + 1024 + g * 128 + c * 8; \
        rb[i] = *(const u32x4*)rp; rc[i] = *(const u32x4*)(rp + 256); } \
    if (tid < 128) rt = T4[(ch) * 128 + tid]; \
    rdec = DEC[ch]; } while (0)
    SSD_LOAD(0);
    const int pbw = wave >> 2, nbw = wave & 3;
    for (int ch = 0; ch < NCH; ++ch) {
#pragma unroll
        for (int i = 0; i < 2; ++i) { const int idx = tid + 512 * i, l = idx >> 3, c = idx & 7; *(LAS u32x4*)(Xs + l * RS_X + c * 16) = rx[i]; }
#pragma unroll
        for (int i = 0; i < 4; ++i) { const int idx = tid + 512 * i, l = idx >> 4, c = idx & 15;
            *(LAS u32x4*)(Bs + l * RS_N + c * 16) = rb[i]; *(LAS u32x4*)(Cs + l * RS_N + c * 16) = rc[i]; }
        if (tid < 128) { acs[tid] = rt[0]; dtv[tid] = rt[1]; wv[tid] = rt[2]; eav[tid] = rt[3]; }
        const float dec = rdec;
        {
            const int pp = 32 * pbw + (lane & 31);
#pragma unroll
            for (int gq = 0; gq < 4; ++gq) { u32x2 o; o[0] = pk2(st[4 * gq], st[4 * gq + 1]); o[1] = pk2(st[4 * gq + 2], st[4 * gq + 3]);
                *(LAS u32x2*)(Ss + pp * RS_N + (32 * nbw + 8 * gq + 4 * (lane >> 5)) * 2) = o; }
        }
        __syncthreads();
        if (ch + 1 < NCH) SSD_LOAD(ch + 1);
        {
            const int lbA = wave >> 1, sbp = wave & 1;
            const int l = 32 * lbA + (lane & 31);
            const float al = acs[l];
#pragma unroll
            for (int q = 0; q < 2; ++q) { const int sb = 2 * sbp + q;
                if (sb <= lbA) {
                    f32x16 cb;
#pragma unroll
                    for (int r = 0; r < 16; ++r) cb[r] = 0.f;
#pragma unroll
                    for (int kk = 0; kk < 8; ++kk) cb = mfma32(frag_row(Bs, RS_N, 32 * sb, 16 * kk, lane), frag_row(Cs, RS_N, 32 * lbA, 16 * kk, lane), cb);
#pragma unroll
                    for (int gq = 0; gq < 4; ++gq) { const int s0 = 32 * sb + 8 * gq + 4 * (lane >> 5);
                        const f32x4 as4 = *(const LAS f32x4*)(acs + s0), dt4 = *(const LAS f32x4*)(dtv + s0);
                        float m[4];
#pragma unroll
                        for (int j = 0; j < 4; ++j) m[j] = (s0 + j <= l) ? cb[4 * gq + j] * __expf(fminf(al - as4[j], 0.f)) * dt4[j] : 0.f;
                        u32x2 o; o[0] = pk2(m[0], m[1]); o[1] = pk2(m[2], m[3]);
                        *(LAS u32x2*)(Ms + l * RS_N + s0 * 2) = o; } } }
        }
        {
#pragma unroll
            for (int r = 0; r < 16; ++r) st[r] *= dec;
#pragma unroll
            for (int kb = 0; kb < 2; ++kb) {
                bf16x4 tx[4][2], tb[4][2];
                tr_col4(Xs, RS_X, 64 * kb, 32 * pbw, lane, tx);
                tr_col4(Bs, RS_N, 64 * kb, 32 * nbw, lane, tb);
#pragma unroll
                for (int k4 = 0; k4 < 4; ++k4) {
                    const int l0 = 16 * (4 * kb + k4) + 8 * (lane >> 5);
                    const f32x4 w0 = *(const LAS f32x4*)(wv + l0), w1 = *(const LAS f32x4*)(wv + l0 + 4);
                    st = mfma32(tr_join(tb[k4][0], tb[k4][1]), scale_frag(tr_join(tx[k4][0], tx[k4][1]), w0, w1), st);
                }
            }
        }
        __syncthreads();
        {
            const int pb = wave >> 2, lb = wave & 3;
            f32x16 acc;
#pragma unroll
            for (int r = 0; r < 16; ++r) acc[r] = 0.f;
#pragma unroll
            for (int kk = 0; kk < 8; ++kk) acc = mfma32(frag_row(Ss, RS_N, 32 * pb, 16 * kk, lane), frag_row(Cs, RS_N, 32 * lb, 16 * kk, lane), acc);
            const int l = 32 * lb + (lane & 31);
            const float ea = eav[l];
#pragma unroll
            for (int r = 0; r < 16; ++r) acc[r] *= ea;
            for (int sb = 0; sb <= lb; ++sb) {
                bf16x4 t2[2][2];
                const bf16x8 m0 = frag_row(Ms, RS_N, 32 * lb, 32 * sb, lane), m1 = frag_row(Ms, RS_N, 32 * lb, 32 * sb + 16, lane);
                tr_col2(Xs, RS_X, 32 * sb, 32 * pb, lane, t2);
                acc = mfma32(tr_join(t2[0][0], t2[0][1]), m0, acc);
                acc = mfma32(tr_join(t2[1][0], t2[1][1]), m1, acc);
            }
            bf16* yp = SCb + (size_t)scan_row<NB>(b, d, ch * 128 + l) * 4096 + d * 1024 + h * 64 + 32 * pb + 4 * (lane >> 5);
#pragma unroll
            for (int gq = 0; gq < 4; ++gq) { u32x2 o; o[0] = pk2(acc[4 * gq], acc[4 * gq + 1]); o[1] = pk2(acc[4 * gq + 2], acc[4 * gq + 3]); *(u32x2*)(yp + 8 * gq) = o; }
        }
        __syncthreads();
    }
#undef SSD_LOAD
}

template <int NB>
__device__ __forceinline__ void mlstm_item(const bf16* PROJ, const unsigned char* tab, bf16* SCb, int b, int d, int hh, int ev, LAS unsigned char* lds) {
    typedef ScanTab<NB> ST;
    const int tid = otid(), lane = tid & 63, wave = tid >> 6, combo = b * 8 + d * 4 + hh;
    LAS unsigned char* Qs = lds; LAS unsigned char* Ks = lds + 34816; LAS unsigned char* Vs = lds + 69632;
    LAS unsigned char* Ct = lds + 88064; LAS unsigned char* Sm = lds + 105472;
    LAS float* tb = (LAS float*)(lds + 140288);
    LAS float* t_u = tb, *t_v = tb + 128, *t_wi = tb + 256, *t_we = tb + 384, *t_em = tb + 512, *t_qn = tb + 640, *t_n = tb + 768, *t_nc = tb + 896, *t_rs = tb + 1024  ;
    const f32x4* T4 = (const f32x4*)(tab + ST::ML_TAB) + (size_t)combo * NSTEP * 2; const float* CH = (const float*)(tab + ST::ML_CH) + combo * 34 * 2;
    const float kscale = 0.08838834764831845f;
    f32x16 st;
#pragma unroll
    for (int r = 0; r < 16; ++r) st[r] = 0.f;
    if (tid < 128) t_n[tid] = 0.f;
    constexpr int NCH = (CTXL + SEQ) / 128;
    const int kbw = wave & 3, ebw = wave >> 2;
    u32x4 rq[4], rk[4], rv[2]; f32x4 rt = {0.f, 0.f, 0.f, 0.f}; float ras = 0.f, rbb = 0.f;
#define ML_LOAD(ch) do { \
    _Pragma("unroll") for (int i = 0; i < 4; ++i) { const int idx = tid + 512 * i, l = idx >> 4, c = idx & 15; \
        const bf16* rp = PROJ + (size_t)scan_row<NB>(b, d, (ch) * 128 + l) * PROJW + hh * 128 + c * 8; \
        rq[i] = *(const u32x4*)(rp + PC_Q); rk[i] = *(const u32x4*)(rp + PC_K); } \
    _Pragma("unroll") for (int i = 0; i < 2; ++i) { const int idx = tid + 512 * i, l = idx >> 3, c = idx & 7; \
        rv[i] = *(const u32x4*)(PROJ + (size_t)scan_row<NB>(b, d, (ch) * 128 + l) * PROJW + PC_V + hh * 256 + ev * 64 + c * 8); } \
    if (tid < 256) rt = T4[(size_t)(ch) * 256 + tid]; \
    ras = CH[2 * (ch)]; rbb = CH[2 * (ch) + 1]; } while (0)
    ML_LOAD(0);
    for (int ch = 0; ch < NCH; ++ch) {
#pragma unroll
        for (int i = 0; i < 4; ++i) { const int idx = tid + 512 * i, l = idx >> 4, c = idx & 15;
            *(LAS u32x4*)(Qs + l * RS_N + c * 16) = rq[i]; *(LAS u32x4*)(Ks + l * RS_N + c * 16) = rk[i]; }
#pragma unroll
        for (int i = 0; i < 2; ++i) { const int idx = tid + 512 * i, l = idx >> 3, c = idx & 7; *(LAS u32x4*)(Vs + l * RS_X + c * 16) = rv[i]; }
        if (tid < 256) { const int l = tid >> 1; if (tid & 1) t_em[l] = rt[0]; else { t_u[l] = rt[0]; t_v[l] = rt[1]; t_wi[l] = rt[2]; t_we[l] = rt[3]; } }
        const float a_s = ras, bbs = rbb;
        {
            const int ee = 32 * ebw + (lane & 31);
#pragma unroll
            for (int gq = 0; gq < 4; ++gq) { u32x2 o; o[0] = pk2(st[4 * gq], st[4 * gq + 1]); o[1] = pk2(st[4 * gq + 2], st[4 * gq + 3]);
                *(LAS u32x2*)(Ct + ee * RS_N + (32 * kbw + 8 * gq + 4 * (lane >> 5)) * 2) = o; }
        }
        __syncthreads();
        if (ch + 1 < NCH) ML_LOAD(ch + 1);
        {
            const int lbA = wave >> 1, sbp = wave & 1;
            const int l = 32 * lbA + (lane & 31);
            const float ul = t_u[l] * kscale;
#pragma unroll
            for (int q = 0; q < 2; ++q) { const int sb = 2 * sbp + q;
                if (sb <= lbA) {
                    f32x16 cb;
#pragma unroll
                    for (int r = 0; r < 16; ++r) cb[r] = 0.f;
#pragma unroll
                    for (int kk = 0; kk < 8; ++kk) cb = mfma32(frag_row(Ks, RS_N, 32 * sb, 16 * kk, lane), frag_row(Qs, RS_N, 32 * lbA, 16 * kk, lane), cb);
                    float rsum = 0.f;
#pragma unroll
                    for (int gq = 0; gq < 4; ++gq) { const int s0 = 32 * sb + 8 * gq + 4 * (lane >> 5);
                        const f32x4 v4 = *(const LAS f32x4*)(t_v + s0);
                        float m[4];
#pragma unroll
                        for (int j = 0; j < 4; ++j) { m[j] = (s0 + j <= l) ? cb[4 * gq + j] * ul * v4[j] : 0.f; rsum += m[j]; }
                        u32x2 o; o[0] = pk2(m[0], m[1]); o[1] = pk2(m[2], m[3]);
                        *(LAS u32x2*)(Sm + l * RS_N + s0 * 2) = o; }
                    rsum += __shfl_xor(rsum, 32);
                    if (lane < 32) t_rs[sb * 128 + l] = rsum;
                } }
            if (wave == 1 || wave == 3) {
                const int lq = (wave == 1 ? 0 : 64) + lane;
                float qn = 0.f;
#pragma unroll 4
                for (int c = 0; c < 16; ++c) { const u32x4 qv = *(const LAS u32x4*)(Qs + lq * RS_N + c * 16);
                    const f32x4 n0 = *(const LAS f32x4*)(t_n + c * 8), n1 = *(const LAS f32x4*)(t_n + c * 8 + 4);
                    qn += bflo(qv[0]) * n0[0] + bfhi(qv[0]) * n0[1] + bflo(qv[1]) * n0[2] + bfhi(qv[1]) * n0[3]
                        + bflo(qv[2]) * n1[0] + bfhi(qv[2]) * n1[1] + bflo(qv[3]) * n1[2] + bfhi(qv[3]) * n1[3]; }
                t_qn[lq] = qn;
            }
        }
        {
#pragma unroll
            for (int r = 0; r < 16; ++r) st[r] *= a_s;
            const float f = bbs * kscale;
            f32x16 nacc;
#pragma unroll
            for (int r = 0; r < 16; ++r) nacc[r] = 0.f;
            bf16x8 ones;
#pragma unroll
            for (int j = 0; j < 8; ++j) ones[j] = (short)0x3f80;
#pragma unroll
            for (int kb2 = 0; kb2 < 2; ++kb2) {
                bf16x4 tk[4][2], tv[4][2];
                tr_col4(Ks, RS_N, 64 * kb2, 32 * kbw, lane, tk);
                tr_col4(Vs, RS_X, 64 * kb2, 32 * ebw, lane, tv);
#pragma unroll
                for (int k4 = 0; k4 < 4; ++k4) {
                    const int l0 = 16 * (4 * kb2 + k4) + 8 * (lane >> 5);
                    f32x4 w0 = *(const LAS f32x4*)(t_we + l0), w1 = *(const LAS f32x4*)(t_we + l0 + 4);
#pragma unroll
                    for (int j = 0; j < 4; ++j) { w0[j] *= f; w1[j] *= f; }
                    const bf16x8 ka = scale_frag(tr_join(tk[k4][0], tk[k4][1]), w0, w1);
                    st = mfma32(ka, tr_join(tv[k4][0], tv[k4][1]), st);
                    if (ebw == 0) nacc = mfma32(ka, ones, nacc);
                }
            }
            if (ebw == 0 && (lane & 31) == 0) {
#pragma unroll
                for (int gq = 0; gq < 4; ++gq)
#pragma unroll
                    for (int j = 0; j < 4; ++j) t_nc[32 * kbw + 8 * gq + 4 * (lane >> 5) + j] = nacc[4 * gq + j];
            }
        }
        __syncthreads();
        if (tid < 128) t_n[tid] = a_s * t_n[tid] + t_nc[tid];
        {
            const int eb = wave >> 2, lb = wave & 3;
            f32x16 acc;
#pragma unroll
            for (int r = 0; r < 16; ++r) acc[r] = 0.f;
#pragma unroll
            for (int kk = 0; kk < 8; ++kk) acc = mfma32(frag_row(Ct, RS_N, 32 * eb, 16 * kk, lane), frag_row(Qs, RS_N, 32 * lb, 16 * kk, lane), acc);
            const int l = 32 * lb + (lane & 31);
            const float wi = t_wi[l];
#pragma unroll
            for (int r = 0; r < 16; ++r) acc[r] *= wi;
            float rsum = 0.f;
            for (int sb = 0; sb <= lb; ++sb) {
                bf16x4 t2[2][2];
                const bf16x8 m0 = frag_row(Sm, RS_N, 32 * lb, 32 * sb, lane), m1 = frag_row(Sm, RS_N, 32 * lb, 32 * sb + 16, lane);
                rsum += t_rs[sb * 128 + l];
                tr_col2(Vs, RS_X, 32 * sb, 32 * eb, lane, t2);
                acc = mfma32(tr_join(t2[0][0], t2[0][1]), m0, acc);
                acc = mfma32(tr_join(t2[1][0], t2[1][1]), m1, acc);
            }
            float den = rsum + t_qn[l] * wi;
            den = fmaxf(fabsf(den), t_em[l]);
            const float inv = 1.f / den;
            bf16* hp = SCb + (size_t)scan_row<NB>(b, d, ch * 128 + l) * 4096 + 2048 + d * 1024 + hh * 256 + ev * 64 + 32 * eb + 4 * (lane >> 5);
#pragma unroll
            for (int gq = 0; gq < 4; ++gq) { u32x2 o; o[0] = pk2(acc[4 * gq] * inv, acc[4 * gq + 1] * inv); o[1] = pk2(acc[4 * gq + 2] * inv, acc[4 * gq + 3] * inv); *(u32x2*)(hp + 8 * gq) = o; }
        }
        __syncthreads();
    }
#undef ML_LOAD
}

template <int NB>
__device__ __forceinline__ void phase_scan(const bf16* PROJ, const unsigned char* tab, const bf16* XBC, bf16* SCb, LAS unsigned char* lds, int mode = 3) {
    const int G = gridDim.x, bi = blockIdx.x;
    if (NB == 4 && G == 256) {
        const int x = bi & 7, y = bi >> 3;
        if (y < 16) { if (mode & 1) { const int q = x + 8 * (y >> 3), hh = y & 7; ssd_item<NB>(XBC, tab, SCb, q >> 2, (q >> 1) & 1, (q & 1) * 8 + hh, lds); } }
        else { if (mode & 2) { const int y2 = y - 16, c = x + 8 * (y2 >> 2), ev = y2 & 3; mlstm_item<NB>(PROJ, tab, SCb, c >> 3, (c >> 2) & 1, c & 3, ev, lds); } }
        return;
    }
    if (mode & 1) for (int item = bi; item < NB * 32; item += G) { const int b = item / 32, d = (item >> 4) & 1, h = item & 15;
        ssd_item<NB>(XBC, tab, SCb, b, d, h, lds); }
    const int v = (bi + G - (NB * 32) % G) % G;
    if (mode & 2) for (int it = v; it < NB * 32; it += G) { const int b = it / 32, d = (it >> 4) & 1, hh = (it >> 2) & 3, ev = it & 3;
        mlstm_item<NB>(PROJ, tab, SCb, b, d, hh, ev, lds); }
}

template <int NB>
__device__ __forceinline__ void phase_mixer_out(const In& in, const bf16* PROJ, const bf16* XBC, bf16* SCb, bf16* scratch_out = nullptr) {
    constexpr int T = NB * (SEQ + CTXL);
    const int lane = otid() & 63, wave = otid() >> 6;
    for (int row = blockIdx.x * NWAVE + wave; row < T; row += gridDim.x * NWAVE) {
        bf16* sc = SCb + (size_t)row * 4096;
        const bf16* pr = PROJ + (size_t)row * PROJW;
        float yv[16], hv[16], ss = 0.f, hs[2] = {0.f, 0.f};
#pragma unroll
        for (int i = 0; i < 2; ++i) { const int c = lane * 8 + 512 * i;
            const u32x4 y0 = *(const u32x4*)(sc + c), y1 = *(const u32x4*)(sc + 1024 + c), h0 = *(const u32x4*)(sc + 2048 + c), h1 = *(const u32x4*)(sc + 3072 + c);
            const u32x4 xs = *(const u32x4*)(XBC + (size_t)row * 1536 + c), z = *(const u32x4*)(pr + PC_Z + c);
            const float dk = in.ssd_d[c >> 6];
#pragma unroll
            for (int j = 0; j < 4; ++j) {
                float a0 = bflo(y0[j]) + bflo(y1[j]) + dk * bflo(xs[j]), a1 = bfhi(y0[j]) + bfhi(y1[j]) + dk * bfhi(xs[j]);
                a0 *= siluf(bflo(z[j])); a1 *= siluf(bfhi(z[j]));
                yv[8 * i + 2 * j] = a0; yv[8 * i + 2 * j + 1] = a1; ss += a0 * a0 + a1 * a1;
                const float b0 = bflo(h0[j]) + bflo(h1[j]), b1 = bfhi(h0[j]) + bfhi(h1[j]);
                hv[8 * i + 2 * j] = b0; hv[8 * i + 2 * j + 1] = b1; hs[i] += b0 * b0 + b1 * b1; } }
        ss = wave_sum(ss);
        const float rs = rsqrtf(ss * (1.f / 1024.f) + 1e-6f);
#pragma unroll
        for (int i = 0; i < 2; ++i) {
#pragma unroll
            for (int o = 16; o > 0; o >>= 1) hs[i] += __shfl_xor(hs[i], o);
            hs[i] = rsqrtf(hs[i] * (1.f / 256.f) + 1e-6f); }
        __builtin_amdgcn_s_waitcnt(0);
#pragma unroll
        for (int i = 0; i < 2; ++i) { const int c = lane * 8 + 512 * i;
            const u32x4 ov = *(const u32x4*)(pr + PC_O + c);
            u32x4 oy, oh;
#pragma unroll
            for (int j = 0; j < 4; ++j) {
                oy[j] = pk2(yv[8 * i + 2 * j] * rs * in.ssd_norm_w[c + 2 * j], yv[8 * i + 2 * j + 1] * rs * in.ssd_norm_w[c + 2 * j + 1]);
                oh[j] = pk2(hv[8 * i + 2 * j] * hs[i] * in.ml_norm_w[c + 2 * j] * sigmf(bflo(ov[j])), hv[8 * i + 2 * j + 1] * hs[i] * in.ml_norm_w[c + 2 * j + 1] * sigmf(bfhi(ov[j]))); }
            bf16* dstp = scratch_out ? scratch_out + (size_t)row * 2048 : sc;
            *(u32x4*)(dstp + c) = oy; *(u32x4*)(dstp + 1024 + c) = oh; }
    }
}

template <int NB, class Idle>
__device__ __forceinline__ void phase_outproj(const bf16* A, int lda, int K, const bf16* Wt, int nrows, const float* xl, const float* xc, const float* modl, float* Xout,
                                              LAS unsigned char* lds, Idle&& idle) {
    constexpr int TL = NB * SEQ;
    const int MT = nrows / 256;
    for (int r = 0; r * (int)gridDim.x < MT * 8; ++r) {
        const int u = xcd_unit(r);
        if (u >= MT * 8) {
            idle(u - MT * 8, (r + 1) * (int)gridDim.x - MT * 8); continue; }
        int mt, nt; unit_tile(u, MT, 8, mt, nt);
        const bf16* arow[4];
#pragma unroll
        for (int i = 0; i < 4; ++i) arow[i] = A + (size_t)(mt * 256 + (otid() >> 3) + 64 * i) * lda;
        gemm_tile(arow, Wt + (size_t)nt * 128 * K, K, K, lds, [&](const f32x16 (&acc)[2][2], int wm, int wn, int lane) { stage_f32_128(acc, lds, wm, wn, lane); });
        __syncthreads();
        {
            const float* mv = modl + (size_t)mod_row<NB>(mt * 256) * 6144 + 2 * 1024 + nt * 128;
            const int t = otid(), piece = t & 31;
            const f32x4 m2 = *(const f32x4*)(mv + piece * 4);
#pragma unroll 4
            for (int it = 0; it < 16; ++it) { const int rl = it * 16 + (t >> 5), row = mt * 256 + rl;
                const f32x4 a = *(const LAS f32x4*)(lds + rl * CST_F32 + piece * 16);
                const float* srcp = (row < TL ? xl + (size_t)row * D : xc + (size_t)(row - TL) * D) + nt * 128 + piece * 4;
                const f32x4 xv = *(const f32x4*)srcp;
                f32x4 o;
#pragma unroll
                for (int j = 0; j < 4; ++j) o[j] = xv[j] + m2[j] * a[j];
                __builtin_nontemporal_store(o, (f32x4*)(Xout + (size_t)row * D + nt * 128 + piece * 4)); }
        }
        __syncthreads();
    }
}
}
namespace fx {
__device__ __forceinline__ int moe_prefix(const int* cnt, LAS int* pre  ) {
    __syncthreads();
    if (otid() < 64) {
        const int lane = otid();
        int v = lane < 32 ? (cnt[lane * 64] + 255) >> 8 : 0;
#pragma unroll
        for (int o = 1; o < 32; o <<= 1) { const int t = __shfl_up(v, o); if (lane >= o) v += t; }
        if (lane < 32) pre[lane + 1] = v;
        if (lane == 0) pre[0] = 0;
    }
    __syncthreads();
    return pre[32];
}
__device__ __forceinline__ int moe_find(const LAS int* pre, int t) { int e = 0;
#pragma unroll
    for (int i = 1; i < 32; ++i) e += (t >= pre[i]) ? 1 : 0;
    return e; }

__device__ __forceinline__ void phase_moe_up(const bf16* H2, const bf16* Wgu, const int* cnt, const int* list, int cap, const float* route_w, bf16* ACT, LAS unsigned char* lds) {
    LAS int* pre = (LAS int*)(lds + GEMM_LDS);
    const int ntile = moe_prefix(cnt, pre);
    for (int r = 0; r * (int)gridDim.x < ntile * 8; ++r) {
        const int u = xcd_unit(r); if (u >= ntile * 8) continue;
        const int t = u >> 3, nt = u & 7, e = moe_find(pre, t), mt = t - pre[e], ce = cnt[e * 64];
        const int* le = list + (size_t)e * cap + mt * 256;
        const int nvalid = ce - mt * 256;
        const bf16* arow[4];
#pragma unroll
        for (int i = 0; i < 4; ++i) { const int r = (otid() >> 3) + 64 * i; const int ent = le[r < nvalid ? r : 0]; arow[i] = H2 + (size_t)(ent >> 1) * D; }
        gemm_tile(arow, Wgu + (size_t)e * 1024 * 1024 + (size_t)nt * 128 * 1024, 1024, 1024, lds, [&](const f32x16 (&acc)[2][2], int wm, int wn, int lane) {
#pragma unroll
            for (int mi = 0; mi < 2; ++mi) { const int r = wm * 64 + mi * 32 + (lane & 31);
                const float w = r < nvalid ? route_w[le[r]] : 0.f;
                LAS unsigned char* rp = lds + r * CST_BF64 + (wn * 32 + 4 * (lane >> 5)) * 2;
#pragma unroll
                for (int g = 0; g < 4; ++g) { float v[4];
#pragma unroll
                    for (int j = 0; j < 4; ++j) v[j] = siluf(acc[mi][0][4 * g + j]) * acc[mi][1][4 * g + j] * w;
                    u32x2 o; o[0] = pk2(v[0], v[1]); o[1] = pk2(v[2], v[3]); *(LAS u32x2*)(rp + 8 * g * 2) = o; } }
        });
        __syncthreads();
        flush_bf16_64(lds, [&](int r) -> bf16* { return r < nvalid ? ACT + (size_t)le[r] * 512 + nt * 64 : nullptr; });
        __syncthreads();
    }
}
__device__ __forceinline__ void phase_moe_down(const bf16* ACT, const bf16* Wd, const int* cnt, const int* list, int cap, bf16* Y2, LAS unsigned char* lds) {
    LAS int* pre = (LAS int*)(lds + GEMM_LDS);
    const int ntile = moe_prefix(cnt, pre);
    for (int r = 0; r * (int)gridDim.x < ntile * 8; ++r) {
        const int u = xcd_unit(r); if (u >= ntile * 8) continue;
        const int t = u >> 3, nt = u & 7, e = moe_find(pre, t), mt = t - pre[e], ce = cnt[e * 64];
        const int* le = list + (size_t)e * cap + mt * 256;
        const int nvalid = ce - mt * 256;
        const bf16* arow[4];
#pragma unroll
        for (int i = 0; i < 4; ++i) { const int r = (otid() >> 3) + 64 * i; const int ent = le[r < nvalid ? r : 0]; arow[i] = ACT + (size_t)ent * 512; }
        gemm_tile(arow, Wd + (size_t)e * 1024 * 512 + (size_t)nt * 128 * 512, 512, 512, lds, [&](const f32x16 (&acc)[2][2], int wm, int wn, int lane) { stage_bf16_128(acc, lds, wm, wn, lane); });
        __syncthreads();
        flush_bf16_128(lds, [&](int r) -> bf16* { return r < nvalid ? Y2 + (size_t)le[r] * D + nt * 128 : nullptr; });
        __syncthreads();
    }
}

template <int NB>
__device__ __forceinline__ void phase_qkv(const bf16* H, const bf16* Wt, const float* qn, const float* kn, bf16* QKV, LAS unsigned char* lds) {
    constexpr int T = NB * (SEQ + CTXL), MT = T / 256;
    for (int r = 0; r * (int)gridDim.x < MT * 24; ++r) {
        const int u = xcd_unit(r); if (u >= MT * 24) continue;
        int mt, nt; unit_tile(u, MT, 24, mt, nt);
        const bf16* arow[4];
#pragma unroll
        for (int i = 0; i < 4; ++i) arow[i] = H + (size_t)(mt * 256 + (otid() >> 3) + 64 * i) * D;
        gemm_tile(arow, Wt + (size_t)nt * 128 * D, D, D, lds, [&](const f32x16 (&acc)[2][2], int wm, int wn, int lane) {
            const int which = nt >> 3;
#pragma unroll
            for (int mi = 0; mi < 2; ++mi) {
                float rs = 1.f;
                if (which < 2) { float ss = 0.f;
#pragma unroll
                    for (int ni = 0; ni < 2; ++ni)
#pragma unroll
                        for (int r = 0; r < 16; ++r) ss += acc[mi][ni][r] * acc[mi][ni][r];
                    ss += __shfl_xor(ss, 32);
                    rs = rsqrtf(ss * (1.f / 64.f) + 1e-6f) * (which == 0 ? 0.125f : 1.f); }
                const float* nwp = which == 0 ? qn : kn;
                LAS unsigned char* rp = lds + (wm * 64 + mi * 32 + (lane & 31)) * CST_BF + (wn * 64 + 4 * (lane >> 5)) * 2;
#pragma unroll
                for (int ni = 0; ni < 2; ++ni)
#pragma unroll
                    for (int g = 0; g < 4; ++g) { float v[4];
#pragma unroll
                        for (int j = 0; j < 4; ++j) { v[j] = acc[mi][ni][4 * g + j]; if (which < 2) v[j] *= rs * nwp[ni * 32 + 8 * g + 4 * (lane >> 5) + j]; }
                        u32x2 o; o[0] = pk2(v[0], v[1]); o[1] = pk2(v[2], v[3]); *(LAS u32x2*)(rp + (ni * 32 + 8 * g) * 2) = o; } }
        });
        __syncthreads();
        flush_bf16_128(lds, [&](int r) { return QKV + (size_t)(mt * 256 + r) * 3072 + nt * 128; });
        __syncthreads();
    }
}

__device__ __forceinline__ bf16x8 frag16_row(const LAS unsigned char* T, int RS, int r0, int c0, int lane) {
    return *(const LAS bf16x8*)(T + (r0 + (lane & 15)) * RS + (c0 + 8 * (lane >> 4)) * 2);
}
__device__ __forceinline__ bf16x8 frag16_vt(const LAS unsigned char* T, int RS, int kb, int c0, int lane) {
    const int g4 = lane >> 4, q = (lane & 15) >> 2, p = lane & 3;
    const unsigned a0 = (unsigned)(size_t)(T + (kb + 4 * g4 + q) * RS + (c0 + 4 * p) * 2);
    const unsigned a1 = a0 + 16 * RS;
    bf16x4 v0, v1;
    asm volatile("ds_read_b64_tr_b16 %0, %2\n\tds_read_b64_tr_b16 %1, %3\n\ts_waitcnt lgkmcnt(0)" : "=&v"(v0), "=&v"(v1) : "v"(a0), "v"(a1) : "memory");
    bf16x8 r; r[0] = v0[0]; r[1] = v0[1]; r[2] = v0[2]; r[3] = v0[3]; r[4] = v1[0]; r[5] = v1[1]; r[6] = v1[2]; r[7] = v1[3];
    return r;
}

__device__ __forceinline__ int att_off(int row, int ch) { return 256 * row + 16 * (ch ^ (((row & 3) << 2) | ((row >> 2) & 3))); }
__device__ __forceinline__ bf16x8 att_krow(const LAS unsigned char* T, int r0, int c0, int lane) {
    return *(const LAS bf16x8*)(T + att_off(r0 + (lane & 15), (c0 >> 3) + (lane >> 4)));
}
__device__ __forceinline__ unsigned att_vaddr(const LAS unsigned char* T, int row, int col) { return (unsigned)(size_t)(T + att_off(row, col >> 3) + (col & 7) * 2); }

template <bool LOCAL>
__device__ __forceinline__ void attn_group(const LAS unsigned char* Kt, const LAS unsigned char* Vt, int koff, int kb, int hsel, int lane, int g4,
                                           const bf16x8& q0, const bf16x8& q1, f32x4 (&oacc)[4], float& l_run,
                                           int cs, int c, int brow  , const LAS float* rp) {
    f32x4 s[2];
#pragma unroll
    for (int sb = 0; sb < 2; ++sb) { s[sb] = (f32x4){0.f, 0.f, 0.f, 0.f};
        s[sb] = mfma16(att_krow(Kt, koff + kb + 16 * sb, hsel * 64, lane), q0, s[sb]);
        s[sb] = mfma16(att_krow(Kt, koff + kb + 16 * sb, hsel * 64 + 32, lane), q1, s[sb]); }
    float ps = 0.f; float p[8];
#pragma unroll
    for (int sb = 0; sb < 2; ++sb)
#pragma unroll
        for (int j = 0; j < 4; ++j) {
            float e;
            if (LOCAL) { const int kc = kb + 16 * sb + 4 * g4 + j; const bool ok = kc >= cs && kc < cs + 16;
                e = ok ? __expf(s[sb][j] + rp[hsel * 465 + (ok ? brow + (kc - c + 15) : 0)] - 8.f) : 0.f; }
            else e = __expf(s[sb][j] - 8.f);
            p[4 * sb + j] = e; ps += e; }
    l_run += ps;
    u32x4 pu; pu[0] = pk2(p[0], p[1]); pu[1] = pk2(p[2], p[3]); pu[2] = pk2(p[4], p[5]); pu[3] = pk2(p[6], p[7]);
    const bf16x8 pf = __builtin_bit_cast(bf16x8, pu);
    bf16x4 tv[4][2];
    {
        const int q = (lane & 15) >> 2, p4 = lane & 3;
        const int vr = koff + kb + 4 * g4 + q, vc = hsel * 64 + 4 * p4;
        tr8(att_vaddr(Vt, vr, vc), att_vaddr(Vt, vr + 16, vc), att_vaddr(Vt, vr, vc + 16), att_vaddr(Vt, vr + 16, vc + 16),
            att_vaddr(Vt, vr, vc + 32), att_vaddr(Vt, vr + 16, vc + 32), att_vaddr(Vt, vr, vc + 48), att_vaddr(Vt, vr + 16, vc + 48),
            tv[0][0], tv[0][1], tv[1][0], tv[1][1], tv[2][0], tv[2][1], tv[3][0], tv[3][1]);
    }
#pragma unroll
    for (int db = 0; db < 4; ++db) oacc[db] = mfma16(tr_join(tv[db][0], tv[db][1]), pf, oacc[db]);
}

template <bool LOCAL>
__device__ __forceinline__ void attn_group2(const LAS unsigned char* Kt, const LAS unsigned char* Vt, int koff, int kb, int hsel, int lane, int g4,
                                            const bf16x8 (&q0)[2], const bf16x8 (&q1)[2], f32x4 (&oacc)[2][4], float (&l_run)[2],
                                            int cs, int c, int brow0, int brow1, const LAS float* rp) {
    bf16x8 kf[2][2];
#pragma unroll
    for (int sb = 0; sb < 2; ++sb) { kf[sb][0] = att_krow(Kt, koff + kb + 16 * sb, hsel * 64, lane); kf[sb][1] = att_krow(Kt, koff + kb + 16 * sb, hsel * 64 + 32, lane); }
    f32x4 s[2][2];
#pragma unroll
    for (int qr = 0; qr < 2; ++qr)
#pragma unroll
        for (int sb = 0; sb < 2; ++sb) { s[qr][sb] = (f32x4){0.f, 0.f, 0.f, 0.f};
            s[qr][sb] = mfma16(kf[sb][0], q0[qr], s[qr][sb]); s[qr][sb] = mfma16(kf[sb][1], q1[qr], s[qr][sb]); }
    bf16x8 pf[2];
#pragma unroll
    for (int qr = 0; qr < 2; ++qr) {
        float ps = 0.f; float p[8];
        const int brow = qr ? brow1 : brow0;
#pragma unroll
        for (int sb = 0; sb < 2; ++sb)
#pragma unroll
            for (int j = 0; j < 4; ++j) {
                float e;
                if (LOCAL) { const int kc = kb + 16 * sb + 4 * g4 + j; const bool ok = kc >= cs && kc < cs + 16;
                    const float bv = rp[hsel * 465 + (ok ? brow + (kc - c + 15) : 0)];
                    const float ex = __expf(s[qr][sb][j] + bv - 8.f);
                    e = ok ? ex : 0.f; }
                else e = __expf(s[qr][sb][j] - 8.f);
                p[4 * sb + j] = e; ps += e; }
        l_run[qr] += ps;
        u32x4 pu; pu[0] = pk2(p[0], p[1]); pu[1] = pk2(p[2], p[3]); pu[2] = pk2(p[4], p[5]); pu[3] = pk2(p[6], p[7]);
        pf[qr] = __builtin_bit_cast(bf16x8, pu);
    }
    bf16x4 tv[4][2];
    {
        const int q = (lane & 15) >> 2, p4 = lane & 3;
        const int vr = koff + kb + 4 * g4 + q, vc = hsel * 64 + 4 * p4;
        tr8(att_vaddr(Vt, vr, vc), att_vaddr(Vt, vr + 16, vc), att_vaddr(Vt, vr, vc + 16), att_vaddr(Vt, vr + 16, vc + 16),
            att_vaddr(Vt, vr, vc + 32), att_vaddr(Vt, vr + 16, vc + 32), att_vaddr(Vt, vr, vc + 48), att_vaddr(Vt, vr + 16, vc + 48),
            tv[0][0], tv[0][1], tv[1][0], tv[1][1], tv[2][0], tv[2][1], tv[3][0], tv[3][1]);
    }
#pragma unroll
    for (int db = 0; db < 4; ++db) { const bf16x8 vf = tr_join(tv[db][0], tv[db][1]);
        oacc[0][db] = mfma16(vf, pf[0], oacc[0][db]); oacc[1][db] = mfma16(vf, pf[1], oacc[1][db]); }
}

constexpr int ATT_QR = 2;
template <int NB>
__device__ __forceinline__ void phase_attn(const bf16* QKV, const float* rpb, bf16* AO, LAS unsigned char* lds) {
    constexpr int TL = NB * SEQ;
    constexpr int TILE = 128 * 256;
    const int tid = otid(), lane = tid & 63, wave = tid >> 6, w = wave & 3, hsel = wave >> 2;
    const int qi = lane & 15, g4 = lane >> 4;
    LAS float* rp = (LAS float*)(lds + 4 * TILE);
    constexpr int QR = ATT_QR, NRG = 64 / QR;
    for (int u = blockIdx.x; u < NB * NRG * 8; u += gridDim.x) {
        const int hp = u & 7, rg = (u >> 3) % NRG, b = (u >> 3) / NRG;
        const int head = 2 * hp + hsel;
        int R0 = QR * rg - 4; R0 = R0 < 0 ? 0 : (R0 > 56 ? 56 : R0);
        int R1 = QR * rg + QR - 1 - 4; R1 = (R1 < 0 ? 0 : (R1 > 56 ? 56 : R1)) + 7;
        const int nloc = R1 - R0 + 1, nl2 = (nloc + 1) >> 1, nit = nl2 + 2;
        __syncthreads();
        for (int i = tid; i < 2 * 465; i += NTHR) rp[i] = rpb[(size_t)(2 * hp) * 465 + i];
        const int c = 16 * w + qi;
        int cs = c - 8; cs = cs < 0 ? 0 : (cs > 48 ? 48 : cs);
        const int kbw = w == 0 ? 0 : (w == 1 ? 8 : (w == 2 ? 24 : 32));
        bf16x8 q0[QR], q1[QR]; f32x4 oacc[QR][4]; float l_run[QR];
#pragma unroll
        for (int qr = 0; qr < QR; ++qr) {
            const size_t qrow = (size_t)b * SEQ + (QR * rg + qr) * 64 + c;
            q0[qr] = *(const bf16x8*)(QKV + qrow * 3072 + head * 64 + 8 * g4); q1[qr] = *(const bf16x8*)(QKV + qrow * 3072 + head * 64 + 32 + 8 * g4);
#pragma unroll
            for (int i = 0; i < 4; ++i) oacc[qr][i] = (f32x4){0.f, 0.f, 0.f, 0.f};
            l_run[qr] = 0.f; }
        const int dkey = 4 * wave + (lane >> 4), dsrc = (lane & 15) ^ ((((lane >> 4) & 3) << 2) | (wave & 3));
#define AT_DMA(it, buf) do { LAS unsigned char* kt_ = lds + (buf) * 2 * TILE + wave * 1024 + lane * 16; \
        _Pragma("unroll") for (int j = 0; j < 4; ++j) { const int key = dkey + 32 * j; \
            int kr_ = R0 + 2 * (it) + (key >> 6); kr_ = kr_ > 63 ? 63 : kr_; \
            const size_t krow = (it) < nl2 ? (size_t)b * SEQ + (size_t)kr_ * 64 + (key & 63) : (size_t)TL + (size_t)b * CTXL + ((it) - nl2) * 128 + key; \
            const bf16* kp = QKV + krow * 3072 + 1024 + hp * 128 + dsrc * 8; \
            __builtin_amdgcn_global_load_lds((const unsigned*)kp, (LAS unsigned*)(kt_ + j * 8192), 16, 0, 0); \
            __builtin_amdgcn_global_load_lds((const unsigned*)(kp + 1024), (LAS unsigned*)(kt_ + TILE + j * 8192), 16, 0, 0); } } while (0)
        AT_DMA(0, 0);
        __syncthreads();
        for (int it = 0; it < nit; ++it) {
            const LAS unsigned char* Kt = lds + (it & 1) * 2 * TILE; const LAS unsigned char* Vt = Kt + TILE;
            if (it + 1 < nit) AT_DMA(it + 1, (it + 1) & 1);
            if (it < nl2) {
                static_assert(QR == 2, "attn_group2 pairs two query rows");
                const int ra = QR * rg, rb = ra + 1;
                int r0a = ra - 4; r0a = r0a < 0 ? 0 : (r0a > 56 ? 56 : r0a);
                int r0b = rb - 4; r0b = r0b < 0 ? 0 : (r0b > 56 ? 56 : r0b);
#pragma unroll 1
                for (int sub = 0; sub < 2; ++sub) {
                    const int kr = R0 + 2 * it + sub;
                    const bool ina = kr >= r0a && kr < r0a + 8, inb = kr >= r0b && kr < r0b + 8;
                    if (ina && inb) attn_group2<true>(Kt, Vt, 64 * sub, kbw, hsel, lane, g4, q0, q1, oacc, l_run, cs, c, (kr - ra + 7) * 31, (kr - rb + 7) * 31, rp);
                    else if (ina) attn_group<true>(Kt, Vt, 64 * sub, kbw, hsel, lane, g4, q0[0], q1[0], oacc[0], l_run[0], cs, c, (kr - ra + 7) * 31, rp);
                    else if (inb) attn_group<true>(Kt, Vt, 64 * sub, kbw, hsel, lane, g4, q0[1], q1[1], oacc[1], l_run[1], cs, c, (kr - rb + 7) * 31, rp);
                }
            } else {
#pragma unroll 1
                for (int g = 0; g < 4; ++g) attn_group2<false>(Kt, Vt, 0, 32 * g, hsel, lane, g4, q0, q1, oacc, l_run, 0, 0, 0, 0, rp);
            }
            __syncthreads();
        }
#undef AT_DMA
#pragma unroll
        for (int qr = 0; qr < QR; ++qr) {
            float l = l_run[qr]; l += __shfl_xor(l, 16); l += __shfl_xor(l, 32);
            const float inv = 1.f / l;
            const size_t qrow = (size_t)b * SEQ + (QR * rg + qr) * 64 + c;
            bf16* op = AO + qrow * D + head * 64 + 4 * g4;
#pragma unroll
            for (int db = 0; db < 4; ++db) { u32x2 o; o[0] = pk2(oacc[qr][db][0] * inv, oacc[qr][db][1] * inv); o[1] = pk2(oacc[qr][db][2] * inv, oacc[qr][db][3] * inv); *(u32x2*)(op + 16 * db) = o; }
        }
    }
}
}
namespace fx {
namespace g8 {
constexpr int BM = 256, BK = 64, HALF = 128, HTB = HALF * BK * 2, STAGE_BYTES = 8 * HTB;
__device__ __forceinline__ int lds_byte(int r, int c) { const int st = (r >> 4) * 2 + (c >> 5), rr = r & 15, cc = c & 31, ob = rr * 64 + cc * 2; return st * 1024 + (ob ^ (((ob >> 9) & 1) << 5)); }
__device__ __forceinline__ void stage_rc(int b, int& R, int& C) { const int st = b / 1024, sb = b % 1024, swz = sb ^ (((sb >> 9) & 1) << 5); R = (st >> 1) * 16 + swz / 64; C = (st & 1) * 32 + (swz % 64) / 2; }
__device__ __forceinline__ int perm32(int rho) { const int n = rho >> 4, i = rho & 15; return 8 * (i >> 2) + 4 * n + (i & 3); }
struct Unit { int pm, pn, i0; const int* p; };

template <class Epi, class Sched>
__device__ __forceinline__ void gemm_phase(LAS unsigned char* lds, int K, const Sched& S, const Epi& E) {
    const int tid = otid(), wid = __builtin_amdgcn_readfirstlane(tid >> 6), lane = tid & 63, wr = wid >> 2, wc = wid & 3, fr = lane & 15, fq = lane >> 4;
    const int nt = K / BK;
    int Rr[2], Cc[2]; unsigned voffB[2];
#pragma unroll
    for (int i = 0; i < 2; ++i) { int R, C; stage_rc(tid * 16 + i * 8192, R, C); Rr[i] = R; Cc[i] = C;
        const int Rb = Epi::PERM ? ((R & ~31) + perm32(R & 31)) : R; voffB[i] = (unsigned)(Rb * K + C) * 2u; }
    const size_t kstep = (size_t)(BK * 2);
    const size_t hstepB = (size_t)HALF * K * 2;
    const unsigned ldsw = (unsigned)wid * 1024u;
    const int aoff = lds_byte(wr * 64 + fr, fq * 8), boff = lds_byte(wc * 32 + fr, fq * 8);
#define G8_SA(b, h) (((b) * 2 + (h)) * HTB)
#define G8_SB(b, h) ((4 + (b) * 2 + (h)) * HTB)
#define G8_STAGE_B(bufoff, gbase) do { _Pragma("unroll") for (int _i = 0; _i < 2; ++_i) \
        __builtin_amdgcn_global_load_lds((const unsigned*)((const char*)(gbase) + voffB[_i]), (LAS unsigned*)(lds + (bufoff) + ldsw + _i * 8192), 16, 0, 0); } while (0)
#define G8_STAGE_A(bufoff, gbase, o0, o1) do { \
        __builtin_amdgcn_global_load_lds((const unsigned*)((const char*)(gbase) + (o0)), (LAS unsigned*)(lds + (bufoff) + ldsw), 16, 0, 0); \
        __builtin_amdgcn_global_load_lds((const unsigned*)((const char*)(gbase) + (o1)), (LAS unsigned*)(lds + (bufoff) + ldsw + 8192), 16, 0, 0); } while (0)
#define G8_LDA(dst, b, h) do { _Pragma("unroll") for (int m = 0; m < 4; ++m) _Pragma("unroll") for (int k = 0; k < 2; ++k) dst[m][k] = *(const LAS bf16x8*)(lds + G8_SA(b, h) + aoff + m * 2048 + k * 1024); } while (0)
#define G8_LDB(dst, b, h) do { _Pragma("unroll") for (int n = 0; n < 2; ++n) _Pragma("unroll") for (int k = 0; k < 2; ++k) dst[n][k] = *(const LAS bf16x8*)(lds + G8_SB(b, h) + boff + n * 2048 + k * 1024); } while (0)
#define G8_MMA(ai, bj, At, Bt) do { __builtin_amdgcn_s_setprio(1); _Pragma("unroll") for (int m = 0; m < 4; ++m) _Pragma("unroll") for (int n = 0; n < 2; ++n) _Pragma("unroll") for (int k = 0; k < 2; ++k) \
        acc[ai][bj][m][n] = __builtin_amdgcn_mfma_f32_16x16x32_bf16(Bt[n][k], At[m][k], acc[ai][bj][m][n], 0, 0, 0); __builtin_amdgcn_s_setprio(0); } while (0)
#define G8_WAIT_V(n) asm volatile("s_waitcnt vmcnt(" #n ")" ::: "memory")
#define G8_WAIT_L(n) asm volatile("s_waitcnt lgkmcnt(" #n ")" ::: "memory")
#define G8_BAR __builtin_amdgcn_s_barrier()
#define G8_SCHED __builtin_amdgcn_sched_barrier(0)
    Unit cur, nxt; int ui = 0;
    if (!S.next(0, cur)) return;
    f32x4 acc[2][2][4][2];
#pragma unroll
    for (int a = 0; a < 2; ++a)
#pragma unroll
        for (int b = 0; b < 2; ++b)
#pragma unroll
            for (int m = 0; m < 4; ++m)
#pragma unroll
                for (int n = 0; n < 2; ++n) acc[a][b][m][n] = (f32x4){0.f, 0.f, 0.f, 0.f};
    bf16x8 At[4][2], B0[2][2], B1[2][2];
    unsigned oaC[2][2], oaN[2][2]; const char* cAb; const char* cB; const char* nAb; const char* nB;
    S.src(cur, Rr, Cc, oaC, cAb, cB);
    G8_STAGE_B(G8_SB(0, 0), cB); G8_STAGE_A(G8_SA(0, 0), cAb, oaC[0][0], oaC[0][1]); G8_STAGE_B(G8_SB(0, 1), cB + hstepB); G8_STAGE_A(G8_SA(0, 1), cAb, oaC[1][0], oaC[1][1]);
    if (wr == 1) G8_BAR;
    G8_WAIT_V(4); G8_BAR;
    G8_STAGE_B(G8_SB(1, 0), cB + kstep); G8_STAGE_A(G8_SA(1, 0), cAb + kstep, oaC[0][0], oaC[0][1]); G8_STAGE_B(G8_SB(1, 1), cB + hstepB + kstep);
    G8_WAIT_V(6); G8_BAR;
    for (;;) {
        const bool has_next = S.next(ui + 1, nxt);
        if (has_next) S.src(nxt, Rr, Cc, oaN, nAb, nB);
        else { nAb = cAb; nB = cB;
#pragma unroll
            for (int h = 0; h < 2; ++h)
#pragma unroll
                for (int i = 0; i < 2; ++i) oaN[h][i] = oaC[h][i]; }
        for (int t = 0; t < nt; t += 2) {
            const bool last = (t == nt - 2);
            const char* a1 = cAb + (size_t)(t + 1) * kstep;
            const char* a2 = last ? nAb : cAb + (size_t)(t + 2) * kstep; const char* b2 = last ? nB : cB + (size_t)(t + 2) * kstep;
            const char* a3 = a2 + kstep; const char* b3 = b2 + kstep;
            const unsigned o00 = last ? oaN[0][0] : oaC[0][0], o01 = last ? oaN[0][1] : oaC[0][1], o10 = last ? oaN[1][0] : oaC[1][0], o11 = last ? oaN[1][1] : oaC[1][1];
            G8_LDB(B0, 0, 0); G8_SCHED; G8_LDA(At, 0, 0); G8_STAGE_A(G8_SA(1, 1), a1, oaC[1][0], oaC[1][1]);
            G8_WAIT_L(8); G8_BAR; G8_WAIT_L(0); G8_MMA(0, 0, At, B0); G8_BAR; G8_SCHED;
            G8_LDB(B1, 0, 1); G8_STAGE_B(G8_SB(0, 0), b2);
            G8_BAR; G8_WAIT_L(0); G8_MMA(0, 1, At, B1); G8_BAR;
            G8_LDA(At, 0, 1); G8_STAGE_A(G8_SA(0, 0), a2, o00, o01);
            G8_BAR; G8_WAIT_L(0); G8_MMA(1, 0, At, B0); G8_BAR; G8_SCHED;
            G8_STAGE_B(G8_SB(0, 1), b2 + hstepB);
            G8_WAIT_V(6); G8_BAR; G8_MMA(1, 1, At, B1); G8_BAR;
            G8_LDB(B0, 1, 0); G8_SCHED; G8_LDA(At, 1, 0); G8_STAGE_A(G8_SA(0, 1), a2, o10, o11);
            G8_WAIT_L(8); G8_BAR; G8_WAIT_L(0); G8_MMA(0, 0, At, B0); G8_BAR; G8_SCHED;
            G8_LDB(B1, 1, 1); G8_STAGE_B(G8_SB(1, 0), b3);
            G8_BAR; G8_WAIT_L(0); G8_MMA(0, 1, At, B1); G8_BAR;
            G8_LDA(At, 1, 1); G8_STAGE_A(G8_SA(1, 0), a3, o00, o01);
            G8_BAR; G8_WAIT_L(0); G8_MMA(1, 0, At, B0); G8_BAR; G8_SCHED;
            G8_STAGE_B(G8_SB(1, 1), b3 + hstepB);
            G8_WAIT_V(6); G8_BAR; G8_MMA(1, 1, At, B1); G8_BAR;
        }
        E(acc, cur, wr, wc, fr, fq);
        if (!has_next) break;
#pragma unroll
        for (int a = 0; a < 2; ++a)
#pragma unroll
            for (int b = 0; b < 2; ++b)
#pragma unroll
                for (int m = 0; m < 4; ++m)
#pragma unroll
                    for (int n = 0; n < 2; ++n) acc[a][b][m][n] = (f32x4){0.f, 0.f, 0.f, 0.f};
        cur = nxt; cAb = nAb; cB = nB; ++ui;
#pragma unroll
        for (int h = 0; h < 2; ++h)
#pragma unroll
            for (int i = 0; i < 2; ++i) oaC[h][i] = oaN[h][i];
    }
    G8_WAIT_V(0);
    if (wr == 0) G8_BAR;
    G8_BAR;
#undef G8_SA
#undef G8_SB
#undef G8_STAGE_A
#undef G8_STAGE_B
#undef G8_LDA
#undef G8_LDB
#undef G8_MMA
#undef G8_WAIT_V
#undef G8_WAIT_L
#undef G8_BAR
#undef G8_SCHED
}

struct DenseSched {
    const bf16* A; int lda; const bf16* Bt; int K; int MT, NT; int F;
    __device__ __forceinline__ bool next(int i, Unit& u) const { const int G = gridDim.x; if (i >= F || i * G >= MT * NT) return false; const int ul = xcd_unit(i); if (ul >= MT * NT) return false;
        int mt, nt_; unit_tile(ul, MT, NT, mt, nt_); u.pm = mt; u.pn = nt_; u.i0 = 0; u.p = nullptr; return true; }
    __device__ __forceinline__ void src(const Unit& u, const int (&R)[2], const int (&C)[2], unsigned (&oa)[2][2], const char*& abase, const char*& bbase) const {
        abase = (const char*)(A + (size_t)u.pm * 256 * lda); bbase = (const char*)(Bt + (size_t)u.pn * 256 * K);
#pragma unroll
        for (int h = 0; h < 2; ++h)
#pragma unroll
            for (int i = 0; i < 2; ++i) oa[h][i] = (unsigned)((128 * h + R[i]) * lda + C[i]) * 2u; }
};
}

struct EpiProj {
    static constexpr bool PERM = true;
    bf16* O; int ldc;
    __device__ __forceinline__ void operator()(const f32x4 (&acc)[2][2][4][2], const g8::Unit& u, int wr, int wc, int fr, int fq) const {
        const int row0 = u.pm * 256 + wr * 64 + fr, col0 = u.pn * 256 + wc * 32 + 8 * fq;
#pragma unroll
        for (int ai = 0; ai < 2; ++ai)
#pragma unroll
            for (int m = 0; m < 4; ++m) { bf16* rowp = O + (size_t)(row0 + ai * 128 + m * 16) * ldc + col0;
#pragma unroll
                for (int bj = 0; bj < 2; ++bj) { const f32x4 v0 = acc[ai][bj][m][0], v1 = acc[ai][bj][m][1];
                    u32x4 w; w[0] = pk2(v0[0], v0[1]); w[1] = pk2(v0[2], v0[3]); w[2] = pk2(v1[0], v1[1]); w[3] = pk2(v1[2], v1[3]);
                    *(u32x4*)(rowp + bj * 128) = w; } }
    }
};
template <int NB>
__device__ __forceinline__ void phase_inproj8(const bf16* H, const bf16* Wt, bf16* PROJ, float* GATES, LAS unsigned char* lds) {
    constexpr int T = NB * (SEQ + CTXL), MT = T / 256;
    g8::DenseSched S{H, D, Wt, D, MT, PROJW / 256, 1 << 20};
    EpiProj E{PROJ, PROJW};
    g8::gemm_phase(lds, D, S, E);
    for (int mt = blockIdx.x; mt < MT; mt += gridDim.x) {
        const bf16* arow[4];
#pragma unroll
        for (int i = 0; i < 4; ++i) arow[i] = H + (size_t)(mt * 256 + (otid() >> 3) + 64 * i) * D;
        gemm_tile(arow, Wt + (size_t)PROJW * D, D, D, lds, [&](const f32x16 (&acc)[2][2], int wm, int wn, int lane) {
            if (wn == 0) {
#pragma unroll
                for (int mi = 0; mi < 2; ++mi) { const int row = mt * 256 + wm * 64 + mi * 32 + (lane & 31);
#pragma unroll
                    for (int ni = 0; ni < 2; ++ni)
#pragma unroll
                        for (int g = 0; g < 4; ++g) { f32x4 o; o[0] = acc[mi][ni][4 * g]; o[1] = acc[mi][ni][4 * g + 1]; o[2] = acc[mi][ni][4 * g + 2]; o[3] = acc[mi][ni][4 * g + 3];
                            *(f32x4*)(GATES + (size_t)row * 64 + ni * 32 + 8 * g + 4 * (lane >> 5)) = o; } } }
        });
        __syncthreads();
    }
}
template <int NB, bool XIN_BF> struct EpiResid {
    static constexpr bool PERM = true;
    const float* xl; const float* xc; const float* modl; bf16* Xout;
    __device__ __forceinline__ void operator()(const f32x4 (&acc)[2][2][4][2], const g8::Unit& u, int wr, int wc, int fr, int fq) const {
        constexpr int TL = NB * SEQ;
        const float* mv = modl + (size_t)mod_row<NB>(u.pm * 256) * 6144 + 2 * 1024;
        const int col0 = u.pn * 256 + wc * 32 + 8 * fq;
#pragma unroll
        for (int ai = 0; ai < 2; ++ai)
#pragma unroll
            for (int m = 0; m < 4; ++m) { const int row = u.pm * 256 + ai * 128 + wr * 64 + m * 16 + fr;
                const size_t soff = (row < TL ? (size_t)row * D : (size_t)(row - TL) * D) + col0;
                bf16* dstp = Xout + (size_t)row * D + col0;
#pragma unroll
                for (int bj = 0; bj < 2; ++bj) { const int co = bj * 128;
                    f32x4 x0, x1;
                    if (XIN_BF) { const u32x4 t4 = *(const u32x4*)((const bf16*)(row < TL ? xl : xc) + soff + co);
                        x0 = (f32x4){bflo(t4[0]), bfhi(t4[0]), bflo(t4[1]), bfhi(t4[1])}; x1 = (f32x4){bflo(t4[2]), bfhi(t4[2]), bflo(t4[3]), bfhi(t4[3])}; }
                    else { const float* sp = (row < TL ? xl : xc) + soff + co; x0 = *(const f32x4*)sp; x1 = *(const f32x4*)(sp + 4); }
                    const f32x4 m0 = *(const f32x4*)(mv + col0 + co), m1 = *(const f32x4*)(mv + col0 + co + 4);
                    float o[8];
#pragma unroll
                    for (int j = 0; j < 4; ++j) { o[j] = x0[j] + m0[j] * acc[ai][bj][m][0][j]; o[4 + j] = x1[j] + m1[j] * acc[ai][bj][m][1][j]; }
                    u32x4 w; w[0] = pk2(o[0], o[1]); w[1] = pk2(o[2], o[3]); w[2] = pk2(o[4], o[5]); w[3] = pk2(o[6], o[7]);
                    *(u32x4*)(dstp + co) = w; } }
    }
};
template <int NB, bool XIN_BF, class Idle>
__device__ __forceinline__ void phase_outproj8(const bf16* A, int lda, int K, const bf16* Wt, int nrows, const float* xl, const float* xc, const float* modl, bf16* Xout, LAS unsigned char* lds, Idle&& idle) {
    constexpr int TL = NB * SEQ;
    const int MT = nrows / 256, U = MT * 4, G = gridDim.x, F = U / G, R = U - F * G;
    if (F > 0) { g8::DenseSched S{A, lda, Wt, K, MT, 4, F}; EpiResid<NB, XIN_BF> E{xl, xc, modl, Xout}; g8::gemm_phase(lds, K, S, E); }
    for (int r = 0; r * G < 2 * R; ++r) {
        const int hu = r * G + (int)blockIdx.x;
        if (hu >= 2 * R) { idle(hu - 2 * R, (r + 1) * G - 2 * R); continue; }
        int mt, nt2; unit_tile(F * G + (hu >> 1), MT, 4, mt, nt2);
        const int nt = 2 * nt2 + (hu & 1);
        const bf16* arow[4];
#pragma unroll
        for (int i = 0; i < 4; ++i) arow[i] = A + (size_t)(mt * 256 + (otid() >> 3) + 64 * i) * lda;
        gemm_tile(arow, Wt + (size_t)nt * 128 * K, K, K, lds, [&](const f32x16 (&acc)[2][2], int wm, int wn, int lane) { stage_f32_128(acc, lds, wm, wn, lane); });
        __syncthreads();
        {
            const float* mv = modl + (size_t)mod_row<NB>(mt * 256) * 6144 + 2 * 1024 + nt * 128;
            const int t = otid(), piece = t & 31;
            const f32x4 m2 = *(const f32x4*)(mv + piece * 4);
#pragma unroll 4
            for (int it = 0; it < 16; ++it) { const int rl = it * 16 + (t >> 5), row = mt * 256 + rl;
                const f32x4 a = *(const LAS f32x4*)(lds + rl * CST_F32 + piece * 16);
                const size_t soff = (row < TL ? (size_t)row * D : (size_t)(row - TL) * D) + nt * 128 + piece * 4;
                f32x4 xv;
                if (XIN_BF) { const u32x2 t2 = *(const u32x2*)((const bf16*)(row < TL ? xl : xc) + soff); xv = (f32x4){bflo(t2[0]), bfhi(t2[0]), bflo(t2[1]), bfhi(t2[1])}; }
                else xv = *(const f32x4*)((row < TL ? xl : xc) + soff);
                u32x2 o2; o2[0] = pk2(xv[0] + m2[0] * a[0], xv[1] + m2[1] * a[1]); o2[1] = pk2(xv[2] + m2[2] * a[2], xv[3] + m2[3] * a[3]);
                *(u32x2*)(Xout + (size_t)row * D + nt * 128 + piece * 4) = o2; }
        }
        __syncthreads();
    }
}
template <bool UP> struct MoeSched {
    const bf16* Abuf; const bf16* W; const int* cnt; const int* list; int cap; const LAS int* pre; int ntile; int F;
    static constexpr int KK = UP ? 1024 : 512;
    __device__ __forceinline__ bool next(int i, g8::Unit& u) const { const int G = gridDim.x; if (i >= F) return false; const int ul = xcd_unit(i); if (ul >= ntile * 4) return false;
        const int t = ul >> 2, e = moe_find(pre, t), mt = t - pre[e]; u.pm = e; u.pn = ul & 3; u.i0 = cnt[e * 64] - mt * 256; u.p = list + (size_t)e * cap + mt * 256; return true; }
    __device__ __forceinline__ void src(const g8::Unit& u, const int (&R)[2], const int (&C)[2], unsigned (&oa)[2][2], const char*& abase, const char*& bbase) const {
        abase = (const char*)Abuf; bbase = (const char*)(W + (size_t)u.pm * 1024 * KK + (size_t)u.pn * 256 * KK);
#pragma unroll
        for (int h = 0; h < 2; ++h)
#pragma unroll
            for (int i = 0; i < 2; ++i) { const int r = 128 * h + R[i]; const int ent = u.p[r < u.i0 ? r : 0];
                oa[h][i] = (unsigned)((UP ? (ent >> 1) * 1024 : ent * 512) + C[i]) * 2u; } }
};
struct EpiMoeUp8 {
    static constexpr bool PERM = true;
    const float* route_w; bf16* ACT;
    __device__ __forceinline__ void operator()(const f32x4 (&acc)[2][2][4][2], const g8::Unit& u, int wr, int wc, int fr, int fq) const {
#pragma unroll
        for (int ai = 0; ai < 2; ++ai)
#pragma unroll
            for (int m = 0; m < 4; ++m) { const int r = ai * 128 + wr * 64 + m * 16 + fr;
                if (r < u.i0) { const int ent = u.p[r]; const float w = route_w[ent];
                    float v[8];
#pragma unroll
                    for (int n = 0; n < 2; ++n)
#pragma unroll
                        for (int j = 0; j < 4; ++j) v[4 * n + j] = siluf(acc[ai][0][m][n][j]) * acc[ai][1][m][n][j] * w;
                    u32x4 o; o[0] = pk2(v[0], v[1]); o[1] = pk2(v[2], v[3]); o[2] = pk2(v[4], v[5]); o[3] = pk2(v[6], v[7]);
                    *(u32x4*)(ACT + (size_t)ent * 512 + u.pn * 128 + wc * 32 + 8 * fq) = o; } }
    }
};
struct EpiMoeDown8 {
    static constexpr bool PERM = true;
    bf16* Y2;
    __device__ __forceinline__ void operator()(const f32x4 (&acc)[2][2][4][2], const g8::Unit& u, int wr, int wc, int fr, int fq) const {
#pragma unroll
        for (int ai = 0; ai < 2; ++ai)
#pragma unroll
            for (int m = 0; m < 4; ++m) { const int r = ai * 128 + wr * 64 + m * 16 + fr;
                if (r < u.i0) { bf16* rowp = Y2 + (size_t)u.p[r] * D + u.pn * 256 + wc * 32 + 8 * fq;
#pragma unroll
                    for (int bj = 0; bj < 2; ++bj) { const f32x4 v0 = acc[ai][bj][m][0], v1 = acc[ai][bj][m][1];
                        u32x4 o; o[0] = pk2(v0[0], v0[1]); o[1] = pk2(v0[2], v0[3]); o[2] = pk2(v1[0], v1[1]); o[3] = pk2(v1[2], v1[3]);
                        *(u32x4*)(rowp + bj * 128) = o; } } }
    }
};
struct BRowGU { int s; __device__ __forceinline__ int operator()(int r) const { return ((r >> 5) & 1) * 128 + 64 * s + (r >> 6) * 32 + (r & 31); } };

__device__ __forceinline__ void phase_moe_up8(const bf16* H2, const bf16* Wgu, const int* cnt, const int* list, int cap, const float* route_w, bf16* ACT, LAS unsigned char* lds) {
    LAS int* pre = (LAS int*)(lds + GEMM_LDS);
    const int ntile = moe_prefix(cnt, pre);
    const int G = gridDim.x, U = ntile * 4, F = U / G, R = U - F * G;
    if (F > 0) { MoeSched<true> S{H2, Wgu, cnt, list, cap, pre, ntile, F}; EpiMoeUp8 E{route_w, ACT}; g8::gemm_phase(lds, 1024, S, E); }
    for (int r = 0; r * G < 2 * R; ++r) {
        const int hu = r * G + (int)blockIdx.x; if (hu >= 2 * R) continue;
        const int ul = F * G + (hu >> 1), s = hu & 1, t = ul >> 2, pn = ul & 3, e = moe_find(pre, t), mt = t - pre[e], ce = cnt[e * 64];
        const int* le = list + (size_t)e * cap + mt * 256;
        const int nvalid = ce - mt * 256;
        const bf16* arow[4];
#pragma unroll
        for (int i = 0; i < 4; ++i) { const int rr = (otid() >> 3) + 64 * i; const int ent = le[rr < nvalid ? rr : 0]; arow[i] = H2 + (size_t)(ent >> 1) * D; }
        gemm_tile(arow, Wgu + (size_t)e * 1024 * 1024 + (size_t)pn * 256 * 1024, 1024, 1024, lds, [&](const f32x16 (&acc)[2][2], int wm, int wn, int lane) {
#pragma unroll
            for (int mi = 0; mi < 2; ++mi) { const int rr = wm * 64 + mi * 32 + (lane & 31);
                const float w = rr < nvalid ? route_w[le[rr]] : 0.f;
                LAS unsigned char* rp = lds + rr * CST_BF64 + (wn * 32 + 4 * (lane >> 5)) * 2;
#pragma unroll
                for (int g = 0; g < 4; ++g) { float v[4];
#pragma unroll
                    for (int j = 0; j < 4; ++j) v[j] = siluf(acc[mi][0][4 * g + j]) * acc[mi][1][4 * g + j] * w;
                    u32x2 o; o[0] = pk2(v[0], v[1]); o[1] = pk2(v[2], v[3]); *(LAS u32x2*)(rp + 8 * g * 2) = o; } }
        }, BRowGU{s});
        __syncthreads();
        flush_bf16_64(lds, [&](int rr) -> bf16* { return rr < nvalid ? ACT + (size_t)le[rr] * 512 + pn * 128 + 64 * s : nullptr; });
        __syncthreads();
    }
}
__device__ __forceinline__ void phase_moe_down8(const bf16* ACT, const bf16* Wd, const int* cnt, const int* list, int cap, bf16* Y2, LAS unsigned char* lds) {
    LAS int* pre = (LAS int*)(lds + GEMM_LDS);
    const int ntile = moe_prefix(cnt, pre);
    const int G = gridDim.x, U = ntile * 4, F = U / G, R = U - F * G;
    if (F > 0) { MoeSched<false> S{ACT, Wd, cnt, list, cap, pre, ntile, F}; EpiMoeDown8 E{Y2}; g8::gemm_phase(lds, 512, S, E); }
    for (int r = 0; r * G < 2 * R; ++r) {
        const int hu = r * G + (int)blockIdx.x; if (hu >= 2 * R) continue;
        const int ul = F * G + (hu >> 1), t = ul >> 2, nt = 2 * (ul & 3) + (hu & 1), e = moe_find(pre, t), mt = t - pre[e], ce = cnt[e * 64];
        const int* le = list + (size_t)e * cap + mt * 256;
        const int nvalid = ce - mt * 256;
        const bf16* arow[4];
#pragma unroll
        for (int i = 0; i < 4; ++i) { const int rr = (otid() >> 3) + 64 * i; const int ent = le[rr < nvalid ? rr : 0]; arow[i] = ACT + (size_t)ent * 512; }
        gemm_tile(arow, Wd + (size_t)e * 1024 * 512 + (size_t)nt * 128 * 512, 512, 512, lds, [&](const f32x16 (&acc)[2][2], int wm, int wn, int lane) { stage_bf16_128(acc, lds, wm, wn, lane); });
        __syncthreads();
        flush_bf16_128(lds, [&](int rr) -> bf16* { return rr < nvalid ? Y2 + (size_t)le[rr] * D + nt * 128 : nullptr; });
        __syncthreads();
    }
}
struct EpiQKV8 {
    static constexpr bool PERM = true;
    const float* qn; const float* kn; bf16* QKV; LAS float* xbuf;
    __device__ __forceinline__ void operator()(const f32x4 (&acc)[2][2][4][2], const g8::Unit& u, int wr, int wc, int fr, int fq) const {
        const int which = u.pn >> 2, wid = wr * 4 + wc;
        float rs[2][4][2];
        if (which < 2) {
#pragma unroll
            for (int ai = 0; ai < 2; ++ai)
#pragma unroll
                for (int m = 0; m < 4; ++m)
#pragma unroll
                    for (int bj = 0; bj < 2; ++bj) { float ss = 0.f;
#pragma unroll
                        for (int n = 0; n < 2; ++n)
#pragma unroll
                            for (int j = 0; j < 4; ++j) ss += acc[ai][bj][m][n][j] * acc[ai][bj][m][n][j];
                        ss += __shfl_xor(ss, 16); ss += __shfl_xor(ss, 32);
                        rs[ai][m][bj] = ss;
                        if (fq == 0) xbuf[(wid * 16 + (ai * 4 + m) * 2 + bj) * 16 + fr] = ss; }
        }
        asm volatile("s_waitcnt lgkmcnt(0)" ::: "memory");
        __builtin_amdgcn_s_barrier();
        asm volatile("" ::: "memory");
        const float* nwp = which == 0 ? qn : kn;
        const int hc = (wc & 1) * 32 + 8 * fq;
#pragma unroll
        for (int ai = 0; ai < 2; ++ai)
#pragma unroll
            for (int m = 0; m < 4; ++m) { const int row = u.pm * 256 + ai * 128 + wr * 64 + m * 16 + fr;
                bf16* rowp = QKV + (size_t)row * 3072 + u.pn * 256 + wc * 32 + 8 * fq;
#pragma unroll
                for (int bj = 0; bj < 2; ++bj) { f32x4 v0 = acc[ai][bj][m][0], v1 = acc[ai][bj][m][1];
                    if (which < 2) {
                        const float tot = rs[ai][m][bj] + xbuf[((wid ^ 1) * 16 + (ai * 4 + m) * 2 + bj) * 16 + fr];
                        const float sc = rsqrtf(tot * (1.f / 64.f) + 1e-6f) * (which == 0 ? 0.125f : 1.f);
                        const f32x4 w0 = *(const f32x4*)(nwp + hc), w1 = *(const f32x4*)(nwp + hc + 4);
#pragma unroll
                        for (int j = 0; j < 4; ++j) { v0[j] *= sc * w0[j]; v1[j] *= sc * w1[j]; } }
                    u32x4 o; o[0] = pk2(v0[0], v0[1]); o[1] = pk2(v0[2], v0[3]); o[2] = pk2(v1[0], v1[1]); o[3] = pk2(v1[2], v1[3]);
                    *(u32x4*)(rowp + bj * 128) = o; } }
    }
};
template <int NB>
__device__ __forceinline__ void phase_qkv8(const bf16* H, const bf16* Wt, const float* qn, const float* kn, bf16* QKV, LAS unsigned char* lds) {
    constexpr int T = NB * (SEQ + CTXL), MT = T / 256, U = MT * 12;
    const int G = gridDim.x, F = U / G, R = U - F * G;
    if (F > 0) { g8::DenseSched S{H, D, Wt, D, MT, 12, F}; EpiQKV8 E{qn, kn, QKV, (LAS float*)(lds + g8::STAGE_BYTES)}; g8::gemm_phase(lds, D, S, E); }
    for (int r = 0; r * G < 2 * R; ++r) {
        const int hu = r * G + (int)blockIdx.x; if (hu >= 2 * R) continue;
        int mt, nt2; unit_tile(F * G + (hu >> 1), MT, 12, mt, nt2);
        const int nt = 2 * nt2 + (hu & 1);
        const bf16* arow[4];
#pragma unroll
        for (int i = 0; i < 4; ++i) arow[i] = H + (size_t)(mt * 256 + (otid() >> 3) + 64 * i) * D;
        gemm_tile(arow, Wt + (size_t)nt * 128 * D, D, D, lds, [&](const f32x16 (&acc)[2][2], int wm, int wn, int lane) {
            const int which = nt >> 3;
#pragma unroll
            for (int mi = 0; mi < 2; ++mi) {
                float rsv = 1.f;
                if (which < 2) { float ss = 0.f;
#pragma unroll
                    for (int ni = 0; ni < 2; ++ni)
#pragma unroll
                        for (int q = 0; q < 16; ++q) ss += acc[mi][ni][q] * acc[mi][ni][q];
                    ss += __shfl_xor(ss, 32);
                    rsv = rsqrtf(ss * (1.f / 64.f) + 1e-6f) * (which == 0 ? 0.125f : 1.f); }
                const float* nwp = which == 0 ? qn : kn;
                LAS unsigned char* rp = lds + (wm * 64 + mi * 32 + (lane & 31)) * CST_BF + (wn * 64 + 4 * (lane >> 5)) * 2;
#pragma unroll
                for (int ni = 0; ni < 2; ++ni)
#pragma unroll
                    for (int g = 0; g < 4; ++g) { float v[4];
#pragma unroll
                        for (int j = 0; j < 4; ++j) { v[j] = acc[mi][ni][4 * g + j]; if (which < 2) v[j] *= rsv * nwp[ni * 32 + 8 * g + 4 * (lane >> 5) + j]; }
                        u32x2 o; o[0] = pk2(v[0], v[1]); o[1] = pk2(v[2], v[3]); *(LAS u32x2*)(rp + (ni * 32 + 8 * g) * 2) = o; } }
        });
        __syncthreads();
        flush_bf16_128(lds, [&](int rr) { return QKV + (size_t)(mt * 256 + rr) * 3072 + nt * 128; });
        __syncthreads();
    }
}
}
#define XB_TMO      128
#define XB_XCNT(j)  (256  + 64 * (j))
#define XB_XSUB(j)  (1280 + 64 * (j))
#define XB_XGEN(j)  (2304 + 64 * (j))
#define XB_TOP      3328
#define XB_TOPGEN   3392
#define XCD_BAR_WORDS 3456
#define XB_SPIN_CAP (1u << 18)

__device__ __forceinline__ unsigned xb_ld(unsigned* p)              { return __hip_atomic_load(p, __ATOMIC_RELAXED, __HIP_MEMORY_SCOPE_AGENT); }
__device__ __forceinline__ unsigned xb_add(unsigned* p, unsigned v) { return __hip_atomic_fetch_add(p, v, __ATOMIC_RELAXED, __HIP_MEMORY_SCOPE_AGENT); }
__device__ __forceinline__ unsigned xb_xcc_id() { return (unsigned)__builtin_amdgcn_s_getreg((3 << 11) | 20) & 0xFu; }
#define XB_SPIN(cond, bar) do { unsigned _sp = 0; while (cond) { __builtin_amdgcn_s_sleep(1); \
    if ((++_sp & 255u) == 0u) { if (xb_ld(&(bar)[XB_TMO])) break; if (_sp > XB_SPIN_CAP) { atomicAdd(&(bar)[XB_TMO], 1u); break; } } } } while (0)

struct XcdBarrier {
    unsigned* bar; unsigned x;
    volatile LAS unsigned* st;
};

__device__ __forceinline__ XcdBarrier xcd_barrier_post(unsigned* bar, volatile LAS unsigned* st) {
    XcdBarrier b; b.bar = bar; b.x = xb_xcc_id(); b.st = st;
    if (threadIdx.x == 0) (void)xb_add(&bar[XB_XCNT(b.x)], 1u);
    return b;
}
__device__ __forceinline__ void xcd_barrier_complete(unsigned* bar, unsigned x, unsigned& nloc, unsigned& nx) {
    const unsigned G = gridDim.x * gridDim.y * gridDim.z;
    unsigned sum, cnt, mine, sp = 0u;
    for (;;) {
        sum = 0u; cnt = 0u; mine = 0u;
#pragma unroll
        for (unsigned j = 0; j < 16; ++j) { const unsigned c = xb_ld(&bar[XB_XCNT(j)]); sum += c; cnt += (c > 0u) ? 1u : 0u; mine = (j == x) ? c : mine; }
        if (sum == G) break;
        __builtin_amdgcn_s_sleep(1);
        if ((++sp & 255u) == 0u) { if (xb_ld(&bar[XB_TMO])) break; if (sp > XB_SPIN_CAP) { atomicAdd(&bar[XB_TMO], 1u); break; } }
    }
    nloc = mine > 0u ? mine : 1u; nx = cnt > 0u ? cnt : 1u;
}

__device__ __forceinline__ void xcd_barrier(const XcdBarrier& b) {
    asm volatile("s_waitcnt vmcnt(0)" ::: "memory");
    __syncthreads();
    if (threadIdx.x == 0) {
        unsigned* bar = b.bar;
        __builtin_amdgcn_s_waitcnt(0);
        unsigned nloc = b.st[0], nx = b.st[1];
        if (nloc == 0u) { xcd_barrier_complete(bar, b.x, nloc, nx); b.st[0] = nloc; b.st[1] = nx; }
        const unsigned old = xb_add(&bar[XB_XSUB(b.x)], 1u);
        const unsigned gen = old / nloc;
        if (old + 1u == (gen + 1u) * nloc) {
            __builtin_amdgcn_fence(__ATOMIC_RELEASE, "agent");
            asm volatile("s_waitcnt vmcnt(0)" ::: "memory");
            const unsigned og = xb_add(&bar[XB_TOP], 1u);
            const unsigned tg = og / nx;
            if (og + 1u == (tg + 1u) * nx) xb_add(&bar[XB_TOPGEN], 1u);
            else XB_SPIN(xb_ld(&bar[XB_TOPGEN]) == tg, bar);
            __builtin_amdgcn_fence(__ATOMIC_ACQUIRE, "agent");
            xb_add(&bar[XB_XGEN(b.x)], 1u);
            asm volatile("s_waitcnt vmcnt(0)" ::: "memory");
        } else {
            XB_SPIN(xb_ld(&bar[XB_XGEN(b.x)]) == gen, bar);
            __builtin_amdgcn_fence(__ATOMIC_ACQUIRE, "agent");
            asm volatile("s_waitcnt vmcnt(0)" ::: "memory");
        }
    }
    __syncthreads();
}
namespace mk {
using namespace fx;
constexpr int NB = 4;
typedef Plan<NB> PL;

__global__ void __launch_bounds__(512, 2) k_mega(P p) {
    extern __shared__ __attribute__((aligned(16))) unsigned char lds_raw[];
    LAS unsigned char* lds = (LAS unsigned char*)lds_raw;
    unsigned char* ws = p.ws;
    const In& in = p.in;
    LAS unsigned* xbw = (LAS unsigned*)(lds + LDS_BYTES - 16);
    if (threadIdx.x == 0) { xbw[0] = 0u; xbw[1] = 0u; xbw[2] = 0u; xbw[3] = 0u; }
    __syncthreads();
    XcdBarrier bar = xcd_barrier_post((unsigned*)(ws + PL::CTL_BAR), (volatile LAS unsigned*)xbw);
    float* modv = (float*)(ws + PL::MODV);
    const float* mod0 = modv; const float* mod1 = modv + 5 * 6144;
    bf16* H = (bf16*)(ws + PL::H);
    int* cnt0 = (int*)(ws + PL::CTL_CNT); int* cnt1 = cnt0 + 32 * 64;
    int* list = (int*)(ws + PL::LIST); float* rw = (float*)(ws + PL::RW);
    bf16* wmoe0 = (bf16*)(ws + PL::W_MOE0); bf16* wmoe1 = (bf16*)(ws + PL::W_MOE1);
    const size_t GU = (size_t)32 * 1024 * 1024;
    float* X1 = (float*)(ws + PL::X1); float* X2 = (float*)(ws + PL::X2); float* X3 = (float*)(ws + PL::X3);
    const float* X1c = (const float*)((const bf16*)X1 + PL::TL * D); const float* X2c = (const float*)((const bf16*)X2 + PL::TL * D);
#ifndef MOE1_EARLY
#define MOE1_EARLY 1792
#endif
#ifndef REPMASK
#define REPMASK 0
#endif
#ifndef XBAR
#define XBAR 0
#endif
#define PH(k, ...) { __VA_ARGS__; xcd_barrier(bar); if ((REPMASK >> (k)) & 1) { __VA_ARGS__; xcd_barrier(bar); } }
    PH(0, conv_small_weights(in, ws, PL::W_IN, PL::W_OUT, PL::W_QKV, PL::W_NAO, lds); mod_vectors(in, modv, lds); conv_moe_weights(in, 0, wmoe0, wmoe0 + GU, lds))
    for (int i = 0; i < XBAR; ++i) xcd_barrier(bar);
    PH(1, rows_phase<NB, false, false, true, false>(in.x, in.ctx, PL::T, nullptr, mod0, mod0, nullptr, nullptr, in.norm1_w, 0, 1, H,
                                              nullptr, nullptr, nullptr, nullptr, nullptr, nullptr, nullptr, 0, lds))
    phase_inproj8<NB>(H, (const bf16*)(ws + PL::W_IN), (bf16*)(ws + PL::PROJ), (float*)(ws + PL::GATES), lds);
    xcd_barrier(bar);
#ifdef GVAR
    phase_inproj_v<NB, GVAR>(H, (const bf16*)(ws + PL::W_IN), (bf16*)(ws + PL::PROJ), (float*)(ws + PL::GATES), lds, p.out == nullptr);
    xcd_barrier(bar);
#endif
    PH(3, phase_tables<NB>(in, (const float*)(ws + PL::GATES), ws + PL::H, lds); phase_conv<NB>((const bf16*)(ws + PL::PROJ), in.ab_conv_w, in.ab_conv_b, (bf16*)(ws + PL::XBC)))
    phase_scan<NB>((const bf16*)(ws + PL::PROJ), ws + PL::H, (const bf16*)(ws + PL::XBC), (bf16*)(ws + PL::SC), lds);
    xcd_barrier(bar);
#ifdef SCANMODE
    phase_scan<NB>((const bf16*)(ws + PL::PROJ), ws + PL::H, (const bf16*)(ws + PL::XBC), (bf16*)(ws + PL::SC), lds, p.out ? SCANMODE : 3);
    xcd_barrier(bar);
#endif
#ifdef REP5
    phase_mixer_out<NB>(in, (const bf16*)(ws + PL::PROJ), (const bf16*)(ws + PL::XBC), (bf16*)(ws + PL::SC), (bf16*)(ws + PL::W_MOE1));
    xcd_barrier(bar);
#endif
    phase_mixer_out<NB>(in, (const bf16*)(ws + PL::PROJ), (const bf16*)(ws + PL::XBC), (bf16*)(ws + PL::SC));
    xcd_barrier(bar);
    PH(6, phase_outproj8<NB, false>((const bf16*)(ws + PL::SC), 4096, 2048, (const bf16*)(ws + PL::W_OUT), PL::T, in.x, in.ctx, mod0, (bf16*)X1, lds,
        [&](int rank, int nidle) { conv_moe_weights(in, 1, wmoe1, wmoe1 + GU, lds, 0, MOE1_EARLY, rank, nidle); }))
    rows_phase<NB, false, false, true, true, true>(X1, X1c, PL::T, nullptr, mod0, mod0, nullptr, nullptr, in.norm2_w, 3, 4, H,
        in.moe_w_group, in.moe_b_group, in.moe_w_expert, in.moe_b_expert, rw, cnt0, list, (int)PL::T, lds);
    PH(7, conv_moe_weights(in, 1, wmoe1, wmoe1 + GU, lds, MOE1_EARLY, MOE_CONV_UNITS))
    PH(8, phase_moe_up8(H, wmoe0, cnt0, list, (int)PL::T, rw, (bf16*)(ws + PL::ACT), lds))
    PH(9, phase_moe_down8((const bf16*)(ws + PL::ACT), wmoe0 + GU, cnt0, list, (int)PL::T, (bf16*)(ws + PL::Y2), lds))
    PH(10, rows_phase<NB, true, true, true, false, true>(X1, X1c, PL::T, (const bf16*)(ws + PL::Y2), mod0, mod1, X2, nullptr, in.norm1_w + 1024, 0, 1, H,
        nullptr, nullptr, nullptr, nullptr, nullptr, nullptr, nullptr, 0, lds))
    PH(11, phase_qkv8<NB>(H, (const bf16*)(ws + PL::W_QKV), in.na_q_norm, in.na_k_norm, (bf16*)(ws + PL::QKV), lds))
    PH(12, phase_attn<NB>((const bf16*)(ws + PL::QKV), in.na_rpb, (bf16*)(ws + PL::AO), lds))
    PH(13, phase_outproj8<NB, true>((const bf16*)(ws + PL::AO), 1024, 1024, (const bf16*)(ws + PL::W_NAO), PL::TL, X2, X2c, mod1, (bf16*)X3, lds, [](int, int) {}))
    rows_phase<NB, false, false, true, true, true>(X3, X3, PL::TL, nullptr, mod1, mod1, nullptr, nullptr, in.norm2_w + 1024, 3, 4, H,
        in.moe_w_group + 1024 * 4, in.moe_b_group + 4, in.moe_w_expert + 1024 * 32, in.moe_b_expert + 32, rw, cnt1, list, (int)PL::T, lds);
    xcd_barrier(bar);
    PH(15, phase_moe_up8(H, wmoe1, cnt1, list, (int)PL::T, rw, (bf16*)(ws + PL::ACT), lds))
    PH(16, phase_moe_down8((const bf16*)(ws + PL::ACT), wmoe1 + GU, cnt1, list, (int)PL::T, (bf16*)(ws + PL::Y2), lds))
    rows_phase<NB, true, false, false, false, true>(X3, X3, PL::TL, (const bf16*)(ws + PL::Y2), mod1, mod1, nullptr, p.out, nullptr, 0, 0, nullptr,
        nullptr, nullptr, nullptr, nullptr, nullptr, nullptr, nullptr, 0, lds);
    if ((REPMASK >> 17) & 1) { xcd_barrier(bar); rows_phase<NB, true, false, false, false, true>(X3, X3, PL::TL, (const bf16*)(ws + PL::Y2), mod1, mod1, nullptr, p.out, nullptr, 0, 0, nullptr,
        nullptr, nullptr, nullptr, nullptr, nullptr, nullptr, nullptr, 0, lds); }
#undef PH
}
__global__ void k_fill(float* q, size_t n, float v) { size_t i = (size_t)blockIdx.x * 256 + threadIdx.x; if (i < n) q[i] = v; }
}

extern "C" void kernel_launch(void* const* d_in, const int* in_sizes, int n_in, void* d_out, int out_size, void* d_ws, size_t ws_size, hipStream_t stream) {
    static int grid = 0;
    if (grid == 0) {
        int dev = 0, cus = 0, per_cu = 0;
        (void)hipGetDevice(&dev);
        (void)hipDeviceGetAttribute(&cus, hipDeviceAttributeMultiprocessorCount, dev);
        if (hipFuncSetAttribute((const void*)mk::k_mega, hipFuncAttributeMaxDynamicSharedMemorySize, fx::LDS_BYTES) != hipSuccess) { grid = -1; }
        else {
            if (hipOccupancyMaxActiveBlocksPerMultiprocessor(&per_cu, (const void*)mk::k_mega, 512, fx::LDS_BYTES) != hipSuccess) per_cu = 0;
            (void)hipGetLastError();
            grid = per_cu >= 1 ? cus : -1;
        }
    }
    if (grid < 0 || n_in != 31 || mk::PL::END > ws_size) { mk::k_fill<<<(out_size + 255) / 256, 256, 0, stream>>>((float*)d_out, (size_t)out_size, 2.f); return; }
    (void)hipMemsetAsync((unsigned char*)d_ws + mk::PL::CTL, 0, mk::PL::CTL_BYTES, stream);
    fx::P fp;
    { const float** q = (const float**)&fp.in; for (int i = 0; i < 31; ++i) q[i] = (const float*)d_in[i]; }
    fp.ws = (unsigned char*)d_ws; fp.out = (float*)d_out;
    hipLaunchKernelGGL(mk::k_mega, dim3(grid), dim3(512), fx::LDS_BYTES, stream, fp);
}
```

```cpp
#include <hip/hip_runtime.h>
#include <cstdio>
#include <cstdint>
namespace fx {
#define LAS __attribute__((address_space(3)))
typedef unsigned short bf16;
typedef short bf16x8 __attribute__((ext_vector_type(8)));
typedef short bf16x4 __attribute__((ext_vector_type(4)));
typedef float f32x16 __attribute__((ext_vector_type(16)));
typedef float f32x4 __attribute__((ext_vector_type(4)));
typedef unsigned u32x4 __attribute__((ext_vector_type(4)));
typedef unsigned u32x2 __attribute__((ext_vector_type(2)));
constexpr int NTHR = 512, NWAVE = 8;
constexpr int D = 1024, SEQ = 4096, CTXL = 256;
constexpr int PROJW = 5632, NIN = 5760;
constexpr int PC_Z = 0, PC_XBC = 1024, PC_Q = 2560, PC_K = 3072, PC_V = 3584, PC_O = 4608;
constexpr int LDS_BYTES = 152 * 1024;

__device__ __forceinline__ int otid() { int t = threadIdx.x; asm volatile("" : "+v"(t)); return t; }
__device__ __forceinline__ float bf2f(bf16 v) { return __uint_as_float((unsigned)v << 16); }
__device__ __forceinline__ float bflo(unsigned u) { return __uint_as_float(u << 16); }
__device__ __forceinline__ float bfhi(unsigned u) { return __uint_as_float(u & 0xffff0000u); }
typedef __bf16 bf16x2_t __attribute__((ext_vector_type(2)));
typedef float f32x2_t __attribute__((ext_vector_type(2)));
__device__ __forceinline__ unsigned pk2(float lo, float hi) { const f32x2_t v = {lo, hi}; return __builtin_bit_cast(unsigned, __builtin_convertvector(v, bf16x2_t)); }
__device__ __forceinline__ float siluf(float v) { return v / (1.f + __expf(-v)); }
__device__ __forceinline__ float sigmf(float v) { return 1.f / (1.f + __expf(-v)); }
__device__ __forceinline__ float softplusf(float v) { return v > 20.f ? v : log1pf(__expf(v)); }
__device__ __forceinline__ float logsigf(float v) { return fminf(v, 0.f) - log1pf(__expf(-fabsf(v))); }
__device__ __forceinline__ float wave_sum(float v) {
#pragma unroll
    for (int o = 32; o > 0; o >>= 1) v += __shfl_xor(v, o);
    return v;
}
__device__ __forceinline__ float wave_max(float v) {
#pragma unroll
    for (int o = 32; o > 0; o >>= 1) v = fmaxf(v, __shfl_xor(v, o));
    return v;
}
__device__ __forceinline__ float rdlane(float v, int l) { return __int_as_float(__builtin_amdgcn_readlane(__float_as_int(v), l)); }
__device__ __forceinline__ void wave_sum4(float (&a)[4], int lane) {
    const bool h5 = (lane & 32) != 0, h4 = (lane & 16) != 0;
    float b0, b1;
    { const float s0 = h5 ? a[0] : a[2], s1 = h5 ? a[1] : a[3]; const float r0 = __shfl_xor(s0, 32), r1 = __shfl_xor(s1, 32);
      b0 = (h5 ? a[2] : a[0]) + r0; b1 = (h5 ? a[3] : a[1]) + r1; }
    float c = (h4 ? b1 : b0) + __shfl_xor(h4 ? b0 : b1, 16);
#pragma unroll
    for (int o = 8; o > 0; o >>= 1) c += __shfl_xor(c, o);
    a[0] = rdlane(c, 0); a[1] = rdlane(c, 16); a[2] = rdlane(c, 32); a[3] = rdlane(c, 48);
}
__device__ __forceinline__ void wave_sum8(float (&a)[8], int lane) {
    const bool h5 = (lane & 32) != 0, h4 = (lane & 16) != 0, h3 = (lane & 8) != 0;
    float b[4];
#pragma unroll
    for (int k = 0; k < 4; ++k) { const float snd = h5 ? a[k] : a[k + 4]; b[k] = (h5 ? a[k + 4] : a[k]) + __shfl_xor(snd, 32); }
    float c[2];
#pragma unroll
    for (int k = 0; k < 2; ++k) { const float snd = h4 ? b[k] : b[k + 2]; c[k] = (h4 ? b[k + 2] : b[k]) + __shfl_xor(snd, 16); }
    float d = (h3 ? c[1] : c[0]) + __shfl_xor(h3 ? c[0] : c[1], 8);
#pragma unroll
    for (int o = 4; o > 0; o >>= 1) d += __shfl_xor(d, o);
#pragma unroll
    for (int k = 0; k < 8; ++k) a[k] = rdlane(d, 8 * k);
}
__device__ __forceinline__ f32x16 mfma32(bf16x8 a, bf16x8 b, f32x16 c) { return __builtin_amdgcn_mfma_f32_32x32x16_bf16(a, b, c, 0, 0, 0); }
__device__ __forceinline__ f32x4 mfma16(bf16x8 a, bf16x8 b, f32x4 c) { return __builtin_amdgcn_mfma_f32_16x16x32_bf16(a, b, c, 0, 0, 0); }

__device__ __forceinline__ bf16x8 frag_row(const LAS unsigned char* T, int RS, int r0, int k0, int lane) {
    return *(const LAS bf16x8*)(T + (r0 + (lane & 31)) * RS + (k0 + 8 * (lane >> 5)) * 2);
}
__device__ __forceinline__ bf16x8 frag_col(const LAS unsigned char* T, int RS, int k0, int c0, int lane) {
    const int h = lane >> 5, blk = (lane >> 4) & 1, q = (lane & 15) >> 2, p = lane & 3;
    const unsigned a0 = (unsigned)(size_t)(T + (k0 + 8 * h + q) * RS + (c0 + 16 * blk + 4 * p) * 2);
    const unsigned a1 = a0 + 4 * RS;
    bf16x4 v0, v1;
    asm volatile("ds_read_b64_tr_b16 %0, %2\n\tds_read_b64_tr_b16 %1, %3\n\ts_waitcnt lgkmcnt(0)" : "=&v"(v0), "=&v"(v1) : "v"(a0), "v"(a1) : "memory");
    bf16x8 r; r[0] = v0[0]; r[1] = v0[1]; r[2] = v0[2]; r[3] = v0[3]; r[4] = v1[0]; r[5] = v1[1]; r[6] = v1[2]; r[7] = v1[3];
    return r;
}

struct In {
    const float *x, *c, *ctx, *c_ctx, *norm1_w, *norm2_w, *mod_w, *mod_b, *ab_w_in, *ab_conv_w, *ab_conv_b, *ssd_a_log, *ssd_dt_bias, *ssd_d,
        *ssd_norm_w, *ml_i_bias, *ml_f_bias, *ml_norm_w, *ab_w_out, *na_w_qkv, *na_q_norm, *na_k_norm, *na_rpb, *na_w_out,
        *moe_w_group, *moe_b_group, *moe_w_expert, *moe_b_expert, *moe_w_gate, *moe_w_up, *moe_w_down;
};

constexpr size_t cmax(size_t a, size_t b) { return a > b ? a : b; }
constexpr size_t al256(size_t x) { return (x + 255) & ~(size_t)255; }

template <int NB> struct Plan {
    static constexpr size_t TL = (size_t)NB * SEQ, TC = (size_t)NB * CTXL, T = TL + TC;
    static constexpr size_t CTL = 0;
    static constexpr size_t CTL_BAR = 0, CTL_CNT = 16384  , CTL_BYTES = 32768;
    static constexpr size_t MODV = CTL + CTL_BYTES;
    static constexpr size_t RW = MODV + al256(2 * 5 * 6144 * 4);
    static constexpr size_t LIST = RW + al256(2 * T * 4);
    static constexpr size_t W_IN = LIST + al256(32 * T * 4);
    static constexpr size_t W_OUT = W_IN + (size_t)NIN * 1024 * 2;
    static constexpr size_t W_QKV = W_OUT + (size_t)1024 * 2048 * 2;
    static constexpr size_t W_NAO = W_QKV + (size_t)3072 * 1024 * 2;
    static constexpr size_t ARENA = W_NAO + (size_t)1024 * 1024 * 2;
    static constexpr size_t MOEW = (size_t)32 * 1024 * 1024 * 2 + (size_t)32 * 1024 * 512 * 2;
    static constexpr size_t SZ_B = al256(T * 1024 * 2);
    static constexpr size_t SZ_A = al256(cmax(MOEW, cmax(T * 3072 * 2, T * 1024 * 4)));
    static constexpr size_t SZ_X = al256(T * 1024 * 4);
    static constexpr size_t SZ_C = al256(cmax(T * PROJW * 2 + T * 64 * 4, SZ_X + MOEW));
    static constexpr size_t SZ_D = al256(T * 1536 * 2);
    static constexpr size_t SZ_E = al256(T * 4096 * 2);
    static constexpr size_t RB = ARENA, RA = RB + SZ_B, RC = RA + SZ_A, RD = RC + SZ_C, RE = RD + SZ_D, END = RE + SZ_E;
    static constexpr size_t H = RB;
    static constexpr size_t W_MOE0 = RA;
    static constexpr size_t QKV = RA;
    static constexpr size_t X3 = RA;
    static constexpr size_t PROJ = RC;
    static constexpr size_t GATES = RC + T * PROJW * 2;
    static constexpr size_t X1 = RC;
    static constexpr size_t W_MOE1 = RC + SZ_X;
    static constexpr size_t XBC = RD;
    static constexpr size_t ACT = RD;
    static constexpr size_t AO = RD;
    static constexpr size_t SC = RE;
    static constexpr size_t Y2 = RE;
    static constexpr size_t X2 = RE + al256(2 * T * 1024 * 2);
    static_assert(2 * T * 1024 * 2 + T * 1024 * 4 <= SZ_E, "E");
    static_assert(T * 3072 * 2 <= SZ_A + SZ_X, "QKV spill");
};

struct P { In in; unsigned char* ws; float* out; };

template <int NB> __device__ __forceinline__ int mod_row(int row) { return row < NB * SEQ ? row / SEQ : 4; }

template <class ColPtr>
__device__ __forceinline__ void tconv_unit(ColPtr colptr, int ld_src, bf16* dst, int K, int k0, int n0, int ndst, LAS unsigned char* lds) {
    LAS float* tl = (LAS float*)lds;
    const int tid = otid();
    {
        const int n4 = (tid & 63) * 4, kb = tid >> 6;
        const float* sp = colptr(n0 + n4);
        f32x4 v[8];
#pragma unroll
        for (int i = 0; i < 8; ++i) v[i] = sp ? *(const f32x4*)(sp + (size_t)(k0 + kb + 8 * i) * ld_src) : (f32x4){0.f, 0.f, 0.f, 0.f};
#pragma unroll
        for (int i = 0; i < 8; ++i) *(LAS f32x4*)(tl + (kb + 8 * i) * 260 + n4) = v[i];
    }
    __syncthreads();
    {
        const int n = tid >> 1, half = tid & 1;
        if (n0 + n < ndst) {
            float v[32];
#pragma unroll
            for (int j = 0; j < 32; ++j) v[j] = tl[(half * 32 + j) * 260 + n];
            bf16* dp = dst + (size_t)(n0 + n) * K + k0 + half * 32;
#pragma unroll
            for (int q = 0; q < 4; ++q) { u32x4 o; o[0] = pk2(v[8 * q], v[8 * q + 1]); o[1] = pk2(v[8 * q + 2], v[8 * q + 3]); o[2] = pk2(v[8 * q + 4], v[8 * q + 5]); o[3] = pk2(v[8 * q + 6], v[8 * q + 7]);
                *(u32x4*)(dp + 8 * q) = o; }
        }
    }
    __syncthreads();
}

__device__ __forceinline__ int map_in(int n) { return n < 2560 ? n : (n < 5632 ? n + 32 : (n < 5664 ? n - 3072 : (n < 5680 ? n : -1))); }

__device__ __forceinline__ void conv_small_weights(const In& in, unsigned char* ws, size_t o_in, size_t o_out, size_t o_qkv, size_t o_nao, LAS unsigned char* lds) {
    const int total = 368 + 128 + 192 + 64;
    for (int u = blockIdx.x; u < total; u += gridDim.x) {
        if (u < 368) { const int kt = u % 16, nt = u / 16; const float* w = in.ab_w_in;
            tconv_unit([&](int n) -> const float* { const int c = n < NIN ? map_in(n) : -1; return c >= 0 ? w + c : nullptr; }, 5680, (bf16*)(ws + o_in), 1024, kt * 64, nt * 256, NIN, lds); }
        else if (u < 496) { const int v = u - 368, kt = v % 32, nt = v / 32; const float* w = in.ab_w_out;
            tconv_unit([&](int n) { return w + n; }, 1024, (bf16*)(ws + o_out), 2048, kt * 64, nt * 256, 1024, lds); }
        else if (u < 688) { const int v = u - 496, kt = v % 16, nt = v / 16; const float* w = in.na_w_qkv;
            tconv_unit([&](int n) { return w + n; }, 3072, (bf16*)(ws + o_qkv), 1024, kt * 64, nt * 256, 3072, lds); }
        else { const int v = u - 688, kt = v % 16, nt = v / 16; const float* w = in.na_w_out;
            tconv_unit([&](int n) { return w + n; }, 1024, (bf16*)(ws + o_nao), 1024, kt * 64, nt * 256, 1024, lds); }
    }
}

constexpr int MOE_CONV_UNITS = 3072;
__device__ __forceinline__ void conv_moe_weights(const In& in, int layer, bf16* wgu, bf16* wd, LAS unsigned char* lds, int begin = 0, int end = MOE_CONV_UNITS, int rank = -1, int stride = 0) {
    if (rank < 0) { rank = blockIdx.x; stride = gridDim.x; }
    const size_t wsz = (size_t)1024 * 512;
    for (int u = begin + rank; u < end; u += stride) {
        if (u < 2048) {
            const int e = u >> 6, v = u & 63, kt = v & 15, nt = v >> 4;
            const float* g = in.moe_w_gate + ((size_t)layer * 32 + e) * wsz; const float* up = in.moe_w_up + ((size_t)layer * 32 + e) * wsz;
            tconv_unit([&](int n) { const int f = (n >> 8) * 128 + (n & 127); return ((n & 128) ? up : g) + f; }, 512, wgu + (size_t)e * 1024 * 1024, 1024, kt * 64, nt * 256, 1024, lds);
        } else {
            const int w = u - 2048, e = w >> 5, v = w & 31, kt = v & 7, nt = v >> 3;
            const float* dsrc = in.moe_w_down + ((size_t)layer * 32 + e) * wsz;
            tconv_unit([&](int n) { return dsrc + n; }, 1024, wd + (size_t)e * 1024 * 512, 512, kt * 64, nt * 256, 1024, lds);
        }
    }
}

__device__ __forceinline__ void mod_vectors(const In& in, float* modv, LAS unsigned char* lds) {
    LAS float* sc = (LAS float*)lds;
    LAS float* red = sc + 5 * 1024;
    const int tid = otid();
    for (int i = tid; i < 5 * 1024; i += NTHR) { const int r = i >> 10, k = i & 1023; const float v = r < 4 ? in.c[r * 1024 + k] : in.c_ctx[k]; sc[i] = siluf(v); }
    __syncthreads();
    const int col = tid & 31, kq = tid >> 5;
    for (int u = blockIdx.x; u < 2 * 192; u += gridDim.x) {
        const int layer = u / 192, c0 = (u % 192) * 32;
        const float* w = in.mod_w + (size_t)layer * 1024 * 6144 + c0 + col;
        float a0 = 0.f, a1 = 0.f, a2 = 0.f, a3 = 0.f, a4 = 0.f;
#pragma unroll 8
        for (int j = 0; j < 64; ++j) { const int k = kq + 16 * j; const float wv = w[(size_t)k * 6144];
            a0 += sc[k] * wv; a1 += sc[1024 + k] * wv; a2 += sc[2048 + k] * wv; a3 += sc[3072 + k] * wv; a4 += sc[4096 + k] * wv; }
        red[(0 * 16 + kq) * 32 + col] = a0; red[(1 * 16 + kq) * 32 + col] = a1; red[(2 * 16 + kq) * 32 + col] = a2;
        red[(3 * 16 + kq) * 32 + col] = a3; red[(4 * 16 + kq) * 32 + col] = a4;
        __syncthreads();
        if (tid < 160) { const int r = tid >> 5, cc = tid & 31; float s = 0.f;
#pragma unroll
            for (int q = 0; q < 16; ++q) s += red[(r * 16 + q) * 32 + cc];
            modv[((size_t)layer * 5 + r) * 6144 + c0 + cc] = s + in.mod_b[layer * 6144 + c0 + cc]; }
        __syncthreads();
    }
}

template <int NB, bool COMBINE, bool XOUT, bool NORM, bool ROUTER, bool XBF = false>
__device__ __forceinline__ void rows_phase(const float* xl, const float* xc, int nrows, const bf16* y2, const float* modc  , const float* modl  ,
                                           float* xout, float* out_final, const float* nw, int shift_i, int scale_i, bf16* hout,
                                           const float* wg, const float* bg, const float* we, const float* be, float* route_w, int* cnt, int* list, int cap,
                                           LAS unsigned char* lds) {
    constexpr int TL = NB * SEQ;
    const int tid = otid(), lane = tid & 63, wave = tid >> 6;
    LAS float* wt = (LAS float*)lds;
    constexpr int WTS = 1028;
    LAS int* lcnt = (LAS int*)(lds + 36 * WTS * 4); LAS int* lbase = lcnt + 32; LAS int* rinfo = lcnt + 64;
    if (ROUTER) {
        if (tid < 32) lcnt[tid] = 0;
        for (int i = tid; i < 4 * 1024; i += NTHR) wt[(i & 3) * WTS + (i >> 2)] = wg[i];
        for (int i = tid; i < 32 * 1024; i += NTHR) wt[(4 + (i & 31)) * WTS + (i >> 5)] = we[i];
        __syncthreads();
    }
    int lrow = wave;
    for (int row = blockIdx.x * NWAVE + wave; row < nrows; row += gridDim.x * NWAVE, lrow += NWAVE) {
        const size_t soff = row < TL ? (size_t)row * D : (size_t)(row - TL) * D;
        const float* src = (row < TL ? xl : xc) + (XBF ? 0 : soff);
        const float* mv = modl + (size_t)mod_row<NB>(row) * 6144;
        const float* mvc = modc + (size_t)mod_row<NB>(row) * 6144;
        f32x4 v[4];
#pragma unroll
        for (int i = 0; i < 4; ++i) {
            if (XBF) { const u32x2 t2 = *(const u32x2*)((const bf16*)src + soff + lane * 4 + 256 * i); v[i] = (f32x4){bflo(t2[0]), bfhi(t2[0]), bflo(t2[1]), bfhi(t2[1])}; }
            else v[i] = *(const f32x4*)(src + lane * 4 + 256 * i); }
        if (COMBINE) {
#pragma unroll
            for (int i = 0; i < 4; ++i) { const int c = lane * 4 + 256 * i;
                const u32x2 ya = *(const u32x2*)(y2 + (size_t)(2 * row) * D + c), yb = *(const u32x2*)(y2 + (size_t)(2 * row + 1) * D + c);
                const f32x4 m5 = *(const f32x4*)(mvc + 5 * 1024 + c);
                v[i][0] += m5[0] * (bflo(ya[0]) + bflo(yb[0])); v[i][1] += m5[1] * (bfhi(ya[0]) + bfhi(yb[0]));
                v[i][2] += m5[2] * (bflo(ya[1]) + bflo(yb[1])); v[i][3] += m5[3] * (bfhi(ya[1]) + bfhi(yb[1])); }
            if (XOUT) {
#pragma unroll
                for (int i = 0; i < 4; ++i) {
                    if (XBF) { u32x2 o2; o2[0] = pk2(v[i][0], v[i][1]); o2[1] = pk2(v[i][2], v[i][3]); *(u32x2*)((bf16*)xout + (size_t)row * D + lane * 4 + 256 * i) = o2;
                        v[i] = (f32x4){bflo(o2[0]), bfhi(o2[0]), bflo(o2[1]), bfhi(o2[1])}; }
                    else *(f32x4*)(xout + (size_t)row * D + lane * 4 + 256 * i) = v[i]; } }
            if (out_final) {
#pragma unroll
                for (int i = 0; i < 4; ++i) *(f32x4*)(out_final + (size_t)row * D + lane * 4 + 256 * i) = v[i]; }
        }
        if (NORM) {
            float ss = 0.f;
#pragma unroll
            for (int i = 0; i < 4; ++i) ss += v[i][0] * v[i][0] + v[i][1] * v[i][1] + v[i][2] * v[i][2] + v[i][3] * v[i][3];
            ss = wave_sum(ss);
            const float rs = rsqrtf(ss * (1.f / D) + 1e-6f);
            f32x4 hv[4];
#pragma unroll
            for (int i = 0; i < 4; ++i) { const int c = lane * 4 + 256 * i;
                const f32x4 w4 = *(const f32x4*)(nw + c), sc4 = *(const f32x4*)(mv + scale_i * 1024 + c), sh4 = *(const f32x4*)(mv + shift_i * 1024 + c);
#pragma unroll
                for (int j = 0; j < 4; ++j) hv[i][j] = v[i][j] * rs * w4[j] * (1.f + sc4[j]) + sh4[j];
                u32x2 o; o[0] = pk2(hv[i][0], hv[i][1]); o[1] = pk2(hv[i][2], hv[i][3]);
                *(u32x2*)(hout + (size_t)row * D + c) = o; }
            if (ROUTER) {
                float lg[4];
#pragma unroll
                for (int j = 0; j < 4; ++j) { float a = 0.f;
#pragma unroll
                    for (int i = 0; i < 4; ++i) { const f32x4 w4 = *(const LAS f32x4*)(wt + j * WTS + lane * 4 + 256 * i);
                        a += hv[i][0] * w4[0] + hv[i][1] * w4[1] + hv[i][2] * w4[2] + hv[i][3] * w4[3]; }
                    lg[j] = a; }
                wave_sum4(lg, lane);
#pragma unroll
                for (int j = 0; j < 4; ++j) lg[j] += bg[j];
                int gi = 0; float gm = lg[0];
#pragma unroll
                for (int j = 1; j < 4; ++j) if (lg[j] > gm) { gm = lg[j]; gi = j; }
                float gs = 0.f;
#pragma unroll
                for (int j = 0; j < 4; ++j) gs += __expf(lg[j] - gm);
                const float gprob = 1.f / gs;
                float le[8];
#pragma unroll
                for (int j = 0; j < 8; ++j) { float a = 0.f; const LAS float* wr = wt + (4 + gi * 8 + j) * WTS + lane * 4;
#pragma unroll
                    for (int i = 0; i < 4; ++i) { const f32x4 w4 = *(const LAS f32x4*)(wr + 256 * i);
                        a += hv[i][0] * w4[0] + hv[i][1] * w4[1] + hv[i][2] * w4[2] + hv[i][3] * w4[3]; }
                    le[j] = a; }
                wave_sum8(le, lane);
#pragma unroll
                for (int j = 0; j < 8; ++j) le[j] += be[gi * 8 + j];
                int e0 = 0; float m0 = le[0];
#pragma unroll
                for (int j = 1; j < 8; ++j) if (le[j] > m0) { m0 = le[j]; e0 = j; }
                int e1 = 0; float m1 = -3.0e38f;
#pragma unroll
                for (int j = 0; j < 8; ++j) if (j != e0 && le[j] > m1) { m1 = le[j]; e1 = j; }
                const float p1 = __expf(m1 - m0);
                if (lane == 0) {
                    const int ge0 = gi * 8 + e0, ge1 = gi * 8 + e1;
                    route_w[2 * row] = gprob / (1.f + p1); route_w[2 * row + 1] = gprob * p1 / (1.f + p1);
                    const int s0 = atomicAdd((int*)&lcnt[ge0], 1), s1 = atomicAdd((int*)&lcnt[ge1], 1);
                    rinfo[2 * lrow] = (ge0 << 16) | s0; rinfo[2 * lrow + 1] = (ge1 << 16) | s1;
                }
            }
        }
    }
    if (ROUTER) {
        __syncthreads();
        if (tid < 32) { const int c = lcnt[tid]; lbase[tid] = c ? atomicAdd(&cnt[tid * 64], c) : 0; }
        __syncthreads();
        int lrow = wave;
        for (int row = blockIdx.x * NWAVE + wave; row < nrows; row += gridDim.x * NWAVE, lrow += NWAVE) {
            if (lane < 2) { const int ri = rinfo[2 * lrow + lane], ge = ri >> 16, sl = ri & 0xffff; list[(size_t)ge * cap + lbase[ge] + sl] = 2 * row + lane; }
        }
        __syncthreads();
    }
}

__device__ __forceinline__ int xcd_unit(int r) { const int G = gridDim.x, bx = blockIdx.x; return G == 256 ? ((r * 8 + (bx & 7)) * 32 + (bx >> 3)) : r * G + bx; }
__device__ __forceinline__ void unit_tile(int u, int MT, int NT, int& mt, int& nt) {
    if ((MT & 3) == 0) { const int band = u / (4 * NT), w = u - band * 4 * NT; nt = w >> 2; mt = band * 4 + (w & 3); }
    else { mt = u / NT; nt = u - mt * NT; }
}
constexpr int GEMM_STAGE = 256 * 128 + 128 * 128;
constexpr int GEMM_LDS = 3 * GEMM_STAGE;
__device__ __forceinline__ int sw_off(int row, int chunk) { return row * 128 + ((chunk ^ ((row >> 1) & 7)) << 4); }

struct BRowId { __device__ __forceinline__ int operator()(int r) const { return r; } };
template <int VAR = 0, class Epi, class BRow = BRowId>
__device__ __forceinline__ void gemm_tile(const bf16* const (&arow)[4], const bf16* bt  , int ldb, int K, LAS unsigned char* lds, Epi&& epi, BRow brow = BRow()) {
    const int tid = otid(), lane = tid & 63, wave = tid >> 6, wm = wave >> 1, wn = wave & 1;
    const int r8 = tid >> 3;
    const int schunk = (lane & 7) ^ ((r8 >> 1) & 7);
    const bf16* ga[4]; const bf16* gb[2];
#pragma unroll
    for (int i = 0; i < 4; ++i) ga[i] = arow[i] + schunk * 8;
#pragma unroll
    for (int i = 0; i < 2; ++i) gb[i] = bt + (size_t)brow(r8 + 64 * i) * ldb + schunk * 8;
    f32x16 acc[2][2];
#pragma unroll
    for (int mi = 0; mi < 2; ++mi)
#pragma unroll
        for (int ni = 0; ni < 2; ++ni)
#pragma unroll
            for (int r = 0; r < 16; ++r) acc[mi][ni][r] = 0.f;
#define G_DMA(t, st) do { LAS unsigned char* sa_ = lds + (st) * GEMM_STAGE + wave * 1024 + lane * 16; \
    _Pragma("unroll") for (int i = 0; i < 4; ++i) __builtin_amdgcn_global_load_lds((const unsigned*)(ga[i] + (t) * 64), (LAS unsigned*)(sa_ + i * 8192), 16, 0, 0); \
    _Pragma("unroll") for (int i = 0; i < 2; ++i) __builtin_amdgcn_global_load_lds((const unsigned*)(gb[i] + (t) * 64), (LAS unsigned*)(sa_ + 256 * 128 + i * 8192), 16, 0, 0); } while (0)
    const int KT = K >> 6;
    G_DMA(0, 0);
    G_DMA(1, 1);
    asm volatile("s_waitcnt vmcnt(6)" ::: "memory");
    __builtin_amdgcn_s_barrier();
    asm volatile("" ::: "memory");
    int st = 0;
    for (int kt = 0; kt < KT; ++kt) {
        const int st2 = st >= 1 ? st - 1 : 2;
        if (VAR != 2) { if (kt + 2 < KT) G_DMA(kt + 2, st2); }
        const LAS unsigned char* sa = lds + st * GEMM_STAGE; const LAS unsigned char* sb = sa + 256 * 128;
        bf16x8 af[2], bfr[2];
        if (VAR == 1) {
#pragma unroll
            for (int mi = 0; mi < 2; ++mi) af[mi] = *(const LAS bf16x8*)(sa + sw_off(wm * 64 + mi * 32 + (lane & 31), (lane >> 5)));
#pragma unroll
            for (int ni = 0; ni < 2; ++ni) bfr[ni] = *(const LAS bf16x8*)(sb + sw_off(wn * 64 + ni * 32 + (lane & 31), (lane >> 5)));
        }
#pragma unroll
        for (int kk = 0; kk < 4; ++kk) {
            if (VAR != 1) {
#pragma unroll
            for (int mi = 0; mi < 2; ++mi) af[mi] = *(const LAS bf16x8*)(sa + sw_off(wm * 64 + mi * 32 + (lane & 31), 2 * kk + (lane >> 5)));
#pragma unroll
            for (int ni = 0; ni < 2; ++ni) bfr[ni] = *(const LAS bf16x8*)(sb + sw_off(wn * 64 + ni * 32 + (lane & 31), 2 * kk + (lane >> 5)));
            }
            if (VAR == 3) {
#pragma unroll
                for (int mi = 0; mi < 2; ++mi) acc[mi][0][kk] += __builtin_bit_cast(f32x4, af[mi])[0] + __builtin_bit_cast(f32x4, bfr[mi])[1];
            } else {
#pragma unroll
            for (int mi = 0; mi < 2; ++mi)
#pragma unroll
                for (int ni = 0; ni < 2; ++ni) acc[mi][ni] = mfma32(bfr[ni], af[mi], acc[mi][ni]);
            }
        }
        if (kt + 2 < KT) asm volatile("s_waitcnt vmcnt(6)" ::: "memory"); else asm volatile("s_waitcnt vmcnt(0)" ::: "memory");
        __builtin_amdgcn_s_barrier();
        asm volatile("" ::: "memory");
        st = st == 2 ? 0 : st + 1;
    }
#undef G_DMA
    epi(acc, wm, wn, lane);
}

constexpr int CST_BF = 272, CST_BF64 = 144, CST_F32 = 528;
__device__ __forceinline__ void stage_bf16_128(const f32x16 (&acc)[2][2], LAS unsigned char* lds, int wm, int wn, int lane) {
#pragma unroll
    for (int mi = 0; mi < 2; ++mi) { LAS unsigned char* rp = lds + (wm * 64 + mi * 32 + (lane & 31)) * CST_BF + (wn * 64 + 4 * (lane >> 5)) * 2;
#pragma unroll
        for (int ni = 0; ni < 2; ++ni)
#pragma unroll
            for (int g = 0; g < 4; ++g) { u32x2 o; o[0] = pk2(acc[mi][ni][4 * g], acc[mi][ni][4 * g + 1]); o[1] = pk2(acc[mi][ni][4 * g + 2], acc[mi][ni][4 * g + 3]);
                *(LAS u32x2*)(rp + (ni * 32 + 8 * g) * 2) = o; } }
}
template <class RowPtr>
__device__ __forceinline__ void flush_bf16_128(const LAS unsigned char* lds, RowPtr&& rowptr) {
    const int t = otid();
#pragma unroll
    for (int it = 0; it < 8; ++it) { const int row = it * 32 + (t >> 4), piece = t & 15;
        const u32x4 v = *(const LAS u32x4*)(lds + row * CST_BF + piece * 16);
        bf16* dst = rowptr(row);
        if (dst) __builtin_nontemporal_store(v, (u32x4*)(dst + piece * 8)); }
}
template <class RowPtr>
__device__ __forceinline__ void flush_bf16_64(const LAS unsigned char* lds, RowPtr&& rowptr) {
    const int t = otid();
#pragma unroll
    for (int it = 0; it < 4; ++it) { const int row = it * 64 + (t >> 3), piece = t & 7;
        const u32x4 v = *(const LAS u32x4*)(lds + row * CST_BF64 + piece * 16);
        bf16* dst = rowptr(row);
        if (dst) __builtin_nontemporal_store(v, (u32x4*)(dst + piece * 8)); }
}
__device__ __forceinline__ void stage_f32_128(const f32x16 (&acc)[2][2], LAS unsigned char* lds, int wm, int wn, int lane) {
#pragma unroll
    for (int mi = 0; mi < 2; ++mi) { LAS unsigned char* rp = lds + (wm * 64 + mi * 32 + (lane & 31)) * CST_F32 + (wn * 64 + 4 * (lane >> 5)) * 4;
#pragma unroll
        for (int ni = 0; ni < 2; ++ni)
#pragma unroll
            for (int g = 0; g < 4; ++g) { f32x4 o; o[0] = acc[mi][ni][4 * g]; o[1] = acc[mi][ni][4 * g + 1]; o[2] = acc[mi][ni][4 * g + 2]; o[3] = acc[mi][ni][4 * g + 3];
                *(LAS f32x4*)(rp + (ni * 32 + 8 * g) * 4) = o; } }
}

template <int NB, int VAR = 0>
__device__ __forceinline__ void phase_inproj_v(const bf16* H, const bf16* Wt, bf16* PROJ, float* GATES, LAS unsigned char* lds, bool dostore = true) {
    constexpr int T = NB * (SEQ + CTXL), MT = T / 256, NT_ = NIN / 128;
    for (int r = 0; r * (int)gridDim.x < MT * NT_; ++r) {
        const int u = xcd_unit(r); if (u >= MT * NT_) continue;
        int mt, nt; unit_tile(u, MT, NT_, mt, nt);
        const bf16* arow[4];
#pragma unroll
        for (int i = 0; i < 4; ++i) arow[i] = H + (size_t)(mt * 256 + (otid() >> 3) + 64 * i) * D;
        gemm_tile<VAR>(arow, Wt + (size_t)nt * 128 * D, D, D, lds, [&](const f32x16 (&acc)[2][2], int wm, int wn, int lane) {
            if (!dostore) return;
            if (nt < NT_ - 1) stage_bf16_128(acc, lds, wm, wn, lane);
            else if (wn == 0) {
#pragma unroll
                for (int mi = 0; mi < 2; ++mi) { const int row = mt * 256 + wm * 64 + mi * 32 + (lane & 31);
#pragma unroll
                    for (int ni = 0; ni < 2; ++ni)
#pragma unroll
                        for (int g = 0; g < 4; ++g) { f32x4 o; o[0] = acc[mi][ni][4 * g]; o[1] = acc[mi][ni][4 * g + 1]; o[2] = acc[mi][ni][4 * g + 2]; o[3] = acc[mi][ni][4 * g + 3];
                            *(f32x4*)(GATES + (size_t)row * 64 + ni * 32 + 8 * g + 4 * (lane >> 5)) = o; } } }
        });
        if (dostore && nt < NT_ - 1) {
            __syncthreads();
            flush_bf16_128(lds, [&](int r) { return PROJ + (size_t)(mt * 256 + r) * PROJW + nt * 128; });
        }
        __syncthreads();
    }
}

template <int NB> __device__ __forceinline__ void phase_inproj(const bf16* H, const bf16* Wt, bf16* PROJ, float* GATES, LAS unsigned char* lds) { phase_inproj_v<NB, 0>(H, Wt, PROJ, GATES, lds, true); }

template <int NB>
__device__ __forceinline__ void phase_conv(const bf16* PROJ, const float* cw, const float* cb, bf16* XBC) {
    constexpr int TL = NB * SEQ, T = NB * (SEQ + CTXL);
    for (size_t it = (size_t)blockIdx.x * NTHR + otid(); it < (size_t)T * 192; it += (size_t)gridDim.x * NTHR) {
        const int row = (int)(it / 192), c0 = (int)(it % 192) * 8;
        int t, L;
        if (row < TL) { t = row % SEQ; L = SEQ; } else { t = (row - TL) % CTXL; L = CTXL; }
        const bf16* p = PROJ + (size_t)row * PROJW + PC_XBC + c0;
        const u32x4 cur = *(const u32x4*)p;
        u32x4 prv = {0u, 0u, 0u, 0u}, nxt = {0u, 0u, 0u, 0u};
        if (t > 0) prv = *(const u32x4*)(p - PROJW);
        if (t < L - 1) nxt = *(const u32x4*)(p + PROJW);
        float o[8];
#pragma unroll
        for (int j = 0; j < 4; ++j) {
            const int c = c0 + 2 * j;
            o[2 * j] = bflo(prv[j]) * cw[c] + bflo(cur[j]) * cw[1536 + c] + bflo(nxt[j]) * cw[3072 + c] + cb[c];
            o[2 * j + 1] = bfhi(prv[j]) * cw[c + 1] + bfhi(cur[j]) * cw[1536 + c + 1] + bfhi(nxt[j]) * cw[3072 + c + 1] + cb[c + 1];
        }
        u32x4 r; r[0] = pk2(siluf(o[0]), siluf(o[1])); r[1] = pk2(siluf(o[2]), siluf(o[3])); r[2] = pk2(siluf(o[4]), siluf(o[5])); r[3] = pk2(siluf(o[6]), siluf(o[7]));
        *(u32x4*)(XBC + (size_t)row * 1536 + c0) = r;
    }
}
}
namespace fx {
constexpr int RS_X = 144, RS_N = 272;

template <int NB> __device__ __forceinline__ int scan_row(int b, int d, int step) {
    if (step < CTXL) return NB * SEQ + b * CTXL + (d ? CTXL - 1 - step : step);
    step -= CTXL; return b * SEQ + (d ? SEQ - 1 - step : step);
}
__device__ __forceinline__ bf16x8 scale_frag(bf16x8 v, f32x4 w0, f32x4 w1) {
    const u32x4 u = __builtin_bit_cast(u32x4, v);
    u32x4 o;
    o[0] = pk2(bflo(u[0]) * w0[0], bfhi(u[0]) * w0[1]); o[1] = pk2(bflo(u[1]) * w0[2], bfhi(u[1]) * w0[3]);
    o[2] = pk2(bflo(u[2]) * w1[0], bfhi(u[2]) * w1[1]); o[3] = pk2(bflo(u[3]) * w1[2], bfhi(u[3]) * w1[3]);
    return __builtin_bit_cast(bf16x8, o);
}

__device__ __forceinline__ unsigned tr_addr(const LAS unsigned char* T, int RS, int k0, int c0, int lane) {
    const int h = lane >> 5, blk = (lane >> 4) & 1, q = (lane & 15) >> 2, p = lane & 3;
    return (unsigned)(size_t)(T + (k0 + 8 * h + q) * RS + (c0 + 16 * blk + 4 * p) * 2);
}
__device__ __forceinline__ void tr8(unsigned a0, unsigned a1, unsigned a2, unsigned a3, unsigned a4, unsigned a5, unsigned a6, unsigned a7,
                                    bf16x4& v0, bf16x4& v1, bf16x4& v2, bf16x4& v3, bf16x4& v4, bf16x4& v5, bf16x4& v6, bf16x4& v7) {
    asm volatile("ds_read_b64_tr_b16 %0, %8\n\tds_read_b64_tr_b16 %1, %9\n\tds_read_b64_tr_b16 %2, %10\n\tds_read_b64_tr_b16 %3, %11\n\t"
                 "ds_read_b64_tr_b16 %4, %12\n\tds_read_b64_tr_b16 %5, %13\n\tds_read_b64_tr_b16 %6, %14\n\tds_read_b64_tr_b16 %7, %15\n\ts_waitcnt lgkmcnt(0)"
                 : "=&v"(v0), "=&v"(v1), "=&v"(v2), "=&v"(v3), "=&v"(v4), "=&v"(v5), "=&v"(v6), "=&v"(v7)
                 : "v"(a0), "v"(a1), "v"(a2), "v"(a3), "v"(a4), "v"(a5), "v"(a6), "v"(a7) : "memory");
}
__device__ __forceinline__ void tr4(unsigned a0, unsigned a1, unsigned a2, unsigned a3, bf16x4& v0, bf16x4& v1, bf16x4& v2, bf16x4& v3) {
    asm volatile("ds_read_b64_tr_b16 %0, %4\n\tds_read_b64_tr_b16 %1, %5\n\tds_read_b64_tr_b16 %2, %6\n\tds_read_b64_tr_b16 %3, %7\n\ts_waitcnt lgkmcnt(0)"
                 : "=&v"(v0), "=&v"(v1), "=&v"(v2), "=&v"(v3) : "v"(a0), "v"(a1), "v"(a2), "v"(a3) : "memory");
}
__device__ __forceinline__ bf16x8 tr_join(bf16x4 v0, bf16x4 v1) { bf16x8 r; r[0] = v0[0]; r[1] = v0[1]; r[2] = v0[2]; r[3] = v0[3]; r[4] = v1[0]; r[5] = v1[1]; r[6] = v1[2]; r[7] = v1[3]; return r; }
__device__ __forceinline__ void tr_col4(const LAS unsigned char* T, int RS, int k0, int c0, int lane, bf16x4 (&t)[4][2]) {
    const unsigned a = tr_addr(T, RS, k0, c0, lane);
    tr8(a, a + 4 * RS, a + 16 * RS, a + 20 * RS, a + 32 * RS, a + 36 * RS, a + 48 * RS, a + 52 * RS, t[0][0], t[0][1], t[1][0], t[1][1], t[2][0], t[2][1], t[3][0], t[3][1]);
}
__device__ __forceinline__ void tr_col2(const LAS unsigned char* T, int RS, int k0, int c0, int lane, bf16x4 (&t)[2][2]) {
    const unsigned a = tr_addr(T, RS, k0, c0, lane);
    tr4(a, a + 4 * RS, a + 16 * RS, a + 20 * RS, t[0][0], t[0][1], t[1][0], t[1][1]);
}

constexpr int NSTEP = SEQ + CTXL;
template <int NB> struct ScanTab {
    static constexpr size_t SSD_TAB = 0, ML_TAB = SSD_TAB + (size_t)NB * 32 * NSTEP * 16, SSD_DEC = ML_TAB + (size_t)NB * 8 * NSTEP * 32,
                            ML_CH = SSD_DEC + (size_t)NB * 32 * 34 * 4, END = ML_CH + (size_t)NB * 8 * 34 * 8;
};
template <int NB>
__device__ __forceinline__ void phase_tables(const In& in, const float* GATES, unsigned char* tab, LAS unsigned char* lds) {
    typedef ScanTab<NB> ST;
    const int tid = otid(), lane = tid & 63, wave = tid >> 6;
    LAS float* l_g = (LAS float*)lds; LAS float* l_ml = l_g + 68; LAS float* l_mr = l_g + 136;
    for (int job = blockIdx.x; job < NB * 40; job += gridDim.x) {
        if (job < NB * 32) {
            const int b = job >> 5, d = (job >> 4) & 1, h = job & 15;
            const float a = -__expf(in.ssd_a_log[d * 16 + h]), dtb = in.ssd_dt_bias[d * 16 + h];
            f32x4* T4 = (f32x4*)(tab + ST::SSD_TAB) + (size_t)job * NSTEP; float* DEC = (float*)(tab + ST::SSD_DEC) + job * 34;
            for (int ch = wave; ch < 34; ch += NWAVE) {
                const float dt0 = softplusf(GATES[(size_t)scan_row<NB>(b, d, ch * 128 + lane) * 64 + d * 16 + h] + dtb);
                const float dt1 = softplusf(GATES[(size_t)scan_row<NB>(b, d, ch * 128 + 64 + lane) * 64 + d * 16 + h] + dtb);
                float v0 = dt0 * a, v1 = dt1 * a;
#pragma unroll
                for (int o = 1; o < 64; o <<= 1) { const float t0 = __shfl_up(v0, o), t1 = __shfl_up(v1, o); if (lane >= o) { v0 += t0; v1 += t1; } }
                v1 += __shfl(v0, 63);
                const float tot = __shfl(v1, 63);
                T4[ch * 128 + lane] = (f32x4){v0, dt0, dt0 * __expf(tot - v0), __expf(v0)};
                T4[ch * 128 + 64 + lane] = (f32x4){v1, dt1, dt1 * __expf(tot - v1), __expf(v1)};
                if (lane == 0) DEC[ch] = __expf(tot);
            }
        } else {
            const int j2 = job - NB * 32, b = j2 >> 3, d = (j2 >> 2) & 1, hh = j2 & 3;
            const float ib = in.ml_i_bias[d * 4 + hh], fb = in.ml_f_bias[d * 4 + hh];
            f32x4* T4 = (f32x4*)(tab + ST::ML_TAB) + (size_t)j2 * NSTEP * 2; float* CH = (float*)(tab + ST::ML_CH) + j2 * 34 * 2;
            float s_li[5][2], s_bc[5][2], s_mi[5][2], s_we[5][2];
            __syncthreads();
#pragma unroll
            for (int k = 0; k < 5; ++k) { const int ch = wave + 8 * k;
#pragma unroll
                for (int q = 0; q < 2; ++q) { s_li[k][q] = 0.f; s_bc[k][q] = 0.f; s_mi[k][q] = 0.f; s_we[k][q] = 0.f; }
                if (ch < 34) {
                    const float* g0 = GATES + (size_t)scan_row<NB>(b, d, ch * 128 + lane) * 64; const float* g1 = GATES + (size_t)scan_row<NB>(b, d, ch * 128 + 64 + lane) * 64;
                    const float li0 = g0[32 + d * 4 + hh] + ib, li1 = g1[32 + d * 4 + hh] + ib;
                    float bc0 = logsigf(g0[40 + d * 4 + hh] + fb), bc1 = logsigf(g1[40 + d * 4 + hh] + fb);
#pragma unroll
                    for (int o = 1; o < 64; o <<= 1) { const float t0 = __shfl_up(bc0, o), t1 = __shfl_up(bc1, o); if (lane >= o) { bc0 += t0; bc1 += t1; } }
                    bc1 += __shfl(bc0, 63);
                    float pm0 = li0 - bc0, pm1 = li1 - bc1;
#pragma unroll
                    for (int o = 1; o < 64; o <<= 1) { const float t0 = __shfl_up(pm0, o), t1 = __shfl_up(pm1, o); if (lane >= o) { pm0 = fmaxf(pm0, t0); pm1 = fmaxf(pm1, t1); } }
                    pm1 = fmaxf(pm1, __shfl(pm0, 63));
                    const float gtot = __shfl(bc1, 63);
                    const float ae0 = gtot - bc0 + li0, ae1 = gtot - bc1 + li1;
                    const float m_loc = wave_max(fmaxf(ae0, ae1));
                    s_li[k][0] = li0; s_li[k][1] = li1; s_bc[k][0] = bc0; s_bc[k][1] = bc1; s_mi[k][0] = bc0 + pm0; s_mi[k][1] = bc1 + pm1;
                    s_we[k][0] = __expf(ae0 - m_loc); s_we[k][1] = __expf(ae1 - m_loc);
                    if (lane == 0) { l_g[ch] = gtot; l_ml[ch] = m_loc; }
                } }
            __syncthreads();
            if (tid == 0) { float m = 0.f;
                for (int ch = 0; ch < 34; ++ch) { const float g = l_g[ch], ml = l_ml[ch], mn = fmaxf(g + m, ml);
                    l_mr[ch] = m; CH[2 * ch] = __expf(g + m - mn); CH[2 * ch + 1] = __expf(ml - mn); m = mn; } }
            __syncthreads();
#pragma unroll
            for (int k = 0; k < 5; ++k) { const int ch = wave + 8 * k;
                if (ch < 34) {
#pragma unroll
                    for (int q = 0; q < 2; ++q) {
                        const float m_inter = s_bc[k][q] + l_mr[ch], mt = fmaxf(s_mi[k][q], m_inter);
                        T4[(size_t)(ch * 128 + 64 * q + lane) * 2] = (f32x4){__expf(s_bc[k][q] - mt), __expf(s_li[k][q] - s_bc[k][q]), __expf(m_inter - mt), s_we[k][q]};
                        T4[(size_t)(ch * 128 + 64 * q + lane) * 2 + 1] = (f32x4){__expf(-mt), 0.f, 0.f, 0.f}; }
                } }
        }
    }
}

template <int NB>
__device__ __forceinline__ void ssd_item(const bf16* XBC, const unsigned char* tab, bf16* SCb, int b, int d, int h, LAS unsigned char* lds) {
    typedef ScanTab<NB> ST;
    const int tid = otid(), lane = tid & 63, wave = tid >> 6, g = h >> 3, combo = b * 32 + d * 16 + h;
    LAS unsigned char* Xs = lds; LAS unsigned char* Bs = lds + 18432; LAS unsigned char* Cs = lds + 53248;
    LAS unsigned char* Ss = lds + 88064; LAS unsigned char* Ms = lds + 105472;
    LAS float* acs = (LAS float*)(lds + 140288); LAS float* dtv = acs + 128; LAS float* wv = acs + 256; LAS float* eav = acs + 384;
    const f32x4* T4 = (const f32x4*)(tab + ST::SSD_TAB) + (size_t)combo * NSTEP; const float* DEC = (const float*)(tab + ST::SSD_DEC) + combo * 34;
    f32x16 st;
#pragma unroll
    for (int r = 0; r < 16; ++r) st[r] = 0.f;
    constexpr int NCH = (CTXL + SEQ) / 128;
    u32x4 rx[2], rb[4], rc[4]; f32x4 rt = {0.f, 0.f, 0.f, 0.f}; float rdec = 0.f;
#define SSD_LOAD(ch) do { \
    _Pragma("unroll") for (int i = 0; i < 2; ++i) { const int idx = tid + 512 * i, l = idx >> 3, c = idx & 7; \
        rx[i] = *(const u32x4*)(XBC + (size_t)scan_row<NB>(b, d, (ch) * 128 + l) * 1536 + h * 64 + c * 8); } \
    _Pragma("unroll") for (int i = 0; i < 4; ++i) { const int idx = tid + 512 * i, l = idx >> 4, c = idx & 15; \
        const bf16* rp = XBC + (size_t)scan_row<NB>(b, d, (ch) * 128 + l) * 1536 + 1024 + g * 128 + c * 8; \
        rb[i] = *(const u32x4*)rp; rc[i] = *(const u32x4*)(rp + 256); } \
    if (tid < 128) rt = T4[(ch) * 128 + tid]; \
    rdec = DEC[ch]; } while (0)
    SSD_LOAD(0);
    const int pbw = wave >> 2, nbw = wave & 3;
    for (int ch = 0; ch < NCH; ++ch) {
#pragma unroll
        for (int i = 0; i < 2; ++i) { const int idx = tid + 512 * i, l = idx >> 3, c = idx & 7; *(LAS u32x4*)(Xs + l * RS_X + c * 16) = rx[i]; }
#pragma unroll
        for (int i = 0; i < 4; ++i) { const int idx = tid + 512 * i, l = idx >> 4, c = idx & 15;
            *(LAS u32x4*)(Bs + l * RS_N + c * 16) = rb[i]; *(LAS u32x4*)(Cs + l * RS_N + c * 16) = rc[i]; }
        if (tid < 128) { acs[tid] = rt[0]; dtv[tid] = rt[1]; wv[tid] = rt[2]; eav[tid] = rt[3]; }
        const float dec = rdec;
        {
            const int pp = 32 * pbw + (lane & 31);
#pragma unroll
            for (int gq = 0; gq < 4; ++gq) { u32x2 o; o[0] = pk2(st[4 * gq], st[4 * gq + 1]); o[1] = pk2(st[4 * gq + 2], st[4 * gq + 3]);
                *(LAS u32x2*)(Ss + pp * RS_N + (32 * nbw + 8 * gq + 4 * (lane >> 5)) * 2) = o; }
        }
        __syncthreads();
        if (ch + 1 < NCH) SSD_LOAD(ch + 1);
        {
            const int lbA = wave >> 1, sbp = wave & 1;
            const int l = 32 * lbA + (lane & 31);
            const float al = acs[l];
#pragma unroll
            for (int q = 0; q < 2; ++q) { const int sb = 2 * sbp + q;
                if (sb <= lbA) {
                    f32x16 cb;
#pragma unroll
                    for (int r = 0; r < 16; ++r) cb[r] = 0.f;
#pragma unroll
                    for (int kk = 0; kk < 8; ++kk) cb = mfma32(frag_row(Bs, RS_N, 32 * sb, 16 * kk, lane), frag_row(Cs, RS_N, 32 * lbA, 16 * kk, lane), cb);
#pragma unroll
                    for (int gq = 0; gq < 4; ++gq) { const int s0 = 32 * sb + 8 * gq + 4 * (lane >> 5);
                        const f32x4 as4 = *(const LAS f32x4*)(acs + s0), dt4 = *(const LAS f32x4*)(dtv + s0);
                        float m[4];
#pragma unroll
                        for (int j = 0; j < 4; ++j) m[j] = (s0 + j <= l) ? cb[4 * gq + j] * __expf(fminf(al - as4[j], 0.f)) * dt4[j] : 0.f;
                        u32x2 o; o[0] = pk2(m[0], m[1]); o[1] = pk2(m[2], m[3]);
                        *(LAS u32x2*)(Ms + l * RS_N + s0 * 2) = o; } } }
        }
        {
#pragma unroll
            for (int r = 0; r < 16; ++r) st[r] *= dec;
#pragma unroll
            for (int kb = 0; kb < 2; ++kb) {
                bf16x4 tx[4][2], tb[4][2];
                tr_col4(Xs, RS_X, 64 * kb, 32 * pbw, lane, tx);
                tr_col4(Bs, RS_N, 64 * kb, 32 * nbw, lane, tb);
#pragma unroll
                for (int k4 = 0; k4 < 4; ++k4) {
                    const int l0 = 16 * (4 * kb + k4) + 8 * (lane >> 5);
                    const f32x4 w0 = *(const LAS f32x4*)(wv + l0), w1 = *(const LAS f32x4*)(wv + l0 + 4);
                    st = mfma32(tr_join(tb[k4][0], tb[k4][1]), scale_frag(tr_join(tx[k4][0], tx[k4][1]), w0, w1), st);
                }
            }
        }
        __syncthreads();
        {
            const int pb = wave >> 2, lb = wave & 3;
            f32x16 acc;
#pragma unroll
            for (int r = 0; r < 16; ++r) acc[r] = 0.f;
#pragma unroll
            for (int kk = 0; kk < 8; ++kk) acc = mfma32(frag_row(Ss, RS_N, 32 * pb, 16 * kk, lane), frag_row(Cs, RS_N, 32 * lb, 16 * kk, lane), acc);
            const int l = 32 * lb + (lane & 31);
            const float ea = eav[l];
#pragma unroll
            for (int r = 0; r < 16; ++r) acc[r] *= ea;
            for (int sb = 0; sb <= lb; ++sb) {
                bf16x4 t2[2][2];
                const bf16x8 m0 = frag_row(Ms, RS_N, 32 * lb, 32 * sb, lane), m1 = frag_row(Ms, RS_N, 32 * lb, 32 * sb + 16, lane);
                tr_col2(Xs, RS_X, 32 * sb, 32 * pb, lane, t2);
                acc = mfma32(tr_join(t2[0][0], t2[0][1]), m0, acc);
                acc = mfma32(tr_join(t2[1][0], t2[1][1]), m1, acc);
            }
            bf16* yp = SCb + (size_t)scan_row<NB>(b, d, ch * 128 + l) * 4096 + d * 1024 + h * 64 + 32 * pb + 4 * (lane >> 5);
#pragma unroll
            for (int gq = 0; gq < 4; ++gq) { u32x2 o; o[0] = pk2(acc[4 * gq], acc[4 * gq + 1]); o[1] = pk2(acc[4 * gq + 2], acc[4 * gq + 3]); *(u32x2*)(yp + 8 * gq) = o; }
        }
        __syncthreads();
    }
#undef SSD_LOAD
}

template <int NB>
__device__ __forceinline__ void mlstm_item(const bf16* PROJ, const unsigned char* tab, bf16* SCb, int b, int d, int hh, int ev, LAS unsigned char* lds) {
    typedef ScanTab<NB> ST;
    const int tid = otid(), lane = tid & 63, wave = tid >> 6, combo = b * 8 + d * 4 + hh;
    LAS unsigned char* Qs = lds; LAS unsigned char* Ks = lds + 34816; LAS unsigned char* Vs = lds + 69632;
    LAS unsigned char* Ct = lds + 88064; LAS unsigned char* Sm = lds + 105472;
    LAS float* tb = (LAS float*)(lds + 140288);
    LAS float* t_u = tb, *t_v = tb + 128, *t_wi = tb + 256, *t_we = tb + 384, *t_em = tb + 512, *t_qn = tb + 640, *t_n = tb + 768, *t_nc = tb + 896, *t_rs = tb + 1024  ;
    const f32x4* T4 = (const f32x4*)(tab + ST::ML_TAB) + (size_t)combo * NSTEP * 2; const float* CH = (const float*)(tab + ST::ML_CH) + combo * 34 * 2;
    const float kscale = 0.08838834764831845f;
    f32x16 st;
#pragma unroll
    for (int r = 0; r < 16; ++r) st[r] = 0.f;
    if (tid < 128) t_n[tid] = 0.f;
    constexpr int NCH = (CTXL + SEQ) / 128;
    const int kbw = wave & 3, ebw = wave >> 2;
    u32x4 rq[4], rk[4], rv[2]; f32x4 rt = {0.f, 0.f, 0.f, 0.f}; float ras = 0.f, rbb = 0.f;
#define ML_LOAD(ch) do { \
    _Pragma("unroll") for (int i = 0; i < 4; ++i) { const int idx = tid + 512 * i, l = idx >> 4, c = idx & 15; \
        const bf16* rp = PROJ + (size_t)scan_row<NB>(b, d, (ch) * 128 + l) * PROJW + hh * 128 + c * 8; \
        rq[i] = *(const u32x4*)(rp + PC_Q); rk[i] = *(const u32x4*)(rp + PC_K); } \
    _Pragma("unroll") for (int i = 0; i < 2; ++i) { const int idx = tid + 512 * i, l = idx >> 3, c = idx & 7; \
        rv[i] = *(const u32x4*)(PROJ + (size_t)scan_row<NB>(b, d, (ch) * 128 + l) * PROJW + PC_V + hh * 256 + ev * 64 + c * 8); } \
    if (tid < 256) rt = T4[(size_t)(ch) * 256 + tid]; \
    ras = CH[2 * (ch)]; rbb = CH[2 * (ch) + 1]; } while (0)
    ML_LOAD(0);
    for (int ch = 0; ch < NCH; ++ch) {
#pragma unroll
        for (int i = 0; i < 4; ++i) { const int idx = tid + 512 * i, l = idx >> 4, c = idx & 15;
            *(LAS u32x4*)(Qs + l * RS_N + c * 16) = rq[i]; *(LAS u32x4*)(Ks + l * RS_N + c * 16) = rk[i]; }
#pragma unroll
        for (int i = 0; i < 2; ++i) { const int idx = tid + 512 * i, l = idx >> 3, c = idx & 7; *(LAS u32x4*)(Vs + l * RS_X + c * 16) = rv[i]; }
        if (tid < 256) { const int l = tid >> 1; if (tid & 1) t_em[l] = rt[0]; else { t_u[l] = rt[0]; t_v[l] = rt[1]; t_wi[l] = rt[2]; t_we[l] = rt[3]; } }
        const float a_s = ras, bbs = rbb;
        {
            const int ee = 32 * ebw + (lane & 31);
#pragma unroll
            for (int gq = 0; gq < 4; ++gq) { u32x2 o; o[0] = pk2(st[4 * gq], st[4 * gq + 1]); o[1] = pk2(st[4 * gq + 2], st[4 * gq + 3]);
                *(LAS u32x2*)(Ct + ee * RS_N + (32 * kbw + 8 * gq + 4 * (lane >> 5)) * 2) = o; }
        }
        __syncthreads();
        if (ch + 1 < NCH) ML_LOAD(ch + 1);
        {
            const int lbA = wave >> 1, sbp = wave & 1;
            const int l = 32 * lbA + (lane & 31);
            const float ul = t_u[l] * kscale;
#pragma unroll
            for (int q = 0; q < 2; ++q) { const int sb = 2 * sbp + q;
                if (sb <= lbA) {
                    f32x16 cb;
#pragma unroll
                    for (int r = 0; r < 16; ++r) cb[r] = 0.f;
#pragma unroll
                    for (int kk = 0; kk < 8; ++kk) cb = mfma32(frag_row(Ks, RS_N, 32 * sb, 16 * kk, lane), frag_row(Qs, RS_N, 32 * lbA, 16 * kk, lane), cb);
                    float rsum = 0.f;
#pragma unroll
                    for (int gq = 0; gq < 4; ++gq) { const int s0 = 32 * sb + 8 * gq + 4 * (lane >> 5);
                        const f32x4 v4 = *(const LAS f32x4*)(t_v + s0);
                        float m[4];
#pragma unroll
                        for (int j = 0; j < 4; ++j) { m[j] = (s0 + j <= l) ? cb[4 * gq + j] * ul * v4[j] : 0.f; rsum += m[j]; }
                        u32x2 o; o[0] = pk2(m[0], m[1]); o[1] = pk2(m[2], m[3]);
                        *(LAS u32x2*)(Sm + l * RS_N + s0 * 2) = o; }
                    rsum += __shfl_xor(rsum, 32);
                    if (lane < 32) t_rs[sb * 128 + l] = rsum;
                } }
            if (wave == 1 || wave == 3) {
                const int lq = (wave == 1 ? 0 : 64) + lane;
                float qn = 0.f;
#pragma unroll 4
                for (int c = 0; c < 16; ++c) { const u32x4 qv = *(const LAS u32x4*)(Qs + lq * RS_N + c * 16);
                    const f32x4 n0 = *(const LAS f32x4*)(t_n + c * 8), n1 = *(const LAS f32x4*)(t_n + c * 8 + 4);
                    qn += bflo(qv[0]) * n0[0] + bfhi(qv[0]) * n0[1] + bflo(qv[1]) * n0[2] + bfhi(qv[1]) * n0[3]
                        + bflo(qv[2]) * n1[0] + bfhi(qv[2]) * n1[1] + bflo(qv[3]) * n1[2] + bfhi(qv[3]) * n1[3]; }
                t_qn[lq] = qn;
            }
        }
        {
#pragma unroll
            for (int r = 0; r < 16; ++r) st[r] *= a_s;
            const float f = bbs * kscale;
            f32x16 nacc;
#pragma unroll
            for (int r = 0; r < 16; ++r) nacc[r] = 0.f;
            bf16x8 ones;
#pragma unroll
            for (int j = 0; j < 8; ++j) ones[j] = (short)0x3f80;
#pragma unroll
            for (int kb2 = 0; kb2 < 2; ++kb2) {
                bf16x4 tk[4][2], tv[4][2];
                tr_col4(Ks, RS_N, 64 * kb2, 32 * kbw, lane, tk);
                tr_col4(Vs, RS_X, 64 * kb2, 32 * ebw, lane, tv);
#pragma unroll
                for (int k4 = 0; k4 < 4; ++k4) {
                    const int l0 = 16 * (4 * kb2 + k4) + 8 * (lane >> 5);
                    f32x4 w0 = *(const LAS f32x4*)(t_we + l0), w1 = *(const LAS f32x4*)(t_we + l0 + 4);
#pragma unroll
                    for (int j = 0; j < 4; ++j) { w0[j] *= f; w1[j] *= f; }
                    const bf16x8 ka = scale_frag(tr_join(tk[k4][0], tk[k4][1]), w0, w1);
                    st = mfma32(ka, tr_join(tv[k4][0], tv[k4][1]), st);
                    if (ebw == 0) nacc = mfma32(ka, ones, nacc);
                }
            }
            if (ebw == 0 && (lane & 31) == 0) {
#pragma unroll
                for (int gq = 0; gq < 4; ++gq)
#pragma unroll
                    for (int j = 0; j < 4; ++j) t_nc[32 * kbw + 8 * gq + 4 * (lane >> 5) + j] = nacc[4 * gq + j];
            }
        }
        __syncthreads();
        if (tid < 128) t_n[tid] = a_s * t_n[tid] + t_nc[tid];
        {
            const int eb = wave >> 2, lb = wave & 3;
            f32x16 acc;
#pragma unroll
            for (int r = 0; r < 16; ++r) acc[r] = 0.f;
#pragma unroll
            for (int kk = 0; kk < 8; ++kk) acc = mfma32(frag_row(Ct, RS_N, 32 * eb, 16 * kk, lane), frag_row(Qs, RS_N, 32 * lb, 16 * kk, lane), acc);
            const int l = 32 * lb + (lane & 31);
            const float wi = t_wi[l];
#pragma unroll
            for (int r = 0; r < 16; ++r) acc[r] *= wi;
            float rsum = 0.f;
            for (int sb = 0; sb <= lb; ++sb) {
                bf16x4 t2[2][2];
                const bf16x8 m0 = frag_row(Sm, RS_N, 32 * lb, 32 * sb, lane), m1 = frag_row(Sm, RS_N, 32 * lb, 32 * sb + 16, lane);
                rsum += t_rs[sb * 128 + l];
                tr_col2(Vs, RS_X, 32 * sb, 32 * eb, lane, t2);
                acc = mfma32(tr_join(t2[0][0], t2[0][1]), m0, acc);
                acc = mfma32(tr_join(t2[1][0], t2[1][1]), m1, acc);
            }
            float den = rsum + t_qn[l] * wi;
            den = fmaxf(fabsf(den), t_em[l]);
            const float inv = 1.f / den;
            bf16* hp = SCb + (size_t)scan_row<NB>(b, d, ch * 128 + l) * 4096 + 2048 + d * 1024 + hh * 256 + ev * 64 + 32 * eb + 4 * (lane >> 5);
#pragma unroll
            for (int gq = 0; gq < 4; ++gq) { u32x2 o; o[0] = pk2(acc[4 * gq] * inv, acc[4 * gq + 1] * inv); o[1] = pk2(acc[4 * gq + 2] * inv, acc[4 * gq + 3] * inv); *(u32x2*)(hp + 8 * gq) = o; }
        }
        __syncthreads();
    }
#undef ML_LOAD
}

template <int NB>
__device__ __forceinline__ void phase_scan(const bf16* PROJ, const unsigned char* tab, const bf16* XBC, bf16* SCb, LAS unsigned char* lds, int mode = 3) {
    const int G = gridDim.x, bi = blockIdx.x;
    if (NB == 4 && G == 256) {
        const int x = bi & 7, y = bi >> 3;
        if (y < 16) { if (mode & 1) { const int q = x + 8 * (y >> 3), hh = y & 7; ssd_item<NB>(XBC, tab, SCb, q >> 2, (q >> 1) & 1, (q & 1) * 8 + hh, lds); } }
        else { if (mode & 2) { const int y2 = y - 16, c = x + 8 * (y2 >> 2), ev = y2 & 3; mlstm_item<NB>(PROJ, tab, SCb, c >> 3, (c >> 2) & 1, c & 3, ev, lds); } }
        return;
    }
    if (mode & 1) for (int item = bi; item < NB * 32; item += G) { const int b = item / 32, d = (item >> 4) & 1, h = item & 15;
        ssd_item<NB>(XBC, tab, SCb, b, d, h, lds); }
    const int v = (bi + G - (NB * 32) % G) % G;
    if (mode & 2) for (int it = v; it < NB * 32; it += G) { const int b = it / 32, d = (it >> 4) & 1, hh = (it >> 2) & 3, ev = it & 3;
        mlstm_item<NB>(PROJ, tab, SCb, b, d, hh, ev, lds); }
}

template <int NB>
__device__ __forceinline__ void phase_mixer_out(const In& in, const bf16* PROJ, const bf16* XBC, bf16* SCb, bf16* scratch_out = nullptr) {
    constexpr int T = NB * (SEQ + CTXL);
    const int lane = otid() & 63, wave = otid() >> 6;
    for (int row = blockIdx.x * NWAVE + wave; row < T; row += gridDim.x * NWAVE) {
        bf16* sc = SCb + (size_t)row * 4096;
        const bf16* pr = PROJ + (size_t)row * PROJW;
        float yv[16], hv[16], ss = 0.f, hs[2] = {0.f, 0.f};
#pragma unroll
        for (int i = 0; i < 2; ++i) { const int c = lane * 8 + 512 * i;
            const u32x4 y0 = *(const u32x4*)(sc + c), y1 = *(const u32x4*)(sc + 1024 + c), h0 = *(const u32x4*)(sc + 2048 + c), h1 = *(const u32x4*)(sc + 3072 + c);
            const u32x4 xs = *(const u32x4*)(XBC + (size_t)row * 1536 + c), z = *(const u32x4*)(pr + PC_Z + c);
            const float dk = in.ssd_d[c >> 6];
#pragma unroll
            for (int j = 0; j < 4; ++j) {
                float a0 = bflo(y0[j]) + bflo(y1[j]) + dk * bflo(xs[j]), a1 = bfhi(y0[j]) + bfhi(y1[j]) + dk * bfhi(xs[j]);
                a0 *= siluf(bflo(z[j])); a1 *= siluf(bfhi(z[j]));
                yv[8 * i + 2 * j] = a0; yv[8 * i + 2 * j + 1] = a1; ss += a0 * a0 + a1 * a1;
                const float b0 = bflo(h0[j]) + bflo(h1[j]), b1 = bfhi(h0[j]) + bfhi(h1[j]);
                hv[8 * i + 2 * j] = b0; hv[8 * i + 2 * j + 1] = b1; hs[i] += b0 * b0 + b1 * b1; } }
        ss = wave_sum(ss);
        const float rs = rsqrtf(ss * (1.f / 1024.f) + 1e-6f);
#pragma unroll
        for (int i = 0; i < 2; ++i) {
#pragma unroll
            for (int o = 16; o > 0; o >>= 1) hs[i] += __shfl_xor(hs[i], o);
            hs[i] = rsqrtf(hs[i] * (1.f / 256.f) + 1e-6f); }
        __builtin_amdgcn_s_waitcnt(0);
#pragma unroll
        for (int i = 0; i < 2; ++i) { const int c = lane * 8 + 512 * i;
            const u32x4 ov = *(const u32x4*)(pr + PC_O + c);
            u32x4 oy, oh;
#pragma unroll
            for (int j = 0; j < 4; ++j) {
                oy[j] = pk2(yv[8 * i + 2 * j] * rs * in.ssd_norm_w[c + 2 * j], yv[8 * i + 2 * j + 1] * rs * in.ssd_norm_w[c + 2 * j + 1]);
                oh[j] = pk2(hv[8 * i + 2 * j] * hs[i] * in.ml_norm_w[c + 2 * j] * sigmf(bflo(ov[j])), hv[8 * i + 2 * j + 1] * hs[i] * in.ml_norm_w[c + 2 * j + 1] * sigmf(bfhi(ov[j]))); }
            bf16* dstp = scratch_out ? scratch_out + (size_t)row * 2048 : sc;
            *(u32x4*)(dstp + c) = oy; *(u32x4*)(dstp + 1024 + c) = oh; }
    }
}

template <int NB, class Idle>
__device__ __forceinline__ void phase_outproj(const bf16* A, int lda, int K, const bf16* Wt, int nrows, const float* xl, const float* xc, const float* modl, float* Xout,
                                              LAS unsigned char* lds, Idle&& idle) {
    constexpr int TL = NB * SEQ;
    const int MT = nrows / 256;
    for (int r = 0; r * (int)gridDim.x < MT * 8; ++r) {
        const int u = xcd_unit(r);
        if (u >= MT * 8) {
            idle(u - MT * 8, (r + 1) * (int)gridDim.x - MT * 8); continue; }
        int mt, nt; unit_tile(u, MT, 8, mt, nt);
        const bf16* arow[4];
#pragma unroll
        for (int i = 0; i < 4; ++i) arow[i] = A + (size_t)(mt * 256 + (otid() >> 3) + 64 * i) * lda;
        gemm_tile(arow, Wt + (size_t)nt * 128 * K, K, K, lds, [&](const f32x16 (&acc)[2][2], int wm, int wn, int lane) { stage_f32_128(acc, lds, wm, wn, lane); });
        __syncthreads();
        {
            const float* mv = modl + (size_t)mod_row<NB>(mt * 256) * 6144 + 2 * 1024 + nt * 128;
            const int t = otid(), piece = t & 31;
            const f32x4 m2 = *(const f32x4*)(mv + piece * 4);
#pragma unroll 4
            for (int it = 0; it < 16; ++it) { const int rl = it * 16 + (t >> 5), row = mt * 256 + rl;
                const f32x4 a = *(const LAS f32x4*)(lds + rl * CST_F32 + piece * 16);
                const float* srcp = (row < TL ? xl + (size_t)row * D : xc + (size_t)(row - TL) * D) + nt * 128 + piece * 4;
                const f32x4 xv = *(const f32x4*)srcp;
                f32x4 o;
#pragma unroll
                for (int j = 0; j < 4; ++j) o[j] = xv[j] + m2[j] * a[j];
                __builtin_nontemporal_store(o, (f32x4*)(Xout + (size_t)row * D + nt * 128 + piece * 4)); }
        }
        __syncthreads();
    }
}
}
namespace fx {
__device__ __forceinline__ int moe_prefix(const int* cnt, LAS int* pre  ) {
    __syncthreads();
    if (otid() < 64) {
        const int lane = otid();
        int v = lane < 32 ? (cnt[lane * 64] + 255) >> 8 : 0;
#pragma unroll
        for (int o = 1; o < 32; o <<= 1) { const int t = __shfl_up(v, o); if (lane >= o) v += t; }
        if (lane < 32) pre[lane + 1] = v;
        if (lane == 0) pre[0] = 0;
    }
    __syncthreads();
    return pre[32];
}
__device__ __forceinline__ int moe_find(const LAS int* pre, int t) { int e = 0;
#pragma unroll
    for (int i = 1; i < 32; ++i) e += (t >= pre[i]) ? 1 : 0;
    return e; }

__device__ __forceinline__ void phase_moe_up(const bf16* H2, const bf16* Wgu, const int* cnt, const int* list, int cap, const float* route_w, bf16* ACT, LAS unsigned char* lds) {
    LAS int* pre = (LAS int*)(lds + GEMM_LDS);
    const int ntile = moe_prefix(cnt, pre);
    for (int r = 0; r * (int)gridDim.x < ntile * 8; ++r) {
        const int u = xcd_unit(r); if (u >= ntile * 8) continue;
        const int t = u >> 3, nt = u & 7, e = moe_find(pre, t), mt = t - pre[e], ce = cnt[e * 64];
        const int* le = list + (size_t)e * cap + mt * 256;
        const int nvalid = ce - mt * 256;
        const bf16* arow[4];
#pragma unroll
        for (int i = 0; i < 4; ++i) { const int r = (otid() >> 3) + 64 * i; const int ent = le[r < nvalid ? r : 0]; arow[i] = H2 + (size_t)(ent >> 1) * D; }
        gemm_tile(arow, Wgu + (size_t)e * 1024 * 1024 + (size_t)nt * 128 * 1024, 1024, 1024, lds, [&](const f32x16 (&acc)[2][2], int wm, int wn, int lane) {
#pragma unroll
            for (int mi = 0; mi < 2; ++mi) { const int r = wm * 64 + mi * 32 + (lane & 31);
                const float w = r < nvalid ? route_w[le[r]] : 0.f;
                LAS unsigned char* rp = lds + r * CST_BF64 + (wn * 32 + 4 * (lane >> 5)) * 2;
#pragma unroll
                for (int g = 0; g < 4; ++g) { float v[4];
#pragma unroll
                    for (int j = 0; j < 4; ++j) v[j] = siluf(acc[mi][0][4 * g + j]) * acc[mi][1][4 * g + j] * w;
                    u32x2 o; o[0] = pk2(v[0], v[1]); o[1] = pk2(v[2], v[3]); *(LAS u32x2*)(rp + 8 * g * 2) = o; } }
        });
        __syncthreads();
        flush_bf16_64(lds, [&](int r) -> bf16* { return r < nvalid ? ACT + (size_t)le[r] * 512 + nt * 64 : nullptr; });
        __syncthreads();
    }
}
__device__ __forceinline__ void phase_moe_down(const bf16* ACT, const bf16* Wd, const int* cnt, const int* list, int cap, bf16* Y2, LAS unsigned char* lds) {
    LAS int* pre = (LAS int*)(lds + GEMM_LDS);
    const int ntile = moe_prefix(cnt, pre);
    for (int r = 0; r * (int)gridDim.x < ntile * 8; ++r) {
        const int u = xcd_unit(r); if (u >= ntile * 8) continue;
        const int t = u >> 3, nt = u & 7, e = moe_find(pre, t), mt = t - pre[e], ce = cnt[e * 64];
        const int* le = list + (size_t)e * cap + mt * 256;
        const int nvalid = ce - mt * 256;
        const bf16* arow[4];
#pragma unroll
        for (int i = 0; i < 4; ++i) { const int r = (otid() >> 3) + 64 * i; const int ent = le[r < nvalid ? r : 0]; arow[i] = ACT + (size_t)ent * 512; }
        gemm_tile(arow, Wd + (size_t)e * 1024 * 512 + (size_t)nt * 128 * 512, 512, 512, lds, [&](const f32x16 (&acc)[2][2], int wm, int wn, int lane) { stage_bf16_128(acc, lds, wm, wn, lane); });
        __syncthreads();
        flush_bf16_128(lds, [&](int r) -> bf16* { return r < nvalid ? Y2 + (size_t)le[r] * D + nt * 128 : nullptr; });
        __syncthreads();
    }
}

template <int NB>
__device__ __forceinline__ void phase_qkv(const bf16* H, const bf16* Wt, const float* qn, const float* kn, bf16* QKV, LAS unsigned char* lds) {
    constexpr int T = NB * (SEQ + CTXL), MT = T / 256;
    for (int r = 0; r * (int)gridDim.x < MT * 24; ++r) {
        const int u = xcd_unit(r); if (u >= MT * 24) continue;
        int mt, nt; unit_tile(u, MT, 24, mt, nt);
        const bf16* arow[4];
#pragma unroll
        for (int i = 0; i < 4; ++i) arow[i] = H + (size_t)(mt * 256 + (otid() >> 3) + 64 * i) * D;
        gemm_tile(arow, Wt + (size_t)nt * 128 * D, D, D, lds, [&](const f32x16 (&acc)[2][2], int wm, int wn, int lane) {
            const int which = nt >> 3;
#pragma unroll
            for (int mi = 0; mi < 2; ++mi) {
                float rs = 1.f;
                if (which < 2) { float ss = 0.f;
#pragma unroll
                    for (int ni = 0; ni < 2; ++ni)
#pragma unroll
                        for (int r = 0; r < 16; ++r) ss += acc[mi][ni][r] * acc[mi][ni][r];
                    ss += __shfl_xor(ss, 32);
                    rs = rsqrtf(ss * (1.f / 64.f) + 1e-6f) * (which == 0 ? 0.125f : 1.f); }
                const float* nwp = which == 0 ? qn : kn;
                LAS unsigned char* rp = lds + (wm * 64 + mi * 32 + (lane & 31)) * CST_BF + (wn * 64 + 4 * (lane >> 5)) * 2;
#pragma unroll
                for (int ni = 0; ni < 2; ++ni)
#pragma unroll
                    for (int g = 0; g < 4; ++g) { float v[4];
#pragma unroll
                        for (int j = 0; j < 4; ++j) { v[j] = acc[mi][ni][4 * g + j]; if (which < 2) v[j] *= rs * nwp[ni * 32 + 8 * g + 4 * (lane >> 5) + j]; }
                        u32x2 o; o[0] = pk2(v[0], v[1]); o[1] = pk2(v[2], v[3]); *(LAS u32x2*)(rp + (ni * 32 + 8 * g) * 2) = o; } }
        });
        __syncthreads();
        flush_bf16_128(lds, [&](int r) { return QKV + (size_t)(mt * 256 + r) * 3072 + nt * 128; });
        __syncthreads();
    }
}

__device__ __forceinline__ bf16x8 frag16_row(const LAS unsigned char* T, int RS, int r0, int c0, int lane) {
    return *(const LAS bf16x8*)(T + (r0 + (lane & 15)) * RS + (c0 + 8 * (lane >> 4)) * 2);
}
__device__ __forceinline__ bf16x8 frag16_vt(const LAS unsigned char* T, int RS, int kb, int c0, int lane) {
    const int g4 = lane >> 4, q = (lane & 15) >> 2, p = lane & 3;
    const unsigned a0 = (unsigned)(size_t)(T + (kb + 4 * g4 + q) * RS + (c0 + 4 * p) * 2);
    const unsigned a1 = a0 + 16 * RS;
    bf16x4 v0, v1;
    asm volatile("ds_read_b64_tr_b16 %0, %2\n\tds_read_b64_tr_b16 %1, %3\n\ts_waitcnt lgkmcnt(0)" : "=&v"(v0), "=&v"(v1) : "v"(a0), "v"(a1) : "memory");
    bf16x8 r; r[0] = v0[0]; r[1] = v0[1]; r[2] = v0[2]; r[3] = v0[3]; r[4] = v1[0]; r[5] = v1[1]; r[6] = v1[2]; r[7] = v1[3];
    return r;
}

__device__ __forceinline__ int att_off(int row, int ch) { return 256 * row + 16 * (ch ^ (((row & 3) << 2) | ((row >> 2) & 3))); }
__device__ __forceinline__ bf16x8 att_krow(const LAS unsigned char* T, int r0, int c0, int lane) {
    return *(const LAS bf16x8*)(T + att_off(r0 + (lane & 15), (c0 >> 3) + (lane >> 4)));
}
__device__ __forceinline__ unsigned att_vaddr(const LAS unsigned char* T, int row, int col) { return (unsigned)(size_t)(T + att_off(row, col >> 3) + (col & 7) * 2); }

template <bool LOCAL>
__device__ __forceinline__ void attn_group(const LAS unsigned char* Kt, const LAS unsigned char* Vt, int koff, int kb, int hsel, int lane, int g4,
                                           const bf16x8& q0, const bf16x8& q1, f32x4 (&oacc)[4], float& l_run,
                                           int cs, int c, int brow  , const LAS float* rp) {
    f32x4 s[2];
#pragma unroll
    for (int sb = 0; sb < 2; ++sb) { s[sb] = (f32x4){0.f, 0.f, 0.f, 0.f};
        s[sb] = mfma16(att_krow(Kt, koff + kb + 16 * sb, hsel * 64, lane), q0, s[sb]);
        s[sb] = mfma16(att_krow(Kt, koff + kb + 16 * sb, hsel * 64 + 32, lane), q1, s[sb]); }
    float ps = 0.f; float p[8];
#pragma unroll
    for (int sb = 0; sb < 2; ++sb)
#pragma unroll
        for (int j = 0; j < 4; ++j) {
            float e;
            if (LOCAL) { const int kc = kb + 16 * sb + 4 * g4 + j; const bool ok = kc >= cs && kc < cs + 16;
                e = ok ? __expf(s[sb][j] + rp[hsel * 465 + (ok ? brow + (kc - c + 15) : 0)] - 8.f) : 0.f; }
            else e = __expf(s[sb][j] - 8.f);
            p[4 * sb + j] = e; ps += e; }
    l_run += ps;
    u32x4 pu; pu[0] = pk2(p[0], p[1]); pu[1] = pk2(p[2], p[3]); pu[2] = pk2(p[4], p[5]); pu[3] = pk2(p[6], p[7]);
    const bf16x8 pf = __builtin_bit_cast(bf16x8, pu);
    bf16x4 tv[4][2];
    {
        const int q = (lane & 15) >> 2, p4 = lane & 3;
        const int vr = koff + kb + 4 * g4 + q, vc = hsel * 64 + 4 * p4;
        tr8(att_vaddr(Vt, vr, vc), att_vaddr(Vt, vr + 16, vc), att_vaddr(Vt, vr, vc + 16), att_vaddr(Vt, vr + 16, vc + 16),
            att_vaddr(Vt, vr, vc + 32), att_vaddr(Vt, vr + 16, vc + 32), att_vaddr(Vt, vr, vc + 48), att_vaddr(Vt, vr + 16, vc + 48),
            tv[0][0], tv[0][1], tv[1][0], tv[1][1], tv[2][0], tv[2][1], tv[3][0], tv[3][1]);
    }
#pragma unroll
    for (int db = 0; db < 4; ++db) oacc[db] = mfma16(tr_join(tv[db][0], tv[db][1]), pf, oacc[db]);
}

template <bool LOCAL>
__device__ __forceinline__ void attn_group2(const LAS unsigned char* Kt, const LAS unsigned char* Vt, int koff, int kb, int hsel, int lane, int g4,
                                            const bf16x8 (&q0)[2], const bf16x8 (&q1)[2], f32x4 (&oacc)[2][4], float (&l_run)[2],
                                            int cs, int c, int brow0, int brow1, const LAS float* rp) {
    bf16x8 kf[2][2];
#pragma unroll
    for (int sb = 0; sb < 2; ++sb) { kf[sb][0] = att_krow(Kt, koff + kb + 16 * sb, hsel * 64, lane); kf[sb][1] = att_krow(Kt, koff + kb + 16 * sb, hsel * 64 + 32, lane); }
    f32x4 s[2][2];
#pragma unroll
    for (int qr = 0; qr < 2; ++qr)
#pragma unroll
        for (int sb = 0; sb < 2; ++sb) { s[qr][sb] = (f32x4){0.f, 0.f, 0.f, 0.f};
            s[qr][sb] = mfma16(kf[sb][0], q0[qr], s[qr][sb]); s[qr][sb] = mfma16(kf[sb][1], q1[qr], s[qr][sb]); }
    bf16x8 pf[2];
#pragma unroll
    for (int qr = 0; qr < 2; ++qr) {
        float ps = 0.f; float p[8];
        const int brow = qr ? brow1 : brow0;
#pragma unroll
        for (int sb = 0; sb < 2; ++sb)
#pragma unroll
            for (int j = 0; j < 4; ++j) {
                float e;
                if (LOCAL) { const int kc = kb + 16 * sb + 4 * g4 + j; const bool ok = kc >= cs && kc < cs + 16;
                    const float bv = rp[hsel * 465 + (ok ? brow + (kc - c + 15) : 0)];
                    const float ex = __expf(s[qr][sb][j] + bv - 8.f);
                    e = ok ? ex : 0.f; }
                else e = __expf(s[qr][sb][j] - 8.f);
                p[4 * sb + j] = e; ps += e; }
        l_run[qr] += ps;
        u32x4 pu; pu[0] = pk2(p[0], p[1]); pu[1] = pk2(p[2], p[3]); pu[2] = pk2(p[4], p[5]); pu[3] = pk2(p[6], p[7]);
        pf[qr] = __builtin_bit_cast(bf16x8, pu);
    }
    bf16x4 tv[4][2];
    {
        const int q = (lane & 15) >> 2, p4 = lane & 3;
        const int vr = koff + kb + 4 * g4 + q, vc = hsel * 64 + 4 * p4;
        tr8(att_vaddr(Vt, vr, vc), att_vaddr(Vt, vr + 16, vc), att_vaddr(Vt, vr, vc + 16), att_vaddr(Vt, vr + 16, vc + 16),
            att_vaddr(Vt, vr, vc + 32), att_vaddr(Vt, vr + 16, vc + 32), att_vaddr(Vt, vr, vc + 48), att_vaddr(Vt, vr + 16, vc + 48),
            tv[0][0], tv[0][1], tv[1][0], tv[1][1], tv[2][0], tv[2][1], tv[3][0], tv[3][1]);
    }
#pragma unroll
    for (int db = 0; db < 4; ++db) { const bf16x8 vf = tr_join(tv[db][0], tv[db][1]);
        oacc[0][db] = mfma16(vf, pf[0], oacc[0][db]); oacc[1][db] = mfma16(vf, pf[1], oacc[1][db]); }
}

constexpr int ATT_QR = 2;
template <int NB>
__device__ __forceinline__ void phase_attn(const bf16* QKV, const float* rpb, bf16* AO, LAS unsigned char* lds) {
    constexpr int TL = NB * SEQ;
    constexpr int TILE = 128 * 256;
    const int tid = otid(), lane = tid & 63, wave = tid >> 6, w = wave & 3, hsel = wave >> 2;
    const int qi = lane & 15, g4 = lane >> 4;
    LAS float* rp = (LAS float*)(lds + 4 * TILE);
    constexpr int QR = ATT_QR, NRG = 64 / QR;
    for (int u = blockIdx.x; u < NB * NRG * 8; u += gridDim.x) {
        const int hp = u & 7, rg = (u >> 3) % NRG, b = (u >> 3) / NRG;
        const int head = 2 * hp + hsel;
        int R0 = QR * rg - 4; R0 = R0 < 0 ? 0 : (R0 > 56 ? 56 : R0);
        int R1 = QR * rg + QR - 1 - 4; R1 = (R1 < 0 ? 0 : (R1 > 56 ? 56 : R1)) + 7;
        const int nloc = R1 - R0 + 1, nl2 = (nloc + 1) >> 1, nit = nl2 + 2;
        __syncthreads();
        for (int i = tid; i < 2 * 465; i += NTHR) rp[i] = rpb[(size_t)(2 * hp) * 465 + i];
        const int c = 16 * w + qi;
        int cs = c - 8; cs = cs < 0 ? 0 : (cs > 48 ? 48 : cs);
        const int kbw = w == 0 ? 0 : (w == 1 ? 8 : (w == 2 ? 24 : 32));
        bf16x8 q0[QR], q1[QR]; f32x4 oacc[QR][4]; float l_run[QR];
#pragma unroll
        for (int qr = 0; qr < QR; ++qr) {
            const size_t qrow = (size_t)b * SEQ + (QR * rg + qr) * 64 + c;
            q0[qr] = *(const bf16x8*)(QKV + qrow * 3072 + head * 64 + 8 * g4); q1[qr] = *(const bf16x8*)(QKV + qrow * 3072 + head * 64 + 32 + 8 * g4);
#pragma unroll
            for (int i = 0; i < 4; ++i) oacc[qr][i] = (f32x4){0.f, 0.f, 0.f, 0.f};
            l_run[qr] = 0.f; }
        const int dkey = 4 * wave + (lane >> 4), dsrc = (lane & 15) ^ ((((lane >> 4) & 3) << 2) | (wave & 3));
#define AT_DMA(it, buf) do { LAS unsigned char* kt_ = lds + (buf) * 2 * TILE + wave * 1024 + lane * 16; \
        _Pragma("unroll") for (int j = 0; j < 4; ++j) { const int key = dkey + 32 * j; \
            int kr_ = R0 + 2 * (it) + (key >> 6); kr_ = kr_ > 63 ? 63 : kr_; \
            const size_t krow = (it) < nl2 ? (size_t)b * SEQ + (size_t)kr_ * 64 + (key & 63) : (size_t)TL + (size_t)b * CTXL + ((it) - nl2) * 128 + key; \
            const bf16* kp = QKV + krow * 3072 + 1024 + hp * 128 + dsrc * 8; \
            __builtin_amdgcn_global_load_lds((const unsigned*)kp, (LAS unsigned*)(kt_ + j * 8192), 16, 0, 0); \
            __builtin_amdgcn_global_load_lds((const unsigned*)(kp + 1024), (LAS unsigned*)(kt_ + TILE + j * 8192), 16, 0, 0); } } while (0)
        AT_DMA(0, 0);
        __syncthreads();
        for (int it = 0; it < nit; ++it) {
            const LAS unsigned char* Kt = lds + (it & 1) * 2 * TILE; const LAS unsigned char* Vt = Kt + TILE;
            if (it + 1 < nit) AT_DMA(it + 1, (it + 1) & 1);
            if (it < nl2) {
                static_assert(QR == 2, "attn_group2 pairs two query rows");
                const int ra = QR * rg, rb = ra + 1;
                int r0a = ra - 4; r0a = r0a < 0 ? 0 : (r0a > 56 ? 56 : r0a);
                int r0b = rb - 4; r0b = r0b < 0 ? 0 : (r0b > 56 ? 56 : r0b);
#pragma unroll 1
                for (int sub = 0; sub < 2; ++sub) {
                    const int kr = R0 + 2 * it + sub;
                    const bool ina = kr >= r0a && kr < r0a + 8, inb = kr >= r0b && kr < r0b + 8;
                    if (ina && inb) attn_group2<true>(Kt, Vt, 64 * sub, kbw, hsel, lane, g4, q0, q1, oacc, l_run, cs, c, (kr - ra + 7) * 31, (kr - rb + 7) * 31, rp);
                    else if (ina) attn_group<true>(Kt, Vt, 64 * sub, kbw, hsel, lane, g4, q0[0], q1[0], oacc[0], l_run[0], cs, c, (kr - ra + 7) * 31, rp);
                    else if (inb) attn_group<true>(Kt, Vt, 64 * sub, kbw, hsel, lane, g4, q0[1], q1[1], oacc[1], l_run[1], cs, c, (kr - rb + 7) * 31, rp);
                }
            } else {
#pragma unroll 1
                for (int g = 0; g < 4; ++g) attn_group2<false>(Kt, Vt, 0, 32 * g, hsel, lane, g4, q0, q1, oacc, l_run, 0, 0, 0, 0, rp);
            }
            __syncthreads();
        }
#undef AT_DMA
#pragma unroll
        for (int qr = 0; qr < QR; ++qr) {
            float l = l_run[qr]; l += __shfl_xor(l, 16); l += __shfl_xor(l, 32);
            const float inv = 1.f / l;
            const size_t qrow = (size_t)b * SEQ + (QR * rg + qr) * 64 + c;
            bf16* op = AO + qrow * D + head * 64 + 4 * g4;
#pragma unroll
            for (int db = 0; db < 4; ++db) { u32x2 o; o[0] = pk2(oacc[qr][db][0] * inv, oacc[qr][db][1] * inv); o[1] = pk2(oacc[qr][db][2] * inv, oacc[qr][db][3] * inv); *(u32x2*)(op + 16 * db) = o; }
        }
    }
}
}
namespace fx {
namespace g8 {
constexpr int BM = 256, BK = 64, HALF = 128, HTB = HALF * BK * 2, STAGE_BYTES = 8 * HTB;
__device__ __forceinline__ int lds_byte(int r, int c) { const int st = (r >> 4) * 2 + (c >> 5), rr = r & 15, cc = c & 31, ob = rr * 64 + cc * 2; return st * 1024 + (ob ^ (((ob >> 9) & 1) << 5)); }
__device__ __forceinline__ void stage_rc(int b, int& R, int& C) { const int st = b / 1024, sb = b % 1024, swz = sb ^ (((sb >> 9) & 1) << 5); R = (st >> 1) * 16 + swz / 64; C = (st & 1) * 32 + (swz % 64) / 2; }
__device__ __forceinline__ int perm32(int rho) { const int n = rho >> 4, i = rho & 15; return 8 * (i >> 2) + 4 * n + (i & 3); }
struct Unit { int pm, pn, i0; const int* p; };

template <class Epi, class Sched>
__device__ __forceinline__ void gemm_phase(LAS unsigned char* lds, int K, const Sched& S, const Epi& E) {
    const int tid = otid(), wid = __builtin_amdgcn_readfirstlane(tid >> 6), lane = tid & 63, wr = wid >> 2, wc = wid & 3, fr = lane & 15, fq = lane >> 4;
    const int nt = K / BK;
    int Rr[2], Cc[2]; unsigned voffB[2];
#pragma unroll
    for (int i = 0; i < 2; ++i) { int R, C; stage_rc(tid * 16 + i * 8192, R, C); Rr[i] = R; Cc[i] = C;
        const int Rb = Epi::PERM ? ((R & ~31) + perm32(R & 31)) : R; voffB[i] = (unsigned)(Rb * K + C) * 2u; }
    const size_t kstep = (size_t)(BK * 2);
    const size_t hstepB = (size_t)HALF * K * 2;
    const unsigned ldsw = (unsigned)wid * 1024u;
    const int aoff = lds_byte(wr * 64 + fr, fq * 8), boff = lds_byte(wc * 32 + fr, fq * 8);
#define G8_SA(b, h) (((b) * 2 + (h)) * HTB)
#define G8_SB(b, h) ((4 + (b) * 2 + (h)) * HTB)
#define G8_STAGE_B(bufoff, gbase) do { _Pragma("unroll") for (int _i = 0; _i < 2; ++_i) \
        __builtin_amdgcn_global_load_lds((const unsigned*)((const char*)(gbase) + voffB[_i]), (LAS unsigned*)(lds + (bufoff) + ldsw + _i * 8192), 16, 0, 0); } while (0)
#define G8_STAGE_A(bufoff, gbase, o0, o1) do { \
        __builtin_amdgcn_global_load_lds((const unsigned*)((const char*)(gbase) + (o0)), (LAS unsigned*)(lds + (bufoff) + ldsw), 16, 0, 0); \
        __builtin_amdgcn_global_load_lds((const unsigned*)((const char*)(gbase) + (o1)), (LAS unsigned*)(lds + (bufoff) + ldsw + 8192), 16, 0, 0); } while (0)
#define G8_LDA(dst, b, h) do { _Pragma("unroll") for (int m = 0; m < 4; ++m) _Pragma("unroll") for (int k = 0; k < 2; ++k) dst[m][k] = *(const LAS bf16x8*)(lds + G8_SA(b, h) + aoff + m * 2048 + k * 1024); } while (0)
#define G8_LDB(dst, b, h) do { _Pragma("unroll") for (int n = 0; n < 2; ++n) _Pragma("unroll") for (int k = 0; k < 2; ++k) dst[n][k] = *(const LAS bf16x8*)(lds + G8_SB(b, h) + boff + n * 2048 + k * 1024); } while (0)
#define G8_MMA(ai, bj, At, Bt) do { __builtin_amdgcn_s_setprio(1); _Pragma("unroll") for (int m = 0; m < 4; ++m) _Pragma("unroll") for (int n = 0; n < 2; ++n) _Pragma("unroll") for (int k = 0; k < 2; ++k) \
        acc[ai][bj][m][n] = __builtin_amdgcn_mfma_f32_16x16x32_bf16(Bt[n][k], At[m][k], acc[ai][bj][m][n], 0, 0, 0); __builtin_amdgcn_s_setprio(0); } while (0)
#define G8_WAIT_V(n) asm volatile("s_waitcnt vmcnt(" #n ")" ::: "memory")
#define G8_WAIT_L(n) asm volatile("s_waitcnt lgkmcnt(" #n ")" ::: "memory")
#define G8_BAR __builtin_amdgcn_s_barrier()
#define G8_SCHED __builtin_amdgcn_sched_barrier(0)
    Unit cur, nxt; int ui = 0;
    if (!S.next(0, cur)) return;
    f32x4 acc[2][2][4][2];
#pragma unroll
    for (int a = 0; a < 2; ++a)
#pragma unroll
        for (int b = 0; b < 2; ++b)
#pragma unroll
            for (int m = 0; m < 4; ++m)
#pragma unroll
                for (int n = 0; n < 2; ++n) acc[a][b][m][n] = (f32x4){0.f, 0.f, 0.f, 0.f};
    bf16x8 At[4][2], B0[2][2], B1[2][2];
    unsigned oaC[2][2], oaN[2][2]; const char* cAb; const char* cB; const char* nAb; const char* nB;
    S.src(cur, Rr, Cc, oaC, cAb, cB);
    G8_STAGE_B(G8_SB(0, 0), cB); G8_STAGE_A(G8_SA(0, 0), cAb, oaC[0][0], oaC[0][1]); G8_STAGE_B(G8_SB(0, 1), cB + hstepB); G8_STAGE_A(G8_SA(0, 1), cAb, oaC[1][0], oaC[1][1]);
    if (wr == 1) G8_BAR;
    G8_WAIT_V(4); G8_BAR;
    G8_STAGE_B(G8_SB(1, 0), cB + kstep); G8_STAGE_A(G8_SA(1, 0), cAb + kstep, oaC[0][0], oaC[0][1]); G8_STAGE_B(G8_SB(1, 1), cB + hstepB + kstep);
    G8_WAIT_V(6); G8_BAR;
    for (;;) {
        const bool has_next = S.next(ui + 1, nxt);
        if (has_next) S.src(nxt, Rr, Cc, oaN, nAb, nB);
        else { nAb = cAb; nB = cB;
#pragma unroll
            for (int h = 0; h < 2; ++h)
#pragma unroll
                for (int i = 0; i < 2; ++i) oaN[h][i] = oaC[h][i]; }
        for (int t = 0; t < nt; t += 2) {
            const bool last = (t == nt - 2);
            const char* a1 = cAb + (size_t)(t + 1) * kstep;
            const char* a2 = last ? nAb : cAb + (size_t)(t + 2) * kstep; const char* b2 = last ? nB : cB + (size_t)(t + 2) * kstep;
            const char* a3 = a2 + kstep; const char* b3 = b2 + kstep;
            const unsigned o00 = last ? oaN[0][0] : oaC[0][0], o01 = last ? oaN[0][1] : oaC[0][1], o10 = last ? oaN[1][0] : oaC[1][0], o11 = last ? oaN[1][1] : oaC[1][1];
            G8_LDB(B0, 0, 0); G8_SCHED; G8_LDA(At, 0, 0); G8_STAGE_A(G8_SA(1, 1), a1, oaC[1][0], oaC[1][1]);
            G8_WAIT_L(8); G8_BAR; G8_WAIT_L(0); G8_MMA(0, 0, At, B0); G8_BAR; G8_SCHED;
            G8_LDB(B1, 0, 1); G8_STAGE_B(G8_SB(0, 0), b2);
            G8_BAR; G8_WAIT_L(0); G8_MMA(0, 1, At, B1); G8_BAR;
            G8_LDA(At, 0, 1); G8_STAGE_A(G8_SA(0, 0), a2, o00, o01);
            G8_BAR; G8_WAIT_L(0); G8_MMA(1, 0, At, B0); G8_BAR; G8_SCHED;
            G8_STAGE_B(G8_SB(0, 1), b2 + hstepB);
            G8_WAIT_V(6); G8_BAR; G8_MMA(1, 1, At, B1); G8_BAR;
            G8_LDB(B0, 1, 0); G8_SCHED; G8_LDA(At, 1, 0); G8_STAGE_A(G8_SA(0, 1), a2, o10, o11);
            G8_WAIT_L(8); G8_BAR; G8_WAIT_L(0); G8_MMA(0, 0, At, B0); G8_BAR; G8_SCHED;
            G8_LDB(B1, 1, 1); G8_STAGE_B(G8_SB(1, 0), b3);
            G8_BAR; G8_WAIT_L(0); G8_MMA(0, 1, At, B1); G8_BAR;
            G8_LDA(At, 1, 1); G8_STAGE_A(G8_SA(1, 0), a3, o00, o01);
            G8_BAR; G8_WAIT_L(0); G8_MMA(1, 0, At, B0); G8_BAR; G8_SCHED;
            G8_STAGE_B(G8_SB(1, 1), b3 + hstepB);
            G8_WAIT_V(6); G8_BAR; G8_MMA(1, 1, At, B1); G8_BAR;
        }
        E(acc, cur, wr, wc, fr, fq);
        if (!has_next) break;
#pragma unroll
        for (int a = 0; a < 2; ++a)
#pragma unroll
            for (int b = 0; b < 2; ++b)
#pragma unroll
                for (int m = 0; m < 4; ++m)
#pragma unroll
                    for (int n = 0; n < 2; ++n) acc[a][b][m][n] = (f32x4){0.f, 0.f, 0.f, 0.f};
        cur = nxt; cAb = nAb; cB = nB; ++ui;
#pragma unroll
        for (int h = 0; h < 2; ++h)
#pragma unroll
            for (int i = 0; i < 2; ++i) oaC[h][i] = oaN[h][i];
    }
    G8_WAIT_V(0);
    if (wr == 0) G8_BAR;
    G8_BAR;
#undef G8_SA
#undef G8_SB
#undef G8_STAGE_A
#undef G8_STAGE_B
#undef G8_LDA
#undef G8_LDB
#undef G8_MMA
#undef G8_WAIT_V
#undef G8_WAIT_L
#undef G8_BAR
#undef G8_SCHED
}

struct DenseSched {
    const bf16* A; int lda; const bf16* Bt; int K; int MT, NT; int F;
    __device__ __forceinline__ bool next(int i, Unit& u) const { const int G = gridDim.x; if (i >= F || i * G >= MT * NT) return false; const int ul = xcd_unit(i); if (ul >= MT * NT) return false;
        int mt, nt_; unit_tile(ul, MT, NT, mt, nt_); u.pm = mt; u.pn = nt_; u.i0 = 0; u.p = nullptr; return true; }
    __device__ __forceinline__ void src(const Unit& u, const int (&R)[2], const int (&C)[2], unsigned (&oa)[2][2], const char*& abase, const char*& bbase) const {
        abase = (const char*)(A + (size_t)u.pm * 256 * lda); bbase = (const char*)(Bt + (size_t)u.pn * 256 * K);
#pragma unroll
        for (int h = 0; h < 2; ++h)
#pragma unroll
            for (int i = 0; i < 2; ++i) oa[h][i] = (unsigned)((128 * h + R[i]) * lda + C[i]) * 2u; }
};
}

struct EpiProj {
    static constexpr bool PERM = true;
    bf16* O; int ldc;
    __device__ __forceinline__ void operator()(const f32x4 (&acc)[2][2][4][2], const g8::Unit& u, int wr, int wc, int fr, int fq) const {
        const int row0 = u.pm * 256 + wr * 64 + fr, col0 = u.pn * 256 + wc * 32 + 8 * fq;
#pragma unroll
        for (int ai = 0; ai < 2; ++ai)
#pragma unroll
            for (int m = 0; m < 4; ++m) { bf16* rowp = O + (size_t)(row0 + ai * 128 + m * 16) * ldc + col0;
#pragma unroll
                for (int bj = 0; bj < 2; ++bj) { const f32x4 v0 = acc[ai][bj][m][0], v1 = acc[ai][bj][m][1];
                    u32x4 w; w[0] = pk2(v0[0], v0[1]); w[1] = pk2(v0[2], v0[3]); w[2] = pk2(v1[0], v1[1]); w[3] = pk2(v1[2], v1[3]);
                    *(u32x4*)(rowp + bj * 128) = w; } }
    }
};
template <int NB>
__device__ __forceinline__ void phase_inproj8(const bf16* H, const bf16* Wt, bf16* PROJ, float* GATES, LAS unsigned char* lds) {
    constexpr int T = NB * (SEQ + CTXL), MT = T / 256;
    g8::DenseSched S{H, D, Wt, D, MT, PROJW / 256, 1 << 20};
    EpiProj E{PROJ, PROJW};
    g8::gemm_phase(lds, D, S, E);
    const int G = gridDim.x, NU = MT * (PROJW / 256), lastr = (NU + G - 1) / G - 1, nidle = (lastr + 1) * G - NU;
    int gstart = blockIdx.x, gstep = G;
    if (nidle >= 24) { const int u = xcd_unit(lastr); gstart = u >= NU ? u - NU : MT; gstep = nidle; }
    for (int mt = gstart; mt < MT; mt += gstep) {
        const bf16* arow[4];
#pragma unroll
        for (int i = 0; i < 4; ++i) arow[i] = H + (size_t)(mt * 256 + (otid() >> 3) + 64 * i) * D;
        gemm_tile(arow, Wt + (size_t)PROJW * D, D, D, lds, [&](const f32x16 (&acc)[2][2], int wm, int wn, int lane) {
            if (wn == 0) {
#pragma unroll
                for (int mi = 0; mi < 2; ++mi) { const int row = mt * 256 + wm * 64 + mi * 32 + (lane & 31);
#pragma unroll
                    for (int ni = 0; ni < 2; ++ni)
#pragma unroll
                        for (int g = 0; g < 4; ++g) { f32x4 o; o[0] = acc[mi][ni][4 * g]; o[1] = acc[mi][ni][4 * g + 1]; o[2] = acc[mi][ni][4 * g + 2]; o[3] = acc[mi][ni][4 * g + 3];
                            *(f32x4*)(GATES + (size_t)row * 64 + ni * 32 + 8 * g + 4 * (lane >> 5)) = o; } } }
        });
        __syncthreads();
    }
}
template <int NB, bool XIN_BF> struct EpiResid {
    static constexpr bool PERM = true;
    const float* xl; const float* xc; const float* modl; bf16* Xout;
    __device__ __forceinline__ void operator()(const f32x4 (&acc)[2][2][4][2], const g8::Unit& u, int wr, int wc, int fr, int fq) const {
        constexpr int TL = NB * SEQ;
        const float* mv = modl + (size_t)mod_row<NB>(u.pm * 256) * 6144 + 2 * 1024;
        const int col0 = u.pn * 256 + wc * 32 + 8 * fq;
#pragma unroll
        for (int ai = 0; ai < 2; ++ai)
#pragma unroll
            for (int m = 0; m < 4; ++m) { const int row = u.pm * 256 + ai * 128 + wr * 64 + m * 16 + fr;
                const size_t soff = (row < TL ? (size_t)row * D : (size_t)(row - TL) * D) + col0;
                bf16* dstp = Xout + (size_t)row * D + col0;
#pragma unroll
                for (int bj = 0; bj < 2; ++bj) { const int co = bj * 128;
                    f32x4 x0, x1;
                    if (XIN_BF) { const u32x4 t4 = *(const u32x4*)((const bf16*)(row < TL ? xl : xc) + soff + co);
                        x0 = (f32x4){bflo(t4[0]), bfhi(t4[0]), bflo(t4[1]), bfhi(t4[1])}; x1 = (f32x4){bflo(t4[2]), bfhi(t4[2]), bflo(t4[3]), bfhi(t4[3])}; }
                    else { const float* sp = (row < TL ? xl : xc) + soff + co; x0 = *(const f32x4*)sp; x1 = *(const f32x4*)(sp + 4); }
                    const f32x4 m0 = *(const f32x4*)(mv + col0 + co), m1 = *(const f32x4*)(mv + col0 + co + 4);
                    float o[8];
#pragma unroll
                    for (int j = 0; j < 4; ++j) { o[j] = x0[j] + m0[j] * acc[ai][bj][m][0][j]; o[4 + j] = x1[j] + m1[j] * acc[ai][bj][m][1][j]; }
                    u32x4 w; w[0] = pk2(o[0], o[1]); w[1] = pk2(o[2], o[3]); w[2] = pk2(o[4], o[5]); w[3] = pk2(o[6], o[7]);
                    *(u32x4*)(dstp + co) = w; } }
    }
};
template <int NB, bool XIN_BF, class Idle>
__device__ __forceinline__ void phase_outproj8(const bf16* A, int lda, int K, const bf16* Wt, int nrows, const float* xl, const float* xc, const float* modl, bf16* Xout, LAS unsigned char* lds, Idle&& idle) {
    constexpr int TL = NB * SEQ;
    const int MT = nrows / 256, U = MT * 4, G = gridDim.x, F = U / G, R = U - F * G;
    if (F > 0) { g8::DenseSched S{A, lda, Wt, K, MT, 4, F}; EpiResid<NB, XIN_BF> E{xl, xc, modl, Xout}; g8::gemm_phase(lds, K, S, E); }
    for (int r = 0; r * G < 2 * R; ++r) {
        const int hu = r * G + (int)blockIdx.x;
        if (hu >= 2 * R) { idle(hu - 2 * R, (r + 1) * G - 2 * R); continue; }
        int mt, nt2; unit_tile(F * G + (hu >> 1), MT, 4, mt, nt2);
        const int nt = 2 * nt2 + (hu & 1);
        const bf16* arow[4];
#pragma unroll
        for (int i = 0; i < 4; ++i) arow[i] = A + (size_t)(mt * 256 + (otid() >> 3) + 64 * i) * lda;
        gemm_tile(arow, Wt + (size_t)nt * 128 * K, K, K, lds, [&](const f32x16 (&acc)[2][2], int wm, int wn, int lane) { stage_f32_128(acc, lds, wm, wn, lane); });
        __syncthreads();
        {
            const float* mv = modl + (size_t)mod_row<NB>(mt * 256) * 6144 + 2 * 1024 + nt * 128;
            const int t = otid(), piece = t & 31;
            const f32x4 m2 = *(const f32x4*)(mv + piece * 4);
#pragma unroll 4
            for (int it = 0; it < 16; ++it) { const int rl = it * 16 + (t >> 5), row = mt * 256 + rl;
                const f32x4 a = *(const LAS f32x4*)(lds + rl * CST_F32 + piece * 16);
                const size_t soff = (row < TL ? (size_t)row * D : (size_t)(row - TL) * D) + nt * 128 + piece * 4;
                f32x4 xv;
                if (XIN_BF) { const u32x2 t2 = *(const u32x2*)((const bf16*)(row < TL ? xl : xc) + soff); xv = (f32x4){bflo(t2[0]), bfhi(t2[0]), bflo(t2[1]), bfhi(t2[1])}; }
                else xv = *(const f32x4*)((row < TL ? xl : xc) + soff);
                u32x2 o2; o2[0] = pk2(xv[0] + m2[0] * a[0], xv[1] + m2[1] * a[1]); o2[1] = pk2(xv[2] + m2[2] * a[2], xv[3] + m2[3] * a[3]);
                *(u32x2*)(Xout + (size_t)row * D + nt * 128 + piece * 4) = o2; }
        }
        __syncthreads();
    }
}
template <bool UP> struct MoeSched {
    const bf16* Abuf; const bf16* W; const int* cnt; const int* list; int cap; const LAS int* pre; int ntile; int F;
    static constexpr int KK = UP ? 1024 : 512;
    __device__ __forceinline__ bool next(int i, g8::Unit& u) const { const int G = gridDim.x; if (i >= F) return false; const int ul = xcd_unit(i); if (ul >= ntile * 4) return false;
        const int t = ul >> 2, e = moe_find(pre, t), mt = t - pre[e]; u.pm = e; u.pn = ul & 3; u.i0 = cnt[e * 64] - mt * 256; u.p = list + (size_t)e * cap + mt * 256; return true; }
    __device__ __forceinline__ void src(const g8::Unit& u, const int (&R)[2], const int (&C)[2], unsigned (&oa)[2][2], const char*& abase, const char*& bbase) const {
        abase = (const char*)Abuf; bbase = (const char*)(W + (size_t)u.pm * 1024 * KK + (size_t)u.pn * 256 * KK);
#pragma unroll
        for (int h = 0; h < 2; ++h)
#pragma unroll
            for (int i = 0; i < 2; ++i) { const int r = 128 * h + R[i]; const int ent = u.p[r < u.i0 ? r : 0];
                oa[h][i] = (unsigned)((UP ? (ent >> 1) * 1024 : ent * 512) + C[i]) * 2u; } }
};
struct EpiMoeUp8 {
    static constexpr bool PERM = true;
    const float* route_w; bf16* ACT;
    __device__ __forceinline__ void operator()(const f32x4 (&acc)[2][2][4][2], const g8::Unit& u, int wr, int wc, int fr, int fq) const {
#pragma unroll
        for (int ai = 0; ai < 2; ++ai)
#pragma unroll
            for (int m = 0; m < 4; ++m) { const int r = ai * 128 + wr * 64 + m * 16 + fr;
                if (r < u.i0) { const int ent = u.p[r]; const float w = route_w[ent];
                    float v[8];
#pragma unroll
                    for (int n = 0; n < 2; ++n)
#pragma unroll
                        for (int j = 0; j < 4; ++j) v[4 * n + j] = siluf(acc[ai][0][m][n][j]) * acc[ai][1][m][n][j] * w;
                    u32x4 o; o[0] = pk2(v[0], v[1]); o[1] = pk2(v[2], v[3]); o[2] = pk2(v[4], v[5]); o[3] = pk2(v[6], v[7]);
                    *(u32x4*)(ACT + (size_t)ent * 512 + u.pn * 128 + wc * 32 + 8 * fq) = o; } }
    }
};
struct EpiMoeDown8 {
    static constexpr bool PERM = true;
    bf16* Y2;
    __device__ __forceinline__ void operator()(const f32x4 (&acc)[2][2][4][2], const g8::Unit& u, int wr, int wc, int fr, int fq) const {
#pragma unroll
        for (int ai = 0; ai < 2; ++ai)
#pragma unroll
            for (int m = 0; m < 4; ++m) { const int r = ai * 128 + wr * 64 + m * 16 + fr;
                if (r < u.i0) { bf16* rowp = Y2 + (size_t)u.p[r] * D + u.pn * 256 + wc * 32 + 8 * fq;
#pragma unroll
                    for (int bj = 0; bj < 2; ++bj) { const f32x4 v0 = acc[ai][bj][m][0], v1 = acc[ai][bj][m][1];
                        u32x4 o; o[0] = pk2(v0[0], v0[1]); o[1] = pk2(v0[2], v0[3]); o[2] = pk2(v1[0], v1[1]); o[3] = pk2(v1[2], v1[3]);
                        *(u32x4*)(rowp + bj * 128) = o; } } }
    }
};
struct BRowGU { int s; __device__ __forceinline__ int operator()(int r) const { return ((r >> 5) & 1) * 128 + 64 * s + (r >> 6) * 32 + (r & 31); } };

__device__ __forceinline__ void phase_moe_up8(const bf16* H2, const bf16* Wgu, const int* cnt, const int* list, int cap, const float* route_w, bf16* ACT, LAS unsigned char* lds) {
    LAS int* pre = (LAS int*)(lds + GEMM_LDS);
    const int ntile = moe_prefix(cnt, pre);
    const int G = gridDim.x, U = ntile * 4, F = U / G, R = U - F * G;
    if (F > 0) { MoeSched<true> S{H2, Wgu, cnt, list, cap, pre, ntile, F}; EpiMoeUp8 E{route_w, ACT}; g8::gemm_phase(lds, 1024, S, E); }
    for (int r = 0; r * G < 2 * R; ++r) {
        const int hu = r * G + (int)blockIdx.x; if (hu >= 2 * R) continue;
        const int ul = F * G + (hu >> 1), s = hu & 1, t = ul >> 2, pn = ul & 3, e = moe_find(pre, t), mt = t - pre[e], ce = cnt[e * 64];
        const int* le = list + (size_t)e * cap + mt * 256;
        const int nvalid = ce - mt * 256;
        const bf16* arow[4];
#pragma unroll
        for (int i = 0; i < 4; ++i) { const int rr = (otid() >> 3) + 64 * i; const int ent = le[rr < nvalid ? rr : 0]; arow[i] = H2 + (size_t)(ent >> 1) * D; }
        gemm_tile(arow, Wgu + (size_t)e * 1024 * 1024 + (size_t)pn * 256 * 1024, 1024, 1024, lds, [&](const f32x16 (&acc)[2][2], int wm, int wn, int lane) {
#pragma unroll
            for (int mi = 0; mi < 2; ++mi) { const int rr = wm * 64 + mi * 32 + (lane & 31);
                const float w = rr < nvalid ? route_w[le[rr]] : 0.f;
                LAS unsigned char* rp = lds + rr * CST_BF64 + (wn * 32 + 4 * (lane >> 5)) * 2;
#pragma unroll
                for (int g = 0; g < 4; ++g) { float v[4];
#pragma unroll
                    for (int j = 0; j < 4; ++j) v[j] = siluf(acc[mi][0][4 * g + j]) * acc[mi][1][4 * g + j] * w;
                    u32x2 o; o[0] = pk2(v[0], v[1]); o[1] = pk2(v[2], v[3]); *(LAS u32x2*)(rp + 8 * g * 2) = o; } }
        }, BRowGU{s});
        __syncthreads();
        flush_bf16_64(lds, [&](int rr) -> bf16* { return rr < nvalid ? ACT + (size_t)le[rr] * 512 + pn * 128 + 64 * s : nullptr; });
        __syncthreads();
    }
}
__device__ __forceinline__ void phase_moe_down8(const bf16* ACT, const bf16* Wd, const int* cnt, const int* list, int cap, bf16* Y2, LAS unsigned char* lds) {
    LAS int* pre = (LAS int*)(lds + GEMM_LDS);
    const int ntile = moe_prefix(cnt, pre);
    const int G = gridDim.x, U = ntile * 4, F = U / G, R = U - F * G;
    if (F > 0) { MoeSched<false> S{ACT, Wd, cnt, list, cap, pre, ntile, F}; EpiMoeDown8 E{Y2}; g8::gemm_phase(lds, 512, S, E); }
    for (int r = 0; r * G < 2 * R; ++r) {
        const int hu = r * G + (int)blockIdx.x; if (hu >= 2 * R) continue;
        const int ul = F * G + (hu >> 1), t = ul >> 2, nt = 2 * (ul & 3) + (hu & 1), e = moe_find(pre, t), mt = t - pre[e], ce = cnt[e * 64];
        const int* le = list + (size_t)e * cap + mt * 256;
        const int nvalid = ce - mt * 256;
        const bf16* arow[4];
#pragma unroll
        for (int i = 0; i < 4; ++i) { const int rr = (otid() >> 3) + 64 * i; const int ent = le[rr < nvalid ? rr : 0]; arow[i] = ACT + (size_t)ent * 512; }
        gemm_tile(arow, Wd + (size_t)e * 1024 * 512 + (size_t)nt * 128 * 512, 512, 512, lds, [&](const f32x16 (&acc)[2][2], int wm, int wn, int lane) { stage_bf16_128(acc, lds, wm, wn, lane); });
        __syncthreads();
        flush_bf16_128(lds, [&](int rr) -> bf16* { return rr < nvalid ? Y2 + (size_t)le[rr] * D + nt * 128 : nullptr; });
        __syncthreads();
    }
}
struct EpiQKV8 {
    static constexpr bool PERM = true;
    const float* qn; const float* kn; bf16* QKV; LAS float* xbuf;
    __device__ __forceinline__ void operator()(const f32x4 (&acc)[2][2][4][2], const g8::Unit& u, int wr, int wc, int fr, int fq) const {
        const int which = u.pn >> 2, wid = wr * 4 + wc;
        float rs[2][4][2];
        if (which < 2) {
#pragma unroll
            for (int ai = 0; ai < 2; ++ai)
#pragma unroll
                for (int m = 0; m < 4; ++m)
#pragma unroll
                    for (int bj = 0; bj < 2; ++bj) { float ss = 0.f;
#pragma unroll
                        for (int n = 0; n < 2; ++n)
#pragma unroll
                            for (int j = 0; j < 4; ++j) ss += acc[ai][bj][m][n][j] * acc[ai][bj][m][n][j];
                        ss += __shfl_xor(ss, 16); ss += __shfl_xor(ss, 32);
                        rs[ai][m][bj] = ss;
                        if (fq == 0) xbuf[(wid * 16 + (ai * 4 + m) * 2 + bj) * 16 + fr] = ss; }
        }
        asm volatile("s_waitcnt lgkmcnt(0)" ::: "memory");
        __builtin_amdgcn_s_barrier();
        asm volatile("" ::: "memory");
        const float* nwp = which == 0 ? qn : kn;
        const int hc = (wc & 1) * 32 + 8 * fq;
#pragma unroll
        for (int ai = 0; ai < 2; ++ai)
#pragma unroll
            for (int m = 0; m < 4; ++m) { const int row = u.pm * 256 + ai * 128 + wr * 64 + m * 16 + fr;
                bf16* rowp = QKV + (size_t)row * 3072 + u.pn * 256 + wc * 32 + 8 * fq;
#pragma unroll
                for (int bj = 0; bj < 2; ++bj) { f32x4 v0 = acc[ai][bj][m][0], v1 = acc[ai][bj][m][1];
                    if (which < 2) {
                        const float tot = rs[ai][m][bj] + xbuf[((wid ^ 1) * 16 + (ai * 4 + m) * 2 + bj) * 16 + fr];
                        const float sc = rsqrtf(tot * (1.f / 64.f) + 1e-6f) * (which == 0 ? 0.125f : 1.f);
                        const f32x4 w0 = *(const f32x4*)(nwp + hc), w1 = *(const f32x4*)(nwp + hc + 4);
#pragma unroll
                        for (int j = 0; j < 4; ++j) { v0[j] *= sc * w0[j]; v1[j] *= sc * w1[j]; } }
                    u32x4 o; o[0] = pk2(v0[0], v0[1]); o[1] = pk2(v0[2], v0[3]); o[2] = pk2(v1[0], v1[1]); o[3] = pk2(v1[2], v1[3]);
                    *(u32x4*)(rowp + bj * 128) = o; } }
    }
};
template <int NB>
__device__ __forceinline__ void phase_qkv8(const bf16* H, const bf16* Wt, const float* qn, const float* kn, bf16* QKV, LAS unsigned char* lds) {
    constexpr int T = NB * (SEQ + CTXL), MT = T / 256, U = MT * 12;
    const int G = gridDim.x, F = U / G, R = U - F * G;
    if (F > 0) { g8::DenseSched S{H, D, Wt, D, MT, 12, F}; EpiQKV8 E{qn, kn, QKV, (LAS float*)(lds + g8::STAGE_BYTES)}; g8::gemm_phase(lds, D, S, E); }
    for (int r = 0; r * G < 2 * R; ++r) {
        const int hu = r * G + (int)blockIdx.x; if (hu >= 2 * R) continue;
        int mt, nt2; unit_tile(F * G + (hu >> 1), MT, 12, mt, nt2);
        const int nt = 2 * nt2 + (hu & 1);
        const bf16* arow[4];
#pragma unroll
        for (int i = 0; i < 4; ++i) arow[i] = H + (size_t)(mt * 256 + (otid() >> 3) + 64 * i) * D;
        gemm_tile(arow, Wt + (size_t)nt * 128 * D, D, D, lds, [&](const f32x16 (&acc)[2][2], int wm, int wn, int lane) {
            const int which = nt >> 3;
#pragma unroll
            for (int mi = 0; mi < 2; ++mi) {
                float rsv = 1.f;
                if (which < 2) { float ss = 0.f;
#pragma unroll
                    for (int ni = 0; ni < 2; ++ni)
#pragma unroll
                        for (int q = 0; q < 16; ++q) ss += acc[mi][ni][q] * acc[mi][ni][q];
                    ss += __shfl_xor(ss, 32);
                    rsv = rsqrtf(ss * (1.f / 64.f) + 1e-6f) * (which == 0 ? 0.125f : 1.f); }
                const float* nwp = which == 0 ? qn : kn;
                LAS unsigned char* rp = lds + (wm * 64 + mi * 32 + (lane & 31)) * CST_BF + (wn * 64 + 4 * (lane >> 5)) * 2;
#pragma unroll
                for (int ni = 0; ni < 2; ++ni)
#pragma unroll
                    for (int g = 0; g < 4; ++g) { float v[4];
#pragma unroll
                        for (int j = 0; j < 4; ++j) { v[j] = acc[mi][ni][4 * g + j]; if (which < 2) v[j] *= rsv * nwp[ni * 32 + 8 * g + 4 * (lane >> 5) + j]; }
                        u32x2 o; o[0] = pk2(v[0], v[1]); o[1] = pk2(v[2], v[3]); *(LAS u32x2*)(rp + (ni * 32 + 8 * g) * 2) = o; } }
        });
        __syncthreads();
        flush_bf16_128(lds, [&](int rr) { return QKV + (size_t)(mt * 256 + rr) * 3072 + nt * 128; });
        __syncthreads();
    }
}
}
#define XB_TMO      128
#define XB_XCNT(j)  (256  + 64 * (j))
#define XB_XSUB(j)  (1280 + 64 * (j))
#define XB_XGEN(j)  (2304 + 64 * (j))
#define XB_TOP      3328
#define XB_TOPGEN   3392
#define XCD_BAR_WORDS 3456
#define XB_SPIN_CAP (1u << 18)

__device__ __forceinline__ unsigned xb_ld(unsigned* p)              { return __hip_atomic_load(p, __ATOMIC_RELAXED, __HIP_MEMORY_SCOPE_AGENT); }
__device__ __forceinline__ unsigned xb_add(unsigned* p, unsigned v) { return __hip_atomic_fetch_add(p, v, __ATOMIC_RELAXED, __HIP_MEMORY_SCOPE_AGENT); }
__device__ __forceinline__ unsigned xb_xcc_id() { return (unsigned)__builtin_amdgcn_s_getreg((3 << 11) | 20) & 0xFu; }
#define XB_SPIN(cond, bar) do { unsigned _sp = 0; while (cond) { __builtin_amdgcn_s_sleep(1); \
    if ((++_sp & 255u) == 0u) { if (xb_ld(&(bar)[XB_TMO])) break; if (_sp > XB_SPIN_CAP) { atomicAdd(&(bar)[XB_TMO], 1u); break; } } } } while (0)

struct XcdBarrier {
    unsigned* bar; unsigned x;
    volatile LAS unsigned* st;
};

__device__ __forceinline__ XcdBarrier xcd_barrier_post(unsigned* bar, volatile LAS unsigned* st) {
    XcdBarrier b; b.bar = bar; b.x = xb_xcc_id(); b.st = st;
    if (threadIdx.x == 0) (void)xb_add(&bar[XB_XCNT(b.x)], 1u);
    return b;
}
__device__ __forceinline__ void xcd_barrier_complete(unsigned* bar, unsigned x, unsigned& nloc, unsigned& nx) {
    const unsigned G = gridDim.x * gridDim.y * gridDim.z;
    unsigned sum, cnt, mine, sp = 0u;
    for (;;) {
        sum = 0u; cnt = 0u; mine = 0u;
#pragma unroll
        for (unsigned j = 0; j < 16; ++j) { const unsigned c = xb_ld(&bar[XB_XCNT(j)]); sum += c; cnt += (c > 0u) ? 1u : 0u; mine = (j == x) ? c : mine; }
        if (sum == G) break;
        __builtin_amdgcn_s_sleep(1);
        if ((++sp & 255u) == 0u) { if (xb_ld(&bar[XB_TMO])) break; if (sp > XB_SPIN_CAP) { atomicAdd(&bar[XB_TMO], 1u); break; } }
    }
    nloc = mine > 0u ? mine : 1u; nx = cnt > 0u ? cnt : 1u;
}

__device__ __forceinline__ void xcd_barrier(const XcdBarrier& b) {
    asm volatile("s_waitcnt vmcnt(0)" ::: "memory");
    __syncthreads();
    if (threadIdx.x == 0) {
        unsigned* bar = b.bar;
        __builtin_amdgcn_s_waitcnt(0);
        unsigned nloc = b.st[0], nx = b.st[1];
        if (nloc == 0u) { xcd_barrier_complete(bar, b.x, nloc, nx); b.st[0] = nloc; b.st[1] = nx; }
        const unsigned old = xb_add(&bar[XB_XSUB(b.x)], 1u);
        const unsigned gen = old / nloc;
        if (old + 1u == (gen + 1u) * nloc) {
            __builtin_amdgcn_fence(__ATOMIC_RELEASE, "agent");
            asm volatile("s_waitcnt vmcnt(0)" ::: "memory");
            const unsigned og = xb_add(&bar[XB_TOP], 1u);
            const unsigned tg = og / nx;
            if (og + 1u == (tg + 1u) * nx) xb_add(&bar[XB_TOPGEN], 1u);
            else XB_SPIN(xb_ld(&bar[XB_TOPGEN]) == tg, bar);
            __builtin_amdgcn_fence(__ATOMIC_ACQUIRE, "agent");
            xb_add(&bar[XB_XGEN(b.x)], 1u);
            asm volatile("s_waitcnt vmcnt(0)" ::: "memory");
        } else {
            XB_SPIN(xb_ld(&bar[XB_XGEN(b.x)]) == gen, bar);
            __builtin_amdgcn_fence(__ATOMIC_ACQUIRE, "agent");
            asm volatile("s_waitcnt vmcnt(0)" ::: "memory");
        }
    }
    __syncthreads();
}
namespace mk {
using namespace fx;
constexpr int NB = 4;
typedef Plan<NB> PL;

__global__ void __launch_bounds__(512, 2) k_mega(P p) {
    extern __shared__ __attribute__((aligned(16))) unsigned char lds_raw[];
    LAS unsigned char* lds = (LAS unsigned char*)lds_raw;
    unsigned char* ws = p.ws;
    const In& in = p.in;
    LAS unsigned* xbw = (LAS unsigned*)(lds + LDS_BYTES - 16);
    if (threadIdx.x == 0) { xbw[0] = 0u; xbw[1] = 0u; xbw[2] = 0u; xbw[3] = 0u; }
    __syncthreads();
    XcdBarrier bar = xcd_barrier_post((unsigned*)(ws + PL::CTL_BAR), (volatile LAS unsigned*)xbw);
    float* modv = (float*)(ws + PL::MODV);
    const float* mod0 = modv; const float* mod1 = modv + 5 * 6144;
    bf16* H = (bf16*)(ws + PL::H);
    int* cnt0 = (int*)(ws + PL::CTL_CNT); int* cnt1 = cnt0 + 32 * 64;
    int* list = (int*)(ws + PL::LIST); float* rw = (float*)(ws + PL::RW);
    bf16* wmoe0 = (bf16*)(ws + PL::W_MOE0); bf16* wmoe1 = (bf16*)(ws + PL::W_MOE1);
    const size_t GU = (size_t)32 * 1024 * 1024;
    float* X1 = (float*)(ws + PL::X1); float* X2 = (float*)(ws + PL::X2); float* X3 = (float*)(ws + PL::X3);
    const float* X1c = (const float*)((const bf16*)X1 + PL::TL * D); const float* X2c = (const float*)((const bf16*)X2 + PL::TL * D);
#ifndef MOE1_EARLY
#define MOE1_EARLY 1792
#endif
#ifndef REPMASK
#define REPMASK 0
#endif
#ifndef XBAR
#define XBAR 0
#endif
#define PH(k, ...) { __VA_ARGS__; xcd_barrier(bar); if ((REPMASK >> (k)) & 1) { __VA_ARGS__; xcd_barrier(bar); } }
    PH(0, conv_small_weights(in, ws, PL::W_IN, PL::W_OUT, PL::W_QKV, PL::W_NAO, lds); mod_vectors(in, modv, lds); conv_moe_weights(in, 0, wmoe0, wmoe0 + GU, lds))
    for (int i = 0; i < XBAR; ++i) xcd_barrier(bar);
    PH(1, rows_phase<NB, false, false, true, false>(in.x, in.ctx, PL::T, nullptr, mod0, mod0, nullptr, nullptr, in.norm1_w, 0, 1, H,
                                              nullptr, nullptr, nullptr, nullptr, nullptr, nullptr, nullptr, 0, lds))
    phase_inproj8<NB>(H, (const bf16*)(ws + PL::W_IN), (bf16*)(ws + PL::PROJ), (float*)(ws + PL::GATES), lds);
    xcd_barrier(bar);
#ifdef GVAR
    phase_inproj_v<NB, GVAR>(H, (const bf16*)(ws + PL::W_IN), (bf16*)(ws + PL::PROJ), (float*)(ws + PL::GATES), lds, p.out == nullptr);
    xcd_barrier(bar);
#endif
    PH(3, phase_tables<NB>(in, (const float*)(ws + PL::GATES), ws + PL::H, lds); phase_conv<NB>((const bf16*)(ws + PL::PROJ), in.ab_conv_w, in.ab_conv_b, (bf16*)(ws + PL::XBC)))
    phase_scan<NB>((const bf16*)(ws + PL::PROJ), ws + PL::H, (const bf16*)(ws + PL::XBC), (bf16*)(ws + PL::SC), lds);
    xcd_barrier(bar);
#ifdef SCANMODE
    phase_scan<NB>((const bf16*)(ws + PL::PROJ), ws + PL::H, (const bf16*)(ws + PL::XBC), (bf16*)(ws + PL::SC), lds, p.out ? SCANMODE : 3);
    xcd_barrier(bar);
#endif
#ifdef REP5
    phase_mixer_out<NB>(in, (const bf16*)(ws + PL::PROJ), (const bf16*)(ws + PL::XBC), (bf16*)(ws + PL::SC), (bf16*)(ws + PL::W_MOE1));
    xcd_barrier(bar);
#endif
    phase_mixer_out<NB>(in, (const bf16*)(ws + PL::PROJ), (const bf16*)(ws + PL::XBC), (bf16*)(ws + PL::SC));
    xcd_barrier(bar);
    PH(6, phase_outproj8<NB, false>((const bf16*)(ws + PL::SC), 4096, 2048, (const bf16*)(ws + PL::W_OUT), PL::T, in.x, in.ctx, mod0, (bf16*)X1, lds,
        [&](int rank, int nidle) { conv_moe_weights(in, 1, wmoe1, wmoe1 + GU, lds, 0, MOE1_EARLY, rank, nidle); }))
    rows_phase<NB, false, false, true, true, true>(X1, X1c, PL::T, nullptr, mod0, mod0, nullptr, nullptr, in.norm2_w, 3, 4, H,
        in.moe_w_group, in.moe_b_group, in.moe_w_expert, in.moe_b_expert, rw, cnt0, list, (int)PL::T, lds);
    PH(7, conv_moe_weights(in, 1, wmoe1, wmoe1 + GU, lds, MOE1_EARLY, MOE_CONV_UNITS))
    PH(8, phase_moe_up8(H, wmoe0, cnt0, list, (int)PL::T, rw, (bf16*)(ws + PL::ACT), lds))
    PH(9, phase_moe_down8((const bf16*)(ws + PL::ACT), wmoe0 + GU, cnt0, list, (int)PL::T, (bf16*)(ws + PL::Y2), lds))
    PH(10, rows_phase<NB, true, true, true, false, true>(X1, X1c, PL::T, (const bf16*)(ws + PL::Y2), mod0, mod1, X2, nullptr, in.norm1_w + 1024, 0, 1, H,
        nullptr, nullptr, nullptr, nullptr, nullptr, nullptr, nullptr, 0, lds))
    PH(11, phase_qkv8<NB>(H, (const bf16*)(ws + PL::W_QKV), in.na_q_norm, in.na_k_norm, (bf16*)(ws + PL::QKV), lds))
    PH(12, phase_attn<NB>((const bf16*)(ws + PL::QKV), in.na_rpb, (bf16*)(ws + PL::AO), lds))
    PH(13, phase_outproj8<NB, true>((const bf16*)(ws + PL::AO), 1024, 1024, (const bf16*)(ws + PL::W_NAO), PL::TL, X2, X2c, mod1, (bf16*)X3, lds, [](int, int) {}))
    rows_phase<NB, false, false, true, true, true>(X3, X3, PL::TL, nullptr, mod1, mod1, nullptr, nullptr, in.norm2_w + 1024, 3, 4, H,
        in.moe_w_group + 1024 * 4, in.moe_b_group + 4, in.moe_w_expert + 1024 * 32, in.moe_b_expert + 32, rw, cnt1, list, (int)PL::T, lds);
    xcd_barrier(bar);
    PH(15, phase_moe_up8(H, wmoe1, cnt1, list, (int)PL::T, rw, (bf16*)(ws + PL::ACT), lds))
    PH(16, phase_moe_down8((const bf16*)(ws + PL::ACT), wmoe1 + GU, cnt1, list, (int)PL::T, (bf16*)(ws + PL::Y2), lds))
    rows_phase<NB, true, false, false, false, true>(X3, X3, PL::TL, (const bf16*)(ws + PL::Y2), mod1, mod1, nullptr, p.out, nullptr, 0, 0, nullptr,
        nullptr, nullptr, nullptr, nullptr, nullptr, nullptr, nullptr, 0, lds);
    if ((REPMASK >> 17) & 1) { xcd_barrier(bar); rows_phase<NB, true, false, false, false, true>(X3, X3, PL::TL, (const bf16*)(ws + PL::Y2), mod1, mod1, nullptr, p.out, nullptr, 0, 0, nullptr,
        nullptr, nullptr, nullptr, nullptr, nullptr, nullptr, nullptr, 0, lds); }
#undef PH
}
__global__ void k_fill(float* q, size_t n, float v) { size_t i = (size_t)blockIdx.x * 256 + threadIdx.x; if (i < n) q[i] = v; }
}

extern "C" void kernel_launch(void* const* d_in, const int* in_sizes, int n_in, void* d_out, int out_size, void* d_ws, size_t ws_size, hipStream_t stream) {
    static int grid = 0;
    if (grid == 0) {
        int dev = 0, cus = 0, per_cu = 0;
        (void)hipGetDevice(&dev);
        (void)hipDeviceGetAttribute(&cus, hipDeviceAttributeMultiprocessorCount, dev);
        if (hipFuncSetAttribute((const void*)mk::k_mega, hipFuncAttributeMaxDynamicSharedMemorySize, fx::LDS_BYTES) != hipSuccess) { grid = -1; }
        else {
            if (hipOccupancyMaxActiveBlocksPerMultiprocessor(&per_cu, (const void*)mk::k_mega, 512, fx::LDS_BYTES) != hipSuccess) per_cu = 0;
            (void)hipGetLastError();
            grid = per_cu >= 1 ? cus : -1;
        }
    }
    if (grid < 0 || n_in != 31 || mk::PL::END > ws_size) { mk::k_fill<<<(out_size + 255) / 256, 256, 0, stream>>>((float*)d_out, (size_t)out_size, 2.f); return; }
    (void)hipMemsetAsync((unsigned char*)d_ws + mk::PL::CTL, 0, mk::PL::CTL_BYTES, stream);
    fx::P fp;
    { const float** q = (const float**)&fp.in; for (int i = 0; i < 31; ++i) q[i] = (const float*)d_in[i]; }
    fp.ws = (unsigned char*)d_ws; fp.out = (float*)d_out;
    hipLaunchKernelGGL(mk::k_mega, dim3(grid), dim3(512), fx::LDS_BYTES, stream, fp);
}
```
